# Optimizing an MI355X kernel written in HIP

```python
import math
import jax, jax.numpy as jnp
from jax import lax
import numpy as np

D_MODEL = 1024
BATCH = 16
SEQ = 2048
DEPTH = 2

N_EVEN = (DEPTH + 1) // 2
N_ODD = DEPTH // 2

S5_WIDTH = D_MODEL // 2
S5_GROUP = 16
S5_GROUPS = S5_WIDTH // S5_GROUP
S5_STATE = 64
S5_DT_MIN = 1e-3
S5_DT_MAX = 1e-1
MOBA_WIDTH = D_MODEL // 2
MOBA_HEAD_DIM = 64
MOBA_HEADS = MOBA_WIDTH // MOBA_HEAD_DIM
MOBA_BLOCK = 256
MOBA_TOPK = 3
MOBA_Q_CHUNK = 16
REL_BUCKETS = 32
REL_MAX_DIST = 2048
GLA_HEADS = 4
GLA_KEY_DIM = D_MODEL // 2
GLA_VAL_DIM = D_MODEL
GLA_DK = GLA_KEY_DIM // GLA_HEADS
GLA_DV = GLA_VAL_DIM // GLA_HEADS
GLA_GATE_RANK = 16
GLA_GATE_TAU = 16.0
GLA_CHUNK = 64
N_EXPERTS = 32
TOP_K = 4
D_FF = D_MODEL
SWIGLU_LIMIT = 7.0
SWIGLU_ALPHA = 1.702
MOE_BLOCK = 256
DN_ALPHA = (2 * DEPTH) ** 0.25
DN_BETA = (8 * DEPTH) ** -0.25
LN_EPS = 1e-5
RMS_EPS = 1e-5

IN0 = S5_WIDTH + 3 * MOBA_WIDTH
IN1 = 2 * GLA_KEY_DIM + 2 * GLA_VAL_DIM + GLA_GATE_RANK

kernel_name = "hybrid_s5_moba_gla_moe_deepnorm"


def layer_norm(x, g, b):
    xf = x.astype(jnp.float32)
    mu = jnp.mean(xf, -1, keepdims=True)
    var = jnp.mean(jnp.square(xf - mu), -1, keepdims=True)
    return ((xf - mu) * lax.rsqrt(var + LN_EPS) * g + b).astype(x.dtype)


def _cplx_scan_op(e1, e2):
    a1r, a1i, b1r, b1i = e1
    a2r, a2i, b2r, b2i = e2
    ar = a2r * a1r - a2i * a1i
    ai = a2r * a1i + a2i * a1r
    br = a2r * b1r - a2i * b1i + b2r
    bi = a2r * b1i + a2i * b1r + b2i
    return ar, ai, br, bi


def s5_mixer(u, lam_re, lam_im, log_dt, b_re, b_im, c_re, c_im, d_skip, w_glu, b_glu):
    Bn, L, _ = u.shape
    f32 = jnp.float32
    G, P, H = S5_GROUPS, S5_STATE, S5_GROUP
    ug = u.astype(f32).reshape(Bn, L, G, H)
    dt = jnp.exp(log_dt.astype(f32))[:, None]
    lr, li = lam_re.astype(f32), lam_im.astype(f32)
    mag = jnp.exp(lr * dt)
    ab_re, ab_im = mag * jnp.cos(li * dt), mag * jnp.sin(li * dt)
    er, ei = ab_re - 1.0, ab_im
    den = lr * lr + li * li
    q_re = (er * lr + ei * li) / den
    q_im = (ei * lr - er * li) / den
    br_, bi_ = b_re.astype(f32), b_im.astype(f32)
    bb_re = q_re[..., None] * br_ - q_im[..., None] * bi_
    bb_im = q_re[..., None] * bi_ + q_im[..., None] * br_
    bu_re = jnp.einsum('blgh,gph->lbgp', ug, bb_re)
    bu_im = jnp.einsum('blgh,gph->lbgp', ug, bb_im)
    a_re = jnp.broadcast_to(ab_re[None, None], (L, 1, G, P))
    a_im = jnp.broadcast_to(ab_im[None, None], (L, 1, G, P))
    _, _, s_re, s_im = lax.associative_scan(_cplx_scan_op, (a_re, a_im, bu_re, bu_im), axis=0)
    y = (jnp.einsum('lbgp,ghp->blgh', s_re, c_re.astype(f32))
         - jnp.einsum('lbgp,ghp->blgh', s_im, c_im.astype(f32))
         + ug * d_skip.astype(f32))
    y = jax.nn.gelu(y.reshape(Bn, L, S5_WIDTH))
    y = y * jax.nn.sigmoid(y @ w_glu.astype(f32) + b_glu.astype(f32))
    return y.astype(u.dtype)


def rel_bucket(n):
    n = jnp.maximum(n, 0)
    max_exact = REL_BUCKETS // 2
    nf = jnp.maximum(n, 1).astype(jnp.float32)
    large = max_exact + (jnp.log(nf / max_exact) / math.log(REL_MAX_DIST / max_exact)
                         * (REL_BUCKETS - max_exact)).astype(jnp.int32)
    large = jnp.minimum(large, REL_BUCKETS - 1)
    return jnp.where(n < max_exact, n, large)


def moba_attention(q, k, v, rel_table):
    Bn, L, _ = q.shape
    H, dh, bs, qcn = MOBA_HEADS, MOBA_HEAD_DIM, MOBA_BLOCK, MOBA_Q_CHUNK
    Lp = -(-L // bs) * bs
    nb = Lp // bs
    topk = min(MOBA_TOPK, nb)
    f32 = jnp.float32

    def heads(t):
        t = t.astype(f32).reshape(Bn, L, H, dh).transpose(0, 2, 1, 3)
        return jnp.pad(t, ((0, 0), (0, 0), (0, Lp - L), (0, 0)))

    qh = heads(q) * dh ** -0.5
    kh, vh = heads(k), heads(v)
    kb = kh.reshape(Bn, H, nb, bs, dh)
    vb = vh.reshape(Bn, H, nb, bs, dh)
    kmean = jnp.mean(kb, axis=3)
    table_t = rel_table.astype(f32).T
    b_ix = jnp.arange(Bn)[:, None, None, None]
    h_ix = jnp.arange(H)[None, :, None, None]
    neg = jnp.finfo(f32).min

    def chunk(start):
        qc = lax.dynamic_slice_in_dim(qh, start, qcn, axis=2)
        qpos = start + jnp.arange(qcn)
        own = start // bs
        ko = lax.dynamic_slice_in_dim(kh, own * bs, bs, axis=2)
        vo = lax.dynamic_slice_in_dim(vh, own * bs, bs, axis=2)
        rel_o = qpos[:, None] - (own * bs + jnp.arange(bs))[None, :]
        s_own = jnp.einsum('bhqd,bhkd->bhqk', qc, ko) + table_t[:, rel_bucket(rel_o)]
        s_own = jnp.where(rel_o >= 0, s_own, neg)
        gate = jnp.einsum('bhqd,bhnd->bhqn', qc, kmean)
        gate = jnp.where(jnp.arange(nb) < own, gate, neg)
        _, idx = lax.top_k(gate, topk)
        valid = jnp.arange(topk) < own
        ks = kb[b_ix, h_ix, idx]
        vs = vb[b_ix, h_ix, idx]
        rel_s = qpos[:, None, None] - (idx[..., None] * bs + jnp.arange(bs))
        s_sel = (jnp.einsum('bhqd,bhqjkd->bhqjk', qc, ks)
                 + table_t[h_ix[..., None], rel_bucket(rel_s)])
        s_sel = jnp.where(valid[:, None], s_sel, neg).reshape(Bn, H, qcn, topk * bs)
        p = jax.nn.softmax(jnp.concatenate([s_own, s_sel], axis=-1), axis=-1)
        o = (jnp.einsum('bhqk,bhkd->bhqd', p[..., :bs], vo)
             + jnp.einsum('bhqjk,bhqjkd->bhqd', p[..., bs:].reshape(Bn, H, qcn, topk, bs), vs))
        return o

    starts = jnp.arange(0, Lp, qcn, dtype=jnp.int32)
    out = lax.map(chunk, starts)
    out = out.transpose(1, 2, 0, 3, 4).reshape(Bn, H, Lp, dh)[:, :, :L]
    return out.transpose(0, 2, 1, 3).reshape(Bn, L, H * dh).astype(q.dtype)


def gla_mixer(q, k, v, log_a, g, norm_w):
    Bn, L, _ = q.shape
    H, dk, dv, C = GLA_HEADS, GLA_DK, GLA_DV, GLA_CHUNK
    n = L // C
    f32 = jnp.float32

    def split(t, d):
        return t.astype(f32).reshape(Bn, n, C, H, d).transpose(0, 3, 1, 2, 4)

    qc = split(q, dk) * dk ** -0.5
    kc, vc, lg = split(k, dk), split(v, dv), split(log_a, dk)
    bcum = jnp.cumsum(lg, axis=3)
    btot = bcum[:, :, :, -1:]
    q_in = qc * jnp.exp(bcum)
    k_in = kc * jnp.exp(-bcum)
    k_st = kc * jnp.exp(btot - bcum)
    causal = jnp.tril(jnp.ones((C, C), dtype=bool))
    att = jnp.where(causal, jnp.einsum('bhnid,bhnjd->bhnij', q_in, k_in), 0.0)
    o_intra = jnp.einsum('bhnij,bhnjv->bhniv', att, vc)
    kv = jnp.einsum('bhnjd,bhnjv->bhndv', k_st, vc)
    decay = jnp.exp(btot[:, :, :, 0])

    def step(S, inp):
        dec, kv_c = inp
        return dec[..., None] * S + kv_c, S

    S0 = jnp.zeros((Bn, H, dk, dv), f32)
    _, S_prev = lax.scan(step, S0, (decay.transpose(2, 0, 1, 3), kv.transpose(2, 0, 1, 3, 4)))
    o = o_intra + jnp.einsum('bhnid,nbhdv->bhniv', q_in, S_prev)
    o = o.transpose(0, 2, 3, 1, 4).reshape(Bn, L, H, dv)
    o = o * lax.rsqrt(jnp.mean(o * o, -1, keepdims=True) + RMS_EPS) * norm_w.astype(f32)
    o = o.reshape(Bn, L, H * dv) * jax.nn.silu(g.astype(f32))
    return o.astype(q.dtype)


def moe_ffn(x, w_router, b_router, w_gate_up, b_gate_up, w_down, b_down):
    Bn, L, D = x.shape
    f32 = jnp.float32
    T = Bn * L
    A = T * TOP_K
    xt = x.reshape(T, D)
    logits = (xt @ w_router + b_router).astype(f32)
    top_v, top_i = lax.top_k(logits, TOP_K)
    top_w = jax.nn.softmax(top_v, axis=-1)
    e_flat = top_i.reshape(A)
    tok_flat = jnp.repeat(jnp.arange(T, dtype=jnp.int32), TOP_K)
    w_flat = top_w.reshape(A)
    order = jnp.argsort(e_flat)
    se, st, sw = e_flat[order], tok_flat[order], w_flat[order]
    counts = jnp.bincount(e_flat, length=N_EXPERTS)
    padded = (counts + MOE_BLOCK - 1) // MOE_BLOCK * MOE_BLOCK
    start_src = jnp.cumsum(counts) - counts
    start_dst = jnp.cumsum(padded) - padded
    dest = start_dst[se] + jnp.arange(A) - start_src[se]
    P = A + N_EXPERTS * MOE_BLOCK
    pad_tok = jnp.zeros((P,), jnp.int32).at[dest].set(st)
    pad_w = jnp.zeros((P,), f32).at[dest].set(sw)
    nblk = P // MOE_BLOCK
    blk_end = jnp.cumsum(padded // MOE_BLOCK)
    blk_expert = jnp.minimum(jnp.searchsorted(blk_end, jnp.arange(nblk), side='right'), N_EXPERTS - 1)
    xs = xt[pad_tok].reshape(nblk, MOE_BLOCK, D)

    def expert_block(args):
        xb, e = args
        h = (xb @ w_gate_up[e] + b_gate_up[e]).astype(f32)
        gate = jnp.minimum(h[:, 0::2], SWIGLU_LIMIT)
        up = jnp.clip(h[:, 1::2], -SWIGLU_LIMIT, SWIGLU_LIMIT)
        act = gate * jax.nn.sigmoid(SWIGLU_ALPHA * gate) * (up + 1.0)
        return (act.astype(xb.dtype) @ w_down[e] + b_down[e]).astype(f32)

    ys = lax.map(expert_block, (xs, blk_expert)).reshape(P, D)
    out = jnp.zeros((T, D), f32).at[pad_tok].add(ys * pad_w[:, None])
    return out.reshape(Bn, L, D).astype(x.dtype)


def setup_inputs(seed: int = 0) -> dict:
    key = jax.random.key(seed)
    ks = iter(jax.random.split(key, 40))
    f32 = jnp.float32

    def nrm(shape, scale):
        return jax.random.normal(next(ks), shape, f32) * scale

    NE, NO = N_EVEN, N_ODD
    G, P, H = S5_GROUPS, S5_STATE, S5_GROUP
    x = nrm((BATCH, SEQ, D_MODEL), 1.0)
    w_in0 = nrm((NE, D_MODEL, IN0), D_MODEL ** -0.5)
    s5_lam_re = -0.5 + nrm((NE, G, P), 0.01)
    s5_lam_im = jnp.pi * jnp.arange(P, dtype=f32) + nrm((NE, G, P), 0.01)
    s5_log_dt = jax.random.uniform(next(ks), (NE, G), f32, math.log(S5_DT_MIN), math.log(S5_DT_MAX))
    s5_b_re = nrm((NE, G, P, H), (2 * H) ** -0.5)
    s5_b_im = nrm((NE, G, P, H), (2 * H) ** -0.5)
    s5_c_re = nrm((NE, G, H, P), P ** -0.5)
    s5_c_im = nrm((NE, G, H, P), P ** -0.5)
    s5_d = nrm((NE, G, H), 1.0)
    s5_w_glu = nrm((NE, S5_WIDTH, S5_WIDTH), S5_WIDTH ** -0.5)
    s5_b_glu = nrm((NE, S5_WIDTH), 0.01)
    rel_bias = nrm((REL_BUCKETS, MOBA_HEADS), 0.5)
    w_out0 = nrm((NE, D_MODEL, D_MODEL), D_MODEL ** -0.5 * DN_BETA)
    w_in1 = nrm((NO, D_MODEL, IN1), D_MODEL ** -0.5)
    gla_w_gate2 = nrm((NO, GLA_GATE_RANK, GLA_KEY_DIM), GLA_GATE_RANK ** -0.5)
    gla_b_gate = nrm((NO, GLA_KEY_DIM), 0.1)
    gla_norm_w = 1.0 + nrm((NO, GLA_DV), 0.01)
    w_out1 = nrm((NO, GLA_VAL_DIM, D_MODEL), GLA_VAL_DIM ** -0.5 * DN_BETA)
    ln_mix_g = 1.0 + nrm((DEPTH, D_MODEL), 0.01)
    ln_mix_b = nrm((DEPTH, D_MODEL), 0.01)
    ln_ffn_g = 1.0 + nrm((DEPTH, D_MODEL), 0.01)
    ln_ffn_b = nrm((DEPTH, D_MODEL), 0.01)
    router_w = nrm((DEPTH, D_MODEL, N_EXPERTS), D_MODEL ** -0.5)
    router_b = nrm((DEPTH, N_EXPERTS), 0.01)
    exp_w_gate_up = nrm((DEPTH, N_EXPERTS, D_MODEL, 2 * D_FF), D_MODEL ** -0.5)
    exp_b_gate_up = nrm((DEPTH, N_EXPERTS, 2 * D_FF), 0.01)
    exp_w_down = nrm((DEPTH, N_EXPERTS, D_FF, D_MODEL), D_FF ** -0.5 * DN_BETA)
    exp_b_down = nrm((DEPTH, N_EXPERTS, D_MODEL), 0.01)
    return {"x": x, "w_in0": w_in0, "s5_lam_re": s5_lam_re, "s5_lam_im": s5_lam_im,
            "s5_log_dt": s5_log_dt, "s5_b_re": s5_b_re, "s5_b_im": s5_b_im,
            "s5_c_re": s5_c_re, "s5_c_im": s5_c_im, "s5_d": s5_d, "s5_w_glu": s5_w_glu,
            "s5_b_glu": s5_b_glu, "rel_bias": rel_bias, "w_out0": w_out0, "w_in1": w_in1,
            "gla_w_gate2": gla_w_gate2, "gla_b_gate": gla_b_gate, "gla_norm_w": gla_norm_w,
            "w_out1": w_out1, "ln_mix_g": ln_mix_g, "ln_mix_b": ln_mix_b, "ln_ffn_g": ln_ffn_g,
            "ln_ffn_b": ln_ffn_b, "router_w": router_w, "router_b": router_b,
            "exp_w_gate_up": exp_w_gate_up, "exp_b_gate_up": exp_b_gate_up,
            "exp_w_down": exp_w_down, "exp_b_down": exp_b_down}


def reference(x, w_in0, s5_lam_re, s5_lam_im, s5_log_dt, s5_b_re, s5_b_im, s5_c_re, s5_c_im,
              s5_d, s5_w_glu, s5_b_glu, rel_bias, w_out0, w_in1, gla_w_gate2, gla_b_gate,
              gla_norm_w, w_out1, ln_mix_g, ln_mix_b, ln_ffn_g, ln_ffn_b, router_w, router_b,
              exp_w_gate_up, exp_b_gate_up, exp_w_down, exp_b_down):
    f32 = jnp.float32
    for i in range(DEPTH):
        j = i // 2
        if i % 2 == 0:
            h = x @ w_in0[j]
            u, q, k, v = jnp.split(h, [S5_WIDTH, S5_WIDTH + MOBA_WIDTH, S5_WIDTH + 2 * MOBA_WIDTH], axis=-1)
            y_a = s5_mixer(u, s5_lam_re[j], s5_lam_im[j], s5_log_dt[j], s5_b_re[j], s5_b_im[j],
                           s5_c_re[j], s5_c_im[j], s5_d[j], s5_w_glu[j], s5_b_glu[j])
            y_b = moba_attention(q, k, v, rel_bias)
            mix = jnp.concatenate([y_a, y_b], axis=-1) @ w_out0[j]
        else:
            h = x @ w_in1[j]
            q, k, v, g, gr = jnp.split(h, [GLA_KEY_DIM, 2 * GLA_KEY_DIM, 2 * GLA_KEY_DIM + GLA_VAL_DIM,
                                           2 * GLA_KEY_DIM + 2 * GLA_VAL_DIM], axis=-1)
            log_a = jax.nn.log_sigmoid((gr @ gla_w_gate2[j] + gla_b_gate[j]).astype(f32)) / GLA_GATE_TAU
            mix = gla_mixer(q, k, v, log_a, g, gla_norm_w[j]) @ w_out1[j]
        x = layer_norm(DN_ALPHA * x + mix, ln_mix_g[i], ln_mix_b[i])
        ffn = moe_ffn(x, router_w[i], router_b[i], exp_w_gate_up[i], exp_b_gate_up[i],
                      exp_w_down[i], exp_b_down[i])
        x = layer_norm(DN_ALPHA * x + ffn, ln_ffn_g[i], ln_ffn_b[i])
    return x
```

```cpp
#include <hip/hip_runtime.h>
#include <cstdio>
#include <cstdint>
#include <cmath>
#include <cstring>
#define DEV __device__ __forceinline__
constexpr int Bn = 16, L = 2048, D = 1024, T = Bn * L;
namespace nv {
typedef unsigned short bf16_t;
DEV float bf2f(bf16_t h) { return __uint_as_float(((unsigned)h) << 16); }
DEV bf16_t f2bf(float f) { unsigned u = __float_as_uint(f); return (bf16_t)((u + 0x7fffu + ((u >> 16) & 1u)) >> 16); }
DEV float gelu_tanh(float x) { const float c = 0.7978845608028654f; float u = c * (x + 0.044715f * x * x * x); return 0.5f * x * (1.f + tanhf(u)); }
DEV float sigm(float x) { return 1.f / (1.f + expf(-x)); }
DEV float logsigm(float z) { return fminf(z, 0.f) - log1pf(expf(-fabsf(z))); }

struct GemmArgs { const void* A; const int* rowmap; const float* B; const int* tile_e; size_t bstride; int lda, ldb, M, N, K, pad; };
static GemmArgs mk(const void* A, int lda, const int* rowmap, const float* B, int ldb, size_t bstride, const int* tile_e, int M, int N, int K) { GemmArgs g; memset(&g, 0, sizeof g); g.A = A; g.rowmap = rowmap; g.B = B; g.tile_e = tile_e; g.bstride = bstride; g.lda = lda; g.ldb = ldb; g.M = M; g.N = N; g.K = K; g.pad = 0; return g; }
DEV void lda4(const float* p, float (&o)[4]) { float4 v = *(const float4*)p; o[0] = v.x; o[1] = v.y; o[2] = v.z; o[3] = v.w; }
DEV void lda4(const bf16_t* p, float (&o)[4]) { uint2 v = *(const uint2*)p; o[0] = __uint_as_float(v.x << 16); o[1] = __uint_as_float(v.x & 0xffff0000u); o[2] = __uint_as_float(v.y << 16); o[3] = __uint_as_float(v.y & 0xffff0000u); }

template <class TA, class Epi> __global__ __launch_bounds__(256) void gemm(GemmArgs g, Epi epi) {
    __shared__ float As[8][132]; __shared__ float Bs[8][132];
    const int tid = threadIdx.x, tx = tid & 15, ty = tid >> 4;
    const int bm = blockIdx.y * 128, bn = blockIdx.x * 128;
    int e = 0; const float* B = g.B;
    if (g.tile_e) { e = g.tile_e[blockIdx.y]; if (e < 0) return; B += (size_t)e * g.bstride; }
    const int ar = tid >> 1, ak = (tid & 1) * 4;
    const int arow = g.rowmap ? g.rowmap[bm + ar] : bm + ar;
    const TA* Ap = (const TA*)g.A + (size_t)arow * g.lda + ak;
    const int bk = tid >> 5, bc = bn + (tid & 31) * 4;
    const bool bok = bc < g.N;
    const float* Bp = B + (size_t)bk * g.ldb + (bok ? bc : 0);
    float acc[8][8];
#pragma unroll
    for (int i = 0; i < 8; ++i)
#pragma unroll
        for (int j = 0; j < 8; ++j) acc[i][j] = 0.f;
    for (int k0 = 0; k0 < g.K; k0 += 8) {
        float av[4]; lda4(Ap + k0, av);
        float4 bv = *(const float4*)(Bp + (size_t)k0 * g.ldb);
        if (!bok) bv = make_float4(0.f, 0.f, 0.f, 0.f);
        __syncthreads();
        As[ak + 0][ar] = av[0]; As[ak + 1][ar] = av[1]; As[ak + 2][ar] = av[2]; As[ak + 3][ar] = av[3];
        *(float4*)&Bs[bk][(tid & 31) * 4] = bv;
        __syncthreads();
#pragma unroll
        for (int k = 0; k < 8; ++k) {
            float a[8], b[8];
#pragma unroll
            for (int i = 0; i < 8; ++i) a[i] = As[k][ty * 8 + i];
#pragma unroll
            for (int j = 0; j < 8; ++j) b[j] = Bs[k][tx * 8 + j];
#pragma unroll
            for (int i = 0; i < 8; ++i)
#pragma unroll
                for (int j = 0; j < 8; ++j) acc[i][j] = fmaf(a[i], b[j], acc[i][j]);
        }
    }
    const int n0 = bn + tx * 8;
    if (n0 < g.N) {
#pragma unroll
        for (int i = 0; i < 8; ++i) epi(bm + ty * 8 + i, n0, acc[i], e);
    }
}
struct EpiStore { float* C; int ldc, pad;
    DEV void operator()(int m, int n, const float (&v)[8], int) const { float4* p = (float4*)(C + (size_t)m * ldc + n); p[0] = make_float4(v[0], v[1], v[2], v[3]); p[1] = make_float4(v[4], v[5], v[6], v[7]); } };
struct EpiGlu { const float* Y; float* O; const float* b; int ldo, pad;
    DEV void operator()(int m, int n, const float (&v)[8], int) const {
#pragma unroll
        for (int j = 0; j < 8; ++j) { float y = Y[(size_t)m * 512 + n + j]; O[(size_t)m * ldo + n + j] = y * sigm(v[j] + b[n + j]); } } };
struct EpiSwiglu { bf16_t* ACT; const float* bgu;
    DEV void operator()(int m, int n, const float (&v)[8], int e) const {
#pragma unroll
        for (int p = 0; p < 4; ++p) { float gt = fminf(v[2 * p] + bgu[(size_t)e * 2048 + n + 2 * p], 7.f); float up = fminf(fmaxf(v[2 * p + 1] + bgu[(size_t)e * 2048 + n + 2 * p + 1], -7.f), 7.f);
            ACT[(size_t)m * 1024 + n / 2 + p] = f2bf(gt * sigm(1.702f * gt) * (up + 1.f)); } } };
struct EpiDown { float* FFN; const int* tok; const float* w; const float* bd;
    DEV void operator()(int m, int n, const float (&v)[8], int e) const { const float wt = w[m]; if (wt == 0.f) return; const int t = tok[m];
#pragma unroll
        for (int j = 0; j < 8; ++j) atomicAdd(FFN + (size_t)t * 1024 + n + j, wt * (v[j] + bd[(size_t)e * 1024 + n + j])); } };

__global__ __launch_bounds__(64) void s5(const float* H0, int ldh, const float* lam_re, const float* lam_im, const float* log_dt, const float* b_re, const float* b_im,
                                         const float* c_re, const float* c_im, const float* dsk, float* YS) {
    const int b = blockIdx.x / 32, g = blockIdx.x % 32, p = threadIdx.x;
    __shared__ float sre[64], sim[64], cre[16][65], cim[16][65], us[16];
    const float dt = expf(log_dt[g]); const float lr = lam_re[g * 64 + p], li = lam_im[g * 64 + p];
    const float mag = expf(lr * dt); const float ar = mag * cosf(li * dt), ai = mag * sinf(li * dt);
    const float er = ar - 1.f, ei = ai, den = lr * lr + li * li; const float qr = (er * lr + ei * li) / den, qi = (ei * lr - er * li) / den;
    float bbr[16], bbi[16];
#pragma unroll
    for (int h = 0; h < 16; ++h) { const float br = b_re[(g * 64 + p) * 16 + h], bi = b_im[(g * 64 + p) * 16 + h]; bbr[h] = qr * br - qi * bi; bbi[h] = qr * bi + qi * br; }
    for (int i = p; i < 1024; i += 64) { const int h = i / 64, pp = i % 64; cre[h][pp] = c_re[(g * 16 + h) * 64 + pp]; cim[h][pp] = c_im[(g * 16 + h) * 64 + pp]; }
    const float dd = p < 16 ? dsk[g * 16 + p] : 0.f;
    float s_r = 0.f, s_i = 0.f;
    __syncthreads();
    for (int t = 0; t < 2048; ++t) {
        const float* ur = H0 + (size_t)(b * 2048 + t) * ldh + g * 16;
        if (p < 16) us[p] = ur[p];
        __syncthreads();
        float bur = 0.f, bui = 0.f;
#pragma unroll
        for (int h = 0; h < 16; ++h) { const float u = us[h]; bur = fmaf(bbr[h], u, bur); bui = fmaf(bbi[h], u, bui); }
        const float nr = ar * s_r - ai * s_i + bur, ni = ar * s_i + ai * s_r + bui; s_r = nr; s_i = ni;
        sre[p] = s_r; sim[p] = s_i;
        __syncthreads();
        const int h = p & 15, part = p >> 4; float y = 0.f;
#pragma unroll
        for (int q = 0; q < 16; ++q) { const int pp = part * 16 + q; y += cre[h][pp] * sre[pp] - cim[h][pp] * sim[pp]; }
        y += __shfl_xor(y, 16); y += __shfl_xor(y, 32);
        if (p < 16) { y += dd * us[p]; YS[(size_t)(b * 2048 + t) * 512 + g * 16 + p] = gelu_tanh(y); }
        __syncthreads();
    }
}
__global__ __launch_bounds__(64) void kmean(const float* H0, int ldh, float* KM) {
    const int id = blockIdx.x, blk = id % 8, h = (id / 8) % 8, b = id / 64, d = threadIdx.x;
    float s = 0.f; for (int r = 0; r < 256; ++r) s += H0[(size_t)(b * 2048 + blk * 256 + r) * ldh + 1024 + h * 64 + d];
    KM[(size_t)id * 64 + d] = s * (1.f / 256.f);
}
__constant__ int BUCKET_TH[16] = {16, 22, 30, 40, 54, 73, 99, 134, 182, 246, 332, 450, 609, 825, 1117, 1513};
DEV int rel_bucket(int n) { if (n < 16) return n; int bk = 16;
#pragma unroll
    for (int i = 1; i < 16; ++i) bk += (n >= BUCKET_TH[i]) ? 1 : 0; return bk; }
__global__ __launch_bounds__(256) void moba(const float* H0, int ldh, const float* KM, const float* rel_bias, float* Y) {
    __shared__ float ps[4][1024]; __shared__ float biasl[2048];
    const int w = threadIdx.x >> 6, lane = threadIdx.x & 63;
    const long id = (long)blockIdx.x * 4 + w; const int q = (int)(id % 2048), h = (int)((id / 2048) % 8), b = (int)(id / (2048 * 8));
    for (int i = threadIdx.x; i < 2048; i += 256) biasl[i] = rel_bias[rel_bucket(i) * 8 + h];
    __syncthreads();
    const int own = q >> 8;
    const float* qrow = H0 + (size_t)(b * 2048 + q) * ldh + 512 + h * 64;
    float qv[64];
#pragma unroll
    for (int d = 0; d < 64; ++d) qv[d] = qrow[d] * 0.125f;
    float gate = -3.0e38f;
    { const int j = lane < 8 ? lane : 0; const float* km = KM + ((size_t)(b * 8 + h) * 8 + j) * 64; float s = 0.f;
#pragma unroll
      for (int d = 0; d < 64; ++d) s = fmaf(qv[d], km[d], s);
      if (lane < own) gate = s; }
    int rank = 0;
#pragma unroll
    for (int j = 0; j < 8; ++j) { const float g2 = __shfl(gate, j); if (j < own && (g2 > gate || (g2 == gate && j < lane))) ++rank; }
    const bool sel = (lane < own) && rank < 3;
    const unsigned long long selmask = __ballot(sel) | (1ull << own);
    float m = -3.0e38f; int ns = 0;
    for (int blk = 0; blk <= own; ++blk) { if (!((selmask >> blk) & 1ull)) continue;
        for (int kk = lane; kk < 256; kk += 64) { const int key = blk * 256 + kk; float s = -3.0e38f;
            if (key <= q) { const float* kr = H0 + (size_t)(b * 2048 + key) * ldh + 1024 + h * 64; s = 0.f;
#pragma unroll
                for (int d4 = 0; d4 < 16; ++d4) { const float4 kv = *(const float4*)(kr + d4 * 4); s = fmaf(qv[d4 * 4], kv.x, s); s = fmaf(qv[d4 * 4 + 1], kv.y, s); s = fmaf(qv[d4 * 4 + 2], kv.z, s); s = fmaf(qv[d4 * 4 + 3], kv.w, s); }
                s += biasl[q - key]; }
            ps[w][ns * 256 + kk] = s; m = fmaxf(m, s); }
        ++ns; }
#pragma unroll
    for (int o = 1; o < 64; o <<= 1) m = fmaxf(m, __shfl_xor(m, o));
    float sum = 0.f;
    for (int i = lane; i < ns * 256; i += 64) { const float s = ps[w][i]; const float pr = (s < -1.0e38f) ? 0.f : expf(s - m); ps[w][i] = pr; sum += pr; }
#pragma unroll
    for (int o = 1; o < 64; o <<= 1) sum += __shfl_xor(sum, o);
    __syncthreads();
    float o = 0.f; int si = 0;
    for (int blk = 0; blk <= own; ++blk) { if (!((selmask >> blk) & 1ull)) continue;
        const float* vb = H0 + (size_t)(b * 2048 + blk * 256) * ldh + 1536 + h * 64 + lane;
        for (int kk = 0; kk < 256; ++kk) { const float pr = ps[w][si * 256 + kk]; o = fmaf(pr, vb[(size_t)kk * ldh], o); }
        ++si; }
    Y[(size_t)(b * 2048 + q) * 1024 + 512 + h * 64 + lane] = o / sum;
}
__global__ __launch_bounds__(256) void ln(const float* xin, const float* add, const float* g, const float* bb, float* out) {
    const int row = blockIdx.x * 4 + (threadIdx.x >> 6), lane = threadIdx.x & 63;
    const float alpha = 1.4142135623730951f;
    float v[16]; float s = 0.f;
#pragma unroll
    for (int j = 0; j < 4; ++j) { const float4 a = *(const float4*)(xin + (size_t)row * 1024 + j * 256 + lane * 4); const float4 c = *(const float4*)(add + (size_t)row * 1024 + j * 256 + lane * 4);
        v[4 * j] = alpha * a.x + c.x; v[4 * j + 1] = alpha * a.y + c.y; v[4 * j + 2] = alpha * a.z + c.z; v[4 * j + 3] = alpha * a.w + c.w; s += v[4 * j] + v[4 * j + 1] + v[4 * j + 2] + v[4 * j + 3]; }
#pragma unroll
    for (int o = 1; o < 64; o <<= 1) s += __shfl_xor(s, o);
    const float mean = s * (1.f / 1024.f); float q = 0.f;
#pragma unroll
    for (int i = 0; i < 16; ++i) { v[i] -= mean; q += v[i] * v[i]; }
#pragma unroll
    for (int o = 1; o < 64; o <<= 1) q += __shfl_xor(q, o);
    const float rstd = 1.f / sqrtf(q * (1.f / 1024.f) + 1e-5f);
#pragma unroll
    for (int j = 0; j < 4; ++j) { const int c = j * 256 + lane * 4; float4 o4; o4.x = v[4 * j] * rstd * g[c] + bb[c]; o4.y = v[4 * j + 1] * rstd * g[c + 1] + bb[c + 1]; o4.z = v[4 * j + 2] * rstd * g[c + 2] + bb[c + 2]; o4.w = v[4 * j + 3] * rstd * g[c + 3] + bb[c + 3];
        *(float4*)(out + (size_t)row * 1024 + c) = o4; }
}
__global__ __launch_bounds__(256) void router(const float* x, const float* wr, const float* br, int* RE, float* RW, int* counts) {
    __shared__ float xs[4][1024];
    const int w = threadIdx.x >> 6, lane = threadIdx.x & 63; const int t = blockIdx.x * 4 + w;
    for (int i = lane; i < 1024; i += 64) xs[w][i] = x[(size_t)t * 1024 + i];
    __syncthreads();
    const int e = lane & 31, half = lane >> 5; float s = 0.f;
    for (int k = half * 512; k < half * 512 + 512; ++k) s = fmaf(xs[w][k], wr[(size_t)k * 32 + e], s);
    s += __shfl_xor(s, 32); s += br[e];
    float vals[4]; int idx[4]; float cur = s; bool taken = false;
#pragma unroll
    for (int r = 0; r < 4; ++r) { float best = taken ? -3.0e38f : cur; int bi = e;
#pragma unroll
        for (int o = 1; o < 32; o <<= 1) { const float ob = __shfl_xor(best, o); const int oi = __shfl_xor(bi, o); if (ob > best || (ob == best && oi < bi)) { best = ob; bi = oi; } }
        vals[r] = best; idx[r] = bi; if (e == bi) taken = true; }
    const float mx = vals[0]; float ex[4], sm = 0.f;
#pragma unroll
    for (int r = 0; r < 4; ++r) { ex[r] = expf(vals[r] - mx); sm += ex[r]; }
    if (lane == 0) {
#pragma unroll
        for (int r = 0; r < 4; ++r) { RE[t * 4 + r] = idx[r]; RW[t * 4 + r] = ex[r] / sm; atomicAdd(counts + idx[r], 1); } }
}
__global__ __launch_bounds__(256) void offsets(const int* counts, int* cursor, int* tile_e, int ntiles) {
    __shared__ int st[33];
    if (threadIdx.x == 0) { int a = 0; for (int e = 0; e < 32; ++e) { st[e] = a; a += (counts[e] + 255) / 256 * 256; } st[32] = a; }
    __syncthreads();
    if (threadIdx.x < 32) cursor[threadIdx.x] = st[threadIdx.x];
    for (int i = threadIdx.x; i < ntiles; i += 256) { const int r = i * 128; int e = -1; for (int j = 0; j < 32; ++j) if (r >= st[j] && r < st[j + 1]) e = j; tile_e[i] = e; }
}
__global__ __launch_bounds__(256) void filltok(int* tok, float* w, int n) { const int i = blockIdx.x * 256 + threadIdx.x; if (i < n) { tok[i] = 0; w[i] = 0.f; } }
__global__ __launch_bounds__(256) void scatter(const int* RE, const float* RW, int* cursor, int* tok, float* w) {
    const int i = blockIdx.x * 256 + threadIdx.x; const int e = RE[i]; const int pos = atomicAdd(cursor + e, 1); tok[pos] = i >> 2; w[pos] = RW[i];
}
__global__ __launch_bounds__(256) void zero4(float4* p, size_t n4) { for (size_t i = (size_t)blockIdx.x * 256 + threadIdx.x; i < n4; i += (size_t)gridDim.x * 256) p[i] = make_float4(0.f, 0.f, 0.f, 0.f); }
__global__ __launch_bounds__(256) void gla(const float* H1, int ldh, const float* wg2, const float* bg, float* Y) {
    const int b = blockIdx.x / 4, h = blockIdx.x % 4, v = threadIdx.x;
    __shared__ float qs[128], ks[128], as[128];
    float S[128];
#pragma unroll
    for (int d = 0; d < 128; ++d) S[d] = 0.f;
    for (int t = 0; t < 2048; ++t) {
        const float* row = H1 + (size_t)(b * 2048 + t) * ldh;
        if (v < 128) { const int d = v; qs[d] = row[h * 128 + d] * 0.08838834764831845f; ks[d] = row[512 + h * 128 + d];
            float z = bg[h * 128 + d];
#pragma unroll
            for (int r = 0; r < 16; ++r) z = fmaf(row[3072 + r], wg2[r * 512 + h * 128 + d], z);
            as[d] = expf(logsigm(z) * (1.f / 16.f)); }
        __syncthreads();
        const float vv = row[1024 + h * 256 + v]; float o = 0.f;
#pragma unroll
        for (int d = 0; d < 128; ++d) { S[d] = fmaf(as[d], S[d], ks[d] * vv); o = fmaf(qs[d], S[d], o); }
        Y[(size_t)(b * 2048 + t) * 1024 + h * 256 + v] = o;
        __syncthreads();
    }
}
__global__ __launch_bounds__(256) void gla_norm(float* Y, const float* H1, int ldh, const float* nw) {
    const long id = (long)blockIdx.x * 4 + (threadIdx.x >> 6); const int lane = threadIdx.x & 63; const int h = (int)(id & 3); const long t = id >> 2;
    float* p = Y + (size_t)t * 1024 + h * 256 + lane * 4; const float4 o = *(float4*)p; float q = o.x * o.x + o.y * o.y + o.z * o.z + o.w * o.w;
#pragma unroll
    for (int s = 1; s < 64; s <<= 1) q += __shfl_xor(q, s);
    const float r = 1.f / sqrtf(q * (1.f / 256.f) + 1e-5f);
    const float4 g = *(const float4*)(H1 + (size_t)t * ldh + 2048 + h * 256 + lane * 4); const float4 w4 = *(const float4*)(nw + lane * 4);
    float4 y; y.x = o.x * r * w4.x * (g.x * sigm(g.x)); y.y = o.y * r * w4.y * (g.y * sigm(g.y)); y.z = o.z * r * w4.z * (g.z * sigm(g.z)); y.w = o.w * r * w4.w * (g.w * sigm(g.w));
    *(float4*)p = y;
}

constexpr size_t MB = 1u << 20;
constexpr int PMAX = 131072 + 32 * 256;
constexpr size_t O_X = 0, O_H = O_X + 128 * MB, O_YS5 = O_H + 388 * MB, O_Y = O_YS5 + 64 * MB, O_MIX = O_Y + 128 * MB, O_ACT = O_MIX + 128 * MB, O_SM = O_ACT + 272 * MB, O_END = O_SM + 8 * MB;
static_assert((size_t)T * 3088 * 4 <= 388 * MB && (size_t)PMAX * 1024 * 2 <= 272 * MB, "nv map");
constexpr size_t S_KM = 0, S_RE = 1 * MB, S_RW = 2 * MB, S_CNT = 3 * MB, S_CUR = 3 * MB + 4096, S_TE = 3 * MB + 8192, S_TOK = 4 * MB, S_W = 5 * MB;

struct In { const float* p[29]; };

static void moe(hipStream_t st, unsigned char* ws, const In& in, int layer, float* X  , float* out  ) {
    unsigned char* sm = ws + O_SM; int* RE = (int*)(sm + S_RE); float* RW = (float*)(sm + S_RW); int* cnt = (int*)(sm + S_CNT); int* cur = (int*)(sm + S_CUR); int* te = (int*)(sm + S_TE); int* tok = (int*)(sm + S_TOK); float* wt = (float*)(sm + S_W);
    float* FFN = (float*)(ws + O_MIX); bf16_t* ACT = (bf16_t*)(ws + O_ACT);
    (void)hipMemsetAsync(cnt, 0, 128, st);
    router<<<T / 4, 256, 0, st>>>(X, in.p[23] + (size_t)layer * 1024 * 32, in.p[24] + layer * 32, RE, RW, cnt);
    offsets<<<1, 256, 0, st>>>(cnt, cur, te, PMAX / 128);
    filltok<<<(PMAX + 255) / 256, 256, 0, st>>>(tok, wt, PMAX);
    scatter<<<T * 4 / 256, 256, 0, st>>>(RE, RW, cur, tok, wt);
    zero4<<<2048, 256, 0, st>>>((float4*)FFN, (size_t)T * 1024 / 4);
    { GemmArgs g = mk(X, 1024, tok, in.p[25] + (size_t)layer * 32 * 1024 * 2048, 2048, (size_t)1024 * 2048, te, PMAX, 2048, 1024);
      gemm<float, EpiSwiglu><<<dim3(16, PMAX / 128), 256, 0, st>>>(g, EpiSwiglu{ACT, in.p[26] + (size_t)layer * 32 * 2048}); }
    { GemmArgs g = mk(ACT, 1024, nullptr, in.p[27] + (size_t)layer * 32 * 1024 * 1024, 1024, (size_t)1024 * 1024, te, PMAX, 1024, 1024);
      gemm<bf16_t, EpiDown><<<dim3(8, PMAX / 128), 256, 0, st>>>(g, EpiDown{FFN, tok, wt, in.p[28] + (size_t)layer * 32 * 1024}); }
    ln<<<T / 4, 256, 0, st>>>(X, FFN, in.p[21] + layer * 1024, in.p[22] + layer * 1024, out);
}

static void forward(hipStream_t st, unsigned char* ws, const In& in, float* out) {
    float* X = (float*)(ws + O_X); float* H = (float*)(ws + O_H); float* YS5 = (float*)(ws + O_YS5); float* Y = (float*)(ws + O_Y); float* MIX = (float*)(ws + O_MIX);
    float* KM = (float*)(ws + O_SM + S_KM);
    { GemmArgs g = mk(in.p[0], 1024, nullptr, in.p[1], 2048, 0, nullptr, T, 2048, 1024); gemm<float, EpiStore><<<dim3(16, T / 128), 256, 0, st>>>(g, EpiStore{H, 2048, 0}); }
    s5<<<512, 64, 0, st>>>(H, 2048, in.p[2], in.p[3], in.p[4], in.p[5], in.p[6], in.p[7], in.p[8], in.p[9], YS5);
    kmean<<<1024, 64, 0, st>>>(H, 2048, KM);
    moba<<<T * 8 / 4, 256, 0, st>>>(H, 2048, KM, in.p[12], Y);
    { GemmArgs g = mk(YS5, 512, nullptr, in.p[10], 512, 0, nullptr, T, 512, 512); gemm<float, EpiGlu><<<dim3(4, T / 128), 256, 0, st>>>(g, EpiGlu{YS5, Y, in.p[11], 1024, 0}); }
    { GemmArgs g = mk(Y, 1024, nullptr, in.p[13], 1024, 0, nullptr, T, 1024, 1024); gemm<float, EpiStore><<<dim3(8, T / 128), 256, 0, st>>>(g, EpiStore{MIX, 1024, 0}); }
    ln<<<T / 4, 256, 0, st>>>(in.p[0], MIX, in.p[19], in.p[20], X);
    moe(st, ws, in, 0, X, X);
    { GemmArgs g = mk(X, 1024, nullptr, in.p[14], 3088, 0, nullptr, T, 3088, 1024); gemm<float, EpiStore><<<dim3(25, T / 128), 256, 0, st>>>(g, EpiStore{H, 3088, 0}); }
    gla<<<64, 256, 0, st>>>(H, 3088, in.p[15], in.p[16], Y);
    gla_norm<<<T * 4 / 4, 256, 0, st>>>(Y, H, 3088, in.p[17]);
    { GemmArgs g = mk(Y, 1024, nullptr, in.p[18], 1024, 0, nullptr, T, 1024, 1024); gemm<float, EpiStore><<<dim3(8, T / 128), 256, 0, st>>>(g, EpiStore{MIX, 1024, 0}); }
    ln<<<T / 4, 256, 0, st>>>(X, MIX, in.p[19] + 1024, in.p[20] + 1024, X);
    moe(st, ws, in, 1, X, out);
}
}
extern "C" void kernel_launch(void* const* d_in, const int* in_sizes, int n_in, void* d_out, int out_size, void* d_ws, size_t ws_size, hipStream_t stream) {
    if (n_in != 29 || ws_size < nv::O_END) { fprintf(stderr, "kernel_launch: bad args n_in %d ws %zu\n", n_in, ws_size); return; }
    nv::In in; for (int i = 0; i < 29; ++i) in.p[i] = (const float*)d_in[i];
    nv::forward(stream, (unsigned char*)d_ws, in, (float*)d_out);
}
```

```cpp
#include <hip/hip_runtime.h>
#include <cstdio>
#include <cstdint>
#include <cmath>
#include <cstring>
#define DEV __device__ __forceinline__
constexpr int Bn = 16, L = 2048, D = 1024, T = Bn * L;
namespace fk {
#define LAS __attribute__((address_space(3)))
#define GAS __attribute__((address_space(1)))
typedef unsigned short bf16_t;
typedef short bf16x8 __attribute__((ext_vector_type(8)));
typedef short s16x4 __attribute__((ext_vector_type(4)));
typedef float f32x2 __attribute__((ext_vector_type(2)));
typedef float f32x4 __attribute__((ext_vector_type(4)));
typedef float f32x16 __attribute__((ext_vector_type(16)));
typedef unsigned u32x2 __attribute__((ext_vector_type(2)));
typedef unsigned u32x4 __attribute__((ext_vector_type(4)));
typedef __bf16 bf16x2_t __attribute__((ext_vector_type(2)));
DEV unsigned cvt_pk(float lo, float hi) { f32x2 v = {lo, hi}; bf16x2_t b = __builtin_convertvector(v, bf16x2_t); return __builtin_bit_cast(unsigned, b); }
DEV float bflo(unsigned w) { return __uint_as_float(w << 16); }
DEV float bfhi(unsigned w) { return __uint_as_float(w & 0xffff0000u); }
DEV float fast_sigm(float x) { return __builtin_amdgcn_rcpf(1.f + __builtin_amdgcn_exp2f(-1.4426950408889634f * x)); }
DEV float gelu_tanh(float x) { const float u = 0.7978845608028654f * (x + 0.044715f * x * x * x); return x * fast_sigm(2.f * u); }
DEV float wave_sum(float v) {
#pragma unroll
    for (int o = 1; o < 64; o <<= 1) v += __shfl_xor(v, o);
    return v; }
DEV float swap32(float x) { auto rr = __builtin_amdgcn_permlane32_swap(__float_as_uint(x), __float_as_uint(x), false, false); return __uint_as_float((threadIdx.x & 32) ? rr[0] : rr[1]); }

constexpr int BM = 256, BK = 64, HALF = 128, HTB = HALF * BK * 2, STAGE_BYTES = 8 * HTB, NXCD = 8, WGM = 8;
constexpr int LDS_TOK = 135168 - 2048;
constexpr int LDSCTL_OFF = 135168, MISC_OFF = LDSCTL_OFF + 320, LDS_BYTES = 147456;

DEV int lds_byte(int r, int c) { const int st = (r >> 4) * 2 + (c >> 5), rr = r & 15, cc = c & 31, ob = rr * 64 + cc * 2; return st * 1024 + (ob ^ (((ob >> 9) & 1) << 5)); }
DEV void stage_rc(int b, int& R, int& C) { const int st = b / 1024, sb = b % 1024, swz = sb ^ (((sb >> 9) & 1) << 5); R = (st >> 1) * 16 + swz / 64; C = (st & 1) * 32 + (swz % 64) / 2; }
DEV int perm32(int rho) { const int n = rho >> 4, i = rho & 15; return 8 * (i >> 2) + 4 * n + (i & 3); }

struct Unit { int pm, pn, e; };
struct Gemm { const bf16_t* A; const bf16_t* Bt; const int* rowmap; size_t bstride; int K; };

struct StaticOrder {
    int nM, nN, nwg, G, c; const int* tile_e;
    DEV void init(int nM_, int nN_, int G_, int c_, const int* te) { nM = nM_; nN = nN_; nwg = nM * nN; G = G_; c = c_; tile_e = te; }
    DEV bool next(int i, Unit& u) const {
        const long Lx = (long)i * G + c; if (Lx >= nwg) return false;
        int wgid = (int)Lx; { const int q = nwg / NXCD, r = nwg % NXCD, xcd = wgid % NXCD, off = wgid / NXCD; wgid = (xcd < r ? xcd * (q + 1) : r * (q + 1) + (xcd - r) * q) + off; }
        const int nig = WGM * nN, gid = wgid / nig, fm = gid * WGM, gsz = (nM - fm) < WGM ? (nM - fm) : WGM;
        u.pm = fm + ((wgid % nig) % gsz); u.pn = (wgid % nig) / gsz; u.e = tile_e ? __builtin_amdgcn_readfirstlane(tile_e[u.pm]) : 0; return true;
    }
};

template <class F> struct EpiRow8 {
    static constexpr bool PERM = true; F f;
    DEV void operator()(const f32x4 (&acc)[2][2][4][2], const Unit& u, int wr, int wc, int fr, int fq) const {
#pragma unroll
        for (int ai = 0; ai < 2; ++ai)
#pragma unroll
            for (int m = 0; m < 4; ++m) { const int row = u.pm * BM + ai * HALF + wr * 64 + m * 16 + fr;
#pragma unroll
                for (int bj = 0; bj < 2; ++bj) f(u, row, u.pn * BM + bj * HALF + wc * 32 + 8 * fq, acc[ai][bj][m][0], acc[ai][bj][m][1]); }
    }
};

template <bool GATHER, class Epi, class Sched>
DEV void gemm_phase(LAS unsigned char* lds, const Gemm g, const Sched& S, const Epi& E) {
    int tid = threadIdx.x; asm volatile("" : "+v"(tid)); const int wid = __builtin_amdgcn_readfirstlane(tid >> 6), lane = tid & 63, wr = wid >> 2, wc = wid & 3, fr = lane & 15, fq = lane >> 4;
    const int K = g.K, nt = K / BK;
    unsigned voffB[2]; int RA[2], CA[2];
#pragma unroll
    for (int i = 0; i < 2; ++i) { int R, C; stage_rc(tid * 16 + i * 8192, R, C); const int Rb = Epi::PERM ? ((R & ~31) + perm32(R & 31)) : R; RA[i] = R; CA[i] = C; voffB[i] = (unsigned)(Rb * K + C) * 2u; }
    const size_t kstep = (size_t)(BK * 2), hstep = (size_t)HALF * K * 2, tstep = 2 * hstep;
    const unsigned ldsw = (unsigned)wid * 1024u;
    const int aoff = lds_byte(wr * 64 + fr, fq * 8), boff = lds_byte(wc * 32 + fr, fq * 8);
    LAS int* tokb = (LAS int*)(lds + LDS_TOK);
#define PG8_SA(b, h) (((b) * 2 + (h)) * HTB)
#define PG8_SB(b, h) ((4 + (b) * 2 + (h)) * HTB)
#define PG8_STAGE(bufoff, gbase, voff) do { _Pragma("unroll") for (int _i = 0; _i < 2; ++_i) \
        __builtin_amdgcn_global_load_lds((const unsigned*)((const char*)(gbase) + (voff)[_i]), (LAS unsigned*)(lds + (bufoff) + ldsw + _i * 8192), 16, 0, 0); } while (0)
#define PG8_LDA(dst, b, h) do { _Pragma("unroll") for (int m = 0; m < 4; ++m) _Pragma("unroll") for (int k = 0; k < 2; ++k) dst[m][k] = *(const LAS bf16x8*)(lds + PG8_SA(b, h) + aoff + m * 2048 + k * 1024); } while (0)
#define PG8_LDB(dst, b, h) do { _Pragma("unroll") for (int n = 0; n < 2; ++n) _Pragma("unroll") for (int k = 0; k < 2; ++k) dst[n][k] = *(const LAS bf16x8*)(lds + PG8_SB(b, h) + boff + n * 2048 + k * 1024); } while (0)
#define PG8_MMA(ai, bj, At, Bt) do { __builtin_amdgcn_s_setprio(1); _Pragma("unroll") for (int m = 0; m < 4; ++m) _Pragma("unroll") for (int n = 0; n < 2; ++n) _Pragma("unroll") for (int k = 0; k < 2; ++k) \
        acc[ai][bj][m][n] = __builtin_amdgcn_mfma_f32_16x16x32_bf16(Bt[n][k], At[m][k], acc[ai][bj][m][n], 0, 0, 0); __builtin_amdgcn_s_setprio(0); } while (0)
#define PG8_WAIT_V(n) asm volatile("s_waitcnt vmcnt(" #n ")" ::: "memory")
#define PG8_WAIT_L(n) asm volatile("s_waitcnt lgkmcnt(" #n ")" ::: "memory")
#define PG8_BAR __builtin_amdgcn_s_barrier()
#define PG8_SCHED __builtin_amdgcn_sched_barrier(0)
    Unit cur, nxt; int ui = 0;
    if (!S.next(0, cur)) return;
    f32x4 acc[2][2][4][2];
#pragma unroll
    for (int a = 0; a < 2; ++a)
#pragma unroll
        for (int b = 0; b < 2; ++b)
#pragma unroll
            for (int m = 0; m < 4; ++m)
#pragma unroll
                for (int n = 0; n < 2; ++n) acc[a][b][m][n] = (f32x4){0.f, 0.f, 0.f, 0.f};
    bf16x8 At[4][2], B0[2][2], B1[2][2];
    unsigned oA[2][2], nO[2][2];
    const char* cA; const char* cB = (const char*)g.Bt + ((size_t)cur.e * g.bstride) * 2 + (size_t)cur.pn * tstep;
    if constexpr (GATHER) { cA = (const char*)g.A;
#pragma unroll
        for (int h = 0; h < 2; ++h)
#pragma unroll
            for (int i = 0; i < 2; ++i) oA[h][i] = (unsigned)(g.rowmap[cur.pm * BM + h * HALF + RA[i]] * K + CA[i]) * 2u;
    } else { cA = (const char*)g.A + (size_t)cur.pm * tstep;
#pragma unroll
        for (int h = 0; h < 2; ++h)
#pragma unroll
            for (int i = 0; i < 2; ++i) oA[h][i] = (unsigned)(RA[i] * K + CA[i]) * 2u + (unsigned)(h * hstep);
    }
#pragma unroll
    for (int h = 0; h < 2; ++h)
#pragma unroll
        for (int i = 0; i < 2; ++i) nO[h][i] = oA[h][i];
    PG8_STAGE(PG8_SB(0, 0), cB, voffB); PG8_STAGE(PG8_SB(0, 1), cB + hstep, voffB); PG8_STAGE(PG8_SA(0, 0), cA, oA[0]); PG8_STAGE(PG8_SA(0, 1), cA, oA[1]);
    if (wr == 1) PG8_BAR;
    PG8_WAIT_V(2); PG8_BAR;
    PG8_STAGE(PG8_SB(1, 0), cB + kstep, voffB); PG8_STAGE(PG8_SA(1, 0), cA + kstep, oA[0]); PG8_STAGE(PG8_SB(1, 1), cB + hstep + kstep, voffB);
    PG8_WAIT_V(6); PG8_BAR;
    for (;;) {
        const bool has_next = S.next(ui + 1, nxt);
        const char* nA = cA; const char* nB = cB;
        if (has_next) { nB = (const char*)g.Bt + ((size_t)nxt.e * g.bstride) * 2 + (size_t)nxt.pn * tstep;
            if constexpr (GATHER) { if (wid < 4) __builtin_amdgcn_global_load_lds((const unsigned*)(g.rowmap + nxt.pm * BM + wid * 64 + lane), (LAS unsigned*)(tokb + ((ui + 1) & 1) * 256 + wid * 64), 4, 0, 0); }
            else nA = (const char*)g.A + (size_t)nxt.pm * tstep; }
        for (int t = 0; t < nt; t += 2) {
            const bool last = (t == nt - 2);
            if constexpr (GATHER) { if (last && has_next) {
#pragma unroll
                for (int h = 0; h < 2; ++h)
#pragma unroll
                    for (int i = 0; i < 2; ++i) nO[h][i] = (unsigned)(tokb[((ui + 1) & 1) * 256 + h * HALF + RA[i]] * K + CA[i]) * 2u; } }
            const char* a1 = cA + (size_t)(t + 1) * kstep;
            const char* a2 = last ? nA : cA + (size_t)(t + 2) * kstep; const char* b2 = last ? nB : cB + (size_t)(t + 2) * kstep;
            const char* a3 = a2 + kstep; const char* b3 = b2 + kstep;
            unsigned o2[2][2];
#pragma unroll
            for (int h = 0; h < 2; ++h)
#pragma unroll
                for (int i = 0; i < 2; ++i) o2[h][i] = (GATHER && last) ? nO[h][i] : oA[h][i];
            PG8_LDB(B0, 0, 0); PG8_LDB(B1, 0, 1); PG8_SCHED; PG8_LDA(At, 0, 0); PG8_STAGE(PG8_SA(1, 1), a1, oA[1]);
            PG8_WAIT_V(8); PG8_WAIT_L(0); PG8_BAR; PG8_MMA(0, 0, At, B0); PG8_MMA(0, 1, At, B1); PG8_BAR; PG8_SCHED;
            PG8_LDA(At, 0, 1); PG8_STAGE(PG8_SB(0, 0), b2, voffB); PG8_STAGE(PG8_SB(0, 1), b2 + hstep, voffB); PG8_STAGE(PG8_SA(0, 0), a2, o2[0]);
            PG8_WAIT_V(8); PG8_WAIT_L(0); PG8_BAR; PG8_MMA(1, 0, At, B0); PG8_MMA(1, 1, At, B1); PG8_BAR; PG8_SCHED;
            PG8_LDB(B0, 1, 0); PG8_LDB(B1, 1, 1); PG8_SCHED; PG8_LDA(At, 1, 0); PG8_STAGE(PG8_SA(0, 1), a2, o2[1]);
            PG8_WAIT_V(8); PG8_WAIT_L(0); PG8_BAR; PG8_MMA(0, 0, At, B0); PG8_MMA(0, 1, At, B1); PG8_BAR; PG8_SCHED;
            PG8_LDA(At, 1, 1); PG8_STAGE(PG8_SB(1, 0), b3, voffB); PG8_STAGE(PG8_SB(1, 1), b3 + hstep, voffB); PG8_STAGE(PG8_SA(1, 0), a3, o2[0]);
            PG8_WAIT_V(8); PG8_WAIT_L(0); PG8_BAR; PG8_MMA(1, 0, At, B0); PG8_MMA(1, 1, At, B1); PG8_BAR; PG8_SCHED;
        }
        if (wr == 0) PG8_BAR;
        E(acc, cur, wr, wc, fr, fq);
        if (!has_next) break;
#pragma unroll
        for (int a = 0; a < 2; ++a)
#pragma unroll
            for (int b = 0; b < 2; ++b)
#pragma unroll
                for (int m = 0; m < 4; ++m)
#pragma unroll
                    for (int n = 0; n < 2; ++n) acc[a][b][m][n] = (f32x4){0.f, 0.f, 0.f, 0.f};
        cur = nxt; cA = nA; cB = nB; ++ui;
        if constexpr (GATHER) {
#pragma unroll
            for (int h = 0; h < 2; ++h)
#pragma unroll
                for (int i = 0; i < 2; ++i) oA[h][i] = nO[h][i]; }
        if (wr == 1) PG8_BAR;
    }
    PG8_WAIT_V(0);
    PG8_BAR;
#undef PG8_SA
#undef PG8_SB
#undef PG8_STAGE
#undef PG8_LDA
#undef PG8_LDB
#undef PG8_MMA
#undef PG8_WAIT_V
#undef PG8_WAIT_L
#undef PG8_BAR
#undef PG8_SCHED
}

typedef GAS unsigned gu32;
#define XB_TMO      128
#define XB_XCNT(j)  (256  + 64 * (j))
#define XB_XSUB(j)  (1280 + 64 * (j))
#define XB_XGEN(j)  (2304 + 64 * (j))
#define XB_TOP      3328
#define XB_TOPGEN   3392
#define XCD_BAR_WORDS 3456
#define XB_SPIN_CAP (1u << 20)
DEV unsigned xb_ld(unsigned* p) { return __hip_atomic_load(p, __ATOMIC_RELAXED, __HIP_MEMORY_SCOPE_AGENT); }
DEV unsigned xb_add(unsigned* p, unsigned v) { return __hip_atomic_fetch_add(p, v, __ATOMIC_RELAXED, __HIP_MEMORY_SCOPE_AGENT); }
DEV unsigned xb_xcc_id() { return (unsigned)__builtin_amdgcn_s_getreg((3 << 11) | 20) & 0xFu; }
#define XB_SPIN(cond, bar) do { unsigned _sp = 0; while (cond) { __builtin_amdgcn_s_sleep(1); \
    if ((++_sp & 255u) == 0u) { if (xb_ld(&(bar)[XB_TMO])) break; if (_sp > XB_SPIN_CAP) { atomicAdd(&(bar)[XB_TMO], 1u); break; } } } } while (0)
struct XcdBarrier { unsigned* bar; unsigned x; volatile LAS unsigned* st; };
DEV XcdBarrier xcd_barrier_post(unsigned* bar, volatile LAS unsigned* st) {
    XcdBarrier b; b.bar = bar; b.x = xb_xcc_id(); b.st = st;
    if (threadIdx.x == 0) (void)xb_add(&bar[XB_XCNT(b.x)], 1u);
    return b;
}
DEV void xcd_barrier_complete(unsigned* bar, unsigned x, unsigned& nloc, unsigned& nx) {
    const unsigned G = gridDim.x * gridDim.y * gridDim.z;
    unsigned sum, cnt, mine, sp = 0u;
    for (;;) {
        sum = 0u; cnt = 0u; mine = 0u;
#pragma unroll
        for (unsigned j = 0; j < 16; ++j) { const unsigned c = xb_ld(&bar[XB_XCNT(j)]); sum += c; cnt += (c > 0u) ? 1u : 0u; mine = (j == x) ? c : mine; }
        if (sum == G) break;
        __builtin_amdgcn_s_sleep(1);
        if ((++sp & 255u) == 0u) { if (xb_ld(&bar[XB_TMO])) break; if (sp > XB_SPIN_CAP) { atomicAdd(&bar[XB_TMO], 1u); break; } }
    }
    nloc = mine > 0u ? mine : 1u; nx = cnt > 0u ? cnt : 1u;
}
DEV void xcd_barrier(const XcdBarrier& b) {
    asm volatile("s_waitcnt vmcnt(0)" ::: "memory");
    __syncthreads();
    if (threadIdx.x == 0) {
        unsigned* bar = b.bar;
        __builtin_amdgcn_s_waitcnt(0);
        unsigned nloc = b.st[0], nx = b.st[1];
        if (nloc == 0u) { xcd_barrier_complete(bar, b.x, nloc, nx); b.st[0] = nloc; b.st[1] = nx; }
        const unsigned old = xb_add(&bar[XB_XSUB(b.x)], 1u);
        const unsigned gen = old / nloc;
        if (old + 1u == (gen + 1u) * nloc) {
            __builtin_amdgcn_fence(__ATOMIC_RELEASE, "agent");
            asm volatile("s_waitcnt vmcnt(0)" ::: "memory");
            const unsigned og = xb_add(&bar[XB_TOP], 1u);
            const unsigned tg = og / nx;
            if (og + 1u == (tg + 1u) * nx) xb_add(&bar[XB_TOPGEN], 1u);
            else XB_SPIN(xb_ld(&bar[XB_TOPGEN]) == tg, bar);
            __builtin_amdgcn_fence(__ATOMIC_ACQUIRE, "agent");
            xb_add(&bar[XB_XGEN(b.x)], 1u);
            asm volatile("s_waitcnt vmcnt(0)" ::: "memory");
        } else {
            XB_SPIN(xb_ld(&bar[XB_XGEN(b.x)]) == gen, bar);
            __builtin_amdgcn_fence(__ATOMIC_ACQUIRE, "agent");
            asm volatile("s_waitcnt vmcnt(0)" ::: "memory");
        }
    }
    __syncthreads();
}
constexpr size_t MiB = 1u << 20;
constexpr int PMAX = 131072 + 32 * 256;
constexpr size_t W_CTL = 0, CTL_ZERO_BYTES = 1 * MiB;
constexpr size_t W_IN0 = 2 * MiB, W_GLU = 6 * MiB, W_OUT0 = 7 * MiB, W_IN1 = 9 * MiB, W_OUT1 = 16 * MiB;
constexpr size_t W_LUT = 18 * MiB, W_KM = W_LUT + 64 * 1024, W_HIST = W_KM + 256 * 1024, W_SORT = W_HIST + 64 * 1024  , W_GR = 20 * MiB  , W_SS = 22 * MiB  ;
constexpr size_t W_GU = 32 * MiB, W_DN = 288 * MiB, W_XB = 416 * MiB, W_XFA = 480 * MiB, W_XFB = 608 * MiB, W_HB = 736 * MiB, W_YS5 = 928 * MiB, W_Y0 = 960 * MiB, W_MIXB = 1024 * MiB, W_GLAO = 1088 * MiB;
constexpr size_t W_ROUTE = 1152 * MiB  , W_ACT = 736 * MiB  , W_YS = 1160 * MiB, W_END = 1432 * MiB;
static_assert(W_ACT + (size_t)PMAX * 2048 <= W_MIXB && W_YS + (size_t)PMAX * 2048 <= W_END, "ws map");
constexpr int CW_BAR = 4096;

struct Args { const float* in[29]; float* out; unsigned char* ws; int ph_lo, ph_hi; };
struct Frame {
    LAS unsigned char* lds; int tid, lane, wave, vcu, G;
    const float* const* in; unsigned char* ws;
};
#define WSP(T_, off) ((T_*)(F.ws + (off)))

DEV void transpose_item(const float* W, int K, int N, bf16_t* WT, LAS float* scr, int item, int lane) {
    const int nblk = N / 64, kb = item / nblk, nb = item % nblk, k0 = 64 * kb, n0 = 64 * nb;
    const float* src = W + (size_t)k0 * N + n0 + lane;
#pragma unroll 16
    for (int kk = 0; kk < 64; ++kk) scr[kk * 65 + lane] = src[(size_t)kk * N];
    asm volatile("s_waitcnt lgkmcnt(0)" ::: "memory");
    const int c = lane & 7;
#pragma unroll
    for (int j = 0; j < 8; ++j) { const int n = (lane >> 3) + 8 * j; const LAS float* s = scr + (8 * c) * 65 + n;
        u32x4 o; o.x = cvt_pk(s[0 * 65], s[1 * 65]); o.y = cvt_pk(s[2 * 65], s[3 * 65]); o.z = cvt_pk(s[4 * 65], s[5 * 65]); o.w = cvt_pk(s[6 * 65], s[7 * 65]);
        *(u32x4*)(WT + (size_t)(n0 + n) * K + k0 + 8 * c) = o; }
    asm volatile("s_waitcnt lgkmcnt(0)" ::: "memory");
}
__constant__ int BUCKET_TH2[16] = {16, 22, 30, 40, 54, 73, 99, 134, 182, 246, 332, 450, 609, 825, 1117, 1513};
DEV void p0_prologue(Frame& F) {
    LAS float* scr = (LAS float*)(F.lds + F.wave * 16640);
    const int gw = F.vcu * 8 + F.wave, NGW = F.G * 8;
    constexpr int I_GU = 16 * 32, I_DN = 16 * 16, I_IN0 = 16 * 32, I_GLU = 8 * 8, I_O = 16 * 16, I_IN1 = 16 * 48;
    constexpr int N_GU = 64 * I_GU, N_DN = 64 * I_DN;
    constexpr int NITEMS = N_GU + N_DN + I_IN0 + I_GLU + 2 * I_O + I_IN1;
    for (int it = gw; it < NITEMS; it += NGW) {
        int r = it;
        if (r < N_GU) { const int m = r / I_GU; transpose_item(F.in[25] + (size_t)m * 1024 * 2048, 1024, 2048, WSP(bf16_t, W_GU) + (size_t)m * 2048 * 1024, scr, r % I_GU, F.lane); continue; } r -= N_GU;
        if (r < N_DN) { const int m = r / I_DN; transpose_item(F.in[27] + (size_t)m * 1024 * 1024, 1024, 1024, WSP(bf16_t, W_DN) + (size_t)m * 1024 * 1024, scr, r % I_DN, F.lane); continue; } r -= N_DN;
        if (r < I_IN0) { transpose_item(F.in[1], 1024, 2048, WSP(bf16_t, W_IN0), scr, r, F.lane); continue; } r -= I_IN0;
        if (r < I_GLU) { transpose_item(F.in[10], 512, 512, WSP(bf16_t, W_GLU), scr, r, F.lane); continue; } r -= I_GLU;
        if (r < I_O) { transpose_item(F.in[13], 1024, 1024, WSP(bf16_t, W_OUT0), scr, r, F.lane); continue; } r -= I_O;
        if (r < I_O) { transpose_item(F.in[18], 1024, 1024, WSP(bf16_t, W_OUT1), scr, r, F.lane); continue; } r -= I_O;
        { const int kb = r / 48, nb = r % 48; const float* src = F.in[14] + (size_t)(64 * kb) * 3088 + 64 * nb + F.lane;
#pragma unroll 16
          for (int kk = 0; kk < 64; ++kk) scr[kk * 65 + F.lane] = src[(size_t)kk * 3088];
          asm volatile("s_waitcnt lgkmcnt(0)" ::: "memory");
          const int c = F.lane & 7;
#pragma unroll
          for (int j = 0; j < 8; ++j) { const int n = (F.lane >> 3) + 8 * j; const LAS float* s = scr + (8 * c) * 65 + n;
              u32x4 o; o.x = cvt_pk(s[0 * 65], s[1 * 65]); o.y = cvt_pk(s[2 * 65], s[3 * 65]); o.z = cvt_pk(s[4 * 65], s[5 * 65]); o.w = cvt_pk(s[6 * 65], s[7 * 65]);
              *(u32x4*)(WSP(bf16_t, W_IN1) + (size_t)(64 * nb + n) * 1024 + 64 * kb + 8 * c) = o; }
          asm volatile("s_waitcnt lgkmcnt(0)" ::: "memory"); }
    }
    const int gt = F.vcu * 512 + F.tid, NGT = F.G * 512;
    for (int i = gt; i < 16 * 1024; i += NGT) { const int n = i >> 10, k = i & 1023; WSP(bf16_t, W_IN1)[(size_t)(3072 + n) * 1024 + k] = (bf16_t)(cvt_pk(F.in[14][(size_t)k * 3088 + 3072 + n], 0.f) & 0xffffu); }
    { const f32x4* x4 = (const f32x4*)F.in[0]; u32x2* o = WSP(u32x2, W_XB);
      for (size_t i = gt; i < (size_t)T * 1024 / 4; i += NGT) { const f32x4 v = x4[i]; u32x2 w; w.x = cvt_pk(v.x, v.y); w.y = cvt_pk(v.z, v.w); o[i] = w; } }
    for (int i = gt; i < 8 * 2048; i += NGT) { const int h = i >> 11, n = i & 2047; int bk = n;
        if (n >= 16) { bk = 16;
#pragma unroll
            for (int q = 1; q < 16; ++q) bk += (n >= BUCKET_TH2[q]) ? 1 : 0; }
        WSP(float, W_LUT)[i] = F.in[12][bk * 8 + h] * 1.4426950408889634f; }
}

DEV void p_kmean(Frame& F) {
    const int gw = F.vcu * 8 + F.wave, NGW = F.G * 8; const bf16_t* H0 = WSP(bf16_t, W_HB); float* KM = WSP(float, W_KM);
    for (int it = gw; it < 1024; it += NGW) { const int blk = it & 7, h = (it >> 3) & 7, b = it >> 6; const int r8 = F.lane >> 3, c = F.lane & 7;
        const bf16_t* p = H0 + (size_t)(b * 2048 + blk * 256 + r8) * 2048 + 1024 + h * 64 + c * 8; float s[8];
#pragma unroll
        for (int j = 0; j < 8; ++j) s[j] = 0.f;
#pragma unroll 8
        for (int i = 0; i < 32; ++i) { const u32x4 v = *(const u32x4*)(p + (size_t)i * 8 * 2048);
            s[0] += bflo(v.x); s[1] += bfhi(v.x); s[2] += bflo(v.y); s[3] += bfhi(v.y); s[4] += bflo(v.z); s[5] += bfhi(v.z); s[6] += bflo(v.w); s[7] += bfhi(v.w); }
#pragma unroll
        for (int j = 0; j < 8; ++j) { s[j] += __shfl_xor(s[j], 8); s[j] += __shfl_xor(s[j], 16); s[j] += __shfl_xor(s[j], 32); }
        if (F.lane < 8) {
#pragma unroll
            for (int j = 0; j < 8; ++j) KM[(size_t)it * 64 + c * 8 + j] = s[j] * (1.f / 256.f); } }
}

DEV void s5_item(Frame& F, int b, int g, LAS unsigned char* sl  ) {
    const int lane = F.lane, p0 = lane & 31, hi = lane >> 5, q4 = lane >> 4;
    const float* lam_re = F.in[2]; const float* lam_im = F.in[3]; const float* log_dt = F.in[4]; const float* b_re = F.in[5]; const float* b_im = F.in[6];
    const float* c_re = F.in[7]; const float* c_im = F.in[8]; const float* dsk = F.in[9];
    const bf16_t* H0 = WSP(bf16_t, W_HB); bf16_t* YS = WSP(bf16_t, W_YS5);
    const float dt = __expf(log_dt[g]);
    float ar[2], ai[2]; bf16x8 bfr[4];
#pragma unroll
    for (int s = 0; s < 2; ++s) { const int p = p0 + 32 * s; const float lr = lam_re[g * 64 + p], li = lam_im[g * 64 + p]; const float mag = __expf(lr * dt);
        ar[s] = mag * cosf(li * dt); ai[s] = mag * sinf(li * dt);
        const float er = ar[s] - 1.f, ei = ai[s], den = lr * lr + li * li; const float qr = (er * lr + ei * li) / den, qi = (ei * lr - er * li) / den;
        u32x4 wr_, wi_; float vr[8], vi[8];
#pragma unroll
        for (int j = 0; j < 8; ++j) { const float br = b_re[(g * 64 + p) * 16 + 8 * hi + j], bi = b_im[(g * 64 + p) * 16 + 8 * hi + j]; vr[j] = qr * br - qi * bi; vi[j] = qr * bi + qi * br; }
        wr_.x = cvt_pk(vr[0], vr[1]); wr_.y = cvt_pk(vr[2], vr[3]); wr_.z = cvt_pk(vr[4], vr[5]); wr_.w = cvt_pk(vr[6], vr[7]);
        wi_.x = cvt_pk(vi[0], vi[1]); wi_.y = cvt_pk(vi[2], vi[3]); wi_.z = cvt_pk(vi[4], vi[5]); wi_.w = cvt_pk(vi[6], vi[7]);
        bfr[2 * s] = __builtin_bit_cast(bf16x8, wr_); bfr[2 * s + 1] = __builtin_bit_cast(bf16x8, wi_); }
    bf16x8 cfr[4];
#pragma unroll
    for (int ks = 0; ks < 4; ++ks) { float v[8];
#pragma unroll
        for (int j = 0; j < 8; ++j) { const int c = 32 * ks + 8 * q4 + j, p = c >> 1; const int h = lane & 15; v[j] = (c & 1) ? -c_im[(g * 16 + h) * 64 + p] : c_re[(g * 16 + h) * 64 + p]; }
        u32x4 w; w.x = cvt_pk(v[0], v[1]); w.y = cvt_pk(v[2], v[3]); w.z = cvt_pk(v[4], v[5]); w.w = cvt_pk(v[6], v[7]); cfr[ks] = __builtin_bit_cast(bf16x8, w); }
    float dv[4];
#pragma unroll
    for (int r = 0; r < 4; ++r) dv[r] = dsk[g * 16 + 4 * q4 + r];
    const int tm = 16 * ((p0 >> 2) & 1) + 4 * (p0 >> 3) + (p0 & 3);
    const bf16_t* urow = H0 + (size_t)(b * 2048 + tm) * 2048 + g * 16 + 8 * hi;
    float cr[2] = {0.f, 0.f}, ci[2] = {0.f, 0.f};
    bf16x8 ufr = *(const bf16x8*)urow;
    for (int tile = 0; tile < 64; ++tile) {
        const bf16x8 ucur = ufr;
        if (tile + 1 < 64) ufr = *(const bf16x8*)(urow + (size_t)(tile + 1) * 32 * 2048);
        f32x16 x[4];
#pragma unroll
        for (int n = 0; n < 4; ++n) { f32x16 z;
#pragma unroll
            for (int r = 0; r < 16; ++r) z[r] = 0.f;
            x[n] = __builtin_amdgcn_mfma_f32_32x32x16_bf16(ucur, bfr[n], z, 0, 0, 0); }
#pragma unroll
        for (int s = 0; s < 2; ++s) {
            f32x16& xr = x[2 * s]; f32x16& xi = x[2 * s + 1];
            float sr = hi ? 0.f : cr[s], si = hi ? 0.f : ci[s];
#pragma unroll
            for (int r = 0; r < 16; ++r) { const float nr = ar[s] * sr - ai[s] * si + xr[r], ni = ar[s] * si + ai[s] * sr + xi[r]; xr[r] = nr; xi[r] = ni; sr = nr; si = ni; }
            const float o_r = swap32(sr), o_i = swap32(si);
            float wr_ = hi ? o_r : 0.f, wi_ = hi ? o_i : 0.f;
#pragma unroll
            for (int r = 0; r < 16; ++r) { const float nr = ar[s] * wr_ - ai[s] * wi_, ni = ar[s] * wi_ + ai[s] * wr_; wr_ = nr; wi_ = ni; xr[r] += wr_; xi[r] += wi_; }
            const float e_r = swap32(xr[15]), e_i = swap32(xi[15]);
            cr[s] = hi ? xr[15] : e_r; ci[s] = hi ? xi[15] : e_i;
#pragma unroll
            for (int r = 0; r < 16; ++r) *(LAS unsigned*)(sl + (16 * hi + r) * 256 + (p0 + 32 * s) * 4) = cvt_pk(xr[r], xi[r]);
        }
#pragma unroll
        for (int tt = 0; tt < 2; ++tt) {
            f32x4 y = {0.f, 0.f, 0.f, 0.f};
#pragma unroll
            for (int ks = 0; ks < 4; ++ks) { const bf16x8 sf = *(const LAS bf16x8*)(sl + (16 * tt + (lane & 15)) * 256 + ks * 64 + q4 * 16); y = __builtin_amdgcn_mfma_f32_16x16x32_bf16(cfr[ks], sf, y, 0, 0, 0); }
            const int t = tile * 32 + 16 * tt + (lane & 15);
            const u32x2 uw = *(const u32x2*)(H0 + (size_t)(b * 2048 + t) * 2048 + g * 16 + 4 * q4);
            const float y0 = gelu_tanh(y[0] + dv[0] * bflo(uw.x)), y1 = gelu_tanh(y[1] + dv[1] * bfhi(uw.x)), y2 = gelu_tanh(y[2] + dv[2] * bflo(uw.y)), y3 = gelu_tanh(y[3] + dv[3] * bfhi(uw.y));
            u32x2 ow; ow.x = cvt_pk(y0, y1); ow.y = cvt_pk(y2, y3);
            *(u32x2*)(YS + (size_t)(b * 2048 + t) * 512 + g * 16 + 4 * q4) = ow;
        }
    }
}

constexpr int AT_K = 0, AT_V = 16384, AT_LUT = 32768, AT_WS = 40960, AT_OST = 43008, AT_END = AT_OST + 8 * 4096;
DEV int crow(int r, int hi) { return (r & 3) + 8 * (r >> 2) + 4 * hi; }
DEV s16x4 vtr(const LAS unsigned char* p) { typedef short v4i16_t __attribute__((ext_vector_type(4))); return __builtin_bit_cast(s16x4, __builtin_amdgcn_ds_read_tr16_b64_v4i16((LAS v4i16_t*)p)); }
DEV void moba_unit(Frame& F, int b, int h, int own) {
    const int lane = F.lane, wid = F.wave, r32 = lane & 31, hi = lane >> 5;
    LAS unsigned char* lds = F.lds;
    const bf16_t* H0 = WSP(bf16_t, W_HB); const float* KM = WSP(float, W_KM);
    LAS float* lut = (LAS float*)(lds + AT_LUT); LAS float* wsf = (LAS float*)(lds + AT_WS) + wid * 64;
    const size_t rowbase = (size_t)b * 2048;
    const int qpos = own * 256 + wid * 32 + r32;
    bf16x8 qr[4];
#pragma unroll
    for (int d0 = 0; d0 < 4; ++d0) qr[d0] = *(const bf16x8*)(H0 + (rowbase + qpos) * 2048 + 512 + h * 64 + d0 * 16 + hi * 8);
    unsigned selmask = 0u;
    if (own > 0) {
        float gate[7];
#pragma unroll
        for (int j = 0; j < 7; ++j) { float s = 0.f;
            if (j < own) { const float* km = KM + ((size_t)(b * 8 + h) * 8 + j) * 64 + hi * 8;
#pragma unroll
                for (int d0 = 0; d0 < 4; ++d0) { const f32x4 k0 = *(const f32x4*)(km + d0 * 16), k1 = *(const f32x4*)(km + d0 * 16 + 4); const u32x4 qw = __builtin_bit_cast(u32x4, qr[d0]);
                    s += bflo(qw.x) * k0.x + bfhi(qw.x) * k0.y + bflo(qw.y) * k0.z + bfhi(qw.y) * k0.w + bflo(qw.z) * k1.x + bfhi(qw.z) * k1.y + bflo(qw.w) * k1.z + bfhi(qw.w) * k1.w; } }
            gate[j] = s + swap32(s); }
#pragma unroll
        for (int j = 0; j < 7; ++j) { int rank = 0;
#pragma unroll
            for (int j2 = 0; j2 < 7; ++j2) if (j2 != j && j2 < own && (gate[j2] > gate[j] || (gate[j2] == gate[j] && j2 < j))) ++rank;
            if (j < own && rank < 3) selmask |= 1u << j; }
    }
    const int NT = 4 * (own + 1);
#define KV0(i) ((i) < 4 ? own * 256 + (i) * 64 : (((i) - 4) >> 2) * 256 + (((i) - 4) & 3) * 64)
    const bf16_t* kbase = H0 + (rowbase + lane) * 2048 + 1024 + h * 64 + wid * 8;
    const bf16_t* vbase = H0 + (rowbase + 16 * (wid & 3) + (lane >> 2)) * 2048 + 1536 + h * 64 + (wid >> 2) * 32 + (lane & 3) * 8;
#define LOADKV(i) do { const int kv0_ = KV0(i); const int bo_ = ((i) & 1) * 8192; \
        __builtin_amdgcn_global_load_lds((const unsigned*)(kbase + (size_t)kv0_ * 2048), (LAS unsigned*)(lds + AT_K + bo_ + wid * 1024), 16, 0, 0); \
        __builtin_amdgcn_global_load_lds((const unsigned*)(vbase + (size_t)kv0_ * 2048), (LAS unsigned*)(lds + AT_V + bo_ + wid * 1024), 16, 0, 0); } while (0)
    LOADKV(0);
    float m_run = -INFINITY, l_run = 0.f; f32x16 o[2];
#pragma unroll
    for (int r = 0; r < 16; ++r) { o[0][r] = 0.f; o[1][r] = 0.f; }
    asm volatile("s_waitcnt vmcnt(0)" ::: "memory"); __syncthreads();
    for (int i = 0; i < NT; ++i) {
        if (i + 1 < NT) LOADKV(i + 1);
        const int kv0 = KV0(i); const int bo = (i & 1) * 8192;
        const bool rowsel = (i < 4) || ((selmask >> ((i - 4) >> 2)) & 1u);
        f32x16 p0, p1;
#pragma unroll
        for (int r = 0; r < 16; ++r) { p0[r] = 0.f; p1[r] = 0.f; }
        { const LAS unsigned char* kb = lds + AT_K + bo + hi * 1024 + r32 * 16;
#pragma unroll
          for (int d0 = 0; d0 < 4; ++d0) { const bf16x8 k0 = *(const LAS bf16x8*)(kb + d0 * 2048), k1 = *(const LAS bf16x8*)(kb + d0 * 2048 + 512);
              p0 = __builtin_amdgcn_mfma_f32_32x32x16_bf16(k0, qr[d0], p0, 0, 0, 0); p1 = __builtin_amdgcn_mfma_f32_32x32x16_bf16(k1, qr[d0], p1, 0, 0, 0); } }
        const int dbase = qpos - kv0 - 4 * hi;
        float rmax = -INFINITY;
#pragma unroll
        for (int r = 0; r < 16; ++r) { const int d0_ = dbase - ((r & 3) + 8 * (r >> 2)); const int d1_ = d0_ - 32;
            const float b0 = lut[d0_ < 0 ? 0 : d0_], b1 = lut[d1_ < 0 ? 0 : d1_];
            p0[r] = (rowsel && d0_ >= 0) ? p0[r] + b0 : -INFINITY; p1[r] = (rowsel && d1_ >= 0) ? p1[r] + b1 : -INFINITY;
            rmax = fmaxf(rmax, fmaxf(p0[r], p1[r])); }
        rmax = fmaxf(rmax, swap32(rmax));
        const float m_new = fmaxf(m_run, rmax);
        const float msafe = (m_new == -INFINITY) ? 0.f : m_new;
        const float alpha = __builtin_amdgcn_exp2f(m_run - msafe);
        m_run = m_new;
        float rs = 0.f;
#pragma unroll
        for (int r = 0; r < 16; ++r) { p0[r] = __builtin_amdgcn_exp2f(p0[r] - msafe); p1[r] = __builtin_amdgcn_exp2f(p1[r] - msafe); rs += p0[r] + p1[r]; }
        l_run = l_run * alpha + rs;
        if (__any(alpha != 1.f)) { if (hi == 0) wsf[r32] = alpha;
#pragma unroll
            for (int r = 0; r < 16; ++r) { const float f = wsf[crow(r, hi)]; o[0][r] *= f; o[1][r] *= f; } }
        u32x4 pw[4];
        pw[0] = (u32x4){cvt_pk(p0[0], p0[1]), cvt_pk(p0[2], p0[3]), cvt_pk(p0[4], p0[5]), cvt_pk(p0[6], p0[7])};
        pw[1] = (u32x4){cvt_pk(p0[8], p0[9]), cvt_pk(p0[10], p0[11]), cvt_pk(p0[12], p0[13]), cvt_pk(p0[14], p0[15])};
        pw[2] = (u32x4){cvt_pk(p1[0], p1[1]), cvt_pk(p1[2], p1[3]), cvt_pk(p1[4], p1[5]), cvt_pk(p1[6], p1[7])};
        pw[3] = (u32x4){cvt_pk(p1[8], p1[9]), cvt_pk(p1[10], p1[11]), cvt_pk(p1[12], p1[13]), cvt_pk(p1[14], p1[15])};
        { const LAS unsigned char* vp = lds + AT_V + bo + ((lane >> 4) & 1) * 32 + (lane & 3) * 8 + (4 * hi + ((lane & 15) >> 2)) * 64;
#pragma unroll
          for (int d0 = 0; d0 < 2; ++d0)
#pragma unroll
              for (int ks = 0; ks < 4; ++ks) { const s16x4 lo = vtr(vp + d0 * 4096 + ks * 1024), hh = vtr(vp + d0 * 4096 + ks * 1024 + 512);
                  const bf16x8 vf = (bf16x8){lo[0], lo[1], lo[2], lo[3], hh[0], hh[1], hh[2], hh[3]};
                  o[d0] = __builtin_amdgcn_mfma_f32_32x32x16_bf16(__builtin_bit_cast(bf16x8, pw[ks]), vf, o[d0], 0, 0, 0); } }
        asm volatile("s_waitcnt vmcnt(0)" ::: "memory"); __syncthreads();
    }
#undef KV0
#undef LOADKV
    l_run += swap32(l_run);
    if (hi == 0) wsf[32 + r32] = 1.f / l_run;
    bf16_t* Ow = WSP(bf16_t, W_Y0) + (rowbase + own * 256 + wid * 32) * 1024 + 512 + h * 64;
    LAS bf16_t* stg = (LAS bf16_t*)(lds + AT_OST) + wid * 2048;
#pragma unroll
    for (int r = 0; r < 16; ++r) { const int orow = crow(r, hi); const float rl = wsf[32 + orow];
        stg[orow * 64 + r32] = (bf16_t)(cvt_pk(o[0][r] * rl, 0.f) & 0xffffu); stg[orow * 64 + 32 + r32] = (bf16_t)(cvt_pk(o[1][r] * rl, 0.f) & 0xffffu); }
#pragma unroll
    for (int i = 0; i < 4; ++i) { const int row = i * 8 + (lane >> 3), ch = lane & 7; const u32x4 v = *(const LAS u32x4*)(stg + row * 64 + ch * 8); *(u32x4*)(Ow + (size_t)row * 1024 + ch * 8) = v; }
    __syncthreads();
}
DEV void p_s5_moba(Frame& F) {
    for (int it = F.vcu * 2 + (F.wave & 1); it < 512; it += F.G * 2) { if (F.wave < 2) s5_item(F, it >> 5, it & 31, F.lds + 81920 + F.wave * 8192); }
    __syncthreads();
    for (int v = F.vcu; v < 256; v += F.G) { const int bh = v >> 1, b = bh >> 3, h = bh & 7;
        for (int i = F.tid; i < 2048; i += 512) ((LAS float*)(F.lds + AT_LUT))[i] = WSP(float, W_LUT)[h * 2048 + i];
        __syncthreads();
#pragma unroll 1
        for (int i = 0; i < 4; ++i) { const int own = (((v & 1) ? 0x1256 : 0x0347) >> (4 * i)) & 0xF; moba_unit(F, b, h, own); }
    }
}
constexpr size_t R_RE = W_ROUTE, R_RW = W_ROUTE + 512 * 1024, R_POS = W_ROUTE + 1024 * 1024, R_TOK = W_ROUTE + 2 * MiB, R_WGT = W_ROUTE + 3 * MiB;
constexpr int WT_PITCH = 1028;
template <int MODE, bool ROUTER, bool WRITE_XB>
DEV void p_ln(Frame& F, const float* xin, float* xout, const float* gam, const float* bet, const float* wrt, const float* brt) {
    LAS float* wt = (LAS float*)F.lds; LAS int* hist = (LAS int*)(F.lds + 32 * WT_PITCH * 4); LAS float* lg = (LAS float*)(F.lds + 32 * WT_PITCH * 4 + 256) + F.wave * 32;
    const int lane = F.lane;
    if constexpr (ROUTER) {
        for (int i = F.tid; i < 1024 * 32; i += 512) { const int k = i >> 5, e = i & 31; wt[e * WT_PITCH + k] = wrt[i]; }
        if (F.tid < 32) hist[F.tid] = 0;
        __syncthreads();
    }
    const bf16_t* MIXB = WSP(bf16_t, W_MIXB); const bf16_t* YS = WSP(bf16_t, W_YS); const int* POS = WSP(int, R_POS);
    bf16_t* XB = WSP(bf16_t, W_XB); int* RE = WSP(int, R_RE); float* RW = WSP(float, R_RW);
    const float alpha = 1.4142135623730951f;
    for (int wgi = F.vcu; wgi < 256; wgi += F.G) {
        for (int i = 0; i < 16; ++i) { const int row = wgi * 128 + F.wave * 16 + i;
            float v[16]; float s = 0.f;
#pragma unroll
            for (int j = 0; j < 4; ++j) { const f32x4 a = *(const f32x4*)(xin + (size_t)row * 1024 + j * 256 + lane * 4); v[4 * j] = alpha * a.x; v[4 * j + 1] = alpha * a.y; v[4 * j + 2] = alpha * a.z; v[4 * j + 3] = alpha * a.w; }
            if constexpr (MODE == 0) {
#pragma unroll
                for (int j = 0; j < 4; ++j) { const u32x2 m = *(const u32x2*)(MIXB + (size_t)row * 1024 + j * 256 + lane * 4); v[4 * j] += bflo(m.x); v[4 * j + 1] += bfhi(m.x); v[4 * j + 2] += bflo(m.y); v[4 * j + 3] += bfhi(m.y); }
            } else {
#pragma unroll
                for (int kx = 0; kx < 4; ++kx) { const int pos = __builtin_amdgcn_readfirstlane(POS[row * 4 + kx]);
#pragma unroll
                    for (int j = 0; j < 4; ++j) { const u32x2 m = *(const u32x2*)(YS + (size_t)pos * 1024 + j * 256 + lane * 4); v[4 * j] += bflo(m.x); v[4 * j + 1] += bfhi(m.x); v[4 * j + 2] += bflo(m.y); v[4 * j + 3] += bfhi(m.y); } }
            }
#pragma unroll
            for (int q = 0; q < 16; ++q) s += v[q];
            const float mean = wave_sum(s) * (1.f / 1024.f); float q2 = 0.f;
#pragma unroll
            for (int q = 0; q < 16; ++q) { v[q] -= mean; q2 += v[q] * v[q]; }
            const float rstd = 1.f / sqrtf(wave_sum(q2) * (1.f / 1024.f) + 1e-5f);
#pragma unroll
            for (int j = 0; j < 4; ++j) { const int c = j * 256 + lane * 4; const f32x4 g4 = *(const f32x4*)(gam + c), b4 = *(const f32x4*)(bet + c);
                v[4 * j] = v[4 * j] * rstd * g4.x + b4.x; v[4 * j + 1] = v[4 * j + 1] * rstd * g4.y + b4.y; v[4 * j + 2] = v[4 * j + 2] * rstd * g4.z + b4.z; v[4 * j + 3] = v[4 * j + 3] * rstd * g4.w + b4.w;
                *(f32x4*)(xout + (size_t)row * 1024 + c) = (f32x4){v[4 * j], v[4 * j + 1], v[4 * j + 2], v[4 * j + 3]};
                if constexpr (WRITE_XB) { u32x2 w; w.x = cvt_pk(v[4 * j], v[4 * j + 1]); w.y = cvt_pk(v[4 * j + 2], v[4 * j + 3]); *(u32x2*)(XB + (size_t)row * 1024 + c) = w; } }
            if constexpr (ROUTER) {
                float lgt[32];
#pragma unroll
                for (int e = 0; e < 32; ++e) { float a = 0.f;
#pragma unroll
                    for (int j = 0; j < 4; ++j) { const f32x4 w4 = *(const LAS f32x4*)(wt + e * WT_PITCH + j * 256 + lane * 4); a = fmaf(v[4 * j], w4.x, a); a = fmaf(v[4 * j + 1], w4.y, a); a = fmaf(v[4 * j + 2], w4.z, a); a = fmaf(v[4 * j + 3], w4.w, a); }
                    lgt[e] = a; }
                { const bool up = (lane & 32) != 0;
#pragma unroll
                  for (int q = 0; q < 16; ++q) { const float keep = up ? lgt[q + 16] : lgt[q], send = up ? lgt[q] : lgt[q + 16]; lgt[q] = keep + swap32(send); } }
                { const bool up = (lane & 16) != 0;
#pragma unroll
                  for (int q = 0; q < 8; ++q) { const float keep = up ? lgt[q + 8] : lgt[q], send = up ? lgt[q] : lgt[q + 8]; lgt[q] = keep + __shfl_xor(send, 16); } }
                { const bool up = (lane & 8) != 0;
#pragma unroll
                  for (int q = 0; q < 4; ++q) { const float keep = up ? lgt[q + 4] : lgt[q], send = up ? lgt[q] : lgt[q + 4]; lgt[q] = keep + __shfl_xor(send, 8); } }
                { const bool up = (lane & 4) != 0;
#pragma unroll
                  for (int q = 0; q < 2; ++q) { const float keep = up ? lgt[q + 2] : lgt[q], send = up ? lgt[q] : lgt[q + 2]; lgt[q] = keep + __shfl_xor(send, 4); } }
                { const bool up = (lane & 2) != 0; const float keep = up ? lgt[1] : lgt[0], send = up ? lgt[0] : lgt[1]; lgt[0] = keep + __shfl_xor(send, 2); }
                const int e = (lane >> 1) & 31;
                const float mylog = lgt[0] + __shfl_xor(lgt[0], 1) + brt[e];
                if ((lane & 1) == 0) lg[e] = mylog;
                int rank = 0; float mx = -INFINITY;
#pragma unroll
                for (int q = 0; q < 8; ++q) { const f32x4 o4 = *(const LAS f32x4*)(lg + 4 * q);
                    rank += (o4.x > mylog || (o4.x == mylog && 4 * q < e)) ? 1 : 0; rank += (o4.y > mylog || (o4.y == mylog && 4 * q + 1 < e)) ? 1 : 0;
                    rank += (o4.z > mylog || (o4.z == mylog && 4 * q + 2 < e)) ? 1 : 0; rank += (o4.w > mylog || (o4.w == mylog && 4 * q + 3 < e)) ? 1 : 0;
                    mx = fmaxf(mx, fmaxf(fmaxf(o4.x, o4.y), fmaxf(o4.z, o4.w))); }
                const bool win = rank < 4 && (lane & 1) == 0;
                const float ex = win ? __expf(mylog - mx) : 0.f; const float sm = wave_sum(ex);
                if (win) { RE[row * 4 + rank] = e; RW[row * 4 + rank] = ex / sm; atomicAdd((int*)(hist + e), 1); }
            }
        }
        if constexpr (ROUTER) { __syncthreads(); if (F.tid < 32) { WSP(int, W_HIST)[wgi * 32 + F.tid] = hist[F.tid]; hist[F.tid] = 0; } __syncthreads(); }
    }
}

DEV void p_sort(Frame& F) {
    LAS int* Ls = (LAS int*)F.lds; const int tid = F.tid;
    const int* HIST = WSP(int, W_HIST); int* SORT = WSP(int, W_SORT);
    const int* RE = WSP(int, R_RE); const float* RW = WSP(float, R_RW); int* POS = WSP(int, R_POS); int* TOK = WSP(int, R_TOK); float* WGT = WSP(float, R_WGT);
    for (int wgi = F.vcu; wgi < 256; wgi += F.G) {
        { const int e = tid & 31, part = tid >> 5; int tot = 0, pre = 0;
          for (int w = part * 16; w < part * 16 + 16; ++w) { const int hh = HIST[w * 32 + e]; tot += hh; pre += (w < wgi) ? hh : 0; }
          Ls[part * 32 + e] = tot; Ls[512 + part * 32 + e] = pre; }
        Ls[2048 + tid] = RE[wgi * 512 + tid];
        __syncthreads();
        if (tid < 32) { int tot = 0, pre = 0; for (int p = 0; p < 16; ++p) { tot += Ls[p * 32 + tid]; pre += Ls[512 + p * 32 + tid]; } Ls[1200 + tid] = tot; Ls[1300 + tid] = pre; }
        __syncthreads();
        if (tid == 0) { int a = 0; for (int e = 0; e < 32; ++e) { Ls[1024 + e] = a; a += (Ls[1200 + e] + 255) / 256 * 256; } Ls[1056] = a; }
        __syncthreads();
        if (tid < 32) { int c = Ls[1024 + tid] + Ls[1300 + tid]; for (int i = 0; i < 512; ++i) if (Ls[2048 + i] == tid) { Ls[2560 + i] = c; ++c; } }
        __syncthreads();
        { const int pos = Ls[2560 + tid]; TOK[pos] = wgi * 128 + (tid >> 2); WGT[pos] = RW[wgi * 512 + tid]; POS[wgi * 512 + tid] = pos; }
        if (wgi < 32) { const int e = wgi; for (int r = Ls[1024 + e] + Ls[1200 + e] + tid; r < Ls[1024 + e + 1]; r += 512) { TOK[r] = 0; WGT[r] = 0.f; } }
        if (wgi == 0) { if (tid < 33) SORT[tid] = Ls[1024 + tid]; if (tid == 0) SORT[33] = Ls[1056] / 256;
            for (int pm = tid; pm < PMAX / 256; pm += 512) { int e = 0; for (int j = 1; j < 32; ++j) if (pm * 256 >= Ls[1024 + j]) e = j; SORT[64 + pm] = e; } }
        __syncthreads();
    }
}

DEV void p_gr(Frame& F) {
    const int gw = F.vcu * 8 + F.wave, NGW = F.G * 8, lane = F.lane, q4 = lane >> 4; const bf16_t* XB = WSP(bf16_t, W_XB); const bf16_t* Wg = WSP(bf16_t, W_IN1) + (size_t)3072 * 1024; float* GR = WSP(float, W_GR);
    for (int it = gw; it < T / 16; it += NGW) { f32x4 acc = {0.f, 0.f, 0.f, 0.f};
        const bf16_t* ap = XB + (size_t)(it * 16 + (lane & 15)) * 1024 + q4 * 8; const bf16_t* bp = Wg + (size_t)(lane & 15) * 1024 + q4 * 8;
#pragma unroll 8
        for (int ks = 0; ks < 32; ++ks) { const bf16x8 a = *(const bf16x8*)(ap + ks * 32), bb = *(const bf16x8*)(bp + ks * 32); acc = __builtin_amdgcn_mfma_f32_16x16x32_bf16(a, bb, acc, 0, 0, 0); }
#pragma unroll
        for (int r = 0; r < 4; ++r) GR[(size_t)(it * 16 + 4 * q4 + r) * 16 + (lane & 15)] = acc[r]; }
}

constexpr int GP = 272, GP2 = 144;
constexpr int G_QIN = 0, G_KIN = G_QIN + 64 * GP, G_KST = G_KIN + 64 * GP, G_VT = G_KST + 128 * GP2, G_ATT = G_VT + 64 * GP2, G_GRS = G_ATT + 64 * GP2, G_GT = G_GRS + 4096, G_DEC = G_GT + 2048, G_END = G_DEC + 512;
DEV float logsigm_fast(float z) { const float e = __builtin_amdgcn_exp2f(-1.4426950408889634f * fabsf(z)); return fminf(z, 0.f) - 0.6931471805599453f * __builtin_amdgcn_logf(1.f + e); }
DEV void gla_item(Frame& F, int b, int h, int c4) {
    LAS unsigned char* lds = F.lds; const int tid = F.tid, lane = F.lane, wid = F.wave, q4 = lane >> 4, l15 = lane & 15;
    const bf16_t* H1 = WSP(bf16_t, W_HB); const float* GR = WSP(float, W_GR); bf16_t* GO = WSP(bf16_t, W_GLAO); float* SS = WSP(float, W_SS);
    const float* wg2 = F.in[15]; const float* bg = F.in[16];
    for (int i = tid; i < 64 * GP2 / 4; i += 512) ((LAS unsigned*)(lds + G_ATT))[i] = 0u;
    const int dk = tid & 127, tg = tid >> 7;
    float w2[16];
#pragma unroll
    for (int r = 0; r < 16; ++r) w2[r] = wg2[r * 512 + h * 128 + dk];
    const float bgv = bg[h * 128 + dk];
    const int c16 = wid & 3, th = wid >> 2;
    f32x4 sacc[8];
#pragma unroll
    for (int m = 0; m < 8; ++m) sacc[m] = (f32x4){0.f, 0.f, 0.f, 0.f};
    const size_t rb = (size_t)b * 2048;
    for (int n = 0; n < 32; ++n) { const int t0 = n * 64;
        for (int i = tid; i < 1024; i += 512) ((LAS float*)(lds + G_GRS))[i] = GR[(rb + t0) * 16 + i];
        __syncthreads();
        float cs[16]; float run = 0.f;
#pragma unroll
        for (int i = 0; i < 16; ++i) { const LAS float* gr = (const LAS float*)(lds + G_GRS) + (16 * tg + i) * 16; float z = bgv;
#pragma unroll
            for (int r = 0; r < 16; ++r) z = fmaf(gr[r], w2[r], z);
            run += logsigm_fast(z) * (1.f / 16.f); cs[i] = run; }
        ((LAS float*)(lds + G_GT))[tg * 128 + dk] = run;
        __syncthreads();
        float off = 0.f, btot = 0.f;
#pragma unroll
        for (int g2 = 0; g2 < 4; ++g2) { const float gtv = ((LAS float*)(lds + G_GT))[g2 * 128 + dk]; btot += gtv; off += (g2 < tg) ? gtv : 0.f; }
        if (tg == 0) ((LAS float*)(lds + G_DEC))[dk] = __expf(btot);
        { unsigned kst[8];
#pragma unroll
          for (int i = 0; i < 16; i += 2) { float kk[2];
#pragma unroll
              for (int u = 0; u < 2; ++u) { const int t = 16 * tg + i + u; const float bc = cs[i + u] + off;
                  const float qv = bflo((unsigned)H1[(rb + t0 + t) * 3072 + h * 128 + dk]), kv = bflo((unsigned)H1[(rb + t0 + t) * 3072 + 512 + h * 128 + dk]);
                  *(LAS bf16_t*)(lds + G_QIN + t * GP + dk * 2) = (bf16_t)(cvt_pk(qv * __expf(bc), 0.f) & 0xffffu);
                  *(LAS bf16_t*)(lds + G_KIN + t * GP + dk * 2) = (bf16_t)(cvt_pk(kv * __expf(-bc), 0.f) & 0xffffu);
                  kk[u] = kv * __expf(btot - bc); }
              kst[i >> 1] = cvt_pk(kk[0], kk[1]); }
          *(LAS u32x4*)(lds + G_KST + dk * GP2 + tg * 32) = (u32x4){kst[0], kst[1], kst[2], kst[3]};
          *(LAS u32x4*)(lds + G_KST + dk * GP2 + tg * 32 + 16) = (u32x4){kst[4], kst[5], kst[6], kst[7]}; }
        { const int dvl = tid & 63, tq = tid >> 6; unsigned vv[4];
#pragma unroll
          for (int i = 0; i < 8; i += 2) { const unsigned a = H1[(rb + t0 + tq * 8 + i) * 3072 + 1024 + h * 256 + c4 * 64 + dvl], bq = H1[(rb + t0 + tq * 8 + i + 1) * 3072 + 1024 + h * 256 + c4 * 64 + dvl]; vv[i >> 1] = a | (bq << 16); }
          *(LAS u32x4*)(lds + G_VT + dvl * GP2 + tq * 16) = (u32x4){vv[0], vv[1], vv[2], vv[3]}; }
        __syncthreads();
#pragma unroll
        for (int rep = 0; rep < 2; ++rep) { const int ti = wid + 8 * rep; if (ti < 10) {
            int jt, it; if (ti < 4) { jt = 0; it = ti; } else if (ti < 7) { jt = 1; it = ti - 3; } else if (ti < 9) { jt = 2; it = ti - 5; } else { jt = 3; it = 3; }
            f32x4 a4 = {0.f, 0.f, 0.f, 0.f};
#pragma unroll
            for (int ks = 0; ks < 4; ++ks) { const bf16x8 kf = *(const LAS bf16x8*)(lds + G_KIN + (16 * jt + l15) * GP + ks * 64 + q4 * 16), qf = *(const LAS bf16x8*)(lds + G_QIN + (16 * it + l15) * GP + ks * 64 + q4 * 16);
                a4 = __builtin_amdgcn_mfma_f32_16x16x32_bf16(kf, qf, a4, 0, 0, 0); }
            const int i_ = 16 * it + l15, j0 = 16 * jt + 4 * q4;
            u32x2 w; w.x = cvt_pk(j0 <= i_ ? a4[0] : 0.f, j0 + 1 <= i_ ? a4[1] : 0.f); w.y = cvt_pk(j0 + 2 <= i_ ? a4[2] : 0.f, j0 + 3 <= i_ ? a4[3] : 0.f);
            *(LAS u32x2*)(lds + G_ATT + i_ * GP2 + j0 * 2) = w; } }
        __syncthreads();
        bf16x8 vf[2];
#pragma unroll
        for (int ks = 0; ks < 2; ++ks) vf[ks] = *(const LAS bf16x8*)(lds + G_VT + (c16 * 16 + l15) * GP2 + ks * 64 + q4 * 16);
        bf16x8 sf[4];
#pragma unroll
        for (int ks = 0; ks < 4; ++ks) { const u32x4 w = {cvt_pk(sacc[2 * ks][0], sacc[2 * ks][1]), cvt_pk(sacc[2 * ks][2], sacc[2 * ks][3]), cvt_pk(sacc[2 * ks + 1][0], sacc[2 * ks + 1][1]), cvt_pk(sacc[2 * ks + 1][2], sacc[2 * ks + 1][3])}; sf[ks] = __builtin_bit_cast(bf16x8, w); }
#pragma unroll
        for (int mt = 0; mt < 2; ++mt) { const int i_ = 32 * th + 16 * mt + l15; f32x4 oa = {0.f, 0.f, 0.f, 0.f};
#pragma unroll
            for (int ks = 0; ks < 2; ++ks) { if (ks == 1 && th == 0) continue; const bf16x8 af = *(const LAS bf16x8*)(lds + G_ATT + i_ * GP2 + ks * 64 + q4 * 16); oa = __builtin_amdgcn_mfma_f32_16x16x32_bf16(af, vf[ks], oa, 0, 0, 0); }
#pragma unroll
            for (int ks = 0; ks < 4; ++ks) { const u32x2 lo = *(const LAS u32x2*)(lds + G_QIN + i_ * GP + (32 * ks + 4 * q4) * 2), hi2 = *(const LAS u32x2*)(lds + G_QIN + i_ * GP + (32 * ks + 16 + 4 * q4) * 2);
                const u32x4 w = {lo.x, lo.y, hi2.x, hi2.y}; oa = __builtin_amdgcn_mfma_f32_16x16x32_bf16(__builtin_bit_cast(bf16x8, w), sf[ks], oa, 0, 0, 0); }
#pragma unroll
            for (int r = 0; r < 4; ++r) { const size_t trow = rb + t0 + 32 * th + 16 * mt + 4 * q4 + r; GO[trow * 1024 + h * 256 + c4 * 64 + c16 * 16 + l15] = (bf16_t)(cvt_pk(oa[r], 0.f) & 0xffffu);
                float sq = oa[r] * oa[r]; sq += __shfl_xor(sq, 1); sq += __shfl_xor(sq, 2); sq += __shfl_xor(sq, 4); sq += __shfl_xor(sq, 8);
                if (l15 == 0) SS[(trow * 4 + h) * 16 + c4 * 4 + c16] = sq; } }
#pragma unroll
        for (int md = 0; md < 8; ++md) { const f32x4 dc = *(const LAS f32x4*)(lds + G_DEC + (16 * md + 4 * q4) * 4); sacc[md] = sacc[md] * dc;
#pragma unroll
            for (int ks = 0; ks < 2; ++ks) { const bf16x8 kf = *(const LAS bf16x8*)(lds + G_KST + (16 * md + l15) * GP2 + ks * 64 + q4 * 16); sacc[md] = __builtin_amdgcn_mfma_f32_16x16x32_bf16(kf, vf[ks], sacc[md], 0, 0, 0); } }
        __syncthreads();
    }
}
DEV void p_gla(Frame& F) { for (int v = F.vcu; v < 256; v += F.G) gla_item(F, v >> 4, (v >> 2) & 3, v & 3); }

DEV void p_gla_norm(Frame& F) {
    const int gw = F.vcu * 8 + F.wave, NGW = F.G * 8, lane = F.lane; const bf16_t* GO = WSP(bf16_t, W_GLAO); const float* SS = WSP(float, W_SS); const bf16_t* H1 = WSP(bf16_t, W_HB); bf16_t* Y0 = WSP(bf16_t, W_Y0);
    const f32x4 nw = *(const f32x4*)(F.in[17] + lane * 4);
    for (int row = gw; row < T; row += NGW) {
#pragma unroll
        for (int h = 0; h < 4; ++h) { const float* sp = SS + ((size_t)row * 4 + h) * 16; const f32x4 a = *(const f32x4*)sp, b2 = *(const f32x4*)(sp + 4), c = *(const f32x4*)(sp + 8), d = *(const f32x4*)(sp + 12);
            const float sq = (a.x + a.y + a.z + a.w) + (b2.x + b2.y + b2.z + b2.w) + (c.x + c.y + c.z + c.w) + (d.x + d.y + d.z + d.w); const float r = 1.f / sqrtf(sq * (1.f / 256.f) + 1e-5f);
            const u32x2 o = *(const u32x2*)(GO + (size_t)row * 1024 + h * 256 + lane * 4); const u32x2 g = *(const u32x2*)(H1 + (size_t)row * 3072 + 2048 + h * 256 + lane * 4);
            const float g0 = bflo(g.x), g1 = bfhi(g.x), g2 = bflo(g.y), g3 = bfhi(g.y);
            u32x2 w; w.x = cvt_pk(bflo(o.x) * r * nw.x * g0 * fast_sigm(g0), bfhi(o.x) * r * nw.y * g1 * fast_sigm(g1)); w.y = cvt_pk(bflo(o.y) * r * nw.z * g2 * fast_sigm(g2), bfhi(o.y) * r * nw.w * g3 * fast_sigm(g3));
            *(u32x2*)(Y0 + (size_t)row * 1024 + h * 256 + lane * 4) = w; } }
}
struct FStoreScale { bf16_t* O; int ldc, c_lo, c_hi; float sc;
    DEV void operator()(const Unit&, int row, int col, f32x4 v0, f32x4 v1) const { const float s = (col >= c_lo && col < c_hi) ? sc : 1.f;
        const u32x4 w = {cvt_pk(v0[0] * s, v0[1] * s), cvt_pk(v0[2] * s, v0[3] * s), cvt_pk(v1[0] * s, v1[1] * s), cvt_pk(v1[2] * s, v1[3] * s)}; *(u32x4*)(O + (size_t)row * ldc + col) = w; } };
struct FGlu { const bf16_t* Y; bf16_t* O; const float* b;
    DEV void operator()(const Unit&, int row, int col, f32x4 v0, f32x4 v1) const { const u32x4 y = *(const u32x4*)(Y + (size_t)row * 512 + col); const f32x4 b0 = *(const f32x4*)(b + col), b1 = *(const f32x4*)(b + col + 4);
        const u32x4 w = {cvt_pk(bflo(y.x) * fast_sigm(v0[0] + b0.x), bfhi(y.x) * fast_sigm(v0[1] + b0.y)), cvt_pk(bflo(y.y) * fast_sigm(v0[2] + b0.z), bfhi(y.y) * fast_sigm(v0[3] + b0.w)),
                         cvt_pk(bflo(y.z) * fast_sigm(v1[0] + b1.x), bfhi(y.z) * fast_sigm(v1[1] + b1.y)), cvt_pk(bflo(y.w) * fast_sigm(v1[2] + b1.z), bfhi(y.w) * fast_sigm(v1[3] + b1.w))};
        *(u32x4*)(O + (size_t)row * 1024 + col) = w; } };
DEV float swiglu1(float g, float u) { g = fminf(g, 7.f); u = fminf(fmaxf(u, -7.f), 7.f); return g * fast_sigm(1.702f * g) * (u + 1.f); }
struct FSwiglu { bf16_t* ACT; const float* bgu;
    DEV void operator()(const Unit& u, int row, int col, f32x4 v0, f32x4 v1) const { const float* bp = bgu + (size_t)u.e * 2048 + col; const f32x4 b0 = *(const f32x4*)bp, b1 = *(const f32x4*)(bp + 4);
        u32x2 w; w.x = cvt_pk(swiglu1(v0[0] + b0.x, v0[1] + b0.y), swiglu1(v0[2] + b0.z, v0[3] + b0.w)); w.y = cvt_pk(swiglu1(v1[0] + b1.x, v1[1] + b1.y), swiglu1(v1[2] + b1.z, v1[3] + b1.w));
        *(u32x2*)(ACT + (size_t)row * 1024 + (col >> 1)) = w; } };
struct FDown { bf16_t* YS; const float* bd; const float* wgt;
    DEV void operator()(const Unit& u, int row, int col, f32x4 v0, f32x4 v1) const { const float* bp = bd + (size_t)u.e * 1024 + col; const f32x4 b0 = *(const f32x4*)bp, b1 = *(const f32x4*)(bp + 4); const float wt = wgt[row];
        const u32x4 w = {cvt_pk((v0[0] + b0.x) * wt, (v0[1] + b0.y) * wt), cvt_pk((v0[2] + b0.z) * wt, (v0[3] + b0.w) * wt), cvt_pk((v1[0] + b1.x) * wt, (v1[1] + b1.y) * wt), cvt_pk((v1[2] + b1.z) * wt, (v1[3] + b1.w) * wt)};
        *(u32x4*)(YS + (size_t)row * 1024 + col) = w; } };

constexpr int NPH = 20;
constexpr float QSCALE0 = 0.125f * 1.4426950408889634f, QSCALE1 = 0.08838834764831845f;


#define NOINL __device__ __forceinline__
struct PA { const float* const* in; unsigned char* ws; float* out; };
#define MKFRAME extern __shared__ __attribute__((aligned(16))) unsigned char lds_[]; Frame F; F.lds = (LAS unsigned char*)lds_; F.tid = threadIdx.x; asm volatile("" : "+v"(F.tid)); F.lane = F.tid & 63; F.wave = __builtin_amdgcn_readfirstlane(F.tid >> 6); \
    F.G = gridDim.x; { const int bx = blockIdx.x; F.vcu = (F.G % 8 == 0) ? (bx % 8) * (F.G / 8) + bx / 8 : bx; } F.in = pa.in; F.ws = pa.ws;
template <class Fn> DEV void dense_gemm(Frame& F, const bf16_t* A, const bf16_t* Bt, int nM, int nN, int K, const Fn& fn) {
    Gemm g; g.A = A; g.Bt = Bt; g.rowmap = nullptr; g.bstride = 0; g.K = K;
    StaticOrder S; S.init(nM, nN, F.G, (int)blockIdx.x, nullptr);
    EpiRow8<Fn> E{fn};
    gemm_phase<false>(F.lds, g, S, E);
}
NOINL void ph_prologue(PA pa) { MKFRAME p0_prologue(F); }
NOINL void ph_in0(PA pa) { MKFRAME dense_gemm(F, WSP(bf16_t, W_XB), WSP(bf16_t, W_IN0), T / 256, 8, 1024, FStoreScale{WSP(bf16_t, W_HB), 2048, 512, 1024, QSCALE0}); }
NOINL void ph_kmean(PA pa) { MKFRAME p_kmean(F); }
NOINL void ph_s5moba(PA pa) { MKFRAME p_s5_moba(F); }
NOINL void ph_glu(PA pa) { MKFRAME dense_gemm(F, WSP(bf16_t, W_YS5), WSP(bf16_t, W_GLU), T / 256, 2, 512, FGlu{WSP(bf16_t, W_YS5), WSP(bf16_t, W_Y0), F.in[11]}); }
NOINL void ph_out(PA pa, int layer) { MKFRAME dense_gemm(F, WSP(bf16_t, W_Y0), layer ? WSP(bf16_t, W_OUT1) : WSP(bf16_t, W_OUT0), T / 256, 4, 1024, FStoreScale{WSP(bf16_t, W_MIXB), 1024, 0, 0, 1.f}); }
NOINL void ph_in1(PA pa) { MKFRAME dense_gemm(F, WSP(bf16_t, W_XB), WSP(bf16_t, W_IN1), T / 256, 12, 1024, FStoreScale{WSP(bf16_t, W_HB), 3072, 0, 512, QSCALE1}); p_gr(F); }
NOINL void ph_gla(PA pa) { MKFRAME p_gla(F); }
NOINL void ph_glanorm(PA pa) { MKFRAME p_gla_norm(F); }
NOINL void ph_lnrouter(PA pa, int layer) { MKFRAME p_ln<0, true, true>(F, layer ? WSP(float, W_XFB) : F.in[0], WSP(float, W_XFA), F.in[19] + layer * 1024, F.in[20] + layer * 1024, F.in[23] + (size_t)layer * 1024 * 32, F.in[24] + layer * 32); }
NOINL void ph_sort(PA pa) { MKFRAME p_sort(F); }
NOINL void ph_gateup(PA pa, int layer) { MKFRAME const int* SORT = WSP(int, W_SORT);
    Gemm g; g.A = WSP(bf16_t, W_XB); g.Bt = WSP(bf16_t, W_GU) + (size_t)layer * 32 * 2048 * 1024; g.rowmap = WSP(int, R_TOK); g.bstride = (size_t)2048 * 1024; g.K = 1024;
    StaticOrder S; S.init(__builtin_amdgcn_readfirstlane(SORT[33]), 8, F.G, (int)blockIdx.x, SORT + 64);
    EpiRow8<FSwiglu> E{FSwiglu{WSP(bf16_t, W_ACT), F.in[26] + (size_t)layer * 32 * 2048}};
    gemm_phase<true>(F.lds, g, S, E); }
NOINL void ph_down(PA pa, int layer) { MKFRAME const int* SORT = WSP(int, W_SORT);
    Gemm g; g.A = WSP(bf16_t, W_ACT); g.Bt = WSP(bf16_t, W_DN) + (size_t)layer * 32 * 1024 * 1024; g.rowmap = nullptr; g.bstride = (size_t)1024 * 1024; g.K = 1024;
    StaticOrder S; S.init(__builtin_amdgcn_readfirstlane(SORT[33]), 4, F.G, (int)blockIdx.x, SORT + 64);
    EpiRow8<FDown> E{FDown{WSP(bf16_t, W_YS), F.in[28] + (size_t)layer * 32 * 1024, WSP(float, R_WGT)}};
    gemm_phase<false>(F.lds, g, S, E); }
NOINL void ph_combine(PA pa, int layer) { MKFRAME
    if (layer == 0) p_ln<1, false, true>(F, WSP(float, W_XFA), WSP(float, W_XFB), F.in[21], F.in[22], nullptr, nullptr);
    else p_ln<1, false, false>(F, WSP(float, W_XFA), pa.out, F.in[21] + 1024, F.in[22] + 1024, nullptr, nullptr); }

__global__ void __launch_bounds__(512, 2) mega(Args args) {
    extern __shared__ __attribute__((aligned(16))) unsigned char lds_[];
    LAS unsigned char* lds = (LAS unsigned char*)lds_;
    unsigned* ctl = (unsigned*)(args.ws + W_CTL);
    for (int u = threadIdx.x; u < (LDS_BYTES - LDSCTL_OFF) / 4; u += 512) ((LAS unsigned*)(lds + LDSCTL_OFF))[u] = 0u;
    __syncthreads();
    const int lo = args.ph_lo, hi = args.ph_hi;
    XcdBarrier bar; bar.bar = ctl + CW_BAR; bar.x = 0; bar.st = nullptr;
    if (hi - lo > 1) bar = xcd_barrier_post(ctl + CW_BAR, (volatile LAS unsigned*)(lds + MISC_OFF) + 8);
    PA pa; pa.in = args.in; pa.ws = args.ws; pa.out = args.out;
#define IN(k) (lo <= (k) && (k) < hi)
#define SEAM(k) do { if (IN(k) && IN((k) + 1)) xcd_barrier(bar); } while (0)
    if (IN(0)) ph_prologue(pa); SEAM(0);
    if (IN(1)) ph_in0(pa); SEAM(1);
    if (IN(2)) ph_kmean(pa); SEAM(2);
    if (IN(3)) ph_s5moba(pa); SEAM(3);
    if (IN(4)) ph_glu(pa); SEAM(4);
    if (IN(5)) ph_out(pa, 0); SEAM(5);
#pragma unroll 1
    for (int layer = 0; layer < 2; ++layer) {
        const int pb = layer ? 15 : 6;
        if (layer == 1) {
            if (IN(11)) ph_in1(pa); SEAM(11);
            if (IN(12)) ph_gla(pa); SEAM(12);
            if (IN(13)) ph_glanorm(pa); SEAM(13);
            if (IN(14)) ph_out(pa, 1); SEAM(14);
        }
        if (IN(pb)) ph_lnrouter(pa, layer); SEAM(pb);
        if (IN(pb + 1)) ph_sort(pa); SEAM(pb + 1);
        if (IN(pb + 2)) ph_gateup(pa, layer); SEAM(pb + 2);
        if (IN(pb + 3)) ph_down(pa, layer); SEAM(pb + 3);
        if (layer == 0) { if (IN(10)) ph_combine(pa, 0); SEAM(10); }
        else { if (IN(19)) ph_combine(pa, 1); }
    }
#undef IN
#undef SEAM
}

static int g_grid = 0;
static bool launch_setup(size_t ws_size) {
    if (g_grid == 0) {
        if (ws_size < W_END) { fprintf(stderr, "kernel_launch: workspace too small: %zu < %zu\n", ws_size, (size_t)W_END); g_grid = -1; return false; }
        int dev = 0, cus = 0, per_cu = 0;
        if (hipGetDevice(&dev) != hipSuccess || hipDeviceGetAttribute(&cus, hipDeviceAttributeMultiprocessorCount, dev) != hipSuccess) { g_grid = -1; return false; }
        if (hipFuncSetAttribute((const void*)mega, hipFuncAttributeMaxDynamicSharedMemorySize, LDS_BYTES) != hipSuccess) { fprintf(stderr, "kernel_launch: hipFuncSetAttribute failed\n"); g_grid = -1; return false; }
        if (hipOccupancyMaxActiveBlocksPerMultiprocessor(&per_cu, (const void*)mega, 512, LDS_BYTES) != hipSuccess || per_cu < 1) fprintf(stderr, "kernel_launch: occupancy query reports %d blocks/CU\n", per_cu);
        (void)hipGetLastError();
        g_grid = cus;
    }
    return g_grid > 0;
}
static void launch_phases(hipStream_t stream, void* const* d_in, void* d_out, void* d_ws, int lo, int hi) {
    Args a; memset(&a, 0, sizeof a);
    for (int i = 0; i < 29; ++i) a.in[i] = (const float*)d_in[i];
    a.out = (float*)d_out; a.ws = (unsigned char*)d_ws; a.ph_lo = lo; a.ph_hi = hi;
    hipLaunchKernelGGL(mega, dim3(g_grid), dim3(512), LDS_BYTES, stream, a);
}
}
extern "C" void kernel_launch(void* const* d_in, const int* in_sizes, int n_in, void* d_out, int out_size, void* d_ws, size_t ws_size, hipStream_t stream) {
    if (n_in != 29 || out_size != T * D) { fprintf(stderr, "kernel_launch: unexpected arguments (n_in %d, out_size %d)\n", n_in, out_size); return; }
    if (!fk::launch_setup(ws_size)) return;
    (void)hipMemsetAsync((char*)d_ws + fk::W_CTL, 0, fk::CTL_ZERO_BYTES, stream);
    fk::launch_phases(stream, d_in, d_out, d_ws, 0, fk::NPH);
}
```

```cpp
#include <hip/hip_runtime.h>
#include <cstdio>
#include <cstdint>
#include <cmath>
#include <cstring>
#define DEV __device__ __forceinline__
constexpr int Bn = 16, L = 2048, D = 1024, T = Bn * L;
namespace fk {
#define LAS __attribute__((address_space(3)))
#define GAS __attribute__((address_space(1)))
typedef unsigned short bf16_t;
typedef short bf16x8 __attribute__((ext_vector_type(8)));
typedef short s16x4 __attribute__((ext_vector_type(4)));
typedef float f32x2 __attribute__((ext_vector_type(2)));
typedef float f32x4 __attribute__((ext_vector_type(4)));
typedef float f32x16 __attribute__((ext_vector_type(16)));
typedef unsigned u32x2 __attribute__((ext_vector_type(2)));
typedef unsigned u32x4 __attribute__((ext_vector_type(4)));
typedef __bf16 bf16x2_t __attribute__((ext_vector_type(2)));
DEV unsigned cvt_pk(float lo, float hi) { f32x2 v = {lo, hi}; bf16x2_t b = __builtin_convertvector(v, bf16x2_t); return __builtin_bit_cast(unsigned, b); }
DEV float bflo(unsigned w) { return __uint_as_float(w << 16); }
DEV float bfhi(unsigned w) { return __uint_as_float(w & 0xffff0000u); }
DEV float fast_sigm(float x) { return __builtin_amdgcn_rcpf(1.f + __builtin_amdgcn_exp2f(-1.4426950408889634f * x)); }
DEV float gelu_tanh(float x) { const float u = 0.7978845608028654f * (x + 0.044715f * x * x * x); return x * fast_sigm(2.f * u); }
DEV float wave_sum(float v) {
#pragma unroll
    for (int o = 1; o < 64; o <<= 1) v += __shfl_xor(v, o);
    return v; }
DEV float swap32(float x) { auto rr = __builtin_amdgcn_permlane32_swap(__float_as_uint(x), __float_as_uint(x), false, false); return __uint_as_float((threadIdx.x & 32) ? rr[0] : rr[1]); }

constexpr int BM = 256, BK = 64, HALF = 128, HTB = HALF * BK * 2, STAGE_BYTES = 8 * HTB, NXCD = 8, WGM = 8;
constexpr int LDS_TOK = 135168 - 2048;
constexpr int LDSCTL_OFF = 135168, MISC_OFF = LDSCTL_OFF + 320, LDS_BYTES = 163840;

DEV int lds_byte(int r, int c) { const int st = (r >> 4) * 2 + (c >> 5), rr = r & 15, cc = c & 31, ob = rr * 64 + cc * 2; return st * 1024 + (ob ^ (((ob >> 9) & 1) << 5)); }
DEV void stage_rc(int b, int& R, int& C) { const int st = b / 1024, sb = b % 1024, swz = sb ^ (((sb >> 9) & 1) << 5); R = (st >> 1) * 16 + swz / 64; C = (st & 1) * 32 + (swz % 64) / 2; }
DEV int perm32(int rho) { const int n = rho >> 4, i = rho & 15; return 8 * (i >> 2) + 4 * n + (i & 3); }

struct Unit { int pm, pn, e; };
struct Gemm { const bf16_t* A; const bf16_t* Bt; const int* rowmap; size_t bstride; int K; };

struct StaticOrder {
    int nM, nN, nwg, G, c; const int* tile_e;
    DEV void init(int nM_, int nN_, int G_, int c_, const int* te) { nM = nM_; nN = nN_; nwg = nM * nN; G = G_; c = c_; tile_e = te; }
    DEV bool next(int i, Unit& u) const {
        const long Lx = (long)i * G + c; if (Lx >= nwg) return false;
        int wgid = (int)Lx; { const int q = nwg / NXCD, r = nwg % NXCD, xcd = wgid % NXCD, off = wgid / NXCD; wgid = (xcd < r ? xcd * (q + 1) : r * (q + 1) + (xcd - r) * q) + off; }
        const int nig = WGM * nN, gid = wgid / nig, fm = gid * WGM, gsz = (nM - fm) < WGM ? (nM - fm) : WGM;
        u.pm = fm + ((wgid % nig) % gsz); u.pn = (wgid % nig) / gsz; u.e = tile_e ? __builtin_amdgcn_readfirstlane(tile_e[u.pm]) : 0; return true;
    }
};

template <class F> struct EpiRow8 {
    static constexpr bool PERM = true; F f;
    DEV void operator()(const f32x4 (&acc)[2][2][4][2], const Unit& u, int wr, int wc, int fr, int fq) const {
#pragma unroll
        for (int ai = 0; ai < 2; ++ai)
#pragma unroll
            for (int m = 0; m < 4; ++m) { const int row = u.pm * BM + ai * HALF + wr * 64 + m * 16 + fr;
#pragma unroll
                for (int bj = 0; bj < 2; ++bj) f(u, row, u.pn * BM + bj * HALF + wc * 32 + 8 * fq, acc[ai][bj][m][0], acc[ai][bj][m][1]); }
    }
};

template <bool GATHER, class Epi, class Sched>
DEV void gemm_phase(LAS unsigned char* lds, const Gemm g, const Sched& S, const Epi& E) {
    int tid = threadIdx.x; asm volatile("" : "+v"(tid)); const int wid = __builtin_amdgcn_readfirstlane(tid >> 6), lane = tid & 63, wr = wid >> 2, wc = wid & 3, fr = lane & 15, fq = lane >> 4;
    const int K = g.K, nt = K / BK;
    unsigned voffB[2]; int RA[2], CA[2];
#pragma unroll
    for (int i = 0; i < 2; ++i) { int R, C; stage_rc(tid * 16 + i * 8192, R, C); const int Rb = Epi::PERM ? ((R & ~31) + perm32(R & 31)) : R; RA[i] = R; CA[i] = C; voffB[i] = (unsigned)(Rb * K + C) * 2u; }
    const size_t kstep = (size_t)(BK * 2), hstep = (size_t)HALF * K * 2, tstep = 2 * hstep;
    const unsigned ldsw = (unsigned)wid * 1024u;
    const int aoff = lds_byte(wr * 64 + fr, fq * 8), boff = lds_byte(wc * 32 + fr, fq * 8);
    LAS int* tokb = (LAS int*)(lds + LDS_TOK);
#define PG8_SA(b, h) (((b) * 2 + (h)) * HTB)
#define PG8_SB(b, h) ((4 + (b) * 2 + (h)) * HTB)
#define PG8_STAGE(bufoff, gbase, voff) do { _Pragma("unroll") for (int _i = 0; _i < 2; ++_i) \
        __builtin_amdgcn_global_load_lds((const unsigned*)((const char*)(gbase) + (voff)[_i]), (LAS unsigned*)(lds + (bufoff) + ldsw + _i * 8192), 16, 0, 0); } while (0)
#define PG8_LDA(dst, b, h) do { _Pragma("unroll") for (int m = 0; m < 4; ++m) _Pragma("unroll") for (int k = 0; k < 2; ++k) dst[m][k] = *(const LAS bf16x8*)(lds + PG8_SA(b, h) + aoff + m * 2048 + k * 1024); } while (0)
#define PG8_LDB(dst, b, h) do { _Pragma("unroll") for (int n = 0; n < 2; ++n) _Pragma("unroll") for (int k = 0; k < 2; ++k) dst[n][k] = *(const LAS bf16x8*)(lds + PG8_SB(b, h) + boff + n * 2048 + k * 1024); } while (0)
#define PG8_MMA(ai, bj, At, Bt) do { __builtin_amdgcn_s_setprio(1); _Pragma("unroll") for (int m = 0; m < 4; ++m) _Pragma("unroll") for (int n = 0; n < 2; ++n) _Pragma("unroll") for (int k = 0; k < 2; ++k) \
        acc[ai][bj][m][n] = __builtin_amdgcn_mfma_f32_16x16x32_bf16(Bt[n][k], At[m][k], acc[ai][bj][m][n], 0, 0, 0); __builtin_amdgcn_s_setprio(0); } while (0)
#define PG8_WAIT_V(n) asm volatile("s_waitcnt vmcnt(" #n ")" ::: "memory")
#define PG8_WAIT_L(n) asm volatile("s_waitcnt lgkmcnt(" #n ")" ::: "memory")
#define PG8_BAR __builtin_amdgcn_s_barrier()
#define PG8_SCHED __builtin_amdgcn_sched_barrier(0)
    Unit cur, nxt; int ui = 0;
    if (!S.next(0, cur)) return;
    f32x4 acc[2][2][4][2];
#pragma unroll
    for (int a = 0; a < 2; ++a)
#pragma unroll
        for (int b = 0; b < 2; ++b)
#pragma unroll
            for (int m = 0; m < 4; ++m)
#pragma unroll
                for (int n = 0; n < 2; ++n) acc[a][b][m][n] = (f32x4){0.f, 0.f, 0.f, 0.f};
    bf16x8 At[4][2], B0[2][2], B1[2][2];
    unsigned oA[2][2], nO[2][2];
    const char* cA; const char* cB = (const char*)g.Bt + ((size_t)cur.e * g.bstride) * 2 + (size_t)cur.pn * tstep;
    if constexpr (GATHER) { cA = (const char*)g.A;
#pragma unroll
        for (int h = 0; h < 2; ++h)
#pragma unroll
            for (int i = 0; i < 2; ++i) oA[h][i] = (unsigned)(g.rowmap[cur.pm * BM + h * HALF + RA[i]] * K + CA[i]) * 2u;
    } else { cA = (const char*)g.A + (size_t)cur.pm * tstep;
#pragma unroll
        for (int h = 0; h < 2; ++h)
#pragma unroll
            for (int i = 0; i < 2; ++i) oA[h][i] = (unsigned)(RA[i] * K + CA[i]) * 2u + (unsigned)(h * hstep);
    }
#pragma unroll
    for (int h = 0; h < 2; ++h)
#pragma unroll
        for (int i = 0; i < 2; ++i) nO[h][i] = oA[h][i];
    PG8_STAGE(PG8_SB(0, 0), cB, voffB); PG8_STAGE(PG8_SB(0, 1), cB + hstep, voffB); PG8_STAGE(PG8_SA(0, 0), cA, oA[0]); PG8_STAGE(PG8_SA(0, 1), cA, oA[1]);
    if (wr == 1) PG8_BAR;
    PG8_WAIT_V(2); PG8_BAR;
    PG8_STAGE(PG8_SB(1, 0), cB + kstep, voffB); PG8_STAGE(PG8_SA(1, 0), cA + kstep, oA[0]); PG8_STAGE(PG8_SB(1, 1), cB + hstep + kstep, voffB);
    PG8_WAIT_V(6); PG8_BAR;
    for (;;) {
        const bool has_next = S.next(ui + 1, nxt);
        const char* nA = cA; const char* nB = cB;
        if (has_next) { nB = (const char*)g.Bt + ((size_t)nxt.e * g.bstride) * 2 + (size_t)nxt.pn * tstep;
            if constexpr (GATHER) { if (wid < 4) __builtin_amdgcn_global_load_lds((const unsigned*)(g.rowmap + nxt.pm * BM + wid * 64 + lane), (LAS unsigned*)(tokb + ((ui + 1) & 1) * 256 + wid * 64), 4, 0, 0); }
            else nA = (const char*)g.A + (size_t)nxt.pm * tstep; }
        for (int t = 0; t < nt; t += 2) {
            const bool last = (t == nt - 2);
            if constexpr (GATHER) { if (last && has_next) {
#pragma unroll
                for (int h = 0; h < 2; ++h)
#pragma unroll
                    for (int i = 0; i < 2; ++i) nO[h][i] = (unsigned)(tokb[((ui + 1) & 1) * 256 + h * HALF + RA[i]] * K + CA[i]) * 2u; } }
            const char* a1 = cA + (size_t)(t + 1) * kstep;
            const char* a2 = last ? nA : cA + (size_t)(t + 2) * kstep; const char* b2 = last ? nB : cB + (size_t)(t + 2) * kstep;
            const char* a3 = a2 + kstep; const char* b3 = b2 + kstep;
            unsigned o2[2][2];
#pragma unroll
            for (int h = 0; h < 2; ++h)
#pragma unroll
                for (int i = 0; i < 2; ++i) o2[h][i] = (GATHER && last) ? nO[h][i] : oA[h][i];
            PG8_LDB(B0, 0, 0); PG8_LDB(B1, 0, 1); PG8_SCHED; PG8_LDA(At, 0, 0); PG8_STAGE(PG8_SA(1, 1), a1, oA[1]);
            PG8_WAIT_V(8); PG8_WAIT_L(0); PG8_BAR; PG8_MMA(0, 0, At, B0); PG8_MMA(0, 1, At, B1); PG8_BAR; PG8_SCHED;
            PG8_LDA(At, 0, 1); PG8_STAGE(PG8_SB(0, 0), b2, voffB); PG8_STAGE(PG8_SB(0, 1), b2 + hstep, voffB); PG8_STAGE(PG8_SA(0, 0), a2, o2[0]);
            PG8_WAIT_V(8); PG8_WAIT_L(0); PG8_BAR; PG8_MMA(1, 0, At, B0); PG8_MMA(1, 1, At, B1); PG8_BAR; PG8_SCHED;
            PG8_LDB(B0, 1, 0); PG8_LDB(B1, 1, 1); PG8_SCHED; PG8_LDA(At, 1, 0); PG8_STAGE(PG8_SA(0, 1), a2, o2[1]);
            PG8_WAIT_V(8); PG8_WAIT_L(0); PG8_BAR; PG8_MMA(0, 0, At, B0); PG8_MMA(0, 1, At, B1); PG8_BAR; PG8_SCHED;
            PG8_LDA(At, 1, 1); PG8_STAGE(PG8_SB(1, 0), b3, voffB); PG8_STAGE(PG8_SB(1, 1), b3 + hstep, voffB); PG8_STAGE(PG8_SA(1, 0), a3, o2[0]);
            PG8_WAIT_V(8); PG8_WAIT_L(0); PG8_BAR; PG8_MMA(1, 0, At, B0); PG8_MMA(1, 1, At, B1); PG8_BAR; PG8_SCHED;
        }
        if (wr == 0) PG8_BAR;
        E(acc, cur, wr, wc, fr, fq);
        if (!has_next) break;
#pragma unroll
        for (int a = 0; a < 2; ++a)
#pragma unroll
            for (int b = 0; b < 2; ++b)
#pragma unroll
                for (int m = 0; m < 4; ++m)
#pragma unroll
                    for (int n = 0; n < 2; ++n) acc[a][b][m][n] = (f32x4){0.f, 0.f, 0.f, 0.f};
        cur = nxt; cA = nA; cB = nB; ++ui;
        if constexpr (GATHER) {
#pragma unroll
            for (int h = 0; h < 2; ++h)
#pragma unroll
                for (int i = 0; i < 2; ++i) oA[h][i] = nO[h][i]; }
        if (wr == 1) PG8_BAR;
    }
    PG8_WAIT_V(0);
    PG8_BAR;
#undef PG8_SA
#undef PG8_SB
#undef PG8_STAGE
#undef PG8_LDA
#undef PG8_LDB
#undef PG8_MMA
#undef PG8_WAIT_V
#undef PG8_WAIT_L
#undef PG8_BAR
#undef PG8_SCHED
}

typedef GAS unsigned gu32;
#define XB_TMO      128
#define XB_XCNT(j)  (256  + 64 * (j))
#define XB_XSUB(j)  (1280 + 64 * (j))
#define XB_XGEN(j)  (2304 + 64 * (j))
#define XB_TOP      3328
#define XB_TOPGEN   3392
#define XCD_BAR_WORDS 3456
#define XB_SPIN_CAP (1u << 20)
DEV unsigned xb_ld(unsigned* p) { return __hip_atomic_load(p, __ATOMIC_RELAXED, __HIP_MEMORY_SCOPE_AGENT); }
DEV unsigned xb_add(unsigned* p, unsigned v) { return __hip_atomic_fetch_add(p, v, __ATOMIC_RELAXED, __HIP_MEMORY_SCOPE_AGENT); }
DEV unsigned xb_xcc_id() { return (unsigned)__builtin_amdgcn_s_getreg((3 << 11) | 20) & 0xFu; }
#define XB_SPIN(cond, bar) do { unsigned _sp = 0; while (cond) { __builtin_amdgcn_s_sleep(1); \
    if ((++_sp & 255u) == 0u) { if (xb_ld(&(bar)[XB_TMO])) break; if (_sp > XB_SPIN_CAP) { atomicAdd(&(bar)[XB_TMO], 1u); break; } } } } while (0)
struct XcdBarrier { unsigned* bar; unsigned x; volatile LAS unsigned* st; };
DEV XcdBarrier xcd_barrier_post(unsigned* bar, volatile LAS unsigned* st) {
    XcdBarrier b; b.bar = bar; b.x = xb_xcc_id(); b.st = st;
    if (threadIdx.x == 0) (void)xb_add(&bar[XB_XCNT(b.x)], 1u);
    return b;
}
DEV void xcd_barrier_complete(unsigned* bar, unsigned x, unsigned& nloc, unsigned& nx) {
    const unsigned G = gridDim.x * gridDim.y * gridDim.z;
    unsigned sum, cnt, mine, sp = 0u;
    for (;;) {
        sum = 0u; cnt = 0u; mine = 0u;
#pragma unroll
        for (unsigned j = 0; j < 16; ++j) { const unsigned c = xb_ld(&bar[XB_XCNT(j)]); sum += c; cnt += (c > 0u) ? 1u : 0u; mine = (j == x) ? c : mine; }
        if (sum == G) break;
        __builtin_amdgcn_s_sleep(1);
        if ((++sp & 255u) == 0u) { if (xb_ld(&bar[XB_TMO])) break; if (sp > XB_SPIN_CAP) { atomicAdd(&bar[XB_TMO], 1u); break; } }
    }
    nloc = mine > 0u ? mine : 1u; nx = cnt > 0u ? cnt : 1u;
}
DEV void xcd_barrier(const XcdBarrier& b) {
    asm volatile("s_waitcnt vmcnt(0)" ::: "memory");
    __syncthreads();
    if (threadIdx.x == 0) {
        unsigned* bar = b.bar;
        __builtin_amdgcn_s_waitcnt(0);
        unsigned nloc = b.st[0], nx = b.st[1];
        if (nloc == 0u) { xcd_barrier_complete(bar, b.x, nloc, nx); b.st[0] = nloc; b.st[1] = nx; }
        const unsigned old = xb_add(&bar[XB_XSUB(b.x)], 1u);
        const unsigned gen = old / nloc;
        if (old + 1u == (gen + 1u) * nloc) {
            __builtin_amdgcn_fence(__ATOMIC_RELEASE, "agent");
            asm volatile("s_waitcnt vmcnt(0)" ::: "memory");
            const unsigned og = xb_add(&bar[XB_TOP], 1u);
            const unsigned tg = og / nx;
            if (og + 1u == (tg + 1u) * nx) xb_add(&bar[XB_TOPGEN], 1u);
            else XB_SPIN(xb_ld(&bar[XB_TOPGEN]) == tg, bar);
            __builtin_amdgcn_fence(__ATOMIC_ACQUIRE, "agent");
            xb_add(&bar[XB_XGEN(b.x)], 1u);
            asm volatile("s_waitcnt vmcnt(0)" ::: "memory");
        } else {
            XB_SPIN(xb_ld(&bar[XB_XGEN(b.x)]) == gen, bar);
            __builtin_amdgcn_fence(__ATOMIC_ACQUIRE, "agent");
            asm volatile("s_waitcnt vmcnt(0)" ::: "memory");
        }
    }
    __syncthreads();
}
constexpr size_t MiB = 1u << 20;
constexpr int PMAX = 131072 + 32 * 256;
constexpr size_t W_CTL = 0, CTL_ZERO_BYTES = 1 * MiB;
constexpr size_t W_IN0 = 2 * MiB, W_GLU = 6 * MiB, W_OUT0 = 7 * MiB, W_IN1 = 9 * MiB, W_OUT1 = 16 * MiB;
constexpr size_t W_LUT = 18 * MiB, W_KM = W_LUT + 64 * 1024, W_HIST = W_KM + 256 * 1024, W_SORT = W_HIST + 64 * 1024  , W_GR = 20 * MiB  , W_SS = 22 * MiB  ;
constexpr size_t W_GU = 32 * MiB, W_DN = 288 * MiB, W_XB = 416 * MiB  , W_XBB = 480 * MiB  , W_HB = 736 * MiB, W_YS5 = 928 * MiB, W_Y0 = 960 * MiB, W_MIXB = 1024 * MiB, W_GLAO = 1088 * MiB;
constexpr size_t W_ROUTE = 1152 * MiB  , W_ACT = 736 * MiB  , W_YS = 1160 * MiB, W_END = 1432 * MiB;
static_assert(W_ACT + (size_t)PMAX * 2048 <= W_MIXB && W_YS + (size_t)PMAX * 2048 <= W_END, "ws map");
constexpr int CW_BAR = 4096;

struct Args { const float* in[29]; float* out; unsigned char* ws; int ph_lo, ph_hi; };
struct Frame {
    LAS unsigned char* lds; int tid, lane, wave, vcu, G;
    const float* const* in; unsigned char* ws;
};
#define WSP(T_, off) ((T_*)(F.ws + (off)))

DEV void transpose_item(const float* W, int K, int N, bf16_t* WT, LAS float* scr, int item, int lane) {
    const int nblk = N / 64, kb = item / nblk, nb = item % nblk, k0 = 64 * kb, n0 = 64 * nb;
    const float* src = W + (size_t)k0 * N + n0 + lane;
#pragma unroll 16
    for (int kk = 0; kk < 64; ++kk) scr[kk * 65 + lane] = src[(size_t)kk * N];
    asm volatile("s_waitcnt lgkmcnt(0)" ::: "memory");
    const int c = lane & 7;
#pragma unroll
    for (int j = 0; j < 8; ++j) { const int n = (lane >> 3) + 8 * j; const LAS float* s = scr + (8 * c) * 65 + n;
        u32x4 o; o.x = cvt_pk(s[0 * 65], s[1 * 65]); o.y = cvt_pk(s[2 * 65], s[3 * 65]); o.z = cvt_pk(s[4 * 65], s[5 * 65]); o.w = cvt_pk(s[6 * 65], s[7 * 65]);
        *(u32x4*)(WT + (size_t)(n0 + n) * K + k0 + 8 * c) = o; }
    asm volatile("s_waitcnt lgkmcnt(0)" ::: "memory");
}
__constant__ int BUCKET_TH2[16] = {16, 22, 30, 40, 54, 73, 99, 134, 182, 246, 332, 450, 609, 825, 1117, 1513};
DEV void p0_prologue(Frame& F) {
    LAS float* scr = (LAS float*)(F.lds + F.wave * 16640);
    const int gw = F.vcu * 8 + F.wave, NGW = F.G * 8;
    constexpr int I_GU = 16 * 32, I_DN = 16 * 16, I_IN0 = 16 * 32, I_GLU = 8 * 8, I_O = 16 * 16, I_IN1 = 16 * 48;
    constexpr int N_GU = 64 * I_GU, N_DN = 64 * I_DN;
    constexpr int NITEMS = N_GU + N_DN + I_IN0 + I_GLU + 2 * I_O + I_IN1;
    for (int it = gw; it < NITEMS; it += NGW) {
        int r = it;
        if (r < N_GU) { const int m = r / I_GU; transpose_item(F.in[25] + (size_t)m * 1024 * 2048, 1024, 2048, WSP(bf16_t, W_GU) + (size_t)m * 2048 * 1024, scr, r % I_GU, F.lane); continue; } r -= N_GU;
        if (r < N_DN) { const int m = r / I_DN; transpose_item(F.in[27] + (size_t)m * 1024 * 1024, 1024, 1024, WSP(bf16_t, W_DN) + (size_t)m * 1024 * 1024, scr, r % I_DN, F.lane); continue; } r -= N_DN;
        if (r < I_IN0) { transpose_item(F.in[1], 1024, 2048, WSP(bf16_t, W_IN0), scr, r, F.lane); continue; } r -= I_IN0;
        if (r < I_GLU) { transpose_item(F.in[10], 512, 512, WSP(bf16_t, W_GLU), scr, r, F.lane); continue; } r -= I_GLU;
        if (r < I_O) { transpose_item(F.in[13], 1024, 1024, WSP(bf16_t, W_OUT0), scr, r, F.lane); continue; } r -= I_O;
        if (r < I_O) { transpose_item(F.in[18], 1024, 1024, WSP(bf16_t, W_OUT1), scr, r, F.lane); continue; } r -= I_O;
        { const int kb = r / 48, nb = r % 48; const float* src = F.in[14] + (size_t)(64 * kb) * 3088 + 64 * nb + F.lane;
#pragma unroll 16
          for (int kk = 0; kk < 64; ++kk) scr[kk * 65 + F.lane] = src[(size_t)kk * 3088];
          asm volatile("s_waitcnt lgkmcnt(0)" ::: "memory");
          const int c = F.lane & 7;
#pragma unroll
          for (int j = 0; j < 8; ++j) { const int n = (F.lane >> 3) + 8 * j; const LAS float* s = scr + (8 * c) * 65 + n;
              u32x4 o; o.x = cvt_pk(s[0 * 65], s[1 * 65]); o.y = cvt_pk(s[2 * 65], s[3 * 65]); o.z = cvt_pk(s[4 * 65], s[5 * 65]); o.w = cvt_pk(s[6 * 65], s[7 * 65]);
              *(u32x4*)(WSP(bf16_t, W_IN1) + (size_t)(64 * nb + n) * 1024 + 64 * kb + 8 * c) = o; }
          asm volatile("s_waitcnt lgkmcnt(0)" ::: "memory"); }
    }
    const int gt = F.vcu * 512 + F.tid, NGT = F.G * 512;
    for (int i = gt; i < 16 * 1024; i += NGT) { const int n = i >> 10, k = i & 1023; WSP(bf16_t, W_IN1)[(size_t)(3072 + n) * 1024 + k] = (bf16_t)(cvt_pk(F.in[14][(size_t)k * 3088 + 3072 + n], 0.f) & 0xffffu); }
    { const f32x4* x4 = (const f32x4*)F.in[0]; u32x2* o = WSP(u32x2, W_XB);
      for (size_t i = gt; i < (size_t)T * 1024 / 4; i += NGT) { const f32x4 v = x4[i]; u32x2 w; w.x = cvt_pk(v.x, v.y); w.y = cvt_pk(v.z, v.w); o[i] = w; } }
    for (int i = gt; i < 8 * 2048; i += NGT) { const int h = i >> 11, n = i & 2047; int bk = n;
        if (n >= 16) { bk = 16;
#pragma unroll
            for (int q = 1; q < 16; ++q) bk += (n >= BUCKET_TH2[q]) ? 1 : 0; }
        WSP(float, W_LUT)[i] = F.in[12][bk * 8 + h] * 1.4426950408889634f; }
}

DEV void p_kmean(Frame& F) {
    const int gw = F.vcu * 8 + F.wave, NGW = F.G * 8; const bf16_t* H0 = WSP(bf16_t, W_HB); float* KM = WSP(float, W_KM);
    for (int it = gw; it < 1024; it += NGW) { const int blk = it & 7, h = (it >> 3) & 7, b = it >> 6; const int r8 = F.lane >> 3, c = F.lane & 7;
        const bf16_t* p = H0 + (size_t)(b * 2048 + blk * 256 + r8) * 2048 + 1024 + h * 64 + c * 8; float s[8];
#pragma unroll
        for (int j = 0; j < 8; ++j) s[j] = 0.f;
#pragma unroll 8
        for (int i = 0; i < 32; ++i) { const u32x4 v = *(const u32x4*)(p + (size_t)i * 8 * 2048);
            s[0] += bflo(v.x); s[1] += bfhi(v.x); s[2] += bflo(v.y); s[3] += bfhi(v.y); s[4] += bflo(v.z); s[5] += bfhi(v.z); s[6] += bflo(v.w); s[7] += bfhi(v.w); }
#pragma unroll
        for (int j = 0; j < 8; ++j) { s[j] += __shfl_xor(s[j], 8); s[j] += __shfl_xor(s[j], 16); s[j] += __shfl_xor(s[j], 32); }
        if (F.lane < 8) {
#pragma unroll
            for (int j = 0; j < 8; ++j) KM[(size_t)it * 64 + c * 8 + j] = s[j] * (1.f / 256.f); } }
}

DEV void s5_item(Frame& F, int b, int g, LAS unsigned char* sl  ) {
    const int lane = F.lane, p0 = lane & 31, hi = lane >> 5, q4 = lane >> 4;
    const float* lam_re = F.in[2]; const float* lam_im = F.in[3]; const float* log_dt = F.in[4]; const float* b_re = F.in[5]; const float* b_im = F.in[6];
    const float* c_re = F.in[7]; const float* c_im = F.in[8]; const float* dsk = F.in[9];
    const bf16_t* H0 = WSP(bf16_t, W_HB); bf16_t* YS = WSP(bf16_t, W_YS5);
    const float dt = __expf(log_dt[g]);
    float ar[2], ai[2]; bf16x8 bfr[4];
#pragma unroll
    for (int s = 0; s < 2; ++s) { const int p = p0 + 32 * s; const float lr = lam_re[g * 64 + p], li = lam_im[g * 64 + p]; const float mag = __expf(lr * dt);
        ar[s] = mag * cosf(li * dt); ai[s] = mag * sinf(li * dt);
        const float er = ar[s] - 1.f, ei = ai[s], den = lr * lr + li * li; const float qr = (er * lr + ei * li) / den, qi = (ei * lr - er * li) / den;
        u32x4 wr_, wi_; float vr[8], vi[8];
#pragma unroll
        for (int j = 0; j < 8; ++j) { const float br = b_re[(g * 64 + p) * 16 + 8 * hi + j], bi = b_im[(g * 64 + p) * 16 + 8 * hi + j]; vr[j] = qr * br - qi * bi; vi[j] = qr * bi + qi * br; }
        wr_.x = cvt_pk(vr[0], vr[1]); wr_.y = cvt_pk(vr[2], vr[3]); wr_.z = cvt_pk(vr[4], vr[5]); wr_.w = cvt_pk(vr[6], vr[7]);
        wi_.x = cvt_pk(vi[0], vi[1]); wi_.y = cvt_pk(vi[2], vi[3]); wi_.z = cvt_pk(vi[4], vi[5]); wi_.w = cvt_pk(vi[6], vi[7]);
        bfr[2 * s] = __builtin_bit_cast(bf16x8, wr_); bfr[2 * s + 1] = __builtin_bit_cast(bf16x8, wi_); }
    bf16x8 cfr[4];
#pragma unroll
    for (int ks = 0; ks < 4; ++ks) { float v[8];
#pragma unroll
        for (int j = 0; j < 8; ++j) { const int c = 32 * ks + 8 * q4 + j, p = c >> 1; const int h = lane & 15; v[j] = (c & 1) ? -c_im[(g * 16 + h) * 64 + p] : c_re[(g * 16 + h) * 64 + p]; }
        u32x4 w; w.x = cvt_pk(v[0], v[1]); w.y = cvt_pk(v[2], v[3]); w.z = cvt_pk(v[4], v[5]); w.w = cvt_pk(v[6], v[7]); cfr[ks] = __builtin_bit_cast(bf16x8, w); }
    float dv[4];
#pragma unroll
    for (int r = 0; r < 4; ++r) dv[r] = dsk[g * 16 + 4 * q4 + r];
    const int tm = 16 * ((p0 >> 2) & 1) + 4 * (p0 >> 3) + (p0 & 3);
    const bf16_t* urow = H0 + (size_t)(b * 2048 + tm) * 2048 + g * 16 + 8 * hi;
    float cr[2] = {0.f, 0.f}, ci[2] = {0.f, 0.f};
    bf16x8 ufr = *(const bf16x8*)urow;
    for (int tile = 0; tile < 64; ++tile) {
        const bf16x8 ucur = ufr;
        if (tile + 1 < 64) ufr = *(const bf16x8*)(urow + (size_t)(tile + 1) * 32 * 2048);
        f32x16 x[4];
#pragma unroll
        for (int n = 0; n < 4; ++n) { f32x16 z;
#pragma unroll
            for (int r = 0; r < 16; ++r) z[r] = 0.f;
            x[n] = __builtin_amdgcn_mfma_f32_32x32x16_bf16(ucur, bfr[n], z, 0, 0, 0); }
#pragma unroll
        for (int s = 0; s < 2; ++s) {
            f32x16& xr = x[2 * s]; f32x16& xi = x[2 * s + 1];
            float sr = hi ? 0.f : cr[s], si = hi ? 0.f : ci[s];
#pragma unroll
            for (int r = 0; r < 16; ++r) { const float nr = ar[s] * sr - ai[s] * si + xr[r], ni = ar[s] * si + ai[s] * sr + xi[r]; xr[r] = nr; xi[r] = ni; sr = nr; si = ni; }
            const float o_r = swap32(sr), o_i = swap32(si);
            float wr_ = hi ? o_r : 0.f, wi_ = hi ? o_i : 0.f;
#pragma unroll
            for (int r = 0; r < 16; ++r) { const float nr = ar[s] * wr_ - ai[s] * wi_, ni = ar[s] * wi_ + ai[s] * wr_; wr_ = nr; wi_ = ni; xr[r] += wr_; xi[r] += wi_; }
            const float e_r = swap32(xr[15]), e_i = swap32(xi[15]);
            cr[s] = hi ? xr[15] : e_r; ci[s] = hi ? xi[15] : e_i;
#pragma unroll
            for (int r = 0; r < 16; ++r) *(LAS unsigned*)(sl + (16 * hi + r) * 256 + (p0 + 32 * s) * 4) = cvt_pk(xr[r], xi[r]);
        }
#pragma unroll
        for (int tt = 0; tt < 2; ++tt) {
            f32x4 y = {0.f, 0.f, 0.f, 0.f};
#pragma unroll
            for (int ks = 0; ks < 4; ++ks) { const bf16x8 sf = *(const LAS bf16x8*)(sl + (16 * tt + (lane & 15)) * 256 + ks * 64 + q4 * 16); y = __builtin_amdgcn_mfma_f32_16x16x32_bf16(cfr[ks], sf, y, 0, 0, 0); }
            const int t = tile * 32 + 16 * tt + (lane & 15);
            const u32x2 uw = *(const u32x2*)(H0 + (size_t)(b * 2048 + t) * 2048 + g * 16 + 4 * q4);
            const float y0 = gelu_tanh(y[0] + dv[0] * bflo(uw.x)), y1 = gelu_tanh(y[1] + dv[1] * bfhi(uw.x)), y2 = gelu_tanh(y[2] + dv[2] * bflo(uw.y)), y3 = gelu_tanh(y[3] + dv[3] * bfhi(uw.y));
            u32x2 ow; ow.x = cvt_pk(y0, y1); ow.y = cvt_pk(y2, y3);
            *(u32x2*)(YS + (size_t)(b * 2048 + t) * 512 + g * 16 + 4 * q4) = ow;
        }
    }
}

constexpr int AT_K = 0, AT_V = 16384, AT_LUT = 32768, AT_WS = 40960, AT_OST = 43008, AT_END = AT_OST + 8 * 4096;
DEV int crow(int r, int hi) { return (r & 3) + 8 * (r >> 2) + 4 * hi; }
DEV s16x4 vtr(const LAS unsigned char* p) { typedef short v4i16_t __attribute__((ext_vector_type(4))); return __builtin_bit_cast(s16x4, __builtin_amdgcn_ds_read_tr16_b64_v4i16((LAS v4i16_t*)p)); }
DEV void moba_unit(Frame& F, int b, int h, int own) {
    const int lane = F.lane, wid = F.wave, r32 = lane & 31, hi = lane >> 5;
    LAS unsigned char* lds = F.lds;
    const bf16_t* H0 = WSP(bf16_t, W_HB); const float* KM = WSP(float, W_KM);
    LAS float* lut = (LAS float*)(lds + AT_LUT); LAS float* wsf = (LAS float*)(lds + AT_WS) + wid * 64;
    const size_t rowbase = (size_t)b * 2048;
    const int qpos = own * 256 + wid * 32 + r32;
    bf16x8 qr[4];
#pragma unroll
    for (int d0 = 0; d0 < 4; ++d0) qr[d0] = *(const bf16x8*)(H0 + (rowbase + qpos) * 2048 + 512 + h * 64 + d0 * 16 + hi * 8);
    unsigned selmask = 0u;
    if (own > 0) {
        float gate[7];
#pragma unroll
        for (int j = 0; j < 7; ++j) { float s = 0.f;
            if (j < own) { const float* km = KM + ((size_t)(b * 8 + h) * 8 + j) * 64 + hi * 8;
#pragma unroll
                for (int d0 = 0; d0 < 4; ++d0) { const f32x4 k0 = *(const f32x4*)(km + d0 * 16), k1 = *(const f32x4*)(km + d0 * 16 + 4); const u32x4 qw = __builtin_bit_cast(u32x4, qr[d0]);
                    s += bflo(qw.x) * k0.x + bfhi(qw.x) * k0.y + bflo(qw.y) * k0.z + bfhi(qw.y) * k0.w + bflo(qw.z) * k1.x + bfhi(qw.z) * k1.y + bflo(qw.w) * k1.z + bfhi(qw.w) * k1.w; } }
            gate[j] = s + swap32(s); }
#pragma unroll
        for (int j = 0; j < 7; ++j) { int rank = 0;
#pragma unroll
            for (int j2 = 0; j2 < 7; ++j2) if (j2 != j && j2 < own && (gate[j2] > gate[j] || (gate[j2] == gate[j] && j2 < j))) ++rank;
            if (j < own && rank < 3) selmask |= 1u << j; }
    }
    const int NT = 4 * (own + 1);
#define KV0(i) ((i) < 4 ? own * 256 + (i) * 64 : (((i) - 4) >> 2) * 256 + (((i) - 4) & 3) * 64)
    const bf16_t* kbase = H0 + (rowbase + lane) * 2048 + 1024 + h * 64 + wid * 8;
    const bf16_t* vbase = H0 + (rowbase + 16 * (wid & 3) + (lane >> 2)) * 2048 + 1536 + h * 64 + (wid >> 2) * 32 + (lane & 3) * 8;
#define LOADKV(i) do { const int kv0_ = KV0(i); const int bo_ = ((i) & 1) * 8192; \
        __builtin_amdgcn_global_load_lds((const unsigned*)(kbase + (size_t)kv0_ * 2048), (LAS unsigned*)(lds + AT_K + bo_ + wid * 1024), 16, 0, 0); \
        __builtin_amdgcn_global_load_lds((const unsigned*)(vbase + (size_t)kv0_ * 2048), (LAS unsigned*)(lds + AT_V + bo_ + wid * 1024), 16, 0, 0); } while (0)
    LOADKV(0);
    float m_run = -INFINITY, l_run = 0.f; f32x16 o[2];
#pragma unroll
    for (int r = 0; r < 16; ++r) { o[0][r] = 0.f; o[1][r] = 0.f; }
    asm volatile("s_waitcnt vmcnt(0)" ::: "memory"); __syncthreads();
    for (int i = 0; i < NT; ++i) {
        if (i + 1 < NT) LOADKV(i + 1);
        const int kv0 = KV0(i); const int bo = (i & 1) * 8192;
        const bool rowsel = (i < 4) || ((selmask >> ((i - 4) >> 2)) & 1u);
        f32x16 p0, p1;
#pragma unroll
        for (int r = 0; r < 16; ++r) { p0[r] = 0.f; p1[r] = 0.f; }
        { const LAS unsigned char* kb = lds + AT_K + bo + hi * 1024 + r32 * 16;
#pragma unroll
          for (int d0 = 0; d0 < 4; ++d0) { const bf16x8 k0 = *(const LAS bf16x8*)(kb + d0 * 2048), k1 = *(const LAS bf16x8*)(kb + d0 * 2048 + 512);
              p0 = __builtin_amdgcn_mfma_f32_32x32x16_bf16(k0, qr[d0], p0, 0, 0, 0); p1 = __builtin_amdgcn_mfma_f32_32x32x16_bf16(k1, qr[d0], p1, 0, 0, 0); } }
        const int dbase = qpos - kv0 - 4 * hi;
        float rmax = -INFINITY;
#pragma unroll
        for (int r = 0; r < 16; ++r) { const int d0_ = dbase - ((r & 3) + 8 * (r >> 2)); const int d1_ = d0_ - 32;
            const float b0 = lut[d0_ < 0 ? 0 : d0_], b1 = lut[d1_ < 0 ? 0 : d1_];
            p0[r] = (rowsel && d0_ >= 0) ? p0[r] + b0 : -INFINITY; p1[r] = (rowsel && d1_ >= 0) ? p1[r] + b1 : -INFINITY;
            rmax = fmaxf(rmax, fmaxf(p0[r], p1[r])); }
        rmax = fmaxf(rmax, swap32(rmax));
        const float m_new = fmaxf(m_run, rmax);
        const float msafe = (m_new == -INFINITY) ? 0.f : m_new;
        const float alpha = __builtin_amdgcn_exp2f(m_run - msafe);
        m_run = m_new;
        float rs = 0.f;
#pragma unroll
        for (int r = 0; r < 16; ++r) { p0[r] = __builtin_amdgcn_exp2f(p0[r] - msafe); p1[r] = __builtin_amdgcn_exp2f(p1[r] - msafe); rs += p0[r] + p1[r]; }
        l_run = l_run * alpha + rs;
        if (__any(alpha != 1.f)) { if (hi == 0) wsf[r32] = alpha;
#pragma unroll
            for (int r = 0; r < 16; ++r) { const float f = wsf[crow(r, hi)]; o[0][r] *= f; o[1][r] *= f; } }
        u32x4 pw[4];
        pw[0] = (u32x4){cvt_pk(p0[0], p0[1]), cvt_pk(p0[2], p0[3]), cvt_pk(p0[4], p0[5]), cvt_pk(p0[6], p0[7])};
        pw[1] = (u32x4){cvt_pk(p0[8], p0[9]), cvt_pk(p0[10], p0[11]), cvt_pk(p0[12], p0[13]), cvt_pk(p0[14], p0[15])};
        pw[2] = (u32x4){cvt_pk(p1[0], p1[1]), cvt_pk(p1[2], p1[3]), cvt_pk(p1[4], p1[5]), cvt_pk(p1[6], p1[7])};
        pw[3] = (u32x4){cvt_pk(p1[8], p1[9]), cvt_pk(p1[10], p1[11]), cvt_pk(p1[12], p1[13]), cvt_pk(p1[14], p1[15])};
        { const LAS unsigned char* vp = lds + AT_V + bo + ((lane >> 4) & 1) * 32 + (lane & 3) * 8 + (4 * hi + ((lane & 15) >> 2)) * 64;
#pragma unroll
          for (int d0 = 0; d0 < 2; ++d0)
#pragma unroll
              for (int ks = 0; ks < 4; ++ks) { const s16x4 lo = vtr(vp + d0 * 4096 + ks * 1024), hh = vtr(vp + d0 * 4096 + ks * 1024 + 512);
                  const bf16x8 vf = (bf16x8){lo[0], lo[1], lo[2], lo[3], hh[0], hh[1], hh[2], hh[3]};
                  o[d0] = __builtin_amdgcn_mfma_f32_32x32x16_bf16(__builtin_bit_cast(bf16x8, pw[ks]), vf, o[d0], 0, 0, 0); } }
        asm volatile("s_waitcnt vmcnt(0)" ::: "memory"); __syncthreads();
    }
#undef KV0
#undef LOADKV
    l_run += swap32(l_run);
    if (hi == 0) wsf[32 + r32] = 1.f / l_run;
    bf16_t* Ow = WSP(bf16_t, W_Y0) + (rowbase + own * 256 + wid * 32) * 1024 + 512 + h * 64;
    LAS bf16_t* stg = (LAS bf16_t*)(lds + AT_OST) + wid * 2048;
#pragma unroll
    for (int r = 0; r < 16; ++r) { const int orow = crow(r, hi); const float rl = wsf[32 + orow];
        stg[orow * 64 + r32] = (bf16_t)(cvt_pk(o[0][r] * rl, 0.f) & 0xffffu); stg[orow * 64 + 32 + r32] = (bf16_t)(cvt_pk(o[1][r] * rl, 0.f) & 0xffffu); }
#pragma unroll
    for (int i = 0; i < 4; ++i) { const int row = i * 8 + (lane >> 3), ch = lane & 7; const u32x4 v = *(const LAS u32x4*)(stg + row * 64 + ch * 8); *(u32x4*)(Ow + (size_t)row * 1024 + ch * 8) = v; }
    __syncthreads();
}
DEV void p_s5_moba(Frame& F, int mode) {
    if (mode & 1) { for (int it = F.vcu * 2 + (F.wave & 1); it < 512; it += F.G * 2) { if (F.wave < 2) s5_item(F, it >> 5, it & 31, F.lds + 81920 + F.wave * 8192); } }
    __syncthreads();
    if (!(mode & 2)) return;
    for (int v = F.vcu; v < 256; v += F.G) { const int bh = v >> 1, b = bh >> 3, h = bh & 7;
        for (int i = F.tid; i < 2048; i += 512) ((LAS float*)(F.lds + AT_LUT))[i] = WSP(float, W_LUT)[h * 2048 + i];
        __syncthreads();
#pragma unroll 1
        for (int i = 0; i < 4; ++i) { const int own = (((v & 1) ? 0x1256 : 0x0347) >> (4 * i)) & 0xF; moba_unit(F, b, h, own); }
    }
}
constexpr size_t R_RE = W_ROUTE, R_RW = W_ROUTE + 512 * 1024, R_POS = W_ROUTE + 1024 * 1024, R_TOK = W_ROUTE + 2 * MiB, R_WGT = W_ROUTE + 3 * MiB;
constexpr int WT_PITCH = 1028;
constexpr int RW_PITCH = 1032;
constexpr int LN_XT = 32 * RW_PITCH * 2;
constexpr int LN_LG = 147456;
constexpr int LN_HIST = LN_LG + 8 * 528;
static_assert(LN_XT + 8 * 8256 <= LDS_TOK && LN_HIST + 128 <= LDS_BYTES, "LN LDS map");
template <int MODE, bool ROUTER, bool XIN_F32, bool OUT_F32>
DEV void p_ln(Frame& F, const float* xin32, const bf16_t* xinb, bf16_t* xoutb, float* xout32, const float* gam, const float* bet, const float* wrt, const float* brt) {
    LAS bf16_t* whi = (LAS bf16_t*)F.lds; LAS bf16_t* xt = (LAS bf16_t*)(F.lds + LN_XT) + F.wave * 4128; LAS float* lgs = (LAS float*)(F.lds + LN_LG) + F.wave * 132; LAS int* hist = (LAS int*)(F.lds + LN_HIST);
    const int lane = F.lane, l15 = lane & 15, q4 = lane >> 4;
    if constexpr (ROUTER) {
        for (int i = F.tid; i < 1024 * 32; i += 512) { const int k = i >> 5, e = i & 31; whi[e * RW_PITCH + k] = (bf16_t)(cvt_pk(wrt[i], 0.f) & 0xffffu); }
        if (F.tid < 32) hist[F.tid] = 0;
        __syncthreads();
    }
    const bf16_t* MIXB = WSP(bf16_t, W_MIXB); const bf16_t* YS = WSP(bf16_t, W_YS); const int* POS = WSP(int, R_POS);
    int* RE = WSP(int, R_RE); float* RW = WSP(float, R_RW);
    const float alpha = 1.4142135623730951f;
    f32x4 gq[4], bq[4];
#pragma unroll
    for (int j = 0; j < 4; ++j) { gq[j] = *(const f32x4*)(gam + j * 256 + lane * 4); bq[j] = *(const f32x4*)(bet + j * 256 + lane * 4); }
    float bias8[8];
    if constexpr (ROUTER) {
#pragma unroll
        for (int r = 0; r < 8; ++r) bias8[r] = brt[(r >> 2) * 16 + 4 * q4 + (r & 3)]; }
    for (int wgi = F.vcu; wgi < 256; wgi += F.G) {
        const int r0 = wgi * 128 + F.wave * 16;
#pragma unroll 1
        for (int i4 = 0; i4 < 16; i4 += 4) {
            float v[4][16];
#pragma unroll
            for (int u = 0; u < 4; ++u) { const int row = r0 + i4 + u;
                if constexpr (XIN_F32) {
#pragma unroll
                    for (int j = 0; j < 4; ++j) { const f32x4 a = *(const f32x4*)(xin32 + (size_t)row * 1024 + j * 256 + lane * 4); v[u][4 * j] = alpha * a.x; v[u][4 * j + 1] = alpha * a.y; v[u][4 * j + 2] = alpha * a.z; v[u][4 * j + 3] = alpha * a.w; }
                } else {
#pragma unroll
                    for (int j = 0; j < 4; ++j) { const u32x2 a = *(const u32x2*)(xinb + (size_t)row * 1024 + j * 256 + lane * 4); v[u][4 * j] = alpha * bflo(a.x); v[u][4 * j + 1] = alpha * bfhi(a.x); v[u][4 * j + 2] = alpha * bflo(a.y); v[u][4 * j + 3] = alpha * bfhi(a.y); }
                }
                if constexpr (MODE == 0) {
#pragma unroll
                    for (int j = 0; j < 4; ++j) { const u32x2 m = *(const u32x2*)(MIXB + (size_t)row * 1024 + j * 256 + lane * 4); v[u][4 * j] += bflo(m.x); v[u][4 * j + 1] += bfhi(m.x); v[u][4 * j + 2] += bflo(m.y); v[u][4 * j + 3] += bfhi(m.y); }
                } else {
                    const int4 pos4 = *(const int4*)(POS + row * 4);
                    const int ps[4] = {__builtin_amdgcn_readfirstlane(pos4.x), __builtin_amdgcn_readfirstlane(pos4.y), __builtin_amdgcn_readfirstlane(pos4.z), __builtin_amdgcn_readfirstlane(pos4.w)};
#pragma unroll
                    for (int kx = 0; kx < 4; ++kx)
#pragma unroll
                        for (int j = 0; j < 4; ++j) { const u32x2 m = *(const u32x2*)(YS + (size_t)ps[kx] * 1024 + j * 256 + lane * 4); v[u][4 * j] += bflo(m.x); v[u][4 * j + 1] += bfhi(m.x); v[u][4 * j + 2] += bflo(m.y); v[u][4 * j + 3] += bfhi(m.y); }
                }
            }
            float s1[4], s2[4];
#pragma unroll
            for (int u = 0; u < 4; ++u) { s1[u] = 0.f; s2[u] = 0.f;
#pragma unroll
                for (int q = 0; q < 16; ++q) { s1[u] += v[u][q]; s2[u] = fmaf(v[u][q], v[u][q], s2[u]); } }
#pragma unroll
            for (int o = 1; o < 64; o <<= 1) {
#pragma unroll
                for (int u = 0; u < 4; ++u) { s1[u] += __shfl_xor(s1[u], o); s2[u] += __shfl_xor(s2[u], o); } }
#pragma unroll
            for (int u = 0; u < 4; ++u) { const int row = r0 + i4 + u; const float mean = s1[u] * (1.f / 1024.f); const float var = fmaxf(s2[u] * (1.f / 1024.f) - mean * mean, 0.f); const float rstd = 1.f / sqrtf(var + 1e-5f);
#pragma unroll
                for (int j = 0; j < 4; ++j) { const int c = j * 256 + lane * 4; const f32x4 g4 = gq[j], b4 = bq[j];
                    const float y0 = (v[u][4 * j] - mean) * rstd * g4.x + b4.x, y1 = (v[u][4 * j + 1] - mean) * rstd * g4.y + b4.y, y2 = (v[u][4 * j + 2] - mean) * rstd * g4.z + b4.z, y3 = (v[u][4 * j + 3] - mean) * rstd * g4.w + b4.w;
                    if constexpr (OUT_F32) *(f32x4*)(xout32 + (size_t)row * 1024 + c) = (f32x4){y0, y1, y2, y3};
                    else { u32x2 w; w.x = cvt_pk(y0, y1); w.y = cvt_pk(y2, y3); *(u32x2*)(xoutb + (size_t)row * 1024 + c) = w;
                        if constexpr (ROUTER) *(LAS u32x2*)(xt + u * RW_PITCH + c) = w; } } }
            if constexpr (ROUTER) {
                f32x4 acc[2] = {{0.f, 0.f, 0.f, 0.f}, {0.f, 0.f, 0.f, 0.f}};
#pragma unroll 8
                for (int ks = 0; ks < 32; ++ks) { const bf16x8 xb = *(const LAS bf16x8*)(xt + (l15 & 3) * RW_PITCH + ks * 32 + q4 * 8);
#pragma unroll
                    for (int mt = 0; mt < 2; ++mt) { const bf16x8 wa = *(const LAS bf16x8*)(whi + (mt * 16 + l15) * RW_PITCH + ks * 32 + q4 * 8); acc[mt] = __builtin_amdgcn_mfma_f32_16x16x32_bf16(wa, xb, acc[mt], 0, 0, 0); } }
                if (l15 < 4) {
#pragma unroll
                    for (int mt = 0; mt < 2; ++mt)
#pragma unroll
                        for (int r = 0; r < 4; ++r) lgs[l15 * 33 + mt * 16 + 4 * q4 + r] = acc[mt][r] + bias8[mt * 4 + r]; }
                if (lane < 4) { float lg[32];
#pragma unroll
                    for (int e = 0; e < 32; ++e) lg[e] = lgs[lane * 33 + e];
                    unsigned taken = 0u; float tv[4]; int ti[4];
#pragma unroll
                    for (int r = 0; r < 4; ++r) { float best = -INFINITY; int bi = 0;
#pragma unroll
                        for (int e = 0; e < 32; ++e) { const bool ok = !((taken >> e) & 1u) && lg[e] > best; best = ok ? lg[e] : best; bi = ok ? e : bi; }
                        taken |= 1u << bi; tv[r] = best; ti[r] = bi; }
                    float ex[4], sm = 0.f;
#pragma unroll
                    for (int r = 0; r < 4; ++r) { ex[r] = __expf(tv[r] - tv[0]); sm += ex[r]; }
                    const float inv = 1.f / sm; const int row = r0 + i4 + lane;
                    *(int4*)(RE + row * 4) = make_int4(ti[0], ti[1], ti[2], ti[3]); *(f32x4*)(RW + row * 4) = (f32x4){ex[0] * inv, ex[1] * inv, ex[2] * inv, ex[3] * inv};
#pragma unroll
                    for (int r = 0; r < 4; ++r) atomicAdd((int*)(hist + ti[r]), 1); }
            }
        }
        if constexpr (ROUTER) { __syncthreads(); if (F.tid < 32) { WSP(int, W_HIST)[wgi * 32 + F.tid] = hist[F.tid]; hist[F.tid] = 0; } __syncthreads(); }
    }
}

DEV void p_sort(Frame& F) {
    LAS int* Ls = (LAS int*)F.lds; const int tid = F.tid;
    const int* HIST = WSP(int, W_HIST); int* SORT = WSP(int, W_SORT);
    const int* RE = WSP(int, R_RE); const float* RW = WSP(float, R_RW); int* POS = WSP(int, R_POS); int* TOK = WSP(int, R_TOK); float* WGT = WSP(float, R_WGT);
    for (int wgi = F.vcu; wgi < 256; wgi += F.G) {
        { const int e = tid & 31, part = tid >> 5; int tot = 0, pre = 0;
          for (int w = part * 16; w < part * 16 + 16; ++w) { const int hh = HIST[w * 32 + e]; tot += hh; pre += (w < wgi) ? hh : 0; }
          Ls[part * 32 + e] = tot; Ls[512 + part * 32 + e] = pre; }
        Ls[2048 + tid] = RE[wgi * 512 + tid];
        __syncthreads();
        if (tid < 32) { int tot = 0, pre = 0; for (int p = 0; p < 16; ++p) { tot += Ls[p * 32 + tid]; pre += Ls[512 + p * 32 + tid]; } Ls[1200 + tid] = tot; Ls[1300 + tid] = pre; }
        __syncthreads();
        if (tid == 0) { int a = 0; for (int e = 0; e < 32; ++e) { Ls[1024 + e] = a; a += (Ls[1200 + e] + 255) / 256 * 256; } Ls[1056] = a; }
        __syncthreads();
        if (tid < 32) { int c = Ls[1024 + tid] + Ls[1300 + tid]; for (int i = 0; i < 512; ++i) if (Ls[2048 + i] == tid) { Ls[2560 + i] = c; ++c; } }
        __syncthreads();
        { const int pos = Ls[2560 + tid]; TOK[pos] = wgi * 128 + (tid >> 2); WGT[pos] = RW[wgi * 512 + tid]; POS[wgi * 512 + tid] = pos; }
        if (wgi < 32) { const int e = wgi; for (int r = Ls[1024 + e] + Ls[1200 + e] + tid; r < Ls[1024 + e + 1]; r += 512) { TOK[r] = 0; WGT[r] = 0.f; } }
        if (wgi == 0) { if (tid < 33) SORT[tid] = Ls[1024 + tid]; if (tid == 0) SORT[33] = Ls[1056] / 256;
            for (int pm = tid; pm < PMAX / 256; pm += 512) { int e = 0; for (int j = 1; j < 32; ++j) if (pm * 256 >= Ls[1024 + j]) e = j; SORT[64 + pm] = e; } }
        __syncthreads();
    }
}

DEV void p_gr(Frame& F) {
    const int gw = F.vcu * 8 + F.wave, NGW = F.G * 8, lane = F.lane, q4 = lane >> 4; const bf16_t* XB = WSP(bf16_t, W_XB); const bf16_t* Wg = WSP(bf16_t, W_IN1) + (size_t)3072 * 1024; float* GR = WSP(float, W_GR);
    for (int it = gw; it < T / 16; it += NGW) { f32x4 acc = {0.f, 0.f, 0.f, 0.f};
        const bf16_t* ap = XB + (size_t)(it * 16 + (lane & 15)) * 1024 + q4 * 8; const bf16_t* bp = Wg + (size_t)(lane & 15) * 1024 + q4 * 8;
#pragma unroll 8
        for (int ks = 0; ks < 32; ++ks) { const bf16x8 a = *(const bf16x8*)(ap + ks * 32), bb = *(const bf16x8*)(bp + ks * 32); acc = __builtin_amdgcn_mfma_f32_16x16x32_bf16(a, bb, acc, 0, 0, 0); }
#pragma unroll
        for (int r = 0; r < 4; ++r) GR[(size_t)(it * 16 + 4 * q4 + r) * 16 + (lane & 15)] = acc[r]; }
}

constexpr int GP = 272, GP2 = 144;
constexpr int G_QIN = 0, G_KIN = G_QIN + 64 * GP, G_KST = G_KIN + 64 * GP, G_VT = G_KST + 128 * GP2, G_ATT = G_VT + 64 * GP2, G_GRS = G_ATT + 64 * GP2, G_GT = G_GRS + 4096, G_DEC = G_GT + 2048, G_END = G_DEC + 512;
DEV float logsigm_fast(float z) { const float e = __builtin_amdgcn_exp2f(-1.4426950408889634f * fabsf(z)); return fminf(z, 0.f) - 0.6931471805599453f * __builtin_amdgcn_logf(1.f + e); }
DEV void gla_item(Frame& F, int b, int h, int c4) {
    LAS unsigned char* lds = F.lds; const int tid = F.tid, lane = F.lane, wid = F.wave, q4 = lane >> 4, l15 = lane & 15;
    const bf16_t* H1 = WSP(bf16_t, W_HB); const float* GR = WSP(float, W_GR); bf16_t* GO = WSP(bf16_t, W_GLAO); float* SS = WSP(float, W_SS);
    const float* wg2 = F.in[15]; const float* bg = F.in[16];
    for (int i = tid; i < 64 * GP2 / 4; i += 512) ((LAS unsigned*)(lds + G_ATT))[i] = 0u;
    const int dk = tid & 127, tg = tid >> 7;
    float w2[16];
#pragma unroll
    for (int r = 0; r < 16; ++r) w2[r] = wg2[r * 512 + h * 128 + dk];
    const float bgv = bg[h * 128 + dk];
    const int c16 = wid & 3, th = wid >> 2;
    f32x4 sacc[8];
#pragma unroll
    for (int m = 0; m < 8; ++m) sacc[m] = (f32x4){0.f, 0.f, 0.f, 0.f};
    const size_t rb = (size_t)b * 2048;
    for (int n = 0; n < 32; ++n) { const int t0 = n * 64;
        for (int i = tid; i < 1024; i += 512) ((LAS float*)(lds + G_GRS))[i] = GR[(rb + t0) * 16 + i];
        __syncthreads();
        float cs[16]; float run = 0.f;
#pragma unroll
        for (int i = 0; i < 16; ++i) { const LAS float* gr = (const LAS float*)(lds + G_GRS) + (16 * tg + i) * 16; float z = bgv;
#pragma unroll
            for (int r = 0; r < 16; ++r) z = fmaf(gr[r], w2[r], z);
            run += logsigm_fast(z) * (1.f / 16.f); cs[i] = run; }
        ((LAS float*)(lds + G_GT))[tg * 128 + dk] = run;
        __syncthreads();
        float off = 0.f, btot = 0.f;
#pragma unroll
        for (int g2 = 0; g2 < 4; ++g2) { const float gtv = ((LAS float*)(lds + G_GT))[g2 * 128 + dk]; btot += gtv; off += (g2 < tg) ? gtv : 0.f; }
        if (tg == 0) ((LAS float*)(lds + G_DEC))[dk] = __expf(btot);
        { unsigned kst[8];
#pragma unroll
          for (int i = 0; i < 16; i += 2) { float kk[2];
#pragma unroll
              for (int u = 0; u < 2; ++u) { const int t = 16 * tg + i + u; const float bc = cs[i + u] + off;
                  const float qv = bflo((unsigned)H1[(rb + t0 + t) * 3072 + h * 128 + dk]), kv = bflo((unsigned)H1[(rb + t0 + t) * 3072 + 512 + h * 128 + dk]);
                  *(LAS bf16_t*)(lds + G_QIN + t * GP + dk * 2) = (bf16_t)(cvt_pk(qv * __expf(bc), 0.f) & 0xffffu);
                  *(LAS bf16_t*)(lds + G_KIN + t * GP + dk * 2) = (bf16_t)(cvt_pk(kv * __expf(-bc), 0.f) & 0xffffu);
                  kk[u] = kv * __expf(btot - bc); }
              kst[i >> 1] = cvt_pk(kk[0], kk[1]); }
          *(LAS u32x4*)(lds + G_KST + dk * GP2 + tg * 32) = (u32x4){kst[0], kst[1], kst[2], kst[3]};
          *(LAS u32x4*)(lds + G_KST + dk * GP2 + tg * 32 + 16) = (u32x4){kst[4], kst[5], kst[6], kst[7]}; }
        { const int dvl = tid & 63, tq = tid >> 6; unsigned vv[4];
#pragma unroll
          for (int i = 0; i < 8; i += 2) { const unsigned a = H1[(rb + t0 + tq * 8 + i) * 3072 + 1024 + h * 256 + c4 * 64 + dvl], bq = H1[(rb + t0 + tq * 8 + i + 1) * 3072 + 1024 + h * 256 + c4 * 64 + dvl]; vv[i >> 1] = a | (bq << 16); }
          *(LAS u32x4*)(lds + G_VT + dvl * GP2 + tq * 16) = (u32x4){vv[0], vv[1], vv[2], vv[3]}; }
        __syncthreads();
#pragma unroll
        for (int rep = 0; rep < 2; ++rep) { const int ti = wid + 8 * rep; if (ti < 10) {
            int jt, it; if (ti < 4) { jt = 0; it = ti; } else if (ti < 7) { jt = 1; it = ti - 3; } else if (ti < 9) { jt = 2; it = ti - 5; } else { jt = 3; it = 3; }
            f32x4 a4 = {0.f, 0.f, 0.f, 0.f};
#pragma unroll
            for (int ks = 0; ks < 4; ++ks) { const bf16x8 kf = *(const LAS bf16x8*)(lds + G_KIN + (16 * jt + l15) * GP + ks * 64 + q4 * 16), qf = *(const LAS bf16x8*)(lds + G_QIN + (16 * it + l15) * GP + ks * 64 + q4 * 16);
                a4 = __builtin_amdgcn_mfma_f32_16x16x32_bf16(kf, qf, a4, 0, 0, 0); }
            const int i_ = 16 * it + l15, j0 = 16 * jt + 4 * q4;
            u32x2 w; w.x = cvt_pk(j0 <= i_ ? a4[0] : 0.f, j0 + 1 <= i_ ? a4[1] : 0.f); w.y = cvt_pk(j0 + 2 <= i_ ? a4[2] : 0.f, j0 + 3 <= i_ ? a4[3] : 0.f);
            *(LAS u32x2*)(lds + G_ATT + i_ * GP2 + j0 * 2) = w; } }
        __syncthreads();
        bf16x8 vf[2];
#pragma unroll
        for (int ks = 0; ks < 2; ++ks) vf[ks] = *(const LAS bf16x8*)(lds + G_VT + (c16 * 16 + l15) * GP2 + ks * 64 + q4 * 16);
        bf16x8 sf[4];
#pragma unroll
        for (int ks = 0; ks < 4; ++ks) { const u32x4 w = {cvt_pk(sacc[2 * ks][0], sacc[2 * ks][1]), cvt_pk(sacc[2 * ks][2], sacc[2 * ks][3]), cvt_pk(sacc[2 * ks + 1][0], sacc[2 * ks + 1][1]), cvt_pk(sacc[2 * ks + 1][2], sacc[2 * ks + 1][3])}; sf[ks] = __builtin_bit_cast(bf16x8, w); }
#pragma unroll
        for (int mt = 0; mt < 2; ++mt) { const int i_ = 32 * th + 16 * mt + l15; f32x4 oa = {0.f, 0.f, 0.f, 0.f};
#pragma unroll
            for (int ks = 0; ks < 2; ++ks) { if (ks == 1 && th == 0) continue; const bf16x8 af = *(const LAS bf16x8*)(lds + G_ATT + i_ * GP2 + ks * 64 + q4 * 16); oa = __builtin_amdgcn_mfma_f32_16x16x32_bf16(af, vf[ks], oa, 0, 0, 0); }
#pragma unroll
            for (int ks = 0; ks < 4; ++ks) { const u32x2 lo = *(const LAS u32x2*)(lds + G_QIN + i_ * GP + (32 * ks + 4 * q4) * 2), hi2 = *(const LAS u32x2*)(lds + G_QIN + i_ * GP + (32 * ks + 16 + 4 * q4) * 2);
                const u32x4 w = {lo.x, lo.y, hi2.x, hi2.y}; oa = __builtin_amdgcn_mfma_f32_16x16x32_bf16(__builtin_bit_cast(bf16x8, w), sf[ks], oa, 0, 0, 0); }
#pragma unroll
            for (int r = 0; r < 4; ++r) { const size_t trow = rb + t0 + 32 * th + 16 * mt + 4 * q4 + r; GO[trow * 1024 + h * 256 + c4 * 64 + c16 * 16 + l15] = (bf16_t)(cvt_pk(oa[r], 0.f) & 0xffffu);
                float sq = oa[r] * oa[r]; sq += __shfl_xor(sq, 1); sq += __shfl_xor(sq, 2); sq += __shfl_xor(sq, 4); sq += __shfl_xor(sq, 8);
                if (l15 == 0) SS[(trow * 4 + h) * 16 + c4 * 4 + c16] = sq; } }
#pragma unroll
        for (int md = 0; md < 8; ++md) { const f32x4 dc = *(const LAS f32x4*)(lds + G_DEC + (16 * md + 4 * q4) * 4); sacc[md] = sacc[md] * dc;
#pragma unroll
            for (int ks = 0; ks < 2; ++ks) { const bf16x8 kf = *(const LAS bf16x8*)(lds + G_KST + (16 * md + l15) * GP2 + ks * 64 + q4 * 16); sacc[md] = __builtin_amdgcn_mfma_f32_16x16x32_bf16(kf, vf[ks], sacc[md], 0, 0, 0); } }
        __syncthreads();
    }
}
DEV void p_gla(Frame& F) { for (int v = F.vcu; v < 256; v += F.G) gla_item(F, v >> 4, (v >> 2) & 3, v & 3); }

DEV void p_gla_norm(Frame& F) {
    const int gw = F.vcu * 8 + F.wave, NGW = F.G * 8, lane = F.lane; const bf16_t* GO = WSP(bf16_t, W_GLAO); const float* SS = WSP(float, W_SS); const bf16_t* H1 = WSP(bf16_t, W_HB); bf16_t* Y0 = WSP(bf16_t, W_Y0);
    const f32x4 nw = *(const f32x4*)(F.in[17] + lane * 4);
    for (int row = gw; row < T; row += NGW) {
#pragma unroll
        for (int h = 0; h < 4; ++h) { const float* sp = SS + ((size_t)row * 4 + h) * 16; const f32x4 a = *(const f32x4*)sp, b2 = *(const f32x4*)(sp + 4), c = *(const f32x4*)(sp + 8), d = *(const f32x4*)(sp + 12);
            const float sq = (a.x + a.y + a.z + a.w) + (b2.x + b2.y + b2.z + b2.w) + (c.x + c.y + c.z + c.w) + (d.x + d.y + d.z + d.w); const float r = 1.f / sqrtf(sq * (1.f / 256.f) + 1e-5f);
            const u32x2 o = *(const u32x2*)(GO + (size_t)row * 1024 + h * 256 + lane * 4); const u32x2 g = *(const u32x2*)(H1 + (size_t)row * 3072 + 2048 + h * 256 + lane * 4);
            const float g0 = bflo(g.x), g1 = bfhi(g.x), g2 = bflo(g.y), g3 = bfhi(g.y);
            u32x2 w; w.x = cvt_pk(bflo(o.x) * r * nw.x * g0 * fast_sigm(g0), bfhi(o.x) * r * nw.y * g1 * fast_sigm(g1)); w.y = cvt_pk(bflo(o.y) * r * nw.z * g2 * fast_sigm(g2), bfhi(o.y) * r * nw.w * g3 * fast_sigm(g3));
            *(u32x2*)(Y0 + (size_t)row * 1024 + h * 256 + lane * 4) = w; } }
}
struct FStoreScale { bf16_t* O; int ldc, c_lo, c_hi; float sc;
    DEV void operator()(const Unit&, int row, int col, f32x4 v0, f32x4 v1) const { const float s = (col >= c_lo && col < c_hi) ? sc : 1.f;
        const u32x4 w = {cvt_pk(v0[0] * s, v0[1] * s), cvt_pk(v0[2] * s, v0[3] * s), cvt_pk(v1[0] * s, v1[1] * s), cvt_pk(v1[2] * s, v1[3] * s)}; *(u32x4*)(O + (size_t)row * ldc + col) = w; } };
struct FGlu { const bf16_t* Y; bf16_t* O; const float* b;
    DEV void operator()(const Unit&, int row, int col, f32x4 v0, f32x4 v1) const { const u32x4 y = *(const u32x4*)(Y + (size_t)row * 512 + col); const f32x4 b0 = *(const f32x4*)(b + col), b1 = *(const f32x4*)(b + col + 4);
        const u32x4 w = {cvt_pk(bflo(y.x) * fast_sigm(v0[0] + b0.x), bfhi(y.x) * fast_sigm(v0[1] + b0.y)), cvt_pk(bflo(y.y) * fast_sigm(v0[2] + b0.z), bfhi(y.y) * fast_sigm(v0[3] + b0.w)),
                         cvt_pk(bflo(y.z) * fast_sigm(v1[0] + b1.x), bfhi(y.z) * fast_sigm(v1[1] + b1.y)), cvt_pk(bflo(y.w) * fast_sigm(v1[2] + b1.z), bfhi(y.w) * fast_sigm(v1[3] + b1.w))};
        *(u32x4*)(O + (size_t)row * 1024 + col) = w; } };
DEV float swiglu1(float g, float u) { g = fminf(g, 7.f); u = fminf(fmaxf(u, -7.f), 7.f); return g * fast_sigm(1.702f * g) * (u + 1.f); }
struct FSwiglu { bf16_t* ACT; const float* bgu;
    DEV void operator()(const Unit& u, int row, int col, f32x4 v0, f32x4 v1) const { const float* bp = bgu + (size_t)u.e * 2048 + col; const f32x4 b0 = *(const f32x4*)bp, b1 = *(const f32x4*)(bp + 4);
        u32x2 w; w.x = cvt_pk(swiglu1(v0[0] + b0.x, v0[1] + b0.y), swiglu1(v0[2] + b0.z, v0[3] + b0.w)); w.y = cvt_pk(swiglu1(v1[0] + b1.x, v1[1] + b1.y), swiglu1(v1[2] + b1.z, v1[3] + b1.w));
        *(u32x2*)(ACT + (size_t)row * 1024 + (col >> 1)) = w; } };
struct FDown { bf16_t* YS; const float* bd; const float* wgt;
    DEV void operator()(const Unit& u, int row, int col, f32x4 v0, f32x4 v1) const { const float* bp = bd + (size_t)u.e * 1024 + col; const f32x4 b0 = *(const f32x4*)bp, b1 = *(const f32x4*)(bp + 4); const float wt = wgt[row];
        const u32x4 w = {cvt_pk((v0[0] + b0.x) * wt, (v0[1] + b0.y) * wt), cvt_pk((v0[2] + b0.z) * wt, (v0[3] + b0.w) * wt), cvt_pk((v1[0] + b1.x) * wt, (v1[1] + b1.y) * wt), cvt_pk((v1[2] + b1.z) * wt, (v1[3] + b1.w) * wt)};
        *(u32x4*)(YS + (size_t)row * 1024 + col) = w; } };

constexpr int NPH = 20;
constexpr float QSCALE0 = 0.125f * 1.4426950408889634f, QSCALE1 = 0.08838834764831845f;


#define NOINL __device__ __forceinline__
struct PA { const float* const* in; unsigned char* ws; float* out; };
#define MKFRAME extern __shared__ __attribute__((aligned(16))) unsigned char lds_[]; Frame F; F.lds = (LAS unsigned char*)lds_; F.tid = threadIdx.x; asm volatile("" : "+v"(F.tid)); F.lane = F.tid & 63; F.wave = __builtin_amdgcn_readfirstlane(F.tid >> 6); \
    F.G = gridDim.x; { const int bx = blockIdx.x; F.vcu = (F.G % 8 == 0) ? (bx % 8) * (F.G / 8) + bx / 8 : bx; } F.in = pa.in; F.ws = pa.ws;
template <class Fn> DEV void dense_gemm(Frame& F, const bf16_t* A, const bf16_t* Bt, int nM, int nN, int K, const Fn& fn) {
    Gemm g; g.A = A; g.Bt = Bt; g.rowmap = nullptr; g.bstride = 0; g.K = K;
    StaticOrder S; S.init(nM, nN, F.G, (int)blockIdx.x, nullptr);
    EpiRow8<Fn> E{fn};
    gemm_phase<false>(F.lds, g, S, E);
}
NOINL void ph_prologue(PA pa) { MKFRAME p0_prologue(F); }
NOINL void ph_in0(PA pa) { MKFRAME dense_gemm(F, WSP(bf16_t, W_XB), WSP(bf16_t, W_IN0), T / 256, 8, 1024, FStoreScale{WSP(bf16_t, W_HB), 2048, 512, 1024, QSCALE0}); }
NOINL void ph_kmean(PA pa) { MKFRAME p_kmean(F); }
NOINL void ph_s5moba(PA pa, int mode) { MKFRAME p_s5_moba(F, mode); }
NOINL void ph_glu(PA pa) { MKFRAME dense_gemm(F, WSP(bf16_t, W_YS5), WSP(bf16_t, W_GLU), T / 256, 2, 512, FGlu{WSP(bf16_t, W_YS5), WSP(bf16_t, W_Y0), F.in[11]}); }
NOINL void ph_out(PA pa, int layer) { MKFRAME dense_gemm(F, WSP(bf16_t, W_Y0), layer ? WSP(bf16_t, W_OUT1) : WSP(bf16_t, W_OUT0), T / 256, 4, 1024, FStoreScale{WSP(bf16_t, W_MIXB), 1024, 0, 0, 1.f}); }
NOINL void ph_in1(PA pa) { MKFRAME dense_gemm(F, WSP(bf16_t, W_XB), WSP(bf16_t, W_IN1), T / 256, 12, 1024, FStoreScale{WSP(bf16_t, W_HB), 3072, 0, 512, QSCALE1}); p_gr(F); }
NOINL void ph_gla(PA pa) { MKFRAME p_gla(F); }
NOINL void ph_glanorm(PA pa) { MKFRAME p_gla_norm(F); }
NOINL void ph_lnrouter(PA pa, int layer) { MKFRAME
    if (layer == 0) p_ln<0, true, true, false>(F, F.in[0], nullptr, WSP(bf16_t, W_XBB), nullptr, F.in[19], F.in[20], F.in[23], F.in[24]);
    else p_ln<0, true, false, false>(F, nullptr, WSP(bf16_t, W_XB), WSP(bf16_t, W_XBB), nullptr, F.in[19] + 1024, F.in[20] + 1024, F.in[23] + (size_t)1024 * 32, F.in[24] + 32); }
NOINL void ph_sort(PA pa) { MKFRAME p_sort(F); }
NOINL void ph_gateup(PA pa, int layer) { MKFRAME const int* SORT = WSP(int, W_SORT);
    Gemm g; g.A = WSP(bf16_t, W_XBB); g.Bt = WSP(bf16_t, W_GU) + (size_t)layer * 32 * 2048 * 1024; g.rowmap = WSP(int, R_TOK); g.bstride = (size_t)2048 * 1024; g.K = 1024;
    StaticOrder S; S.init(__builtin_amdgcn_readfirstlane(SORT[33]), 8, F.G, (int)blockIdx.x, SORT + 64);
    EpiRow8<FSwiglu> E{FSwiglu{WSP(bf16_t, W_ACT), F.in[26] + (size_t)layer * 32 * 2048}};
    gemm_phase<true>(F.lds, g, S, E); }
NOINL void ph_down(PA pa, int layer) { MKFRAME const int* SORT = WSP(int, W_SORT);
    Gemm g; g.A = WSP(bf16_t, W_ACT); g.Bt = WSP(bf16_t, W_DN) + (size_t)layer * 32 * 1024 * 1024; g.rowmap = nullptr; g.bstride = (size_t)1024 * 1024; g.K = 1024;
    StaticOrder S; S.init(__builtin_amdgcn_readfirstlane(SORT[33]), 4, F.G, (int)blockIdx.x, SORT + 64);
    EpiRow8<FDown> E{FDown{WSP(bf16_t, W_YS), F.in[28] + (size_t)layer * 32 * 1024, WSP(float, R_WGT)}};
    gemm_phase<false>(F.lds, g, S, E); }
NOINL void ph_combine(PA pa, int layer) { MKFRAME
    if (layer == 0) p_ln<1, false, false, false>(F, nullptr, WSP(bf16_t, W_XBB), WSP(bf16_t, W_XB), nullptr, F.in[21], F.in[22], nullptr, nullptr);
    else p_ln<1, false, false, true>(F, nullptr, WSP(bf16_t, W_XBB), nullptr, pa.out, F.in[21] + 1024, F.in[22] + 1024, nullptr, nullptr); }

__global__ void __launch_bounds__(512, 2) mega(Args args) {
    extern __shared__ __attribute__((aligned(16))) unsigned char lds_[];
    LAS unsigned char* lds = (LAS unsigned char*)lds_;
    unsigned* ctl = (unsigned*)(args.ws + W_CTL);
    for (int u = threadIdx.x; u < (LDS_BYTES - LDSCTL_OFF) / 4; u += 512) ((LAS unsigned*)(lds + LDSCTL_OFF))[u] = 0u;
    __syncthreads();
    const int lo = args.ph_lo, hi = args.ph_hi;
    XcdBarrier bar; bar.bar = ctl + CW_BAR; bar.x = 0; bar.st = nullptr;
    if (hi - lo > 1) bar = xcd_barrier_post(ctl + CW_BAR, (volatile LAS unsigned*)(lds + MISC_OFF) + 8);
    PA pa; pa.in = args.in; pa.ws = args.ws; pa.out = args.out;
#define IN(k) (lo <= (k) && (k) < hi)
#ifdef DIAG_LO
    volatile LAS unsigned long long* tsl = (volatile LAS unsigned long long*)(lds + MISC_OFF + 128);
    if (blockIdx.x == 0 && threadIdx.x == 0) tsl[0] = __builtin_amdgcn_s_memrealtime();
#define STAMP(k) do { if (blockIdx.x == 0 && threadIdx.x == 0) tsl[(k) + 1] = __builtin_amdgcn_s_memrealtime(); } while (0)
#else
#define STAMP(k) do { } while (0)
#endif
#define SEAM(k) do { if (IN(k) && IN((k) + 1)) xcd_barrier(bar); STAMP(k); } while (0)
#ifndef REP_PHASE
#define REP_PHASE -1
#define REP_N 0
#endif
#define RUN(k, call) do { if (IN(k)) { const int nrep_ = ((k) == REP_PHASE) ? 1 + REP_N : 1; for (int r_ = 0; r_ < nrep_; ++r_) { call; if (r_ + 1 < nrep_) xcd_barrier(bar); } } } while (0)
    RUN(0, ph_prologue(pa)); SEAM(0);
    RUN(1, ph_in0(pa)); SEAM(1);
    RUN(2, ph_kmean(pa)); SEAM(2);
    if (IN(3)) { const int n30 = (REP_PHASE == 30) ? 1 + REP_N : 1, n31 = (REP_PHASE == 31) ? 1 + REP_N : 1;
        for (int r_ = 0; r_ < n30; ++r_) ph_s5moba(pa, 1);
        for (int r_ = 0; r_ < n31; ++r_) ph_s5moba(pa, 2); } SEAM(3);
    RUN(4, ph_glu(pa)); SEAM(4);
    RUN(5, ph_out(pa, 0)); SEAM(5);
#pragma unroll 1
    for (int layer = 0; layer < 2; ++layer) {
        const int pb = layer ? 15 : 6;
        if (layer == 1) {
            RUN(11, ph_in1(pa)); SEAM(11);
            RUN(12, ph_gla(pa)); SEAM(12);
            RUN(13, ph_glanorm(pa)); SEAM(13);
            RUN(14, ph_out(pa, 1)); SEAM(14);
        }
        RUN(pb, ph_lnrouter(pa, layer)); SEAM(pb);
        RUN(pb + 1, ph_sort(pa)); SEAM(pb + 1);
        RUN(pb + 2, ph_gateup(pa, layer)); SEAM(pb + 2);
        RUN(pb + 3, ph_down(pa, layer)); SEAM(pb + 3);
        if (layer == 0) { RUN(10, ph_combine(pa, 0)); SEAM(10); }
        else { RUN(19, ph_combine(pa, 1)); }
    }
#ifdef DIAG_LO
    xcd_barrier(bar); STAMP(19);
    if (blockIdx.x == 0 && threadIdx.x == 0) { const unsigned long long dtk = tsl[DIAG_HI + 1] - tsl[DIAG_LO]; const float f = (float)dtk * (0.01f / 10000.f); __hip_atomic_store(ctl + 8, __float_as_uint(f), __ATOMIC_RELAXED, __HIP_MEMORY_SCOPE_AGENT); }
    xcd_barrier(bar);
    { const float f = __uint_as_float(__hip_atomic_load(ctl + 8, __ATOMIC_RELAXED, __HIP_MEMORY_SCOPE_AGENT));
      for (size_t i = (size_t)blockIdx.x * 512 + threadIdx.x; i < (size_t)T * 1024; i += (size_t)gridDim.x * 512) args.out[i] *= (1.f + f); }
#endif
#undef IN
#undef SEAM
}

static int g_grid = 0;
static bool launch_setup(size_t ws_size) {
    if (g_grid == 0) {
        if (ws_size < W_END) { fprintf(stderr, "kernel_launch: workspace too small: %zu < %zu\n", ws_size, (size_t)W_END); g_grid = -1; return false; }
        int dev = 0, cus = 0, per_cu = 0;
        if (hipGetDevice(&dev) != hipSuccess || hipDeviceGetAttribute(&cus, hipDeviceAttributeMultiprocessorCount, dev) != hipSuccess) { g_grid = -1; return false; }
        if (hipFuncSetAttribute((const void*)mega, hipFuncAttributeMaxDynamicSharedMemorySize, LDS_BYTES) != hipSuccess) { fprintf(stderr, "kernel_launch: hipFuncSetAttribute failed\n"); g_grid = -1; return false; }
        if (hipOccupancyMaxActiveBlocksPerMultiprocessor(&per_cu, (const void*)mega, 512, LDS_BYTES) != hipSuccess || per_cu < 1) fprintf(stderr, "kernel_launch: occupancy query reports %d blocks/CU\n", per_cu);
        (void)hipGetLastError();
        g_grid = cus;
    }
    return g_grid > 0;
}
static void launch_phases(hipStream_t stream, void* const* d_in, void* d_out, void* d_ws, int lo, int hi) {
    Args a; memset(&a, 0, sizeof a);
    for (int i = 0; i < 29; ++i) a.in[i] = (const float*)d_in[i];
    a.out = (float*)d_out; a.ws = (unsigned char*)d_ws; a.ph_lo = lo; a.ph_hi = hi;
    hipLaunchKernelGGL(mega, dim3(g_grid), dim3(512), LDS_BYTES, stream, a);
}
}
extern "C" void kernel_launch(void* const* d_in, const int* in_sizes, int n_in, void* d_out, int out_size, void* d_ws, size_t ws_size, hipStream_t stream) {
    if (n_in != 29 || out_size != T * D) { fprintf(stderr, "kernel_launch: unexpected arguments (n_in %d, out_size %d)\n", n_in, out_size); return; }
    if (!fk::launch_setup(ws_size)) return;
    (void)hipMemsetAsync((char*)d_ws + fk::W_CTL, 0, fk::CTL_ZERO_BYTES, stream);
    fk::launch_phases(stream, d_in, d_out, d_ws, 0, fk::NPH);
}
```

```cpp
#include <hip/hip_runtime.h>
#include <cstdio>
#include <cstdint>
#include <cmath>
#include <cstring>
#define DEV __device__ __forceinline__
constexpr int Bn = 16, L = 2048, D = 1024, T = Bn * L;
namespace fk {
#define LAS __attribute__((address_space(3)))
#define GAS __attribute__((address_space(1)))
typedef unsigned short bf16_t;
typedef short bf16x8 __attribute__((ext_vector_type(8)));
typedef short s16x4 __attribute__((ext_vector_type(4)));
typedef float f32x2 __attribute__((ext_vector_type(2)));
typedef float f32x4 __attribute__((ext_vector_type(4)));
typedef float f32x16 __attribute__((ext_vector_type(16)));
typedef unsigned u32x2 __attribute__((ext_vector_type(2)));
typedef unsigned u32x4 __attribute__((ext_vector_type(4)));
typedef __bf16 bf16x2_t __attribute__((ext_vector_type(2)));
struct u32x4x2 { u32x4 a, b; };
DEV unsigned cvt_pk(float lo, float hi) { f32x2 v = {lo, hi}; bf16x2_t b = __builtin_convertvector(v, bf16x2_t); return __builtin_bit_cast(unsigned, b); }
DEV float bflo(unsigned w) { return __uint_as_float(w << 16); }
DEV float bfhi(unsigned w) { return __uint_as_float(w & 0xffff0000u); }
DEV float fast_sigm(float x) { return __builtin_amdgcn_rcpf(1.f + __builtin_amdgcn_exp2f(-1.4426950408889634f * x)); }
DEV float gelu_tanh(float x) { const float u = 0.7978845608028654f * (x + 0.044715f * x * x * x); return x * fast_sigm(2.f * u); }
DEV float wave_sum(float v) {
#pragma unroll
    for (int o = 1; o < 64; o <<= 1) v += __shfl_xor(v, o);
    return v; }
DEV float swap32(float x) { auto rr = __builtin_amdgcn_permlane32_swap(__float_as_uint(x), __float_as_uint(x), false, false); return __uint_as_float((__builtin_amdgcn_mbcnt_lo(~0u, 0u) >> 5) ? rr[0] : rr[1]); }

constexpr int BM = 256, BK = 64, HALF = 128, HTB = HALF * BK * 2, STAGE_BYTES = 8 * HTB, NXCD = 8, WGM = 8;
constexpr int LDS_TOK = 135168 - 2048;
constexpr int LDSCTL_OFF = 135168, MISC_OFF = LDSCTL_OFF + 320, LDS_BYTES = 163840;

DEV int lds_byte(int r, int c) { const int st = (r >> 4) * 2 + (c >> 5), rr = r & 15, cc = c & 31, ob = rr * 64 + cc * 2; return st * 1024 + (ob ^ (((ob >> 9) & 1) << 5)); }
DEV void stage_rc(int b, int& R, int& C) { const int st = b / 1024, sb = b % 1024, swz = sb ^ (((sb >> 9) & 1) << 5); R = (st >> 1) * 16 + swz / 64; C = (st & 1) * 32 + (swz % 64) / 2; }
DEV int perm32(int rho) { const int n = rho >> 4, i = rho & 15; return 8 * (i >> 2) + 4 * n + (i & 3); }

struct Unit { int pm, pn, e; };
struct Gemm { const void* A; const void* Bt; const int* rowmap; size_t bstride; int KB; int wave; };

struct StaticOrder {
    int nM, nN, nwg, G, c; const int* tile_e;
    DEV void init(int nM_, int nN_, int G_, int c_, const int* te) { nM = nM_; nN = nN_; nwg = nM * nN; G = G_; c = c_; tile_e = te; }
    DEV bool next(int i, Unit& u) const {
        const long Lx = (long)i * G + c; if (Lx >= nwg) return false;
        int wgid = (int)Lx; { const int q = nwg / NXCD, r = nwg % NXCD, xcd = wgid % NXCD, off = wgid / NXCD; wgid = (xcd < r ? xcd * (q + 1) : r * (q + 1) + (xcd - r) * q) + off; }
        const int nig = WGM * nN, gid = wgid / nig, fm = gid * WGM, gsz = (nM - fm) < WGM ? (nM - fm) : WGM;
        u.pm = fm + ((wgid % nig) % gsz); u.pn = (wgid % nig) / gsz; u.e = tile_e ? __builtin_amdgcn_readfirstlane(tile_e[u.pm]) : 0; return true;
    }
};

template <class F> struct EpiRow8 {
    static constexpr bool PERM = true; F f;
    DEV void operator()(const f32x4 (&acc)[2][2][4][2], const Unit& u, int wr, int wc, int fr, int fq) const {
        { const int ln_ = (int)__builtin_amdgcn_mbcnt_hi(~0u, __builtin_amdgcn_mbcnt_lo(~0u, 0u)); fr = ln_ & 15; fq = ln_ >> 4; }
#pragma unroll
        for (int ai = 0; ai < 2; ++ai)
#pragma unroll
            for (int m = 0; m < 4; ++m) { const int row = u.pm * BM + ai * HALF + wr * 64 + m * 16 + fr;
#pragma unroll
                for (int bj = 0; bj < 2; ++bj) f(u, row, u.pn * BM + bj * HALF + wc * 32 + 8 * fq, acc[ai][bj][m][0], acc[ai][bj][m][1]); }
    }
};

typedef int v8i_t __attribute__((ext_vector_type(8)));
typedef int v4i_t __attribute__((ext_vector_type(4)));
template <bool GATHER, bool FP8, class Epi, class Sched>
DEV void gemm_phase(LAS unsigned char* lds, const Gemm g, const Sched& S, const Epi& E) {
    const int wid = g.wave, lane = (int)__builtin_amdgcn_mbcnt_hi(~0u, __builtin_amdgcn_mbcnt_lo(~0u, 0u)), tid = wid * 64 + lane, wr = wid >> 2, wc = wid & 3, fr = lane & 15, fq = lane >> 4;
    float z0 = 0.f; asm volatile("" : "+v"(z0));
    const int KB = g.KB, nt = KB / 128;
    int R0, C2; { int C; stage_rc(tid * 16, R0, C); C2 = C * 2; }
    unsigned voffB[2]; { const int Rb = Epi::PERM ? ((R0 & ~31) + perm32(R0 & 31)) : R0; voffB[0] = (unsigned)(Rb * KB + C2); voffB[1] = voffB[0] + 64u * (unsigned)KB; }
    const unsigned kstep = 128u, hstep = (unsigned)HALF * KB, tstep = 2u * hstep;
    const unsigned ldsw = (unsigned)wid * 1024u;
    const int aoff = lds_byte(wr * 64 + fr, fq * 8); int boff = lds_byte(wc * 32 + fr, fq * 8) + 4 * HTB; asm volatile("" : "+v"(boff));
    LAS int* tokb = (LAS int*)(lds + LDS_TOK);
    const auto rsA = __builtin_amdgcn_make_buffer_rsrc((void*)g.A, 0, 0x7fffffff, 0x00020000);
    const auto rsB = __builtin_amdgcn_make_buffer_rsrc((void*)g.Bt, 0, 0x7fffffff, 0x00020000);
    const auto rsT = __builtin_amdgcn_make_buffer_rsrc((void*)(GATHER ? (const void*)g.rowmap : g.A), 0, 0x7fffffff, 0x00020000);
#define PG8_SA(b, h) (((b) * 2 + (h)) * HTB)
#define PG8_SB(b, h) ((4 + (b) * 2 + (h)) * HTB)
#define PG8_STAGE(bufoff, rs, soff, voff) do { _Pragma("unroll") for (int _i = 0; _i < 2; ++_i) { \
        if constexpr (GATHER) __builtin_amdgcn_raw_ptr_buffer_load_lds(rs, (LAS void*)(lds + (bufoff) + ldsw + _i * 8192), 16, (int)(voff)[_i], (int)(soff), 0, 0); \
        else __builtin_amdgcn_raw_ptr_buffer_load_lds(rs, (LAS void*)(lds + (bufoff) + ldsw + _i * 8192), 16, (int)(voff)[0], (int)((soff) + _i * 64u * (unsigned)KB), 0, 0); } } while (0)
#define PG8_LDA(dst, b, h) do { _Pragma("unroll") for (int m = 0; m < 4; ++m) _Pragma("unroll") for (int k = 0; k < 2; ++k) dst[m][k] = *(const LAS bf16x8*)(lds + PG8_SA(b, h) + aoff + m * 2048 + k * 1024); } while (0)
#define PG8_LDB(dst, b, h) do { _Pragma("unroll") for (int n = 0; n < 2; ++n) _Pragma("unroll") for (int k = 0; k < 2; ++k) dst[n][k] = *(const LAS bf16x8*)(lds + boff + (PG8_SB(b, h) - 4 * HTB) + n * 2048 + k * 1024); } while (0)
#define PG8_CAT(x) __builtin_shufflevector(__builtin_bit_cast(v4i_t, x[0]), __builtin_bit_cast(v4i_t, x[1]), 0, 1, 2, 3, 4, 5, 6, 7)
#define PG8_MMA(ai, bj, At, Bt) do { __builtin_amdgcn_s_setprio(1); _Pragma("unroll") for (int m = 0; m < 4; ++m) _Pragma("unroll") for (int n = 0; n < 2; ++n) { \
        if constexpr (FP8) acc[ai][bj][m][n] = __builtin_amdgcn_mfma_scale_f32_16x16x128_f8f6f4(PG8_CAT(Bt[n]), PG8_CAT(At[m]), acc[ai][bj][m][n], 0, 0, 0, 0, 0, 0); \
        else { _Pragma("unroll") for (int k = 0; k < 2; ++k) acc[ai][bj][m][n] = __builtin_amdgcn_mfma_f32_16x16x32_bf16(Bt[n][k], At[m][k], acc[ai][bj][m][n], 0, 0, 0); } } __builtin_amdgcn_s_setprio(0); } while (0)
#define PG8_WAIT_V(n) asm volatile("s_waitcnt vmcnt(" #n ")" ::: "memory")
#define PG8_WAIT_L(n) asm volatile("s_waitcnt lgkmcnt(" #n ")" ::: "memory")
#define PG8_BAR __builtin_amdgcn_s_barrier()
#define PG8_SCHED __builtin_amdgcn_sched_barrier(0)
    Unit cur, nxt; int ui = 0;
    if (!S.next(0, cur)) return;
    f32x4 acc[2][2][4][2];
#pragma unroll
    for (int a = 0; a < 2; ++a)
#pragma unroll
        for (int b = 0; b < 2; ++b)
#pragma unroll
            for (int m = 0; m < 4; ++m)
#pragma unroll
                for (int n = 0; n < 2; ++n) acc[a][b][m][n] = (f32x4){z0, z0, z0, z0};
    bf16x8 At[4][2], B0[2][2], B1[2][2];
    unsigned cA, cB = (unsigned)cur.e * (unsigned)g.bstride + (unsigned)cur.pn * tstep;
    unsigned voffA[2]; voffA[0] = (unsigned)(R0 * KB + C2); voffA[1] = voffA[0] + 64u * (unsigned)KB;
    if constexpr (GATHER) { cA = 0u;
        if (wid < 4) __builtin_amdgcn_raw_ptr_buffer_load_lds(rsT, (LAS void*)(tokb + wid * 64), 4, (wid * 64 + lane) * 4, cur.pm * (BM * 4), 0, 0);
        asm volatile("s_waitcnt vmcnt(0)" ::: "memory"); __builtin_amdgcn_s_barrier();
    } else cA = (unsigned)cur.pm * tstep;
    const unsigned hA = GATHER ? 0u : hstep;
#define PG8_OA(dst, sel, h) unsigned dst[2]; if constexpr (GATHER) { dst[0] = (unsigned)(tokb[(sel) * 256 + (h) * HALF + R0] * KB + C2); dst[1] = (unsigned)(tokb[(sel) * 256 + (h) * HALF + R0 + 64] * KB + C2); } else { dst[0] = voffA[0]; dst[1] = voffA[1]; }
    { PG8_OA(p0_, 0, 0); PG8_OA(p1_, 0, 1); PG8_STAGE(PG8_SB(0, 0), rsB, cB, voffB); PG8_STAGE(PG8_SB(0, 1), rsB, cB + hstep, voffB); PG8_STAGE(PG8_SA(0, 0), rsA, cA, p0_); PG8_STAGE(PG8_SA(0, 1), rsA, cA + hA, p1_); }
    if (wr == 1) PG8_BAR;
    PG8_WAIT_V(2); PG8_BAR;
    { PG8_OA(p0_, 0, 0); PG8_STAGE(PG8_SB(1, 0), rsB, cB + kstep, voffB); PG8_STAGE(PG8_SA(1, 0), rsA, cA + kstep, p0_); PG8_STAGE(PG8_SB(1, 1), rsB, cB + hstep + kstep, voffB); }
    PG8_WAIT_V(6); PG8_BAR;
    for (;;) {
        const bool has_next = S.next(ui + 1, nxt);
        unsigned nA = cA, nB = cB;
        if (has_next) { nB = (unsigned)nxt.e * (unsigned)g.bstride + (unsigned)nxt.pn * tstep;
            if constexpr (GATHER) { if (wid < 4) { const int ln_ = (int)__builtin_amdgcn_mbcnt_hi(~0u, __builtin_amdgcn_mbcnt_lo(~0u, 0u)); __builtin_amdgcn_raw_ptr_buffer_load_lds(rsT, (LAS void*)(tokb + ((ui + 1) & 1) * 256 + wid * 64), 4, (wid * 64 + ln_) * 4, nxt.pm * (BM * 4), 0, 0); } }
            else nA = (unsigned)nxt.pm * tstep; }
#pragma unroll 1
        for (int t = 0; t < nt; t += 2) {
            const bool last = (t == nt - 2);
            const unsigned a1 = cA + (unsigned)(t + 1) * kstep;
            const unsigned a2 = last ? nA : cA + (unsigned)(t + 2) * kstep, b2 = last ? nB : cB + (unsigned)(t + 2) * kstep;
            const unsigned a3 = a2 + kstep, b3 = b2 + kstep;
            const int selc = ui & 1, seln = (last && has_next) ? ((ui + 1) & 1) : selc;
            PG8_LDB(B0, 0, 0); PG8_LDB(B1, 0, 1); PG8_SCHED; PG8_LDA(At, 0, 0); { PG8_OA(q_, selc, 1); PG8_STAGE(PG8_SA(1, 1), rsA, a1 + hA, q_); }
            PG8_WAIT_V(8); PG8_WAIT_L(0); PG8_BAR; PG8_MMA(0, 0, At, B0); PG8_MMA(0, 1, At, B1); PG8_BAR; PG8_SCHED;
            PG8_LDA(At, 0, 1); PG8_STAGE(PG8_SB(0, 0), rsB, b2, voffB); PG8_STAGE(PG8_SB(0, 1), rsB, b2 + hstep, voffB); { PG8_OA(q_, seln, 0); PG8_STAGE(PG8_SA(0, 0), rsA, a2, q_); }
            PG8_WAIT_V(8); PG8_WAIT_L(0); PG8_BAR; PG8_MMA(1, 0, At, B0); PG8_MMA(1, 1, At, B1); PG8_BAR; PG8_SCHED;
            PG8_LDB(B0, 1, 0); PG8_LDB(B1, 1, 1); PG8_SCHED; PG8_LDA(At, 1, 0); { PG8_OA(q_, seln, 1); PG8_STAGE(PG8_SA(0, 1), rsA, a2 + hA, q_); }
            PG8_WAIT_V(8); PG8_WAIT_L(0); PG8_BAR; PG8_MMA(0, 0, At, B0); PG8_MMA(0, 1, At, B1); PG8_BAR; PG8_SCHED;
            PG8_LDA(At, 1, 1); PG8_STAGE(PG8_SB(1, 0), rsB, b3, voffB); PG8_STAGE(PG8_SB(1, 1), rsB, b3 + hstep, voffB); { PG8_OA(q_, seln, 0); PG8_STAGE(PG8_SA(1, 0), rsA, a3, q_); }
            PG8_WAIT_V(8); PG8_WAIT_L(0); PG8_BAR; PG8_MMA(1, 0, At, B0); PG8_MMA(1, 1, At, B1); PG8_BAR; PG8_SCHED;
        }
        if (wr == 0) PG8_BAR;
        E(acc, cur, wr, wc, fr, fq);
        if (!has_next) break;
#pragma unroll
        for (int a = 0; a < 2; ++a)
#pragma unroll
            for (int b = 0; b < 2; ++b)
#pragma unroll
                for (int m = 0; m < 4; ++m)
#pragma unroll
                    for (int n = 0; n < 2; ++n) acc[a][b][m][n] = (f32x4){z0, z0, z0, z0};
        cur = nxt; cA = nA; cB = nB; ++ui;
        if (wr == 1) PG8_BAR;
    }
    PG8_WAIT_V(0);
    PG8_BAR;
#undef PG8_SA
#undef PG8_SB
#undef PG8_STAGE
#undef PG8_OA
#undef PG8_LDA
#undef PG8_LDB
#undef PG8_MMA
#undef PG8_CAT
#undef PG8_WAIT_V
#undef PG8_WAIT_L
#undef PG8_BAR
#undef PG8_SCHED
}

typedef GAS unsigned gu32;
#define XB_TMO      128
#define XB_XCNT(j)  (256  + 64 * (j))
#define XB_XSUB(j)  (1280 + 64 * (j))
#define XB_XGEN(j)  (2304 + 64 * (j))
#define XB_TOP      3328
#define XB_TOPGEN   3392
#define XCD_BAR_WORDS 3456
#define XB_SPIN_CAP (1u << 20)
DEV unsigned xb_ld(unsigned* p) { return __hip_atomic_load(p, __ATOMIC_RELAXED, __HIP_MEMORY_SCOPE_AGENT); }
DEV unsigned xb_add(unsigned* p, unsigned v) { return __hip_atomic_fetch_add(p, v, __ATOMIC_RELAXED, __HIP_MEMORY_SCOPE_AGENT); }
DEV unsigned xb_xcc_id() { return (unsigned)__builtin_amdgcn_s_getreg((3 << 11) | 20) & 0xFu; }
#define XB_SPIN(cond, bar) do { unsigned _sp = 0; while (cond) { __builtin_amdgcn_s_sleep(1); \
    if ((++_sp & 255u) == 0u) { if (xb_ld(&(bar)[XB_TMO])) break; if (_sp > XB_SPIN_CAP) { atomicAdd(&(bar)[XB_TMO], 1u); break; } } } } while (0)
struct XcdBarrier { unsigned* bar; unsigned x; volatile LAS unsigned* st; int wave; };
DEV bool xb_thread0(int wave) { return wave == 0 && __builtin_amdgcn_mbcnt_hi(~0u, __builtin_amdgcn_mbcnt_lo(~0u, 0u)) == 0u; }
DEV XcdBarrier xcd_barrier_post(unsigned* bar, volatile LAS unsigned* st, int wave) {
    XcdBarrier b; b.bar = bar; b.x = xb_xcc_id(); b.st = st; b.wave = wave;
    if (xb_thread0(wave)) (void)xb_add(&bar[XB_XCNT(b.x)], 1u);
    return b;
}
DEV void xcd_barrier_complete(unsigned* bar, unsigned x, unsigned& nloc, unsigned& nx) {
    const unsigned G = gridDim.x * gridDim.y * gridDim.z;
    unsigned sum, cnt, mine, sp = 0u;
    for (;;) {
        sum = 0u; cnt = 0u; mine = 0u;
#pragma unroll
        for (unsigned j = 0; j < 16; ++j) { const unsigned c = xb_ld(&bar[XB_XCNT(j)]); sum += c; cnt += (c > 0u) ? 1u : 0u; mine = (j == x) ? c : mine; }
        if (sum == G) break;
        __builtin_amdgcn_s_sleep(1);
        if ((++sp & 255u) == 0u) { if (xb_ld(&bar[XB_TMO])) break; if (sp > XB_SPIN_CAP) { atomicAdd(&bar[XB_TMO], 1u); break; } }
    }
    nloc = mine > 0u ? mine : 1u; nx = cnt > 0u ? cnt : 1u;
}
DEV void xcd_barrier(const XcdBarrier& b) {
    asm volatile("s_waitcnt vmcnt(0)" ::: "memory");
    __syncthreads();
    if (xb_thread0(b.wave)) {
        unsigned* bar = b.bar;
        __builtin_amdgcn_s_waitcnt(0);
        unsigned nloc = b.st[0], nx = b.st[1];
        if (nloc == 0u) { xcd_barrier_complete(bar, b.x, nloc, nx); b.st[0] = nloc; b.st[1] = nx; }
        const unsigned old = xb_add(&bar[XB_XSUB(b.x)], 1u);
        const unsigned gen = old / nloc;
        if (old + 1u == (gen + 1u) * nloc) {
            __builtin_amdgcn_fence(__ATOMIC_RELEASE, "agent");
            asm volatile("s_waitcnt vmcnt(0)" ::: "memory");
            const unsigned og = xb_add(&bar[XB_TOP], 1u);
            const unsigned tg = og / nx;
            if (og + 1u == (tg + 1u) * nx) xb_add(&bar[XB_TOPGEN], 1u);
            else XB_SPIN(xb_ld(&bar[XB_TOPGEN]) == tg, bar);
            __builtin_amdgcn_fence(__ATOMIC_ACQUIRE, "agent");
            xb_add(&bar[XB_XGEN(b.x)], 1u);
            asm volatile("s_waitcnt vmcnt(0)" ::: "memory");
        } else {
            XB_SPIN(xb_ld(&bar[XB_XGEN(b.x)]) == gen, bar);
            __builtin_amdgcn_fence(__ATOMIC_ACQUIRE, "agent");
            asm volatile("s_waitcnt vmcnt(0)" ::: "memory");
        }
    }
    __syncthreads();
}
constexpr size_t MiB = 1u << 20;
constexpr int PMAX = 131072 + 32 * 256;
constexpr size_t W_CTL = 0, CTL_ZERO_BYTES = 1 * MiB;
constexpr size_t W_IN0 = 2 * MiB, W_GLU = 6 * MiB, W_OUT0 = 7 * MiB, W_IN1 = 9 * MiB, W_OUT1 = 16 * MiB;
constexpr size_t W_LUT = 18 * MiB, W_KM = W_LUT + 64 * 1024, W_HIST = W_KM + 256 * 1024, W_SORT = W_HIST + 64 * 1024  , W_GR = 20 * MiB  , W_SS = 22 * MiB  ;
constexpr size_t W_GU = 32 * MiB, W_DN = 288 * MiB, W_XB = 416 * MiB  , W_XBB = 480 * MiB  , W_X8 = 1024 * MiB  , W_HB = 736 * MiB, W_YS5 = 928 * MiB, W_Y0 = 960 * MiB, W_MIXB = 1024 * MiB, W_GLAO = 1088 * MiB;
constexpr size_t W_ROUTE = 26 * MiB  , W_ACT = 736 * MiB  , W_YS = 1160 * MiB, W_END = 1432 * MiB;
static_assert(W_ACT + (size_t)PMAX * 2048 <= W_MIXB && W_YS + (size_t)PMAX * 2048 <= W_END && W_X8 + (size_t)PMAX * 1024 <= W_YS && W_ROUTE + 4 * MiB <= W_GU, "ws map");
constexpr int CW_BAR = 4096;

struct Args { const float* in[29]; float* out; unsigned char* ws; int ph_lo, ph_hi; };
struct Frame {
    LAS unsigned char* lds; int tid, lane, wave, vcu, G;
    const float* const* in; unsigned char* ws;
};
#define WSP(T_, off) ((T_*)(F.ws + (off)))

DEV void transpose_item(const float* W, int K, int N, bf16_t* WT, LAS float* scr, int item, int lane) {
    const int nblk = N / 64, kb = item / nblk, nb = item % nblk, k0 = 64 * kb, n0 = 64 * nb;
    const float* src = W + (size_t)k0 * N + n0 + lane;
#pragma unroll 16
    for (int kk = 0; kk < 64; ++kk) scr[kk * 65 + lane] = src[(size_t)kk * N];
    asm volatile("s_waitcnt lgkmcnt(0)" ::: "memory");
    const int c = lane & 7;
#pragma unroll
    for (int j = 0; j < 8; ++j) { const int n = (lane >> 3) + 8 * j; const LAS float* s = scr + (8 * c) * 65 + n;
        u32x4 o; o.x = cvt_pk(s[0 * 65], s[1 * 65]); o.y = cvt_pk(s[2 * 65], s[3 * 65]); o.z = cvt_pk(s[4 * 65], s[5 * 65]); o.w = cvt_pk(s[6 * 65], s[7 * 65]);
        *(u32x4*)(WT + (size_t)(n0 + n) * K + k0 + 8 * c) = o; }
    asm volatile("s_waitcnt lgkmcnt(0)" ::: "memory");
}
DEV unsigned pk4_fp8(float a, float b, float c, float d) { unsigned w = 0u; w = __builtin_amdgcn_cvt_pk_fp8_f32(a, b, w, false); w = __builtin_amdgcn_cvt_pk_fp8_f32(c, d, w, true); return w; }
DEV void transpose_item_fp8(const float* W, int K, int N, unsigned char* WT, LAS float* scr, int item, int lane, float sc) {
    const int nblk = N / 64, kb = item / nblk, nb = item % nblk, k0 = 64 * kb, n0 = 64 * nb;
    const float* src = W + (size_t)k0 * N + n0 + lane;
#pragma unroll 16
    for (int kk = 0; kk < 64; ++kk) scr[kk * 65 + lane] = src[(size_t)kk * N] * sc;
    asm volatile("s_waitcnt lgkmcnt(0)" ::: "memory");
    const int c = lane & 7;
#pragma unroll
    for (int j = 0; j < 8; ++j) { const int n = (lane >> 3) + 8 * j; const LAS float* s = scr + (8 * c) * 65 + n;
        u32x2 o; o.x = pk4_fp8(s[0 * 65], s[1 * 65], s[2 * 65], s[3 * 65]); o.y = pk4_fp8(s[4 * 65], s[5 * 65], s[6 * 65], s[7 * 65]);
        *(u32x2*)(WT + (size_t)(n0 + n) * K + k0 + 8 * c) = o; }
    asm volatile("s_waitcnt lgkmcnt(0)" ::: "memory");
}
__constant__ int BUCKET_TH2[16] = {16, 22, 30, 40, 54, 73, 99, 134, 182, 246, 332, 450, 609, 825, 1117, 1513};
DEV void p0_prologue(Frame& F) {
    LAS float* scr = (LAS float*)(F.lds + F.wave * 16640);
    const int gw = F.vcu * 8 + F.wave, NGW = F.G * 8;
    constexpr int I_GU = 16 * 32, I_DN = 16 * 16, I_IN0 = 16 * 32, I_GLU = 8 * 8, I_O = 16 * 16, I_IN1 = 16 * 48;
    constexpr int N_GU = 64 * I_GU, N_DN = 64 * I_DN;
    constexpr int NITEMS = N_GU + N_DN + I_IN0 + I_GLU + 2 * I_O + I_IN1;
    for (int it = gw; it < NITEMS; it += NGW) {
        int r = it;
        if (r < N_GU) { const int m = r / I_GU; transpose_item_fp8(F.in[25] + (size_t)m * 1024 * 2048, 1024, 2048, WSP(unsigned char, W_GU) + (size_t)m * 2048 * 1024, scr, r % I_GU, F.lane, 64.f); continue; } r -= N_GU;
        if (r < N_DN) { const int m = r / I_DN; transpose_item(F.in[27] + (size_t)m * 1024 * 1024, 1024, 1024, WSP(bf16_t, W_DN) + (size_t)m * 1024 * 1024, scr, r % I_DN, F.lane); continue; } r -= N_DN;
        if (r < I_IN0) { transpose_item(F.in[1], 1024, 2048, WSP(bf16_t, W_IN0), scr, r, F.lane); continue; } r -= I_IN0;
        if (r < I_GLU) { transpose_item(F.in[10], 512, 512, WSP(bf16_t, W_GLU), scr, r, F.lane); continue; } r -= I_GLU;
        if (r < I_O) { transpose_item(F.in[13], 1024, 1024, WSP(bf16_t, W_OUT0), scr, r, F.lane); continue; } r -= I_O;
        if (r < I_O) { transpose_item(F.in[18], 1024, 1024, WSP(bf16_t, W_OUT1), scr, r, F.lane); continue; } r -= I_O;
        { const int kb = r / 48, nb = r % 48; const float* src = F.in[14] + (size_t)(64 * kb) * 3088 + 64 * nb + F.lane;
#pragma unroll 16
          for (int kk = 0; kk < 64; ++kk) scr[kk * 65 + F.lane] = src[(size_t)kk * 3088];
          asm volatile("s_waitcnt lgkmcnt(0)" ::: "memory");
          const int c = F.lane & 7;
#pragma unroll
          for (int j = 0; j < 8; ++j) { const int n = (F.lane >> 3) + 8 * j; const LAS float* s = scr + (8 * c) * 65 + n;
              u32x4 o; o.x = cvt_pk(s[0 * 65], s[1 * 65]); o.y = cvt_pk(s[2 * 65], s[3 * 65]); o.z = cvt_pk(s[4 * 65], s[5 * 65]); o.w = cvt_pk(s[6 * 65], s[7 * 65]);
              *(u32x4*)(WSP(bf16_t, W_IN1) + (size_t)(64 * nb + n) * 1024 + 64 * kb + 8 * c) = o; }
          asm volatile("s_waitcnt lgkmcnt(0)" ::: "memory"); }
    }
    const int gt = F.vcu * 512 + F.tid, NGT = F.G * 512;
    for (int i = gt; i < 16 * 1024; i += NGT) { const int n = i >> 10, k = i & 1023; WSP(bf16_t, W_IN1)[(size_t)(3072 + n) * 1024 + k] = (bf16_t)(cvt_pk(F.in[14][(size_t)k * 3088 + 3072 + n], 0.f) & 0xffffu); }
    { const f32x4* x4 = (const f32x4*)F.in[0]; u32x2* o = WSP(u32x2, W_XB);
      for (size_t i = gt; i < (size_t)T * 1024 / 4; i += NGT) { const f32x4 v = x4[i]; u32x2 w; w.x = cvt_pk(v.x, v.y); w.y = cvt_pk(v.z, v.w); o[i] = w; } }
    for (int i = gt; i < 8 * 2048; i += NGT) { const int h = i >> 11, n = i & 2047; int bk = n;
        if (n >= 16) { bk = 16;
#pragma unroll
            for (int q = 1; q < 16; ++q) bk += (n >= BUCKET_TH2[q]) ? 1 : 0; }
        WSP(float, W_LUT)[i] = F.in[12][bk * 8 + h] * 1.4426950408889634f; }
}

DEV void p_kmean(Frame& F) {
    const int gw = F.vcu * 8 + F.wave, NGW = F.G * 8; const bf16_t* H0 = WSP(bf16_t, W_HB); float* KM = WSP(float, W_KM);
    for (int it = gw; it < 1024; it += NGW) { const int blk = it & 7, h = (it >> 3) & 7, b = it >> 6; const int r8 = F.lane >> 3, c = F.lane & 7;
        const bf16_t* p = H0 + (size_t)(b * 2048 + blk * 256 + r8) * 2048 + 1024 + h * 64 + c * 8; float s[8];
#pragma unroll
        for (int j = 0; j < 8; ++j) s[j] = 0.f;
#pragma unroll 8
        for (int i = 0; i < 32; ++i) { const u32x4 v = *(const u32x4*)(p + (size_t)i * 8 * 2048);
            s[0] += bflo(v.x); s[1] += bfhi(v.x); s[2] += bflo(v.y); s[3] += bfhi(v.y); s[4] += bflo(v.z); s[5] += bfhi(v.z); s[6] += bflo(v.w); s[7] += bfhi(v.w); }
#pragma unroll
        for (int j = 0; j < 8; ++j) { s[j] += __shfl_xor(s[j], 8); s[j] += __shfl_xor(s[j], 16); s[j] += __shfl_xor(s[j], 32); }
        if (F.lane < 8) {
#pragma unroll
            for (int j = 0; j < 8; ++j) KM[(size_t)it * 64 + c * 8 + j] = s[j] * (1.f / 256.f); } }
}

DEV void s5_item(Frame& F, int b, int g, LAS unsigned char* sl  ) {
    const int lane = F.lane, p0 = lane & 31, hi = lane >> 5, q4 = lane >> 4;
    const float* lam_re = F.in[2]; const float* lam_im = F.in[3]; const float* log_dt = F.in[4]; const float* b_re = F.in[5]; const float* b_im = F.in[6];
    const float* c_re = F.in[7]; const float* c_im = F.in[8]; const float* dsk = F.in[9];
    const bf16_t* H0 = WSP(bf16_t, W_HB); bf16_t* YS = WSP(bf16_t, W_YS5);
    const float dt = __expf(log_dt[g]);
    float ar[2], ai[2]; bf16x8 bfr[4];
#pragma unroll
    for (int s = 0; s < 2; ++s) { const int p = p0 + 32 * s; const float lr = lam_re[g * 64 + p], li = lam_im[g * 64 + p]; const float mag = __expf(lr * dt);
        ar[s] = mag * cosf(li * dt); ai[s] = mag * sinf(li * dt);
        const float er = ar[s] - 1.f, ei = ai[s], den = lr * lr + li * li; const float qr = (er * lr + ei * li) / den, qi = (ei * lr - er * li) / den;
        u32x4 wr_, wi_; float vr[8], vi[8];
#pragma unroll
        for (int j = 0; j < 8; ++j) { const float br = b_re[(g * 64 + p) * 16 + 8 * hi + j], bi = b_im[(g * 64 + p) * 16 + 8 * hi + j]; vr[j] = qr * br - qi * bi; vi[j] = qr * bi + qi * br; }
        wr_.x = cvt_pk(vr[0], vr[1]); wr_.y = cvt_pk(vr[2], vr[3]); wr_.z = cvt_pk(vr[4], vr[5]); wr_.w = cvt_pk(vr[6], vr[7]);
        wi_.x = cvt_pk(vi[0], vi[1]); wi_.y = cvt_pk(vi[2], vi[3]); wi_.z = cvt_pk(vi[4], vi[5]); wi_.w = cvt_pk(vi[6], vi[7]);
        bfr[2 * s] = __builtin_bit_cast(bf16x8, wr_); bfr[2 * s + 1] = __builtin_bit_cast(bf16x8, wi_); }
    bf16x8 cfr[4];
#pragma unroll
    for (int ks = 0; ks < 4; ++ks) { float v[8];
#pragma unroll
        for (int j = 0; j < 8; ++j) { const int c = 32 * ks + 8 * q4 + j, p = c >> 1; const int h = lane & 15; v[j] = (c & 1) ? -c_im[(g * 16 + h) * 64 + p] : c_re[(g * 16 + h) * 64 + p]; }
        u32x4 w; w.x = cvt_pk(v[0], v[1]); w.y = cvt_pk(v[2], v[3]); w.z = cvt_pk(v[4], v[5]); w.w = cvt_pk(v[6], v[7]); cfr[ks] = __builtin_bit_cast(bf16x8, w); }
    float dv[4];
#pragma unroll
    for (int r = 0; r < 4; ++r) dv[r] = dsk[g * 16 + 4 * q4 + r];
    const int tm = 16 * ((p0 >> 2) & 1) + 4 * (p0 >> 3) + (p0 & 3);
    const bf16_t* urow = H0 + (size_t)(b * 2048 + tm) * 2048 + g * 16 + 8 * hi;
    float cr[2] = {0.f, 0.f}, ci[2] = {0.f, 0.f};
    bf16x8 ufr = *(const bf16x8*)urow;
    for (int tile = 0; tile < 64; ++tile) {
        const bf16x8 ucur = ufr;
        if (tile + 1 < 64) ufr = *(const bf16x8*)(urow + (size_t)(tile + 1) * 32 * 2048);
        f32x16 x[4];
#pragma unroll
        for (int n = 0; n < 4; ++n) { f32x16 z;
#pragma unroll
            for (int r = 0; r < 16; ++r) z[r] = 0.f;
            x[n] = __builtin_amdgcn_mfma_f32_32x32x16_bf16(ucur, bfr[n], z, 0, 0, 0); }
#pragma unroll
        for (int s = 0; s < 2; ++s) {
            f32x16& xr = x[2 * s]; f32x16& xi = x[2 * s + 1];
            float sr = hi ? 0.f : cr[s], si = hi ? 0.f : ci[s];
#pragma unroll
            for (int r = 0; r < 16; ++r) { const float nr = ar[s] * sr - ai[s] * si + xr[r], ni = ar[s] * si + ai[s] * sr + xi[r]; xr[r] = nr; xi[r] = ni; sr = nr; si = ni; }
            const float o_r = swap32(sr), o_i = swap32(si);
            float wr_ = hi ? o_r : 0.f, wi_ = hi ? o_i : 0.f;
#pragma unroll
            for (int r = 0; r < 16; ++r) { const float nr = ar[s] * wr_ - ai[s] * wi_, ni = ar[s] * wi_ + ai[s] * wr_; wr_ = nr; wi_ = ni; xr[r] += wr_; xi[r] += wi_; }
            const float e_r = swap32(xr[15]), e_i = swap32(xi[15]);
            cr[s] = hi ? xr[15] : e_r; ci[s] = hi ? xi[15] : e_i;
#pragma unroll
            for (int r = 0; r < 16; ++r) *(LAS unsigned*)(sl + (16 * hi + r) * 256 + (p0 + 32 * s) * 4) = cvt_pk(xr[r], xi[r]);
        }
#pragma unroll
        for (int tt = 0; tt < 2; ++tt) {
            f32x4 y = {0.f, 0.f, 0.f, 0.f};
#pragma unroll
            for (int ks = 0; ks < 4; ++ks) { const bf16x8 sf = *(const LAS bf16x8*)(sl + (16 * tt + (lane & 15)) * 256 + ks * 64 + q4 * 16); y = __builtin_amdgcn_mfma_f32_16x16x32_bf16(cfr[ks], sf, y, 0, 0, 0); }
            const int t = tile * 32 + 16 * tt + (lane & 15);
            const u32x2 uw = *(const u32x2*)(H0 + (size_t)(b * 2048 + t) * 2048 + g * 16 + 4 * q4);
            const float y0 = gelu_tanh(y[0] + dv[0] * bflo(uw.x)), y1 = gelu_tanh(y[1] + dv[1] * bfhi(uw.x)), y2 = gelu_tanh(y[2] + dv[2] * bflo(uw.y)), y3 = gelu_tanh(y[3] + dv[3] * bfhi(uw.y));
            u32x2 ow; ow.x = cvt_pk(y0, y1); ow.y = cvt_pk(y2, y3);
            *(u32x2*)(YS + (size_t)(b * 2048 + t) * 512 + g * 16 + 4 * q4) = ow;
        }
    }
}

constexpr int AT_K = 0, AT_V = 16384, AT_LUT = 32768, AT_WS = 40960, AT_OST = 43008, AT_END = AT_OST + 8 * 4096;
DEV int crow(int r, int hi) { return (r & 3) + 8 * (r >> 2) + 4 * hi; }
DEV s16x4 vtr(const LAS unsigned char* p) { typedef short v4i16_t __attribute__((ext_vector_type(4))); return __builtin_bit_cast(s16x4, __builtin_amdgcn_ds_read_tr16_b64_v4i16((LAS v4i16_t*)p)); }
DEV void moba_unit(Frame& F, int b, int h, int own) {
    const int lane = F.lane, wid = F.wave, r32 = lane & 31, hi = lane >> 5;
    LAS unsigned char* lds = F.lds;
    const bf16_t* H0 = WSP(bf16_t, W_HB); const float* KM = WSP(float, W_KM);
    LAS float* lut = (LAS float*)(lds + AT_LUT); LAS float* wsf = (LAS float*)(lds + AT_WS) + wid * 64;
    const size_t rowbase = (size_t)b * 2048;
    const int qpos = own * 256 + wid * 32 + r32;
    bf16x8 qr[4];
#pragma unroll
    for (int d0 = 0; d0 < 4; ++d0) qr[d0] = *(const bf16x8*)(H0 + (rowbase + qpos) * 2048 + 512 + h * 64 + d0 * 16 + hi * 8);
    unsigned selmask = 0u;
    if (own > 0) {
        float gate[7];
#pragma unroll
        for (int j = 0; j < 7; ++j) { float s = 0.f;
            if (j < own) { const float* km = KM + ((size_t)(b * 8 + h) * 8 + j) * 64 + hi * 8;
#pragma unroll
                for (int d0 = 0; d0 < 4; ++d0) { const f32x4 k0 = *(const f32x4*)(km + d0 * 16), k1 = *(const f32x4*)(km + d0 * 16 + 4); const u32x4 qw = __builtin_bit_cast(u32x4, qr[d0]);
                    s += bflo(qw.x) * k0.x + bfhi(qw.x) * k0.y + bflo(qw.y) * k0.z + bfhi(qw.y) * k0.w + bflo(qw.z) * k1.x + bfhi(qw.z) * k1.y + bflo(qw.w) * k1.z + bfhi(qw.w) * k1.w; } }
            gate[j] = s + swap32(s); }
#pragma unroll
        for (int j = 0; j < 7; ++j) { int rank = 0;
#pragma unroll
            for (int j2 = 0; j2 < 7; ++j2) if (j2 != j && j2 < own && (gate[j2] > gate[j] || (gate[j2] == gate[j] && j2 < j))) ++rank;
            if (j < own && rank < 3) selmask |= 1u << j; }
    }
    const int NT = 4 * (own + 1);
#define KV0(i) ((i) < 4 ? own * 256 + (i) * 64 : (((i) - 4) >> 2) * 256 + (((i) - 4) & 3) * 64)
    const bf16_t* kbase = H0 + (rowbase + lane) * 2048 + 1024 + h * 64 + wid * 8;
    const bf16_t* vbase = H0 + (rowbase + 16 * (wid & 3) + (lane >> 2)) * 2048 + 1536 + h * 64 + (wid >> 2) * 32 + (lane & 3) * 8;
#define LOADKV(i) do { const int kv0_ = KV0(i); const int bo_ = ((i) & 1) * 8192; \
        __builtin_amdgcn_global_load_lds((const unsigned*)(kbase + (size_t)kv0_ * 2048), (LAS unsigned*)(lds + AT_K + bo_ + wid * 1024), 16, 0, 0); \
        __builtin_amdgcn_global_load_lds((const unsigned*)(vbase + (size_t)kv0_ * 2048), (LAS unsigned*)(lds + AT_V + bo_ + wid * 1024), 16, 0, 0); } while (0)
    LOADKV(0);
    float m_run = -INFINITY, l_run = 0.f; f32x16 o[2];
#pragma unroll
    for (int r = 0; r < 16; ++r) { o[0][r] = 0.f; o[1][r] = 0.f; }
    asm volatile("s_waitcnt vmcnt(0)" ::: "memory"); __syncthreads();
    for (int i = 0; i < NT; ++i) {
        if (i + 1 < NT) LOADKV(i + 1);
        const int kv0 = KV0(i); const int bo = (i & 1) * 8192;
        const bool rowsel = (i < 4) || ((selmask >> ((i - 4) >> 2)) & 1u);
        f32x16 p0, p1;
#pragma unroll
        for (int r = 0; r < 16; ++r) { p0[r] = 0.f; p1[r] = 0.f; }
        { const LAS unsigned char* kb = lds + AT_K + bo + hi * 1024 + r32 * 16;
#pragma unroll
          for (int d0 = 0; d0 < 4; ++d0) { const bf16x8 k0 = *(const LAS bf16x8*)(kb + d0 * 2048), k1 = *(const LAS bf16x8*)(kb + d0 * 2048 + 512);
              p0 = __builtin_amdgcn_mfma_f32_32x32x16_bf16(k0, qr[d0], p0, 0, 0, 0); p1 = __builtin_amdgcn_mfma_f32_32x32x16_bf16(k1, qr[d0], p1, 0, 0, 0); } }
        const int dbase = qpos - kv0 - 4 * hi;
        float rmax = -INFINITY;
#pragma unroll
        for (int r = 0; r < 16; ++r) { const int d0_ = dbase - ((r & 3) + 8 * (r >> 2)); const int d1_ = d0_ - 32;
            const float b0 = lut[d0_ < 0 ? 0 : d0_], b1 = lut[d1_ < 0 ? 0 : d1_];
            p0[r] = (rowsel && d0_ >= 0) ? p0[r] + b0 : -INFINITY; p1[r] = (rowsel && d1_ >= 0) ? p1[r] + b1 : -INFINITY;
            rmax = fmaxf(rmax, fmaxf(p0[r], p1[r])); }
        rmax = fmaxf(rmax, swap32(rmax));
        const float m_new = fmaxf(m_run, rmax);
        const float msafe = (m_new == -INFINITY) ? 0.f : m_new;
        const float alpha = __builtin_amdgcn_exp2f(m_run - msafe);
        m_run = m_new;
        float rs = 0.f;
#pragma unroll
        for (int r = 0; r < 16; ++r) { p0[r] = __builtin_amdgcn_exp2f(p0[r] - msafe); p1[r] = __builtin_amdgcn_exp2f(p1[r] - msafe); rs += p0[r] + p1[r]; }
        l_run = l_run * alpha + rs;
        if (__any(alpha != 1.f)) { if (hi == 0) wsf[r32] = alpha;
#pragma unroll
            for (int r = 0; r < 16; ++r) { const float f = wsf[crow(r, hi)]; o[0][r] *= f; o[1][r] *= f; } }
        u32x4 pw[4];
        pw[0] = (u32x4){cvt_pk(p0[0], p0[1]), cvt_pk(p0[2], p0[3]), cvt_pk(p0[4], p0[5]), cvt_pk(p0[6], p0[7])};
        pw[1] = (u32x4){cvt_pk(p0[8], p0[9]), cvt_pk(p0[10], p0[11]), cvt_pk(p0[12], p0[13]), cvt_pk(p0[14], p0[15])};
        pw[2] = (u32x4){cvt_pk(p1[0], p1[1]), cvt_pk(p1[2], p1[3]), cvt_pk(p1[4], p1[5]), cvt_pk(p1[6], p1[7])};
        pw[3] = (u32x4){cvt_pk(p1[8], p1[9]), cvt_pk(p1[10], p1[11]), cvt_pk(p1[12], p1[13]), cvt_pk(p1[14], p1[15])};
        { const LAS unsigned char* vp = lds + AT_V + bo + ((lane >> 4) & 1) * 32 + (lane & 3) * 8 + (4 * hi + ((lane & 15) >> 2)) * 64;
#pragma unroll
          for (int d0 = 0; d0 < 2; ++d0)
#pragma unroll
              for (int ks = 0; ks < 4; ++ks) { const s16x4 lo = vtr(vp + d0 * 4096 + ks * 1024), hh = vtr(vp + d0 * 4096 + ks * 1024 + 512);
                  const bf16x8 vf = (bf16x8){lo[0], lo[1], lo[2], lo[3], hh[0], hh[1], hh[2], hh[3]};
                  o[d0] = __builtin_amdgcn_mfma_f32_32x32x16_bf16(__builtin_bit_cast(bf16x8, pw[ks]), vf, o[d0], 0, 0, 0); } }
        asm volatile("s_waitcnt vmcnt(0)" ::: "memory"); __syncthreads();
    }
#undef KV0
#undef LOADKV
    l_run += swap32(l_run);
    if (hi == 0) wsf[32 + r32] = 1.f / l_run;
    bf16_t* Ow = WSP(bf16_t, W_Y0) + (rowbase + own * 256 + wid * 32) * 1024 + 512 + h * 64;
    LAS bf16_t* stg = (LAS bf16_t*)(lds + AT_OST) + wid * 2048;
#pragma unroll
    for (int r = 0; r < 16; ++r) { const int orow = crow(r, hi); const float rl = wsf[32 + orow];
        stg[orow * 64 + r32] = (bf16_t)(cvt_pk(o[0][r] * rl, 0.f) & 0xffffu); stg[orow * 64 + 32 + r32] = (bf16_t)(cvt_pk(o[1][r] * rl, 0.f) & 0xffffu); }
#pragma unroll
    for (int i = 0; i < 4; ++i) { const int row = i * 8 + (lane >> 3), ch = lane & 7; const u32x4 v = *(const LAS u32x4*)(stg + row * 64 + ch * 8); *(u32x4*)(Ow + (size_t)row * 1024 + ch * 8) = v; }
    __syncthreads();
}
DEV void p_s5_moba(Frame& F, int mode) {
    if (mode & 1) { for (int it = F.vcu * 2 + (F.wave & 1); it < 512; it += F.G * 2) { if (F.wave < 2) s5_item(F, it >> 5, it & 31, F.lds + 81920 + F.wave * 8192); } }
    __syncthreads();
    if (!(mode & 2)) return;
    for (int v = F.vcu; v < 256; v += F.G) { const int bh = v >> 1, b = bh >> 3, h = bh & 7;
        for (int i = F.tid; i < 2048; i += 512) ((LAS float*)(F.lds + AT_LUT))[i] = WSP(float, W_LUT)[h * 2048 + i];
        __syncthreads();
#pragma unroll 1
        for (int i = 0; i < 4; ++i) { const int own = (((v & 1) ? 0x1256 : 0x0347) >> (4 * i)) & 0xF; moba_unit(F, b, h, own); }
    }
}
constexpr size_t R_RE = W_ROUTE, R_RW = W_ROUTE + 512 * 1024, R_POS = W_ROUTE + 1024 * 1024, R_TOK = W_ROUTE + 2 * MiB, R_WGT = W_ROUTE + 3 * MiB;
constexpr int WT_PITCH = 1028;
constexpr int RW_PITCH = 1032;
constexpr int LN_XT = 32 * RW_PITCH * 2;
constexpr int LN_LG = 147456;
constexpr int LN_HIST = LN_LG + 8 * 528;
static_assert(LN_XT + 8 * 8256 <= LDS_TOK && LN_HIST + 128 <= LDS_BYTES, "LN LDS map");
template <int MODE, bool ROUTER, bool XIN_F32, bool OUT_F32>
DEV void p_ln(Frame& F, const float* xin32, const bf16_t* xinb, bf16_t* xoutb, float* xout32, const float* gam, const float* bet, const float* wrt, const float* brt) {
    LAS bf16_t* whi = (LAS bf16_t*)F.lds; LAS bf16_t* xt = (LAS bf16_t*)(F.lds + LN_XT) + F.wave * 4128; LAS float* lgs = (LAS float*)(F.lds + LN_LG) + F.wave * 132; LAS int* hist = (LAS int*)(F.lds + LN_HIST);
    const int lane = F.lane, l15 = lane & 15, q4 = lane >> 4;
    if constexpr (ROUTER) {
        for (int i = F.tid; i < 1024 * 32; i += 512) { const int k = i >> 5, e = i & 31; whi[e * RW_PITCH + k] = (bf16_t)(cvt_pk(wrt[i], 0.f) & 0xffffu); }
        if (F.tid < 32) hist[F.tid] = 0;
        __syncthreads();
    }
    const bf16_t* MIXB = WSP(bf16_t, W_MIXB); const bf16_t* YS = WSP(bf16_t, W_YS); const int* POS = WSP(int, R_POS);
    int* RE = WSP(int, R_RE); float* RW = WSP(float, R_RW);
    const float alpha = 1.4142135623730951f;
    f32x4 gq[4], bq[4];
#pragma unroll
    for (int j = 0; j < 4; ++j) { gq[j] = *(const f32x4*)(gam + j * 256 + lane * 4); bq[j] = *(const f32x4*)(bet + j * 256 + lane * 4); }
    float bias8[8];
    if constexpr (ROUTER) {
#pragma unroll
        for (int r = 0; r < 8; ++r) bias8[r] = brt[(r >> 2) * 16 + 4 * q4 + (r & 3)]; }
    for (int wgi = F.vcu; wgi < 256; wgi += F.G) {
        const int r0 = wgi * 128 + F.wave * 16;
#pragma unroll 1
        for (int i4 = 0; i4 < 16; i4 += 4) {
            float v[4][16];
#pragma unroll
            for (int u = 0; u < 4; ++u) { const int row = r0 + i4 + u;
                if constexpr (XIN_F32) {
#pragma unroll
                    for (int j = 0; j < 4; ++j) { const f32x4 a = *(const f32x4*)(xin32 + (size_t)row * 1024 + j * 256 + lane * 4); v[u][4 * j] = alpha * a.x; v[u][4 * j + 1] = alpha * a.y; v[u][4 * j + 2] = alpha * a.z; v[u][4 * j + 3] = alpha * a.w; }
                } else {
#pragma unroll
                    for (int j = 0; j < 4; ++j) { const u32x2 a = *(const u32x2*)(xinb + (size_t)row * 1024 + j * 256 + lane * 4); v[u][4 * j] = alpha * bflo(a.x); v[u][4 * j + 1] = alpha * bfhi(a.x); v[u][4 * j + 2] = alpha * bflo(a.y); v[u][4 * j + 3] = alpha * bfhi(a.y); }
                }
                if constexpr (MODE == 0) {
#pragma unroll
                    for (int j = 0; j < 4; ++j) { const u32x2 m = *(const u32x2*)(MIXB + (size_t)row * 1024 + j * 256 + lane * 4); v[u][4 * j] += bflo(m.x); v[u][4 * j + 1] += bfhi(m.x); v[u][4 * j + 2] += bflo(m.y); v[u][4 * j + 3] += bfhi(m.y); }
                } else {
                    const int4 pos4 = *(const int4*)(POS + row * 4);
                    const int ps[4] = {__builtin_amdgcn_readfirstlane(pos4.x), __builtin_amdgcn_readfirstlane(pos4.y), __builtin_amdgcn_readfirstlane(pos4.z), __builtin_amdgcn_readfirstlane(pos4.w)};
#pragma unroll
                    for (int kx = 0; kx < 4; ++kx)
#pragma unroll
                        for (int j = 0; j < 4; ++j) { const u32x2 m = *(const u32x2*)(YS + (size_t)ps[kx] * 1024 + j * 256 + lane * 4); v[u][4 * j] += bflo(m.x); v[u][4 * j + 1] += bfhi(m.x); v[u][4 * j + 2] += bflo(m.y); v[u][4 * j + 3] += bfhi(m.y); }
                }
            }
            float s1[4], s2[4];
#pragma unroll
            for (int u = 0; u < 4; ++u) { s1[u] = 0.f; s2[u] = 0.f;
#pragma unroll
                for (int q = 0; q < 16; ++q) { s1[u] += v[u][q]; s2[u] = fmaf(v[u][q], v[u][q], s2[u]); } }
#pragma unroll
            for (int o = 1; o < 64; o <<= 1) {
#pragma unroll
                for (int u = 0; u < 4; ++u) { s1[u] += __shfl_xor(s1[u], o); s2[u] += __shfl_xor(s2[u], o); } }
#pragma unroll
            for (int u = 0; u < 4; ++u) { const int row = r0 + i4 + u; const float mean = s1[u] * (1.f / 1024.f); const float var = fmaxf(s2[u] * (1.f / 1024.f) - mean * mean, 0.f); const float rstd = 1.f / sqrtf(var + 1e-5f);
#pragma unroll
                for (int j = 0; j < 4; ++j) { const int c = j * 256 + lane * 4; const f32x4 g4 = gq[j], b4 = bq[j];
                    const float y0 = (v[u][4 * j] - mean) * rstd * g4.x + b4.x, y1 = (v[u][4 * j + 1] - mean) * rstd * g4.y + b4.y, y2 = (v[u][4 * j + 2] - mean) * rstd * g4.z + b4.z, y3 = (v[u][4 * j + 3] - mean) * rstd * g4.w + b4.w;
                    if constexpr (OUT_F32) *(f32x4*)(xout32 + (size_t)row * 1024 + c) = (f32x4){y0, y1, y2, y3};
                    else { u32x2 w; w.x = cvt_pk(y0, y1); w.y = cvt_pk(y2, y3); *(u32x2*)(xoutb + (size_t)row * 1024 + c) = w;
                        if constexpr (ROUTER) { *(LAS u32x2*)(xt + u * RW_PITCH + c) = w;} } } }
            if constexpr (ROUTER) {
                f32x4 acc[2] = {{0.f, 0.f, 0.f, 0.f}, {0.f, 0.f, 0.f, 0.f}};
#pragma unroll 8
                for (int ks = 0; ks < 32; ++ks) { const bf16x8 xb = *(const LAS bf16x8*)(xt + (l15 & 3) * RW_PITCH + ks * 32 + q4 * 8);
#pragma unroll
                    for (int mt = 0; mt < 2; ++mt) { const bf16x8 wa = *(const LAS bf16x8*)(whi + (mt * 16 + l15) * RW_PITCH + ks * 32 + q4 * 8); acc[mt] = __builtin_amdgcn_mfma_f32_16x16x32_bf16(wa, xb, acc[mt], 0, 0, 0); } }
                if (l15 < 4) {
#pragma unroll
                    for (int mt = 0; mt < 2; ++mt)
#pragma unroll
                        for (int r = 0; r < 4; ++r) lgs[l15 * 33 + mt * 16 + 4 * q4 + r] = acc[mt][r] + bias8[mt * 4 + r]; }
                if (lane < 4) { float lg[32];
#pragma unroll
                    for (int e = 0; e < 32; ++e) lg[e] = lgs[lane * 33 + e];
                    unsigned taken = 0u; float tv[4]; int ti[4];
#pragma unroll
                    for (int r = 0; r < 4; ++r) { float best = -INFINITY; int bi = 0;
#pragma unroll
                        for (int e = 0; e < 32; ++e) { const bool ok = !((taken >> e) & 1u) && lg[e] > best; best = ok ? lg[e] : best; bi = ok ? e : bi; }
                        taken |= 1u << bi; tv[r] = best; ti[r] = bi; }
                    float ex[4], sm = 0.f;
#pragma unroll
                    for (int r = 0; r < 4; ++r) { ex[r] = __expf(tv[r] - tv[0]); sm += ex[r]; }
                    const float inv = 1.f / sm; const int row = r0 + i4 + lane;
                    *(int4*)(RE + row * 4) = make_int4(ti[0], ti[1], ti[2], ti[3]); *(f32x4*)(RW + row * 4) = (f32x4){ex[0] * inv, ex[1] * inv, ex[2] * inv, ex[3] * inv};
#pragma unroll
                    for (int r = 0; r < 4; ++r) atomicAdd((int*)(hist + ti[r]), 1); }
            }
        }
        if constexpr (ROUTER) { __syncthreads(); if (F.tid < 32) { WSP(int, W_HIST)[wgi * 32 + F.tid] = hist[F.tid]; hist[F.tid] = 0; } __syncthreads(); }
    }
}

DEV void p_sort(Frame& F) {
    LAS int* Ls = (LAS int*)F.lds; const int tid = F.tid;
    const int* HIST = WSP(int, W_HIST); int* SORT = WSP(int, W_SORT);
    const int* RE = WSP(int, R_RE); const float* RW = WSP(float, R_RW); int* POS = WSP(int, R_POS); int* TOK = WSP(int, R_TOK); float* WGT = WSP(float, R_WGT);
    for (int wgi = F.vcu; wgi < 256; wgi += F.G) {
        { const int e = tid & 31, part = tid >> 5; int tot = 0, pre = 0;
          for (int w = part * 16; w < part * 16 + 16; ++w) { const int hh = HIST[w * 32 + e]; tot += hh; pre += (w < wgi) ? hh : 0; }
          Ls[part * 32 + e] = tot; Ls[512 + part * 32 + e] = pre; }
        Ls[2048 + tid] = RE[wgi * 512 + tid];
        __syncthreads();
        if (tid < 32) { int tot = 0, pre = 0; for (int p = 0; p < 16; ++p) { tot += Ls[p * 32 + tid]; pre += Ls[512 + p * 32 + tid]; } Ls[1200 + tid] = tot; Ls[1300 + tid] = pre; }
        __syncthreads();
        if (tid == 0) { int a = 0; for (int e = 0; e < 32; ++e) { Ls[1024 + e] = a; a += (Ls[1200 + e] + 255) / 256 * 256; } Ls[1056] = a; }
        __syncthreads();
        if (tid < 32) { int c = Ls[1024 + tid] + Ls[1300 + tid]; for (int i = 0; i < 512; ++i) if (Ls[2048 + i] == tid) { Ls[2560 + i] = c; ++c; } }
        __syncthreads();
        { const int pos = Ls[2560 + tid]; TOK[pos] = wgi * 128 + (tid >> 2); WGT[pos] = RW[wgi * 512 + tid]; POS[wgi * 512 + tid] = pos; }
        { const bf16_t* XBBp = WSP(bf16_t, W_XBB); unsigned char* XS8 = WSP(unsigned char, W_X8);
          for (int r = F.wave; r < 128; r += 8) { const u32x4* src = (const u32x4*)(XBBp + (size_t)(wgi * 128 + r) * 1024 + F.lane * 16); const u32x4 a = src[0], b2 = src[1];
              u32x4 o; o.x = pk4_fp8(bflo(a.x) * 16.f, bfhi(a.x) * 16.f, bflo(a.y) * 16.f, bfhi(a.y) * 16.f); o.y = pk4_fp8(bflo(a.z) * 16.f, bfhi(a.z) * 16.f, bflo(a.w) * 16.f, bfhi(a.w) * 16.f);
              o.z = pk4_fp8(bflo(b2.x) * 16.f, bfhi(b2.x) * 16.f, bflo(b2.y) * 16.f, bfhi(b2.y) * 16.f); o.w = pk4_fp8(bflo(b2.z) * 16.f, bfhi(b2.z) * 16.f, bflo(b2.w) * 16.f, bfhi(b2.w) * 16.f);
#pragma unroll
              for (int kx = 0; kx < 4; ++kx) { const int pos = Ls[2560 + r * 4 + kx]; *(u32x4*)(XS8 + (size_t)pos * 1024 + F.lane * 16) = o; } }
          if (wgi < 32) { const int e = wgi; for (int r = Ls[1024 + e] + Ls[1200 + e] + F.wave; r < Ls[1024 + e + 1]; r += 8) *(u32x4*)(XS8 + (size_t)r * 1024 + F.lane * 16) = (u32x4){0u, 0u, 0u, 0u}; } }
        if (wgi < 32) { const int e = wgi; for (int r = Ls[1024 + e] + Ls[1200 + e] + tid; r < Ls[1024 + e + 1]; r += 512) { TOK[r] = 0; WGT[r] = 0.f; } }
        if (wgi == 0) { if (tid < 33) SORT[tid] = Ls[1024 + tid]; if (tid == 0) SORT[33] = Ls[1056] / 256;
            for (int pm = tid; pm < PMAX / 256; pm += 512) { int e = 0; for (int j = 1; j < 32; ++j) if (pm * 256 >= Ls[1024 + j]) e = j; SORT[64 + pm] = e; } }
        __syncthreads();
    }
}

DEV void p_gr(Frame& F) {
    const int gw = F.vcu * 8 + F.wave, NGW = F.G * 8, lane = F.lane, q4 = lane >> 4; const bf16_t* XB = WSP(bf16_t, W_XB); const bf16_t* Wg = WSP(bf16_t, W_IN1) + (size_t)3072 * 1024; float* GR = WSP(float, W_GR);
    for (int it = gw; it < T / 16; it += NGW) { f32x4 acc = {0.f, 0.f, 0.f, 0.f};
        const bf16_t* ap = XB + (size_t)(it * 16 + (lane & 15)) * 1024 + q4 * 8; const bf16_t* bp = Wg + (size_t)(lane & 15) * 1024 + q4 * 8;
#pragma unroll 8
        for (int ks = 0; ks < 32; ++ks) { const bf16x8 a = *(const bf16x8*)(ap + ks * 32), bb = *(const bf16x8*)(bp + ks * 32); acc = __builtin_amdgcn_mfma_f32_16x16x32_bf16(a, bb, acc, 0, 0, 0); }
#pragma unroll
        for (int r = 0; r < 4; ++r) GR[(size_t)(it * 16 + 4 * q4 + r) * 16 + (lane & 15)] = acc[r]; }
}

constexpr int GP = 272, GP2 = 144;
constexpr int GB_QIN = 0, GB_KST = 17408, GB_ATT = 35840, GB_VT = 45056, GB_DEC = 81920, GB_SIZE = 82944;
constexpr size_t W_GB = W_YS;
static_assert((size_t)2048 * GB_SIZE <= (size_t)PMAX * 2048, "blob region");
constexpr int GA_GRS = 0, GA_GT = 4096, GA_DEC = 6144, GA_QIN = 8192, GA_KIN = GA_QIN + 17408, GA_KST = GA_KIN + 17408, GA_ATT = GA_KST + 18432, GA_VT = GA_ATT + 9216, GA_END = GA_VT + 36864;
DEV float logsigm_fast(float z) { const float e = __builtin_amdgcn_exp2f(-1.4426950408889634f * fabsf(z)); return fminf(z, 0.f) - 0.6931471805599453f * __builtin_amdgcn_logf(1.f + e); }
DEV void p_gla_prep(Frame& F) {
    LAS unsigned char* lds = F.lds; const int tid = F.tid, lane = F.lane, wid = F.wave, q4 = lane >> 4, l15 = lane & 15;
    const bf16_t* H1 = WSP(bf16_t, W_HB); const float* GR = WSP(float, W_GR); unsigned char* GB = F.ws + W_GB;
    const float* wg2 = F.in[15]; const float* bg = F.in[16];
    for (int i = tid; i < 64 * GP2 / 4; i += 512) ((LAS unsigned*)(lds + GA_ATT))[i] = 0u;
    const int dk = tid & 127, tg = tid >> 7;
    const int dvl = tid & 255, th2 = tid >> 8;
    for (int it = F.vcu * 8; it < 2048; it += F.G * 8) {
#pragma unroll 1
      for (int sub = 0; sub < 8; ++sub) { const int item = it + sub; const int h = item & 3, n = (item >> 2) & 31, b = item >> 7;
        const size_t rb = (size_t)b * 2048 + n * 64;
        float w2[16];
#pragma unroll
        for (int r = 0; r < 16; ++r) w2[r] = wg2[r * 512 + h * 128 + dk];
        const float bgv = bg[h * 128 + dk];
        unsigned qraw[16], kraw[16], vraw[32];
#pragma unroll
        for (int i = 0; i < 16; ++i) { const size_t ro = (rb + 16 * tg + i) * 3072; qraw[i] = H1[ro + h * 128 + dk]; kraw[i] = H1[ro + 512 + h * 128 + dk]; }
#pragma unroll
        for (int i = 0; i < 32; ++i) vraw[i] = H1[(rb + 32 * th2 + i) * 3072 + 1024 + h * 256 + dvl];
        const float g0 = GR[rb * 16 + tid], g1 = GR[rb * 16 + 512 + tid];
        ((LAS float*)(lds + GA_GRS))[tid] = g0; ((LAS float*)(lds + GA_GRS))[512 + tid] = g1;
        __syncthreads();
        float cs[16]; float run = 0.f;
#pragma unroll
        for (int i = 0; i < 16; ++i) { const LAS float* gr = (const LAS float*)(lds + GA_GRS) + (16 * tg + i) * 16; float z = bgv;
#pragma unroll
            for (int r = 0; r < 16; ++r) z = fmaf(gr[r], w2[r], z);
            run += logsigm_fast(z) * (1.f / 16.f); cs[i] = run; }
        ((LAS float*)(lds + GA_GT))[tg * 128 + dk] = run;
        __syncthreads();
        float off = 0.f, btot = 0.f;
#pragma unroll
        for (int g2 = 0; g2 < 4; ++g2) { const float gtv = ((LAS float*)(lds + GA_GT))[g2 * 128 + dk]; btot += gtv; off += (g2 < tg) ? gtv : 0.f; }
        if (tg == 0) ((LAS float*)(lds + GA_DEC))[dk] = __expf(btot);
        { unsigned kst[8];
#pragma unroll
          for (int i = 0; i < 16; i += 2) { float kk[2];
#pragma unroll
              for (int u = 0; u < 2; ++u) { const int t = 16 * tg + i + u; const float bc = cs[i + u] + off; const float qv = bflo(qraw[i + u]), kv = bflo(kraw[i + u]);
                  *(LAS bf16_t*)(lds + GA_QIN + t * GP + dk * 2) = (bf16_t)(cvt_pk(qv * __expf(bc), 0.f) & 0xffffu);
                  *(LAS bf16_t*)(lds + GA_KIN + t * GP + dk * 2) = (bf16_t)(cvt_pk(kv * __expf(-bc), 0.f) & 0xffffu);
                  kk[u] = kv * __expf(btot - bc); }
              kst[i >> 1] = cvt_pk(kk[0], kk[1]); }
          *(LAS u32x4*)(lds + GA_KST + dk * GP2 + tg * 32) = (u32x4){kst[0], kst[1], kst[2], kst[3]};
          *(LAS u32x4*)(lds + GA_KST + dk * GP2 + tg * 32 + 16) = (u32x4){kst[4], kst[5], kst[6], kst[7]}; }
#pragma unroll
        for (int i = 0; i < 32; i += 8) *(LAS u32x4*)(lds + GA_VT + dvl * GP2 + (32 * th2 + i) * 2) = (u32x4){vraw[i] | (vraw[i + 1] << 16), vraw[i + 2] | (vraw[i + 3] << 16), vraw[i + 4] | (vraw[i + 5] << 16), vraw[i + 6] | (vraw[i + 7] << 16)};
        __syncthreads();
#pragma unroll
        for (int rep = 0; rep < 2; ++rep) { const int ti = wid + 8 * rep; if (ti < 10) {
            int jt, it2; if (ti < 4) { jt = 0; it2 = ti; } else if (ti < 7) { jt = 1; it2 = ti - 3; } else if (ti < 9) { jt = 2; it2 = ti - 5; } else { jt = 3; it2 = 3; }
            f32x4 a4 = {0.f, 0.f, 0.f, 0.f};
#pragma unroll
            for (int ks = 0; ks < 4; ++ks) { const bf16x8 kf = *(const LAS bf16x8*)(lds + GA_KIN + (16 * jt + l15) * GP + ks * 64 + q4 * 16), qf = *(const LAS bf16x8*)(lds + GA_QIN + (16 * it2 + l15) * GP + ks * 64 + q4 * 16);
                a4 = __builtin_amdgcn_mfma_f32_16x16x32_bf16(kf, qf, a4, 0, 0, 0); }
            const int i_ = 16 * it2 + l15, j0 = 16 * jt + 4 * q4;
            u32x2 w; w.x = cvt_pk(j0 <= i_ ? a4[0] : 0.f, j0 + 1 <= i_ ? a4[1] : 0.f); w.y = cvt_pk(j0 + 2 <= i_ ? a4[2] : 0.f, j0 + 3 <= i_ ? a4[3] : 0.f);
            *(LAS u32x2*)(lds + GA_ATT + i_ * GP2 + j0 * 2) = w; } }
        __syncthreads();
        unsigned char* blob = GB + (size_t)item * GB_SIZE;
        for (int c = tid; c < 17408 / 16; c += 512) *(u32x4*)(blob + GB_QIN + c * 16) = *(const LAS u32x4*)(lds + GA_QIN + c * 16);
        for (int c = tid; c < 18432 / 16; c += 512) *(u32x4*)(blob + GB_KST + c * 16) = *(const LAS u32x4*)(lds + GA_KST + c * 16);
        for (int c = tid; c < 9216 / 16; c += 512) *(u32x4*)(blob + GB_ATT + c * 16) = *(const LAS u32x4*)(lds + GA_ATT + c * 16);
        for (int c = tid; c < 36864 / 16; c += 512) *(u32x4*)(blob + GB_VT + c * 16) = *(const LAS u32x4*)(lds + GA_VT + c * 16);
        if (tid < 32) *(u32x4*)(blob + GB_DEC + tid * 16) = *(const LAS u32x4*)(lds + GA_DEC + tid * 16);
      }
    }
}
constexpr int GS_BUF = 55296;
constexpr int GS_QIN = 0, GS_KST = 17408, GS_ATT = 35840, GS_VT = 45056, GS_DEC = 54272;
DEV void gla_scan_item(Frame& F, int b, int h, int c4) {
    LAS unsigned char* lds = F.lds; const int lane = F.lane, wid = F.wave, q4 = lane >> 4, l15 = lane & 15;
    bf16_t* GO = WSP(bf16_t, W_GLAO); float* SS = WSP(float, W_SS); const unsigned char* GB = F.ws + W_GB;
    const int c16 = wid & 3, th = wid >> 2;
    f32x4 sacc[8];
#pragma unroll
    for (int m = 0; m < 8; ++m) sacc[m] = (f32x4){0.f, 0.f, 0.f, 0.f};
    const size_t rb = (size_t)b * 2048;
#define GS_ISSUE(n_) do { const unsigned char* blob_ = GB + (size_t)((b * 32 + (n_)) * 4 + h) * GB_SIZE; const int bo_ = ((n_) & 1) * GS_BUF; \
        for (int p_ = wid; p_ < 54; p_ += 8) { const int so_ = p_ < 44 ? p_ * 1024 : (p_ < 53 ? GB_VT + c4 * 9216 + (p_ - 44) * 1024 : GB_DEC); \
            __builtin_amdgcn_global_load_lds((const unsigned*)(blob_ + so_ + lane * 16), (LAS unsigned*)(lds + bo_ + p_ * 1024), 16, 0, 0); } } while (0)
    GS_ISSUE(0);
    for (int n = 0; n < 32; ++n) { const int t0 = n * 64;
        asm volatile("s_waitcnt vmcnt(0)" ::: "memory"); __syncthreads();
        if (n + 1 < 32) GS_ISSUE(n + 1);
        const LAS unsigned char* bu = lds + (n & 1) * GS_BUF;
        bf16x8 vf[2];
#pragma unroll
        for (int ks = 0; ks < 2; ++ks) vf[ks] = *(const LAS bf16x8*)(bu + GS_VT + (c16 * 16 + l15) * GP2 + ks * 64 + q4 * 16);
        bf16x8 sf[4];
#pragma unroll
        for (int ks = 0; ks < 4; ++ks) { const u32x4 w = {cvt_pk(sacc[2 * ks][0], sacc[2 * ks][1]), cvt_pk(sacc[2 * ks][2], sacc[2 * ks][3]), cvt_pk(sacc[2 * ks + 1][0], sacc[2 * ks + 1][1]), cvt_pk(sacc[2 * ks + 1][2], sacc[2 * ks + 1][3])}; sf[ks] = __builtin_bit_cast(bf16x8, w); }
#pragma unroll
        for (int mt = 0; mt < 2; ++mt) { const int i_ = 32 * th + 16 * mt + l15; f32x4 oa = {0.f, 0.f, 0.f, 0.f};
#pragma unroll
            for (int ks = 0; ks < 2; ++ks) { if (ks == 1 && th == 0) continue; const bf16x8 af = *(const LAS bf16x8*)(bu + GS_ATT + i_ * GP2 + ks * 64 + q4 * 16); oa = __builtin_amdgcn_mfma_f32_16x16x32_bf16(af, vf[ks], oa, 0, 0, 0); }
#pragma unroll
            for (int ks = 0; ks < 4; ++ks) { const u32x2 lo = *(const LAS u32x2*)(bu + GS_QIN + i_ * GP + (32 * ks + 4 * q4) * 2), hi2 = *(const LAS u32x2*)(bu + GS_QIN + i_ * GP + (32 * ks + 16 + 4 * q4) * 2);
                const u32x4 w = {lo.x, lo.y, hi2.x, hi2.y}; oa = __builtin_amdgcn_mfma_f32_16x16x32_bf16(__builtin_bit_cast(bf16x8, w), sf[ks], oa, 0, 0, 0); }
#pragma unroll
            for (int r = 0; r < 4; ++r) { const size_t trow = rb + t0 + 32 * th + 16 * mt + 4 * q4 + r; GO[trow * 1024 + h * 256 + c4 * 64 + c16 * 16 + l15] = (bf16_t)(cvt_pk(oa[r], 0.f) & 0xffffu);
                float sq = oa[r] * oa[r]; sq += __shfl_xor(sq, 1); sq += __shfl_xor(sq, 2); sq += __shfl_xor(sq, 4); sq += __shfl_xor(sq, 8);
                if (l15 == 0) SS[(trow * 4 + h) * 16 + c4 * 4 + c16] = sq; } }
#pragma unroll
        for (int md = 0; md < 8; ++md) { const f32x4 dc = *(const LAS f32x4*)(bu + GS_DEC + (16 * md + 4 * q4) * 4); sacc[md] = sacc[md] * dc;
#pragma unroll
            for (int ks = 0; ks < 2; ++ks) { const bf16x8 kf = *(const LAS bf16x8*)(bu + GS_KST + (16 * md + l15) * GP2 + ks * 64 + q4 * 16); sacc[md] = __builtin_amdgcn_mfma_f32_16x16x32_bf16(kf, vf[ks], sacc[md], 0, 0, 0); } }
    }
#undef GS_ISSUE
    __syncthreads();
}
DEV void p_gla_scan(Frame& F) { for (int v = F.vcu; v < 256; v += F.G) gla_scan_item(F, v >> 4, (v >> 2) & 3, v & 3); }

DEV void p_gla_norm(Frame& F) {
    const int gw = F.vcu * 8 + F.wave, NGW = F.G * 8, lane = F.lane; const bf16_t* GO = WSP(bf16_t, W_GLAO); const float* SS = WSP(float, W_SS); const bf16_t* H1 = WSP(bf16_t, W_HB); bf16_t* Y0 = WSP(bf16_t, W_Y0);
    const f32x4 nw = *(const f32x4*)(F.in[17] + lane * 4);
    for (int row = gw; row < T; row += NGW) {
#pragma unroll
        for (int h = 0; h < 4; ++h) { const float* sp = SS + ((size_t)row * 4 + h) * 16; const f32x4 a = *(const f32x4*)sp, b2 = *(const f32x4*)(sp + 4), c = *(const f32x4*)(sp + 8), d = *(const f32x4*)(sp + 12);
            const float sq = (a.x + a.y + a.z + a.w) + (b2.x + b2.y + b2.z + b2.w) + (c.x + c.y + c.z + c.w) + (d.x + d.y + d.z + d.w); const float r = 1.f / sqrtf(sq * (1.f / 256.f) + 1e-5f);
            const u32x2 o = *(const u32x2*)(GO + (size_t)row * 1024 + h * 256 + lane * 4); const u32x2 g = *(const u32x2*)(H1 + (size_t)row * 3072 + 2048 + h * 256 + lane * 4);
            const float g0 = bflo(g.x), g1 = bfhi(g.x), g2 = bflo(g.y), g3 = bfhi(g.y);
            u32x2 w; w.x = cvt_pk(bflo(o.x) * r * nw.x * g0 * fast_sigm(g0), bfhi(o.x) * r * nw.y * g1 * fast_sigm(g1)); w.y = cvt_pk(bflo(o.y) * r * nw.z * g2 * fast_sigm(g2), bfhi(o.y) * r * nw.w * g3 * fast_sigm(g3));
            *(u32x2*)(Y0 + (size_t)row * 1024 + h * 256 + lane * 4) = w; } }
}
struct FStoreScale { bf16_t* O; int ldc, c_lo, c_hi; float sc;
    DEV void operator()(const Unit&, int row, int col, f32x4 v0, f32x4 v1) const { const float s = (col >= c_lo && col < c_hi) ? sc : 1.f;
        const u32x4 w = {cvt_pk(v0[0] * s, v0[1] * s), cvt_pk(v0[2] * s, v0[3] * s), cvt_pk(v1[0] * s, v1[1] * s), cvt_pk(v1[2] * s, v1[3] * s)}; *(u32x4*)(O + (size_t)row * ldc + col) = w; } };
struct FGlu { const bf16_t* Y; bf16_t* O; const float* b;
    DEV void operator()(const Unit&, int row, int col, f32x4 v0, f32x4 v1) const { const u32x4 y = *(const u32x4*)(Y + (size_t)row * 512 + col); const f32x4 b0 = *(const f32x4*)(b + col), b1 = *(const f32x4*)(b + col + 4);
        const u32x4 w = {cvt_pk(bflo(y.x) * fast_sigm(v0[0] + b0.x), bfhi(y.x) * fast_sigm(v0[1] + b0.y)), cvt_pk(bflo(y.y) * fast_sigm(v0[2] + b0.z), bfhi(y.y) * fast_sigm(v0[3] + b0.w)),
                         cvt_pk(bflo(y.z) * fast_sigm(v1[0] + b1.x), bfhi(y.z) * fast_sigm(v1[1] + b1.y)), cvt_pk(bflo(y.w) * fast_sigm(v1[2] + b1.z), bfhi(y.w) * fast_sigm(v1[3] + b1.w))};
        *(u32x4*)(O + (size_t)row * 1024 + col) = w; } };
DEV float swiglu1(float g, float u) { g = fminf(g, 7.f); u = fminf(fmaxf(u, -7.f), 7.f); return g * fast_sigm(1.702f * g) * (u + 1.f); }
struct FSwiglu { bf16_t* ACT; const float* bgu; float sc;
    DEV void operator()(const Unit& u, int row, int col, f32x4 v0, f32x4 v1) const { v0 = v0 * sc; v1 = v1 * sc; const float* bp = bgu + (size_t)u.e * 2048 + col; const f32x4 b0 = *(const f32x4*)bp, b1 = *(const f32x4*)(bp + 4);
        u32x2 w; w.x = cvt_pk(swiglu1(v0[0] + b0.x, v0[1] + b0.y), swiglu1(v0[2] + b0.z, v0[3] + b0.w)); w.y = cvt_pk(swiglu1(v1[0] + b1.x, v1[1] + b1.y), swiglu1(v1[2] + b1.z, v1[3] + b1.w));
        *(u32x2*)(ACT + (size_t)row * 1024 + (col >> 1)) = w; } };
struct FDown { bf16_t* YS; const float* bd; const float* wgt;
    DEV void operator()(const Unit& u, int row, int col, f32x4 v0, f32x4 v1) const { const float* bp = bd + (size_t)u.e * 1024 + col; const f32x4 b0 = *(const f32x4*)bp, b1 = *(const f32x4*)(bp + 4); const float wt = wgt[row];
        const u32x4 w = {cvt_pk((v0[0] + b0.x) * wt, (v0[1] + b0.y) * wt), cvt_pk((v0[2] + b0.z) * wt, (v0[3] + b0.w) * wt), cvt_pk((v1[0] + b1.x) * wt, (v1[1] + b1.y) * wt), cvt_pk((v1[2] + b1.z) * wt, (v1[3] + b1.w) * wt)};
        *(u32x4*)(YS + (size_t)row * 1024 + col) = w; } };

constexpr int NPH = 21;
constexpr float X8_SCALE = 16.f, WGU_SCALE = 64.f;
constexpr float QSCALE0 = 0.125f * 1.4426950408889634f, QSCALE1 = 0.08838834764831845f;


#define NOINL __device__ __forceinline__
struct PA { const float* const* in; unsigned char* ws; float* out; int wave; };
#define MKFRAME extern __shared__ __attribute__((aligned(16))) unsigned char lds_[]; Frame F; F.lds = (LAS unsigned char*)lds_; F.wave = pa.wave; F.lane = (int)__builtin_amdgcn_mbcnt_hi(~0u, __builtin_amdgcn_mbcnt_lo(~0u, 0u)); F.tid = F.wave * 64 + F.lane; \
    F.G = gridDim.x; { const int bx = blockIdx.x; F.vcu = (F.G % 8 == 0) ? (bx % 8) * (F.G / 8) + bx / 8 : bx; } F.in = pa.in; F.ws = pa.ws;
template <class Fn> DEV void dense_gemm(Frame& F, const bf16_t* A, const bf16_t* Bt, int nM, int nN, int K, const Fn& fn) {
    Gemm g; g.A = A; g.Bt = Bt; g.rowmap = nullptr; g.bstride = 0; g.KB = K * 2; g.wave = F.wave;
    StaticOrder S; S.init(nM, nN, F.G, (int)blockIdx.x, nullptr);
    EpiRow8<Fn> E{fn};
    gemm_phase<false, false>(F.lds, g, S, E);
}
NOINL void ph_prologue(PA pa) { MKFRAME p0_prologue(F); }
NOINL void ph_in0(PA pa) { MKFRAME dense_gemm(F, WSP(bf16_t, W_XB), WSP(bf16_t, W_IN0), T / 256, 8, 1024, FStoreScale{WSP(bf16_t, W_HB), 2048, 512, 1024, QSCALE0}); }
NOINL void ph_kmean(PA pa) { MKFRAME p_kmean(F); }
NOINL void ph_s5moba(PA pa, int mode) { MKFRAME p_s5_moba(F, mode); }
NOINL void ph_glu(PA pa) { MKFRAME dense_gemm(F, WSP(bf16_t, W_YS5), WSP(bf16_t, W_GLU), T / 256, 2, 512, FGlu{WSP(bf16_t, W_YS5), WSP(bf16_t, W_Y0), F.in[11]}); }
NOINL void ph_out(PA pa, int layer) { MKFRAME dense_gemm(F, WSP(bf16_t, W_Y0), layer ? WSP(bf16_t, W_OUT1) : WSP(bf16_t, W_OUT0), T / 256, 4, 1024, FStoreScale{WSP(bf16_t, W_MIXB), 1024, 0, 0, 1.f}); }
NOINL void ph_in1(PA pa) { MKFRAME dense_gemm(F, WSP(bf16_t, W_XB), WSP(bf16_t, W_IN1), T / 256, 12, 1024, FStoreScale{WSP(bf16_t, W_HB), 3072, 0, 512, QSCALE1}); p_gr(F); }
NOINL void ph_glaprep(PA pa) { MKFRAME p_gla_prep(F); }
NOINL void ph_glascan(PA pa) { MKFRAME p_gla_scan(F); }
NOINL void ph_glanorm(PA pa) { MKFRAME p_gla_norm(F); }
NOINL void ph_lnrouter(PA pa, int layer) { MKFRAME
    if (layer == 0) p_ln<0, true, true, false>(F, F.in[0], nullptr, WSP(bf16_t, W_XBB), nullptr, F.in[19], F.in[20], F.in[23], F.in[24]);
    else p_ln<0, true, false, false>(F, nullptr, WSP(bf16_t, W_XB), WSP(bf16_t, W_XBB), nullptr, F.in[19] + 1024, F.in[20] + 1024, F.in[23] + (size_t)1024 * 32, F.in[24] + 32); }
NOINL void ph_sort(PA pa) { MKFRAME p_sort(F); }
NOINL void ph_gateup(PA pa, int layer) { MKFRAME const int* SORT = WSP(int, W_SORT);
    Gemm g; g.A = WSP(unsigned char, W_X8); g.Bt = WSP(unsigned char, W_GU) + (size_t)layer * 32 * 2048 * 1024; g.rowmap = nullptr; g.bstride = (size_t)2048 * 1024; g.KB = 1024; g.wave = F.wave;
    StaticOrder S; S.init(__builtin_amdgcn_readfirstlane(SORT[33]), 8, F.G, (int)blockIdx.x, SORT + 64);
    EpiRow8<FSwiglu> E{FSwiglu{WSP(bf16_t, W_ACT), F.in[26] + (size_t)layer * 32 * 2048, 1.f / (X8_SCALE * WGU_SCALE)}};
    gemm_phase<false, true>(F.lds, g, S, E); }
NOINL void ph_down(PA pa, int layer) { MKFRAME const int* SORT = WSP(int, W_SORT);
    Gemm g; g.A = WSP(bf16_t, W_ACT); g.Bt = WSP(bf16_t, W_DN) + (size_t)layer * 32 * 1024 * 1024; g.rowmap = nullptr; g.bstride = (size_t)1024 * 1024 * 2; g.KB = 2048; g.wave = F.wave;
    StaticOrder S; S.init(__builtin_amdgcn_readfirstlane(SORT[33]), 4, F.G, (int)blockIdx.x, SORT + 64);
    EpiRow8<FDown> E{FDown{WSP(bf16_t, W_YS), F.in[28] + (size_t)layer * 32 * 1024, WSP(float, R_WGT)}};
    gemm_phase<false, false>(F.lds, g, S, E); }
NOINL void ph_combine(PA pa, int layer) { MKFRAME
    if (layer == 0) p_ln<1, false, false, false>(F, nullptr, WSP(bf16_t, W_XBB), WSP(bf16_t, W_XB), nullptr, F.in[21], F.in[22], nullptr, nullptr);
    else p_ln<1, false, false, true>(F, nullptr, WSP(bf16_t, W_XBB), nullptr, pa.out, F.in[21] + 1024, F.in[22] + 1024, nullptr, nullptr); }

__global__ void __launch_bounds__(512, 2) mega(Args args) {
    extern __shared__ __attribute__((aligned(16))) unsigned char lds_[];
    LAS unsigned char* lds = (LAS unsigned char*)lds_;
    unsigned* ctl = (unsigned*)(args.ws + W_CTL);
    for (int u = threadIdx.x; u < (LDS_BYTES - LDSCTL_OFF) / 4; u += 512) ((LAS unsigned*)(lds + LDSCTL_OFF))[u] = 0u;
    __syncthreads();
    const int lo = args.ph_lo, hi = args.ph_hi;
    PA pa; pa.in = args.in; pa.ws = args.ws; pa.out = args.out; pa.wave = __builtin_amdgcn_readfirstlane(threadIdx.x >> 6);
    XcdBarrier bar; bar.bar = ctl + CW_BAR; bar.x = 0; bar.st = nullptr; bar.wave = pa.wave;
    if (hi - lo > 1) bar = xcd_barrier_post(ctl + CW_BAR, (volatile LAS unsigned*)(lds + MISC_OFF) + 8, pa.wave);
#define IN(k) (lo <= (k) && (k) < hi)
#ifdef DIAG_LO
    volatile LAS unsigned long long* tsl = (volatile LAS unsigned long long*)(lds + MISC_OFF + 128);
    if (blockIdx.x == 0 && threadIdx.x == 0) tsl[0] = __builtin_amdgcn_s_memrealtime();
#define STAMP(k) do { if (blockIdx.x == 0 && threadIdx.x == 0) tsl[(k) + 1] = __builtin_amdgcn_s_memrealtime(); } while (0)
#else
#define STAMP(k) do { } while (0)
#endif
#define SEAM(k) do { if (IN(k) && IN((k) + 1)) xcd_barrier(bar); STAMP(k); } while (0)
#ifndef REP_PHASE
#define REP_PHASE -1
#define REP_N 0
#endif
#define RUN(k, call) do { if (IN(k)) { const int nrep_ = ((k) == REP_PHASE) ? 1 + REP_N : 1; for (int r_ = 0; r_ < nrep_; ++r_) { call; if (r_ + 1 < nrep_) xcd_barrier(bar); } } } while (0)
    RUN(0, ph_prologue(pa)); SEAM(0);
    RUN(1, ph_in0(pa)); SEAM(1);
    RUN(2, ph_kmean(pa)); SEAM(2);
    if (IN(3)) { const int n30 = (REP_PHASE == 30) ? 1 + REP_N : 1, n31 = (REP_PHASE == 31) ? 1 + REP_N : 1;
        for (int r_ = 0; r_ < n30; ++r_) ph_s5moba(pa, 1);
        for (int r_ = 0; r_ < n31; ++r_) ph_s5moba(pa, 2); } SEAM(3);
    RUN(4, ph_glu(pa)); SEAM(4);
    RUN(5, ph_out(pa, 0)); SEAM(5);
    RUN(6, ph_lnrouter(pa, 0)); SEAM(6);
    RUN(7, ph_sort(pa)); SEAM(7);
    RUN(8, ph_gateup(pa, 0)); SEAM(8);
    RUN(9, ph_down(pa, 0)); SEAM(9);
    RUN(10, ph_combine(pa, 0)); SEAM(10);
    RUN(11, ph_in1(pa)); SEAM(11);
    RUN(12, ph_glaprep(pa)); SEAM(12);
    RUN(13, ph_glascan(pa)); SEAM(13);
    RUN(14, ph_glanorm(pa)); SEAM(14);
    RUN(15, ph_out(pa, 1)); SEAM(15);
    RUN(16, ph_lnrouter(pa, 1)); SEAM(16);
    RUN(17, ph_sort(pa)); SEAM(17);
    RUN(18, ph_gateup(pa, 1)); SEAM(18);
    RUN(19, ph_down(pa, 1)); SEAM(19);
    RUN(20, ph_combine(pa, 1));
#ifdef DIAG_LO
    xcd_barrier(bar); STAMP(20);
    if (blockIdx.x == 0 && threadIdx.x == 0) { const unsigned long long dtk = tsl[DIAG_HI + 1] - tsl[DIAG_LO]; const float f = (float)dtk * (0.01f / 10000.f); __hip_atomic_store(ctl + 8, __float_as_uint(f), __ATOMIC_RELAXED, __HIP_MEMORY_SCOPE_AGENT); }
    xcd_barrier(bar);
    { const float f = __uint_as_float(__hip_atomic_load(ctl + 8, __ATOMIC_RELAXED, __HIP_MEMORY_SCOPE_AGENT));
      for (size_t i = (size_t)blockIdx.x * 512 + threadIdx.x; i < (size_t)T * 1024; i += (size_t)gridDim.x * 512) args.out[i] *= (1.f + f); }
#endif
#undef IN
#undef SEAM
}

static int g_grid = 0;
static bool launch_setup(size_t ws_size) {
    if (g_grid == 0) {
        if (ws_size < W_END) { fprintf(stderr, "kernel_launch: workspace too small: %zu < %zu\n", ws_size, (size_t)W_END); g_grid = -1; return false; }
        int dev = 0, cus = 0, per_cu = 0;
        if (hipGetDevice(&dev) != hipSuccess || hipDeviceGetAttribute(&cus, hipDeviceAttributeMultiprocessorCount, dev) != hipSuccess) { g_grid = -1; return false; }
        if (hipFuncSetAttribute((const void*)mega, hipFuncAttributeMaxDynamicSharedMemorySize, LDS_BYTES) != hipSuccess) { fprintf(stderr, "kernel_launch: hipFuncSetAttribute failed\n"); g_grid = -1; return false; }
        if (hipOccupancyMaxActiveBlocksPerMultiprocessor(&per_cu, (const void*)mega, 512, LDS_BYTES) != hipSuccess || per_cu < 1) fprintf(stderr, "kernel_launch: occupancy query reports %d blocks/CU\n", per_cu);
        (void)hipGetLastError();
        g_grid = cus;
    }
    return g_grid > 0;
}
static void launch_phases(hipStream_t stream, void* const* d_in, void* d_out, void* d_ws, int lo, int hi) {
    Args a; memset(&a, 0, sizeof a);
    for (int i = 0; i < 29; ++i) a.in[i] = (const float*)d_in[i];
    a.out = (float*)d_out; a.ws = (unsigned char*)d_ws; a.ph_lo = lo; a.ph_hi = hi;
    hipLaunchKernelGGL(mega, dim3(g_grid), dim3(512), LDS_BYTES, stream, a);
}
}
extern "C" void kernel_launch(void* const* d_in, const int* in_sizes, int n_in, void* d_out, int out_size, void* d_ws, size_t ws_size, hipStream_t stream) {
    if (n_in != 29 || out_size != T * D) { fprintf(stderr, "kernel_launch: unexpected arguments (n_in %d, out_size %d)\n", n_in, out_size); return; }
    if (!fk::launch_setup(ws_size)) return;
    (void)hipMemsetAsync((char*)d_ws + fk::W_CTL, 0, fk::CTL_ZERO_BYTES, stream);
    fk::launch_phases(stream, d_in, d_out, d_ws, 0, fk::NPH);
}
```

```cpp
#include <hip/hip_runtime.h>
#include <cstdio>
#include <cstdint>
#include <cmath>
#include <cstring>
#define DEV __device__ __forceinline__
constexpr int Bn = 16, L = 2048, D = 1024, T = Bn * L;
namespace fk {
#define LAS __attribute__((address_space(3)))
#define GAS __attribute__((address_space(1)))
typedef unsigned short bf16_t;
typedef short bf16x8 __attribute__((ext_vector_type(8)));
typedef short s16x4 __attribute__((ext_vector_type(4)));
typedef float f32x2 __attribute__((ext_vector_type(2)));
typedef float f32x4 __attribute__((ext_vector_type(4)));
typedef float f32x16 __attribute__((ext_vector_type(16)));
typedef unsigned u32x2 __attribute__((ext_vector_type(2)));
typedef unsigned u32x4 __attribute__((ext_vector_type(4)));
typedef __bf16 bf16x2_t __attribute__((ext_vector_type(2)));
struct u32x4x2 { u32x4 a, b; };
DEV unsigned cvt_pk(float lo, float hi) { f32x2 v = {lo, hi}; bf16x2_t b = __builtin_convertvector(v, bf16x2_t); return __builtin_bit_cast(unsigned, b); }
DEV float bflo(unsigned w) { return __uint_as_float(w << 16); }
DEV float bfhi(unsigned w) { return __uint_as_float(w & 0xffff0000u); }
DEV float fast_sigm(float x) { return __builtin_amdgcn_rcpf(1.f + __builtin_amdgcn_exp2f(-1.4426950408889634f * x)); }
DEV float gelu_tanh(float x) { const float u = 0.7978845608028654f * (x + 0.044715f * x * x * x); return x * fast_sigm(2.f * u); }
DEV float wave_sum(float v) {
#pragma unroll
    for (int o = 1; o < 64; o <<= 1) v += __shfl_xor(v, o);
    return v; }
DEV float swap32(float x) { auto rr = __builtin_amdgcn_permlane32_swap(__float_as_uint(x), __float_as_uint(x), false, false); return __uint_as_float((__builtin_amdgcn_mbcnt_lo(~0u, 0u) >> 5) ? rr[0] : rr[1]); }

constexpr int BM = 256, BK = 64, HALF = 128, HTB = HALF * BK * 2, STAGE_BYTES = 8 * HTB, NXCD = 8, WGM = 8;
constexpr int LDS_TOK = 135168 - 2048;
constexpr int LDSCTL_OFF = 135168, MISC_OFF = LDSCTL_OFF + 320, LDS_BYTES = 163840;

DEV int lds_byte(int r, int c) { const int st = (r >> 4) * 2 + (c >> 5), rr = r & 15, cc = c & 31, ob = rr * 64 + cc * 2; return st * 1024 + (ob ^ (((ob >> 9) & 1) << 5)); }
DEV void stage_rc(int b, int& R, int& C) { const int st = b / 1024, sb = b % 1024, swz = sb ^ (((sb >> 9) & 1) << 5); R = (st >> 1) * 16 + swz / 64; C = (st & 1) * 32 + (swz % 64) / 2; }
DEV int perm32(int rho) { const int n = rho >> 4, i = rho & 15; return 8 * (i >> 2) + 4 * n + (i & 3); }

struct Unit { int pm, pn, e; };
struct Gemm { const void* A; const void* Bt; const int* rowmap; size_t bstride; int KB; int wave; };

struct StaticOrder {
    int nM, nN, nwg, G, c; const int* tile_e;
    DEV void init(int nM_, int nN_, int G_, int c_, const int* te) { nM = nM_; nN = nN_; nwg = nM * nN; G = G_; c = c_; tile_e = te; }
    DEV bool next(int i, Unit& u) const {
        const long Lx = (long)i * G + c; if (Lx >= nwg) return false;
        int wgid = (int)Lx; { const int q = nwg / NXCD, r = nwg % NXCD, xcd = wgid % NXCD, off = wgid / NXCD; wgid = (xcd < r ? xcd * (q + 1) : r * (q + 1) + (xcd - r) * q) + off; }
        const int nig = WGM * nN, gid = wgid / nig, fm = gid * WGM, gsz = (nM - fm) < WGM ? (nM - fm) : WGM;
        u.pm = fm + ((wgid % nig) % gsz); u.pn = (wgid % nig) / gsz; u.e = tile_e ? __builtin_amdgcn_readfirstlane(tile_e[u.pm]) : 0; return true;
    }
};

template <class F> struct EpiRow8 {
    static constexpr bool PERM = true; F f;
    DEV void operator()(const f32x4 (&acc)[2][2][4][2], const Unit& u, int wr, int wc, int fr, int fq) const {
        { const int ln_ = (int)__builtin_amdgcn_mbcnt_hi(~0u, __builtin_amdgcn_mbcnt_lo(~0u, 0u)); fr = ln_ & 15; fq = ln_ >> 4; }
#pragma unroll
        for (int ai = 0; ai < 2; ++ai)
#pragma unroll
            for (int m = 0; m < 4; ++m) { const int row = u.pm * BM + ai * HALF + wr * 64 + m * 16 + fr;
#pragma unroll
                for (int bj = 0; bj < 2; ++bj) f(u, row, u.pn * BM + bj * HALF + wc * 32 + 8 * fq, acc[ai][bj][m][0], acc[ai][bj][m][1]); }
    }
};

typedef int v8i_t __attribute__((ext_vector_type(8)));
typedef int v4i_t __attribute__((ext_vector_type(4)));
template <bool GATHER, bool FP8, class Epi, class Sched>
DEV void gemm_phase(LAS unsigned char* lds, const Gemm g, const Sched& S, const Epi& E) {
    const int wid = g.wave, lane = (int)__builtin_amdgcn_mbcnt_hi(~0u, __builtin_amdgcn_mbcnt_lo(~0u, 0u)), tid = wid * 64 + lane, wr = wid >> 2, wc = wid & 3, fr = lane & 15, fq = lane >> 4;
    float z0 = 0.f; asm volatile("" : "+v"(z0));
    const int KB = g.KB, nt = KB / 128;
    int R0, C2; { int C; stage_rc(tid * 16, R0, C); C2 = C * 2; }
    unsigned voffB[2]; { const int Rb = Epi::PERM ? ((R0 & ~31) + perm32(R0 & 31)) : R0; voffB[0] = (unsigned)(Rb * KB + C2); voffB[1] = voffB[0] + 64u * (unsigned)KB; }
    const unsigned kstep = 128u, hstep = (unsigned)HALF * KB, tstep = 2u * hstep;
    const unsigned ldsw = (unsigned)wid * 1024u;
    const int aoff = lds_byte(wr * 64 + fr, fq * 8); int boff = lds_byte(wc * 32 + fr, fq * 8) + 4 * HTB; asm volatile("" : "+v"(boff));
    LAS int* tokb = (LAS int*)(lds + LDS_TOK);
    const auto rsA = __builtin_amdgcn_make_buffer_rsrc((void*)g.A, 0, 0x7fffffff, 0x00020000);
    const auto rsB = __builtin_amdgcn_make_buffer_rsrc((void*)g.Bt, 0, 0x7fffffff, 0x00020000);
    const auto rsT = __builtin_amdgcn_make_buffer_rsrc((void*)(GATHER ? (const void*)g.rowmap : g.A), 0, 0x7fffffff, 0x00020000);
#define PG8_SA(b, h) (((b) * 2 + (h)) * HTB)
#define PG8_SB(b, h) ((4 + (b) * 2 + (h)) * HTB)
#define PG8_STAGE(bufoff, rs, soff, voff) do { _Pragma("unroll") for (int _i = 0; _i < 2; ++_i) { \
        if constexpr (GATHER) __builtin_amdgcn_raw_ptr_buffer_load_lds(rs, (LAS void*)(lds + (bufoff) + ldsw + _i * 8192), 16, (int)(voff)[_i], (int)(soff), 0, 0); \
        else __builtin_amdgcn_raw_ptr_buffer_load_lds(rs, (LAS void*)(lds + (bufoff) + ldsw + _i * 8192), 16, (int)(voff)[0], (int)((soff) + _i * 64u * (unsigned)KB), 0, 0); } } while (0)
#define PG8_LDA(dst, b, h) do { _Pragma("unroll") for (int m = 0; m < 4; ++m) _Pragma("unroll") for (int k = 0; k < 2; ++k) dst[m][k] = *(const LAS bf16x8*)(lds + PG8_SA(b, h) + aoff + m * 2048 + k * 1024); } while (0)
#define PG8_LDB(dst, b, h) do { _Pragma("unroll") for (int n = 0; n < 2; ++n) _Pragma("unroll") for (int k = 0; k < 2; ++k) dst[n][k] = *(const LAS bf16x8*)(lds + boff + (PG8_SB(b, h) - 4 * HTB) + n * 2048 + k * 1024); } while (0)
#define PG8_CAT(x) __builtin_shufflevector(__builtin_bit_cast(v4i_t, x[0]), __builtin_bit_cast(v4i_t, x[1]), 0, 1, 2, 3, 4, 5, 6, 7)
#define PG8_MMA(ai, bj, At, Bt) do { __builtin_amdgcn_s_setprio(1); _Pragma("unroll") for (int m = 0; m < 4; ++m) _Pragma("unroll") for (int n = 0; n < 2; ++n) { \
        if constexpr (FP8) acc[ai][bj][m][n] = __builtin_amdgcn_mfma_scale_f32_16x16x128_f8f6f4(PG8_CAT(Bt[n]), PG8_CAT(At[m]), acc[ai][bj][m][n], 0, 0, 0, 0, 0, 0); \
        else { _Pragma("unroll") for (int k = 0; k < 2; ++k) acc[ai][bj][m][n] = __builtin_amdgcn_mfma_f32_16x16x32_bf16(Bt[n][k], At[m][k], acc[ai][bj][m][n], 0, 0, 0); } } __builtin_amdgcn_s_setprio(0); } while (0)
#define PG8_WAIT_V(n) asm volatile("s_waitcnt vmcnt(" #n ")" ::: "memory")
#define PG8_WAIT_L(n) asm volatile("s_waitcnt lgkmcnt(" #n ")" ::: "memory")
#define PG8_BAR __builtin_amdgcn_s_barrier()
#define PG8_SCHED __builtin_amdgcn_sched_barrier(0)
    Unit cur, nxt; int ui = 0;
    if (!S.next(0, cur)) return;
    f32x4 acc[2][2][4][2];
#pragma unroll
    for (int a = 0; a < 2; ++a)
#pragma unroll
        for (int b = 0; b < 2; ++b)
#pragma unroll
            for (int m = 0; m < 4; ++m)
#pragma unroll
                for (int n = 0; n < 2; ++n) acc[a][b][m][n] = (f32x4){z0, z0, z0, z0};
    bf16x8 At[4][2], B0[2][2], B1[2][2];
    unsigned cA, cB = (unsigned)cur.e * (unsigned)g.bstride + (unsigned)cur.pn * tstep;
    unsigned voffA[2]; voffA[0] = (unsigned)(R0 * KB + C2); voffA[1] = voffA[0] + 64u * (unsigned)KB;
    if constexpr (GATHER) { cA = 0u;
        if (wid < 4) __builtin_amdgcn_raw_ptr_buffer_load_lds(rsT, (LAS void*)(tokb + wid * 64), 4, (wid * 64 + lane) * 4, cur.pm * (BM * 4), 0, 0);
        asm volatile("s_waitcnt vmcnt(0)" ::: "memory"); __builtin_amdgcn_s_barrier();
    } else cA = (unsigned)cur.pm * tstep;
    const unsigned hA = GATHER ? 0u : hstep;
#define PG8_OA(dst, sel, h) unsigned dst[2]; if constexpr (GATHER) { dst[0] = (unsigned)(tokb[(sel) * 256 + (h) * HALF + R0] * KB + C2); dst[1] = (unsigned)(tokb[(sel) * 256 + (h) * HALF + R0 + 64] * KB + C2); } else { dst[0] = voffA[0]; dst[1] = voffA[1]; }
    { PG8_OA(p0_, 0, 0); PG8_OA(p1_, 0, 1); PG8_STAGE(PG8_SB(0, 0), rsB, cB, voffB); PG8_STAGE(PG8_SB(0, 1), rsB, cB + hstep, voffB); PG8_STAGE(PG8_SA(0, 0), rsA, cA, p0_); PG8_STAGE(PG8_SA(0, 1), rsA, cA + hA, p1_); }
    if (wr == 1) PG8_BAR;
    PG8_WAIT_V(2); PG8_BAR;
    { PG8_OA(p0_, 0, 0); PG8_STAGE(PG8_SB(1, 0), rsB, cB + kstep, voffB); PG8_STAGE(PG8_SA(1, 0), rsA, cA + kstep, p0_); PG8_STAGE(PG8_SB(1, 1), rsB, cB + hstep + kstep, voffB); }
    PG8_WAIT_V(6); PG8_BAR;
    for (;;) {
        const bool has_next = S.next(ui + 1, nxt);
        unsigned nA = cA, nB = cB;
        if (has_next) { nB = (unsigned)nxt.e * (unsigned)g.bstride + (unsigned)nxt.pn * tstep;
            if constexpr (GATHER) { if (wid < 4) { const int ln_ = (int)__builtin_amdgcn_mbcnt_hi(~0u, __builtin_amdgcn_mbcnt_lo(~0u, 0u)); __builtin_amdgcn_raw_ptr_buffer_load_lds(rsT, (LAS void*)(tokb + ((ui + 1) & 1) * 256 + wid * 64), 4, (wid * 64 + ln_) * 4, nxt.pm * (BM * 4), 0, 0); } }
            else nA = (unsigned)nxt.pm * tstep; }
#pragma unroll 1
        for (int t = 0; t < nt; t += 2) {
            const bool last = (t == nt - 2);
            const unsigned a1 = cA + (unsigned)(t + 1) * kstep;
            const unsigned a2 = last ? nA : cA + (unsigned)(t + 2) * kstep, b2 = last ? nB : cB + (unsigned)(t + 2) * kstep;
            const unsigned a3 = a2 + kstep, b3 = b2 + kstep;
            const int selc = ui & 1, seln = (last && has_next) ? ((ui + 1) & 1) : selc;
            PG8_LDB(B0, 0, 0); PG8_LDB(B1, 0, 1); PG8_SCHED; PG8_LDA(At, 0, 0); { PG8_OA(q_, selc, 1); PG8_STAGE(PG8_SA(1, 1), rsA, a1 + hA, q_); }
            PG8_WAIT_V(8); PG8_WAIT_L(0); PG8_BAR; PG8_MMA(0, 0, At, B0); PG8_MMA(0, 1, At, B1); PG8_BAR; PG8_SCHED;
            PG8_LDA(At, 0, 1); PG8_STAGE(PG8_SB(0, 0), rsB, b2, voffB); PG8_STAGE(PG8_SB(0, 1), rsB, b2 + hstep, voffB); { PG8_OA(q_, seln, 0); PG8_STAGE(PG8_SA(0, 0), rsA, a2, q_); }
            PG8_WAIT_V(8); PG8_WAIT_L(0); PG8_BAR; PG8_MMA(1, 0, At, B0); PG8_MMA(1, 1, At, B1); PG8_BAR; PG8_SCHED;
            PG8_LDB(B0, 1, 0); PG8_LDB(B1, 1, 1); PG8_SCHED; PG8_LDA(At, 1, 0); { PG8_OA(q_, seln, 1); PG8_STAGE(PG8_SA(0, 1), rsA, a2 + hA, q_); }
            PG8_WAIT_V(8); PG8_WAIT_L(0); PG8_BAR; PG8_MMA(0, 0, At, B0); PG8_MMA(0, 1, At, B1); PG8_BAR; PG8_SCHED;
            PG8_LDA(At, 1, 1); PG8_STAGE(PG8_SB(1, 0), rsB, b3, voffB); PG8_STAGE(PG8_SB(1, 1), rsB, b3 + hstep, voffB); { PG8_OA(q_, seln, 0); PG8_STAGE(PG8_SA(1, 0), rsA, a3, q_); }
            PG8_WAIT_V(8); PG8_WAIT_L(0); PG8_BAR; PG8_MMA(1, 0, At, B0); PG8_MMA(1, 1, At, B1); PG8_BAR; PG8_SCHED;
        }
        if (wr == 0) PG8_BAR;
        E(acc, cur, wr, wc, fr, fq);
        if (!has_next) break;
#pragma unroll
        for (int a = 0; a < 2; ++a)
#pragma unroll
            for (int b = 0; b < 2; ++b)
#pragma unroll
                for (int m = 0; m < 4; ++m)
#pragma unroll
                    for (int n = 0; n < 2; ++n) acc[a][b][m][n] = (f32x4){z0, z0, z0, z0};
        cur = nxt; cA = nA; cB = nB; ++ui;
        if (wr == 1) PG8_BAR;
    }
    PG8_WAIT_V(0);
    PG8_BAR;
#undef PG8_SA
#undef PG8_SB
#undef PG8_STAGE
#undef PG8_OA
#undef PG8_LDA
#undef PG8_LDB
#undef PG8_MMA
#undef PG8_CAT
#undef PG8_WAIT_V
#undef PG8_WAIT_L
#undef PG8_BAR
#undef PG8_SCHED
}

typedef GAS unsigned gu32;
#define XB_TMO      128
#define XB_XCNT(j)  (256  + 64 * (j))
#define XB_XSUB(j)  (1280 + 64 * (j))
#define XB_XGEN(j)  (2304 + 64 * (j))
#define XB_TOP      3328
#define XB_TOPGEN   3392
#define XCD_BAR_WORDS 3456
#define XB_SPIN_CAP (1u << 20)
DEV unsigned xb_ld(unsigned* p) { return __hip_atomic_load(p, __ATOMIC_RELAXED, __HIP_MEMORY_SCOPE_AGENT); }
DEV unsigned xb_add(unsigned* p, unsigned v) { return __hip_atomic_fetch_add(p, v, __ATOMIC_RELAXED, __HIP_MEMORY_SCOPE_AGENT); }
DEV unsigned xb_xcc_id() { return (unsigned)__builtin_amdgcn_s_getreg((3 << 11) | 20) & 0xFu; }
#define XB_SPIN(cond, bar) do { unsigned _sp = 0; while (cond) { __builtin_amdgcn_s_sleep(1); \
    if ((++_sp & 255u) == 0u) { if (xb_ld(&(bar)[XB_TMO])) break; if (_sp > XB_SPIN_CAP) { atomicAdd(&(bar)[XB_TMO], 1u); break; } } } } while (0)
struct XcdBarrier { unsigned* bar; unsigned x; volatile LAS unsigned* st; int wave; };
DEV bool xb_thread0(int wave) { return wave == 0 && __builtin_amdgcn_mbcnt_hi(~0u, __builtin_amdgcn_mbcnt_lo(~0u, 0u)) == 0u; }
DEV XcdBarrier xcd_barrier_post(unsigned* bar, volatile LAS unsigned* st, int wave) {
    XcdBarrier b; b.bar = bar; b.x = xb_xcc_id(); b.st = st; b.wave = wave;
    if (xb_thread0(wave)) (void)xb_add(&bar[XB_XCNT(b.x)], 1u);
    return b;
}
DEV void xcd_barrier_complete(unsigned* bar, unsigned x, unsigned& nloc, unsigned& nx) {
    const unsigned G = gridDim.x * gridDim.y * gridDim.z;
    unsigned sum, cnt, mine, sp = 0u;
    for (;;) {
        sum = 0u; cnt = 0u; mine = 0u;
#pragma unroll
        for (unsigned j = 0; j < 16; ++j) { const unsigned c = xb_ld(&bar[XB_XCNT(j)]); sum += c; cnt += (c > 0u) ? 1u : 0u; mine = (j == x) ? c : mine; }
        if (sum == G) break;
        __builtin_amdgcn_s_sleep(1);
        if ((++sp & 255u) == 0u) { if (xb_ld(&bar[XB_TMO])) break; if (sp > XB_SPIN_CAP) { atomicAdd(&bar[XB_TMO], 1u); break; } }
    }
    nloc = mine > 0u ? mine : 1u; nx = cnt > 0u ? cnt : 1u;
}
DEV void xcd_barrier(const XcdBarrier& b) {
    asm volatile("s_waitcnt vmcnt(0)" ::: "memory");
    __syncthreads();
    if (xb_thread0(b.wave)) {
        unsigned* bar = b.bar;
        __builtin_amdgcn_s_waitcnt(0);
        unsigned nloc = b.st[0], nx = b.st[1];
        if (nloc == 0u) { xcd_barrier_complete(bar, b.x, nloc, nx); b.st[0] = nloc; b.st[1] = nx; }
        const unsigned old = xb_add(&bar[XB_XSUB(b.x)], 1u);
        const unsigned gen = old / nloc;
        if (old + 1u == (gen + 1u) * nloc) {
            __builtin_amdgcn_fence(__ATOMIC_RELEASE, "agent");
            asm volatile("s_waitcnt vmcnt(0)" ::: "memory");
            const unsigned og = xb_add(&bar[XB_TOP], 1u);
            const unsigned tg = og / nx;
            if (og + 1u == (tg + 1u) * nx) xb_add(&bar[XB_TOPGEN], 1u);
            else XB_SPIN(xb_ld(&bar[XB_TOPGEN]) == tg, bar);
            __builtin_amdgcn_fence(__ATOMIC_ACQUIRE, "agent");
            xb_add(&bar[XB_XGEN(b.x)], 1u);
            asm volatile("s_waitcnt vmcnt(0)" ::: "memory");
        } else {
            XB_SPIN(xb_ld(&bar[XB_XGEN(b.x)]) == gen, bar);
            __builtin_amdgcn_fence(__ATOMIC_ACQUIRE, "agent");
            asm volatile("s_waitcnt vmcnt(0)" ::: "memory");
        }
    }
    __syncthreads();
}
constexpr size_t MiB = 1u << 20;
constexpr int PMAX = 131072 + 32 * 256;
constexpr size_t W_CTL = 0, CTL_ZERO_BYTES = 1 * MiB;
constexpr size_t W_IN0 = 2 * MiB, W_GLU = 6 * MiB, W_OUT0 = 7 * MiB, W_IN1 = 9 * MiB, W_OUT1 = 16 * MiB;
constexpr size_t W_LUT = 18 * MiB, W_KM = W_LUT + 64 * 1024, W_HIST = W_KM + 256 * 1024, W_SORT = W_HIST + 64 * 1024  , W_GR = 20 * MiB  , W_SS = 22 * MiB  ;
constexpr size_t W_GU = 32 * MiB, W_DN = 288 * MiB, W_XB = 416 * MiB  , W_XBB = 480 * MiB  , W_X8 = 1024 * MiB  , W_HB = 736 * MiB, W_YS5 = 928 * MiB, W_Y0 = 960 * MiB, W_MIXB = 1024 * MiB, W_GLAO = 1088 * MiB;
constexpr size_t W_ROUTE = 26 * MiB  , W_ACT = 736 * MiB  , W_YS = 1160 * MiB, W_END = 1432 * MiB;
static_assert(W_ACT + (size_t)PMAX * 2048 <= W_MIXB && W_YS + (size_t)PMAX * 2048 <= W_END && W_X8 + (size_t)PMAX * 1024 <= W_YS && W_ROUTE + 4 * MiB <= W_GU, "ws map");
constexpr int CW_BAR = 4096;

struct Args { const float* in[29]; float* out; unsigned char* ws; int ph_lo, ph_hi; };
struct Frame {
    LAS unsigned char* lds; int tid, lane, wave, vcu, G;
    const float* const* in; unsigned char* ws;
};
#define WSP(T_, off) ((T_*)(F.ws + (off)))

DEV void transpose_item(const float* W, int K, int N, bf16_t* WT, LAS float* scr, int item, int lane) {
    const int nblk = N / 64, kb = item / nblk, nb = item % nblk, k0 = 64 * kb, n0 = 64 * nb;
    const float* src = W + (size_t)k0 * N + n0 + lane;
#pragma unroll 16
    for (int kk = 0; kk < 64; ++kk) scr[kk * 65 + lane] = src[(size_t)kk * N];
    asm volatile("s_waitcnt lgkmcnt(0)" ::: "memory");
    const int c = lane & 7;
#pragma unroll
    for (int j = 0; j < 8; ++j) { const int n = (lane >> 3) + 8 * j; const LAS float* s = scr + (8 * c) * 65 + n;
        u32x4 o; o.x = cvt_pk(s[0 * 65], s[1 * 65]); o.y = cvt_pk(s[2 * 65], s[3 * 65]); o.z = cvt_pk(s[4 * 65], s[5 * 65]); o.w = cvt_pk(s[6 * 65], s[7 * 65]);
        *(u32x4*)(WT + (size_t)(n0 + n) * K + k0 + 8 * c) = o; }
    asm volatile("s_waitcnt lgkmcnt(0)" ::: "memory");
}
DEV unsigned pk4_fp8(float a, float b, float c, float d) { unsigned w = 0u; w = __builtin_amdgcn_cvt_pk_fp8_f32(a, b, w, false); w = __builtin_amdgcn_cvt_pk_fp8_f32(c, d, w, true); return w; }
DEV void transpose_item_fp8(const float* W, int K, int N, unsigned char* WT, LAS float* scr, int item, int lane, float sc) {
    const int nblk = N / 64, kb = item / nblk, nb = item % nblk, k0 = 64 * kb, n0 = 64 * nb;
    const float* src = W + (size_t)k0 * N + n0 + lane;
#pragma unroll 16
    for (int kk = 0; kk < 64; ++kk) scr[kk * 65 + lane] = src[(size_t)kk * N] * sc;
    asm volatile("s_waitcnt lgkmcnt(0)" ::: "memory");
    const int c = lane & 7;
#pragma unroll
    for (int j = 0; j < 8; ++j) { const int n = (lane >> 3) + 8 * j; const LAS float* s = scr + (8 * c) * 65 + n;
        u32x2 o; o.x = pk4_fp8(s[0 * 65], s[1 * 65], s[2 * 65], s[3 * 65]); o.y = pk4_fp8(s[4 * 65], s[5 * 65], s[6 * 65], s[7 * 65]);
        *(u32x2*)(WT + (size_t)(n0 + n) * K + k0 + 8 * c) = o; }
    asm volatile("s_waitcnt lgkmcnt(0)" ::: "memory");
}
__constant__ int BUCKET_TH2[16] = {16, 22, 30, 40, 54, 73, 99, 134, 182, 246, 332, 450, 609, 825, 1117, 1513};
DEV void p0_prologue(Frame& F) {
    LAS float* scr = (LAS float*)(F.lds + F.wave * 16640);
    const int gw = F.vcu * 8 + F.wave, NGW = F.G * 8;
    constexpr int I_GU = 16 * 32, I_DN = 16 * 16, I_IN0 = 16 * 32, I_GLU = 8 * 8, I_O = 16 * 16, I_IN1 = 16 * 48;
    constexpr int N_GU = 64 * I_GU, N_DN = 64 * I_DN;
    constexpr int NITEMS = N_GU + N_DN + I_IN0 + I_GLU + 2 * I_O + I_IN1;
    for (int it = gw; it < NITEMS; it += NGW) {
        int r = it;
        if (r < N_GU) { const int m = r / I_GU; transpose_item_fp8(F.in[25] + (size_t)m * 1024 * 2048, 1024, 2048, WSP(unsigned char, W_GU) + (size_t)m * 2048 * 1024, scr, r % I_GU, F.lane, 64.f); continue; } r -= N_GU;
        if (r < N_DN) { const int m = r / I_DN; transpose_item_fp8(F.in[27] + (size_t)m * 1024 * 1024, 1024, 1024, WSP(unsigned char, W_DN) + (size_t)m * 1024 * 1024, scr, r % I_DN, F.lane, 128.f); continue; } r -= N_DN;
        if (r < I_IN0) { transpose_item(F.in[1], 1024, 2048, WSP(bf16_t, W_IN0), scr, r, F.lane); continue; } r -= I_IN0;
        if (r < I_GLU) { transpose_item(F.in[10], 512, 512, WSP(bf16_t, W_GLU), scr, r, F.lane); continue; } r -= I_GLU;
        if (r < I_O) { transpose_item(F.in[13], 1024, 1024, WSP(bf16_t, W_OUT0), scr, r, F.lane); continue; } r -= I_O;
        if (r < I_O) { transpose_item(F.in[18], 1024, 1024, WSP(bf16_t, W_OUT1), scr, r, F.lane); continue; } r -= I_O;
        { const int kb = r / 48, nb = r % 48; const float* src = F.in[14] + (size_t)(64 * kb) * 3088 + 64 * nb + F.lane;
#pragma unroll 16
          for (int kk = 0; kk < 64; ++kk) scr[kk * 65 + F.lane] = src[(size_t)kk * 3088];
          asm volatile("s_waitcnt lgkmcnt(0)" ::: "memory");
          const int c = F.lane & 7;
#pragma unroll
          for (int j = 0; j < 8; ++j) { const int n = (F.lane >> 3) + 8 * j; const LAS float* s = scr + (8 * c) * 65 + n;
              u32x4 o; o.x = cvt_pk(s[0 * 65], s[1 * 65]); o.y = cvt_pk(s[2 * 65], s[3 * 65]); o.z = cvt_pk(s[4 * 65], s[5 * 65]); o.w = cvt_pk(s[6 * 65], s[7 * 65]);
              *(u32x4*)(WSP(bf16_t, W_IN1) + (size_t)(64 * nb + n) * 1024 + 64 * kb + 8 * c) = o; }
          asm volatile("s_waitcnt lgkmcnt(0)" ::: "memory"); }
    }
    const int gt = F.vcu * 512 + F.tid, NGT = F.G * 512;
    for (int i = gt; i < 16 * 1024; i += NGT) { const int n = i >> 10, k = i & 1023; WSP(bf16_t, W_IN1)[(size_t)(3072 + n) * 1024 + k] = (bf16_t)(cvt_pk(F.in[14][(size_t)k * 3088 + 3072 + n], 0.f) & 0xffffu); }
    { const f32x4* x4 = (const f32x4*)F.in[0]; u32x2* o = WSP(u32x2, W_XB);
      for (size_t i = gt; i < (size_t)T * 1024 / 4; i += NGT) { const f32x4 v = x4[i]; u32x2 w; w.x = cvt_pk(v.x, v.y); w.y = cvt_pk(v.z, v.w); o[i] = w; } }
    for (int i = gt; i < 8 * 2048; i += NGT) { const int h = i >> 11, n = i & 2047; int bk = n;
        if (n >= 16) { bk = 16;
#pragma unroll
            for (int q = 1; q < 16; ++q) bk += (n >= BUCKET_TH2[q]) ? 1 : 0; }
        WSP(float, W_LUT)[i] = F.in[12][bk * 8 + h] * 1.4426950408889634f; }
}

DEV void p_kmean(Frame& F) {
    const int gw = F.vcu * 8 + F.wave, NGW = F.G * 8; const bf16_t* H0 = WSP(bf16_t, W_HB); float* KM = WSP(float, W_KM);
    for (int it = gw; it < 1024; it += NGW) { const int blk = it & 7, h = (it >> 3) & 7, b = it >> 6; const int r8 = F.lane >> 3, c = F.lane & 7;
        const bf16_t* p = H0 + (size_t)(b * 2048 + blk * 256 + r8) * 2048 + 1024 + h * 64 + c * 8; float s[8];
#pragma unroll
        for (int j = 0; j < 8; ++j) s[j] = 0.f;
#pragma unroll 8
        for (int i = 0; i < 32; ++i) { const u32x4 v = *(const u32x4*)(p + (size_t)i * 8 * 2048);
            s[0] += bflo(v.x); s[1] += bfhi(v.x); s[2] += bflo(v.y); s[3] += bfhi(v.y); s[4] += bflo(v.z); s[5] += bfhi(v.z); s[6] += bflo(v.w); s[7] += bfhi(v.w); }
#pragma unroll
        for (int j = 0; j < 8; ++j) { s[j] += __shfl_xor(s[j], 8); s[j] += __shfl_xor(s[j], 16); s[j] += __shfl_xor(s[j], 32); }
        if (F.lane < 8) {
#pragma unroll
            for (int j = 0; j < 8; ++j) KM[(size_t)it * 64 + c * 8 + j] = s[j] * (1.f / 256.f); } }
}

DEV void s5_item(Frame& F, int b, int g, LAS unsigned char* sl  ) {
    const int lane = F.lane, p0 = lane & 31, hi = lane >> 5, q4 = lane >> 4;
    const float* lam_re = F.in[2]; const float* lam_im = F.in[3]; const float* log_dt = F.in[4]; const float* b_re = F.in[5]; const float* b_im = F.in[6];
    const float* c_re = F.in[7]; const float* c_im = F.in[8]; const float* dsk = F.in[9];
    const bf16_t* H0 = WSP(bf16_t, W_HB); bf16_t* YS = WSP(bf16_t, W_YS5);
    const float dt = __expf(log_dt[g]);
    float ar[2], ai[2]; bf16x8 bfr[4];
#pragma unroll
    for (int s = 0; s < 2; ++s) { const int p = p0 + 32 * s; const float lr = lam_re[g * 64 + p], li = lam_im[g * 64 + p]; const float mag = __expf(lr * dt);
        ar[s] = mag * cosf(li * dt); ai[s] = mag * sinf(li * dt);
        const float er = ar[s] - 1.f, ei = ai[s], den = lr * lr + li * li; const float qr = (er * lr + ei * li) / den, qi = (ei * lr - er * li) / den;
        u32x4 wr_, wi_; float vr[8], vi[8];
#pragma unroll
        for (int j = 0; j < 8; ++j) { const float br = b_re[(g * 64 + p) * 16 + 8 * hi + j], bi = b_im[(g * 64 + p) * 16 + 8 * hi + j]; vr[j] = qr * br - qi * bi; vi[j] = qr * bi + qi * br; }
        wr_.x = cvt_pk(vr[0], vr[1]); wr_.y = cvt_pk(vr[2], vr[3]); wr_.z = cvt_pk(vr[4], vr[5]); wr_.w = cvt_pk(vr[6], vr[7]);
        wi_.x = cvt_pk(vi[0], vi[1]); wi_.y = cvt_pk(vi[2], vi[3]); wi_.z = cvt_pk(vi[4], vi[5]); wi_.w = cvt_pk(vi[6], vi[7]);
        bfr[2 * s] = __builtin_bit_cast(bf16x8, wr_); bfr[2 * s + 1] = __builtin_bit_cast(bf16x8, wi_); }
    bf16x8 cfr[4];
#pragma unroll
    for (int ks = 0; ks < 4; ++ks) { float v[8];
#pragma unroll
        for (int j = 0; j < 8; ++j) { const int c = 32 * ks + 8 * q4 + j, p = c >> 1; const int h = lane & 15; v[j] = (c & 1) ? -c_im[(g * 16 + h) * 64 + p] : c_re[(g * 16 + h) * 64 + p]; }
        u32x4 w; w.x = cvt_pk(v[0], v[1]); w.y = cvt_pk(v[2], v[3]); w.z = cvt_pk(v[4], v[5]); w.w = cvt_pk(v[6], v[7]); cfr[ks] = __builtin_bit_cast(bf16x8, w); }
    float dv[4];
#pragma unroll
    for (int r = 0; r < 4; ++r) dv[r] = dsk[g * 16 + 4 * q4 + r];
    const int tm = 16 * ((p0 >> 2) & 1) + 4 * (p0 >> 3) + (p0 & 3);
    const bf16_t* urow = H0 + (size_t)(b * 2048 + tm) * 2048 + g * 16 + 8 * hi;
    float cr[2] = {0.f, 0.f}, ci[2] = {0.f, 0.f};
    bf16x8 ufr = *(const bf16x8*)urow;
    for (int tile = 0; tile < 64; ++tile) {
        const bf16x8 ucur = ufr;
        if (tile + 1 < 64) ufr = *(const bf16x8*)(urow + (size_t)(tile + 1) * 32 * 2048);
        f32x16 x[4];
#pragma unroll
        for (int n = 0; n < 4; ++n) { f32x16 z;
#pragma unroll
            for (int r = 0; r < 16; ++r) z[r] = 0.f;
            x[n] = __builtin_amdgcn_mfma_f32_32x32x16_bf16(ucur, bfr[n], z, 0, 0, 0); }
#pragma unroll
        for (int s = 0; s < 2; ++s) {
            f32x16& xr = x[2 * s]; f32x16& xi = x[2 * s + 1];
            float sr = hi ? 0.f : cr[s], si = hi ? 0.f : ci[s];
#pragma unroll
            for (int r = 0; r < 16; ++r) { const float nr = ar[s] * sr - ai[s] * si + xr[r], ni = ar[s] * si + ai[s] * sr + xi[r]; xr[r] = nr; xi[r] = ni; sr = nr; si = ni; }
            const float o_r = swap32(sr), o_i = swap32(si);
            float wr_ = hi ? o_r : 0.f, wi_ = hi ? o_i : 0.f;
#pragma unroll
            for (int r = 0; r < 16; ++r) { const float nr = ar[s] * wr_ - ai[s] * wi_, ni = ar[s] * wi_ + ai[s] * wr_; wr_ = nr; wi_ = ni; xr[r] += wr_; xi[r] += wi_; }
            const float e_r = swap32(xr[15]), e_i = swap32(xi[15]);
            cr[s] = hi ? xr[15] : e_r; ci[s] = hi ? xi[15] : e_i;
#pragma unroll
            for (int r = 0; r < 16; ++r) *(LAS unsigned*)(sl + (16 * hi + r) * 256 + (p0 + 32 * s) * 4) = cvt_pk(xr[r], xi[r]);
        }
#pragma unroll
        for (int tt = 0; tt < 2; ++tt) {
            f32x4 y = {0.f, 0.f, 0.f, 0.f};
#pragma unroll
            for (int ks = 0; ks < 4; ++ks) { const bf16x8 sf = *(const LAS bf16x8*)(sl + (16 * tt + (lane & 15)) * 256 + ks * 64 + q4 * 16); y = __builtin_amdgcn_mfma_f32_16x16x32_bf16(cfr[ks], sf, y, 0, 0, 0); }
            const int t = tile * 32 + 16 * tt + (lane & 15);
            const u32x2 uw = *(const u32x2*)(H0 + (size_t)(b * 2048 + t) * 2048 + g * 16 + 4 * q4);
            const float y0 = gelu_tanh(y[0] + dv[0] * bflo(uw.x)), y1 = gelu_tanh(y[1] + dv[1] * bfhi(uw.x)), y2 = gelu_tanh(y[2] + dv[2] * bflo(uw.y)), y3 = gelu_tanh(y[3] + dv[3] * bfhi(uw.y));
            u32x2 ow; ow.x = cvt_pk(y0, y1); ow.y = cvt_pk(y2, y3);
            *(u32x2*)(YS + (size_t)(b * 2048 + t) * 512 + g * 16 + 4 * q4) = ow;
        }
    }
}

constexpr int AT_K = 0, AT_V = 16384, AT_LUT = 32768, AT_WS = 40960, AT_OST = 43008, AT_END = AT_OST + 8 * 4096;
DEV int crow(int r, int hi) { return (r & 3) + 8 * (r >> 2) + 4 * hi; }
DEV s16x4 vtr(const LAS unsigned char* p) { typedef short v4i16_t __attribute__((ext_vector_type(4))); return __builtin_bit_cast(s16x4, __builtin_amdgcn_ds_read_tr16_b64_v4i16((LAS v4i16_t*)p)); }
DEV void moba_unit(Frame& F, int b, int h, int own) {
    const int lane = F.lane, wid = F.wave, r32 = lane & 31, hi = lane >> 5;
    LAS unsigned char* lds = F.lds;
    const bf16_t* H0 = WSP(bf16_t, W_HB); const float* KM = WSP(float, W_KM);
    LAS float* lut = (LAS float*)(lds + AT_LUT); LAS float* wsf = (LAS float*)(lds + AT_WS) + wid * 64;
    const size_t rowbase = (size_t)b * 2048;
    const int qpos = own * 256 + wid * 32 + r32;
    bf16x8 qr[4];
#pragma unroll
    for (int d0 = 0; d0 < 4; ++d0) qr[d0] = *(const bf16x8*)(H0 + (rowbase + qpos) * 2048 + 512 + h * 64 + d0 * 16 + hi * 8);
    unsigned selmask = 0u;
    if (own > 0) {
        float gate[7];
#pragma unroll
        for (int j = 0; j < 7; ++j) { float s = 0.f;
            if (j < own) { const float* km = KM + ((size_t)(b * 8 + h) * 8 + j) * 64 + hi * 8;
#pragma unroll
                for (int d0 = 0; d0 < 4; ++d0) { const f32x4 k0 = *(const f32x4*)(km + d0 * 16), k1 = *(const f32x4*)(km + d0 * 16 + 4); const u32x4 qw = __builtin_bit_cast(u32x4, qr[d0]);
                    s += bflo(qw.x) * k0.x + bfhi(qw.x) * k0.y + bflo(qw.y) * k0.z + bfhi(qw.y) * k0.w + bflo(qw.z) * k1.x + bfhi(qw.z) * k1.y + bflo(qw.w) * k1.z + bfhi(qw.w) * k1.w; } }
            gate[j] = s + swap32(s); }
#pragma unroll
        for (int j = 0; j < 7; ++j) { int rank = 0;
#pragma unroll
            for (int j2 = 0; j2 < 7; ++j2) if (j2 != j && j2 < own && (gate[j2] > gate[j] || (gate[j2] == gate[j] && j2 < j))) ++rank;
            if (j < own && rank < 3) selmask |= 1u << j; }
    }
    const int NT = 4 * (own + 1);
#define KV0(i) ((i) < 4 ? own * 256 + (i) * 64 : (((i) - 4) >> 2) * 256 + (((i) - 4) & 3) * 64)
    const bf16_t* kbase = H0 + (rowbase + lane) * 2048 + 1024 + h * 64 + wid * 8;
    const bf16_t* vbase = H0 + (rowbase + 16 * (wid & 3) + (lane >> 2)) * 2048 + 1536 + h * 64 + (wid >> 2) * 32 + (lane & 3) * 8;
#define LOADKV(i) do { const int kv0_ = KV0(i); const int bo_ = ((i) & 1) * 8192; \
        __builtin_amdgcn_global_load_lds((const unsigned*)(kbase + (size_t)kv0_ * 2048), (LAS unsigned*)(lds + AT_K + bo_ + wid * 1024), 16, 0, 0); \
        __builtin_amdgcn_global_load_lds((const unsigned*)(vbase + (size_t)kv0_ * 2048), (LAS unsigned*)(lds + AT_V + bo_ + wid * 1024), 16, 0, 0); } while (0)
    LOADKV(0);
    float m_run = -INFINITY, l_run = 0.f; f32x16 o[2];
#pragma unroll
    for (int r = 0; r < 16; ++r) { o[0][r] = 0.f; o[1][r] = 0.f; }
    asm volatile("s_waitcnt vmcnt(0)" ::: "memory"); __syncthreads();
    for (int i = 0; i < NT; ++i) {
        if (i + 1 < NT) LOADKV(i + 1);
        const int kv0 = KV0(i); const int bo = (i & 1) * 8192;
        const bool rowsel = (i < 4) || ((selmask >> ((i - 4) >> 2)) & 1u);
        f32x16 p0, p1;
#pragma unroll
        for (int r = 0; r < 16; ++r) { p0[r] = 0.f; p1[r] = 0.f; }
        { const LAS unsigned char* kb = lds + AT_K + bo + hi * 1024 + r32 * 16;
#pragma unroll
          for (int d0 = 0; d0 < 4; ++d0) { const bf16x8 k0 = *(const LAS bf16x8*)(kb + d0 * 2048), k1 = *(const LAS bf16x8*)(kb + d0 * 2048 + 512);
              p0 = __builtin_amdgcn_mfma_f32_32x32x16_bf16(k0, qr[d0], p0, 0, 0, 0); p1 = __builtin_amdgcn_mfma_f32_32x32x16_bf16(k1, qr[d0], p1, 0, 0, 0); } }
        const int dbase = qpos - kv0 - 4 * hi;
        float rmax = -INFINITY;
#pragma unroll
        for (int r = 0; r < 16; ++r) { const int d0_ = dbase - ((r & 3) + 8 * (r >> 2)); const int d1_ = d0_ - 32;
            const float b0 = lut[d0_ < 0 ? 0 : d0_], b1 = lut[d1_ < 0 ? 0 : d1_];
            p0[r] = (rowsel && d0_ >= 0) ? p0[r] + b0 : -INFINITY; p1[r] = (rowsel && d1_ >= 0) ? p1[r] + b1 : -INFINITY;
            rmax = fmaxf(rmax, fmaxf(p0[r], p1[r])); }
        rmax = fmaxf(rmax, swap32(rmax));
        const float m_new = fmaxf(m_run, rmax);
        const float msafe = (m_new == -INFINITY) ? 0.f : m_new;
        const float alpha = __builtin_amdgcn_exp2f(m_run - msafe);
        m_run = m_new;
        float rs = 0.f;
#pragma unroll
        for (int r = 0; r < 16; ++r) { p0[r] = __builtin_amdgcn_exp2f(p0[r] - msafe); p1[r] = __builtin_amdgcn_exp2f(p1[r] - msafe); rs += p0[r] + p1[r]; }
        l_run = l_run * alpha + rs;
        if (__any(alpha != 1.f)) { if (hi == 0) wsf[r32] = alpha;
#pragma unroll
            for (int r = 0; r < 16; ++r) { const float f = wsf[crow(r, hi)]; o[0][r] *= f; o[1][r] *= f; } }
        u32x4 pw[4];
        pw[0] = (u32x4){cvt_pk(p0[0], p0[1]), cvt_pk(p0[2], p0[3]), cvt_pk(p0[4], p0[5]), cvt_pk(p0[6], p0[7])};
        pw[1] = (u32x4){cvt_pk(p0[8], p0[9]), cvt_pk(p0[10], p0[11]), cvt_pk(p0[12], p0[13]), cvt_pk(p0[14], p0[15])};
        pw[2] = (u32x4){cvt_pk(p1[0], p1[1]), cvt_pk(p1[2], p1[3]), cvt_pk(p1[4], p1[5]), cvt_pk(p1[6], p1[7])};
        pw[3] = (u32x4){cvt_pk(p1[8], p1[9]), cvt_pk(p1[10], p1[11]), cvt_pk(p1[12], p1[13]), cvt_pk(p1[14], p1[15])};
        { const LAS unsigned char* vp = lds + AT_V + bo + ((lane >> 4) & 1) * 32 + (lane & 3) * 8 + (4 * hi + ((lane & 15) >> 2)) * 64;
#pragma unroll
          for (int d0 = 0; d0 < 2; ++d0)
#pragma unroll
              for (int ks = 0; ks < 4; ++ks) { const s16x4 lo = vtr(vp + d0 * 4096 + ks * 1024), hh = vtr(vp + d0 * 4096 + ks * 1024 + 512);
                  const bf16x8 vf = (bf16x8){lo[0], lo[1], lo[2], lo[3], hh[0], hh[1], hh[2], hh[3]};
                  o[d0] = __builtin_amdgcn_mfma_f32_32x32x16_bf16(__builtin_bit_cast(bf16x8, pw[ks]), vf, o[d0], 0, 0, 0); } }
        asm volatile("s_waitcnt vmcnt(0)" ::: "memory"); __syncthreads();
    }
#undef KV0
#undef LOADKV
    l_run += swap32(l_run);
    if (hi == 0) wsf[32 + r32] = 1.f / l_run;
    bf16_t* Ow = WSP(bf16_t, W_Y0) + (rowbase + own * 256 + wid * 32) * 1024 + 512 + h * 64;
    LAS bf16_t* stg = (LAS bf16_t*)(lds + AT_OST) + wid * 2048;
#pragma unroll
    for (int r = 0; r < 16; ++r) { const int orow = crow(r, hi); const float rl = wsf[32 + orow];
        stg[orow * 64 + r32] = (bf16_t)(cvt_pk(o[0][r] * rl, 0.f) & 0xffffu); stg[orow * 64 + 32 + r32] = (bf16_t)(cvt_pk(o[1][r] * rl, 0.f) & 0xffffu); }
#pragma unroll
    for (int i = 0; i < 4; ++i) { const int row = i * 8 + (lane >> 3), ch = lane & 7; const u32x4 v = *(const LAS u32x4*)(stg + row * 64 + ch * 8); *(u32x4*)(Ow + (size_t)row * 1024 + ch * 8) = v; }
    __syncthreads();
}
DEV void p_s5_moba(Frame& F, int mode) {
    if (mode & 1) { for (int it = F.vcu * 2 + (F.wave & 1); it < 512; it += F.G * 2) { if (F.wave < 2) s5_item(F, it >> 5, it & 31, F.lds + 81920 + F.wave * 8192); } }
    __syncthreads();
    if (!(mode & 2)) return;
    for (int v = F.vcu; v < 256; v += F.G) { const int bh = v >> 1, b = bh >> 3, h = bh & 7;
        for (int i = F.tid; i < 2048; i += 512) ((LAS float*)(F.lds + AT_LUT))[i] = WSP(float, W_LUT)[h * 2048 + i];
        __syncthreads();
#pragma unroll 1
        for (int i = 0; i < 4; ++i) { const int own = (((v & 1) ? 0x1256 : 0x0347) >> (4 * i)) & 0xF; moba_unit(F, b, h, own); }
    }
}
constexpr size_t R_RE = W_ROUTE, R_RW = W_ROUTE + 512 * 1024, R_POS = W_ROUTE + 1024 * 1024, R_TOK = W_ROUTE + 2 * MiB, R_WGT = W_ROUTE + 3 * MiB;
constexpr int WT_PITCH = 1028;
constexpr int RW_PITCH = 1032;
constexpr int LN_XT = 32 * RW_PITCH * 2;
constexpr int LN_LG = 147456;
constexpr int LN_HIST = LN_LG + 8 * 528;
static_assert(LN_XT + 8 * 8256 <= LDS_TOK && LN_HIST + 128 <= LDS_BYTES, "LN LDS map");
template <int MODE, bool ROUTER, bool XIN_F32, bool OUT_F32>
DEV void p_ln(Frame& F, const float* xin32, const bf16_t* xinb, bf16_t* xoutb, float* xout32, const float* gam, const float* bet, const float* wrt, const float* brt) {
    LAS bf16_t* whi = (LAS bf16_t*)F.lds; LAS bf16_t* xt = (LAS bf16_t*)(F.lds + LN_XT) + F.wave * 4128; LAS float* lgs = (LAS float*)(F.lds + LN_LG) + F.wave * 132; LAS int* hist = (LAS int*)(F.lds + LN_HIST);
    const int lane = F.lane, l15 = lane & 15, q4 = lane >> 4;
    if constexpr (ROUTER) {
        for (int i = F.tid; i < 1024 * 32; i += 512) { const int k = i >> 5, e = i & 31; whi[e * RW_PITCH + k] = (bf16_t)(cvt_pk(wrt[i], 0.f) & 0xffffu); }
        if (F.tid < 32) hist[F.tid] = 0;
        __syncthreads();
    }
    const bf16_t* MIXB = WSP(bf16_t, W_MIXB); const bf16_t* YS = WSP(bf16_t, W_YS); const int* POS = WSP(int, R_POS);
    int* RE = WSP(int, R_RE); float* RW = WSP(float, R_RW);
    const float alpha = 1.4142135623730951f;
    f32x4 gq[4], bq[4];
#pragma unroll
    for (int j = 0; j < 4; ++j) { gq[j] = *(const f32x4*)(gam + j * 256 + lane * 4); bq[j] = *(const f32x4*)(bet + j * 256 + lane * 4); }
    float bias8[8];
    if constexpr (ROUTER) {
#pragma unroll
        for (int r = 0; r < 8; ++r) bias8[r] = brt[(r >> 2) * 16 + 4 * q4 + (r & 3)]; }
    for (int wgi = F.vcu; wgi < 256; wgi += F.G) {
        const int r0 = wgi * 128 + F.wave * 16;
#pragma unroll 1
        for (int i4 = 0; i4 < 16; i4 += 4) {
            float v[4][16];
#pragma unroll
            for (int u = 0; u < 4; ++u) { const int row = r0 + i4 + u;
                if constexpr (XIN_F32) {
#pragma unroll
                    for (int j = 0; j < 4; ++j) { const f32x4 a = *(const f32x4*)(xin32 + (size_t)row * 1024 + j * 256 + lane * 4); v[u][4 * j] = alpha * a.x; v[u][4 * j + 1] = alpha * a.y; v[u][4 * j + 2] = alpha * a.z; v[u][4 * j + 3] = alpha * a.w; }
                } else {
#pragma unroll
                    for (int j = 0; j < 4; ++j) { const u32x2 a = *(const u32x2*)(xinb + (size_t)row * 1024 + j * 256 + lane * 4); v[u][4 * j] = alpha * bflo(a.x); v[u][4 * j + 1] = alpha * bfhi(a.x); v[u][4 * j + 2] = alpha * bflo(a.y); v[u][4 * j + 3] = alpha * bfhi(a.y); }
                }
                if constexpr (MODE == 0) {
#pragma unroll
                    for (int j = 0; j < 4; ++j) { const u32x2 m = *(const u32x2*)(MIXB + (size_t)row * 1024 + j * 256 + lane * 4); v[u][4 * j] += bflo(m.x); v[u][4 * j + 1] += bfhi(m.x); v[u][4 * j + 2] += bflo(m.y); v[u][4 * j + 3] += bfhi(m.y); }
                } else {
                    const int4 pos4 = *(const int4*)(POS + row * 4);
                    const int ps[4] = {__builtin_amdgcn_readfirstlane(pos4.x), __builtin_amdgcn_readfirstlane(pos4.y), __builtin_amdgcn_readfirstlane(pos4.z), __builtin_amdgcn_readfirstlane(pos4.w)};
#pragma unroll
                    for (int kx = 0; kx < 4; ++kx)
#pragma unroll
                        for (int j = 0; j < 4; ++j) { const u32x2 m = *(const u32x2*)(YS + (size_t)ps[kx] * 1024 + j * 256 + lane * 4); v[u][4 * j] += bflo(m.x); v[u][4 * j + 1] += bfhi(m.x); v[u][4 * j + 2] += bflo(m.y); v[u][4 * j + 3] += bfhi(m.y); }
                }
            }
            float s1[4], s2[4];
#pragma unroll
            for (int u = 0; u < 4; ++u) { s1[u] = 0.f; s2[u] = 0.f;
#pragma unroll
                for (int q = 0; q < 16; ++q) { s1[u] += v[u][q]; s2[u] = fmaf(v[u][q], v[u][q], s2[u]); } }
#pragma unroll
            for (int o = 1; o < 64; o <<= 1) {
#pragma unroll
                for (int u = 0; u < 4; ++u) { s1[u] += __shfl_xor(s1[u], o); s2[u] += __shfl_xor(s2[u], o); } }
#pragma unroll
            for (int u = 0; u < 4; ++u) { const int row = r0 + i4 + u; const float mean = s1[u] * (1.f / 1024.f); const float var = fmaxf(s2[u] * (1.f / 1024.f) - mean * mean, 0.f); const float rstd = 1.f / sqrtf(var + 1e-5f);
#pragma unroll
                for (int j = 0; j < 4; ++j) { const int c = j * 256 + lane * 4; const f32x4 g4 = gq[j], b4 = bq[j];
                    const float y0 = (v[u][4 * j] - mean) * rstd * g4.x + b4.x, y1 = (v[u][4 * j + 1] - mean) * rstd * g4.y + b4.y, y2 = (v[u][4 * j + 2] - mean) * rstd * g4.z + b4.z, y3 = (v[u][4 * j + 3] - mean) * rstd * g4.w + b4.w;
                    if constexpr (OUT_F32) *(f32x4*)(xout32 + (size_t)row * 1024 + c) = (f32x4){y0, y1, y2, y3};
                    else { u32x2 w; w.x = cvt_pk(y0, y1); w.y = cvt_pk(y2, y3); *(u32x2*)(xoutb + (size_t)row * 1024 + c) = w;
                        if constexpr (ROUTER) { *(LAS u32x2*)(xt + u * RW_PITCH + c) = w;} } } }
            if constexpr (ROUTER) {
                f32x4 acc[2] = {{0.f, 0.f, 0.f, 0.f}, {0.f, 0.f, 0.f, 0.f}};
#pragma unroll 8
                for (int ks = 0; ks < 32; ++ks) { const bf16x8 xb = *(const LAS bf16x8*)(xt + (l15 & 3) * RW_PITCH + ks * 32 + q4 * 8);
#pragma unroll
                    for (int mt = 0; mt < 2; ++mt) { const bf16x8 wa = *(const LAS bf16x8*)(whi + (mt * 16 + l15) * RW_PITCH + ks * 32 + q4 * 8); acc[mt] = __builtin_amdgcn_mfma_f32_16x16x32_bf16(wa, xb, acc[mt], 0, 0, 0); } }
                if (l15 < 4) {
#pragma unroll
                    for (int mt = 0; mt < 2; ++mt)
#pragma unroll
                        for (int r = 0; r < 4; ++r) lgs[l15 * 33 + mt * 16 + 4 * q4 + r] = acc[mt][r] + bias8[mt * 4 + r]; }
                if (lane < 4) { float lg[32];
#pragma unroll
                    for (int e = 0; e < 32; ++e) lg[e] = lgs[lane * 33 + e];
                    unsigned taken = 0u; float tv[4]; int ti[4];
#pragma unroll
                    for (int r = 0; r < 4; ++r) { float best = -INFINITY; int bi = 0;
#pragma unroll
                        for (int e = 0; e < 32; ++e) { const bool ok = !((taken >> e) & 1u) && lg[e] > best; best = ok ? lg[e] : best; bi = ok ? e : bi; }
                        taken |= 1u << bi; tv[r] = best; ti[r] = bi; }
                    float ex[4], sm = 0.f;
#pragma unroll
                    for (int r = 0; r < 4; ++r) { ex[r] = __expf(tv[r] - tv[0]); sm += ex[r]; }
                    const float inv = 1.f / sm; const int row = r0 + i4 + lane;
                    *(int4*)(RE + row * 4) = make_int4(ti[0], ti[1], ti[2], ti[3]); *(f32x4*)(RW + row * 4) = (f32x4){ex[0] * inv, ex[1] * inv, ex[2] * inv, ex[3] * inv};
#pragma unroll
                    for (int r = 0; r < 4; ++r) atomicAdd((int*)(hist + ti[r]), 1); }
            }
        }
        if constexpr (ROUTER) { __syncthreads(); if (F.tid < 32) { WSP(int, W_HIST)[wgi * 32 + F.tid] = hist[F.tid]; hist[F.tid] = 0; } __syncthreads(); }
    }
}

DEV void p_sort(Frame& F) {
    LAS int* Ls = (LAS int*)F.lds; const int tid = F.tid;
    const int* HIST = WSP(int, W_HIST); int* SORT = WSP(int, W_SORT);
    const int* RE = WSP(int, R_RE); const float* RW = WSP(float, R_RW); int* POS = WSP(int, R_POS); int* TOK = WSP(int, R_TOK); float* WGT = WSP(float, R_WGT);
    for (int wgi = F.vcu; wgi < 256; wgi += F.G) {
        { const int e = tid & 31, part = tid >> 5; int tot = 0, pre = 0;
          for (int w = part * 16; w < part * 16 + 16; ++w) { const int hh = HIST[w * 32 + e]; tot += hh; pre += (w < wgi) ? hh : 0; }
          Ls[part * 32 + e] = tot; Ls[512 + part * 32 + e] = pre; }
        Ls[2048 + tid] = RE[wgi * 512 + tid];
        __syncthreads();
        if (tid < 32) { int tot = 0, pre = 0; for (int p = 0; p < 16; ++p) { tot += Ls[p * 32 + tid]; pre += Ls[512 + p * 32 + tid]; } Ls[1200 + tid] = tot; Ls[1300 + tid] = pre; }
        __syncthreads();
        if (tid == 0) { int a = 0; for (int e = 0; e < 32; ++e) { Ls[1024 + e] = a; a += (Ls[1200 + e] + 255) / 256 * 256; } Ls[1056] = a; }
        __syncthreads();
        if (tid < 32) { int c = Ls[1024 + tid] + Ls[1300 + tid]; for (int i = 0; i < 512; ++i) if (Ls[2048 + i] == tid) { Ls[2560 + i] = c; ++c; } }
        __syncthreads();
        { const int pos = Ls[2560 + tid]; TOK[pos] = wgi * 128 + (tid >> 2); WGT[pos] = RW[wgi * 512 + tid]; POS[wgi * 512 + tid] = pos; }
        { const bf16_t* XBBp = WSP(bf16_t, W_XBB); unsigned char* XS8 = WSP(unsigned char, W_X8);
          for (int r = F.wave; r < 128; r += 8) { const u32x4* src = (const u32x4*)(XBBp + (size_t)(wgi * 128 + r) * 1024 + F.lane * 16); const u32x4 a = src[0], b2 = src[1];
              u32x4 o; o.x = pk4_fp8(bflo(a.x) * 16.f, bfhi(a.x) * 16.f, bflo(a.y) * 16.f, bfhi(a.y) * 16.f); o.y = pk4_fp8(bflo(a.z) * 16.f, bfhi(a.z) * 16.f, bflo(a.w) * 16.f, bfhi(a.w) * 16.f);
              o.z = pk4_fp8(bflo(b2.x) * 16.f, bfhi(b2.x) * 16.f, bflo(b2.y) * 16.f, bfhi(b2.y) * 16.f); o.w = pk4_fp8(bflo(b2.z) * 16.f, bfhi(b2.z) * 16.f, bflo(b2.w) * 16.f, bfhi(b2.w) * 16.f);
#pragma unroll
              for (int kx = 0; kx < 4; ++kx) { const int pos = Ls[2560 + r * 4 + kx]; *(u32x4*)(XS8 + (size_t)pos * 1024 + F.lane * 16) = o; } }
          if (wgi < 32) { const int e = wgi; for (int r = Ls[1024 + e] + Ls[1200 + e] + F.wave; r < Ls[1024 + e + 1]; r += 8) *(u32x4*)(XS8 + (size_t)r * 1024 + F.lane * 16) = (u32x4){0u, 0u, 0u, 0u}; } }
        if (wgi < 32) { const int e = wgi; for (int r = Ls[1024 + e] + Ls[1200 + e] + tid; r < Ls[1024 + e + 1]; r += 512) { TOK[r] = 0; WGT[r] = 0.f; } }
        if (wgi == 0) { if (tid < 33) SORT[tid] = Ls[1024 + tid]; if (tid == 0) SORT[33] = Ls[1056] / 256;
            for (int pm = tid; pm < PMAX / 256; pm += 512) { int e = 0; for (int j = 1; j < 32; ++j) if (pm * 256 >= Ls[1024 + j]) e = j; SORT[64 + pm] = e; } }
        __syncthreads();
    }
}

DEV void p_gr(Frame& F) {
    const int gw = F.vcu * 8 + F.wave, NGW = F.G * 8, lane = F.lane, q4 = lane >> 4; const bf16_t* XB = WSP(bf16_t, W_XB); const bf16_t* Wg = WSP(bf16_t, W_IN1) + (size_t)3072 * 1024; float* GR = WSP(float, W_GR);
    for (int it = gw; it < T / 16; it += NGW) { f32x4 acc = {0.f, 0.f, 0.f, 0.f};
        const bf16_t* ap = XB + (size_t)(it * 16 + (lane & 15)) * 1024 + q4 * 8; const bf16_t* bp = Wg + (size_t)(lane & 15) * 1024 + q4 * 8;
#pragma unroll 8
        for (int ks = 0; ks < 32; ++ks) { const bf16x8 a = *(const bf16x8*)(ap + ks * 32), bb = *(const bf16x8*)(bp + ks * 32); acc = __builtin_amdgcn_mfma_f32_16x16x32_bf16(a, bb, acc, 0, 0, 0); }
#pragma unroll
        for (int r = 0; r < 4; ++r) GR[(size_t)(it * 16 + 4 * q4 + r) * 16 + (lane & 15)] = acc[r]; }
}

constexpr int GP = 272, GP2 = 144;
constexpr int GB_QIN = 0, GB_KST = 17408, GB_ATT = 35840, GB_VT = 45056, GB_DEC = 81920, GB_SIZE = 82944;
constexpr size_t W_GB = W_YS;
static_assert((size_t)2048 * GB_SIZE <= (size_t)PMAX * 2048, "blob region");
constexpr int GA_GRS = 0, GA_GT = 4096, GA_DEC = 6144, GA_QIN = 8192, GA_KIN = GA_QIN + 17408, GA_KST = GA_KIN + 17408, GA_ATT = GA_KST + 18432, GA_VT = GA_ATT + 9216, GA_END = GA_VT + 36864;
DEV float logsigm_fast(float z) { const float e = __builtin_amdgcn_exp2f(-1.4426950408889634f * fabsf(z)); return fminf(z, 0.f) - 0.6931471805599453f * __builtin_amdgcn_logf(1.f + e); }
DEV void p_gla_prep(Frame& F) {
    LAS unsigned char* lds = F.lds; const int tid = F.tid, lane = F.lane, wid = F.wave, q4 = lane >> 4, l15 = lane & 15;
    const bf16_t* H1 = WSP(bf16_t, W_HB); const float* GR = WSP(float, W_GR); unsigned char* GB = F.ws + W_GB;
    const float* wg2 = F.in[15]; const float* bg = F.in[16];
    for (int i = tid; i < 64 * GP2 / 4; i += 512) ((LAS unsigned*)(lds + GA_ATT))[i] = 0u;
    const int dk = tid & 127, tg = tid >> 7;
    const int dvl = tid & 255, th2 = tid >> 8;
    for (int it = F.vcu * 8; it < 2048; it += F.G * 8) {
#pragma unroll 1
      for (int sub = 0; sub < 8; ++sub) { const int item = it + sub; const int h = item & 3, n = (item >> 2) & 31, b = item >> 7;
        const size_t rb = (size_t)b * 2048 + n * 64;
        float w2[16];
#pragma unroll
        for (int r = 0; r < 16; ++r) w2[r] = wg2[r * 512 + h * 128 + dk];
        const float bgv = bg[h * 128 + dk];
        unsigned qraw[16], kraw[16], vraw[32];
#pragma unroll
        for (int i = 0; i < 16; ++i) { const size_t ro = (rb + 16 * tg + i) * 3072; qraw[i] = H1[ro + h * 128 + dk]; kraw[i] = H1[ro + 512 + h * 128 + dk]; }
#pragma unroll
        for (int i = 0; i < 32; ++i) vraw[i] = H1[(rb + 32 * th2 + i) * 3072 + 1024 + h * 256 + dvl];
        const float g0 = GR[rb * 16 + tid], g1 = GR[rb * 16 + 512 + tid];
        ((LAS float*)(lds + GA_GRS))[tid] = g0; ((LAS float*)(lds + GA_GRS))[512 + tid] = g1;
        __syncthreads();
        float cs[16]; float run = 0.f;
#pragma unroll
        for (int i = 0; i < 16; ++i) { const LAS float* gr = (const LAS float*)(lds + GA_GRS) + (16 * tg + i) * 16; float z = bgv;
#pragma unroll
            for (int r = 0; r < 16; ++r) z = fmaf(gr[r], w2[r], z);
            run += logsigm_fast(z) * (1.f / 16.f); cs[i] = run; }
        ((LAS float*)(lds + GA_GT))[tg * 128 + dk] = run;
        __syncthreads();
        float off = 0.f, btot = 0.f;
#pragma unroll
        for (int g2 = 0; g2 < 4; ++g2) { const float gtv = ((LAS float*)(lds + GA_GT))[g2 * 128 + dk]; btot += gtv; off += (g2 < tg) ? gtv : 0.f; }
        if (tg == 0) ((LAS float*)(lds + GA_DEC))[dk] = __expf(btot);
        { unsigned kst[8];
#pragma unroll
          for (int i = 0; i < 16; i += 2) { float kk[2];
#pragma unroll
              for (int u = 0; u < 2; ++u) { const int t = 16 * tg + i + u; const float bc = cs[i + u] + off; const float qv = bflo(qraw[i + u]), kv = bflo(kraw[i + u]);
                  *(LAS bf16_t*)(lds + GA_QIN + t * GP + dk * 2) = (bf16_t)(cvt_pk(qv * __expf(bc), 0.f) & 0xffffu);
                  *(LAS bf16_t*)(lds + GA_KIN + t * GP + dk * 2) = (bf16_t)(cvt_pk(kv * __expf(-bc), 0.f) & 0xffffu);
                  kk[u] = kv * __expf(btot - bc); }
              kst[i >> 1] = cvt_pk(kk[0], kk[1]); }
          *(LAS u32x4*)(lds + GA_KST + dk * GP2 + tg * 32) = (u32x4){kst[0], kst[1], kst[2], kst[3]};
          *(LAS u32x4*)(lds + GA_KST + dk * GP2 + tg * 32 + 16) = (u32x4){kst[4], kst[5], kst[6], kst[7]}; }
#pragma unroll
        for (int i = 0; i < 32; i += 8) *(LAS u32x4*)(lds + GA_VT + dvl * GP2 + (32 * th2 + i) * 2) = (u32x4){vraw[i] | (vraw[i + 1] << 16), vraw[i + 2] | (vraw[i + 3] << 16), vraw[i + 4] | (vraw[i + 5] << 16), vraw[i + 6] | (vraw[i + 7] << 16)};
        __syncthreads();
#pragma unroll
        for (int rep = 0; rep < 2; ++rep) { const int ti = wid + 8 * rep; if (ti < 10) {
            int jt, it2; if (ti < 4) { jt = 0; it2 = ti; } else if (ti < 7) { jt = 1; it2 = ti - 3; } else if (ti < 9) { jt = 2; it2 = ti - 5; } else { jt = 3; it2 = 3; }
            f32x4 a4 = {0.f, 0.f, 0.f, 0.f};
#pragma unroll
            for (int ks = 0; ks < 4; ++ks) { const bf16x8 kf = *(const LAS bf16x8*)(lds + GA_KIN + (16 * jt + l15) * GP + ks * 64 + q4 * 16), qf = *(const LAS bf16x8*)(lds + GA_QIN + (16 * it2 + l15) * GP + ks * 64 + q4 * 16);
                a4 = __builtin_amdgcn_mfma_f32_16x16x32_bf16(kf, qf, a4, 0, 0, 0); }
            const int i_ = 16 * it2 + l15, j0 = 16 * jt + 4 * q4;
            u32x2 w; w.x = cvt_pk(j0 <= i_ ? a4[0] : 0.f, j0 + 1 <= i_ ? a4[1] : 0.f); w.y = cvt_pk(j0 + 2 <= i_ ? a4[2] : 0.f, j0 + 3 <= i_ ? a4[3] : 0.f);
            *(LAS u32x2*)(lds + GA_ATT + i_ * GP2 + j0 * 2) = w; } }
        __syncthreads();
        unsigned char* blob = GB + (size_t)item * GB_SIZE;
        for (int c = tid; c < 17408 / 16; c += 512) *(u32x4*)(blob + GB_QIN + c * 16) = *(const LAS u32x4*)(lds + GA_QIN + c * 16);
        for (int c = tid; c < 18432 / 16; c += 512) *(u32x4*)(blob + GB_KST + c * 16) = *(const LAS u32x4*)(lds + GA_KST + c * 16);
        for (int c = tid; c < 9216 / 16; c += 512) *(u32x4*)(blob + GB_ATT + c * 16) = *(const LAS u32x4*)(lds + GA_ATT + c * 16);
        for (int c = tid; c < 36864 / 16; c += 512) *(u32x4*)(blob + GB_VT + c * 16) = *(const LAS u32x4*)(lds + GA_VT + c * 16);
        if (tid < 32) *(u32x4*)(blob + GB_DEC + tid * 16) = *(const LAS u32x4*)(lds + GA_DEC + tid * 16);
      }
    }
}
constexpr int GS_BUF = 55296;
constexpr int GS_QIN = 0, GS_KST = 17408, GS_ATT = 35840, GS_VT = 45056, GS_DEC = 54272;
DEV void gla_scan_item(Frame& F, int b, int h, int c4) {
    LAS unsigned char* lds = F.lds; const int lane = F.lane, wid = F.wave, q4 = lane >> 4, l15 = lane & 15;
    bf16_t* GO = WSP(bf16_t, W_GLAO); float* SS = WSP(float, W_SS); const unsigned char* GB = F.ws + W_GB;
    const int c16 = wid & 3, th = wid >> 2;
    f32x4 sacc[8];
#pragma unroll
    for (int m = 0; m < 8; ++m) sacc[m] = (f32x4){0.f, 0.f, 0.f, 0.f};
    const size_t rb = (size_t)b * 2048;
#define GS_ISSUE(n_) do { const unsigned char* blob_ = GB + (size_t)((b * 32 + (n_)) * 4 + h) * GB_SIZE; const int bo_ = ((n_) & 1) * GS_BUF; \
        for (int p_ = wid; p_ < 54; p_ += 8) { const int so_ = p_ < 44 ? p_ * 1024 : (p_ < 53 ? GB_VT + c4 * 9216 + (p_ - 44) * 1024 : GB_DEC); \
            __builtin_amdgcn_global_load_lds((const unsigned*)(blob_ + so_ + lane * 16), (LAS unsigned*)(lds + bo_ + p_ * 1024), 16, 0, 0); } } while (0)
    GS_ISSUE(0);
    for (int n = 0; n < 32; ++n) { const int t0 = n * 64;
        asm volatile("s_waitcnt vmcnt(0)" ::: "memory"); __syncthreads();
        if (n + 1 < 32) GS_ISSUE(n + 1);
        const LAS unsigned char* bu = lds + (n & 1) * GS_BUF;
        bf16x8 vf[2];
#pragma unroll
        for (int ks = 0; ks < 2; ++ks) vf[ks] = *(const LAS bf16x8*)(bu + GS_VT + (c16 * 16 + l15) * GP2 + ks * 64 + q4 * 16);
        bf16x8 sf[4];
#pragma unroll
        for (int ks = 0; ks < 4; ++ks) { const u32x4 w = {cvt_pk(sacc[2 * ks][0], sacc[2 * ks][1]), cvt_pk(sacc[2 * ks][2], sacc[2 * ks][3]), cvt_pk(sacc[2 * ks + 1][0], sacc[2 * ks + 1][1]), cvt_pk(sacc[2 * ks + 1][2], sacc[2 * ks + 1][3])}; sf[ks] = __builtin_bit_cast(bf16x8, w); }
#pragma unroll
        for (int mt = 0; mt < 2; ++mt) { const int i_ = 32 * th + 16 * mt + l15; f32x4 oa = {0.f, 0.f, 0.f, 0.f};
#pragma unroll
            for (int ks = 0; ks < 2; ++ks) { if (ks == 1 && th == 0) continue; const bf16x8 af = *(const LAS bf16x8*)(bu + GS_ATT + i_ * GP2 + ks * 64 + q4 * 16); oa = __builtin_amdgcn_mfma_f32_16x16x32_bf16(af, vf[ks], oa, 0, 0, 0); }
#pragma unroll
            for (int ks = 0; ks < 4; ++ks) { const u32x2 lo = *(const LAS u32x2*)(bu + GS_QIN + i_ * GP + (32 * ks + 4 * q4) * 2), hi2 = *(const LAS u32x2*)(bu + GS_QIN + i_ * GP + (32 * ks + 16 + 4 * q4) * 2);
                const u32x4 w = {lo.x, lo.y, hi2.x, hi2.y}; oa = __builtin_amdgcn_mfma_f32_16x16x32_bf16(__builtin_bit_cast(bf16x8, w), sf[ks], oa, 0, 0, 0); }
#pragma unroll
            for (int r = 0; r < 4; ++r) { const size_t trow = rb + t0 + 32 * th + 16 * mt + 4 * q4 + r; GO[trow * 1024 + h * 256 + c4 * 64 + c16 * 16 + l15] = (bf16_t)(cvt_pk(oa[r], 0.f) & 0xffffu);
                float sq = oa[r] * oa[r]; sq += __shfl_xor(sq, 1); sq += __shfl_xor(sq, 2); sq += __shfl_xor(sq, 4); sq += __shfl_xor(sq, 8);
                if (l15 == 0) SS[(trow * 4 + h) * 16 + c4 * 4 + c16] = sq; } }
#pragma unroll
        for (int md = 0; md < 8; ++md) { const f32x4 dc = *(const LAS f32x4*)(bu + GS_DEC + (16 * md + 4 * q4) * 4); sacc[md] = sacc[md] * dc;
#pragma unroll
            for (int ks = 0; ks < 2; ++ks) { const bf16x8 kf = *(const LAS bf16x8*)(bu + GS_KST + (16 * md + l15) * GP2 + ks * 64 + q4 * 16); sacc[md] = __builtin_amdgcn_mfma_f32_16x16x32_bf16(kf, vf[ks], sacc[md], 0, 0, 0); } }
    }
#undef GS_ISSUE
    __syncthreads();
}
DEV void p_gla_scan(Frame& F) { for (int v = F.vcu; v < 256; v += F.G) gla_scan_item(F, v >> 4, (v >> 2) & 3, v & 3); }

DEV void p_gla_norm(Frame& F) {
    const int gw = F.vcu * 8 + F.wave, NGW = F.G * 8, lane = F.lane; const bf16_t* GO = WSP(bf16_t, W_GLAO); const float* SS = WSP(float, W_SS); const bf16_t* H1 = WSP(bf16_t, W_HB); bf16_t* Y0 = WSP(bf16_t, W_Y0);
    const f32x4 nw = *(const f32x4*)(F.in[17] + lane * 4);
    for (int row = gw; row < T; row += NGW) {
#pragma unroll
        for (int h = 0; h < 4; ++h) { const float* sp = SS + ((size_t)row * 4 + h) * 16; const f32x4 a = *(const f32x4*)sp, b2 = *(const f32x4*)(sp + 4), c = *(const f32x4*)(sp + 8), d = *(const f32x4*)(sp + 12);
            const float sq = (a.x + a.y + a.z + a.w) + (b2.x + b2.y + b2.z + b2.w) + (c.x + c.y + c.z + c.w) + (d.x + d.y + d.z + d.w); const float r = 1.f / sqrtf(sq * (1.f / 256.f) + 1e-5f);
            const u32x2 o = *(const u32x2*)(GO + (size_t)row * 1024 + h * 256 + lane * 4); const u32x2 g = *(const u32x2*)(H1 + (size_t)row * 3072 + 2048 + h * 256 + lane * 4);
            const float g0 = bflo(g.x), g1 = bfhi(g.x), g2 = bflo(g.y), g3 = bfhi(g.y);
            u32x2 w; w.x = cvt_pk(bflo(o.x) * r * nw.x * g0 * fast_sigm(g0), bfhi(o.x) * r * nw.y * g1 * fast_sigm(g1)); w.y = cvt_pk(bflo(o.y) * r * nw.z * g2 * fast_sigm(g2), bfhi(o.y) * r * nw.w * g3 * fast_sigm(g3));
            *(u32x2*)(Y0 + (size_t)row * 1024 + h * 256 + lane * 4) = w; } }
}
struct FStoreScale { bf16_t* O; int ldc, c_lo, c_hi; float sc;
    DEV void operator()(const Unit&, int row, int col, f32x4 v0, f32x4 v1) const { const float s = (col >= c_lo && col < c_hi) ? sc : 1.f;
        const u32x4 w = {cvt_pk(v0[0] * s, v0[1] * s), cvt_pk(v0[2] * s, v0[3] * s), cvt_pk(v1[0] * s, v1[1] * s), cvt_pk(v1[2] * s, v1[3] * s)}; *(u32x4*)(O + (size_t)row * ldc + col) = w; } };
struct FGlu { const bf16_t* Y; bf16_t* O; const float* b;
    DEV void operator()(const Unit&, int row, int col, f32x4 v0, f32x4 v1) const { const u32x4 y = *(const u32x4*)(Y + (size_t)row * 512 + col); const f32x4 b0 = *(const f32x4*)(b + col), b1 = *(const f32x4*)(b + col + 4);
        const u32x4 w = {cvt_pk(bflo(y.x) * fast_sigm(v0[0] + b0.x), bfhi(y.x) * fast_sigm(v0[1] + b0.y)), cvt_pk(bflo(y.y) * fast_sigm(v0[2] + b0.z), bfhi(y.y) * fast_sigm(v0[3] + b0.w)),
                         cvt_pk(bflo(y.z) * fast_sigm(v1[0] + b1.x), bfhi(y.z) * fast_sigm(v1[1] + b1.y)), cvt_pk(bflo(y.w) * fast_sigm(v1[2] + b1.z), bfhi(y.w) * fast_sigm(v1[3] + b1.w))};
        *(u32x4*)(O + (size_t)row * 1024 + col) = w; } };
constexpr float ACT_SCALE = 4.f, WDN_SCALE = 128.f;
DEV float swiglu1(float g, float u) { g = fminf(g, 7.f); u = fminf(fmaxf(u, -7.f), 7.f); return g * fast_sigm(1.702f * g) * (u + 1.f); }
struct FSwiglu { unsigned char* ACT; const float* bgu; float sc;
    DEV void operator()(const Unit& u, int row, int col, f32x4 v0, f32x4 v1) const { v0 = v0 * sc; v1 = v1 * sc; const float* bp = bgu + (size_t)u.e * 2048 + col; const f32x4 b0 = *(const f32x4*)bp, b1 = *(const f32x4*)(bp + 4);
        const unsigned w = pk4_fp8(ACT_SCALE * swiglu1(v0[0] + b0.x, v0[1] + b0.y), ACT_SCALE * swiglu1(v0[2] + b0.z, v0[3] + b0.w), ACT_SCALE * swiglu1(v1[0] + b1.x, v1[1] + b1.y), ACT_SCALE * swiglu1(v1[2] + b1.z, v1[3] + b1.w));
        *(unsigned*)(ACT + (size_t)row * 1024 + (col >> 1)) = w; } };
struct FDown { bf16_t* YS; const float* bd; const float* wgt; float sc;
    DEV void operator()(const Unit& u, int row, int col, f32x4 v0, f32x4 v1) const { v0 = v0 * sc; v1 = v1 * sc; const float* bp = bd + (size_t)u.e * 1024 + col; const f32x4 b0 = *(const f32x4*)bp, b1 = *(const f32x4*)(bp + 4); const float wt = wgt[row];
        const u32x4 w = {cvt_pk((v0[0] + b0.x) * wt, (v0[1] + b0.y) * wt), cvt_pk((v0[2] + b0.z) * wt, (v0[3] + b0.w) * wt), cvt_pk((v1[0] + b1.x) * wt, (v1[1] + b1.y) * wt), cvt_pk((v1[2] + b1.z) * wt, (v1[3] + b1.w) * wt)};
        *(u32x4*)(YS + (size_t)row * 1024 + col) = w; } };

constexpr int NPH = 21;
constexpr float X8_SCALE = 16.f, WGU_SCALE = 64.f;
constexpr float QSCALE0 = 0.125f * 1.4426950408889634f, QSCALE1 = 0.08838834764831845f;


#define NOINL __device__ __forceinline__
struct PA { const float* const* in; unsigned char* ws; float* out; int wave; };
#define MKFRAME extern __shared__ __attribute__((aligned(16))) unsigned char lds_[]; Frame F; F.lds = (LAS unsigned char*)lds_; F.wave = pa.wave; F.lane = (int)__builtin_amdgcn_mbcnt_hi(~0u, __builtin_amdgcn_mbcnt_lo(~0u, 0u)); F.tid = F.wave * 64 + F.lane; \
    F.G = gridDim.x; { const int bx = blockIdx.x; F.vcu = (F.G % 8 == 0) ? (bx % 8) * (F.G / 8) + bx / 8 : bx; } F.in = pa.in; F.ws = pa.ws;
template <class Fn> DEV void dense_gemm(Frame& F, const bf16_t* A, const bf16_t* Bt, int nM, int nN, int K, const Fn& fn) {
    Gemm g; g.A = A; g.Bt = Bt; g.rowmap = nullptr; g.bstride = 0; g.KB = K * 2; g.wave = F.wave;
    StaticOrder S; S.init(nM, nN, F.G, (int)blockIdx.x, nullptr);
    EpiRow8<Fn> E{fn};
    gemm_phase<false, false>(F.lds, g, S, E);
}
NOINL void ph_prologue(PA pa) { MKFRAME p0_prologue(F); }
NOINL void ph_in0(PA pa) { MKFRAME dense_gemm(F, WSP(bf16_t, W_XB), WSP(bf16_t, W_IN0), T / 256, 8, 1024, FStoreScale{WSP(bf16_t, W_HB), 2048, 512, 1024, QSCALE0}); }
NOINL void ph_kmean(PA pa) { MKFRAME p_kmean(F); }
NOINL void ph_s5moba(PA pa, int mode) { MKFRAME p_s5_moba(F, mode); }
NOINL void ph_glu(PA pa) { MKFRAME dense_gemm(F, WSP(bf16_t, W_YS5), WSP(bf16_t, W_GLU), T / 256, 2, 512, FGlu{WSP(bf16_t, W_YS5), WSP(bf16_t, W_Y0), F.in[11]}); }
NOINL void ph_out(PA pa, int layer) { MKFRAME dense_gemm(F, WSP(bf16_t, W_Y0), layer ? WSP(bf16_t, W_OUT1) : WSP(bf16_t, W_OUT0), T / 256, 4, 1024, FStoreScale{WSP(bf16_t, W_MIXB), 1024, 0, 0, 1.f}); }
NOINL void ph_in1(PA pa) { MKFRAME dense_gemm(F, WSP(bf16_t, W_XB), WSP(bf16_t, W_IN1), T / 256, 12, 1024, FStoreScale{WSP(bf16_t, W_HB), 3072, 0, 512, QSCALE1}); p_gr(F); }
NOINL void ph_glaprep(PA pa) { MKFRAME p_gla_prep(F); }
NOINL void ph_glascan(PA pa) { MKFRAME p_gla_scan(F); }
NOINL void ph_glanorm(PA pa) { MKFRAME p_gla_norm(F); }
NOINL void ph_lnrouter(PA pa, int layer) { MKFRAME
    if (layer == 0) p_ln<0, true, true, false>(F, F.in[0], nullptr, WSP(bf16_t, W_XBB), nullptr, F.in[19], F.in[20], F.in[23], F.in[24]);
    else p_ln<0, true, false, false>(F, nullptr, WSP(bf16_t, W_XB), WSP(bf16_t, W_XBB), nullptr, F.in[19] + 1024, F.in[20] + 1024, F.in[23] + (size_t)1024 * 32, F.in[24] + 32); }
NOINL void ph_sort(PA pa) { MKFRAME p_sort(F); }
NOINL void ph_gateup(PA pa, int layer) { MKFRAME const int* SORT = WSP(int, W_SORT);
    Gemm g; g.A = WSP(unsigned char, W_X8); g.Bt = WSP(unsigned char, W_GU) + (size_t)layer * 32 * 2048 * 1024; g.rowmap = nullptr; g.bstride = (size_t)2048 * 1024; g.KB = 1024; g.wave = F.wave;
    StaticOrder S; S.init(__builtin_amdgcn_readfirstlane(SORT[33]), 8, F.G, (int)blockIdx.x, SORT + 64);
    EpiRow8<FSwiglu> E{FSwiglu{WSP(unsigned char, W_ACT), F.in[26] + (size_t)layer * 32 * 2048, 1.f / (X8_SCALE * WGU_SCALE)}};
    gemm_phase<false, true>(F.lds, g, S, E); }
NOINL void ph_down(PA pa, int layer) { MKFRAME const int* SORT = WSP(int, W_SORT);
    Gemm g; g.A = WSP(unsigned char, W_ACT); g.Bt = WSP(unsigned char, W_DN) + (size_t)layer * 32 * 1024 * 1024; g.rowmap = nullptr; g.bstride = (size_t)1024 * 1024; g.KB = 1024; g.wave = F.wave;
    StaticOrder S; S.init(__builtin_amdgcn_readfirstlane(SORT[33]), 4, F.G, (int)blockIdx.x, SORT + 64);
    EpiRow8<FDown> E{FDown{WSP(bf16_t, W_YS), F.in[28] + (size_t)layer * 32 * 1024, WSP(float, R_WGT), 1.f / (ACT_SCALE * WDN_SCALE)}};
    gemm_phase<false, true>(F.lds, g, S, E); }
NOINL void ph_combine(PA pa, int layer) { MKFRAME
    if (layer == 0) p_ln<1, false, false, false>(F, nullptr, WSP(bf16_t, W_XBB), WSP(bf16_t, W_XB), nullptr, F.in[21], F.in[22], nullptr, nullptr);
    else p_ln<1, false, false, true>(F, nullptr, WSP(bf16_t, W_XBB), nullptr, pa.out, F.in[21] + 1024, F.in[22] + 1024, nullptr, nullptr); }

__global__ void __launch_bounds__(512, 2) mega(Args args) {
    extern __shared__ __attribute__((aligned(16))) unsigned char lds_[];
    LAS unsigned char* lds = (LAS unsigned char*)lds_;
    unsigned* ctl = (unsigned*)(args.ws + W_CTL);
    for (int u = threadIdx.x; u < (LDS_BYTES - LDSCTL_OFF) / 4; u += 512) ((LAS unsigned*)(lds + LDSCTL_OFF))[u] = 0u;
    __syncthreads();
    const int lo = args.ph_lo, hi = args.ph_hi;
    PA pa; pa.in = args.in; pa.ws = args.ws; pa.out = args.out; pa.wave = __builtin_amdgcn_readfirstlane(threadIdx.x >> 6);
    XcdBarrier bar; bar.bar = ctl + CW_BAR; bar.x = 0; bar.st = nullptr; bar.wave = pa.wave;
    if (hi - lo > 1) bar = xcd_barrier_post(ctl + CW_BAR, (volatile LAS unsigned*)(lds + MISC_OFF) + 8, pa.wave);
#define IN(k) (lo <= (k) && (k) < hi)
#ifdef DIAG_LO
    volatile LAS unsigned long long* tsl = (volatile LAS unsigned long long*)(lds + MISC_OFF + 128);
    if (blockIdx.x == 0 && threadIdx.x == 0) tsl[0] = __builtin_amdgcn_s_memrealtime();
#define STAMP(k) do { if (blockIdx.x == 0 && threadIdx.x == 0) tsl[(k) + 1] = __builtin_amdgcn_s_memrealtime(); } while (0)
#else
#define STAMP(k) do { } while (0)
#endif
#define SEAM(k) do { if (IN(k) && IN((k) + 1)) xcd_barrier(bar); STAMP(k); } while (0)
#ifndef REP_PHASE
#define REP_PHASE -1
#define REP_N 0
#endif
#define RUN(k, call) do { if (IN(k)) { const int nrep_ = ((k) == REP_PHASE) ? 1 + REP_N : 1; for (int r_ = 0; r_ < nrep_; ++r_) { call; if (r_ + 1 < nrep_) xcd_barrier(bar); } } } while (0)
    RUN(0, ph_prologue(pa)); SEAM(0);
    RUN(1, ph_in0(pa)); SEAM(1);
    RUN(2, ph_kmean(pa)); SEAM(2);
    if (IN(3)) { const int n30 = (REP_PHASE == 30) ? 1 + REP_N : 1, n31 = (REP_PHASE == 31) ? 1 + REP_N : 1;
        for (int r_ = 0; r_ < n30; ++r_) ph_s5moba(pa, 1);
        for (int r_ = 0; r_ < n31; ++r_) ph_s5moba(pa, 2); } SEAM(3);
    RUN(4, ph_glu(pa)); SEAM(4);
    RUN(5, ph_out(pa, 0)); SEAM(5);
    RUN(6, ph_lnrouter(pa, 0)); SEAM(6);
    RUN(7, ph_sort(pa)); SEAM(7);
    RUN(8, ph_gateup(pa, 0)); SEAM(8);
    RUN(9, ph_down(pa, 0)); SEAM(9);
    RUN(10, ph_combine(pa, 0)); SEAM(10);
    RUN(11, ph_in1(pa)); SEAM(11);
    RUN(12, ph_glaprep(pa)); SEAM(12);
    RUN(13, ph_glascan(pa)); SEAM(13);
    RUN(14, ph_glanorm(pa)); SEAM(14);
    RUN(15, ph_out(pa, 1)); SEAM(15);
    RUN(16, ph_lnrouter(pa, 1)); SEAM(16);
    RUN(17, ph_sort(pa)); SEAM(17);
    RUN(18, ph_gateup(pa, 1)); SEAM(18);
    RUN(19, ph_down(pa, 1)); SEAM(19);
    RUN(20, ph_combine(pa, 1));
#ifdef DIAG_LO
    xcd_barrier(bar); STAMP(20);
    if (blockIdx.x == 0 && threadIdx.x == 0) { const unsigned long long dtk = tsl[DIAG_HI + 1] - tsl[DIAG_LO]; const float f = (float)dtk * (0.01f / 10000.f); __hip_atomic_store(ctl + 8, __float_as_uint(f), __ATOMIC_RELAXED, __HIP_MEMORY_SCOPE_AGENT); }
    xcd_barrier(bar);
    { const float f = __uint_as_float(__hip_atomic_load(ctl + 8, __ATOMIC_RELAXED, __HIP_MEMORY_SCOPE_AGENT));
      for (size_t i = (size_t)blockIdx.x * 512 + threadIdx.x; i < (size_t)T * 1024; i += (size_t)gridDim.x * 512) args.out[i] *= (1.f + f); }
#endif
#undef IN
#undef SEAM
}

static int g_grid = 0;
static bool launch_setup(size_t ws_size) {
    if (g_grid == 0) {
        if (ws_size < W_END) { fprintf(stderr, "kernel_launch: workspace too small: %zu < %zu\n", ws_size, (size_t)W_END); g_grid = -1; return false; }
        int dev = 0, cus = 0, per_cu = 0;
        if (hipGetDevice(&dev) != hipSuccess || hipDeviceGetAttribute(&cus, hipDeviceAttributeMultiprocessorCount, dev) != hipSuccess) { g_grid = -1; return false; }
        if (hipFuncSetAttribute((const void*)mega, hipFuncAttributeMaxDynamicSharedMemorySize, LDS_BYTES) != hipSuccess) { fprintf(stderr, "kernel_launch: hipFuncSetAttribute failed\n"); g_grid = -1; return false; }
        if (hipOccupancyMaxActiveBlocksPerMultiprocessor(&per_cu, (const void*)mega, 512, LDS_BYTES) != hipSuccess || per_cu < 1) fprintf(stderr, "kernel_launch: occupancy query reports %d blocks/CU\n", per_cu);
        (void)hipGetLastError();
        g_grid = cus;
    }
    return g_grid > 0;
}
static void launch_phases(hipStream_t stream, void* const* d_in, void* d_out, void* d_ws, int lo, int hi) {
    Args a; memset(&a, 0, sizeof a);
    for (int i = 0; i < 29; ++i) a.in[i] = (const float*)d_in[i];
    a.out = (float*)d_out; a.ws = (unsigned char*)d_ws; a.ph_lo = lo; a.ph_hi = hi;
    hipLaunchKernelGGL(mega, dim3(g_grid), dim3(512), LDS_BYTES, stream, a);
}
}
extern "C" void kernel_launch(void* const* d_in, const int* in_sizes, int n_in, void* d_out, int out_size, void* d_ws, size_t ws_size, hipStream_t stream) {
    if (n_in != 29 || out_size != T * D) { fprintf(stderr, "kernel_launch: unexpected arguments (n_in %d, out_size %d)\n", n_in, out_size); return; }
    if (!fk::launch_setup(ws_size)) return;
    (void)hipMemsetAsync((char*)d_ws + fk::W_CTL, 0, fk::CTL_ZERO_BYTES, stream);
    fk::launch_phases(stream, d_in, d_out, d_ws, 0, fk::NPH);
}
```

```cpp
#include <hip/hip_runtime.h>
#include <cstdio>
#include <cstdint>
#include <cmath>
#include <cstring>
#define DEV __device__ __forceinline__
constexpr int Bn = 16, L = 2048, D = 1024, T = Bn * L;
namespace fk {
#define LAS __attribute__((address_space(3)))
#define GAS __attribute__((address_space(1)))
typedef unsigned short bf16_t;
typedef short bf16x8 __attribute__((ext_vector_type(8)));
typedef short s16x4 __attribute__((ext_vector_type(4)));
typedef float f32x2 __attribute__((ext_vector_type(2)));
typedef float f32x4 __attribute__((ext_vector_type(4)));
typedef float f32x16 __attribute__((ext_vector_type(16)));
typedef unsigned u32x2 __attribute__((ext_vector_type(2)));
typedef unsigned u32x4 __attribute__((ext_vector_type(4)));
typedef __bf16 bf16x2_t __attribute__((ext_vector_type(2)));
struct u32x4x2 { u32x4 a, b; };
DEV unsigned cvt_pk(float lo, float hi) { f32x2 v = {lo, hi}; bf16x2_t b = __builtin_convertvector(v, bf16x2_t); return __builtin_bit_cast(unsigned, b); }
DEV float bflo(unsigned w) { return __uint_as_float(w << 16); }
DEV float bfhi(unsigned w) { return __uint_as_float(w & 0xffff0000u); }
DEV float fast_sigm(float x) { return __builtin_amdgcn_rcpf(1.f + __builtin_amdgcn_exp2f(-1.4426950408889634f * x)); }
DEV float gelu_tanh(float x) { const float u = 0.7978845608028654f * (x + 0.044715f * x * x * x); return x * fast_sigm(2.f * u); }
DEV float wave_sum(float v) {
#pragma unroll
    for (int o = 1; o < 64; o <<= 1) v += __shfl_xor(v, o);
    return v; }
DEV float swap32(float x) { auto rr = __builtin_amdgcn_permlane32_swap(__float_as_uint(x), __float_as_uint(x), false, false); return __uint_as_float((__builtin_amdgcn_mbcnt_lo(~0u, 0u) >> 5) ? rr[0] : rr[1]); }

constexpr int BM = 256, BK = 64, HALF = 128, HTB = HALF * BK * 2, STAGE_BYTES = 8 * HTB, NXCD = 8, WGM = 8;
constexpr int LDS_TOK = 135168 - 2048;
constexpr int LDS_BYTES = 163840, LDSCTL_OFF = LDS_BYTES - 1024, MISC_OFF = LDSCTL_OFF + 320;

DEV int lds_byte(int r, int c) { const int st = (r >> 4) * 2 + (c >> 5), rr = r & 15, cc = c & 31, ob = rr * 64 + cc * 2; return st * 1024 + (ob ^ (((ob >> 9) & 1) << 5)); }
DEV void stage_rc(int b, int& R, int& C) { const int st = b / 1024, sb = b % 1024, swz = sb ^ (((sb >> 9) & 1) << 5); R = (st >> 1) * 16 + swz / 64; C = (st & 1) * 32 + (swz % 64) / 2; }
DEV int perm32(int rho) { const int n = rho >> 4, i = rho & 15; return 8 * (i >> 2) + 4 * n + (i & 3); }

struct Unit { int pm, pn, e; };
struct Gemm { const void* A; const void* Bt; const int* rowmap; size_t bstride; int KB; int wave; };

struct StaticOrder {
    int nM, nN, nwg, G, c; const int* tile_e;
    DEV void init(int nM_, int nN_, int G_, int c_, const int* te) { nM = nM_; nN = nN_; nwg = nM * nN; G = G_; c = c_; tile_e = te; }
    DEV bool next(int i, Unit& u) const {
        const long Lx = (long)i * G + c; if (Lx >= nwg) return false;
        int wgid = (int)Lx; { const int q = nwg / NXCD, r = nwg % NXCD, xcd = wgid % NXCD, off = wgid / NXCD; wgid = (xcd < r ? xcd * (q + 1) : r * (q + 1) + (xcd - r) * q) + off; }
        const int nig = WGM * nN, gid = wgid / nig, fm = gid * WGM, gsz = (nM - fm) < WGM ? (nM - fm) : WGM;
        u.pm = fm + ((wgid % nig) % gsz); u.pn = (wgid % nig) / gsz; u.e = tile_e ? __builtin_amdgcn_readfirstlane(tile_e[u.pm]) : 0; return true;
    }
};

template <class F> struct EpiRow8 {
    static constexpr bool PERM = true; F f;
    DEV void operator()(const f32x4 (&acc)[2][2][4][2], const Unit& u, int wr, int wc, int fr, int fq) const {
        { const int ln_ = (int)__builtin_amdgcn_mbcnt_hi(~0u, __builtin_amdgcn_mbcnt_lo(~0u, 0u)); fr = ln_ & 15; fq = ln_ >> 4; }
#pragma unroll
        for (int ai = 0; ai < 2; ++ai)
#pragma unroll
            for (int m = 0; m < 4; ++m) { const int row = u.pm * BM + ai * HALF + wr * 64 + m * 16 + fr;
#pragma unroll
                for (int bj = 0; bj < 2; ++bj) f(u, row, u.pn * BM + bj * HALF + wc * 32 + 8 * fq, acc[ai][bj][m][0], acc[ai][bj][m][1]); }
    }
};

typedef int v8i_t __attribute__((ext_vector_type(8)));
typedef int v4i_t __attribute__((ext_vector_type(4)));
template <bool GATHER, bool FP8, class Epi, class Sched>
DEV void gemm_phase(LAS unsigned char* lds, const Gemm g, const Sched& S, const Epi& E) {
    const int wid = g.wave, lane = (int)__builtin_amdgcn_mbcnt_hi(~0u, __builtin_amdgcn_mbcnt_lo(~0u, 0u)), tid = wid * 64 + lane, wr = wid >> 2, wc = wid & 3, fr = lane & 15, fq = lane >> 4;
    float z0 = 0.f; asm volatile("" : "+v"(z0));
    const int KB = g.KB, nt = KB / 128;
    int R0, C2; { int C; stage_rc(tid * 16, R0, C); C2 = C * 2; }
    unsigned voffB[2]; { const int Rb = Epi::PERM ? ((R0 & ~31) + perm32(R0 & 31)) : R0; voffB[0] = (unsigned)(Rb * KB + C2); voffB[1] = voffB[0] + 64u * (unsigned)KB; }
    const unsigned kstep = 128u, hstep = (unsigned)HALF * KB, tstep = 2u * hstep;
    const unsigned ldsw = (unsigned)wid * 1024u;
    const int aoff = lds_byte(wr * 64 + fr, fq * 8); int boff = lds_byte(wc * 32 + fr, fq * 8) + 4 * HTB; asm volatile("" : "+v"(boff));
    LAS int* tokb = (LAS int*)(lds + LDS_TOK);
    const auto rsA = __builtin_amdgcn_make_buffer_rsrc((void*)g.A, 0, 0x7fffffff, 0x00020000);
    const auto rsB = __builtin_amdgcn_make_buffer_rsrc((void*)g.Bt, 0, 0x7fffffff, 0x00020000);
    const auto rsT = __builtin_amdgcn_make_buffer_rsrc((void*)(GATHER ? (const void*)g.rowmap : g.A), 0, 0x7fffffff, 0x00020000);
#define PG8_SA(b, h) (((b) * 2 + (h)) * HTB)
#define PG8_SB(b, h) ((4 + (b) * 2 + (h)) * HTB)
#define PG8_STAGE(bufoff, rs, soff, voff) do { _Pragma("unroll") for (int _i = 0; _i < 2; ++_i) { \
        if constexpr (GATHER) __builtin_amdgcn_raw_ptr_buffer_load_lds(rs, (LAS void*)(lds + (bufoff) + ldsw + _i * 8192), 16, (int)(voff)[_i], (int)(soff), 0, 0); \
        else __builtin_amdgcn_raw_ptr_buffer_load_lds(rs, (LAS void*)(lds + (bufoff) + ldsw + _i * 8192), 16, (int)(voff)[0], (int)((soff) + _i * 64u * (unsigned)KB), 0, 0); } } while (0)
#define PG8_LDA(dst, b, h) do { _Pragma("unroll") for (int m = 0; m < 4; ++m) _Pragma("unroll") for (int k = 0; k < 2; ++k) dst[m][k] = *(const LAS bf16x8*)(lds + PG8_SA(b, h) + aoff + m * 2048 + k * 1024); } while (0)
#define PG8_LDB(dst, b, h) do { _Pragma("unroll") for (int n = 0; n < 2; ++n) _Pragma("unroll") for (int k = 0; k < 2; ++k) dst[n][k] = *(const LAS bf16x8*)(lds + boff + (PG8_SB(b, h) - 4 * HTB) + n * 2048 + k * 1024); } while (0)
#define PG8_CAT(x) __builtin_shufflevector(__builtin_bit_cast(v4i_t, x[0]), __builtin_bit_cast(v4i_t, x[1]), 0, 1, 2, 3, 4, 5, 6, 7)
#define PG8_MMA(ai, bj, At, Bt) do { __builtin_amdgcn_s_setprio(1); _Pragma("unroll") for (int m = 0; m < 4; ++m) _Pragma("unroll") for (int n = 0; n < 2; ++n) { \
        if constexpr (FP8) acc[ai][bj][m][n] = __builtin_amdgcn_mfma_scale_f32_16x16x128_f8f6f4(PG8_CAT(Bt[n]), PG8_CAT(At[m]), acc[ai][bj][m][n], 0, 0, 0, 0, 0, 0); \
        else { _Pragma("unroll") for (int k = 0; k < 2; ++k) acc[ai][bj][m][n] = __builtin_amdgcn_mfma_f32_16x16x32_bf16(Bt[n][k], At[m][k], acc[ai][bj][m][n], 0, 0, 0); } } __builtin_amdgcn_s_setprio(0); } while (0)
#define PG8_WAIT_V(n) asm volatile("s_waitcnt vmcnt(" #n ")" ::: "memory")
#define PG8_WAIT_L(n) asm volatile("s_waitcnt lgkmcnt(" #n ")" ::: "memory")
#define PG8_BAR __builtin_amdgcn_s_barrier()
#define PG8_SCHED __builtin_amdgcn_sched_barrier(0)
    Unit cur, nxt; int ui = 0;
    if (!S.next(0, cur)) return;
    f32x4 acc[2][2][4][2];
#pragma unroll
    for (int a = 0; a < 2; ++a)
#pragma unroll
        for (int b = 0; b < 2; ++b)
#pragma unroll
            for (int m = 0; m < 4; ++m)
#pragma unroll
                for (int n = 0; n < 2; ++n) acc[a][b][m][n] = (f32x4){z0, z0, z0, z0};
    bf16x8 At[4][2], B0[2][2], B1[2][2];
    unsigned cA, cB = (unsigned)cur.e * (unsigned)g.bstride + (unsigned)cur.pn * tstep;
    unsigned voffA[2]; voffA[0] = (unsigned)(R0 * KB + C2); voffA[1] = voffA[0] + 64u * (unsigned)KB;
    if constexpr (GATHER) { cA = 0u;
        if (wid < 4) __builtin_amdgcn_raw_ptr_buffer_load_lds(rsT, (LAS void*)(tokb + wid * 64), 4, (wid * 64 + lane) * 4, cur.pm * (BM * 4), 0, 0);
        asm volatile("s_waitcnt vmcnt(0)" ::: "memory"); __builtin_amdgcn_s_barrier();
    } else cA = (unsigned)cur.pm * tstep;
    const unsigned hA = GATHER ? 0u : hstep;
#define PG8_OA(dst, sel, h) unsigned dst[2]; if constexpr (GATHER) { dst[0] = (unsigned)(tokb[(sel) * 256 + (h) * HALF + R0] * KB + C2); dst[1] = (unsigned)(tokb[(sel) * 256 + (h) * HALF + R0 + 64] * KB + C2); } else { dst[0] = voffA[0]; dst[1] = voffA[1]; }
    { PG8_OA(p0_, 0, 0); PG8_OA(p1_, 0, 1); PG8_STAGE(PG8_SB(0, 0), rsB, cB, voffB); PG8_STAGE(PG8_SB(0, 1), rsB, cB + hstep, voffB); PG8_STAGE(PG8_SA(0, 0), rsA, cA, p0_); PG8_STAGE(PG8_SA(0, 1), rsA, cA + hA, p1_); }
    if (wr == 1) PG8_BAR;
    PG8_WAIT_V(2); PG8_BAR;
    { PG8_OA(p0_, 0, 0); PG8_STAGE(PG8_SB(1, 0), rsB, cB + kstep, voffB); PG8_STAGE(PG8_SA(1, 0), rsA, cA + kstep, p0_); PG8_STAGE(PG8_SB(1, 1), rsB, cB + hstep + kstep, voffB); }
    PG8_WAIT_V(6); PG8_BAR;
    for (;;) {
        const bool has_next = S.next(ui + 1, nxt);
        unsigned nA = cA, nB = cB;
        if (has_next) { nB = (unsigned)nxt.e * (unsigned)g.bstride + (unsigned)nxt.pn * tstep;
            if constexpr (GATHER) { if (wid < 4) { const int ln_ = (int)__builtin_amdgcn_mbcnt_hi(~0u, __builtin_amdgcn_mbcnt_lo(~0u, 0u)); __builtin_amdgcn_raw_ptr_buffer_load_lds(rsT, (LAS void*)(tokb + ((ui + 1) & 1) * 256 + wid * 64), 4, (wid * 64 + ln_) * 4, nxt.pm * (BM * 4), 0, 0); } }
            else nA = (unsigned)nxt.pm * tstep; }
#pragma unroll 1
        for (int t = 0; t < nt; t += 2) {
            const bool last = (t == nt - 2);
            const unsigned a1 = cA + (unsigned)(t + 1) * kstep;
            const unsigned a2 = last ? nA : cA + (unsigned)(t + 2) * kstep, b2 = last ? nB : cB + (unsigned)(t + 2) * kstep;
            const unsigned a3 = a2 + kstep, b3 = b2 + kstep;
            const int selc = ui & 1, seln = (last && has_next) ? ((ui + 1) & 1) : selc;
            PG8_LDB(B0, 0, 0); PG8_LDB(B1, 0, 1); PG8_SCHED; PG8_LDA(At, 0, 0); { PG8_OA(q_, selc, 1); PG8_STAGE(PG8_SA(1, 1), rsA, a1 + hA, q_); }
            PG8_WAIT_V(8); PG8_WAIT_L(0); PG8_BAR; PG8_MMA(0, 0, At, B0); PG8_MMA(0, 1, At, B1); PG8_BAR; PG8_SCHED;
            PG8_LDA(At, 0, 1); PG8_STAGE(PG8_SB(0, 0), rsB, b2, voffB); PG8_STAGE(PG8_SB(0, 1), rsB, b2 + hstep, voffB); { PG8_OA(q_, seln, 0); PG8_STAGE(PG8_SA(0, 0), rsA, a2, q_); }
            PG8_WAIT_V(8); PG8_WAIT_L(0); PG8_BAR; PG8_MMA(1, 0, At, B0); PG8_MMA(1, 1, At, B1); PG8_BAR; PG8_SCHED;
            PG8_LDB(B0, 1, 0); PG8_LDB(B1, 1, 1); PG8_SCHED; PG8_LDA(At, 1, 0); { PG8_OA(q_, seln, 1); PG8_STAGE(PG8_SA(0, 1), rsA, a2 + hA, q_); }
            PG8_WAIT_V(8); PG8_WAIT_L(0); PG8_BAR; PG8_MMA(0, 0, At, B0); PG8_MMA(0, 1, At, B1); PG8_BAR; PG8_SCHED;
            PG8_LDA(At, 1, 1); PG8_STAGE(PG8_SB(1, 0), rsB, b3, voffB); PG8_STAGE(PG8_SB(1, 1), rsB, b3 + hstep, voffB); { PG8_OA(q_, seln, 0); PG8_STAGE(PG8_SA(1, 0), rsA, a3, q_); }
            PG8_WAIT_V(8); PG8_WAIT_L(0); PG8_BAR; PG8_MMA(1, 0, At, B0); PG8_MMA(1, 1, At, B1); PG8_BAR; PG8_SCHED;
        }
        if (wr == 0) PG8_BAR;
        E(acc, cur, wr, wc, fr, fq);
        if (!has_next) break;
#pragma unroll
        for (int a = 0; a < 2; ++a)
#pragma unroll
            for (int b = 0; b < 2; ++b)
#pragma unroll
                for (int m = 0; m < 4; ++m)
#pragma unroll
                    for (int n = 0; n < 2; ++n) acc[a][b][m][n] = (f32x4){z0, z0, z0, z0};
        cur = nxt; cA = nA; cB = nB; ++ui;
        if (wr == 1) PG8_BAR;
    }
    PG8_WAIT_V(0);
    PG8_BAR;
#undef PG8_SA
#undef PG8_SB
#undef PG8_STAGE
#undef PG8_OA
#undef PG8_LDA
#undef PG8_LDB
#undef PG8_MMA
#undef PG8_CAT
#undef PG8_WAIT_V
#undef PG8_WAIT_L
#undef PG8_BAR
#undef PG8_SCHED
}

typedef GAS unsigned gu32;
#define XB_TMO      128
#define XB_XCNT(j)  (256  + 64 * (j))
#define XB_XSUB(j)  (1280 + 64 * (j))
#define XB_XGEN(j)  (2304 + 64 * (j))
#define XB_TOP      3328
#define XB_TOPGEN   3392
#define XCD_BAR_WORDS 3456
#define XB_SPIN_CAP (1u << 20)
DEV unsigned xb_ld(unsigned* p) { return __hip_atomic_load(p, __ATOMIC_RELAXED, __HIP_MEMORY_SCOPE_AGENT); }
DEV unsigned xb_add(unsigned* p, unsigned v) { return __hip_atomic_fetch_add(p, v, __ATOMIC_RELAXED, __HIP_MEMORY_SCOPE_AGENT); }
DEV unsigned xb_xcc_id() { return (unsigned)__builtin_amdgcn_s_getreg((3 << 11) | 20) & 0xFu; }
#define XB_SPIN(cond, bar) do { unsigned _sp = 0; while (cond) { __builtin_amdgcn_s_sleep(1); \
    if ((++_sp & 255u) == 0u) { if (xb_ld(&(bar)[XB_TMO])) break; if (_sp > XB_SPIN_CAP) { atomicAdd(&(bar)[XB_TMO], 1u); break; } } } } while (0)
struct XcdBarrier { unsigned* bar; unsigned x; volatile LAS unsigned* st; int wave; };
DEV bool xb_thread0(int wave) { return wave == 0 && __builtin_amdgcn_mbcnt_hi(~0u, __builtin_amdgcn_mbcnt_lo(~0u, 0u)) == 0u; }
DEV XcdBarrier xcd_barrier_post(unsigned* bar, volatile LAS unsigned* st, int wave) {
    XcdBarrier b; b.bar = bar; b.x = xb_xcc_id(); b.st = st; b.wave = wave;
    if (xb_thread0(wave)) (void)xb_add(&bar[XB_XCNT(b.x)], 1u);
    return b;
}
DEV void xcd_barrier_complete(unsigned* bar, unsigned x, unsigned& nloc, unsigned& nx) {
    const unsigned G = gridDim.x * gridDim.y * gridDim.z;
    unsigned sum, cnt, mine, sp = 0u;
    for (;;) {
        sum = 0u; cnt = 0u; mine = 0u;
#pragma unroll
        for (unsigned j = 0; j < 16; ++j) { const unsigned c = xb_ld(&bar[XB_XCNT(j)]); sum += c; cnt += (c > 0u) ? 1u : 0u; mine = (j == x) ? c : mine; }
        if (sum == G) break;
        __builtin_amdgcn_s_sleep(1);
        if ((++sp & 255u) == 0u) { if (xb_ld(&bar[XB_TMO])) break; if (sp > XB_SPIN_CAP) { atomicAdd(&bar[XB_TMO], 1u); break; } }
    }
    nloc = mine > 0u ? mine : 1u; nx = cnt > 0u ? cnt : 1u;
}
DEV void xcd_barrier(const XcdBarrier& b) {
    asm volatile("s_waitcnt vmcnt(0)" ::: "memory");
    __syncthreads();
    if (xb_thread0(b.wave)) {
        unsigned* bar = b.bar;
        __builtin_amdgcn_s_waitcnt(0);
        unsigned nloc = b.st[0], nx = b.st[1];
        if (nloc == 0u) { xcd_barrier_complete(bar, b.x, nloc, nx); b.st[0] = nloc; b.st[1] = nx; }
        const unsigned old = xb_add(&bar[XB_XSUB(b.x)], 1u);
        const unsigned gen = old / nloc;
        if (old + 1u == (gen + 1u) * nloc) {
            __builtin_amdgcn_fence(__ATOMIC_RELEASE, "agent");
            asm volatile("s_waitcnt vmcnt(0)" ::: "memory");
            const unsigned og = xb_add(&bar[XB_TOP], 1u);
            const unsigned tg = og / nx;
            if (og + 1u == (tg + 1u) * nx) xb_add(&bar[XB_TOPGEN], 1u);
            else XB_SPIN(xb_ld(&bar[XB_TOPGEN]) == tg, bar);
            __builtin_amdgcn_fence(__ATOMIC_ACQUIRE, "agent");
            xb_add(&bar[XB_XGEN(b.x)], 1u);
            asm volatile("s_waitcnt vmcnt(0)" ::: "memory");
        } else {
            XB_SPIN(xb_ld(&bar[XB_XGEN(b.x)]) == gen, bar);
            __builtin_amdgcn_fence(__ATOMIC_ACQUIRE, "agent");
            asm volatile("s_waitcnt vmcnt(0)" ::: "memory");
        }
    }
    __syncthreads();
}
constexpr size_t MiB = 1u << 20;
constexpr int PMAX = 131072 + 32 * 256;
constexpr size_t W_CTL = 0, CTL_ZERO_BYTES = 1 * MiB;
constexpr size_t W_IN0 = 2 * MiB, W_GLU = 6 * MiB, W_OUT0 = 7 * MiB, W_IN1 = 9 * MiB, W_OUT1 = 16 * MiB;
constexpr size_t W_LUT = 18 * MiB, W_KM = W_LUT + 64 * 1024, W_HIST = W_KM + 256 * 1024, W_SORT = W_HIST + 64 * 1024  , W_GR = 20 * MiB  , W_SS = 22 * MiB  ;
constexpr size_t W_GU = 32 * MiB, W_DN = 288 * MiB, W_XB = 416 * MiB  , W_XBB = 480 * MiB  , W_X8 = 1024 * MiB  , W_HB = 736 * MiB, W_YS5 = 928 * MiB, W_Y0 = 960 * MiB, W_MIXB = 1024 * MiB, W_GLAO = 1088 * MiB;
constexpr size_t W_ROUTE = 26 * MiB  , W_ACT = 736 * MiB  , W_YS = 1160 * MiB, W_END = 1432 * MiB;
static_assert(W_ACT + (size_t)PMAX * 2048 <= W_MIXB && W_YS + (size_t)PMAX * 2048 <= W_END && W_X8 + (size_t)PMAX * 1024 <= W_YS && W_ROUTE + 4 * MiB <= W_GU, "ws map");
constexpr int CW_BAR = 4096;

struct Args { const float* in[29]; float* out; unsigned char* ws; int ph_lo, ph_hi; };
struct Frame {
    LAS unsigned char* lds; int tid, lane, wave, vcu, G;
    const float* const* in; unsigned char* ws;
};
#define WSP(T_, off) ((T_*)(F.ws + (off)))

DEV unsigned pk4_fp8(float a, float b, float c, float d) { unsigned w = 0u; w = __builtin_amdgcn_cvt_pk_fp8_f32(a, b, w, false); w = __builtin_amdgcn_cvt_pk_fp8_f32(c, d, w, true); return w; }
struct CvItem { const float* src; unsigned char* dst; int pitch, K; float sc; };
constexpr int P0_I_GU = 16 * 32, P0_I_DN = 16 * 16, P0_I_IN0 = 16 * 32, P0_I_GLU = 8 * 8, P0_I_O = 16 * 16, P0_I_IN1 = 16 * 48;
constexpr int P0_N_GU = 64 * P0_I_GU, P0_N_DN = 64 * P0_I_DN, P0_NITEMS = P0_N_GU + P0_N_DN + P0_I_IN0 + P0_I_GLU + 2 * P0_I_O + P0_I_IN1;
DEV CvItem cv_decode(Frame& F, int it, int lane) {
    int r = it; const float* W; unsigned char* D; int K, N, NP, es; float sc = 0.f;
    if (r < P0_N_GU) { const int m = r / P0_I_GU; r %= P0_I_GU; W = F.in[25] + (size_t)m * 1024 * 2048; D = WSP(unsigned char, W_GU) + (size_t)m * 2048 * 1024; K = 1024; N = 2048; NP = 2048; es = 1; sc = 64.f; }
    else if ((r -= P0_N_GU) < P0_N_DN) { const int m = r / P0_I_DN; r %= P0_I_DN; W = F.in[27] + (size_t)m * 1024 * 1024; D = WSP(unsigned char, W_DN) + (size_t)m * 1024 * 1024; K = 1024; N = 1024; NP = 1024; es = 1; sc = 128.f; }
    else if ((r -= P0_N_DN) < P0_I_IN0) { W = F.in[1]; D = WSP(unsigned char, W_IN0); K = 1024; N = 2048; NP = 2048; es = 2; }
    else if ((r -= P0_I_IN0) < P0_I_GLU) { W = F.in[10]; D = WSP(unsigned char, W_GLU); K = 512; N = 512; NP = 512; es = 2; }
    else if ((r -= P0_I_GLU) < P0_I_O) { W = F.in[13]; D = WSP(unsigned char, W_OUT0); K = 1024; N = 1024; NP = 1024; es = 2; }
    else if ((r -= P0_I_O) < P0_I_O) { W = F.in[18]; D = WSP(unsigned char, W_OUT1); K = 1024; N = 1024; NP = 1024; es = 2; }
    else { r -= P0_I_O; W = F.in[14]; D = WSP(unsigned char, W_IN1); K = 1024; N = 3072; NP = 3088; es = 2; }
    const int nblk = N / 64, kb = r / nblk, nb = r % nblk;
    CvItem c; c.src = W + (size_t)(64 * kb) * NP + 64 * nb + lane; c.dst = D + ((size_t)(64 * nb) * K + 64 * kb) * es; c.pitch = NP; c.K = K; c.sc = sc; return c;
}
DEV void cv_load(const CvItem& c, float (&v)[64]) {
#pragma unroll
    for (int kk = 0; kk < 64; ++kk) v[kk] = c.src[(size_t)kk * c.pitch];
}
DEV void cv_store(const CvItem& c, const float (&v)[64], LAS float* scr, int lane) {
#pragma unroll
    for (int kk = 0; kk < 64; ++kk) scr[kk * 65 + lane] = v[kk];
    asm volatile("s_waitcnt lgkmcnt(0)" ::: "memory");
    const int cc = lane & 7;
    if (c.sc > 0.f) {
#pragma unroll
        for (int j = 0; j < 8; ++j) { const int n = (lane >> 3) + 8 * j; const LAS float* s = scr + (8 * cc) * 65 + n; const float q = c.sc;
            u32x2 o; o.x = pk4_fp8(s[0 * 65] * q, s[1 * 65] * q, s[2 * 65] * q, s[3 * 65] * q); o.y = pk4_fp8(s[4 * 65] * q, s[5 * 65] * q, s[6 * 65] * q, s[7 * 65] * q);
            *(u32x2*)(c.dst + (size_t)n * c.K + 8 * cc) = o; }
    } else {
#pragma unroll
        for (int j = 0; j < 8; ++j) { const int n = (lane >> 3) + 8 * j; const LAS float* s = scr + (8 * cc) * 65 + n;
            u32x4 o; o.x = cvt_pk(s[0 * 65], s[1 * 65]); o.y = cvt_pk(s[2 * 65], s[3 * 65]); o.z = cvt_pk(s[4 * 65], s[5 * 65]); o.w = cvt_pk(s[6 * 65], s[7 * 65]);
            *(u32x4*)(c.dst + ((size_t)n * c.K + 8 * cc) * 2) = o; }
    }
    asm volatile("s_waitcnt lgkmcnt(0)" ::: "memory");
}
__constant__ int BUCKET_TH2[16] = {16, 22, 30, 40, 54, 73, 99, 134, 182, 246, 332, 450, 609, 825, 1117, 1513};
DEV void p0_prologue(Frame& F) {
    { LAS float* scr = (LAS float*)(F.lds + F.wave * 16640); const int gw = F.vcu * 8 + F.wave, NGW = F.G * 8;
      float va[64], vb[64];
      int it = gw;
      if (it < P0_NITEMS) { CvItem ca = cv_decode(F, it, F.lane); cv_load(ca, va);
#pragma unroll 1
          for (;;) {
              const int it2 = it + NGW; CvItem cb = ca; const bool h2 = it2 < P0_NITEMS; if (h2) { cb = cv_decode(F, it2, F.lane); cv_load(cb, vb); }
              cv_store(ca, va, scr, F.lane);
              if (!h2) break;
              const int it3 = it2 + NGW; const bool h3 = it3 < P0_NITEMS; if (h3) { ca = cv_decode(F, it3, F.lane); cv_load(ca, va); }
              cv_store(cb, vb, scr, F.lane);
              if (!h3) break;
              it = it3;
          } } }
    const int gt = F.vcu * 512 + F.tid, NGT = F.G * 512;
    for (int i = gt; i < 16 * 1024; i += NGT) { const int n = i >> 10, k = i & 1023; WSP(bf16_t, W_IN1)[(size_t)(3072 + n) * 1024 + k] = (bf16_t)(cvt_pk(F.in[14][(size_t)k * 3088 + 3072 + n], 0.f) & 0xffffu); }
    { const f32x4* x4 = (const f32x4*)F.in[0]; u32x2* o = WSP(u32x2, W_XB);
      for (size_t i = gt; i < (size_t)T * 1024 / 4; i += (size_t)NGT * 8) { f32x4 v[8];
#pragma unroll
          for (int u = 0; u < 8; ++u) v[u] = x4[i + (size_t)u * NGT];
#pragma unroll
          for (int u = 0; u < 8; ++u) { u32x2 w; w.x = cvt_pk(v[u].x, v[u].y); w.y = cvt_pk(v[u].z, v[u].w); o[i + (size_t)u * NGT] = w; } } }
    for (int i = gt; i < 8 * 2048; i += NGT) { const int h = i >> 11, n = i & 2047; int bk = n;
        if (n >= 16) { bk = 16;
#pragma unroll
            for (int q = 1; q < 16; ++q) bk += (n >= BUCKET_TH2[q]) ? 1 : 0; }
        WSP(float, W_LUT)[i] = F.in[12][bk * 8 + h] * 1.4426950408889634f; }
}

DEV void p_kmean(Frame& F) {
    const int gw = F.vcu * 8 + F.wave, NGW = F.G * 8; const bf16_t* H0 = WSP(bf16_t, W_HB); float* KM = WSP(float, W_KM);
    for (int it = gw; it < 1024; it += NGW) { const int blk = it & 7, h = (it >> 3) & 7, b = it >> 6; const int r8 = F.lane >> 3, c = F.lane & 7;
        const bf16_t* p = H0 + (size_t)(b * 2048 + blk * 256 + r8) * 2048 + 1024 + h * 64 + c * 8; float s[8];
#pragma unroll
        for (int j = 0; j < 8; ++j) s[j] = 0.f;
#pragma unroll 8
        for (int i = 0; i < 32; ++i) { const u32x4 v = *(const u32x4*)(p + (size_t)i * 8 * 2048);
            s[0] += bflo(v.x); s[1] += bfhi(v.x); s[2] += bflo(v.y); s[3] += bfhi(v.y); s[4] += bflo(v.z); s[5] += bfhi(v.z); s[6] += bflo(v.w); s[7] += bfhi(v.w); }
#pragma unroll
        for (int j = 0; j < 8; ++j) { s[j] += __shfl_xor(s[j], 8); s[j] += __shfl_xor(s[j], 16); s[j] += __shfl_xor(s[j], 32); }
        if (F.lane < 8) {
#pragma unroll
            for (int j = 0; j < 8; ++j) KM[(size_t)it * 64 + c * 8 + j] = s[j] * (1.f / 256.f); } }
}

DEV void s5_item(Frame& F, int b, int g, LAS unsigned char* sl  ) {
    const int lane = F.lane, p0 = lane & 31, hi = lane >> 5, q4 = lane >> 4;
    const float* lam_re = F.in[2]; const float* lam_im = F.in[3]; const float* log_dt = F.in[4]; const float* b_re = F.in[5]; const float* b_im = F.in[6];
    const float* c_re = F.in[7]; const float* c_im = F.in[8]; const float* dsk = F.in[9];
    const bf16_t* H0 = WSP(bf16_t, W_HB); bf16_t* YS = WSP(bf16_t, W_YS5);
    const float dt = __expf(log_dt[g]);
    float ar[2], ai[2]; bf16x8 bfr[4];
#pragma unroll
    for (int s = 0; s < 2; ++s) { const int p = p0 + 32 * s; const float lr = lam_re[g * 64 + p], li = lam_im[g * 64 + p]; const float mag = __expf(lr * dt);
        ar[s] = mag * cosf(li * dt); ai[s] = mag * sinf(li * dt);
        const float er = ar[s] - 1.f, ei = ai[s], den = lr * lr + li * li; const float qr = (er * lr + ei * li) / den, qi = (ei * lr - er * li) / den;
        u32x4 wr_, wi_; float vr[8], vi[8];
#pragma unroll
        for (int j = 0; j < 8; ++j) { const float br = b_re[(g * 64 + p) * 16 + 8 * hi + j], bi = b_im[(g * 64 + p) * 16 + 8 * hi + j]; vr[j] = qr * br - qi * bi; vi[j] = qr * bi + qi * br; }
        wr_.x = cvt_pk(vr[0], vr[1]); wr_.y = cvt_pk(vr[2], vr[3]); wr_.z = cvt_pk(vr[4], vr[5]); wr_.w = cvt_pk(vr[6], vr[7]);
        wi_.x = cvt_pk(vi[0], vi[1]); wi_.y = cvt_pk(vi[2], vi[3]); wi_.z = cvt_pk(vi[4], vi[5]); wi_.w = cvt_pk(vi[6], vi[7]);
        bfr[2 * s] = __builtin_bit_cast(bf16x8, wr_); bfr[2 * s + 1] = __builtin_bit_cast(bf16x8, wi_); }
    bf16x8 cfr[4];
#pragma unroll
    for (int ks = 0; ks < 4; ++ks) { float v[8];
#pragma unroll
        for (int j = 0; j < 8; ++j) { const int c = 32 * ks + 8 * q4 + j, p = c >> 1; const int h = lane & 15; v[j] = (c & 1) ? -c_im[(g * 16 + h) * 64 + p] : c_re[(g * 16 + h) * 64 + p]; }
        u32x4 w; w.x = cvt_pk(v[0], v[1]); w.y = cvt_pk(v[2], v[3]); w.z = cvt_pk(v[4], v[5]); w.w = cvt_pk(v[6], v[7]); cfr[ks] = __builtin_bit_cast(bf16x8, w); }
    float dv[4];
#pragma unroll
    for (int r = 0; r < 4; ++r) dv[r] = dsk[g * 16 + 4 * q4 + r];
    const int tm = 16 * ((p0 >> 2) & 1) + 4 * (p0 >> 3) + (p0 & 3);
    const bf16_t* urow = H0 + (size_t)(b * 2048 + tm) * 2048 + g * 16 + 8 * hi;
    float cr[2] = {0.f, 0.f}, ci[2] = {0.f, 0.f};
    bf16x8 ufr = *(const bf16x8*)urow;
    for (int tile = 0; tile < 64; ++tile) {
        const bf16x8 ucur = ufr;
        if (tile + 1 < 64) ufr = *(const bf16x8*)(urow + (size_t)(tile + 1) * 32 * 2048);
        f32x16 x[4];
#pragma unroll
        for (int n = 0; n < 4; ++n) { f32x16 z;
#pragma unroll
            for (int r = 0; r < 16; ++r) z[r] = 0.f;
            x[n] = __builtin_amdgcn_mfma_f32_32x32x16_bf16(ucur, bfr[n], z, 0, 0, 0); }
#pragma unroll
        for (int s = 0; s < 2; ++s) {
            f32x16& xr = x[2 * s]; f32x16& xi = x[2 * s + 1];
            float sr = hi ? 0.f : cr[s], si = hi ? 0.f : ci[s];
#pragma unroll
            for (int r = 0; r < 16; ++r) { const float nr = ar[s] * sr - ai[s] * si + xr[r], ni = ar[s] * si + ai[s] * sr + xi[r]; xr[r] = nr; xi[r] = ni; sr = nr; si = ni; }
            const float o_r = swap32(sr), o_i = swap32(si);
            float wr_ = hi ? o_r : 0.f, wi_ = hi ? o_i : 0.f;
#pragma unroll
            for (int r = 0; r < 16; ++r) { const float nr = ar[s] * wr_ - ai[s] * wi_, ni = ar[s] * wi_ + ai[s] * wr_; wr_ = nr; wi_ = ni; xr[r] += wr_; xi[r] += wi_; }
            const float e_r = swap32(xr[15]), e_i = swap32(xi[15]);
            cr[s] = hi ? xr[15] : e_r; ci[s] = hi ? xi[15] : e_i;
#pragma unroll
            for (int r = 0; r < 16; ++r) *(LAS unsigned*)(sl + (16 * hi + r) * 256 + (p0 + 32 * s) * 4) = cvt_pk(xr[r], xi[r]);
        }
#pragma unroll
        for (int tt = 0; tt < 2; ++tt) {
            f32x4 y = {0.f, 0.f, 0.f, 0.f};
#pragma unroll
            for (int ks = 0; ks < 4; ++ks) { const bf16x8 sf = *(const LAS bf16x8*)(sl + (16 * tt + (lane & 15)) * 256 + ks * 64 + q4 * 16); y = __builtin_amdgcn_mfma_f32_16x16x32_bf16(cfr[ks], sf, y, 0, 0, 0); }
            const int t = tile * 32 + 16 * tt + (lane & 15);
            const u32x2 uw = *(const u32x2*)(H0 + (size_t)(b * 2048 + t) * 2048 + g * 16 + 4 * q4);
            const float y0 = gelu_tanh(y[0] + dv[0] * bflo(uw.x)), y1 = gelu_tanh(y[1] + dv[1] * bfhi(uw.x)), y2 = gelu_tanh(y[2] + dv[2] * bflo(uw.y)), y3 = gelu_tanh(y[3] + dv[3] * bfhi(uw.y));
            u32x2 ow; ow.x = cvt_pk(y0, y1); ow.y = cvt_pk(y2, y3);
            *(u32x2*)(YS + (size_t)(b * 2048 + t) * 512 + g * 16 + 4 * q4) = ow;
        }
    }
}

constexpr int AT_K = 0, AT_V = 24576, AT_WS = 49152, AT_OST = 51200, AT_LUT = AT_OST + 8 * 4096  , AT_LUTB = 8704, AT_Q = AT_LUT + 8 * AT_LUTB  , AT_END = AT_Q + 64;
DEV int crow(int r, int hi) { return (r & 3) + 8 * (r >> 2) + 4 * hi; }
DEV s16x4 vtr(const LAS unsigned char* p) { typedef short v4i16_t __attribute__((ext_vector_type(4))); return __builtin_bit_cast(s16x4, __builtin_amdgcn_ds_read_tr16_b64_v4i16((LAS v4i16_t*)p)); }
DEV void moba_unit(Frame& F, int b, int h, int own) {
    const int lane = F.lane, wid = F.wave, r32 = lane & 31, hi = lane >> 5;
    LAS unsigned char* lds = F.lds;
    const bf16_t* H0 = WSP(bf16_t, W_HB); const float* KM = WSP(float, W_KM);
    LAS float* lut = (LAS float*)(lds + AT_LUT + h * AT_LUTB); LAS float* wsf = (LAS float*)(lds + AT_WS) + wid * 64;
    const size_t rowbase = (size_t)b * 2048;
    const int qpos = own * 256 + wid * 32 + r32;
    bf16x8 qr[4];
#pragma unroll
    for (int d0 = 0; d0 < 4; ++d0) qr[d0] = *(const bf16x8*)(H0 + (rowbase + qpos) * 2048 + 512 + h * 64 + d0 * 16 + hi * 8);
    unsigned selmask = 0u;
    if (own > 0) {
        float gate[7];
#pragma unroll
        for (int j = 0; j < 7; ++j) { float s = 0.f;
            if (j < own) { const float* km = KM + ((size_t)(b * 8 + h) * 8 + j) * 64 + hi * 8;
#pragma unroll
                for (int d0 = 0; d0 < 4; ++d0) { const f32x4 k0 = *(const f32x4*)(km + d0 * 16), k1 = *(const f32x4*)(km + d0 * 16 + 4); const u32x4 qw = __builtin_bit_cast(u32x4, qr[d0]);
                    s += bflo(qw.x) * k0.x + bfhi(qw.x) * k0.y + bflo(qw.y) * k0.z + bfhi(qw.y) * k0.w + bflo(qw.z) * k1.x + bfhi(qw.z) * k1.y + bflo(qw.w) * k1.z + bfhi(qw.w) * k1.w; } }
            gate[j] = s + swap32(s); }
#pragma unroll
        for (int j = 0; j < 7; ++j) { int rank = 0;
#pragma unroll
            for (int j2 = 0; j2 < 7; ++j2) if (j2 != j && j2 < own && (gate[j2] > gate[j] || (gate[j2] == gate[j] && j2 < j))) ++rank;
            if (j < own && rank < 3) selmask |= 1u << j; }
    }
    const int NT = 4 * (own + 1);
#define KV0(i) ((i) < 4 ? own * 256 + (i) * 64 : (((i) - 4) >> 2) * 256 + (((i) - 4) & 3) * 64)
    const bf16_t* kbase = H0 + (rowbase + lane) * 2048 + 1024 + h * 64 + wid * 8;
    const bf16_t* vbase = H0 + (rowbase + 16 * (wid & 3) + (lane >> 2)) * 2048 + 1536 + h * 64 + (wid >> 2) * 32 + (lane & 3) * 8;
#define LOADKV(i, bo_) do { const int kv0_ = KV0(i); \
        __builtin_amdgcn_global_load_lds((const unsigned*)(kbase + (size_t)kv0_ * 2048), (LAS unsigned*)(lds + AT_K + bo_ + wid * 1024), 16, 0, 0); \
        __builtin_amdgcn_global_load_lds((const unsigned*)(vbase + (size_t)kv0_ * 2048), (LAS unsigned*)(lds + AT_V + bo_ + wid * 1024), 16, 0, 0); } while (0)
    LOADKV(0, 0); LOADKV(1, 8192);
    int bo = 0, bo2 = 16384;
    float m_ref = 0.f, l_run = 0.f; f32x16 o[2];
#pragma unroll
    for (int r = 0; r < 16; ++r) { o[0][r] = 0.f; o[1][r] = 0.f; }
    const int Q0 = own * 256 + wid * 32;
#pragma unroll 1
    for (int i = 0; i < NT; ++i) {
        if (i + 1 < NT) asm volatile("s_waitcnt vmcnt(2) lgkmcnt(0)\n\ts_barrier" ::: "memory"); else asm volatile("s_waitcnt vmcnt(0) lgkmcnt(0)\n\ts_barrier" ::: "memory");
        if (i + 2 < NT) LOADKV(i + 2, bo2);
        const int kv0 = KV0(i);
        const bool ownblk = i < 4;
        if (!(ownblk && kv0 > Q0 + 31)) {
            const bool partial = ownblk && (kv0 + 63 > Q0);
            const bool rowsel = ownblk || ((selmask >> ((i - 4) >> 2)) & 1u);
            f32x16 p0, p1;
            { const LAS float* lp = lut + 128 + (qpos - kv0 - 4 * hi - 59);
#pragma unroll
              for (int r = 0; r < 16; ++r) { const int c = (r & 3) + 8 * (r >> 2); p0[r] = lp[59 - c] - m_ref; p1[r] = lp[59 - c - 32] - m_ref; } }
            { const LAS unsigned char* kb = lds + AT_K + bo + hi * 1024 + r32 * 16;
#pragma unroll
              for (int d0 = 0; d0 < 4; ++d0) { const bf16x8 k0 = *(const LAS bf16x8*)(kb + d0 * 2048), k1 = *(const LAS bf16x8*)(kb + d0 * 2048 + 512);
                  p0 = __builtin_amdgcn_mfma_f32_32x32x16_bf16(k0, qr[d0], p0, 0, 0, 0); p1 = __builtin_amdgcn_mfma_f32_32x32x16_bf16(k1, qr[d0], p1, 0, 0, 0); } }
            if (partial) { const int dbase = qpos - kv0 - 4 * hi;
#pragma unroll
                for (int r = 0; r < 16; ++r) { const int d0_ = dbase - ((r & 3) + 8 * (r >> 2)); p0[r] = d0_ >= 0 ? p0[r] : -INFINITY; p1[r] = d0_ >= 32 ? p1[r] : -INFINITY; } }
            float rmax = fmaxf(p0[0], p1[0]);
#pragma unroll
            for (int r = 1; r < 16; ++r) rmax = fmaxf(rmax, fmaxf(p0[r], p1[r]));
            rmax = fmaxf(rmax, swap32(rmax));
            rmax = rowsel ? rmax : -INFINITY;
            if (i == 0 || __any(rmax > 8.f)) {
                const float dl = (i == 0) ? rmax : fmaxf(rmax, 0.f); m_ref += dl;
#pragma unroll
                for (int r = 0; r < 16; ++r) { p0[r] -= dl; p1[r] -= dl; }
                const float alpha = __builtin_amdgcn_exp2f(-dl); l_run *= alpha;
                if (hi == 0) wsf[r32] = alpha;
#pragma unroll
                for (int r = 0; r < 16; ++r) { const float f = wsf[crow(r, hi)]; o[0][r] *= f; o[1][r] *= f; }
            }
            float rs = 0.f;
#pragma unroll
            for (int r = 0; r < 16; ++r) { p0[r] = __builtin_amdgcn_exp2f(p0[r]); p1[r] = __builtin_amdgcn_exp2f(p1[r]); rs += p0[r] + p1[r]; }
            l_run += rowsel ? rs : 0.f;
            const unsigned km = rowsel ? 0xffffffffu : 0u;
            u32x4 pw[4];
            pw[0] = (u32x4){cvt_pk(p0[0], p0[1]) & km, cvt_pk(p0[2], p0[3]) & km, cvt_pk(p0[4], p0[5]) & km, cvt_pk(p0[6], p0[7]) & km};
            pw[1] = (u32x4){cvt_pk(p0[8], p0[9]) & km, cvt_pk(p0[10], p0[11]) & km, cvt_pk(p0[12], p0[13]) & km, cvt_pk(p0[14], p0[15]) & km};
            pw[2] = (u32x4){cvt_pk(p1[0], p1[1]) & km, cvt_pk(p1[2], p1[3]) & km, cvt_pk(p1[4], p1[5]) & km, cvt_pk(p1[6], p1[7]) & km};
            pw[3] = (u32x4){cvt_pk(p1[8], p1[9]) & km, cvt_pk(p1[10], p1[11]) & km, cvt_pk(p1[12], p1[13]) & km, cvt_pk(p1[14], p1[15]) & km};
            { const LAS unsigned char* vp = lds + AT_V + bo + ((lane >> 4) & 1) * 32 + (lane & 3) * 8 + (4 * hi + ((lane & 15) >> 2)) * 64;
#pragma unroll
              for (int d0 = 0; d0 < 2; ++d0)
#pragma unroll
                  for (int ks = 0; ks < 4; ++ks) { const s16x4 lo = vtr(vp + d0 * 4096 + ks * 1024), hh = vtr(vp + d0 * 4096 + ks * 1024 + 512);
                      const bf16x8 vf = (bf16x8){lo[0], lo[1], lo[2], lo[3], hh[0], hh[1], hh[2], hh[3]};
                      o[d0] = __builtin_amdgcn_mfma_f32_32x32x16_bf16(__builtin_bit_cast(bf16x8, pw[ks]), vf, o[d0], 0, 0, 0); } }
        }
        bo = (bo == 16384) ? 0 : bo + 8192; bo2 = (bo2 == 16384) ? 0 : bo2 + 8192;
    }
    __syncthreads();
#undef KV0
#undef LOADKV
    l_run += swap32(l_run);
    if (hi == 0) wsf[32 + r32] = 1.f / l_run;
    bf16_t* Ow = WSP(bf16_t, W_Y0) + (rowbase + own * 256 + wid * 32) * 1024 + 512 + h * 64;
    LAS bf16_t* stg = (LAS bf16_t*)(lds + AT_OST) + wid * 2048;
#pragma unroll
    for (int r = 0; r < 16; ++r) { const int orow = crow(r, hi); const float rl = wsf[32 + orow];
        stg[orow * 64 + r32] = (bf16_t)(cvt_pk(o[0][r] * rl, 0.f) & 0xffffu); stg[orow * 64 + 32 + r32] = (bf16_t)(cvt_pk(o[1][r] * rl, 0.f) & 0xffffu); }
#pragma unroll
    for (int i = 0; i < 4; ++i) { const int row = i * 8 + (lane >> 3), ch = lane & 7; const u32x4 v = *(const LAS u32x4*)(stg + row * 64 + ch * 8); *(u32x4*)(Ow + (size_t)row * 1024 + ch * 8) = v; }
    __syncthreads();
}
constexpr int CW_MOBAQ = 64;
DEV void p_s5_moba(Frame& F, int mode) {
    if ((mode & 1) && (F.vcu & 3) == 3) { const int it = (F.vcu >> 2) * 8 + F.wave; if (it < 512) s5_item(F, it >> 5, it & 31, F.lds + 65536 + F.wave * 8192); }
    __syncthreads();
    if (!(mode & 2)) return;
    for (int i = F.tid; i < 8 * 2176; i += 512) { const int hh = i / 2176, j = i % 2176; ((LAS float*)(F.lds + AT_LUT))[i] = j < 128 ? 0.f : WSP(float, W_LUT)[hh * 2048 + j - 128]; }
    volatile LAS int* qw = (volatile LAS int*)(F.lds + AT_Q);
    unsigned* ctl = (unsigned*)(F.ws + W_CTL);
    for (;;) {
        __syncthreads();
        if (F.tid == 0) qw[0] = (int)__hip_atomic_fetch_add(ctl + CW_MOBAQ, 1u, __ATOMIC_RELAXED, __HIP_MEMORY_SCOPE_AGENT);
        __syncthreads();
        const int u = __builtin_amdgcn_readfirstlane(qw[0]);
        if (u >= 1024) break;
        const int own = 7 - (u >> 7), bh = u & 127;
        moba_unit(F, bh >> 3, bh & 7, own);
    }
}
constexpr size_t R_RE = W_ROUTE, R_RW = W_ROUTE + 512 * 1024, R_POS = W_ROUTE + 1024 * 1024, R_TOK = W_ROUTE + 2 * MiB, R_WGT = W_ROUTE + 3 * MiB;
constexpr int WT_PITCH = 1028;
constexpr int RW_PITCH = 1032;
constexpr int LN_XT = 32 * RW_PITCH * 2;
constexpr int LN_LG = 147456;
constexpr int LN_HIST = LN_LG + 8 * 528;
static_assert(LN_XT + 8 * 8256 <= LDS_TOK && LN_HIST + 128 <= LDSCTL_OFF, "LN LDS map");
template <int MODE, bool ROUTER, bool XIN_F32, bool OUT_F32, bool GRP = false>
DEV void p_ln(Frame& F, const float* xin32, const bf16_t* xinb, bf16_t* xoutb, float* xout32, const float* gam, const float* bet, const float* wrt, const float* brt) {
    LAS bf16_t* whi = (LAS bf16_t*)F.lds; LAS bf16_t* xt = (LAS bf16_t*)(F.lds + LN_XT) + F.wave * 4128; LAS float* lgs = (LAS float*)(F.lds + LN_LG) + F.wave * 132; LAS int* hist = (LAS int*)(F.lds + LN_HIST);
    const int lane = F.lane, l15 = lane & 15, q4 = lane >> 4;
    if constexpr (ROUTER) {
        for (int i = F.tid; i < 1024 * 32; i += 512) { const int k = i >> 5, e = i & 31; whi[e * RW_PITCH + k] = (bf16_t)(cvt_pk(wrt[i], 0.f) & 0xffffu); }
        if (F.tid < 32) hist[F.tid] = 0;
        __syncthreads();
    }
    if constexpr (GRP) {
        const u32x4* src = (const u32x4*)(WSP(bf16_t, W_IN1) + (size_t)3072 * 1024);
        for (int i = F.tid; i < 16 * 128; i += 512) { const int e = i >> 7, c = i & 127; *(LAS u32x4*)(whi + e * RW_PITCH + c * 8) = src[i]; }
        __syncthreads();
    }
    const bf16_t* MIXB = WSP(bf16_t, W_MIXB); const bf16_t* YS = WSP(bf16_t, W_YS); const int* POS = WSP(int, R_POS);
    int* RE = WSP(int, R_RE); float* RW = WSP(float, R_RW);
    const float alpha = 1.4142135623730951f;
    f32x4 gq[4], bq[4];
#pragma unroll
    for (int j = 0; j < 4; ++j) { gq[j] = *(const f32x4*)(gam + j * 256 + lane * 4); bq[j] = *(const f32x4*)(bet + j * 256 + lane * 4); }
    float bias8[8];
    if constexpr (ROUTER) {
#pragma unroll
        for (int r = 0; r < 8; ++r) bias8[r] = brt[(r >> 2) * 16 + 4 * q4 + (r & 3)]; }
    for (int wgi = F.vcu; wgi < 256; wgi += F.G) {
        const int r0 = wgi * 128 + F.wave * 16;
#pragma unroll 1
        for (int i4 = 0; i4 < 16; i4 += 4) {
            float v[4][16];
#pragma unroll
            for (int u = 0; u < 4; ++u) { const int row = r0 + i4 + u;
                if constexpr (XIN_F32) {
#pragma unroll
                    for (int j = 0; j < 4; ++j) { const f32x4 a = *(const f32x4*)(xin32 + (size_t)row * 1024 + j * 256 + lane * 4); v[u][4 * j] = alpha * a.x; v[u][4 * j + 1] = alpha * a.y; v[u][4 * j + 2] = alpha * a.z; v[u][4 * j + 3] = alpha * a.w; }
                } else {
#pragma unroll
                    for (int j = 0; j < 4; ++j) { const u32x2 a = *(const u32x2*)(xinb + (size_t)row * 1024 + j * 256 + lane * 4); v[u][4 * j] = alpha * bflo(a.x); v[u][4 * j + 1] = alpha * bfhi(a.x); v[u][4 * j + 2] = alpha * bflo(a.y); v[u][4 * j + 3] = alpha * bfhi(a.y); }
                }
                if constexpr (MODE == 0) {
#pragma unroll
                    for (int j = 0; j < 4; ++j) { const u32x2 m = *(const u32x2*)(MIXB + (size_t)row * 1024 + j * 256 + lane * 4); v[u][4 * j] += bflo(m.x); v[u][4 * j + 1] += bfhi(m.x); v[u][4 * j + 2] += bflo(m.y); v[u][4 * j + 3] += bfhi(m.y); }
                } else {
                    const int4 pos4 = *(const int4*)(POS + row * 4);
                    const int ps[4] = {__builtin_amdgcn_readfirstlane(pos4.x), __builtin_amdgcn_readfirstlane(pos4.y), __builtin_amdgcn_readfirstlane(pos4.z), __builtin_amdgcn_readfirstlane(pos4.w)};
#pragma unroll
                    for (int kx = 0; kx < 4; ++kx)
#pragma unroll
                        for (int j = 0; j < 4; ++j) { const u32x2 m = *(const u32x2*)(YS + (size_t)ps[kx] * 1024 + j * 256 + lane * 4); v[u][4 * j] += bflo(m.x); v[u][4 * j + 1] += bfhi(m.x); v[u][4 * j + 2] += bflo(m.y); v[u][4 * j + 3] += bfhi(m.y); }
                }
            }
            float s1[4], s2[4];
#pragma unroll
            for (int u = 0; u < 4; ++u) { s1[u] = 0.f; s2[u] = 0.f;
#pragma unroll
                for (int q = 0; q < 16; ++q) { s1[u] += v[u][q]; s2[u] = fmaf(v[u][q], v[u][q], s2[u]); } }
#pragma unroll
            for (int o = 1; o < 64; o <<= 1) {
#pragma unroll
                for (int u = 0; u < 4; ++u) { s1[u] += __shfl_xor(s1[u], o); s2[u] += __shfl_xor(s2[u], o); } }
#pragma unroll
            for (int u = 0; u < 4; ++u) { const int row = r0 + i4 + u; const float mean = s1[u] * (1.f / 1024.f); const float var = fmaxf(s2[u] * (1.f / 1024.f) - mean * mean, 0.f); const float rstd = 1.f / sqrtf(var + 1e-5f);
#pragma unroll
                for (int j = 0; j < 4; ++j) { const int c = j * 256 + lane * 4; const f32x4 g4 = gq[j], b4 = bq[j];
                    const float y0 = (v[u][4 * j] - mean) * rstd * g4.x + b4.x, y1 = (v[u][4 * j + 1] - mean) * rstd * g4.y + b4.y, y2 = (v[u][4 * j + 2] - mean) * rstd * g4.z + b4.z, y3 = (v[u][4 * j + 3] - mean) * rstd * g4.w + b4.w;
                    if constexpr (OUT_F32) *(f32x4*)(xout32 + (size_t)row * 1024 + c) = (f32x4){y0, y1, y2, y3};
                    else { u32x2 w; w.x = cvt_pk(y0, y1); w.y = cvt_pk(y2, y3); *(u32x2*)(xoutb + (size_t)row * 1024 + c) = w;
                        if constexpr (ROUTER || GRP) { *(LAS u32x2*)(xt + u * RW_PITCH + c) = w; } } } }
            if constexpr (GRP) {
                f32x4 ga = {0.f, 0.f, 0.f, 0.f};
#pragma unroll 8
                for (int ks = 0; ks < 32; ++ks) { const bf16x8 xb = *(const LAS bf16x8*)(xt + (l15 & 3) * RW_PITCH + ks * 32 + q4 * 8), wa = *(const LAS bf16x8*)(whi + l15 * RW_PITCH + ks * 32 + q4 * 8);
                    ga = __builtin_amdgcn_mfma_f32_16x16x32_bf16(wa, xb, ga, 0, 0, 0); }
                if (l15 < 4) *(f32x4*)(WSP(float, W_GR) + (size_t)(r0 + i4 + l15) * 16 + 4 * q4) = ga; }
            if constexpr (ROUTER) {
                f32x4 acc[2] = {{0.f, 0.f, 0.f, 0.f}, {0.f, 0.f, 0.f, 0.f}};
#pragma unroll 8
                for (int ks = 0; ks < 32; ++ks) { const bf16x8 xb = *(const LAS bf16x8*)(xt + (l15 & 3) * RW_PITCH + ks * 32 + q4 * 8);
#pragma unroll
                    for (int mt = 0; mt < 2; ++mt) { const bf16x8 wa = *(const LAS bf16x8*)(whi + (mt * 16 + l15) * RW_PITCH + ks * 32 + q4 * 8); acc[mt] = __builtin_amdgcn_mfma_f32_16x16x32_bf16(wa, xb, acc[mt], 0, 0, 0); } }
                if (l15 < 4) {
#pragma unroll
                    for (int mt = 0; mt < 2; ++mt)
#pragma unroll
                        for (int r = 0; r < 4; ++r) lgs[l15 * 33 + mt * 16 + 4 * q4 + r] = acc[mt][r] + bias8[mt * 4 + r]; }
                if (lane < 4) { float lg[32];
#pragma unroll
                    for (int e = 0; e < 32; ++e) lg[e] = lgs[lane * 33 + e];
                    unsigned taken = 0u; float tv[4]; int ti[4];
#pragma unroll
                    for (int r = 0; r < 4; ++r) { float best = -INFINITY; int bi = 0;
#pragma unroll
                        for (int e = 0; e < 32; ++e) { const bool ok = !((taken >> e) & 1u) && lg[e] > best; best = ok ? lg[e] : best; bi = ok ? e : bi; }
                        taken |= 1u << bi; tv[r] = best; ti[r] = bi; }
                    float ex[4], sm = 0.f;
#pragma unroll
                    for (int r = 0; r < 4; ++r) { ex[r] = __expf(tv[r] - tv[0]); sm += ex[r]; }
                    const float inv = 1.f / sm; const int row = r0 + i4 + lane;
                    *(int4*)(RE + row * 4) = make_int4(ti[0], ti[1], ti[2], ti[3]); *(f32x4*)(RW + row * 4) = (f32x4){ex[0] * inv, ex[1] * inv, ex[2] * inv, ex[3] * inv};
#pragma unroll
                    for (int r = 0; r < 4; ++r) atomicAdd((int*)(hist + ti[r]), 1); }
            }
        }
        if constexpr (ROUTER) { __syncthreads(); if (F.tid < 32) { WSP(int, W_HIST)[wgi * 32 + F.tid] = hist[F.tid]; hist[F.tid] = 0; } __syncthreads(); }
    }
}

DEV void p_sort(Frame& F) {
    LAS int* Ls = (LAS int*)F.lds; const int tid = F.tid;
    const int* HIST = WSP(int, W_HIST); int* SORT = WSP(int, W_SORT);
    const int* RE = WSP(int, R_RE); const float* RW = WSP(float, R_RW); int* POS = WSP(int, R_POS); int* TOK = WSP(int, R_TOK); float* WGT = WSP(float, R_WGT);
    for (int wgi = F.vcu; wgi < 256; wgi += F.G) {
        { const int e = tid & 31, part = tid >> 5; int tot = 0, pre = 0;
          for (int w = part * 16; w < part * 16 + 16; ++w) { const int hh = HIST[w * 32 + e]; tot += hh; pre += (w < wgi) ? hh : 0; }
          Ls[part * 32 + e] = tot; Ls[512 + part * 32 + e] = pre; }
        Ls[2048 + tid] = RE[wgi * 512 + tid];
        __syncthreads();
        if (tid < 32) { int tot = 0, pre = 0; for (int p = 0; p < 16; ++p) { tot += Ls[p * 32 + tid]; pre += Ls[512 + p * 32 + tid]; } Ls[1200 + tid] = tot; Ls[1300 + tid] = pre; }
        __syncthreads();
        if (tid == 0) { int a = 0; for (int e = 0; e < 32; ++e) { Ls[1024 + e] = a; a += (Ls[1200 + e] + 255) / 256 * 256; } Ls[1056] = a; }
        __syncthreads();
        if (tid < 32) { int c = Ls[1024 + tid] + Ls[1300 + tid]; for (int i = 0; i < 512; ++i) if (Ls[2048 + i] == tid) { Ls[2560 + i] = c; ++c; } }
        __syncthreads();
        { const int pos = Ls[2560 + tid]; TOK[pos] = wgi * 128 + (tid >> 2); WGT[pos] = RW[wgi * 512 + tid]; POS[wgi * 512 + tid] = pos; }
        { const bf16_t* XBBp = WSP(bf16_t, W_XBB); unsigned char* XS8 = WSP(unsigned char, W_X8);
          for (int r = F.wave; r < 128; r += 8) { const u32x4* src = (const u32x4*)(XBBp + (size_t)(wgi * 128 + r) * 1024 + F.lane * 16); const u32x4 a = src[0], b2 = src[1];
              u32x4 o; o.x = pk4_fp8(bflo(a.x) * 16.f, bfhi(a.x) * 16.f, bflo(a.y) * 16.f, bfhi(a.y) * 16.f); o.y = pk4_fp8(bflo(a.z) * 16.f, bfhi(a.z) * 16.f, bflo(a.w) * 16.f, bfhi(a.w) * 16.f);
              o.z = pk4_fp8(bflo(b2.x) * 16.f, bfhi(b2.x) * 16.f, bflo(b2.y) * 16.f, bfhi(b2.y) * 16.f); o.w = pk4_fp8(bflo(b2.z) * 16.f, bfhi(b2.z) * 16.f, bflo(b2.w) * 16.f, bfhi(b2.w) * 16.f);
#pragma unroll
              for (int kx = 0; kx < 4; ++kx) { const int pos = Ls[2560 + r * 4 + kx]; *(u32x4*)(XS8 + (size_t)pos * 1024 + F.lane * 16) = o; } }
          if (wgi < 32) { const int e = wgi; for (int r = Ls[1024 + e] + Ls[1200 + e] + F.wave; r < Ls[1024 + e + 1]; r += 8) *(u32x4*)(XS8 + (size_t)r * 1024 + F.lane * 16) = (u32x4){0u, 0u, 0u, 0u}; } }
        if (wgi < 32) { const int e = wgi; for (int r = Ls[1024 + e] + Ls[1200 + e] + tid; r < Ls[1024 + e + 1]; r += 512) { TOK[r] = 0; WGT[r] = 0.f; } }
        if (wgi == 0) { if (tid < 33) SORT[tid] = Ls[1024 + tid]; if (tid == 0) SORT[33] = Ls[1056] / 256;
            for (int pm = tid; pm < PMAX / 256; pm += 512) { int e = 0; for (int j = 1; j < 32; ++j) if (pm * 256 >= Ls[1024 + j]) e = j; SORT[64 + pm] = e; } }
        __syncthreads();
    }
}

DEV void p_gr(Frame& F) {
    const int gw = F.vcu * 8 + F.wave, NGW = F.G * 8, lane = F.lane, q4 = lane >> 4; const bf16_t* XB = WSP(bf16_t, W_XB); const bf16_t* Wg = WSP(bf16_t, W_IN1) + (size_t)3072 * 1024; float* GR = WSP(float, W_GR);
    for (int it = gw; it < T / 16; it += NGW) { f32x4 acc = {0.f, 0.f, 0.f, 0.f};
        const bf16_t* ap = XB + (size_t)(it * 16 + (lane & 15)) * 1024 + q4 * 8; const bf16_t* bp = Wg + (size_t)(lane & 15) * 1024 + q4 * 8;
#pragma unroll 8
        for (int ks = 0; ks < 32; ++ks) { const bf16x8 a = *(const bf16x8*)(ap + ks * 32), bb = *(const bf16x8*)(bp + ks * 32); acc = __builtin_amdgcn_mfma_f32_16x16x32_bf16(a, bb, acc, 0, 0, 0); }
#pragma unroll
        for (int r = 0; r < 4; ++r) GR[(size_t)(it * 16 + 4 * q4 + r) * 16 + (lane & 15)] = acc[r]; }
}

constexpr int GP = 264, GP2 = 144;
constexpr int GB_QIN = 0, GB_KST = 16896, GB_ATT = 35328, GB_DEC = 44544, GB_VT = 45056, GB_SIZE = 81920;
constexpr size_t W_GB = W_YS;
static_assert((size_t)2048 * GB_SIZE <= (size_t)PMAX * 2048, "blob region");
constexpr int GA_GRS = 0, GA_GT = 4096, GA_BL = 8192  , GA_QIN = GA_BL + GB_QIN, GA_KST = GA_BL + GB_KST, GA_ATT = GA_BL + GB_ATT, GA_DEC = GA_BL + GB_DEC, GA_KIN = GA_BL + 45056  , GA_VT = GA_KIN + 17408, GA_END = GA_VT + 36864;
DEV float logsigm_fast(float z) { const float e = __builtin_amdgcn_exp2f(-1.4426950408889634f * fabsf(z)); return fminf(z, 0.f) - 0.6931471805599453f * __builtin_amdgcn_logf(1.f + e); }
DEV void p_gla_prep(Frame& F) {
    LAS unsigned char* lds = F.lds; const int tid = F.tid, lane = F.lane, wid = F.wave, q4 = lane >> 4, l15 = lane & 15;
    const bf16_t* H1 = WSP(bf16_t, W_HB); const float* GR = WSP(float, W_GR); unsigned char* GB = F.ws + W_GB;
    const float* wg2 = F.in[15]; const float* bg = F.in[16];
    for (int i = tid; i < 64 * GP2 / 4; i += 512) ((LAS unsigned*)(lds + GA_ATT))[i] = 0u;
    const int dk = tid & 127, tg = tid >> 7;
    const int dvl = tid & 255, th2 = tid >> 8;
    for (int it = F.vcu * 8; it < 2048; it += F.G * 8) {
#pragma unroll 1
      for (int sub = 0; sub < 8; ++sub) { const int item = it + sub; const int h = item & 3, n = (item >> 2) & 31, b = item >> 7;
        const size_t rb = (size_t)b * 2048 + n * 64;
        float w2[16];
#pragma unroll
        for (int r = 0; r < 16; ++r) w2[r] = wg2[r * 512 + h * 128 + dk];
        const float bgv = bg[h * 128 + dk];
        unsigned qraw[16], kraw[16], vraw[32];
#pragma unroll
        for (int i = 0; i < 16; ++i) { const size_t ro = (rb + 16 * tg + i) * 3072; qraw[i] = H1[ro + h * 128 + dk]; kraw[i] = H1[ro + 512 + h * 128 + dk]; }
#pragma unroll
        for (int i = 0; i < 32; ++i) vraw[i] = H1[(rb + 32 * th2 + i) * 3072 + 1024 + h * 256 + dvl];
        const float g0 = GR[rb * 16 + tid], g1 = GR[rb * 16 + 512 + tid];
        ((LAS float*)(lds + GA_GRS))[tid] = g0; ((LAS float*)(lds + GA_GRS))[512 + tid] = g1;
        __syncthreads();
        float cs[16]; float run = 0.f;
#pragma unroll
        for (int i = 0; i < 16; ++i) { const LAS float* gr = (const LAS float*)(lds + GA_GRS) + (16 * tg + i) * 16; float z = bgv;
#pragma unroll
            for (int r = 0; r < 16; ++r) z = fmaf(gr[r], w2[r], z);
            run += logsigm_fast(z) * (1.f / 16.f); cs[i] = run; }
        ((LAS float*)(lds + GA_GT))[tg * 128 + dk] = run;
        __syncthreads();
        float off = 0.f, btot = 0.f;
#pragma unroll
        for (int g2 = 0; g2 < 4; ++g2) { const float gtv = ((LAS float*)(lds + GA_GT))[g2 * 128 + dk]; btot += gtv; off += (g2 < tg) ? gtv : 0.f; }
        if (tg == 0) ((LAS float*)(lds + GA_DEC))[dk] = __expf(btot);
        { unsigned kst[8];
#pragma unroll
          for (int i = 0; i < 16; i += 2) { float kk[2];
#pragma unroll
              for (int u = 0; u < 2; ++u) { const int t = 16 * tg + i + u; const float bc = cs[i + u] + off; const float qv = bflo(qraw[i + u]), kv = bflo(kraw[i + u]);
                  *(LAS bf16_t*)(lds + GA_QIN + t * GP + dk * 2) = (bf16_t)(cvt_pk(qv * __expf(bc), 0.f) & 0xffffu);
                  *(LAS bf16_t*)(lds + GA_KIN + t * 272 + dk * 2) = (bf16_t)(cvt_pk(kv * __expf(-bc), 0.f) & 0xffffu);
                  kk[u] = kv * __expf(btot - bc); }
              kst[i >> 1] = cvt_pk(kk[0], kk[1]); }
          *(LAS u32x4*)(lds + GA_KST + dk * GP2 + tg * 32) = (u32x4){kst[0], kst[1], kst[2], kst[3]};
          *(LAS u32x4*)(lds + GA_KST + dk * GP2 + tg * 32 + 16) = (u32x4){kst[4], kst[5], kst[6], kst[7]}; }
#pragma unroll
        for (int i = 0; i < 32; i += 8) *(LAS u32x4*)(lds + GA_VT + dvl * GP2 + (32 * th2 + i) * 2) = (u32x4){vraw[i] | (vraw[i + 1] << 16), vraw[i + 2] | (vraw[i + 3] << 16), vraw[i + 4] | (vraw[i + 5] << 16), vraw[i + 6] | (vraw[i + 7] << 16)};
        __syncthreads();
#pragma unroll
        for (int rep = 0; rep < 2; ++rep) { const int ti = wid + 8 * rep; if (ti < 10) {
            int jt, it2; if (ti < 4) { jt = 0; it2 = ti; } else if (ti < 7) { jt = 1; it2 = ti - 3; } else if (ti < 9) { jt = 2; it2 = ti - 5; } else { jt = 3; it2 = 3; }
            f32x4 a4 = {0.f, 0.f, 0.f, 0.f};
#pragma unroll
            for (int ks = 0; ks < 4; ++ks) { const bf16x8 kf = *(const LAS bf16x8*)(lds + GA_KIN + (16 * jt + l15) * 272 + ks * 64 + q4 * 16); const u32x2 q0_ = *(const LAS u32x2*)(lds + GA_QIN + (16 * it2 + l15) * GP + ks * 64 + q4 * 16), q1_ = *(const LAS u32x2*)(lds + GA_QIN + (16 * it2 + l15) * GP + ks * 64 + q4 * 16 + 8); const bf16x8 qf = __builtin_bit_cast(bf16x8, (u32x4){q0_.x, q0_.y, q1_.x, q1_.y});
                a4 = __builtin_amdgcn_mfma_f32_16x16x32_bf16(kf, qf, a4, 0, 0, 0); }
            const int i_ = 16 * it2 + l15, j0 = 16 * jt + 4 * q4;
            u32x2 w; w.x = cvt_pk(j0 <= i_ ? a4[0] : 0.f, j0 + 1 <= i_ ? a4[1] : 0.f); w.y = cvt_pk(j0 + 2 <= i_ ? a4[2] : 0.f, j0 + 3 <= i_ ? a4[3] : 0.f);
            *(LAS u32x2*)(lds + GA_ATT + i_ * GP2 + j0 * 2) = w; } }
        __syncthreads();
        unsigned char* blob = GB + (size_t)item * GB_SIZE;
        for (int c = tid; c < 45056 / 16; c += 512) *(u32x4*)(blob + c * 16) = *(const LAS u32x4*)(lds + GA_BL + c * 16);
        for (int c = tid; c < 36864 / 16; c += 512) *(u32x4*)(blob + GB_VT + c * 16) = *(const LAS u32x4*)(lds + GA_VT + c * 16);
      }
    }
}
constexpr int GS_BUF = 54272;
constexpr int GS_VT = 0, GS_QIN = 9216, GS_KST = GS_QIN + 16896, GS_ATT = GS_KST + 18432, GS_DEC = GS_ATT + 9216;
static_assert(3 * GS_BUF <= LDSCTL_OFF, "GLA ring");
DEV void gla_scan_item(Frame& F, int b, int h, int c4) {
    LAS unsigned char* lds = F.lds; const int lane = F.lane, wid = F.wave, q4 = lane >> 4, l15 = lane & 15;
    bf16_t* GO = WSP(bf16_t, W_GLAO); float* SS = WSP(float, W_SS); const unsigned char* GB = F.ws + W_GB;
    const int c16 = wid & 3, th = wid >> 2;
    f32x4 sacc[8];
#pragma unroll
    for (int m = 0; m < 8; ++m) sacc[m] = (f32x4){0.f, 0.f, 0.f, 0.f};
    const size_t rb = (size_t)b * 2048;
    float sqv[2][4]; unsigned ov[2][4];
#pragma unroll
    for (int mt = 0; mt < 2; ++mt)
#pragma unroll
        for (int r = 0; r < 4; ++r) { sqv[mt][r] = 0.f; ov[mt][r] = 0u; }
    const int npc = (wid < 5) ? 7 : 6;
#define GS_ISSUE(n_, bo_) do { const unsigned char* blob_ = GB + (size_t)((b * 32 + (n_)) * 4 + h) * GB_SIZE; \
        for (int p_ = wid; p_ < 53; p_ += 8) { const int so_ = p_ < 9 ? GB_VT + c4 * 9216 + p_ * 1024 : (p_ - 9) * 1024; \
            __builtin_amdgcn_global_load_lds((const unsigned*)(blob_ + so_ + lane * 16), (LAS unsigned*)(lds + (bo_) + p_ * 1024), 16, 0, 0); } } while (0)
    GS_ISSUE(0, 0); GS_ISSUE(1, GS_BUF);
    int bo = 0, bo2 = 2 * GS_BUF;
#pragma unroll 1
    for (int n = 0; n < 32; ++n) { const int t0 = n * 64;
        if (n + 1 < 32) { if (npc == 7) asm volatile("s_waitcnt vmcnt(7) lgkmcnt(0)\n\ts_barrier" ::: "memory"); else asm volatile("s_waitcnt vmcnt(6) lgkmcnt(0)\n\ts_barrier" ::: "memory"); } else asm volatile("s_waitcnt vmcnt(0) lgkmcnt(0)\n\ts_barrier" ::: "memory");
        if (n > 0) {
#pragma unroll
            for (int mt = 0; mt < 2; ++mt)
#pragma unroll
                for (int r = 0; r < 4; ++r) { const size_t trow = rb + (t0 - 64) + 32 * th + 16 * mt + 4 * q4 + r; GO[trow * 1024 + h * 256 + c4 * 64 + c16 * 16 + l15] = (bf16_t)ov[mt][r];
                    SS[(trow * 4 + h) * 16 + c4 * 4 + c16] = sqv[mt][r]; } }
        if (n + 2 < 32) GS_ISSUE(n + 2, bo2);
        const LAS unsigned char* bu = lds + bo;
        bf16x8 vf[2];
#pragma unroll
        for (int ks = 0; ks < 2; ++ks) vf[ks] = *(const LAS bf16x8*)(bu + GS_VT + (c16 * 16 + l15) * GP2 + ks * 64 + q4 * 16);
        bf16x8 sf[4];
#pragma unroll
        for (int ks = 0; ks < 4; ++ks) { const u32x4 w = {cvt_pk(sacc[2 * ks][0], sacc[2 * ks][1]), cvt_pk(sacc[2 * ks][2], sacc[2 * ks][3]), cvt_pk(sacc[2 * ks + 1][0], sacc[2 * ks + 1][1]), cvt_pk(sacc[2 * ks + 1][2], sacc[2 * ks + 1][3])}; sf[ks] = __builtin_bit_cast(bf16x8, w); }
#pragma unroll
        for (int mt = 0; mt < 2; ++mt) { const int i_ = 32 * th + 16 * mt + l15; f32x4 oa = {0.f, 0.f, 0.f, 0.f};
#pragma unroll
            for (int ks = 0; ks < 2; ++ks) { if (ks == 1 && th == 0) continue; const bf16x8 af = *(const LAS bf16x8*)(bu + GS_ATT + i_ * GP2 + ks * 64 + q4 * 16); oa = __builtin_amdgcn_mfma_f32_16x16x32_bf16(af, vf[ks], oa, 0, 0, 0); }
#pragma unroll
            for (int ks = 0; ks < 4; ++ks) { const u32x2 lo = *(const LAS u32x2*)(bu + GS_QIN + i_ * GP + (32 * ks + 4 * q4) * 2), hi2 = *(const LAS u32x2*)(bu + GS_QIN + i_ * GP + (32 * ks + 16 + 4 * q4) * 2);
                const u32x4 w = {lo.x, lo.y, hi2.x, hi2.y}; oa = __builtin_amdgcn_mfma_f32_16x16x32_bf16(__builtin_bit_cast(bf16x8, w), sf[ks], oa, 0, 0, 0); }
#pragma unroll
            for (int r = 0; r < 4; ++r) { ov[mt][r] = cvt_pk(oa[r], 0.f) & 0xffffu; float sq = oa[r] * oa[r]; sq += __shfl_xor(sq, 1); sq += __shfl_xor(sq, 2); sq += __shfl_xor(sq, 4); sq += __shfl_xor(sq, 8); sqv[mt][r] = sq; } }
#pragma unroll
        for (int md = 0; md < 8; ++md) { const f32x4 dc = *(const LAS f32x4*)(bu + GS_DEC + (16 * md + 4 * q4) * 4); sacc[md] = sacc[md] * dc;
#pragma unroll
            for (int ks = 0; ks < 2; ++ks) { const bf16x8 kf = *(const LAS bf16x8*)(bu + GS_KST + (16 * md + l15) * GP2 + ks * 64 + q4 * 16); sacc[md] = __builtin_amdgcn_mfma_f32_16x16x32_bf16(kf, vf[ks], sacc[md], 0, 0, 0); } }
        bo = (bo == 2 * GS_BUF) ? 0 : bo + GS_BUF; bo2 = (bo2 == 2 * GS_BUF) ? 0 : bo2 + GS_BUF;
    }
#undef GS_ISSUE
#pragma unroll
    for (int mt = 0; mt < 2; ++mt)
#pragma unroll
        for (int r = 0; r < 4; ++r) { const size_t trow = rb + 31 * 64 + 32 * th + 16 * mt + 4 * q4 + r; GO[trow * 1024 + h * 256 + c4 * 64 + c16 * 16 + l15] = (bf16_t)ov[mt][r]; SS[(trow * 4 + h) * 16 + c4 * 4 + c16] = sqv[mt][r]; }
    asm volatile("s_waitcnt vmcnt(0)" ::: "memory");
    __syncthreads();
}
DEV void p_gla_scan(Frame& F) { for (int v = F.vcu; v < 256; v += F.G) gla_scan_item(F, v >> 4, (v >> 2) & 3, v & 3); }

DEV void p_gla_norm(Frame& F) {
    const int gw = F.vcu * 8 + F.wave, NGW = F.G * 8, lane = F.lane; const bf16_t* GO = WSP(bf16_t, W_GLAO); const float* SS = WSP(float, W_SS); const bf16_t* H1 = WSP(bf16_t, W_HB); bf16_t* Y0 = WSP(bf16_t, W_Y0);
    const f32x4 nw = *(const f32x4*)(F.in[17] + lane * 4);
    for (int row = gw; row < T; row += NGW) {
#pragma unroll
        for (int h = 0; h < 4; ++h) { const float* sp = SS + ((size_t)row * 4 + h) * 16; const f32x4 a = *(const f32x4*)sp, b2 = *(const f32x4*)(sp + 4), c = *(const f32x4*)(sp + 8), d = *(const f32x4*)(sp + 12);
            const float sq = (a.x + a.y + a.z + a.w) + (b2.x + b2.y + b2.z + b2.w) + (c.x + c.y + c.z + c.w) + (d.x + d.y + d.z + d.w); const float r = 1.f / sqrtf(sq * (1.f / 256.f) + 1e-5f);
            const u32x2 o = *(const u32x2*)(GO + (size_t)row * 1024 + h * 256 + lane * 4); const u32x2 g = *(const u32x2*)(H1 + (size_t)row * 3072 + 2048 + h * 256 + lane * 4);
            const float g0 = bflo(g.x), g1 = bfhi(g.x), g2 = bflo(g.y), g3 = bfhi(g.y);
            u32x2 w; w.x = cvt_pk(bflo(o.x) * r * nw.x * g0 * fast_sigm(g0), bfhi(o.x) * r * nw.y * g1 * fast_sigm(g1)); w.y = cvt_pk(bflo(o.y) * r * nw.z * g2 * fast_sigm(g2), bfhi(o.y) * r * nw.w * g3 * fast_sigm(g3));
            *(u32x2*)(Y0 + (size_t)row * 1024 + h * 256 + lane * 4) = w; } }
}
struct FStoreScale { bf16_t* O; int ldc, c_lo, c_hi; float sc;
    DEV void operator()(const Unit&, int row, int col, f32x4 v0, f32x4 v1) const { const float s = (col >= c_lo && col < c_hi) ? sc : 1.f;
        const u32x4 w = {cvt_pk(v0[0] * s, v0[1] * s), cvt_pk(v0[2] * s, v0[3] * s), cvt_pk(v1[0] * s, v1[1] * s), cvt_pk(v1[2] * s, v1[3] * s)}; *(u32x4*)(O + (size_t)row * ldc + col) = w; } };
struct FGlu { const bf16_t* Y; bf16_t* O; const float* b;
    DEV void operator()(const Unit&, int row, int col, f32x4 v0, f32x4 v1) const { const u32x4 y = *(const u32x4*)(Y + (size_t)row * 512 + col); const f32x4 b0 = *(const f32x4*)(b + col), b1 = *(const f32x4*)(b + col + 4);
        const u32x4 w = {cvt_pk(bflo(y.x) * fast_sigm(v0[0] + b0.x), bfhi(y.x) * fast_sigm(v0[1] + b0.y)), cvt_pk(bflo(y.y) * fast_sigm(v0[2] + b0.z), bfhi(y.y) * fast_sigm(v0[3] + b0.w)),
                         cvt_pk(bflo(y.z) * fast_sigm(v1[0] + b1.x), bfhi(y.z) * fast_sigm(v1[1] + b1.y)), cvt_pk(bflo(y.w) * fast_sigm(v1[2] + b1.z), bfhi(y.w) * fast_sigm(v1[3] + b1.w))};
        *(u32x4*)(O + (size_t)row * 1024 + col) = w; } };
constexpr float ACT_SCALE = 4.f, WDN_SCALE = 128.f;
DEV float swiglu1(float g, float u) { g = fminf(g, 7.f); u = fminf(fmaxf(u, -7.f), 7.f); return g * fast_sigm(1.702f * g) * (u + 1.f); }
struct FSwiglu { unsigned char* ACT; const float* bgu; float sc;
    DEV void operator()(const Unit& u, int row, int col, f32x4 v0, f32x4 v1) const { v0 = v0 * sc; v1 = v1 * sc; const float* bp = bgu + (size_t)u.e * 2048 + col; const f32x4 b0 = *(const f32x4*)bp, b1 = *(const f32x4*)(bp + 4);
        const unsigned w = pk4_fp8(ACT_SCALE * swiglu1(v0[0] + b0.x, v0[1] + b0.y), ACT_SCALE * swiglu1(v0[2] + b0.z, v0[3] + b0.w), ACT_SCALE * swiglu1(v1[0] + b1.x, v1[1] + b1.y), ACT_SCALE * swiglu1(v1[2] + b1.z, v1[3] + b1.w));
        *(unsigned*)(ACT + (size_t)row * 1024 + (col >> 1)) = w; } };
struct FDown { bf16_t* YS; const float* bd; const float* wgt; float sc;
    DEV void operator()(const Unit& u, int row, int col, f32x4 v0, f32x4 v1) const { v0 = v0 * sc; v1 = v1 * sc; const float* bp = bd + (size_t)u.e * 1024 + col; const f32x4 b0 = *(const f32x4*)bp, b1 = *(const f32x4*)(bp + 4); const float wt = wgt[row];
        const u32x4 w = {cvt_pk((v0[0] + b0.x) * wt, (v0[1] + b0.y) * wt), cvt_pk((v0[2] + b0.z) * wt, (v0[3] + b0.w) * wt), cvt_pk((v1[0] + b1.x) * wt, (v1[1] + b1.y) * wt), cvt_pk((v1[2] + b1.z) * wt, (v1[3] + b1.w) * wt)};
        *(u32x4*)(YS + (size_t)row * 1024 + col) = w; } };

constexpr int NPH = 21;
constexpr float X8_SCALE = 16.f, WGU_SCALE = 64.f;
constexpr float QSCALE0 = 0.125f * 1.4426950408889634f, QSCALE1 = 0.08838834764831845f;


#define NOINL __device__ __forceinline__
struct PA { const float* const* in; unsigned char* ws; float* out; int wave; };
#define MKFRAME extern __shared__ __attribute__((aligned(16))) unsigned char lds_[]; Frame F; F.lds = (LAS unsigned char*)lds_; F.wave = pa.wave; F.lane = (int)__builtin_amdgcn_mbcnt_hi(~0u, __builtin_amdgcn_mbcnt_lo(~0u, 0u)); F.tid = F.wave * 64 + F.lane; \
    F.G = gridDim.x; { const int bx = blockIdx.x; F.vcu = (F.G % 8 == 0) ? (bx % 8) * (F.G / 8) + bx / 8 : bx; } F.in = pa.in; F.ws = pa.ws;
template <class Fn> DEV void dense_gemm(Frame& F, const bf16_t* A, const bf16_t* Bt, int nM, int nN, int K, const Fn& fn) {
    Gemm g; g.A = A; g.Bt = Bt; g.rowmap = nullptr; g.bstride = 0; g.KB = K * 2; g.wave = F.wave;
    StaticOrder S; S.init(nM, nN, F.G, (int)blockIdx.x, nullptr);
    EpiRow8<Fn> E{fn};
    gemm_phase<false, false>(F.lds, g, S, E);
}
NOINL void ph_prologue(PA pa) { MKFRAME p0_prologue(F); }
NOINL void ph_in0(PA pa) { MKFRAME dense_gemm(F, WSP(bf16_t, W_XB), WSP(bf16_t, W_IN0), T / 256, 8, 1024, FStoreScale{WSP(bf16_t, W_HB), 2048, 512, 1024, QSCALE0}); }
NOINL void ph_kmean(PA pa) { MKFRAME p_kmean(F); }
NOINL void ph_s5moba(PA pa, int mode) { MKFRAME p_s5_moba(F, mode); }
NOINL void ph_glu(PA pa) { MKFRAME dense_gemm(F, WSP(bf16_t, W_YS5), WSP(bf16_t, W_GLU), T / 256, 2, 512, FGlu{WSP(bf16_t, W_YS5), WSP(bf16_t, W_Y0), F.in[11]}); }
NOINL void ph_out(PA pa, int layer) { MKFRAME dense_gemm(F, WSP(bf16_t, W_Y0), layer ? WSP(bf16_t, W_OUT1) : WSP(bf16_t, W_OUT0), T / 256, 4, 1024, FStoreScale{WSP(bf16_t, W_MIXB), 1024, 0, 0, 1.f}); }
NOINL void ph_in1(PA pa) { MKFRAME dense_gemm(F, WSP(bf16_t, W_XB), WSP(bf16_t, W_IN1), T / 256, 12, 1024, FStoreScale{WSP(bf16_t, W_HB), 3072, 0, 512, QSCALE1}); p_gr(F); }
NOINL void ph_glaprep(PA pa) { MKFRAME p_gla_prep(F); }
NOINL void ph_glascan(PA pa) { MKFRAME p_gla_scan(F); }
NOINL void ph_glanorm(PA pa) { MKFRAME p_gla_norm(F); }
NOINL void ph_lnrouter(PA pa, int layer) { MKFRAME
    if (layer == 0) p_ln<0, true, true, false>(F, F.in[0], nullptr, WSP(bf16_t, W_XBB), nullptr, F.in[19], F.in[20], F.in[23], F.in[24]);
    else p_ln<0, true, false, false>(F, nullptr, WSP(bf16_t, W_XB), WSP(bf16_t, W_XBB), nullptr, F.in[19] + 1024, F.in[20] + 1024, F.in[23] + (size_t)1024 * 32, F.in[24] + 32); }
NOINL void ph_sort(PA pa) { MKFRAME p_sort(F); }
NOINL void ph_gateup(PA pa, int layer) { MKFRAME const int* SORT = WSP(int, W_SORT);
    Gemm g; g.A = WSP(unsigned char, W_X8); g.Bt = WSP(unsigned char, W_GU) + (size_t)layer * 32 * 2048 * 1024; g.rowmap = nullptr; g.bstride = (size_t)2048 * 1024; g.KB = 1024; g.wave = F.wave;
    StaticOrder S; S.init(__builtin_amdgcn_readfirstlane(SORT[33]), 8, F.G, (int)blockIdx.x, SORT + 64);
    EpiRow8<FSwiglu> E{FSwiglu{WSP(unsigned char, W_ACT), F.in[26] + (size_t)layer * 32 * 2048, 1.f / (X8_SCALE * WGU_SCALE)}};
    gemm_phase<false, true>(F.lds, g, S, E); }
NOINL void ph_down(PA pa, int layer) { MKFRAME const int* SORT = WSP(int, W_SORT);
    Gemm g; g.A = WSP(unsigned char, W_ACT); g.Bt = WSP(unsigned char, W_DN) + (size_t)layer * 32 * 1024 * 1024; g.rowmap = nullptr; g.bstride = (size_t)1024 * 1024; g.KB = 1024; g.wave = F.wave;
    StaticOrder S; S.init(__builtin_amdgcn_readfirstlane(SORT[33]), 4, F.G, (int)blockIdx.x, SORT + 64);
    EpiRow8<FDown> E{FDown{WSP(bf16_t, W_YS), F.in[28] + (size_t)layer * 32 * 1024, WSP(float, R_WGT), 1.f / (ACT_SCALE * WDN_SCALE)}};
    gemm_phase<false, true>(F.lds, g, S, E); }
NOINL void ph_combine(PA pa, int layer) { MKFRAME
    if (layer == 0) p_ln<1, false, false, false, false>(F, nullptr, WSP(bf16_t, W_XBB), WSP(bf16_t, W_XB), nullptr, F.in[21], F.in[22], nullptr, nullptr);
    else p_ln<1, false, false, true>(F, nullptr, WSP(bf16_t, W_XBB), nullptr, pa.out, F.in[21] + 1024, F.in[22] + 1024, nullptr, nullptr); }

__global__ void __launch_bounds__(512, 2) mega(Args args) {
    extern __shared__ __attribute__((aligned(16))) unsigned char lds_[];
    LAS unsigned char* lds = (LAS unsigned char*)lds_;
    unsigned* ctl = (unsigned*)(args.ws + W_CTL);
    for (int u = threadIdx.x; u < (LDS_BYTES - LDSCTL_OFF) / 4; u += 512) ((LAS unsigned*)(lds + LDSCTL_OFF))[u] = 0u;
    __syncthreads();
    const int lo = args.ph_lo, hi = args.ph_hi;
    PA pa; pa.in = args.in; pa.ws = args.ws; pa.out = args.out; pa.wave = __builtin_amdgcn_readfirstlane(threadIdx.x >> 6);
    XcdBarrier bar; bar.bar = ctl + CW_BAR; bar.x = 0; bar.st = nullptr; bar.wave = pa.wave;
    if (hi - lo > 1) bar = xcd_barrier_post(ctl + CW_BAR, (volatile LAS unsigned*)(lds + MISC_OFF) + 8, pa.wave);
#define IN(k) (lo <= (k) && (k) < hi)
#ifdef DIAG_LO
    volatile LAS unsigned long long* tsl = (volatile LAS unsigned long long*)(lds + MISC_OFF + 128);
    if (blockIdx.x == 0 && threadIdx.x == 0) tsl[0] = __builtin_amdgcn_s_memrealtime();
#define STAMP(k) do { if (blockIdx.x == 0 && threadIdx.x == 0) tsl[(k) + 1] = __builtin_amdgcn_s_memrealtime(); } while (0)
#else
#define STAMP(k) do { } while (0)
#endif
#define SEAM(k) do { if (IN(k) && IN((k) + 1)) xcd_barrier(bar); STAMP(k); } while (0)
#ifndef REP_PHASE
#define REP_PHASE -1
#define REP_N 0
#endif
#define RUN(k, call) do { if (IN(k)) { call; if ((k) == REP_PHASE) { xcd_barrier(bar); call; } } } while (0)
    RUN(0, ph_prologue(pa)); SEAM(0);
    RUN(1, ph_in0(pa)); SEAM(1);
    RUN(2, ph_kmean(pa)); SEAM(2);
    if (IN(3)) { ph_s5moba(pa, 1); if (REP_PHASE == 30) ph_s5moba(pa, 1); ph_s5moba(pa, 2); if (REP_PHASE == 31) ph_s5moba(pa, 2); } SEAM(3);
    RUN(4, ph_glu(pa)); SEAM(4);
    RUN(5, ph_out(pa, 0)); SEAM(5);
    RUN(6, ph_lnrouter(pa, 0)); SEAM(6);
    RUN(7, ph_sort(pa)); SEAM(7);
    RUN(8, ph_gateup(pa, 0)); SEAM(8);
    RUN(9, ph_down(pa, 0)); SEAM(9);
    RUN(10, ph_combine(pa, 0)); SEAM(10);
    RUN(11, ph_in1(pa)); SEAM(11);
    RUN(12, ph_glaprep(pa)); SEAM(12);
    RUN(13, ph_glascan(pa)); SEAM(13);
    RUN(14, ph_glanorm(pa)); SEAM(14);
    RUN(15, ph_out(pa, 1)); SEAM(15);
    RUN(16, ph_lnrouter(pa, 1)); SEAM(16);
    RUN(17, ph_sort(pa)); SEAM(17);
    RUN(18, ph_gateup(pa, 1)); SEAM(18);
    RUN(19, ph_down(pa, 1)); SEAM(19);
    RUN(20, ph_combine(pa, 1));
#ifdef DIAG_LO
    xcd_barrier(bar); STAMP(20);
    if (blockIdx.x == 0 && threadIdx.x == 0) { const unsigned long long dtk = tsl[DIAG_HI + 1] - tsl[DIAG_LO]; const float f = (float)dtk * (0.01f / 10000.f); __hip_atomic_store(ctl + 8, __float_as_uint(f), __ATOMIC_RELAXED, __HIP_MEMORY_SCOPE_AGENT); }
    xcd_barrier(bar);
    { const float f = __uint_as_float(__hip_atomic_load(ctl + 8, __ATOMIC_RELAXED, __HIP_MEMORY_SCOPE_AGENT));
      for (size_t i = (size_t)blockIdx.x * 512 + threadIdx.x; i < (size_t)T * 1024; i += (size_t)gridDim.x * 512) args.out[i] *= (1.f + f); }
#endif
#undef IN
#undef SEAM
}

static int g_grid = 0;
static bool launch_setup(size_t ws_size) {
    if (g_grid == 0) {
        if (ws_size < W_END) { fprintf(stderr, "kernel_launch: workspace too small: %zu < %zu\n", ws_size, (size_t)W_END); g_grid = -1; return false; }
        int dev = 0, cus = 0, per_cu = 0;
        if (hipGetDevice(&dev) != hipSuccess || hipDeviceGetAttribute(&cus, hipDeviceAttributeMultiprocessorCount, dev) != hipSuccess) { g_grid = -1; return false; }
        if (hipFuncSetAttribute((const void*)mega, hipFuncAttributeMaxDynamicSharedMemorySize, LDS_BYTES) != hipSuccess) { fprintf(stderr, "kernel_launch: hipFuncSetAttribute failed\n"); g_grid = -1; return false; }
        if (hipOccupancyMaxActiveBlocksPerMultiprocessor(&per_cu, (const void*)mega, 512, LDS_BYTES) != hipSuccess || per_cu < 1) fprintf(stderr, "kernel_launch: occupancy query reports %d blocks/CU\n", per_cu);
        (void)hipGetLastError();
        g_grid = cus;
    }
    return g_grid > 0;
}
static void launch_phases(hipStream_t stream, void* const* d_in, void* d_out, void* d_ws, int lo, int hi) {
    Args a; memset(&a, 0, sizeof a);
    for (int i = 0; i < 29; ++i) a.in[i] = (const float*)d_in[i];
    a.out = (float*)d_out; a.ws = (unsigned char*)d_ws; a.ph_lo = lo; a.ph_hi = hi;
    hipLaunchKernelGGL(mega, dim3(g_grid), dim3(512), LDS_BYTES, stream, a);
}
}
extern "C" void kernel_launch(void* const* d_in, const int* in_sizes, int n_in, void* d_out, int out_size, void* d_ws, size_t ws_size, hipStream_t stream) {
    if (n_in != 29 || out_size != T * D) { fprintf(stderr, "kernel_launch: unexpected arguments (n_in %d, out_size %d)\n", n_in, out_size); return; }
    if (!fk::launch_setup(ws_size)) return;
    (void)hipMemsetAsync((char*)d_ws + fk::W_CTL, 0, fk::CTL_ZERO_BYTES, stream);
    fk::launch_phases(stream, d_in, d_out, d_ws, 0, fk::NPH);
}
```

```cpp
#include <hip/hip_runtime.h>
#include <cstdio>
#include <cstdint>
#include <cmath>
#include <cstring>
#define DEV __device__ __forceinline__
constexpr int Bn = 16, L = 2048, D = 1024, T = Bn * L;
namespace fk {
#define LAS __attribute__((address_space(3)))
#define GAS __attribute__((address_space(1)))
typedef unsigned short bf16_t;
typedef short bf16x8 __attribute__((ext_vector_type(8)));
typedef short s16x4 __attribute__((ext_vector_type(4)));
typedef float f32x2 __attribute__((ext_vector_type(2)));
typedef float f32x4 __attribute__((ext_vector_type(4)));
typedef float f32x16 __attribute__((ext_vector_type(16)));
typedef unsigned u32x2 __attribute__((ext_vector_type(2)));
typedef unsigned u32x4 __attribute__((ext_vector_type(4)));
typedef __bf16 bf16x2_t __attribute__((ext_vector_type(2)));
struct u32x4x2 { u32x4 a, b; };
DEV unsigned cvt_pk(float lo, float hi) { f32x2 v = {lo, hi}; bf16x2_t b = __builtin_convertvector(v, bf16x2_t); return __builtin_bit_cast(unsigned, b); }
DEV float bflo(unsigned w) { return __uint_as_float(w << 16); }
DEV float bfhi(unsigned w) { return __uint_as_float(w & 0xffff0000u); }
DEV float fast_sigm(float x) { return __builtin_amdgcn_rcpf(1.f + __builtin_amdgcn_exp2f(-1.4426950408889634f * x)); }
DEV float gelu_tanh(float x) { const float u = 0.7978845608028654f * (x + 0.044715f * x * x * x); return x * fast_sigm(2.f * u); }
DEV float wave_sum(float v) {
#pragma unroll
    for (int o = 1; o < 64; o <<= 1) v += __shfl_xor(v, o);
    return v; }
DEV float swap32(float x) { auto rr = __builtin_amdgcn_permlane32_swap(__float_as_uint(x), __float_as_uint(x), false, false); return __uint_as_float((__builtin_amdgcn_mbcnt_lo(~0u, 0u) >> 5) ? rr[0] : rr[1]); }

constexpr int BM = 256, BK = 64, HALF = 128, HTB = HALF * BK * 2, STAGE_BYTES = 8 * HTB, NXCD = 8, WGM = 8;
constexpr int LDS_TOK = 135168 - 2048;
constexpr int LDS_SIDE = 135168;
constexpr int LDS_BYTES = 163840, LDSCTL_OFF = LDS_BYTES - 1024, MISC_OFF = LDSCTL_OFF + 320;

DEV int lds_byte(int r, int c) { const int st = (r >> 4) * 2 + (c >> 5), rr = r & 15, cc = c & 31, ob = rr * 64 + cc * 2; return st * 1024 + (ob ^ (((ob >> 9) & 1) << 5)); }
DEV void stage_rc(int b, int& R, int& C) { const int st = b / 1024, sb = b % 1024, swz = sb ^ (((sb >> 9) & 1) << 5); R = (st >> 1) * 16 + swz / 64; C = (st & 1) * 32 + (swz % 64) / 2; }
DEV int perm32(int rho) { const int n = rho >> 4, i = rho & 15; return 8 * (i >> 2) + 4 * n + (i & 3); }

struct Unit { int pm, pn, e; };
struct Gemm { const void* A; const void* Bt; const int* rowmap; size_t bstride; int KB; int wave; };

struct StaticOrder {
    int nM, nN, nwg, G, c; const LAS int* elist;
    DEV void init(int nM_, int nN_, int G_, int c_, const LAS int* el) { nM = nM_; nN = nN_; nwg = nM * nN; G = G_; c = c_; elist = el; }
    DEV bool place(int i, Unit& u) const {
        const long Lx = (long)i * G + c; if (Lx >= nwg) return false;
        int wgid = (int)Lx; { const int q = nwg / NXCD, r = nwg % NXCD, xcd = wgid % NXCD, off = wgid / NXCD; wgid = (xcd < r ? xcd * (q + 1) : r * (q + 1) + (xcd - r) * q) + off; }
        const int nig = WGM * nN, gid = wgid / nig, fm = gid * WGM, gsz = (nM - fm) < WGM ? (nM - fm) : WGM;
        u.pm = fm + ((wgid % nig) % gsz); u.pn = (wgid % nig) / gsz; u.e = 0; return true;
    }
    DEV bool next(int i, Unit& u) const { if (!place(i, u)) return false; if (elist) u.e = __builtin_amdgcn_readfirstlane(elist[i]); return true; }
};
constexpr int LDS_ELIST = 135168 + 6144;
DEV void fill_elist(LAS unsigned char* lds, const StaticOrder& S, const int* tile_e, int tid) {
    LAS int* el = (LAS int*)(lds + LDS_ELIST);
    if (tid < 64) { Unit u; el[tid] = S.place(tid, u) ? tile_e[u.pm] : 0; }
    __syncthreads();
}

struct NoPre {};
template <class F> struct EpiRow8 {
    static constexpr bool PERM = true; static constexpr int NSIDE = F::NSIDE; F f;
    DEV const void* side(const Unit& u, int k) const { return f.side(u, k); }
    DEV void operator()(const f32x4 (&acc)[2][2][4][2], const Unit& u, int wr, int wc, int fr, int fq, const LAS float* sd) const {
        { const int ln_ = (int)__builtin_amdgcn_mbcnt_hi(~0u, __builtin_amdgcn_mbcnt_lo(~0u, 0u)); fr = ln_ & 15; fq = ln_ >> 4; }
        const int cl = wc * 32 + 8 * fq, c0 = u.pn * BM + cl;
        const auto p0 = f.pre(u, c0, sd + cl), p1 = f.pre(u, c0 + HALF, sd + cl + HALF);
#pragma unroll
        for (int ai = 0; ai < 2; ++ai)
#pragma unroll
            for (int m = 0; m < 4; ++m) { const int rl = ai * HALF + wr * 64 + m * 16 + fr, row = u.pm * BM + rl;
                f(u, row, c0, acc[ai][0][m][0], acc[ai][0][m][1], p0, sd + 256 + rl); f(u, row, c0 + HALF, acc[ai][1][m][0], acc[ai][1][m][1], p1, sd + 256 + rl); }
    }
};

typedef int v8i_t __attribute__((ext_vector_type(8)));
typedef int v4i_t __attribute__((ext_vector_type(4)));
template <bool GATHER, bool FP8, class Epi, class Sched>
DEV void gemm_phase(LAS unsigned char* lds, const Gemm g, const Sched& S, const Epi& E) {
    const int wid = g.wave, lane = (int)__builtin_amdgcn_mbcnt_hi(~0u, __builtin_amdgcn_mbcnt_lo(~0u, 0u)), tid = wid * 64 + lane, wr = wid >> 2, wc = wid & 3, fr = lane & 15, fq = lane >> 4;
    float z0 = 0.f; asm volatile("" : "+v"(z0));
    const int KB = g.KB, nt = KB / 128;
    int R0, C2; { int C; stage_rc(tid * 16, R0, C); C2 = C * 2; }
    unsigned voffB[2]; { const int Rb = Epi::PERM ? ((R0 & ~31) + perm32(R0 & 31)) : R0; voffB[0] = (unsigned)(Rb * KB + C2); voffB[1] = voffB[0] + 64u * (unsigned)KB; }
    const unsigned kstep = 128u, hstep = (unsigned)HALF * KB, tstep = 2u * hstep;
    const unsigned ldsw = (unsigned)wid * 1024u;
    const int aoff = lds_byte(wr * 64 + fr, fq * 8); int boff = lds_byte(wc * 32 + fr, fq * 8) + 4 * HTB; asm volatile("" : "+v"(boff));
    LAS int* tokb = (LAS int*)(lds + LDS_TOK);
    const auto rsA = __builtin_amdgcn_make_buffer_rsrc((void*)g.A, 0, 0x7fffffff, 0x00020000);
    const auto rsB = __builtin_amdgcn_make_buffer_rsrc((void*)g.Bt, 0, 0x7fffffff, 0x00020000);
    const auto rsT = __builtin_amdgcn_make_buffer_rsrc((void*)(GATHER ? (const void*)g.rowmap : g.A), 0, 0x7fffffff, 0x00020000);
#define PG8_SA(b, h) (((b) * 2 + (h)) * HTB)
#define PG8_SB(b, h) ((4 + (b) * 2 + (h)) * HTB)
#define PG8_STAGE(bufoff, rs, soff, voff) do { _Pragma("unroll") for (int _i = 0; _i < 2; ++_i) { \
        if constexpr (GATHER) __builtin_amdgcn_raw_ptr_buffer_load_lds(rs, (LAS void*)(lds + (bufoff) + ldsw + _i * 8192), 16, (int)(voff)[_i], (int)(soff), 0, 0); \
        else __builtin_amdgcn_raw_ptr_buffer_load_lds(rs, (LAS void*)(lds + (bufoff) + ldsw + _i * 8192), 16, (int)(voff)[0], (int)((soff) + _i * 64u * (unsigned)KB), 0, 0); } } while (0)
#define PG8_LDA(dst, b, h) do { _Pragma("unroll") for (int m = 0; m < 4; ++m) _Pragma("unroll") for (int k = 0; k < 2; ++k) dst[m][k] = *(const LAS bf16x8*)(lds + PG8_SA(b, h) + aoff + m * 2048 + k * 1024); } while (0)
#define PG8_LDB(dst, b, h) do { _Pragma("unroll") for (int n = 0; n < 2; ++n) _Pragma("unroll") for (int k = 0; k < 2; ++k) dst[n][k] = *(const LAS bf16x8*)(lds + boff + (PG8_SB(b, h) - 4 * HTB) + n * 2048 + k * 1024); } while (0)
#define PG8_CAT(x) __builtin_shufflevector(__builtin_bit_cast(v4i_t, x[0]), __builtin_bit_cast(v4i_t, x[1]), 0, 1, 2, 3, 4, 5, 6, 7)
#define PG8_MMA(ai, bj, At, Bt) do { __builtin_amdgcn_s_setprio(1); _Pragma("unroll") for (int m = 0; m < 4; ++m) _Pragma("unroll") for (int n = 0; n < 2; ++n) { \
        if constexpr (FP8) acc[ai][bj][m][n] = __builtin_amdgcn_mfma_scale_f32_16x16x128_f8f6f4(PG8_CAT(Bt[n]), PG8_CAT(At[m]), acc[ai][bj][m][n], 0, 0, 0, 0, 0, 0); \
        else { _Pragma("unroll") for (int k = 0; k < 2; ++k) acc[ai][bj][m][n] = __builtin_amdgcn_mfma_f32_16x16x32_bf16(Bt[n][k], At[m][k], acc[ai][bj][m][n], 0, 0, 0); } } __builtin_amdgcn_s_setprio(0); } while (0)
#define PG8_WAIT_V(n) asm volatile("s_waitcnt vmcnt(" #n ")" ::: "memory")
#define PG8_WAIT_L(n) asm volatile("s_waitcnt lgkmcnt(" #n ")" ::: "memory")
#define PG8_BAR __builtin_amdgcn_s_barrier()
#define PG8_SCHED __builtin_amdgcn_sched_barrier(0)
    Unit cur, nxt; int ui = 0;
    if (!S.next(0, cur)) return;
    f32x4 acc[2][2][4][2];
#pragma unroll
    for (int a = 0; a < 2; ++a)
#pragma unroll
        for (int b = 0; b < 2; ++b)
#pragma unroll
            for (int m = 0; m < 4; ++m)
#pragma unroll
                for (int n = 0; n < 2; ++n) acc[a][b][m][n] = (f32x4){z0, z0, z0, z0};
    bf16x8 At[4][2], B0[2][2], B1[2][2];
    unsigned cA, cB = (unsigned)cur.e * (unsigned)g.bstride + (unsigned)cur.pn * tstep;
    unsigned voffA[2]; voffA[0] = (unsigned)(R0 * KB + C2); voffA[1] = voffA[0] + 64u * (unsigned)KB;
    if constexpr (GATHER) { cA = 0u;
        if (wid < 4) __builtin_amdgcn_raw_ptr_buffer_load_lds(rsT, (LAS void*)(tokb + wid * 64), 4, (wid * 64 + lane) * 4, cur.pm * (BM * 4), 0, 0);
        asm volatile("s_waitcnt vmcnt(0)" ::: "memory"); __builtin_amdgcn_s_barrier();
    } else cA = (unsigned)cur.pm * tstep;
    const unsigned hA = GATHER ? 0u : hstep;
    LAS float* sideb = (LAS float*)(lds + LDS_SIDE);
#define PG8_SIDE(un, sel) do { if constexpr (Epi::NSIDE > 0) { if (wid < Epi::NSIDE) { const char* sp_ = (const char*)E.side(un, wid); int ln_ = (int)__builtin_amdgcn_mbcnt_hi(~0u, __builtin_amdgcn_mbcnt_lo(~0u, 0u)); asm volatile("" : "+v"(ln_)); \
        __builtin_amdgcn_global_load_lds((const unsigned*)(sp_ + ln_ * 16), (LAS unsigned*)(sideb + (sel) * 512 + wid * 256), 16, 0, 0); } } } while (0)
    PG8_SIDE(cur, 0);
#define PG8_OA(dst, sel, h) unsigned dst[2]; if constexpr (GATHER) { dst[0] = (unsigned)(tokb[(sel) * 256 + (h) * HALF + R0] * KB + C2); dst[1] = (unsigned)(tokb[(sel) * 256 + (h) * HALF + R0 + 64] * KB + C2); } else { dst[0] = voffA[0]; dst[1] = voffA[1]; }
    { PG8_OA(p0_, 0, 0); PG8_OA(p1_, 0, 1); PG8_STAGE(PG8_SB(0, 0), rsB, cB, voffB); PG8_STAGE(PG8_SB(0, 1), rsB, cB + hstep, voffB); PG8_STAGE(PG8_SA(0, 0), rsA, cA, p0_); PG8_STAGE(PG8_SA(0, 1), rsA, cA + hA, p1_); }
    if (wr == 1) PG8_BAR;
    PG8_WAIT_V(2); PG8_BAR;
    { PG8_OA(p0_, 0, 0); PG8_STAGE(PG8_SB(1, 0), rsB, cB + kstep, voffB); PG8_STAGE(PG8_SA(1, 0), rsA, cA + kstep, p0_); PG8_STAGE(PG8_SB(1, 1), rsB, cB + hstep + kstep, voffB); }
    PG8_WAIT_V(6); PG8_BAR;
    for (;;) {
        const bool has_next = S.next(ui + 1, nxt);
        unsigned nA = cA, nB = cB;
        if (has_next) { nB = (unsigned)nxt.e * (unsigned)g.bstride + (unsigned)nxt.pn * tstep;
            if constexpr (GATHER) { if (wid < 4) { const int ln_ = (int)__builtin_amdgcn_mbcnt_hi(~0u, __builtin_amdgcn_mbcnt_lo(~0u, 0u)); __builtin_amdgcn_raw_ptr_buffer_load_lds(rsT, (LAS void*)(tokb + ((ui + 1) & 1) * 256 + wid * 64), 4, (wid * 64 + ln_) * 4, nxt.pm * (BM * 4), 0, 0); } }
            else nA = (unsigned)nxt.pm * tstep;
            PG8_SIDE(nxt, (ui + 1) % 3); }
#pragma unroll 1
        for (int t = 0; t < nt; t += 2) {
            const bool last = (t == nt - 2);
            const unsigned a1 = cA + (unsigned)(t + 1) * kstep;
            const unsigned a2 = last ? nA : cA + (unsigned)(t + 2) * kstep, b2 = last ? nB : cB + (unsigned)(t + 2) * kstep;
            const unsigned a3 = a2 + kstep, b3 = b2 + kstep;
            const int selc = ui & 1, seln = (last && has_next) ? ((ui + 1) & 1) : selc;
            PG8_LDB(B0, 0, 0); PG8_LDB(B1, 0, 1); PG8_SCHED; PG8_LDA(At, 0, 0); { PG8_OA(q_, selc, 1); PG8_STAGE(PG8_SA(1, 1), rsA, a1 + hA, q_); }
            PG8_WAIT_V(8); PG8_WAIT_L(0); PG8_BAR; PG8_MMA(0, 0, At, B0); PG8_MMA(0, 1, At, B1); PG8_BAR; PG8_SCHED;
            PG8_LDA(At, 0, 1); PG8_STAGE(PG8_SB(0, 0), rsB, b2, voffB); PG8_STAGE(PG8_SB(0, 1), rsB, b2 + hstep, voffB); { PG8_OA(q_, seln, 0); PG8_STAGE(PG8_SA(0, 0), rsA, a2, q_); }
            PG8_WAIT_V(8); PG8_WAIT_L(0); PG8_BAR; PG8_MMA(1, 0, At, B0); PG8_MMA(1, 1, At, B1); PG8_BAR; PG8_SCHED;
            PG8_LDB(B0, 1, 0); PG8_LDB(B1, 1, 1); PG8_SCHED; PG8_LDA(At, 1, 0); { PG8_OA(q_, seln, 1); PG8_STAGE(PG8_SA(0, 1), rsA, a2 + hA, q_); }
            PG8_WAIT_V(8); PG8_WAIT_L(0); PG8_BAR; PG8_MMA(0, 0, At, B0); PG8_MMA(0, 1, At, B1); PG8_BAR; PG8_SCHED;
            PG8_LDA(At, 1, 1); PG8_STAGE(PG8_SB(1, 0), rsB, b3, voffB); PG8_STAGE(PG8_SB(1, 1), rsB, b3 + hstep, voffB); { PG8_OA(q_, seln, 0); PG8_STAGE(PG8_SA(1, 0), rsA, a3, q_); }
            PG8_WAIT_V(8); PG8_WAIT_L(0); PG8_BAR; PG8_MMA(1, 0, At, B0); PG8_MMA(1, 1, At, B1); PG8_BAR; PG8_SCHED;
        }
        if (wr == 0) PG8_BAR;
        E(acc, cur, wr, wc, fr, fq, sideb + (ui % 3) * 512);
        if (!has_next) break;
#pragma unroll
        for (int a = 0; a < 2; ++a)
#pragma unroll
            for (int b = 0; b < 2; ++b)
#pragma unroll
                for (int m = 0; m < 4; ++m)
#pragma unroll
                    for (int n = 0; n < 2; ++n) acc[a][b][m][n] = (f32x4){z0, z0, z0, z0};
        cur = nxt; cA = nA; cB = nB; ++ui;
        if (wr == 1) PG8_BAR;
    }
    PG8_WAIT_V(0);
    PG8_BAR;
#undef PG8_SA
#undef PG8_SB
#undef PG8_STAGE
#undef PG8_SIDE
#undef PG8_OA
#undef PG8_LDA
#undef PG8_LDB
#undef PG8_MMA
#undef PG8_CAT
#undef PG8_WAIT_V
#undef PG8_WAIT_L
#undef PG8_BAR
#undef PG8_SCHED
}

typedef GAS unsigned gu32;
#define XB_TMO      128
#define XB_XCNT(j)  (256  + 64 * (j))
#define XB_XSUB(j)  (1280 + 64 * (j))
#define XB_XGEN(j)  (2304 + 64 * (j))
#define XB_TOP      3328
#define XB_TOPGEN   3392
#define XCD_BAR_WORDS 3456
#define XB_SPIN_CAP (1u << 20)
DEV unsigned xb_ld(unsigned* p) { return __hip_atomic_load(p, __ATOMIC_RELAXED, __HIP_MEMORY_SCOPE_AGENT); }
DEV unsigned xb_add(unsigned* p, unsigned v) { return __hip_atomic_fetch_add(p, v, __ATOMIC_RELAXED, __HIP_MEMORY_SCOPE_AGENT); }
DEV unsigned xb_xcc_id() { return (unsigned)__builtin_amdgcn_s_getreg((3 << 11) | 20) & 0xFu; }
#define XB_SPIN(cond, bar) do { unsigned _sp = 0; while (cond) { __builtin_amdgcn_s_sleep(1); \
    if ((++_sp & 255u) == 0u) { if (xb_ld(&(bar)[XB_TMO])) break; if (_sp > XB_SPIN_CAP) { atomicAdd(&(bar)[XB_TMO], 1u); break; } } } } while (0)
struct XcdBarrier { unsigned* bar; unsigned x; volatile LAS unsigned* st; int wave; };
DEV bool xb_thread0(int wave) { return wave == 0 && __builtin_amdgcn_mbcnt_hi(~0u, __builtin_amdgcn_mbcnt_lo(~0u, 0u)) == 0u; }
DEV XcdBarrier xcd_barrier_post(unsigned* bar, volatile LAS unsigned* st, int wave) {
    XcdBarrier b; b.bar = bar; b.x = xb_xcc_id(); b.st = st; b.wave = wave;
    if (xb_thread0(wave)) (void)xb_add(&bar[XB_XCNT(b.x)], 1u);
    return b;
}
DEV void xcd_barrier_complete(unsigned* bar, unsigned x, unsigned& nloc, unsigned& nx) {
    const unsigned G = gridDim.x * gridDim.y * gridDim.z;
    unsigned sum, cnt, mine, sp = 0u;
    for (;;) {
        sum = 0u; cnt = 0u; mine = 0u;
#pragma unroll
        for (unsigned j = 0; j < 16; ++j) { const unsigned c = xb_ld(&bar[XB_XCNT(j)]); sum += c; cnt += (c > 0u) ? 1u : 0u; mine = (j == x) ? c : mine; }
        if (sum == G) break;
        __builtin_amdgcn_s_sleep(1);
        if ((++sp & 255u) == 0u) { if (xb_ld(&bar[XB_TMO])) break; if (sp > XB_SPIN_CAP) { atomicAdd(&bar[XB_TMO], 1u); break; } }
    }
    nloc = mine > 0u ? mine : 1u; nx = cnt > 0u ? cnt : 1u;
}
DEV void xcd_barrier(const XcdBarrier& b) {
    asm volatile("s_waitcnt vmcnt(0)" ::: "memory");
    __syncthreads();
    if (xb_thread0(b.wave)) {
        unsigned* bar = b.bar;
        __builtin_amdgcn_s_waitcnt(0);
        unsigned nloc = b.st[0], nx = b.st[1];
        if (nloc == 0u) { xcd_barrier_complete(bar, b.x, nloc, nx); b.st[0] = nloc; b.st[1] = nx; }
        const unsigned old = xb_add(&bar[XB_XSUB(b.x)], 1u);
        const unsigned gen = old / nloc;
        if (old + 1u == (gen + 1u) * nloc) {
            __builtin_amdgcn_fence(__ATOMIC_RELEASE, "agent");
            asm volatile("s_waitcnt vmcnt(0)" ::: "memory");
            const unsigned og = xb_add(&bar[XB_TOP], 1u);
            const unsigned tg = og / nx;
            if (og + 1u == (tg + 1u) * nx) xb_add(&bar[XB_TOPGEN], 1u);
            else XB_SPIN(xb_ld(&bar[XB_TOPGEN]) == tg, bar);
            __builtin_amdgcn_fence(__ATOMIC_ACQUIRE, "agent");
            xb_add(&bar[XB_XGEN(b.x)], 1u);
            asm volatile("s_waitcnt vmcnt(0)" ::: "memory");
        } else {
            XB_SPIN(xb_ld(&bar[XB_XGEN(b.x)]) == gen, bar);
            __builtin_amdgcn_fence(__ATOMIC_ACQUIRE, "agent");
            asm volatile("s_waitcnt vmcnt(0)" ::: "memory");
        }
    }
    __syncthreads();
}
constexpr size_t MiB = 1u << 20;
constexpr int PMAX = 131072 + 32 * 256;
constexpr size_t W_CTL = 0, CTL_ZERO_BYTES = 1 * MiB;
constexpr size_t W_IN0 = 2 * MiB, W_GLU = 6 * MiB, W_OUT0 = 7 * MiB, W_IN1 = 9 * MiB, W_OUT1 = 16 * MiB;
constexpr size_t W_LUT = 18 * MiB, W_KM = W_LUT + 64 * 1024, W_HIST = W_KM + 256 * 1024, W_SORT = W_HIST + 64 * 1024  , W_GR = 20 * MiB  , W_SS = 22 * MiB  ;
constexpr size_t W_GU = 32 * MiB, W_DN = 288 * MiB, W_XB = 416 * MiB  , W_XBB = 480 * MiB  , W_X8 = 1024 * MiB  , W_HB = 736 * MiB, W_YS5 = 928 * MiB, W_Y0 = 960 * MiB, W_MIXB = 1024 * MiB, W_GLAO = 1088 * MiB;
constexpr size_t W_ROUTE = 26 * MiB  , W_ACT = 736 * MiB  , W_YS = 1160 * MiB, W_END = 1432 * MiB;
static_assert(W_ACT + (size_t)PMAX * 2048 <= W_MIXB && W_YS + (size_t)PMAX * 2048 <= W_END && W_X8 + (size_t)PMAX * 1024 <= W_YS && W_ROUTE + 4 * MiB <= W_GU, "ws map");
constexpr int CW_BAR = 4096;

struct Args { const float* in[29]; float* out; unsigned char* ws; int ph_lo, ph_hi; };
struct Frame {
    LAS unsigned char* lds; int tid, lane, wave, vcu, G;
    const float* const* in; unsigned char* ws;
};
#define WSP(T_, off) ((T_*)(F.ws + (off)))

DEV unsigned pk4_fp8(float a, float b, float c, float d) { unsigned w = 0u; w = __builtin_amdgcn_cvt_pk_fp8_f32(a, b, w, false); w = __builtin_amdgcn_cvt_pk_fp8_f32(c, d, w, true); return w; }
struct CvItem { const float* src; unsigned char* dst; int pitch, K; float sc; };
constexpr int P0_I_GU = 8 * 8, P0_I_DN = 8 * 4, P0_I_IN0 = 8 * 8, P0_I_GLU = 4 * 2, P0_I_O = 8 * 4, P0_I_IN1 = 8 * 12;
constexpr int P0_N_GU = 64 * P0_I_GU, P0_N_DN = 64 * P0_I_DN, P0_NITEMS = P0_N_GU + P0_N_DN + P0_I_IN0 + P0_I_GLU + 2 * P0_I_O + P0_I_IN1;
DEV CvItem cv_decode(Frame& F, int it) {
    int r = it; const float* W; unsigned char* D; int K, N, NP, es; float sc = 0.f;
    if (r < P0_N_GU) { const int m = r / P0_I_GU; r %= P0_I_GU; W = F.in[25] + (size_t)m * 1024 * 2048; D = WSP(unsigned char, W_GU) + (size_t)m * 2048 * 1024; K = 1024; N = 2048; NP = 2048; es = 1; sc = 64.f; }
    else if ((r -= P0_N_GU) < P0_N_DN) { const int m = r / P0_I_DN; r %= P0_I_DN; W = F.in[27] + (size_t)m * 1024 * 1024; D = WSP(unsigned char, W_DN) + (size_t)m * 1024 * 1024; K = 1024; N = 1024; NP = 1024; es = 1; sc = 128.f; }
    else if ((r -= P0_N_DN) < P0_I_IN0) { W = F.in[1]; D = WSP(unsigned char, W_IN0); K = 1024; N = 2048; NP = 2048; es = 2; }
    else if ((r -= P0_I_IN0) < P0_I_GLU) { W = F.in[10]; D = WSP(unsigned char, W_GLU); K = 512; N = 512; NP = 512; es = 2; }
    else if ((r -= P0_I_GLU) < P0_I_O) { W = F.in[13]; D = WSP(unsigned char, W_OUT0); K = 1024; N = 1024; NP = 1024; es = 2; }
    else if ((r -= P0_I_O) < P0_I_O) { W = F.in[18]; D = WSP(unsigned char, W_OUT1); K = 1024; N = 1024; NP = 1024; es = 2; }
    else { r -= P0_I_O; W = F.in[14]; D = WSP(unsigned char, W_IN1); K = 1024; N = 3072; NP = 3088; es = 2; }
    const int nblk = N / 256, kb = r / nblk, nb = r % nblk;
    CvItem c; c.src = W + (size_t)(128 * kb) * NP + 256 * nb; c.dst = D + ((size_t)(256 * nb) * K + 128 * kb) * es; c.pitch = NP; c.K = K; c.sc = sc; return c;
}
DEV void cv_load(const CvItem& c, f32x4 (&v)[16], int tid) {
#pragma unroll
    for (int i = 0; i < 16; ++i) v[i] = *(const f32x4*)(c.src + (size_t)(8 * i + (tid >> 6)) * c.pitch + 4 * (tid & 63));
}
DEV void cv_store(const CvItem& c, const f32x4 (&v)[16], LAS float* T_, int tid) {
#pragma unroll
    for (int i = 0; i < 16; ++i) *(LAS f32x4*)(T_ + (8 * i + (tid >> 6)) * 260 + 4 * (tid & 63)) = v[i];
    __syncthreads();
    const int n = tid & 255, kh = tid >> 8; const LAS float* s = T_ + (64 * kh) * 260 + n;
    if (c.sc > 0.f) { const float q = c.sc; unsigned char* d = c.dst + (size_t)n * c.K + 64 * kh;
#pragma unroll
        for (int g = 0; g < 4; ++g) { u32x4 o;
            o.x = pk4_fp8(s[(16 * g + 0) * 260] * q, s[(16 * g + 1) * 260] * q, s[(16 * g + 2) * 260] * q, s[(16 * g + 3) * 260] * q); o.y = pk4_fp8(s[(16 * g + 4) * 260] * q, s[(16 * g + 5) * 260] * q, s[(16 * g + 6) * 260] * q, s[(16 * g + 7) * 260] * q);
            o.z = pk4_fp8(s[(16 * g + 8) * 260] * q, s[(16 * g + 9) * 260] * q, s[(16 * g + 10) * 260] * q, s[(16 * g + 11) * 260] * q); o.w = pk4_fp8(s[(16 * g + 12) * 260] * q, s[(16 * g + 13) * 260] * q, s[(16 * g + 14) * 260] * q, s[(16 * g + 15) * 260] * q);
            *(u32x4*)(d + 16 * g) = o; }
    } else { unsigned char* d = c.dst + ((size_t)n * c.K + 64 * kh) * 2;
#pragma unroll
        for (int g = 0; g < 8; ++g) { u32x4 o; o.x = cvt_pk(s[(8 * g + 0) * 260], s[(8 * g + 1) * 260]); o.y = cvt_pk(s[(8 * g + 2) * 260], s[(8 * g + 3) * 260]); o.z = cvt_pk(s[(8 * g + 4) * 260], s[(8 * g + 5) * 260]); o.w = cvt_pk(s[(8 * g + 6) * 260], s[(8 * g + 7) * 260]);
            *(u32x4*)(d + 16 * g) = o; }
    }
    __syncthreads();
}
__constant__ int BUCKET_TH2[16] = {16, 22, 30, 40, 54, 73, 99, 134, 182, 246, 332, 450, 609, 825, 1117, 1513};
DEV void p0_prologue(Frame& F) {
    { LAS float* T_ = (LAS float*)F.lds; f32x4 va[16], vb[16];
      int it = F.vcu;
      if (it < P0_NITEMS) { CvItem ca = cv_decode(F, it); cv_load(ca, va, F.tid);
#pragma unroll 1
          for (;;) {
              const int it2 = it + F.G; CvItem cb = ca; const bool h2 = it2 < P0_NITEMS; if (h2) { cb = cv_decode(F, it2); cv_load(cb, vb, F.tid); }
              cv_store(ca, va, T_, F.tid);
              if (!h2) break;
              const int it3 = it2 + F.G; const bool h3 = it3 < P0_NITEMS; if (h3) { ca = cv_decode(F, it3); cv_load(ca, va, F.tid); }
              cv_store(cb, vb, T_, F.tid);
              if (!h3) break;
              it = it3;
          } } }
    const int gt = F.vcu * 512 + F.tid, NGT = F.G * 512;
    for (int i = gt; i < 16 * 1024; i += NGT) { const int n = i >> 10, k = i & 1023; WSP(bf16_t, W_IN1)[(size_t)(3072 + n) * 1024 + k] = (bf16_t)(cvt_pk(F.in[14][(size_t)k * 3088 + 3072 + n], 0.f) & 0xffffu); }
    { const f32x4* x4 = (const f32x4*)F.in[0]; u32x2* o = WSP(u32x2, W_XB);
      for (size_t i = gt; i < (size_t)T * 1024 / 4; i += (size_t)NGT * 8) { f32x4 v[8];
#pragma unroll
          for (int u = 0; u < 8; ++u) v[u] = x4[i + (size_t)u * NGT];
#pragma unroll
          for (int u = 0; u < 8; ++u) { u32x2 w; w.x = cvt_pk(v[u].x, v[u].y); w.y = cvt_pk(v[u].z, v[u].w); o[i + (size_t)u * NGT] = w; } } }
    for (int i = gt; i < 8 * 2048; i += NGT) { const int h = i >> 11, n = i & 2047; int bk = n;
        if (n >= 16) { bk = 16;
#pragma unroll
            for (int q = 1; q < 16; ++q) bk += (n >= BUCKET_TH2[q]) ? 1 : 0; }
        WSP(float, W_LUT)[i] = F.in[12][bk * 8 + h] * 1.4426950408889634f; }
}

DEV void p_kmean(Frame& F) {
    const int gw = F.vcu * 8 + F.wave, NGW = F.G * 8; const bf16_t* H0 = WSP(bf16_t, W_HB); float* KM = WSP(float, W_KM);
    for (int it = gw; it < 1024; it += NGW) { const int blk = it & 7, h = (it >> 3) & 7, b = it >> 6; const int r8 = F.lane >> 3, c = F.lane & 7;
        const bf16_t* p = H0 + (size_t)(b * 2048 + blk * 256 + r8) * 2048 + 1024 + h * 64 + c * 8; float s[8];
#pragma unroll
        for (int j = 0; j < 8; ++j) s[j] = 0.f;
#pragma unroll 8
        for (int i = 0; i < 32; ++i) { const u32x4 v = *(const u32x4*)(p + (size_t)i * 8 * 2048);
            s[0] += bflo(v.x); s[1] += bfhi(v.x); s[2] += bflo(v.y); s[3] += bfhi(v.y); s[4] += bflo(v.z); s[5] += bfhi(v.z); s[6] += bflo(v.w); s[7] += bfhi(v.w); }
#pragma unroll
        for (int j = 0; j < 8; ++j) { s[j] += __shfl_xor(s[j], 8); s[j] += __shfl_xor(s[j], 16); s[j] += __shfl_xor(s[j], 32); }
        if (F.lane < 8) {
#pragma unroll
            for (int j = 0; j < 8; ++j) KM[(size_t)it * 64 + c * 8 + j] = s[j] * (1.f / 256.f); } }
}

DEV void s5_item(Frame& F, int b, int g, LAS unsigned char* sl  ) {
    const int lane = F.lane, p0 = lane & 31, hi = lane >> 5, q4 = lane >> 4;
    const float* lam_re = F.in[2]; const float* lam_im = F.in[3]; const float* log_dt = F.in[4]; const float* b_re = F.in[5]; const float* b_im = F.in[6];
    const float* c_re = F.in[7]; const float* c_im = F.in[8]; const float* dsk = F.in[9];
    const bf16_t* H0 = WSP(bf16_t, W_HB); bf16_t* YS = WSP(bf16_t, W_YS5);
    const float dt = __expf(log_dt[g]);
    float ar[2], ai[2]; bf16x8 bfr[4];
#pragma unroll
    for (int s = 0; s < 2; ++s) { const int p = p0 + 32 * s; const float lr = lam_re[g * 64 + p], li = lam_im[g * 64 + p]; const float mag = __expf(lr * dt);
        ar[s] = mag * cosf(li * dt); ai[s] = mag * sinf(li * dt);
        const float er = ar[s] - 1.f, ei = ai[s], den = lr * lr + li * li; const float qr = (er * lr + ei * li) / den, qi = (ei * lr - er * li) / den;
        u32x4 wr_, wi_; float vr[8], vi[8];
#pragma unroll
        for (int j = 0; j < 8; ++j) { const float br = b_re[(g * 64 + p) * 16 + 8 * hi + j], bi = b_im[(g * 64 + p) * 16 + 8 * hi + j]; vr[j] = qr * br - qi * bi; vi[j] = qr * bi + qi * br; }
        wr_.x = cvt_pk(vr[0], vr[1]); wr_.y = cvt_pk(vr[2], vr[3]); wr_.z = cvt_pk(vr[4], vr[5]); wr_.w = cvt_pk(vr[6], vr[7]);
        wi_.x = cvt_pk(vi[0], vi[1]); wi_.y = cvt_pk(vi[2], vi[3]); wi_.z = cvt_pk(vi[4], vi[5]); wi_.w = cvt_pk(vi[6], vi[7]);
        bfr[2 * s] = __builtin_bit_cast(bf16x8, wr_); bfr[2 * s + 1] = __builtin_bit_cast(bf16x8, wi_); }
    bf16x8 cfr[4];
#pragma unroll
    for (int ks = 0; ks < 4; ++ks) { float v[8];
#pragma unroll
        for (int j = 0; j < 8; ++j) { const int c = 32 * ks + 8 * q4 + j, p = c >> 1; const int h = lane & 15; v[j] = (c & 1) ? -c_im[(g * 16 + h) * 64 + p] : c_re[(g * 16 + h) * 64 + p]; }
        u32x4 w; w.x = cvt_pk(v[0], v[1]); w.y = cvt_pk(v[2], v[3]); w.z = cvt_pk(v[4], v[5]); w.w = cvt_pk(v[6], v[7]); cfr[ks] = __builtin_bit_cast(bf16x8, w); }
    float dv[4];
#pragma unroll
    for (int r = 0; r < 4; ++r) dv[r] = dsk[g * 16 + 4 * q4 + r];
    const int tm = 16 * ((p0 >> 2) & 1) + 4 * (p0 >> 3) + (p0 & 3);
    const bf16_t* urow = H0 + (size_t)(b * 2048 + tm) * 2048 + g * 16 + 8 * hi;
    float cr[2] = {0.f, 0.f}, ci[2] = {0.f, 0.f};
    bf16x8 ufr = *(const bf16x8*)urow;
    for (int tile = 0; tile < 64; ++tile) {
        const bf16x8 ucur = ufr;
        if (tile + 1 < 64) ufr = *(const bf16x8*)(urow + (size_t)(tile + 1) * 32 * 2048);
        f32x16 x[4];
#pragma unroll
        for (int n = 0; n < 4; ++n) { f32x16 z;
#pragma unroll
            for (int r = 0; r < 16; ++r) z[r] = 0.f;
            x[n] = __builtin_amdgcn_mfma_f32_32x32x16_bf16(ucur, bfr[n], z, 0, 0, 0); }
#pragma unroll
        for (int s = 0; s < 2; ++s) {
            f32x16& xr = x[2 * s]; f32x16& xi = x[2 * s + 1];
            float sr = hi ? 0.f : cr[s], si = hi ? 0.f : ci[s];
#pragma unroll
            for (int r = 0; r < 16; ++r) { const float nr = ar[s] * sr - ai[s] * si + xr[r], ni = ar[s] * si + ai[s] * sr + xi[r]; xr[r] = nr; xi[r] = ni; sr = nr; si = ni; }
            const float o_r = swap32(sr), o_i = swap32(si);
            float wr_ = hi ? o_r : 0.f, wi_ = hi ? o_i : 0.f;
#pragma unroll
            for (int r = 0; r < 16; ++r) { const float nr = ar[s] * wr_ - ai[s] * wi_, ni = ar[s] * wi_ + ai[s] * wr_; wr_ = nr; wi_ = ni; xr[r] += wr_; xi[r] += wi_; }
            const float e_r = swap32(xr[15]), e_i = swap32(xi[15]);
            cr[s] = hi ? xr[15] : e_r; ci[s] = hi ? xi[15] : e_i;
#pragma unroll
            for (int r = 0; r < 16; ++r) *(LAS unsigned*)(sl + (16 * hi + r) * 256 + (p0 + 32 * s) * 4) = cvt_pk(xr[r], xi[r]);
        }
#pragma unroll
        for (int tt = 0; tt < 2; ++tt) {
            f32x4 y = {0.f, 0.f, 0.f, 0.f};
#pragma unroll
            for (int ks = 0; ks < 4; ++ks) { const bf16x8 sf = *(const LAS bf16x8*)(sl + (16 * tt + (lane & 15)) * 256 + ks * 64 + q4 * 16); y = __builtin_amdgcn_mfma_f32_16x16x32_bf16(cfr[ks], sf, y, 0, 0, 0); }
            const int t = tile * 32 + 16 * tt + (lane & 15);
            const u32x2 uw = *(const u32x2*)(H0 + (size_t)(b * 2048 + t) * 2048 + g * 16 + 4 * q4);
            const float y0 = gelu_tanh(y[0] + dv[0] * bflo(uw.x)), y1 = gelu_tanh(y[1] + dv[1] * bfhi(uw.x)), y2 = gelu_tanh(y[2] + dv[2] * bflo(uw.y)), y3 = gelu_tanh(y[3] + dv[3] * bfhi(uw.y));
            u32x2 ow; ow.x = cvt_pk(y0, y1); ow.y = cvt_pk(y2, y3);
            *(u32x2*)(YS + (size_t)(b * 2048 + t) * 512 + g * 16 + 4 * q4) = ow;
        }
    }
}

constexpr int AT_K = 0, AT_V = 24576, AT_WS = 49152, AT_OST = 51200, AT_LUT = AT_OST + 8 * 4096  , AT_LUTB = 8704, AT_Q = AT_LUT + 8 * AT_LUTB  , AT_END = AT_Q + 64;
DEV int crow(int r, int hi) { return (r & 3) + 8 * (r >> 2) + 4 * hi; }
DEV s16x4 vtr(const LAS unsigned char* p) { typedef short v4i16_t __attribute__((ext_vector_type(4))); return __builtin_bit_cast(s16x4, __builtin_amdgcn_ds_read_tr16_b64_v4i16((LAS v4i16_t*)p)); }
DEV void moba_unit(Frame& F, int b, int h, int own) {
    const int lane = F.lane, wid = F.wave, r32 = lane & 31, hi = lane >> 5;
    LAS unsigned char* lds = F.lds;
    const bf16_t* H0 = WSP(bf16_t, W_HB); const float* KM = WSP(float, W_KM);
    LAS float* lut = (LAS float*)(lds + AT_LUT + h * AT_LUTB); LAS float* wsf = (LAS float*)(lds + AT_WS) + wid * 64;
    const size_t rowbase = (size_t)b * 2048;
    const int qpos = own * 256 + wid * 32 + r32;
    bf16x8 qr[4];
#pragma unroll
    for (int d0 = 0; d0 < 4; ++d0) qr[d0] = *(const bf16x8*)(H0 + (rowbase + qpos) * 2048 + 512 + h * 64 + d0 * 16 + hi * 8);
    unsigned selmask = 0u;
    if (own > 0) {
        float gate[7];
#pragma unroll
        for (int j = 0; j < 7; ++j) { float s = 0.f;
            if (j < own) { const float* km = KM + ((size_t)(b * 8 + h) * 8 + j) * 64 + hi * 8;
#pragma unroll
                for (int d0 = 0; d0 < 4; ++d0) { const f32x4 k0 = *(const f32x4*)(km + d0 * 16), k1 = *(const f32x4*)(km + d0 * 16 + 4); const u32x4 qw = __builtin_bit_cast(u32x4, qr[d0]);
                    s += bflo(qw.x) * k0.x + bfhi(qw.x) * k0.y + bflo(qw.y) * k0.z + bfhi(qw.y) * k0.w + bflo(qw.z) * k1.x + bfhi(qw.z) * k1.y + bflo(qw.w) * k1.z + bfhi(qw.w) * k1.w; } }
            gate[j] = s + swap32(s); }
#pragma unroll
        for (int j = 0; j < 7; ++j) { int rank = 0;
#pragma unroll
            for (int j2 = 0; j2 < 7; ++j2) if (j2 != j && j2 < own && (gate[j2] > gate[j] || (gate[j2] == gate[j] && j2 < j))) ++rank;
            if (j < own && rank < 3) selmask |= 1u << j; }
    }
    const int NT = 4 * (own + 1);
#define KV0(i) ((i) < 4 ? own * 256 + (i) * 64 : (((i) - 4) >> 2) * 256 + (((i) - 4) & 3) * 64)
    const bf16_t* kbase = H0 + (rowbase + lane) * 2048 + 1024 + h * 64 + wid * 8;
    const bf16_t* vbase = H0 + (rowbase + 16 * (wid & 3) + (lane >> 2)) * 2048 + 1536 + h * 64 + (wid >> 2) * 32 + (lane & 3) * 8;
#define LOADKV(i, bo_) do { const int kv0_ = KV0(i); \
        __builtin_amdgcn_global_load_lds((const unsigned*)(kbase + (size_t)kv0_ * 2048), (LAS unsigned*)(lds + AT_K + bo_ + wid * 1024), 16, 0, 0); \
        __builtin_amdgcn_global_load_lds((const unsigned*)(vbase + (size_t)kv0_ * 2048), (LAS unsigned*)(lds + AT_V + bo_ + wid * 1024), 16, 0, 0); } while (0)
    LOADKV(0, 0); LOADKV(1, 8192);
    int bo = 0, bo2 = 16384;
    float m_ref = 0.f, l_run = 0.f; f32x16 o[2];
#pragma unroll
    for (int r = 0; r < 16; ++r) { o[0][r] = 0.f; o[1][r] = 0.f; }
    const int Q0 = own * 256 + wid * 32;
#pragma unroll 1
    for (int i = 0; i < NT; ++i) {
        if (i + 1 < NT) asm volatile("s_waitcnt vmcnt(2) lgkmcnt(0)\n\ts_barrier" ::: "memory"); else asm volatile("s_waitcnt vmcnt(0) lgkmcnt(0)\n\ts_barrier" ::: "memory");
        if (i + 2 < NT) LOADKV(i + 2, bo2);
        const int kv0 = KV0(i);
        const bool ownblk = i < 4;
        if (!(ownblk && kv0 > Q0 + 31)) {
            const bool partial = ownblk && (kv0 + 63 > Q0);
            const bool rowsel = ownblk || ((selmask >> ((i - 4) >> 2)) & 1u);
            f32x16 p0, p1;
            { const LAS float* lp = lut + 128 + (qpos - kv0 - 4 * hi - 59);
#pragma unroll
              for (int r = 0; r < 16; ++r) { const int c = (r & 3) + 8 * (r >> 2); p0[r] = lp[59 - c] - m_ref; p1[r] = lp[59 - c - 32] - m_ref; } }
            { const LAS unsigned char* kb = lds + AT_K + bo + hi * 1024 + r32 * 16;
#pragma unroll
              for (int d0 = 0; d0 < 4; ++d0) { const bf16x8 k0 = *(const LAS bf16x8*)(kb + d0 * 2048), k1 = *(const LAS bf16x8*)(kb + d0 * 2048 + 512);
                  p0 = __builtin_amdgcn_mfma_f32_32x32x16_bf16(k0, qr[d0], p0, 0, 0, 0); p1 = __builtin_amdgcn_mfma_f32_32x32x16_bf16(k1, qr[d0], p1, 0, 0, 0); } }
            if (partial) { const int dbase = qpos - kv0 - 4 * hi;
#pragma unroll
                for (int r = 0; r < 16; ++r) { const int d0_ = dbase - ((r & 3) + 8 * (r >> 2)); p0[r] = d0_ >= 0 ? p0[r] : -INFINITY; p1[r] = d0_ >= 32 ? p1[r] : -INFINITY; } }
            float rmax = fmaxf(p0[0], p1[0]);
#pragma unroll
            for (int r = 1; r < 16; ++r) rmax = fmaxf(rmax, fmaxf(p0[r], p1[r]));
            rmax = fmaxf(rmax, swap32(rmax));
            rmax = rowsel ? rmax : -INFINITY;
            if (i == 0 || __any(rmax > 8.f)) {
                const float dl = (i == 0) ? rmax : fmaxf(rmax, 0.f); m_ref += dl;
#pragma unroll
                for (int r = 0; r < 16; ++r) { p0[r] -= dl; p1[r] -= dl; }
                const float alpha = __builtin_amdgcn_exp2f(-dl); l_run *= alpha;
                if (hi == 0) wsf[r32] = alpha;
#pragma unroll
                for (int r = 0; r < 16; ++r) { const float f = wsf[crow(r, hi)]; o[0][r] *= f; o[1][r] *= f; }
            }
            float rs = 0.f;
#pragma unroll
            for (int r = 0; r < 16; ++r) { p0[r] = __builtin_amdgcn_exp2f(p0[r]); p1[r] = __builtin_amdgcn_exp2f(p1[r]); rs += p0[r] + p1[r]; }
            l_run += rowsel ? rs : 0.f;
            const unsigned km = rowsel ? 0xffffffffu : 0u;
            u32x4 pw[4];
            pw[0] = (u32x4){cvt_pk(p0[0], p0[1]) & km, cvt_pk(p0[2], p0[3]) & km, cvt_pk(p0[4], p0[5]) & km, cvt_pk(p0[6], p0[7]) & km};
            pw[1] = (u32x4){cvt_pk(p0[8], p0[9]) & km, cvt_pk(p0[10], p0[11]) & km, cvt_pk(p0[12], p0[13]) & km, cvt_pk(p0[14], p0[15]) & km};
            pw[2] = (u32x4){cvt_pk(p1[0], p1[1]) & km, cvt_pk(p1[2], p1[3]) & km, cvt_pk(p1[4], p1[5]) & km, cvt_pk(p1[6], p1[7]) & km};
            pw[3] = (u32x4){cvt_pk(p1[8], p1[9]) & km, cvt_pk(p1[10], p1[11]) & km, cvt_pk(p1[12], p1[13]) & km, cvt_pk(p1[14], p1[15]) & km};
            { const LAS unsigned char* vp = lds + AT_V + bo + ((lane >> 4) & 1) * 32 + (lane & 3) * 8 + (4 * hi + ((lane & 15) >> 2)) * 64;
#pragma unroll
              for (int d0 = 0; d0 < 2; ++d0)
#pragma unroll
                  for (int ks = 0; ks < 4; ++ks) { const s16x4 lo = vtr(vp + d0 * 4096 + ks * 1024), hh = vtr(vp + d0 * 4096 + ks * 1024 + 512);
                      const bf16x8 vf = (bf16x8){lo[0], lo[1], lo[2], lo[3], hh[0], hh[1], hh[2], hh[3]};
                      o[d0] = __builtin_amdgcn_mfma_f32_32x32x16_bf16(__builtin_bit_cast(bf16x8, pw[ks]), vf, o[d0], 0, 0, 0); } }
        }
        bo = (bo == 16384) ? 0 : bo + 8192; bo2 = (bo2 == 16384) ? 0 : bo2 + 8192;
    }
    __syncthreads();
#undef KV0
#undef LOADKV
    l_run += swap32(l_run);
    if (hi == 0) wsf[32 + r32] = 1.f / l_run;
    bf16_t* Ow = WSP(bf16_t, W_Y0) + (rowbase + own * 256 + wid * 32) * 1024 + 512 + h * 64;
    LAS bf16_t* stg = (LAS bf16_t*)(lds + AT_OST) + wid * 2048;
#pragma unroll
    for (int r = 0; r < 16; ++r) { const int orow = crow(r, hi); const float rl = wsf[32 + orow];
        stg[orow * 64 + r32] = (bf16_t)(cvt_pk(o[0][r] * rl, 0.f) & 0xffffu); stg[orow * 64 + 32 + r32] = (bf16_t)(cvt_pk(o[1][r] * rl, 0.f) & 0xffffu); }
#pragma unroll
    for (int i = 0; i < 4; ++i) { const int row = i * 8 + (lane >> 3), ch = lane & 7; const u32x4 v = *(const LAS u32x4*)(stg + row * 64 + ch * 8); *(u32x4*)(Ow + (size_t)row * 1024 + ch * 8) = v; }
    __syncthreads();
}
constexpr int CW_MOBAQ = 64;
DEV void p_s5_moba(Frame& F, int mode) {
    if ((mode & 1) && (F.vcu & 3) == 3) { const int it = (F.vcu >> 2) * 8 + F.wave; if (it < 512) s5_item(F, it >> 5, it & 31, F.lds + 65536 + F.wave * 8192); }
    __syncthreads();
    if (!(mode & 2)) return;
    for (int i = F.tid; i < 8 * 2176; i += 512) { const int hh = i / 2176, j = i % 2176; ((LAS float*)(F.lds + AT_LUT))[i] = j < 128 ? 0.f : WSP(float, W_LUT)[hh * 2048 + j - 128]; }
    volatile LAS int* qw = (volatile LAS int*)(F.lds + AT_Q);
    unsigned* ctl = (unsigned*)(F.ws + W_CTL);
    for (;;) {
        __syncthreads();
        if (F.tid == 0) qw[0] = (int)__hip_atomic_fetch_add(ctl + CW_MOBAQ, 1u, __ATOMIC_RELAXED, __HIP_MEMORY_SCOPE_AGENT);
        __syncthreads();
        const int u = __builtin_amdgcn_readfirstlane(qw[0]);
        if (u >= 1024) break;
        const int own = 7 - (u >> 7), bh = u & 127;
        moba_unit(F, bh >> 3, bh & 7, own);
    }
}
constexpr size_t R_RE = W_ROUTE, R_RW = W_ROUTE + 512 * 1024, R_POS = W_ROUTE + 1024 * 1024, R_TOK = W_ROUTE + 2 * MiB, R_WGT = W_ROUTE + 3 * MiB;
constexpr int WT_PITCH = 1028;
constexpr int RW_PITCH = 1032;
constexpr int LN_XT = 32 * RW_PITCH * 2;
constexpr int LN_LG = 147456;
constexpr int LN_HIST = LN_LG + 8 * 528;
static_assert(LN_XT + 8 * 8256 <= LDS_TOK && LN_HIST + 128 <= LDSCTL_OFF, "LN LDS map");
template <int MODE, bool ROUTER, bool XIN_F32, bool OUT_F32, bool GRP = false>
DEV void p_ln(Frame& F, const float* xin32, const bf16_t* xinb, bf16_t* xoutb, float* xout32, const float* gam, const float* bet, const float* wrt, const float* brt) {
    LAS bf16_t* whi = (LAS bf16_t*)F.lds; LAS bf16_t* xt = (LAS bf16_t*)(F.lds + LN_XT) + F.wave * 4128; LAS float* lgs = (LAS float*)(F.lds + LN_LG) + F.wave * 132; LAS int* hist = (LAS int*)(F.lds + LN_HIST);
    const int lane = F.lane, l15 = lane & 15, q4 = lane >> 4;
    if constexpr (ROUTER) {
        for (int i = F.tid; i < 1024 * 32; i += 512) { const int k = i >> 5, e = i & 31; whi[e * RW_PITCH + k] = (bf16_t)(cvt_pk(wrt[i], 0.f) & 0xffffu); }
        if (F.tid < 32) hist[F.tid] = 0;
        __syncthreads();
    }
    if constexpr (GRP) {
        const u32x4* src = (const u32x4*)(WSP(bf16_t, W_IN1) + (size_t)3072 * 1024);
        for (int i = F.tid; i < 16 * 128; i += 512) { const int e = i >> 7, c = i & 127; *(LAS u32x4*)(whi + e * RW_PITCH + c * 8) = src[i]; }
        __syncthreads();
    }
    const bf16_t* MIXB = WSP(bf16_t, W_MIXB); const bf16_t* YS = WSP(bf16_t, W_YS); const int* POS = WSP(int, R_POS);
    int* RE = WSP(int, R_RE); float* RW = WSP(float, R_RW);
    const float alpha = 1.4142135623730951f;
    f32x4 gq[4], bq[4];
#pragma unroll
    for (int j = 0; j < 4; ++j) { gq[j] = *(const f32x4*)(gam + j * 256 + lane * 4); bq[j] = *(const f32x4*)(bet + j * 256 + lane * 4); }
    float bias8[8];
    if constexpr (ROUTER) {
#pragma unroll
        for (int r = 0; r < 8; ++r) bias8[r] = brt[(r >> 2) * 16 + 4 * q4 + (r & 3)]; }
    for (int wgi = F.vcu; wgi < 256; wgi += F.G) {
        const int r0 = wgi * 128 + F.wave * 16;
#pragma unroll 1
        for (int i4 = 0; i4 < 16; i4 += 4) {
            float v[4][16];
#pragma unroll
            for (int u = 0; u < 4; ++u) { const int row = r0 + i4 + u;
                if constexpr (XIN_F32) {
#pragma unroll
                    for (int j = 0; j < 4; ++j) { const f32x4 a = *(const f32x4*)(xin32 + (size_t)row * 1024 + j * 256 + lane * 4); v[u][4 * j] = alpha * a.x; v[u][4 * j + 1] = alpha * a.y; v[u][4 * j + 2] = alpha * a.z; v[u][4 * j + 3] = alpha * a.w; }
                } else {
#pragma unroll
                    for (int j = 0; j < 4; ++j) { const u32x2 a = *(const u32x2*)(xinb + (size_t)row * 1024 + j * 256 + lane * 4); v[u][4 * j] = alpha * bflo(a.x); v[u][4 * j + 1] = alpha * bfhi(a.x); v[u][4 * j + 2] = alpha * bflo(a.y); v[u][4 * j + 3] = alpha * bfhi(a.y); }
                }
                if constexpr (MODE == 0) {
#pragma unroll
                    for (int j = 0; j < 4; ++j) { const u32x2 m = *(const u32x2*)(MIXB + (size_t)row * 1024 + j * 256 + lane * 4); v[u][4 * j] += bflo(m.x); v[u][4 * j + 1] += bfhi(m.x); v[u][4 * j + 2] += bflo(m.y); v[u][4 * j + 3] += bfhi(m.y); }
                } else {
                    const int4 pos4 = *(const int4*)(POS + row * 4);
                    const int ps[4] = {__builtin_amdgcn_readfirstlane(pos4.x), __builtin_amdgcn_readfirstlane(pos4.y), __builtin_amdgcn_readfirstlane(pos4.z), __builtin_amdgcn_readfirstlane(pos4.w)};
#pragma unroll
                    for (int kx = 0; kx < 4; ++kx)
#pragma unroll
                        for (int j = 0; j < 4; ++j) { const u32x2 m = *(const u32x2*)(YS + (size_t)ps[kx] * 1024 + j * 256 + lane * 4); v[u][4 * j] += bflo(m.x); v[u][4 * j + 1] += bfhi(m.x); v[u][4 * j + 2] += bflo(m.y); v[u][4 * j + 3] += bfhi(m.y); }
                }
            }
            float s1[4], s2[4];
#pragma unroll
            for (int u = 0; u < 4; ++u) { s1[u] = 0.f; s2[u] = 0.f;
#pragma unroll
                for (int q = 0; q < 16; ++q) { s1[u] += v[u][q]; s2[u] = fmaf(v[u][q], v[u][q], s2[u]); } }
#pragma unroll
            for (int o = 1; o < 64; o <<= 1) {
#pragma unroll
                for (int u = 0; u < 4; ++u) { s1[u] += __shfl_xor(s1[u], o); s2[u] += __shfl_xor(s2[u], o); } }
#pragma unroll
            for (int u = 0; u < 4; ++u) { const int row = r0 + i4 + u; const float mean = s1[u] * (1.f / 1024.f); const float var = fmaxf(s2[u] * (1.f / 1024.f) - mean * mean, 0.f); const float rstd = 1.f / sqrtf(var + 1e-5f);
#pragma unroll
                for (int j = 0; j < 4; ++j) { const int c = j * 256 + lane * 4; const f32x4 g4 = gq[j], b4 = bq[j];
                    const float y0 = (v[u][4 * j] - mean) * rstd * g4.x + b4.x, y1 = (v[u][4 * j + 1] - mean) * rstd * g4.y + b4.y, y2 = (v[u][4 * j + 2] - mean) * rstd * g4.z + b4.z, y3 = (v[u][4 * j + 3] - mean) * rstd * g4.w + b4.w;
                    if constexpr (OUT_F32) *(f32x4*)(xout32 + (size_t)row * 1024 + c) = (f32x4){y0, y1, y2, y3};
                    else { u32x2 w; w.x = cvt_pk(y0, y1); w.y = cvt_pk(y2, y3); *(u32x2*)(xoutb + (size_t)row * 1024 + c) = w;
                        if constexpr (ROUTER || GRP) { *(LAS u32x2*)(xt + u * RW_PITCH + c) = w; } } } }
            if constexpr (GRP) {
                f32x4 ga = {0.f, 0.f, 0.f, 0.f};
#pragma unroll 8
                for (int ks = 0; ks < 32; ++ks) { const bf16x8 xb = *(const LAS bf16x8*)(xt + (l15 & 3) * RW_PITCH + ks * 32 + q4 * 8), wa = *(const LAS bf16x8*)(whi + l15 * RW_PITCH + ks * 32 + q4 * 8);
                    ga = __builtin_amdgcn_mfma_f32_16x16x32_bf16(wa, xb, ga, 0, 0, 0); }
                if (l15 < 4) *(f32x4*)(WSP(float, W_GR) + (size_t)(r0 + i4 + l15) * 16 + 4 * q4) = ga; }
            if constexpr (ROUTER) {
                f32x4 acc[2] = {{0.f, 0.f, 0.f, 0.f}, {0.f, 0.f, 0.f, 0.f}};
#pragma unroll 8
                for (int ks = 0; ks < 32; ++ks) { const bf16x8 xb = *(const LAS bf16x8*)(xt + (l15 & 3) * RW_PITCH + ks * 32 + q4 * 8);
#pragma unroll
                    for (int mt = 0; mt < 2; ++mt) { const bf16x8 wa = *(const LAS bf16x8*)(whi + (mt * 16 + l15) * RW_PITCH + ks * 32 + q4 * 8); acc[mt] = __builtin_amdgcn_mfma_f32_16x16x32_bf16(wa, xb, acc[mt], 0, 0, 0); } }
                if (l15 < 4) {
#pragma unroll
                    for (int mt = 0; mt < 2; ++mt)
#pragma unroll
                        for (int r = 0; r < 4; ++r) lgs[l15 * 33 + mt * 16 + 4 * q4 + r] = acc[mt][r] + bias8[mt * 4 + r]; }
                if (lane < 4) { float lg[32];
#pragma unroll
                    for (int e = 0; e < 32; ++e) lg[e] = lgs[lane * 33 + e];
                    unsigned taken = 0u; float tv[4]; int ti[4];
#pragma unroll
                    for (int r = 0; r < 4; ++r) { float best = -INFINITY; int bi = 0;
#pragma unroll
                        for (int e = 0; e < 32; ++e) { const bool ok = !((taken >> e) & 1u) && lg[e] > best; best = ok ? lg[e] : best; bi = ok ? e : bi; }
                        taken |= 1u << bi; tv[r] = best; ti[r] = bi; }
                    float ex[4], sm = 0.f;
#pragma unroll
                    for (int r = 0; r < 4; ++r) { ex[r] = __expf(tv[r] - tv[0]); sm += ex[r]; }
                    const float inv = 1.f / sm; const int row = r0 + i4 + lane;
                    *(int4*)(RE + row * 4) = make_int4(ti[0], ti[1], ti[2], ti[3]); *(f32x4*)(RW + row * 4) = (f32x4){ex[0] * inv, ex[1] * inv, ex[2] * inv, ex[3] * inv};
#pragma unroll
                    for (int r = 0; r < 4; ++r) atomicAdd((int*)(hist + ti[r]), 1); }
            }
        }
        if constexpr (ROUTER) { __syncthreads(); if (F.tid < 32) { WSP(int, W_HIST)[wgi * 32 + F.tid] = hist[F.tid]; hist[F.tid] = 0; } __syncthreads(); }
    }
}

DEV void p_sort(Frame& F) {
    LAS int* Ls = (LAS int*)F.lds; const int tid = F.tid;
    const int* HIST = WSP(int, W_HIST); int* SORT = WSP(int, W_SORT);
    const int* RE = WSP(int, R_RE); const float* RW = WSP(float, R_RW); int* POS = WSP(int, R_POS); int* TOK = WSP(int, R_TOK); float* WGT = WSP(float, R_WGT);
    for (int wgi = F.vcu; wgi < 256; wgi += F.G) {
        { const int e = tid & 31, part = tid >> 5; int tot = 0, pre = 0;
          for (int w = part * 16; w < part * 16 + 16; ++w) { const int hh = HIST[w * 32 + e]; tot += hh; pre += (w < wgi) ? hh : 0; }
          Ls[part * 32 + e] = tot; Ls[512 + part * 32 + e] = pre; }
        Ls[2048 + tid] = RE[wgi * 512 + tid];
        __syncthreads();
        if (tid < 32) { int tot = 0, pre = 0; for (int p = 0; p < 16; ++p) { tot += Ls[p * 32 + tid]; pre += Ls[512 + p * 32 + tid]; } Ls[1200 + tid] = tot; Ls[1300 + tid] = pre; }
        __syncthreads();
        if (tid == 0) { int a = 0; for (int e = 0; e < 32; ++e) { Ls[1024 + e] = a; a += (Ls[1200 + e] + 255) / 256 * 256; } Ls[1056] = a; }
        __syncthreads();
        if (tid < 32) { int c = Ls[1024 + tid] + Ls[1300 + tid]; for (int i = 0; i < 512; ++i) if (Ls[2048 + i] == tid) { Ls[2560 + i] = c; ++c; } }
        __syncthreads();
        { const int pos = Ls[2560 + tid]; TOK[pos] = wgi * 128 + (tid >> 2); WGT[pos] = RW[wgi * 512 + tid]; POS[wgi * 512 + tid] = pos; }
        { const bf16_t* XBBp = WSP(bf16_t, W_XBB); unsigned char* XS8 = WSP(unsigned char, W_X8);
          for (int rg = 0; rg < 16; rg += 4) {
              u32x4 a[4], b2[4];
#pragma unroll
              for (int u = 0; u < 4; ++u) { const int r = F.wave * 16 + rg + u; const u32x4* src = (const u32x4*)(XBBp + (size_t)(wgi * 128 + r) * 1024 + F.lane * 16); a[u] = src[0]; b2[u] = src[1]; }
#pragma unroll
              for (int u = 0; u < 4; ++u) { const int r = F.wave * 16 + rg + u;
                  u32x4 o; o.x = pk4_fp8(bflo(a[u].x) * 16.f, bfhi(a[u].x) * 16.f, bflo(a[u].y) * 16.f, bfhi(a[u].y) * 16.f); o.y = pk4_fp8(bflo(a[u].z) * 16.f, bfhi(a[u].z) * 16.f, bflo(a[u].w) * 16.f, bfhi(a[u].w) * 16.f);
                  o.z = pk4_fp8(bflo(b2[u].x) * 16.f, bfhi(b2[u].x) * 16.f, bflo(b2[u].y) * 16.f, bfhi(b2[u].y) * 16.f); o.w = pk4_fp8(bflo(b2[u].z) * 16.f, bfhi(b2[u].z) * 16.f, bflo(b2[u].w) * 16.f, bfhi(b2[u].w) * 16.f);
#pragma unroll
                  for (int kx = 0; kx < 4; ++kx) { const int pos = Ls[2560 + r * 4 + kx]; *(u32x4*)(XS8 + (size_t)pos * 1024 + F.lane * 16) = o; } } }
          if (wgi < 32) { const int e = wgi; for (int r = Ls[1024 + e] + Ls[1200 + e] + F.wave; r < Ls[1024 + e + 1]; r += 8) *(u32x4*)(XS8 + (size_t)r * 1024 + F.lane * 16) = (u32x4){0u, 0u, 0u, 0u}; } }
        if (wgi < 32) { const int e = wgi; for (int r = Ls[1024 + e] + Ls[1200 + e] + tid; r < Ls[1024 + e + 1]; r += 512) { TOK[r] = 0; WGT[r] = 0.f; } }
        if (wgi == 0) { if (tid < 33) SORT[tid] = Ls[1024 + tid]; if (tid == 0) SORT[33] = Ls[1056] / 256;
            for (int pm = tid; pm < PMAX / 256; pm += 512) { int e = 0; for (int j = 1; j < 32; ++j) if (pm * 256 >= Ls[1024 + j]) e = j; SORT[64 + pm] = e; } }
        __syncthreads();
    }
}

DEV void p_gr(Frame& F) {
    const int gw = F.vcu * 8 + F.wave, NGW = F.G * 8, lane = F.lane, q4 = lane >> 4; const bf16_t* XB = WSP(bf16_t, W_XB); const bf16_t* Wg = WSP(bf16_t, W_IN1) + (size_t)3072 * 1024; float* GR = WSP(float, W_GR);
    for (int it = gw; it < T / 16; it += NGW) { f32x4 acc = {0.f, 0.f, 0.f, 0.f};
        const bf16_t* ap = XB + (size_t)(it * 16 + (lane & 15)) * 1024 + q4 * 8; const bf16_t* bp = Wg + (size_t)(lane & 15) * 1024 + q4 * 8;
        bf16x8 a[32], bb[32];
#pragma unroll
        for (int ks = 0; ks < 32; ++ks) { a[ks] = *(const bf16x8*)(ap + ks * 32); bb[ks] = *(const bf16x8*)(bp + ks * 32); }
#pragma unroll
        for (int ks = 0; ks < 32; ++ks) acc = __builtin_amdgcn_mfma_f32_16x16x32_bf16(a[ks], bb[ks], acc, 0, 0, 0);
#pragma unroll
        for (int r = 0; r < 4; ++r) GR[(size_t)(it * 16 + 4 * q4 + r) * 16 + (lane & 15)] = acc[r]; }
}

constexpr int GP = 264, GP2 = 144;
constexpr int GB_QIN = 0, GB_KST = 16896, GB_ATT = 35328, GB_DEC = 44544, GB_VT = 45056, GB_SIZE = 81920;
constexpr size_t W_GB = W_YS;
static_assert((size_t)2048 * GB_SIZE <= (size_t)PMAX * 2048, "blob region");
constexpr int GA_GRS = 0, GA_GT = 4096, GA_BL = 8192  , GA_QIN = GA_BL + GB_QIN, GA_KST = GA_BL + GB_KST, GA_ATT = GA_BL + GB_ATT, GA_DEC = GA_BL + GB_DEC, GA_KIN = GA_BL + 45056  , GA_VT = GA_KIN + 17408, GA_END = GA_VT + 36864;
DEV float logsigm_fast(float z) { const float e = __builtin_amdgcn_exp2f(-1.4426950408889634f * fabsf(z)); return fminf(z, 0.f) - 0.6931471805599453f * __builtin_amdgcn_logf(1.f + e); }
struct GlaRaw { unsigned q[16], k[16], v[32]; float g0, g1; };
DEV void p_gla_prep(Frame& F) {
    LAS unsigned char* lds = F.lds; const int tid = F.tid, lane = F.lane, wid = F.wave, q4 = lane >> 4, l15 = lane & 15;
    const bf16_t* H1 = WSP(bf16_t, W_HB); const float* GR = WSP(float, W_GR); unsigned char* GB = F.ws + W_GB;
    const float* wg2 = F.in[15]; const float* bg = F.in[16];
    for (int i = tid; i < 64 * GP2 / 4; i += 512) ((LAS unsigned*)(lds + GA_ATT))[i] = 0u;
    const int dk = tid & 127, tg = tid >> 7;
    const int dvl = tid & 255, th2 = tid >> 8;
    for (int wg = F.vcu; wg < 256; wg += F.G) {
        const int b = wg >> 4, h = (wg >> 2) & 3, n0 = (wg & 3) * 8;
        float w2[16];
#pragma unroll
        for (int r = 0; r < 16; ++r) w2[r] = wg2[r * 512 + h * 128 + dk];
        const float bgv = bg[h * 128 + dk];
#define GLA_LOAD(R, n_) do { const size_t rb_ = (size_t)b * 2048 + (n_) * 64; \
        _Pragma("unroll") for (int i = 0; i < 16; ++i) { const size_t ro = (rb_ + 16 * tg + i) * 3072; R.q[i] = H1[ro + h * 128 + dk]; R.k[i] = H1[ro + 512 + h * 128 + dk]; } \
        _Pragma("unroll") for (int i = 0; i < 32; ++i) R.v[i] = H1[(rb_ + 32 * th2 + i) * 3072 + 1024 + h * 256 + dvl]; \
        R.g0 = GR[rb_ * 16 + tid]; R.g1 = GR[rb_ * 16 + 512 + tid]; } while (0)
        GlaRaw cur, nxt; GLA_LOAD(cur, n0); nxt = cur;
#pragma unroll 1
      for (int sub = 0; sub < 8; ++sub) { const int n = n0 + sub;
        if (sub + 1 < 8) GLA_LOAD(nxt, n + 1);
        ((LAS float*)(lds + GA_GRS))[tid] = cur.g0; ((LAS float*)(lds + GA_GRS))[512 + tid] = cur.g1;
        __syncthreads();
        float cs[16]; float run = 0.f;
#pragma unroll
        for (int i = 0; i < 16; ++i) { const LAS float* gr = (const LAS float*)(lds + GA_GRS) + (16 * tg + i) * 16; float z = bgv;
#pragma unroll
            for (int r = 0; r < 16; ++r) z = fmaf(gr[r], w2[r], z);
            run += logsigm_fast(z) * (1.f / 16.f); cs[i] = run; }
        ((LAS float*)(lds + GA_GT))[tg * 128 + dk] = run;
        __syncthreads();
        float off = 0.f, btot = 0.f;
#pragma unroll
        for (int g2 = 0; g2 < 4; ++g2) { const float gtv = ((LAS float*)(lds + GA_GT))[g2 * 128 + dk]; btot += gtv; off += (g2 < tg) ? gtv : 0.f; }
        if (tg == 0) ((LAS float*)(lds + GA_DEC))[dk] = __expf(btot);
        { unsigned kst[8];
#pragma unroll
          for (int i = 0; i < 16; i += 2) { float kk[2];
#pragma unroll
              for (int u = 0; u < 2; ++u) { const int t = 16 * tg + i + u; const float bc = cs[i + u] + off; const float qv = bflo(cur.q[i + u]), kv = bflo(cur.k[i + u]);
                  *(LAS bf16_t*)(lds + GA_QIN + t * GP + dk * 2) = (bf16_t)(cvt_pk(qv * __expf(bc), 0.f) & 0xffffu);
                  *(LAS bf16_t*)(lds + GA_KIN + t * 272 + dk * 2) = (bf16_t)(cvt_pk(kv * __expf(-bc), 0.f) & 0xffffu);
                  kk[u] = kv * __expf(btot - bc); }
              kst[i >> 1] = cvt_pk(kk[0], kk[1]); }
          *(LAS u32x4*)(lds + GA_KST + dk * GP2 + tg * 32) = (u32x4){kst[0], kst[1], kst[2], kst[3]};
          *(LAS u32x4*)(lds + GA_KST + dk * GP2 + tg * 32 + 16) = (u32x4){kst[4], kst[5], kst[6], kst[7]}; }
#pragma unroll
        for (int i = 0; i < 32; i += 8) *(LAS u32x4*)(lds + GA_VT + dvl * GP2 + (32 * th2 + i) * 2) = (u32x4){cur.v[i] | (cur.v[i + 1] << 16), cur.v[i + 2] | (cur.v[i + 3] << 16), cur.v[i + 4] | (cur.v[i + 5] << 16), cur.v[i + 6] | (cur.v[i + 7] << 16)};
        __syncthreads();
#pragma unroll
        for (int rep = 0; rep < 2; ++rep) { const int ti = wid + 8 * rep; if (ti < 10) {
            int jt, it2; if (ti < 4) { jt = 0; it2 = ti; } else if (ti < 7) { jt = 1; it2 = ti - 3; } else if (ti < 9) { jt = 2; it2 = ti - 5; } else { jt = 3; it2 = 3; }
            f32x4 a4 = {0.f, 0.f, 0.f, 0.f};
#pragma unroll
            for (int ks = 0; ks < 4; ++ks) { const bf16x8 kf = *(const LAS bf16x8*)(lds + GA_KIN + (16 * jt + l15) * 272 + ks * 64 + q4 * 16); const u32x2 q0_ = *(const LAS u32x2*)(lds + GA_QIN + (16 * it2 + l15) * GP + ks * 64 + q4 * 16), q1_ = *(const LAS u32x2*)(lds + GA_QIN + (16 * it2 + l15) * GP + ks * 64 + q4 * 16 + 8); const bf16x8 qf = __builtin_bit_cast(bf16x8, (u32x4){q0_.x, q0_.y, q1_.x, q1_.y});
                a4 = __builtin_amdgcn_mfma_f32_16x16x32_bf16(kf, qf, a4, 0, 0, 0); }
            const int i_ = 16 * it2 + l15, j0 = 16 * jt + 4 * q4;
            u32x2 w; w.x = cvt_pk(j0 <= i_ ? a4[0] : 0.f, j0 + 1 <= i_ ? a4[1] : 0.f); w.y = cvt_pk(j0 + 2 <= i_ ? a4[2] : 0.f, j0 + 3 <= i_ ? a4[3] : 0.f);
            *(LAS u32x2*)(lds + GA_ATT + i_ * GP2 + j0 * 2) = w; } }
        __syncthreads();
        unsigned char* blob = GB + (size_t)((b * 32 + n) * 4 + h) * GB_SIZE;
        for (int c = tid; c < 45056 / 16; c += 512) *(u32x4*)(blob + c * 16) = *(const LAS u32x4*)(lds + GA_BL + c * 16);
        for (int c = tid; c < 36864 / 16; c += 512) *(u32x4*)(blob + GB_VT + c * 16) = *(const LAS u32x4*)(lds + GA_VT + c * 16);
        cur = nxt;
      }
#undef GLA_LOAD
    }
}
constexpr int GS_BUF = 54272;
constexpr int GS_VT = 0, GS_QIN = 9216, GS_KST = GS_QIN + 16896, GS_ATT = GS_KST + 18432, GS_DEC = GS_ATT + 9216;
static_assert(3 * GS_BUF <= LDSCTL_OFF, "GLA ring");
DEV void gla_scan_item(Frame& F, int b, int h, int c4) {
    LAS unsigned char* lds = F.lds; const int lane = F.lane, wid = F.wave, q4 = lane >> 4, l15 = lane & 15;
    bf16_t* GO = WSP(bf16_t, W_GLAO); float* SS = WSP(float, W_SS); const unsigned char* GB = F.ws + W_GB;
    const int c16 = wid & 3, th = wid >> 2;
    f32x4 sacc[8];
#pragma unroll
    for (int m = 0; m < 8; ++m) sacc[m] = (f32x4){0.f, 0.f, 0.f, 0.f};
    const size_t rb = (size_t)b * 2048;
    float sqv[2][4]; unsigned ov[2][4];
#pragma unroll
    for (int mt = 0; mt < 2; ++mt)
#pragma unroll
        for (int r = 0; r < 4; ++r) { sqv[mt][r] = 0.f; ov[mt][r] = 0u; }
    const int npc = (wid < 5) ? 7 : 6;
#define GS_ISSUE(n_, bo_) do { const unsigned char* blob_ = GB + (size_t)((b * 32 + (n_)) * 4 + h) * GB_SIZE; \
        for (int p_ = wid; p_ < 53; p_ += 8) { const int so_ = p_ < 9 ? GB_VT + c4 * 9216 + p_ * 1024 : (p_ - 9) * 1024; \
            __builtin_amdgcn_global_load_lds((const unsigned*)(blob_ + so_ + lane * 16), (LAS unsigned*)(lds + (bo_) + p_ * 1024), 16, 0, 0); } } while (0)
    GS_ISSUE(0, 0); GS_ISSUE(1, GS_BUF);
    int bo = 0, bo2 = 2 * GS_BUF;
#pragma unroll 1
    for (int n = 0; n < 32; ++n) { const int t0 = n * 64;
        if (n + 1 < 32) { if (npc == 7) asm volatile("s_waitcnt vmcnt(7) lgkmcnt(0)\n\ts_barrier" ::: "memory"); else asm volatile("s_waitcnt vmcnt(6) lgkmcnt(0)\n\ts_barrier" ::: "memory"); } else asm volatile("s_waitcnt vmcnt(0) lgkmcnt(0)\n\ts_barrier" ::: "memory");
        if (n > 0) {
#pragma unroll
            for (int mt = 0; mt < 2; ++mt)
#pragma unroll
                for (int r = 0; r < 4; ++r) { const size_t trow = rb + (t0 - 64) + 32 * th + 16 * mt + 4 * q4 + r; GO[trow * 1024 + h * 256 + c4 * 64 + c16 * 16 + l15] = (bf16_t)ov[mt][r];
                    SS[(trow * 4 + h) * 16 + c4 * 4 + c16] = sqv[mt][r]; } }
        if (n + 2 < 32) GS_ISSUE(n + 2, bo2);
        const LAS unsigned char* bu = lds + bo;
        bf16x8 vf[2];
#pragma unroll
        for (int ks = 0; ks < 2; ++ks) vf[ks] = *(const LAS bf16x8*)(bu + GS_VT + (c16 * 16 + l15) * GP2 + ks * 64 + q4 * 16);
        bf16x8 sf[4];
#pragma unroll
        for (int ks = 0; ks < 4; ++ks) { const u32x4 w = {cvt_pk(sacc[2 * ks][0], sacc[2 * ks][1]), cvt_pk(sacc[2 * ks][2], sacc[2 * ks][3]), cvt_pk(sacc[2 * ks + 1][0], sacc[2 * ks + 1][1]), cvt_pk(sacc[2 * ks + 1][2], sacc[2 * ks + 1][3])}; sf[ks] = __builtin_bit_cast(bf16x8, w); }
#pragma unroll
        for (int mt = 0; mt < 2; ++mt) { const int i_ = 32 * th + 16 * mt + l15; f32x4 oa = {0.f, 0.f, 0.f, 0.f};
#pragma unroll
            for (int ks = 0; ks < 2; ++ks) { if (ks == 1 && th == 0) continue; const bf16x8 af = *(const LAS bf16x8*)(bu + GS_ATT + i_ * GP2 + ks * 64 + q4 * 16); oa = __builtin_amdgcn_mfma_f32_16x16x32_bf16(af, vf[ks], oa, 0, 0, 0); }
#pragma unroll
            for (int ks = 0; ks < 4; ++ks) { const u32x2 lo = *(const LAS u32x2*)(bu + GS_QIN + i_ * GP + (32 * ks + 4 * q4) * 2), hi2 = *(const LAS u32x2*)(bu + GS_QIN + i_ * GP + (32 * ks + 16 + 4 * q4) * 2);
                const u32x4 w = {lo.x, lo.y, hi2.x, hi2.y}; oa = __builtin_amdgcn_mfma_f32_16x16x32_bf16(__builtin_bit_cast(bf16x8, w), sf[ks], oa, 0, 0, 0); }
#pragma unroll
            for (int r = 0; r < 4; ++r) { ov[mt][r] = cvt_pk(oa[r], 0.f) & 0xffffu; float sq = oa[r] * oa[r]; sq += __shfl_xor(sq, 1); sq += __shfl_xor(sq, 2); sq += __shfl_xor(sq, 4); sq += __shfl_xor(sq, 8); sqv[mt][r] = sq; } }
#pragma unroll
        for (int md = 0; md < 8; ++md) { const f32x4 dc = *(const LAS f32x4*)(bu + GS_DEC + (16 * md + 4 * q4) * 4); sacc[md] = sacc[md] * dc;
#pragma unroll
            for (int ks = 0; ks < 2; ++ks) { const bf16x8 kf = *(const LAS bf16x8*)(bu + GS_KST + (16 * md + l15) * GP2 + ks * 64 + q4 * 16); sacc[md] = __builtin_amdgcn_mfma_f32_16x16x32_bf16(kf, vf[ks], sacc[md], 0, 0, 0); } }
        bo = (bo == 2 * GS_BUF) ? 0 : bo + GS_BUF; bo2 = (bo2 == 2 * GS_BUF) ? 0 : bo2 + GS_BUF;
    }
#undef GS_ISSUE
#pragma unroll
    for (int mt = 0; mt < 2; ++mt)
#pragma unroll
        for (int r = 0; r < 4; ++r) { const size_t trow = rb + 31 * 64 + 32 * th + 16 * mt + 4 * q4 + r; GO[trow * 1024 + h * 256 + c4 * 64 + c16 * 16 + l15] = (bf16_t)ov[mt][r]; SS[(trow * 4 + h) * 16 + c4 * 4 + c16] = sqv[mt][r]; }
    asm volatile("s_waitcnt vmcnt(0)" ::: "memory");
    __syncthreads();
}
DEV void p_gla_scan(Frame& F) { for (int v = F.vcu; v < 256; v += F.G) gla_scan_item(F, v >> 4, (v >> 2) & 3, v & 3); }

DEV void p_gla_norm(Frame& F) {
    const int gw = F.vcu * 8 + F.wave, NGW = F.G * 8, lane = F.lane; const bf16_t* GO = WSP(bf16_t, W_GLAO); const float* SS = WSP(float, W_SS); const bf16_t* H1 = WSP(bf16_t, W_HB); bf16_t* Y0 = WSP(bf16_t, W_Y0);
    const f32x4 nw = *(const f32x4*)(F.in[17] + lane * 4);
    for (int row = gw; row < T; row += NGW) {
#pragma unroll
        for (int h = 0; h < 4; ++h) { const float* sp = SS + ((size_t)row * 4 + h) * 16; const f32x4 a = *(const f32x4*)sp, b2 = *(const f32x4*)(sp + 4), c = *(const f32x4*)(sp + 8), d = *(const f32x4*)(sp + 12);
            const float sq = (a.x + a.y + a.z + a.w) + (b2.x + b2.y + b2.z + b2.w) + (c.x + c.y + c.z + c.w) + (d.x + d.y + d.z + d.w); const float r = 1.f / sqrtf(sq * (1.f / 256.f) + 1e-5f);
            const u32x2 o = *(const u32x2*)(GO + (size_t)row * 1024 + h * 256 + lane * 4); const u32x2 g = *(const u32x2*)(H1 + (size_t)row * 3072 + 2048 + h * 256 + lane * 4);
            const float g0 = bflo(g.x), g1 = bfhi(g.x), g2 = bflo(g.y), g3 = bfhi(g.y);
            u32x2 w; w.x = cvt_pk(bflo(o.x) * r * nw.x * g0 * fast_sigm(g0), bfhi(o.x) * r * nw.y * g1 * fast_sigm(g1)); w.y = cvt_pk(bflo(o.y) * r * nw.z * g2 * fast_sigm(g2), bfhi(o.y) * r * nw.w * g3 * fast_sigm(g3));
            *(u32x2*)(Y0 + (size_t)row * 1024 + h * 256 + lane * 4) = w; } }
}
struct FStoreScale { bf16_t* O; int ldc, c_lo, c_hi; float sc; static constexpr int NSIDE = 0;
    DEV const void* side(const Unit&, int) const { return nullptr; }
    DEV NoPre pre(const Unit&, int, const LAS float*) const { return NoPre{}; }
    DEV void operator()(const Unit&, int row, int col, f32x4 v0, f32x4 v1, NoPre, const LAS float*) const { const float s = (col >= c_lo && col < c_hi) ? sc : 1.f;
        const u32x4 w = {cvt_pk(v0[0] * s, v0[1] * s), cvt_pk(v0[2] * s, v0[3] * s), cvt_pk(v1[0] * s, v1[1] * s), cvt_pk(v1[2] * s, v1[3] * s)}; *(u32x4*)(O + (size_t)row * ldc + col) = w; } };
struct Pre8 { f32x4 b0, b1; };
struct FGlu { const bf16_t* Y; bf16_t* O; const float* b; static constexpr int NSIDE = 0;
    DEV const void* side(const Unit&, int) const { return nullptr; }
    DEV Pre8 pre(const Unit&, int col, const LAS float*) const { return Pre8{*(const f32x4*)(b + col), *(const f32x4*)(b + col + 4)}; }
    DEV void operator()(const Unit&, int row, int col, f32x4 v0, f32x4 v1, const Pre8& pp, const LAS float*) const { const u32x4 y = *(const u32x4*)(Y + (size_t)row * 512 + col); const f32x4 b0 = pp.b0, b1 = pp.b1;
        const u32x4 w = {cvt_pk(bflo(y.x) * fast_sigm(v0[0] + b0.x), bfhi(y.x) * fast_sigm(v0[1] + b0.y)), cvt_pk(bflo(y.y) * fast_sigm(v0[2] + b0.z), bfhi(y.y) * fast_sigm(v0[3] + b0.w)),
                         cvt_pk(bflo(y.z) * fast_sigm(v1[0] + b1.x), bfhi(y.z) * fast_sigm(v1[1] + b1.y)), cvt_pk(bflo(y.w) * fast_sigm(v1[2] + b1.z), bfhi(y.w) * fast_sigm(v1[3] + b1.w))};
        *(u32x4*)(O + (size_t)row * 1024 + col) = w; } };
constexpr float ACT_SCALE = 4.f, WDN_SCALE = 128.f;
DEV float swiglu1s(float g, float u) { g = fminf(g, 7.f); u = __builtin_amdgcn_fmed3f(u, -7.f, 7.f); const float r = __builtin_amdgcn_rcpf(1.f + __builtin_amdgcn_exp2f(-1.702f * 1.4426950408889634f * g)); return (g * r) * fmaf(u, ACT_SCALE, ACT_SCALE); }
struct FSwiglu { unsigned char* ACT; const float* bgu; float sc; static constexpr int NSIDE = 1;
    DEV const void* side(const Unit& u, int) const { return bgu + (size_t)u.e * 2048 + u.pn * BM; }
    DEV Pre8 pre(const Unit&, int, const LAS float* sb) const { return Pre8{*(const LAS f32x4*)sb, *(const LAS f32x4*)(sb + 4)}; }
    DEV void operator()(const Unit& u, int row, int col, f32x4 v0, f32x4 v1, const Pre8& pp, const LAS float*) const { const f32x4 b0 = pp.b0, b1 = pp.b1;
        const unsigned w = pk4_fp8(swiglu1s(fmaf(v0[0], sc, b0.x), fmaf(v0[1], sc, b0.y)), swiglu1s(fmaf(v0[2], sc, b0.z), fmaf(v0[3], sc, b0.w)), swiglu1s(fmaf(v1[0], sc, b1.x), fmaf(v1[1], sc, b1.y)), swiglu1s(fmaf(v1[2], sc, b1.z), fmaf(v1[3], sc, b1.w)));
        *(unsigned*)(ACT + (size_t)row * 1024 + (col >> 1)) = w; } };
struct FDown { bf16_t* YS; const float* bd; const float* wgt; float sc; static constexpr int NSIDE = 2;
    DEV const void* side(const Unit& u, int k) const { return k == 0 ? (const void*)(bd + (size_t)u.e * 1024 + u.pn * BM) : (const void*)(wgt + (size_t)u.pm * BM); }
    DEV Pre8 pre(const Unit&, int, const LAS float* sb) const { return Pre8{*(const LAS f32x4*)sb, *(const LAS f32x4*)(sb + 4)}; }
    DEV void operator()(const Unit& u, int row, int col, f32x4 v0, f32x4 v1, const Pre8& pp, const LAS float* sr) const { const f32x4 b0 = pp.b0, b1 = pp.b1; const float wt = *sr, ws_ = sc * wt;
        const u32x4 w = {cvt_pk(fmaf(v0[0], ws_, b0.x * wt), fmaf(v0[1], ws_, b0.y * wt)), cvt_pk(fmaf(v0[2], ws_, b0.z * wt), fmaf(v0[3], ws_, b0.w * wt)), cvt_pk(fmaf(v1[0], ws_, b1.x * wt), fmaf(v1[1], ws_, b1.y * wt)), cvt_pk(fmaf(v1[2], ws_, b1.z * wt), fmaf(v1[3], ws_, b1.w * wt))};
        *(u32x4*)(YS + (size_t)row * 1024 + col) = w; } };

constexpr int NPH = 21;
constexpr float X8_SCALE = 16.f, WGU_SCALE = 64.f;
constexpr float QSCALE0 = 0.125f * 1.4426950408889634f, QSCALE1 = 0.08838834764831845f;


#define NOINL __device__ __forceinline__
struct PA { const float* const* in; unsigned char* ws; float* out; int wave; };
#define MKFRAME extern __shared__ __attribute__((aligned(16))) unsigned char lds_[]; Frame F; F.lds = (LAS unsigned char*)lds_; F.wave = pa.wave; F.lane = (int)__builtin_amdgcn_mbcnt_hi(~0u, __builtin_amdgcn_mbcnt_lo(~0u, 0u)); F.tid = F.wave * 64 + F.lane; \
    F.G = gridDim.x; { const int bx = blockIdx.x; F.vcu = (F.G % 8 == 0) ? (bx % 8) * (F.G / 8) + bx / 8 : bx; } F.in = pa.in; F.ws = pa.ws;
template <class Fn> DEV void dense_gemm(Frame& F, const bf16_t* A, const bf16_t* Bt, int nM, int nN, int K, const Fn& fn) {
    Gemm g; g.A = A; g.Bt = Bt; g.rowmap = nullptr; g.bstride = 0; g.KB = K * 2; g.wave = F.wave;
    StaticOrder S; S.init(nM, nN, F.G, (int)blockIdx.x, nullptr);
    EpiRow8<Fn> E{fn};
    gemm_phase<false, false>(F.lds, g, S, E);
}
NOINL void ph_prologue(PA pa) { MKFRAME p0_prologue(F); }
NOINL void ph_in0(PA pa) { MKFRAME dense_gemm(F, WSP(bf16_t, W_XB), WSP(bf16_t, W_IN0), T / 256, 8, 1024, FStoreScale{WSP(bf16_t, W_HB), 2048, 512, 1024, QSCALE0}); }
NOINL void ph_kmean(PA pa) { MKFRAME p_kmean(F); }
NOINL void ph_s5moba(PA pa, int mode) { MKFRAME p_s5_moba(F, mode); }
NOINL void ph_glu(PA pa) { MKFRAME dense_gemm(F, WSP(bf16_t, W_YS5), WSP(bf16_t, W_GLU), T / 256, 2, 512, FGlu{WSP(bf16_t, W_YS5), WSP(bf16_t, W_Y0), F.in[11]}); }
NOINL void ph_out(PA pa, int layer) { MKFRAME dense_gemm(F, WSP(bf16_t, W_Y0), layer ? WSP(bf16_t, W_OUT1) : WSP(bf16_t, W_OUT0), T / 256, 4, 1024, FStoreScale{WSP(bf16_t, W_MIXB), 1024, 0, 0, 1.f}); }
NOINL void ph_in1(PA pa) { MKFRAME dense_gemm(F, WSP(bf16_t, W_XB), WSP(bf16_t, W_IN1), T / 256, 12, 1024, FStoreScale{WSP(bf16_t, W_HB), 3072, 0, 512, QSCALE1}); p_gr(F); }
NOINL void ph_glaprep(PA pa) { MKFRAME p_gla_prep(F); }
NOINL void ph_glascan(PA pa) { MKFRAME p_gla_scan(F); }
NOINL void ph_glanorm(PA pa) { MKFRAME p_gla_norm(F); }
NOINL void ph_lnrouter(PA pa, int layer) { MKFRAME
    if (layer == 0) p_ln<0, true, false, false>(F, nullptr, WSP(bf16_t, W_XB), WSP(bf16_t, W_XBB), nullptr, F.in[19], F.in[20], F.in[23], F.in[24]);
    else p_ln<0, true, false, false>(F, nullptr, WSP(bf16_t, W_XB), WSP(bf16_t, W_XBB), nullptr, F.in[19] + 1024, F.in[20] + 1024, F.in[23] + (size_t)1024 * 32, F.in[24] + 32); }
NOINL void ph_sort(PA pa) { MKFRAME p_sort(F); }
NOINL void ph_gateup(PA pa, int layer) { MKFRAME const int* SORT = WSP(int, W_SORT);
    Gemm g; g.A = WSP(unsigned char, W_X8); g.Bt = WSP(unsigned char, W_GU) + (size_t)layer * 32 * 2048 * 1024; g.rowmap = nullptr; g.bstride = (size_t)2048 * 1024; g.KB = 1024; g.wave = F.wave;
    StaticOrder S; S.init(__builtin_amdgcn_readfirstlane(SORT[33]), 8, F.G, (int)blockIdx.x, (const LAS int*)(F.lds + LDS_ELIST)); fill_elist(F.lds, S, SORT + 64, F.tid);
    EpiRow8<FSwiglu> E{FSwiglu{WSP(unsigned char, W_ACT), F.in[26] + (size_t)layer * 32 * 2048, 1.f / (X8_SCALE * WGU_SCALE)}};
    gemm_phase<false, true>(F.lds, g, S, E); }
NOINL void ph_down(PA pa, int layer) { MKFRAME const int* SORT = WSP(int, W_SORT);
    Gemm g; g.A = WSP(unsigned char, W_ACT); g.Bt = WSP(unsigned char, W_DN) + (size_t)layer * 32 * 1024 * 1024; g.rowmap = nullptr; g.bstride = (size_t)1024 * 1024; g.KB = 1024; g.wave = F.wave;
    StaticOrder S; S.init(__builtin_amdgcn_readfirstlane(SORT[33]), 4, F.G, (int)blockIdx.x, (const LAS int*)(F.lds + LDS_ELIST)); fill_elist(F.lds, S, SORT + 64, F.tid);
    EpiRow8<FDown> E{FDown{WSP(bf16_t, W_YS), F.in[28] + (size_t)layer * 32 * 1024, WSP(float, R_WGT), 1.f / (ACT_SCALE * WDN_SCALE)}};
    gemm_phase<false, true>(F.lds, g, S, E); }
NOINL void ph_combine(PA pa, int layer) { MKFRAME
    if (layer == 0) p_ln<1, false, false, false, false>(F, nullptr, WSP(bf16_t, W_XBB), WSP(bf16_t, W_XB), nullptr, F.in[21], F.in[22], nullptr, nullptr);
    else p_ln<1, false, false, true>(F, nullptr, WSP(bf16_t, W_XBB), nullptr, pa.out, F.in[21] + 1024, F.in[22] + 1024, nullptr, nullptr); }

__global__ void __launch_bounds__(512, 2) mega(Args args) {
    extern __shared__ __attribute__((aligned(16))) unsigned char lds_[];
    LAS unsigned char* lds = (LAS unsigned char*)lds_;
    unsigned* ctl = (unsigned*)(args.ws + W_CTL);
    for (int u = threadIdx.x; u < (LDS_BYTES - LDSCTL_OFF) / 4; u += 512) ((LAS unsigned*)(lds + LDSCTL_OFF))[u] = 0u;
    __syncthreads();
    const int lo = args.ph_lo, hi = args.ph_hi;
    PA pa; pa.in = args.in; pa.ws = args.ws; pa.out = args.out; pa.wave = __builtin_amdgcn_readfirstlane(threadIdx.x >> 6);
    XcdBarrier bar; bar.bar = ctl + CW_BAR; bar.x = 0; bar.st = nullptr; bar.wave = pa.wave;
    if (hi - lo > 1) bar = xcd_barrier_post(ctl + CW_BAR, (volatile LAS unsigned*)(lds + MISC_OFF) + 8, pa.wave);
#define IN(k) (lo <= (k) && (k) < hi)
#ifdef DIAG_LO
    volatile LAS unsigned long long* tsl = (volatile LAS unsigned long long*)(lds + MISC_OFF + 128);
    if (blockIdx.x == 0 && threadIdx.x == 0) tsl[0] = __builtin_amdgcn_s_memrealtime();
#define STAMP(k) do { if (blockIdx.x == 0 && threadIdx.x == 0) tsl[(k) + 1] = __builtin_amdgcn_s_memrealtime(); } while (0)
#else
#define STAMP(k) do { } while (0)
#endif
#define SEAM(k) do { if (IN(k) && IN((k) + 1)) xcd_barrier(bar); STAMP(k); } while (0)
#ifndef REP_PHASE
#define REP_PHASE -1
#define REP_N 0
#endif
#define RUN(k, call) do { if (IN(k)) { call; if ((k) == REP_PHASE) { xcd_barrier(bar); call; } } } while (0)
    RUN(0, ph_prologue(pa)); SEAM(0);
    RUN(1, ph_in0(pa)); SEAM(1);
    RUN(2, ph_kmean(pa)); SEAM(2);
    if (IN(3)) { ph_s5moba(pa, 1); if (REP_PHASE == 30) ph_s5moba(pa, 1); ph_s5moba(pa, 2); if (REP_PHASE == 31) ph_s5moba(pa, 2); } SEAM(3);
    RUN(4, ph_glu(pa)); SEAM(4);
    RUN(5, ph_out(pa, 0)); SEAM(5);
    if (REP_PHASE == 99) { for (int q_ = 0; q_ < 20; ++q_) xcd_barrier(bar); }
    RUN(6, ph_lnrouter(pa, 0)); SEAM(6);
    RUN(7, ph_sort(pa)); SEAM(7);
    RUN(8, ph_gateup(pa, 0)); SEAM(8);
    RUN(9, ph_down(pa, 0)); SEAM(9);
    RUN(10, ph_combine(pa, 0)); SEAM(10);
    RUN(11, ph_in1(pa)); SEAM(11);
    RUN(12, ph_glaprep(pa)); SEAM(12);
    RUN(13, ph_glascan(pa)); SEAM(13);
    RUN(14, ph_glanorm(pa)); SEAM(14);
    RUN(15, ph_out(pa, 1)); SEAM(15);
    RUN(16, ph_lnrouter(pa, 1)); SEAM(16);
    RUN(17, ph_sort(pa)); SEAM(17);
    RUN(18, ph_gateup(pa, 1)); SEAM(18);
    RUN(19, ph_down(pa, 1)); SEAM(19);
    RUN(20, ph_combine(pa, 1));
#ifdef DIAG_LO
    xcd_barrier(bar); STAMP(20);
    if (blockIdx.x == 0 && threadIdx.x == 0) { const unsigned long long dtk = tsl[DIAG_HI + 1] - tsl[DIAG_LO]; const float f = (float)dtk * (0.01f / 10000.f); __hip_atomic_store(ctl + 8, __float_as_uint(f), __ATOMIC_RELAXED, __HIP_MEMORY_SCOPE_AGENT); }
    xcd_barrier(bar);
    { const float f = __uint_as_float(__hip_atomic_load(ctl + 8, __ATOMIC_RELAXED, __HIP_MEMORY_SCOPE_AGENT));
      for (size_t i = (size_t)blockIdx.x * 512 + threadIdx.x; i < (size_t)T * 1024; i += (size_t)gridDim.x * 512) args.out[i] *= (1.f + f); }
#endif
#undef IN
#undef SEAM
}

static int g_grid = 0;
static bool launch_setup(size_t ws_size) {
    if (g_grid == 0) {
        if (ws_size < W_END) { fprintf(stderr, "kernel_launch: workspace too small: %zu < %zu\n", ws_size, (size_t)W_END); g_grid = -1; return false; }
        int dev = 0, cus = 0, per_cu = 0;
        if (hipGetDevice(&dev) != hipSuccess || hipDeviceGetAttribute(&cus, hipDeviceAttributeMultiprocessorCount, dev) != hipSuccess) { g_grid = -1; return false; }
        if (hipFuncSetAttribute((const void*)mega, hipFuncAttributeMaxDynamicSharedMemorySize, LDS_BYTES) != hipSuccess) { fprintf(stderr, "kernel_launch: hipFuncSetAttribute failed\n"); g_grid = -1; return false; }
        if (hipOccupancyMaxActiveBlocksPerMultiprocessor(&per_cu, (const void*)mega, 512, LDS_BYTES) != hipSuccess || per_cu < 1) fprintf(stderr, "kernel_launch: occupancy query reports %d blocks/CU\n", per_cu);
        (void)hipGetLastError();
        g_grid = cus;
    }
    return g_grid > 0;
}
static void launch_phases(hipStream_t stream, void* const* d_in, void* d_out, void* d_ws, int lo, int hi) {
    Args a; memset(&a, 0, sizeof a);
    for (int i = 0; i < 29; ++i) a.in[i] = (const float*)d_in[i];
    a.out = (float*)d_out; a.ws = (unsigned char*)d_ws; a.ph_lo = lo; a.ph_hi = hi;
    hipLaunchKernelGGL(mega, dim3(g_grid), dim3(512), LDS_BYTES, stream, a);
}
}
extern "C" void kernel_launch(void* const* d_in, const int* in_sizes, int n_in, void* d_out, int out_size, void* d_ws, size_t ws_size, hipStream_t stream) {
    if (n_in != 29 || out_size != T * D) { fprintf(stderr, "kernel_launch: unexpected arguments (n_in %d, out_size %d)\n", n_in, out_size); return; }
    if (!fk::launch_setup(ws_size)) return;
    (void)hipMemsetAsync((char*)d_ws + fk::W_CTL, 0, fk::CTL_ZERO_BYTES, stream);
    fk::launch_phases(stream, d_in, d_out, d_ws, 0, fk::NPH);
}
```

```cpp
#include <hip/hip_runtime.h>
#include <cstdio>
#include <cstdint>
#include <cmath>
#include <cstring>
#define DEV __device__ __forceinline__
constexpr int Bn = 16, L = 2048, D = 1024, T = Bn * L;
namespace fk {
#define LAS __attribute__((address_space(3)))
#define GAS __attribute__((address_space(1)))
typedef unsigned short bf16_t;
typedef short bf16x8 __attribute__((ext_vector_type(8)));
typedef short s16x4 __attribute__((ext_vector_type(4)));
typedef float f32x2 __attribute__((ext_vector_type(2)));
typedef float f32x4 __attribute__((ext_vector_type(4)));
typedef float f32x16 __attribute__((ext_vector_type(16)));
typedef unsigned u32x2 __attribute__((ext_vector_type(2)));
typedef unsigned u32x4 __attribute__((ext_vector_type(4)));
typedef __bf16 bf16x2_t __attribute__((ext_vector_type(2)));
struct u32x4x2 { u32x4 a, b; };
DEV unsigned cvt_pk(float lo, float hi) { f32x2 v = {lo, hi}; bf16x2_t b = __builtin_convertvector(v, bf16x2_t); return __builtin_bit_cast(unsigned, b); }
DEV float bflo(unsigned w) { return __uint_as_float(w << 16); }
DEV float bfhi(unsigned w) { return __uint_as_float(w & 0xffff0000u); }
DEV float fast_sigm(float x) { return __builtin_amdgcn_rcpf(1.f + __builtin_amdgcn_exp2f(-1.4426950408889634f * x)); }
DEV float gelu_tanh(float x) { const float u = 0.7978845608028654f * (x + 0.044715f * x * x * x); return x * fast_sigm(2.f * u); }
DEV float wave_sum(float v) {
#pragma unroll
    for (int o = 1; o < 64; o <<= 1) v += __shfl_xor(v, o);
    return v; }
DEV float swap32(float x) { auto rr = __builtin_amdgcn_permlane32_swap(__float_as_uint(x), __float_as_uint(x), false, false); return __uint_as_float((__builtin_amdgcn_mbcnt_lo(~0u, 0u) >> 5) ? rr[0] : rr[1]); }

constexpr int BM = 256, BK = 64, HALF = 128, HTB = HALF * BK * 2, STAGE_BYTES = 8 * HTB, NXCD = 8, WGM = 8;
constexpr int LDS_TOK = 135168 - 2048;
constexpr int LDS_SIDE = 135168;
constexpr int LDS_BYTES = 163840, LDSCTL_OFF = LDS_BYTES - 1024, MISC_OFF = LDSCTL_OFF + 320;

DEV int lds_byte(int r, int c) { const int st = (r >> 4) * 2 + (c >> 5), rr = r & 15, cc = c & 31, ob = rr * 64 + cc * 2; return st * 1024 + (ob ^ (((ob >> 9) & 1) << 5)); }
DEV void stage_rc(int b, int& R, int& C) { const int st = b / 1024, sb = b % 1024, swz = sb ^ (((sb >> 9) & 1) << 5); R = (st >> 1) * 16 + swz / 64; C = (st & 1) * 32 + (swz % 64) / 2; }
DEV int perm32(int rho) { const int n = rho >> 4, i = rho & 15; return 8 * (i >> 2) + 4 * n + (i & 3); }

struct Unit { int pm, pn, e; };
struct Gemm { const void* A; const void* Bt; const int* rowmap; size_t bstride; int KB; int wave; };

struct StaticOrder {
    int nM, nN, nwg, G, c; const LAS int* elist;
    DEV void init(int nM_, int nN_, int G_, int c_, const LAS int* el) { nM = nM_; nN = nN_; nwg = nM * nN; G = G_; c = c_; elist = el; }
    DEV bool place(int i, Unit& u) const {
        const long Lx = (long)i * G + c; if (Lx >= nwg) return false;
        int wgid = (int)Lx; { const int q = nwg / NXCD, r = nwg % NXCD, xcd = wgid % NXCD, off = wgid / NXCD; wgid = (xcd < r ? xcd * (q + 1) : r * (q + 1) + (xcd - r) * q) + off; }
        const int nig = WGM * nN, gid = wgid / nig, fm = gid * WGM, gsz = (nM - fm) < WGM ? (nM - fm) : WGM;
        u.pm = fm + ((wgid % nig) % gsz); u.pn = (wgid % nig) / gsz; u.e = 0; return true;
    }
    DEV bool next(int i, Unit& u) const { if (!place(i, u)) return false; if (elist) u.e = __builtin_amdgcn_readfirstlane(elist[i]); return true; }
};
constexpr int LDS_ELIST = 135168 + 6144;
DEV void fill_elist(LAS unsigned char* lds, const StaticOrder& S, const int* tile_e, int tid) {
    LAS int* el = (LAS int*)(lds + LDS_ELIST);
    if (tid < 64) { Unit u; el[tid] = S.place(tid, u) ? tile_e[u.pm] : 0; }
    __syncthreads();
}

struct NoPre {};
template <class F> struct EpiRow8 {
    static constexpr bool PERM = true; static constexpr int NSIDE = F::NSIDE; F f;
    DEV const void* side(const Unit& u, int k) const { return f.side(u, k); }
    DEV void operator()(const f32x4 (&acc)[2][2][4][2], const Unit& u, int wr, int wc, int fr, int fq, const LAS float* sd) const {
        { const int ln_ = (int)__builtin_amdgcn_mbcnt_hi(~0u, __builtin_amdgcn_mbcnt_lo(~0u, 0u)); fr = ln_ & 15; fq = ln_ >> 4; }
        const int cl = wc * 32 + 8 * fq, c0 = u.pn * BM + cl;
        const auto p0 = f.pre(u, c0, sd + cl), p1 = f.pre(u, c0 + HALF, sd + cl + HALF);
#pragma unroll
        for (int ai = 0; ai < 2; ++ai)
#pragma unroll
            for (int m = 0; m < 4; ++m) { const int rl = ai * HALF + wr * 64 + m * 16 + fr, row = u.pm * BM + rl;
                f(u, row, c0, acc[ai][0][m][0], acc[ai][0][m][1], p0, sd + 256 + rl); f(u, row, c0 + HALF, acc[ai][1][m][0], acc[ai][1][m][1], p1, sd + 256 + rl); }
    }
};

typedef int v8i_t __attribute__((ext_vector_type(8)));
typedef int v4i_t __attribute__((ext_vector_type(4)));
template <bool GATHER, bool FP8, class Epi, class Sched>
DEV void gemm_phase(LAS unsigned char* lds, const Gemm g, const Sched& S, const Epi& E) {
    const int wid = g.wave, lane = (int)__builtin_amdgcn_mbcnt_hi(~0u, __builtin_amdgcn_mbcnt_lo(~0u, 0u)), tid = wid * 64 + lane, wr = wid >> 2, wc = wid & 3, fr = lane & 15, fq = lane >> 4;
    float z0 = 0.f; asm volatile("" : "+v"(z0));
    const int KB = g.KB, nt = KB / 128;
    int R0, C2; { int C; stage_rc(tid * 16, R0, C); C2 = C * 2; }
    unsigned voffB[2]; { const int Rb = Epi::PERM ? ((R0 & ~31) + perm32(R0 & 31)) : R0; voffB[0] = (unsigned)(Rb * KB + C2); voffB[1] = voffB[0] + 64u * (unsigned)KB; }
    const unsigned kstep = 128u, hstep = (unsigned)HALF * KB, tstep = 2u * hstep;
    const unsigned ldsw = (unsigned)wid * 1024u;
    const int aoff = lds_byte(wr * 64 + fr, fq * 8); int boff = lds_byte(wc * 32 + fr, fq * 8) + 4 * HTB; asm volatile("" : "+v"(boff));
    LAS int* tokb = (LAS int*)(lds + LDS_TOK);
    const auto rsA = __builtin_amdgcn_make_buffer_rsrc((void*)g.A, 0, 0x7fffffff, 0x00020000);
    const auto rsB = __builtin_amdgcn_make_buffer_rsrc((void*)g.Bt, 0, 0x7fffffff, 0x00020000);
    const auto rsT = __builtin_amdgcn_make_buffer_rsrc((void*)(GATHER ? (const void*)g.rowmap : g.A), 0, 0x7fffffff, 0x00020000);
#define PG8_SA(b, h) (((b) * 2 + (h)) * HTB)
#define PG8_SB(b, h) ((4 + (b) * 2 + (h)) * HTB)
#define PG8_STAGE(bufoff, rs, soff, voff) do { _Pragma("unroll") for (int _i = 0; _i < 2; ++_i) { \
        if constexpr (GATHER) __builtin_amdgcn_raw_ptr_buffer_load_lds(rs, (LAS void*)(lds + (bufoff) + ldsw + _i * 8192), 16, (int)(voff)[_i], (int)(soff), 0, 0); \
        else __builtin_amdgcn_raw_ptr_buffer_load_lds(rs, (LAS void*)(lds + (bufoff) + ldsw + _i * 8192), 16, (int)(voff)[0], (int)((soff) + _i * 64u * (unsigned)KB), 0, 0); } } while (0)
#define PG8_LDA(dst, b, h) do { _Pragma("unroll") for (int m = 0; m < 4; ++m) _Pragma("unroll") for (int k = 0; k < 2; ++k) dst[m][k] = *(const LAS bf16x8*)(lds + PG8_SA(b, h) + aoff + m * 2048 + k * 1024); } while (0)
#define PG8_LDB(dst, b, h) do { _Pragma("unroll") for (int n = 0; n < 2; ++n) _Pragma("unroll") for (int k = 0; k < 2; ++k) dst[n][k] = *(const LAS bf16x8*)(lds + boff + (PG8_SB(b, h) - 4 * HTB) + n * 2048 + k * 1024); } while (0)
#define PG8_CAT(x) __builtin_shufflevector(__builtin_bit_cast(v4i_t, x[0]), __builtin_bit_cast(v4i_t, x[1]), 0, 1, 2, 3, 4, 5, 6, 7)
#define PG8_MMA(ai, bj, At, Bt) do { __builtin_amdgcn_s_setprio(1); _Pragma("unroll") for (int m = 0; m < 4; ++m) _Pragma("unroll") for (int n = 0; n < 2; ++n) { \
        if constexpr (FP8) acc[ai][bj][m][n] = __builtin_amdgcn_mfma_scale_f32_16x16x128_f8f6f4(PG8_CAT(Bt[n]), PG8_CAT(At[m]), acc[ai][bj][m][n], 0, 0, 0, 0, 0, 0); \
        else { _Pragma("unroll") for (int k = 0; k < 2; ++k) acc[ai][bj][m][n] = __builtin_amdgcn_mfma_f32_16x16x32_bf16(Bt[n][k], At[m][k], acc[ai][bj][m][n], 0, 0, 0); } } __builtin_amdgcn_s_setprio(0); } while (0)
#define PG8_WAIT_V(n) asm volatile("s_waitcnt vmcnt(" #n ")" ::: "memory")
#define PG8_WAIT_L(n) asm volatile("s_waitcnt lgkmcnt(" #n ")" ::: "memory")
#define PG8_BAR __builtin_amdgcn_s_barrier()
#define PG8_SCHED __builtin_amdgcn_sched_barrier(0)
    Unit cur, nxt; int ui = 0;
    if (!S.next(0, cur)) return;
    f32x4 acc[2][2][4][2];
#pragma unroll
    for (int a = 0; a < 2; ++a)
#pragma unroll
        for (int b = 0; b < 2; ++b)
#pragma unroll
            for (int m = 0; m < 4; ++m)
#pragma unroll
                for (int n = 0; n < 2; ++n) acc[a][b][m][n] = (f32x4){z0, z0, z0, z0};
    bf16x8 At[4][2], B0[2][2], B1[2][2];
    unsigned cA, cB = (unsigned)cur.e * (unsigned)g.bstride + (unsigned)cur.pn * tstep;
    unsigned voffA[2]; voffA[0] = (unsigned)(R0 * KB + C2); voffA[1] = voffA[0] + 64u * (unsigned)KB;
    if constexpr (GATHER) { cA = 0u;
        if (wid < 4) __builtin_amdgcn_raw_ptr_buffer_load_lds(rsT, (LAS void*)(tokb + wid * 64), 4, (wid * 64 + lane) * 4, cur.pm * (BM * 4), 0, 0);
        asm volatile("s_waitcnt vmcnt(0)" ::: "memory"); __builtin_amdgcn_s_barrier();
    } else cA = (unsigned)cur.pm * tstep;
    const unsigned hA = GATHER ? 0u : hstep;
    LAS float* sideb = (LAS float*)(lds + LDS_SIDE);
#define PG8_SIDE(un, sel) do { if constexpr (Epi::NSIDE > 0) { if (wid < Epi::NSIDE) { const char* sp_ = (const char*)E.side(un, wid); int ln_ = (int)__builtin_amdgcn_mbcnt_hi(~0u, __builtin_amdgcn_mbcnt_lo(~0u, 0u)); asm volatile("" : "+v"(ln_)); \
        __builtin_amdgcn_global_load_lds((const unsigned*)(sp_ + ln_ * 16), (LAS unsigned*)(sideb + (sel) * 512 + wid * 256), 16, 0, 0); } } } while (0)
    PG8_SIDE(cur, 0);
#define PG8_OA(dst, sel, h) unsigned dst[2]; if constexpr (GATHER) { dst[0] = (unsigned)(tokb[(sel) * 256 + (h) * HALF + R0] * KB + C2); dst[1] = (unsigned)(tokb[(sel) * 256 + (h) * HALF + R0 + 64] * KB + C2); } else { dst[0] = voffA[0]; dst[1] = voffA[1]; }
    { PG8_OA(p0_, 0, 0); PG8_OA(p1_, 0, 1); PG8_STAGE(PG8_SB(0, 0), rsB, cB, voffB); PG8_STAGE(PG8_SB(0, 1), rsB, cB + hstep, voffB); PG8_STAGE(PG8_SA(0, 0), rsA, cA, p0_); PG8_STAGE(PG8_SA(0, 1), rsA, cA + hA, p1_); }
    if (wr == 1) PG8_BAR;
    PG8_WAIT_V(2); PG8_BAR;
    { PG8_OA(p0_, 0, 0); PG8_STAGE(PG8_SB(1, 0), rsB, cB + kstep, voffB); PG8_STAGE(PG8_SA(1, 0), rsA, cA + kstep, p0_); PG8_STAGE(PG8_SB(1, 1), rsB, cB + hstep + kstep, voffB); }
    PG8_WAIT_V(6); PG8_BAR;
    for (;;) {
        const bool has_next = S.next(ui + 1, nxt);
        unsigned nA = cA, nB = cB;
        if (has_next) { nB = (unsigned)nxt.e * (unsigned)g.bstride + (unsigned)nxt.pn * tstep;
            if constexpr (GATHER) { if (wid < 4) { const int ln_ = (int)__builtin_amdgcn_mbcnt_hi(~0u, __builtin_amdgcn_mbcnt_lo(~0u, 0u)); __builtin_amdgcn_raw_ptr_buffer_load_lds(rsT, (LAS void*)(tokb + ((ui + 1) & 1) * 256 + wid * 64), 4, (wid * 64 + ln_) * 4, nxt.pm * (BM * 4), 0, 0); } }
            else nA = (unsigned)nxt.pm * tstep;
            PG8_SIDE(nxt, (ui + 1) % 3); }
#pragma unroll 1
        for (int t = 0; t < nt; t += 2) {
            const bool last = (t == nt - 2);
            const unsigned a1 = cA + (unsigned)(t + 1) * kstep;
            const unsigned a2 = last ? nA : cA + (unsigned)(t + 2) * kstep, b2 = last ? nB : cB + (unsigned)(t + 2) * kstep;
            const unsigned a3 = a2 + kstep, b3 = b2 + kstep;
            const int selc = ui & 1, seln = (last && has_next) ? ((ui + 1) & 1) : selc;
            PG8_LDB(B0, 0, 0); PG8_LDB(B1, 0, 1); PG8_SCHED; PG8_LDA(At, 0, 0); { PG8_OA(q_, selc, 1); PG8_STAGE(PG8_SA(1, 1), rsA, a1 + hA, q_); }
            PG8_WAIT_V(8); PG8_WAIT_L(0); PG8_BAR; PG8_MMA(0, 0, At, B0); PG8_MMA(0, 1, At, B1); PG8_BAR; PG8_SCHED;
            PG8_LDA(At, 0, 1); PG8_STAGE(PG8_SB(0, 0), rsB, b2, voffB); PG8_STAGE(PG8_SB(0, 1), rsB, b2 + hstep, voffB); { PG8_OA(q_, seln, 0); PG8_STAGE(PG8_SA(0, 0), rsA, a2, q_); }
            PG8_WAIT_V(8); PG8_WAIT_L(0); PG8_BAR; PG8_MMA(1, 0, At, B0); PG8_MMA(1, 1, At, B1); PG8_BAR; PG8_SCHED;
            PG8_LDB(B0, 1, 0); PG8_LDB(B1, 1, 1); PG8_SCHED; PG8_LDA(At, 1, 0); { PG8_OA(q_, seln, 1); PG8_STAGE(PG8_SA(0, 1), rsA, a2 + hA, q_); }
            PG8_WAIT_V(8); PG8_WAIT_L(0); PG8_BAR; PG8_MMA(0, 0, At, B0); PG8_MMA(0, 1, At, B1); PG8_BAR; PG8_SCHED;
            PG8_LDA(At, 1, 1); PG8_STAGE(PG8_SB(1, 0), rsB, b3, voffB); PG8_STAGE(PG8_SB(1, 1), rsB, b3 + hstep, voffB); { PG8_OA(q_, seln, 0); PG8_STAGE(PG8_SA(1, 0), rsA, a3, q_); }
            PG8_WAIT_V(8); PG8_WAIT_L(0); PG8_BAR; PG8_MMA(1, 0, At, B0); PG8_MMA(1, 1, At, B1); PG8_BAR; PG8_SCHED;
        }
        if (wr == 0) PG8_BAR;
        E(acc, cur, wr, wc, fr, fq, sideb + (ui % 3) * 512);
        if (!has_next) break;
#pragma unroll
        for (int a = 0; a < 2; ++a)
#pragma unroll
            for (int b = 0; b < 2; ++b)
#pragma unroll
                for (int m = 0; m < 4; ++m)
#pragma unroll
                    for (int n = 0; n < 2; ++n) acc[a][b][m][n] = (f32x4){z0, z0, z0, z0};
        cur = nxt; cA = nA; cB = nB; ++ui;
        if (wr == 1) PG8_BAR;
    }
    PG8_WAIT_V(0);
    PG8_BAR;
#undef PG8_SA
#undef PG8_SB
#undef PG8_STAGE
#undef PG8_SIDE
#undef PG8_OA
#undef PG8_LDA
#undef PG8_LDB
#undef PG8_MMA
#undef PG8_CAT
#undef PG8_WAIT_V
#undef PG8_WAIT_L
#undef PG8_BAR
#undef PG8_SCHED
}

typedef GAS unsigned gu32;
#define XB_TMO      128
#define XB_XCNT(j)  (256  + 64 * (j))
#define XB_XSUB(j)  (1280 + 64 * (j))
#define XB_XGEN(j)  (2304 + 64 * (j))
#define XB_TOP      3328
#define XB_TOPGEN   3392
#define XCD_BAR_WORDS 3456
#define XB_SPIN_CAP (1u << 20)
DEV unsigned xb_ld(unsigned* p) { return __hip_atomic_load(p, __ATOMIC_RELAXED, __HIP_MEMORY_SCOPE_AGENT); }
DEV unsigned xb_add(unsigned* p, unsigned v) { return __hip_atomic_fetch_add(p, v, __ATOMIC_RELAXED, __HIP_MEMORY_SCOPE_AGENT); }
DEV unsigned xb_xcc_id() { return (unsigned)__builtin_amdgcn_s_getreg((3 << 11) | 20) & 0xFu; }
#define XB_SPIN(cond, bar) do { unsigned _sp = 0; while (cond) { __builtin_amdgcn_s_sleep(1); \
    if ((++_sp & 255u) == 0u) { if (xb_ld(&(bar)[XB_TMO])) break; if (_sp > XB_SPIN_CAP) { atomicAdd(&(bar)[XB_TMO], 1u); break; } } } } while (0)
struct XcdBarrier { unsigned* bar; unsigned x; volatile LAS unsigned* st; int wave; };
DEV bool xb_thread0(int wave) { return wave == 0 && __builtin_amdgcn_mbcnt_hi(~0u, __builtin_amdgcn_mbcnt_lo(~0u, 0u)) == 0u; }
DEV XcdBarrier xcd_barrier_post(unsigned* bar, volatile LAS unsigned* st, int wave) {
    XcdBarrier b; b.bar = bar; b.x = xb_xcc_id(); b.st = st; b.wave = wave;
    if (xb_thread0(wave)) (void)xb_add(&bar[XB_XCNT(b.x)], 1u);
    return b;
}
DEV void xcd_barrier_complete(unsigned* bar, unsigned x, unsigned& nloc, unsigned& nx) {
    const unsigned G = gridDim.x * gridDim.y * gridDim.z;
    unsigned sum, cnt, mine, sp = 0u;
    for (;;) {
        sum = 0u; cnt = 0u; mine = 0u;
#pragma unroll
        for (unsigned j = 0; j < 16; ++j) { const unsigned c = xb_ld(&bar[XB_XCNT(j)]); sum += c; cnt += (c > 0u) ? 1u : 0u; mine = (j == x) ? c : mine; }
        if (sum == G) break;
        __builtin_amdgcn_s_sleep(1);
        if ((++sp & 255u) == 0u) { if (xb_ld(&bar[XB_TMO])) break; if (sp > XB_SPIN_CAP) { atomicAdd(&bar[XB_TMO], 1u); break; } }
    }
    nloc = mine > 0u ? mine : 1u; nx = cnt > 0u ? cnt : 1u;
}
DEV void xcd_barrier(const XcdBarrier& b) {
    asm volatile("s_waitcnt vmcnt(0)" ::: "memory");
    __syncthreads();
    if (xb_thread0(b.wave)) {
        unsigned* bar = b.bar;
        __builtin_amdgcn_s_waitcnt(0);
        unsigned nloc = b.st[0], nx = b.st[1];
        if (nloc == 0u) { xcd_barrier_complete(bar, b.x, nloc, nx); b.st[0] = nloc; b.st[1] = nx; }
        const unsigned old = xb_add(&bar[XB_XSUB(b.x)], 1u);
        const unsigned gen = old / nloc;
        if (old + 1u == (gen + 1u) * nloc) {
            __builtin_amdgcn_fence(__ATOMIC_RELEASE, "agent");
            asm volatile("s_waitcnt vmcnt(0)" ::: "memory");
            const unsigned og = xb_add(&bar[XB_TOP], 1u);
            const unsigned tg = og / nx;
            if (og + 1u == (tg + 1u) * nx) xb_add(&bar[XB_TOPGEN], 1u);
            else XB_SPIN(xb_ld(&bar[XB_TOPGEN]) == tg, bar);
            __builtin_amdgcn_fence(__ATOMIC_ACQUIRE, "agent");
            xb_add(&bar[XB_XGEN(b.x)], 1u);
            asm volatile("s_waitcnt vmcnt(0)" ::: "memory");
        } else {
            XB_SPIN(xb_ld(&bar[XB_XGEN(b.x)]) == gen, bar);
            __builtin_amdgcn_fence(__ATOMIC_ACQUIRE, "agent");
            asm volatile("s_waitcnt vmcnt(0)" ::: "memory");
        }
    }
    __syncthreads();
}
constexpr size_t MiB = 1u << 20;
constexpr int PMAX = 131072 + 32 * 256;
constexpr size_t W_CTL = 0, CTL_ZERO_BYTES = 1 * MiB;
constexpr size_t W_IN0 = 2 * MiB, W_GLU = 6 * MiB, W_OUT0 = 7 * MiB, W_IN1 = 9 * MiB, W_OUT1 = 16 * MiB;
constexpr size_t W_LUT = 18 * MiB, W_KM = W_LUT + 64 * 1024, W_HIST = W_KM + 256 * 1024, W_SORT = W_HIST + 64 * 1024  , W_GR = 20 * MiB  , W_SS = 22 * MiB  ;
constexpr size_t W_GU = 32 * MiB, W_DN = 288 * MiB, W_XB = 416 * MiB  , W_XBB = 480 * MiB  , W_X8 = 1024 * MiB  , W_HB = 736 * MiB, W_YS5 = 928 * MiB, W_Y0 = 960 * MiB, W_MIXB = 1024 * MiB, W_GLAO = 1088 * MiB;
constexpr size_t W_ROUTE = 26 * MiB  , W_ACT = 736 * MiB  , W_YS = 1160 * MiB, W_END = 1432 * MiB;
static_assert(W_ACT + (size_t)PMAX * 2048 <= W_MIXB && W_YS + (size_t)PMAX * 2048 <= W_END && W_X8 + (size_t)PMAX * 1024 <= W_YS && W_ROUTE + 4 * MiB <= W_GU, "ws map");
constexpr int CW_BAR = 4096;

struct Args { const float* in[29]; float* out; unsigned char* ws; int ph_lo, ph_hi; };
struct Frame {
    LAS unsigned char* lds; int tid, lane, wave, vcu, G;
    const float* const* in; unsigned char* ws;
};
#define WSP(T_, off) ((T_*)(F.ws + (off)))

DEV unsigned pk4_fp8(float a, float b, float c, float d) { unsigned w = 0u; w = __builtin_amdgcn_cvt_pk_fp8_f32(a, b, w, false); w = __builtin_amdgcn_cvt_pk_fp8_f32(c, d, w, true); return w; }
struct CvItem { const float* src; unsigned char* dst; int pitch, K; float sc; };
constexpr int P0_I_GU = 8 * 8, P0_I_DN = 8 * 4, P0_I_IN0 = 8 * 8, P0_I_GLU = 4 * 2, P0_I_O = 8 * 4, P0_I_IN1 = 8 * 12;
constexpr int P0_N_GU = 64 * P0_I_GU, P0_N_DN = 64 * P0_I_DN, P0_NITEMS = P0_N_GU + P0_N_DN + P0_I_IN0 + P0_I_GLU + 2 * P0_I_O + P0_I_IN1;
DEV CvItem cv_decode(Frame& F, int it) {
    int r = it; const float* W; unsigned char* D; int K, N, NP, es; float sc = 0.f;
    if (r < P0_N_GU) { const int m = r / P0_I_GU; r %= P0_I_GU; W = F.in[25] + (size_t)m * 1024 * 2048; D = WSP(unsigned char, W_GU) + (size_t)m * 2048 * 1024; K = 1024; N = 2048; NP = 2048; es = 1; sc = 64.f; }
    else if ((r -= P0_N_GU) < P0_N_DN) { const int m = r / P0_I_DN; r %= P0_I_DN; W = F.in[27] + (size_t)m * 1024 * 1024; D = WSP(unsigned char, W_DN) + (size_t)m * 1024 * 1024; K = 1024; N = 1024; NP = 1024; es = 1; sc = 128.f; }
    else if ((r -= P0_N_DN) < P0_I_IN0) { W = F.in[1]; D = WSP(unsigned char, W_IN0); K = 1024; N = 2048; NP = 2048; es = 2; }
    else if ((r -= P0_I_IN0) < P0_I_GLU) { W = F.in[10]; D = WSP(unsigned char, W_GLU); K = 512; N = 512; NP = 512; es = 2; }
    else if ((r -= P0_I_GLU) < P0_I_O) { W = F.in[13]; D = WSP(unsigned char, W_OUT0); K = 1024; N = 1024; NP = 1024; es = 2; }
    else if ((r -= P0_I_O) < P0_I_O) { W = F.in[18]; D = WSP(unsigned char, W_OUT1); K = 1024; N = 1024; NP = 1024; es = 2; }
    else { r -= P0_I_O; W = F.in[14]; D = WSP(unsigned char, W_IN1); K = 1024; N = 3072; NP = 3088; es = 2; }
    const int nblk = N / 256, kb = r / nblk, nb = r % nblk;
    CvItem c; c.src = W + (size_t)(128 * kb) * NP + 256 * nb; c.dst = D + ((size_t)(256 * nb) * K + 128 * kb) * es; c.pitch = NP; c.K = K; c.sc = sc; return c;
}
DEV void cv_load(const CvItem& c, f32x4 (&v)[16], int tid) {
#pragma unroll
    for (int i = 0; i < 16; ++i) v[i] = *(const f32x4*)(c.src + (size_t)(8 * i + (tid >> 6)) * c.pitch + 4 * (tid & 63));
}
DEV void cv_store(const CvItem& c, const f32x4 (&v)[16], LAS float* T_, int tid) {
#pragma unroll
    for (int i = 0; i < 16; ++i) *(LAS f32x4*)(T_ + (8 * i + (tid >> 6)) * 260 + 4 * (tid & 63)) = v[i];
    __syncthreads();
    const int n = tid & 255, kh = tid >> 8; const LAS float* s = T_ + (64 * kh) * 260 + n;
    if (c.sc > 0.f) { const float q = c.sc; unsigned char* d = c.dst + (size_t)n * c.K + 64 * kh;
#pragma unroll
        for (int g = 0; g < 4; ++g) { u32x4 o;
            o.x = pk4_fp8(s[(16 * g + 0) * 260] * q, s[(16 * g + 1) * 260] * q, s[(16 * g + 2) * 260] * q, s[(16 * g + 3) * 260] * q); o.y = pk4_fp8(s[(16 * g + 4) * 260] * q, s[(16 * g + 5) * 260] * q, s[(16 * g + 6) * 260] * q, s[(16 * g + 7) * 260] * q);
            o.z = pk4_fp8(s[(16 * g + 8) * 260] * q, s[(16 * g + 9) * 260] * q, s[(16 * g + 10) * 260] * q, s[(16 * g + 11) * 260] * q); o.w = pk4_fp8(s[(16 * g + 12) * 260] * q, s[(16 * g + 13) * 260] * q, s[(16 * g + 14) * 260] * q, s[(16 * g + 15) * 260] * q);
            *(u32x4*)(d + 16 * g) = o; }
    } else { unsigned char* d = c.dst + ((size_t)n * c.K + 64 * kh) * 2;
#pragma unroll
        for (int g = 0; g < 8; ++g) { u32x4 o; o.x = cvt_pk(s[(8 * g + 0) * 260], s[(8 * g + 1) * 260]); o.y = cvt_pk(s[(8 * g + 2) * 260], s[(8 * g + 3) * 260]); o.z = cvt_pk(s[(8 * g + 4) * 260], s[(8 * g + 5) * 260]); o.w = cvt_pk(s[(8 * g + 6) * 260], s[(8 * g + 7) * 260]);
            *(u32x4*)(d + 16 * g) = o; }
    }
    __syncthreads();
}
__constant__ int BUCKET_TH2[16] = {16, 22, 30, 40, 54, 73, 99, 134, 182, 246, 332, 450, 609, 825, 1117, 1513};
DEV void p0_prologue(Frame& F) {
    { LAS float* T_ = (LAS float*)F.lds; f32x4 va[16], vb[16];
      int it = F.vcu;
      if (it < P0_NITEMS) { CvItem ca = cv_decode(F, it); cv_load(ca, va, F.tid);
#pragma unroll 1
          for (;;) {
              const int it2 = it + F.G; CvItem cb = ca; const bool h2 = it2 < P0_NITEMS; if (h2) { cb = cv_decode(F, it2); cv_load(cb, vb, F.tid); }
              cv_store(ca, va, T_, F.tid);
              if (!h2) break;
              const int it3 = it2 + F.G; const bool h3 = it3 < P0_NITEMS; if (h3) { ca = cv_decode(F, it3); cv_load(ca, va, F.tid); }
              cv_store(cb, vb, T_, F.tid);
              if (!h3) break;
              it = it3;
          } } }
    const int gt = F.vcu * 512 + F.tid, NGT = F.G * 512;
    for (int i = gt; i < 16 * 1024; i += NGT) { const int n = i >> 10, k = i & 1023; WSP(bf16_t, W_IN1)[(size_t)(3072 + n) * 1024 + k] = (bf16_t)(cvt_pk(F.in[14][(size_t)k * 3088 + 3072 + n], 0.f) & 0xffffu); }
    { const f32x4* x4 = (const f32x4*)F.in[0]; u32x2* o = WSP(u32x2, W_XB);
      for (size_t i = gt; i < (size_t)T * 1024 / 4; i += (size_t)NGT * 8) { f32x4 v[8];
#pragma unroll
          for (int u = 0; u < 8; ++u) v[u] = x4[i + (size_t)u * NGT];
#pragma unroll
          for (int u = 0; u < 8; ++u) { u32x2 w; w.x = cvt_pk(v[u].x, v[u].y); w.y = cvt_pk(v[u].z, v[u].w); o[i + (size_t)u * NGT] = w; } } }
    for (int i = gt; i < 8 * 2048; i += NGT) { const int h = i >> 11, n = i & 2047; int bk = n;
        if (n >= 16) { bk = 16;
#pragma unroll
            for (int q = 1; q < 16; ++q) bk += (n >= BUCKET_TH2[q]) ? 1 : 0; }
        WSP(float, W_LUT)[i] = F.in[12][bk * 8 + h] * 1.4426950408889634f; }
}

DEV void p_kmean(Frame& F) {
    const int gw = F.vcu * 8 + F.wave, NGW = F.G * 8; const bf16_t* H0 = WSP(bf16_t, W_HB); float* KM = WSP(float, W_KM);
    for (int it = gw; it < 1024; it += NGW) { const int blk = it & 7, h = (it >> 3) & 7, b = it >> 6; const int r8 = F.lane >> 3, c = F.lane & 7;
        const bf16_t* p = H0 + (size_t)(b * 2048 + blk * 256 + r8) * 2048 + 1024 + h * 64 + c * 8; float s[8];
#pragma unroll
        for (int j = 0; j < 8; ++j) s[j] = 0.f;
#pragma unroll 8
        for (int i = 0; i < 32; ++i) { const u32x4 v = *(const u32x4*)(p + (size_t)i * 8 * 2048);
            s[0] += bflo(v.x); s[1] += bfhi(v.x); s[2] += bflo(v.y); s[3] += bfhi(v.y); s[4] += bflo(v.z); s[5] += bfhi(v.z); s[6] += bflo(v.w); s[7] += bfhi(v.w); }
#pragma unroll
        for (int j = 0; j < 8; ++j) { s[j] += __shfl_xor(s[j], 8); s[j] += __shfl_xor(s[j], 16); s[j] += __shfl_xor(s[j], 32); }
        if (F.lane < 8) {
#pragma unroll
            for (int j = 0; j < 8; ++j) KM[(size_t)it * 64 + c * 8 + j] = s[j] * (1.f / 256.f); } }
}

DEV void s5_item(Frame& F, int b, int g, LAS unsigned char* sl  ) {
    const int lane = F.lane, p0 = lane & 31, hi = lane >> 5, q4 = lane >> 4;
    const float* lam_re = F.in[2]; const float* lam_im = F.in[3]; const float* log_dt = F.in[4]; const float* b_re = F.in[5]; const float* b_im = F.in[6];
    const float* c_re = F.in[7]; const float* c_im = F.in[8]; const float* dsk = F.in[9];
    const bf16_t* H0 = WSP(bf16_t, W_HB); bf16_t* YS = WSP(bf16_t, W_YS5);
    const float dt = __expf(log_dt[g]);
    float ar[2], ai[2]; bf16x8 bfr[4];
#pragma unroll
    for (int s = 0; s < 2; ++s) { const int p = p0 + 32 * s; const float lr = lam_re[g * 64 + p], li = lam_im[g * 64 + p]; const float mag = __expf(lr * dt);
        ar[s] = mag * cosf(li * dt); ai[s] = mag * sinf(li * dt);
        const float er = ar[s] - 1.f, ei = ai[s], den = lr * lr + li * li; const float qr = (er * lr + ei * li) / den, qi = (ei * lr - er * li) / den;
        u32x4 wr_, wi_; float vr[8], vi[8];
#pragma unroll
        for (int j = 0; j < 8; ++j) { const float br = b_re[(g * 64 + p) * 16 + 8 * hi + j], bi = b_im[(g * 64 + p) * 16 + 8 * hi + j]; vr[j] = qr * br - qi * bi; vi[j] = qr * bi + qi * br; }
        wr_.x = cvt_pk(vr[0], vr[1]); wr_.y = cvt_pk(vr[2], vr[3]); wr_.z = cvt_pk(vr[4], vr[5]); wr_.w = cvt_pk(vr[6], vr[7]);
        wi_.x = cvt_pk(vi[0], vi[1]); wi_.y = cvt_pk(vi[2], vi[3]); wi_.z = cvt_pk(vi[4], vi[5]); wi_.w = cvt_pk(vi[6], vi[7]);
        bfr[2 * s] = __builtin_bit_cast(bf16x8, wr_); bfr[2 * s + 1] = __builtin_bit_cast(bf16x8, wi_); }
    bf16x8 cfr[4];
#pragma unroll
    for (int ks = 0; ks < 4; ++ks) { float v[8];
#pragma unroll
        for (int j = 0; j < 8; ++j) { const int c = 32 * ks + 8 * q4 + j, p = c >> 1; const int h = lane & 15; v[j] = (c & 1) ? -c_im[(g * 16 + h) * 64 + p] : c_re[(g * 16 + h) * 64 + p]; }
        u32x4 w; w.x = cvt_pk(v[0], v[1]); w.y = cvt_pk(v[2], v[3]); w.z = cvt_pk(v[4], v[5]); w.w = cvt_pk(v[6], v[7]); cfr[ks] = __builtin_bit_cast(bf16x8, w); }
    float dv[4];
#pragma unroll
    for (int r = 0; r < 4; ++r) dv[r] = dsk[g * 16 + 4 * q4 + r];
    const int tm = 16 * ((p0 >> 2) & 1) + 4 * (p0 >> 3) + (p0 & 3);
    const bf16_t* urow = H0 + (size_t)(b * 2048 + tm) * 2048 + g * 16 + 8 * hi;
    float cr[2] = {0.f, 0.f}, ci[2] = {0.f, 0.f};
    bf16x8 ufr = *(const bf16x8*)urow;
    for (int tile = 0; tile < 64; ++tile) {
        const bf16x8 ucur = ufr;
        if (tile + 1 < 64) ufr = *(const bf16x8*)(urow + (size_t)(tile + 1) * 32 * 2048);
        f32x16 x[4];
#pragma unroll
        for (int n = 0; n < 4; ++n) { f32x16 z;
#pragma unroll
            for (int r = 0; r < 16; ++r) z[r] = 0.f;
            x[n] = __builtin_amdgcn_mfma_f32_32x32x16_bf16(ucur, bfr[n], z, 0, 0, 0); }
#pragma unroll
        for (int s = 0; s < 2; ++s) {
            f32x16& xr = x[2 * s]; f32x16& xi = x[2 * s + 1];
            float sr = hi ? 0.f : cr[s], si = hi ? 0.f : ci[s];
#pragma unroll
            for (int r = 0; r < 16; ++r) { const float nr = ar[s] * sr - ai[s] * si + xr[r], ni = ar[s] * si + ai[s] * sr + xi[r]; xr[r] = nr; xi[r] = ni; sr = nr; si = ni; }
            const float o_r = swap32(sr), o_i = swap32(si);
            float wr_ = hi ? o_r : 0.f, wi_ = hi ? o_i : 0.f;
#pragma unroll
            for (int r = 0; r < 16; ++r) { const float nr = ar[s] * wr_ - ai[s] * wi_, ni = ar[s] * wi_ + ai[s] * wr_; wr_ = nr; wi_ = ni; xr[r] += wr_; xi[r] += wi_; }
            const float e_r = swap32(xr[15]), e_i = swap32(xi[15]);
            cr[s] = hi ? xr[15] : e_r; ci[s] = hi ? xi[15] : e_i;
#pragma unroll
            for (int r = 0; r < 16; ++r) *(LAS unsigned*)(sl + (16 * hi + r) * 256 + (p0 + 32 * s) * 4) = cvt_pk(xr[r], xi[r]);
        }
#pragma unroll
        for (int tt = 0; tt < 2; ++tt) {
            f32x4 y = {0.f, 0.f, 0.f, 0.f};
#pragma unroll
            for (int ks = 0; ks < 4; ++ks) { const bf16x8 sf = *(const LAS bf16x8*)(sl + (16 * tt + (lane & 15)) * 256 + ks * 64 + q4 * 16); y = __builtin_amdgcn_mfma_f32_16x16x32_bf16(cfr[ks], sf, y, 0, 0, 0); }
            const int t = tile * 32 + 16 * tt + (lane & 15);
            const u32x2 uw = *(const u32x2*)(H0 + (size_t)(b * 2048 + t) * 2048 + g * 16 + 4 * q4);
            const float y0 = gelu_tanh(y[0] + dv[0] * bflo(uw.x)), y1 = gelu_tanh(y[1] + dv[1] * bfhi(uw.x)), y2 = gelu_tanh(y[2] + dv[2] * bflo(uw.y)), y3 = gelu_tanh(y[3] + dv[3] * bfhi(uw.y));
            u32x2 ow; ow.x = cvt_pk(y0, y1); ow.y = cvt_pk(y2, y3);
            *(u32x2*)(YS + (size_t)(b * 2048 + t) * 512 + g * 16 + 4 * q4) = ow;
        }
    }
}

constexpr int AT_K = 0, AT_V = 24576, AT_WS = 49152, AT_OST = 51200, AT_LUT = AT_OST + 8 * 4096  , AT_LUTB = 8704, AT_Q = AT_LUT + 8 * AT_LUTB  , AT_END = AT_Q + 64;
DEV int crow(int r, int hi) { return (r & 3) + 8 * (r >> 2) + 4 * hi; }
DEV s16x4 vtr(const LAS unsigned char* p) { typedef short v4i16_t __attribute__((ext_vector_type(4))); return __builtin_bit_cast(s16x4, __builtin_amdgcn_ds_read_tr16_b64_v4i16((LAS v4i16_t*)p)); }
DEV void moba_unit(Frame& F, int b, int h, int own) {
    const int lane = F.lane, wid = F.wave, r32 = lane & 31, hi = lane >> 5;
    LAS unsigned char* lds = F.lds;
    const bf16_t* H0 = WSP(bf16_t, W_HB); const float* KM = WSP(float, W_KM);
    LAS float* lut = (LAS float*)(lds + AT_LUT + h * AT_LUTB); LAS float* wsf = (LAS float*)(lds + AT_WS) + wid * 64;
    const size_t rowbase = (size_t)b * 2048;
    const int qpos = own * 256 + wid * 32 + r32;
    bf16x8 qr[4];
#pragma unroll
    for (int d0 = 0; d0 < 4; ++d0) qr[d0] = *(const bf16x8*)(H0 + (rowbase + qpos) * 2048 + 512 + h * 64 + d0 * 16 + hi * 8);
    unsigned selmask = 0u;
    if (own > 0) {
        float gate[7];
#pragma unroll
        for (int j = 0; j < 7; ++j) { float s = 0.f;
            if (j < own) { const float* km = KM + ((size_t)(b * 8 + h) * 8 + j) * 64 + hi * 8;
#pragma unroll
                for (int d0 = 0; d0 < 4; ++d0) { const f32x4 k0 = *(const f32x4*)(km + d0 * 16), k1 = *(const f32x4*)(km + d0 * 16 + 4); const u32x4 qw = __builtin_bit_cast(u32x4, qr[d0]);
                    s += bflo(qw.x) * k0.x + bfhi(qw.x) * k0.y + bflo(qw.y) * k0.z + bfhi(qw.y) * k0.w + bflo(qw.z) * k1.x + bfhi(qw.z) * k1.y + bflo(qw.w) * k1.z + bfhi(qw.w) * k1.w; } }
            gate[j] = s + swap32(s); }
#pragma unroll
        for (int j = 0; j < 7; ++j) { int rank = 0;
#pragma unroll
            for (int j2 = 0; j2 < 7; ++j2) if (j2 != j && j2 < own && (gate[j2] > gate[j] || (gate[j2] == gate[j] && j2 < j))) ++rank;
            if (j < own && rank < 3) selmask |= 1u << j; }
    }
    const int NT = 4 * (own + 1);
#define KV0(i) ((i) < 4 ? own * 256 + (i) * 64 : (((i) - 4) >> 2) * 256 + (((i) - 4) & 3) * 64)
    const bf16_t* kbase = H0 + (rowbase + lane) * 2048 + 1024 + h * 64 + wid * 8;
    const bf16_t* vbase = H0 + (rowbase + 16 * (wid & 3) + (lane >> 2)) * 2048 + 1536 + h * 64 + (wid >> 2) * 32 + (lane & 3) * 8;
#define LOADKV(i, bo_) do { const int kv0_ = KV0(i); \
        __builtin_amdgcn_global_load_lds((const unsigned*)(kbase + (size_t)kv0_ * 2048), (LAS unsigned*)(lds + AT_K + bo_ + wid * 1024), 16, 0, 0); \
        __builtin_amdgcn_global_load_lds((const unsigned*)(vbase + (size_t)kv0_ * 2048), (LAS unsigned*)(lds + AT_V + bo_ + wid * 1024), 16, 0, 0); } while (0)
    LOADKV(0, 0); LOADKV(1, 8192);
    int bo = 0, bo2 = 16384;
    float m_ref = 0.f, l_run = 0.f; f32x16 o[2];
#pragma unroll
    for (int r = 0; r < 16; ++r) { o[0][r] = 0.f; o[1][r] = 0.f; }
    const int Q0 = own * 256 + wid * 32;
#pragma unroll 1
    for (int i = 0; i < NT; ++i) {
        if (i + 1 < NT) asm volatile("s_waitcnt vmcnt(2) lgkmcnt(0)\n\ts_barrier" ::: "memory"); else asm volatile("s_waitcnt vmcnt(0) lgkmcnt(0)\n\ts_barrier" ::: "memory");
        if (i + 2 < NT) LOADKV(i + 2, bo2);
        const int kv0 = KV0(i);
        const bool ownblk = i < 4;
        if (!(ownblk && kv0 > Q0 + 31)) {
            const bool partial = ownblk && (kv0 + 63 > Q0);
            const bool rowsel = ownblk || ((selmask >> ((i - 4) >> 2)) & 1u);
            f32x16 p0, p1;
            { const LAS float* lp = lut + 128 + (qpos - kv0 - 4 * hi - 59);
#pragma unroll
              for (int r = 0; r < 16; ++r) { const int c = (r & 3) + 8 * (r >> 2); p0[r] = lp[59 - c] - m_ref; p1[r] = lp[59 - c - 32] - m_ref; } }
            { const LAS unsigned char* kb = lds + AT_K + bo + hi * 1024 + r32 * 16;
#pragma unroll
              for (int d0 = 0; d0 < 4; ++d0) { const bf16x8 k0 = *(const LAS bf16x8*)(kb + d0 * 2048), k1 = *(const LAS bf16x8*)(kb + d0 * 2048 + 512);
                  p0 = __builtin_amdgcn_mfma_f32_32x32x16_bf16(k0, qr[d0], p0, 0, 0, 0); p1 = __builtin_amdgcn_mfma_f32_32x32x16_bf16(k1, qr[d0], p1, 0, 0, 0); } }
            if (partial) { const int dbase = qpos - kv0 - 4 * hi;
#pragma unroll
                for (int r = 0; r < 16; ++r) { const int d0_ = dbase - ((r & 3) + 8 * (r >> 2)); p0[r] = d0_ >= 0 ? p0[r] : -INFINITY; p1[r] = d0_ >= 32 ? p1[r] : -INFINITY; } }
            float rmax = fmaxf(p0[0], p1[0]);
#pragma unroll
            for (int r = 1; r < 16; ++r) rmax = fmaxf(rmax, fmaxf(p0[r], p1[r]));
            rmax = fmaxf(rmax, swap32(rmax));
            rmax = rowsel ? rmax : -INFINITY;
            if (i == 0 || __any(rmax > 8.f)) {
                const float dl = (i == 0) ? rmax : fmaxf(rmax, 0.f); m_ref += dl;
#pragma unroll
                for (int r = 0; r < 16; ++r) { p0[r] -= dl; p1[r] -= dl; }
                const float alpha = __builtin_amdgcn_exp2f(-dl); l_run *= alpha;
                if (hi == 0) wsf[r32] = alpha;
#pragma unroll
                for (int r = 0; r < 16; ++r) { const float f = wsf[crow(r, hi)]; o[0][r] *= f; o[1][r] *= f; }
            }
            float rs = 0.f;
#pragma unroll
            for (int r = 0; r < 16; ++r) { p0[r] = __builtin_amdgcn_exp2f(p0[r]); p1[r] = __builtin_amdgcn_exp2f(p1[r]); rs += p0[r] + p1[r]; }
            l_run += rowsel ? rs : 0.f;
            const unsigned km = rowsel ? 0xffffffffu : 0u;
            u32x4 pw[4];
            pw[0] = (u32x4){cvt_pk(p0[0], p0[1]) & km, cvt_pk(p0[2], p0[3]) & km, cvt_pk(p0[4], p0[5]) & km, cvt_pk(p0[6], p0[7]) & km};
            pw[1] = (u32x4){cvt_pk(p0[8], p0[9]) & km, cvt_pk(p0[10], p0[11]) & km, cvt_pk(p0[12], p0[13]) & km, cvt_pk(p0[14], p0[15]) & km};
            pw[2] = (u32x4){cvt_pk(p1[0], p1[1]) & km, cvt_pk(p1[2], p1[3]) & km, cvt_pk(p1[4], p1[5]) & km, cvt_pk(p1[6], p1[7]) & km};
            pw[3] = (u32x4){cvt_pk(p1[8], p1[9]) & km, cvt_pk(p1[10], p1[11]) & km, cvt_pk(p1[12], p1[13]) & km, cvt_pk(p1[14], p1[15]) & km};
            { const LAS unsigned char* vp = lds + AT_V + bo + ((lane >> 4) & 1) * 32 + (lane & 3) * 8 + (4 * hi + ((lane & 15) >> 2)) * 64;
#pragma unroll
              for (int d0 = 0; d0 < 2; ++d0)
#pragma unroll
                  for (int ks = 0; ks < 4; ++ks) { const s16x4 lo = vtr(vp + d0 * 4096 + ks * 1024), hh = vtr(vp + d0 * 4096 + ks * 1024 + 512);
                      const bf16x8 vf = (bf16x8){lo[0], lo[1], lo[2], lo[3], hh[0], hh[1], hh[2], hh[3]};
                      o[d0] = __builtin_amdgcn_mfma_f32_32x32x16_bf16(__builtin_bit_cast(bf16x8, pw[ks]), vf, o[d0], 0, 0, 0); } }
        }
        bo = (bo == 16384) ? 0 : bo + 8192; bo2 = (bo2 == 16384) ? 0 : bo2 + 8192;
    }
    __syncthreads();
#undef KV0
#undef LOADKV
    l_run += swap32(l_run);
    if (hi == 0) wsf[32 + r32] = 1.f / l_run;
    bf16_t* Ow = WSP(bf16_t, W_Y0) + (rowbase + own * 256 + wid * 32) * 1024 + 512 + h * 64;
    LAS bf16_t* stg = (LAS bf16_t*)(lds + AT_OST) + wid * 2048;
#pragma unroll
    for (int r = 0; r < 16; ++r) { const int orow = crow(r, hi); const float rl = wsf[32 + orow];
        stg[orow * 64 + r32] = (bf16_t)(cvt_pk(o[0][r] * rl, 0.f) & 0xffffu); stg[orow * 64 + 32 + r32] = (bf16_t)(cvt_pk(o[1][r] * rl, 0.f) & 0xffffu); }
#pragma unroll
    for (int i = 0; i < 4; ++i) { const int row = i * 8 + (lane >> 3), ch = lane & 7; const u32x4 v = *(const LAS u32x4*)(stg + row * 64 + ch * 8); *(u32x4*)(Ow + (size_t)row * 1024 + ch * 8) = v; }
    __syncthreads();
}
constexpr int CW_MOBAQ = 64;
DEV void p_s5_moba(Frame& F, int mode) {
    if ((mode & 1) && (F.vcu & 3) == 3) { const int it = (F.vcu >> 2) * 8 + F.wave; if (it < 512) s5_item(F, it >> 5, it & 31, F.lds + 65536 + F.wave * 8192); }
    __syncthreads();
    if (!(mode & 2)) return;
    for (int i = F.tid; i < 8 * 2176; i += 512) { const int hh = i / 2176, j = i % 2176; ((LAS float*)(F.lds + AT_LUT))[i] = j < 128 ? 0.f : WSP(float, W_LUT)[hh * 2048 + j - 128]; }
    volatile LAS int* qw = (volatile LAS int*)(F.lds + AT_Q);
    unsigned* ctl = (unsigned*)(F.ws + W_CTL);
    for (;;) {
        __syncthreads();
        if (F.tid == 0) qw[0] = (int)__hip_atomic_fetch_add(ctl + CW_MOBAQ, 1u, __ATOMIC_RELAXED, __HIP_MEMORY_SCOPE_AGENT);
        __syncthreads();
        const int u = __builtin_amdgcn_readfirstlane(qw[0]);
        if (u >= 1024) break;
        const int own = 7 - (u >> 7), bh = u & 127;
        moba_unit(F, bh >> 3, bh & 7, own);
    }
}
constexpr size_t R_RE = W_ROUTE, R_RW = W_ROUTE + 512 * 1024, R_POS = W_ROUTE + 1024 * 1024, R_TOK = W_ROUTE + 2 * MiB, R_WGT = W_ROUTE + 3 * MiB;
constexpr int WT_PITCH = 1028;
constexpr int RW_PITCH = 1032;
constexpr int LN_XT = 32 * RW_PITCH * 2;
constexpr int LN_LG = 147456;
constexpr int LN_HIST = LN_LG + 8 * 528;
static_assert(LN_XT + 8 * 8256 <= LDS_TOK && LN_HIST + 128 <= LDSCTL_OFF, "LN LDS map");
template <int MODE, bool ROUTER, bool XIN_F32, bool OUT_F32, bool GRP = false>
DEV void p_ln(Frame& F, const float* xin32, const bf16_t* xinb, bf16_t* xoutb, float* xout32, const float* gam, const float* bet, const float* wrt, const float* brt) {
    LAS bf16_t* whi = (LAS bf16_t*)F.lds; LAS bf16_t* xt = (LAS bf16_t*)(F.lds + LN_XT) + F.wave * 4128; LAS float* lgs = (LAS float*)(F.lds + LN_LG) + F.wave * 132; LAS int* hist = (LAS int*)(F.lds + LN_HIST);
    const int lane = F.lane, l15 = lane & 15, q4 = lane >> 4;
    if constexpr (ROUTER) {
        for (int i = F.tid; i < 1024 * 32; i += 512) { const int k = i >> 5, e = i & 31; whi[e * RW_PITCH + k] = (bf16_t)(cvt_pk(wrt[i], 0.f) & 0xffffu); }
        if (F.tid < 32) hist[F.tid] = 0;
        __syncthreads();
    }
    if constexpr (GRP) {
        const u32x4* src = (const u32x4*)(WSP(bf16_t, W_IN1) + (size_t)3072 * 1024);
        for (int i = F.tid; i < 16 * 128; i += 512) { const int e = i >> 7, c = i & 127; *(LAS u32x4*)(whi + e * RW_PITCH + c * 8) = src[i]; }
        __syncthreads();
    }
    const bf16_t* MIXB = WSP(bf16_t, W_MIXB); const bf16_t* YS = WSP(bf16_t, W_YS); const int* POS = WSP(int, R_POS);
    int* RE = WSP(int, R_RE); float* RW = WSP(float, R_RW);
    const float alpha = 1.4142135623730951f;
    f32x4 gq[4], bq[4];
#pragma unroll
    for (int j = 0; j < 4; ++j) { gq[j] = *(const f32x4*)(gam + j * 256 + lane * 4); bq[j] = *(const f32x4*)(bet + j * 256 + lane * 4); }
    float bias8[8];
    if constexpr (ROUTER) {
#pragma unroll
        for (int r = 0; r < 8; ++r) bias8[r] = brt[(r >> 2) * 16 + 4 * q4 + (r & 3)]; }
    for (int wgi = F.vcu; wgi < 256; wgi += F.G) {
        const int r0 = wgi * 128 + F.wave * 16;
        constexpr bool PF = (MODE == 0) && !XIN_F32;
        u32x2 rx[4][4], rm[4][4];
        if constexpr (PF) {
#pragma unroll
            for (int u = 0; u < 4; ++u)
#pragma unroll
                for (int j = 0; j < 4; ++j) { rx[u][j] = *(const u32x2*)(xinb + (size_t)(r0 + u) * 1024 + j * 256 + lane * 4); rm[u][j] = *(const u32x2*)(MIXB + (size_t)(r0 + u) * 1024 + j * 256 + lane * 4); } }
#pragma unroll 1
        for (int i4 = 0; i4 < 16; i4 += 4) {
            float v[4][16];
            if constexpr (PF) {
#pragma unroll
                for (int u = 0; u < 4; ++u)
#pragma unroll
                    for (int j = 0; j < 4; ++j) { v[u][4 * j] = alpha * bflo(rx[u][j].x) + bflo(rm[u][j].x); v[u][4 * j + 1] = alpha * bfhi(rx[u][j].x) + bfhi(rm[u][j].x); v[u][4 * j + 2] = alpha * bflo(rx[u][j].y) + bflo(rm[u][j].y); v[u][4 * j + 3] = alpha * bfhi(rx[u][j].y) + bfhi(rm[u][j].y); }
                if (i4 + 4 < 16) {
#pragma unroll
                    for (int u = 0; u < 4; ++u)
#pragma unroll
                        for (int j = 0; j < 4; ++j) { rx[u][j] = *(const u32x2*)(xinb + (size_t)(r0 + i4 + 4 + u) * 1024 + j * 256 + lane * 4); rm[u][j] = *(const u32x2*)(MIXB + (size_t)(r0 + i4 + 4 + u) * 1024 + j * 256 + lane * 4); } }
            } else {
#pragma unroll
            for (int u = 0; u < 4; ++u) { const int row = r0 + i4 + u;
                if constexpr (XIN_F32) {
#pragma unroll
                    for (int j = 0; j < 4; ++j) { const f32x4 a = *(const f32x4*)(xin32 + (size_t)row * 1024 + j * 256 + lane * 4); v[u][4 * j] = alpha * a.x; v[u][4 * j + 1] = alpha * a.y; v[u][4 * j + 2] = alpha * a.z; v[u][4 * j + 3] = alpha * a.w; }
                } else {
#pragma unroll
                    for (int j = 0; j < 4; ++j) { const u32x2 a = *(const u32x2*)(xinb + (size_t)row * 1024 + j * 256 + lane * 4); v[u][4 * j] = alpha * bflo(a.x); v[u][4 * j + 1] = alpha * bfhi(a.x); v[u][4 * j + 2] = alpha * bflo(a.y); v[u][4 * j + 3] = alpha * bfhi(a.y); }
                }
                if constexpr (MODE == 0) {
#pragma unroll
                    for (int j = 0; j < 4; ++j) { const u32x2 m = *(const u32x2*)(MIXB + (size_t)row * 1024 + j * 256 + lane * 4); v[u][4 * j] += bflo(m.x); v[u][4 * j + 1] += bfhi(m.x); v[u][4 * j + 2] += bflo(m.y); v[u][4 * j + 3] += bfhi(m.y); }
                } else {
                    const int4 pos4 = *(const int4*)(POS + row * 4);
                    const int ps[4] = {__builtin_amdgcn_readfirstlane(pos4.x), __builtin_amdgcn_readfirstlane(pos4.y), __builtin_amdgcn_readfirstlane(pos4.z), __builtin_amdgcn_readfirstlane(pos4.w)};
#pragma unroll
                    for (int kx = 0; kx < 4; ++kx)
#pragma unroll
                        for (int j = 0; j < 4; ++j) { const u32x2 m = *(const u32x2*)(YS + (size_t)ps[kx] * 1024 + j * 256 + lane * 4); v[u][4 * j] += bflo(m.x); v[u][4 * j + 1] += bfhi(m.x); v[u][4 * j + 2] += bflo(m.y); v[u][4 * j + 3] += bfhi(m.y); }
                }
            }
            }
            float s1[4], s2[4];
#pragma unroll
            for (int u = 0; u < 4; ++u) { s1[u] = 0.f; s2[u] = 0.f;
#pragma unroll
                for (int q = 0; q < 16; ++q) { s1[u] += v[u][q]; s2[u] = fmaf(v[u][q], v[u][q], s2[u]); } }
#pragma unroll
            for (int o = 1; o < 64; o <<= 1) {
#pragma unroll
                for (int u = 0; u < 4; ++u) { s1[u] += __shfl_xor(s1[u], o); s2[u] += __shfl_xor(s2[u], o); } }
#pragma unroll
            for (int u = 0; u < 4; ++u) { const int row = r0 + i4 + u; const float mean = s1[u] * (1.f / 1024.f); const float var = fmaxf(s2[u] * (1.f / 1024.f) - mean * mean, 0.f); const float rstd = 1.f / sqrtf(var + 1e-5f);
#pragma unroll
                for (int j = 0; j < 4; ++j) { const int c = j * 256 + lane * 4; const f32x4 g4 = gq[j], b4 = bq[j];
                    const float y0 = (v[u][4 * j] - mean) * rstd * g4.x + b4.x, y1 = (v[u][4 * j + 1] - mean) * rstd * g4.y + b4.y, y2 = (v[u][4 * j + 2] - mean) * rstd * g4.z + b4.z, y3 = (v[u][4 * j + 3] - mean) * rstd * g4.w + b4.w;
                    if constexpr (OUT_F32) *(f32x4*)(xout32 + (size_t)row * 1024 + c) = (f32x4){y0, y1, y2, y3};
                    else { u32x2 w; w.x = cvt_pk(y0, y1); w.y = cvt_pk(y2, y3); *(u32x2*)(xoutb + (size_t)row * 1024 + c) = w;
                        if constexpr (ROUTER || GRP) { *(LAS u32x2*)(xt + u * RW_PITCH + c) = w; } } } }
            if constexpr (GRP) {
                f32x4 ga = {0.f, 0.f, 0.f, 0.f};
#pragma unroll 8
                for (int ks = 0; ks < 32; ++ks) { const bf16x8 xb = *(const LAS bf16x8*)(xt + (l15 & 3) * RW_PITCH + ks * 32 + q4 * 8), wa = *(const LAS bf16x8*)(whi + l15 * RW_PITCH + ks * 32 + q4 * 8);
                    ga = __builtin_amdgcn_mfma_f32_16x16x32_bf16(wa, xb, ga, 0, 0, 0); }
                if (l15 < 4) *(f32x4*)(WSP(float, W_GR) + (size_t)(r0 + i4 + l15) * 16 + 4 * q4) = ga; }
            if constexpr (ROUTER) {
                f32x4 acc[2] = {{0.f, 0.f, 0.f, 0.f}, {0.f, 0.f, 0.f, 0.f}};
#pragma unroll 8
                for (int ks = 0; ks < 32; ++ks) { const bf16x8 xb = *(const LAS bf16x8*)(xt + (l15 & 3) * RW_PITCH + ks * 32 + q4 * 8);
#pragma unroll
                    for (int mt = 0; mt < 2; ++mt) { const bf16x8 wa = *(const LAS bf16x8*)(whi + (mt * 16 + l15) * RW_PITCH + ks * 32 + q4 * 8); acc[mt] = __builtin_amdgcn_mfma_f32_16x16x32_bf16(wa, xb, acc[mt], 0, 0, 0); } }
                if (l15 < 4) {
#pragma unroll
                    for (int mt = 0; mt < 2; ++mt)
#pragma unroll
                        for (int r = 0; r < 4; ++r) lgs[l15 * 33 + mt * 16 + 4 * q4 + r] = acc[mt][r] + bias8[mt * 4 + r]; }
                if (lane < 4) { float lg[32];
#pragma unroll
                    for (int e = 0; e < 32; ++e) lg[e] = lgs[lane * 33 + e];
                    unsigned taken = 0u; float tv[4]; int ti[4];
#pragma unroll
                    for (int r = 0; r < 4; ++r) { float best = -INFINITY; int bi = 0;
#pragma unroll
                        for (int e = 0; e < 32; ++e) { const bool ok = !((taken >> e) & 1u) && lg[e] > best; best = ok ? lg[e] : best; bi = ok ? e : bi; }
                        taken |= 1u << bi; tv[r] = best; ti[r] = bi; }
                    float ex[4], sm = 0.f;
#pragma unroll
                    for (int r = 0; r < 4; ++r) { ex[r] = __expf(tv[r] - tv[0]); sm += ex[r]; }
                    const float inv = 1.f / sm; const int row = r0 + i4 + lane;
                    *(int4*)(RE + row * 4) = make_int4(ti[0], ti[1], ti[2], ti[3]); *(f32x4*)(RW + row * 4) = (f32x4){ex[0] * inv, ex[1] * inv, ex[2] * inv, ex[3] * inv};
#pragma unroll
                    for (int r = 0; r < 4; ++r) atomicAdd((int*)(hist + ti[r]), 1); }
            }
        }
        if constexpr (ROUTER) { __syncthreads(); if (F.tid < 32) { WSP(int, W_HIST)[wgi * 32 + F.tid] = hist[F.tid]; hist[F.tid] = 0; } __syncthreads(); }
    }
}

DEV void p_sort(Frame& F) {
    LAS int* Ls = (LAS int*)F.lds; const int tid = F.tid;
    const int* HIST = WSP(int, W_HIST); int* SORT = WSP(int, W_SORT);
    const int* RE = WSP(int, R_RE); const float* RW = WSP(float, R_RW); int* POS = WSP(int, R_POS); int* TOK = WSP(int, R_TOK); float* WGT = WSP(float, R_WGT);
    for (int wgi = F.vcu; wgi < 256; wgi += F.G) {
        { const int e = tid & 31, part = tid >> 5; int tot = 0, pre = 0;
          for (int w = part * 16; w < part * 16 + 16; ++w) { const int hh = HIST[w * 32 + e]; tot += hh; pre += (w < wgi) ? hh : 0; }
          Ls[part * 32 + e] = tot; Ls[512 + part * 32 + e] = pre; }
        Ls[2048 + tid] = RE[wgi * 512 + tid];
        __syncthreads();
        if (tid < 32) { int tot = 0, pre = 0; for (int p = 0; p < 16; ++p) { tot += Ls[p * 32 + tid]; pre += Ls[512 + p * 32 + tid]; } Ls[1200 + tid] = tot; Ls[1300 + tid] = pre; }
        __syncthreads();
        if (tid == 0) { int a = 0; for (int e = 0; e < 32; ++e) { Ls[1024 + e] = a; a += (Ls[1200 + e] + 255) / 256 * 256; } Ls[1056] = a; }
        __syncthreads();
        { const int e = tid & 31, seg = tid >> 5; int cnt = 0;
#pragma unroll 8
          for (int i = 0; i < 32; ++i) cnt += (Ls[2048 + seg * 32 + i] == e) ? 1 : 0;
          Ls[3072 + seg * 32 + e] = cnt;
          __syncthreads();
          int c = Ls[1024 + e] + Ls[1300 + e];
          for (int s2 = 0; s2 < seg; ++s2) c += Ls[3072 + s2 * 32 + e];
#pragma unroll 8
          for (int i = 0; i < 32; ++i) if (Ls[2048 + seg * 32 + i] == e) { Ls[2560 + seg * 32 + i] = c; ++c; } }
        __syncthreads();
        { const int pos = Ls[2560 + tid]; TOK[pos] = wgi * 128 + (tid >> 2); WGT[pos] = RW[wgi * 512 + tid]; POS[wgi * 512 + tid] = pos; }
        { const bf16_t* XBBp = WSP(bf16_t, W_XBB); unsigned char* XS8 = WSP(unsigned char, W_X8);
          for (int rg = 0; rg < 16; rg += 4) {
              u32x4 a[4], b2[4];
#pragma unroll
              for (int u = 0; u < 4; ++u) { const int r = F.wave * 16 + rg + u; const u32x4* src = (const u32x4*)(XBBp + (size_t)(wgi * 128 + r) * 1024 + F.lane * 16); a[u] = src[0]; b2[u] = src[1]; }
#pragma unroll
              for (int u = 0; u < 4; ++u) { const int r = F.wave * 16 + rg + u;
                  u32x4 o; o.x = pk4_fp8(bflo(a[u].x) * 16.f, bfhi(a[u].x) * 16.f, bflo(a[u].y) * 16.f, bfhi(a[u].y) * 16.f); o.y = pk4_fp8(bflo(a[u].z) * 16.f, bfhi(a[u].z) * 16.f, bflo(a[u].w) * 16.f, bfhi(a[u].w) * 16.f);
                  o.z = pk4_fp8(bflo(b2[u].x) * 16.f, bfhi(b2[u].x) * 16.f, bflo(b2[u].y) * 16.f, bfhi(b2[u].y) * 16.f); o.w = pk4_fp8(bflo(b2[u].z) * 16.f, bfhi(b2[u].z) * 16.f, bflo(b2[u].w) * 16.f, bfhi(b2[u].w) * 16.f);
#pragma unroll
                  for (int kx = 0; kx < 4; ++kx) { const int pos = Ls[2560 + r * 4 + kx]; *(u32x4*)(XS8 + (size_t)pos * 1024 + F.lane * 16) = o; } } }
          if (wgi < 32) { const int e = wgi; for (int r = Ls[1024 + e] + Ls[1200 + e] + F.wave; r < Ls[1024 + e + 1]; r += 8) *(u32x4*)(XS8 + (size_t)r * 1024 + F.lane * 16) = (u32x4){0u, 0u, 0u, 0u}; } }
        if (wgi < 32) { const int e = wgi; for (int r = Ls[1024 + e] + Ls[1200 + e] + tid; r < Ls[1024 + e + 1]; r += 512) { TOK[r] = 0; WGT[r] = 0.f; } }
        if (wgi == 0) { if (tid < 33) SORT[tid] = Ls[1024 + tid]; if (tid == 0) SORT[33] = Ls[1056] / 256;
            for (int pm = tid; pm < PMAX / 256; pm += 512) { int e = 0; for (int j = 1; j < 32; ++j) if (pm * 256 >= Ls[1024 + j]) e = j; SORT[64 + pm] = e; } }
        __syncthreads();
    }
}

DEV void p_gr(Frame& F) {
    const int gw = F.vcu * 8 + F.wave, NGW = F.G * 8, lane = F.lane, q4 = lane >> 4; const bf16_t* XB = WSP(bf16_t, W_XB); const bf16_t* Wg = WSP(bf16_t, W_IN1) + (size_t)3072 * 1024; float* GR = WSP(float, W_GR);
    for (int it = gw; it < T / 16; it += NGW) { f32x4 acc = {0.f, 0.f, 0.f, 0.f};
        const bf16_t* ap = XB + (size_t)(it * 16 + (lane & 15)) * 1024 + q4 * 8; const bf16_t* bp = Wg + (size_t)(lane & 15) * 1024 + q4 * 8;
        bf16x8 a[32], bb[32];
#pragma unroll
        for (int ks = 0; ks < 32; ++ks) { a[ks] = *(const bf16x8*)(ap + ks * 32); bb[ks] = *(const bf16x8*)(bp + ks * 32); }
#pragma unroll
        for (int ks = 0; ks < 32; ++ks) acc = __builtin_amdgcn_mfma_f32_16x16x32_bf16(a[ks], bb[ks], acc, 0, 0, 0);
#pragma unroll
        for (int r = 0; r < 4; ++r) GR[(size_t)(it * 16 + 4 * q4 + r) * 16 + (lane & 15)] = acc[r]; }
}

constexpr int GP = 264, GP2 = 144;
constexpr int GB_QIN = 0, GB_KST = 16896, GB_ATT = 35328, GB_DEC = 44544, GB_VT = 45056, GB_SIZE = 81920;
constexpr size_t W_GB = W_YS;
static_assert((size_t)2048 * GB_SIZE <= (size_t)PMAX * 2048, "blob region");
constexpr int GA_GRS = 0, GA_GT = 4096, GA_BL = 8192  , GA_QIN = GA_BL + GB_QIN, GA_KST = GA_BL + GB_KST, GA_ATT = GA_BL + GB_ATT, GA_DEC = GA_BL + GB_DEC, GA_KIN = GA_BL + 45056  , GA_VT = GA_KIN + 17408, GA_END = GA_VT + 36864;
DEV float logsigm_fast(float z) { const float e = __builtin_amdgcn_exp2f(-1.4426950408889634f * fabsf(z)); return fminf(z, 0.f) - 0.6931471805599453f * __builtin_amdgcn_logf(1.f + e); }
struct GlaRaw { unsigned q[16], k[16], v[32]; f32x4 ga, gb; };
DEV void p_gla_prep(Frame& F) {
    LAS unsigned char* lds = F.lds; const int tid = F.tid, lane = F.lane, wid = F.wave, q4 = lane >> 4, l15 = lane & 15;
    const bf16_t* H1 = WSP(bf16_t, W_HB); const float* GR = WSP(float, W_GR); unsigned char* GB = F.ws + W_GB;
    const float* wg2 = F.in[15]; const float* bg = F.in[16];
    for (int i = tid; i < 64 * GP2 / 4; i += 512) ((LAS unsigned*)(lds + GA_ATT))[i] = 0u;
    const int dk = 32 * (wid & 3) + (lane & 31), tg = 2 * (wid >> 2) + (lane >> 5);
    const int dvl = tid & 255, th2 = tid >> 8;
    const int tzm = 16 * (((lane & 31) >> 2) & 1) + 4 * ((lane & 31) >> 3) + (lane & 3);
    for (int wg = F.vcu; wg < 256; wg += F.G) {
        const int b = wg >> 4, h = (wg >> 2) & 3, n0 = (wg & 3) * 8;
        bf16x8 w2f; { float wv[8];
#pragma unroll
          for (int j = 0; j < 8; ++j) wv[j] = wg2[(8 * (lane >> 5) + j) * 512 + h * 128 + dk];
          const u32x4 ww = {cvt_pk(wv[0], wv[1]), cvt_pk(wv[2], wv[3]), cvt_pk(wv[4], wv[5]), cvt_pk(wv[6], wv[7])}; w2f = __builtin_bit_cast(bf16x8, ww); }
        const float bgv = bg[h * 128 + dk];
#define GLA_LOAD(R, n_) do { const size_t rb_ = (size_t)b * 2048 + (n_) * 64; \
        _Pragma("unroll") for (int i = 0; i < 16; ++i) { const size_t ro = (rb_ + 16 * tg + i) * 3072; R.q[i] = H1[ro + h * 128 + dk]; R.k[i] = H1[ro + 512 + h * 128 + dk]; } \
        _Pragma("unroll") for (int i = 0; i < 32; ++i) R.v[i] = H1[(rb_ + 32 * th2 + i) * 3072 + 1024 + h * 256 + dvl]; \
        { const float* gp_ = GR + (rb_ + 32 * (wid >> 2) + tzm) * 16 + 8 * (lane >> 5); R.ga = *(const f32x4*)gp_; R.gb = *(const f32x4*)(gp_ + 4); } } while (0)
        GlaRaw cur, nxt; GLA_LOAD(cur, n0); nxt = cur;
#pragma unroll 1
      for (int sub = 0; sub < 8; ++sub) { const int n = n0 + sub;
        if (sub + 1 < 8) GLA_LOAD(nxt, n + 1);
        float cs[16]; float run = 0.f;
        { const u32x4 aw = {cvt_pk(cur.ga.x, cur.ga.y), cvt_pk(cur.ga.z, cur.ga.w), cvt_pk(cur.gb.x, cur.gb.y), cvt_pk(cur.gb.z, cur.gb.w)};
          f32x16 zz;
#pragma unroll
          for (int r = 0; r < 16; ++r) zz[r] = bgv;
          zz = __builtin_amdgcn_mfma_f32_32x32x16_bf16(__builtin_bit_cast(bf16x8, aw), w2f, zz, 0, 0, 0);
#pragma unroll
          for (int i = 0; i < 16; ++i) { run += logsigm_fast(zz[i]) * (1.f / 16.f); cs[i] = run; } }
        ((LAS float*)(lds + GA_GT))[tg * 128 + dk] = run;
        __syncthreads();
        float off = 0.f, btot = 0.f;
#pragma unroll
        for (int g2 = 0; g2 < 4; ++g2) { const float gtv = ((LAS float*)(lds + GA_GT))[g2 * 128 + dk]; btot += gtv; off += (g2 < tg) ? gtv : 0.f; }
        if (tg == 0) ((LAS float*)(lds + GA_DEC))[dk] = __expf(btot);
        { unsigned kst[8];
#pragma unroll
          for (int i = 0; i < 16; i += 2) { float kk[2];
#pragma unroll
              for (int u = 0; u < 2; ++u) { const int t = 16 * tg + i + u; const float bc = cs[i + u] + off; const float qv = bflo(cur.q[i + u]), kv = bflo(cur.k[i + u]);
                  *(LAS bf16_t*)(lds + GA_QIN + t * GP + dk * 2) = (bf16_t)(cvt_pk(qv * __expf(bc), 0.f) & 0xffffu);
                  *(LAS bf16_t*)(lds + GA_KIN + t * 272 + dk * 2) = (bf16_t)(cvt_pk(kv * __expf(-bc), 0.f) & 0xffffu);
                  kk[u] = kv * __expf(btot - bc); }
              kst[i >> 1] = cvt_pk(kk[0], kk[1]); }
          *(LAS u32x4*)(lds + GA_KST + dk * GP2 + tg * 32) = (u32x4){kst[0], kst[1], kst[2], kst[3]};
          *(LAS u32x4*)(lds + GA_KST + dk * GP2 + tg * 32 + 16) = (u32x4){kst[4], kst[5], kst[6], kst[7]}; }
#pragma unroll
        for (int i = 0; i < 32; i += 8) *(LAS u32x4*)(lds + GA_VT + dvl * GP2 + (32 * th2 + i) * 2) = (u32x4){cur.v[i] | (cur.v[i + 1] << 16), cur.v[i + 2] | (cur.v[i + 3] << 16), cur.v[i + 4] | (cur.v[i + 5] << 16), cur.v[i + 6] | (cur.v[i + 7] << 16)};
        __syncthreads();
#pragma unroll
        for (int rep = 0; rep < 2; ++rep) { const int ti = wid + 8 * rep; if (ti < 10) {
            int jt, it2; if (ti < 4) { jt = 0; it2 = ti; } else if (ti < 7) { jt = 1; it2 = ti - 3; } else if (ti < 9) { jt = 2; it2 = ti - 5; } else { jt = 3; it2 = 3; }
            f32x4 a4 = {0.f, 0.f, 0.f, 0.f};
#pragma unroll
            for (int ks = 0; ks < 4; ++ks) { const bf16x8 kf = *(const LAS bf16x8*)(lds + GA_KIN + (16 * jt + l15) * 272 + ks * 64 + q4 * 16); const u32x2 q0_ = *(const LAS u32x2*)(lds + GA_QIN + (16 * it2 + l15) * GP + ks * 64 + q4 * 16), q1_ = *(const LAS u32x2*)(lds + GA_QIN + (16 * it2 + l15) * GP + ks * 64 + q4 * 16 + 8); const bf16x8 qf = __builtin_bit_cast(bf16x8, (u32x4){q0_.x, q0_.y, q1_.x, q1_.y});
                a4 = __builtin_amdgcn_mfma_f32_16x16x32_bf16(kf, qf, a4, 0, 0, 0); }
            const int i_ = 16 * it2 + l15, j0 = 16 * jt + 4 * q4;
            u32x2 w; w.x = cvt_pk(j0 <= i_ ? a4[0] : 0.f, j0 + 1 <= i_ ? a4[1] : 0.f); w.y = cvt_pk(j0 + 2 <= i_ ? a4[2] : 0.f, j0 + 3 <= i_ ? a4[3] : 0.f);
            *(LAS u32x2*)(lds + GA_ATT + i_ * GP2 + j0 * 2) = w; } }
        __syncthreads();
        unsigned char* blob = GB + (size_t)((b * 32 + n) * 4 + h) * GB_SIZE;
        for (int c = tid; c < 45056 / 16; c += 512) *(u32x4*)(blob + c * 16) = *(const LAS u32x4*)(lds + GA_BL + c * 16);
        for (int c = tid; c < 36864 / 16; c += 512) *(u32x4*)(blob + GB_VT + c * 16) = *(const LAS u32x4*)(lds + GA_VT + c * 16);
        cur = nxt;
      }
#undef GLA_LOAD
    }
}
constexpr int GS_BUF = 54272;
constexpr int GS_VT = 0, GS_QIN = 9216, GS_KST = GS_QIN + 16896, GS_ATT = GS_KST + 18432, GS_DEC = GS_ATT + 9216;
static_assert(3 * GS_BUF <= LDSCTL_OFF, "GLA ring");
DEV void gla_scan_item(Frame& F, int b, int h, int c4) {
    LAS unsigned char* lds = F.lds; const int lane = F.lane, wid = F.wave, q4 = lane >> 4, l15 = lane & 15;
    bf16_t* GO = WSP(bf16_t, W_GLAO); float* SS = WSP(float, W_SS); const unsigned char* GB = F.ws + W_GB;
    const int c16 = wid & 3, th = wid >> 2;
    f32x4 sacc[8];
#pragma unroll
    for (int m = 0; m < 8; ++m) sacc[m] = (f32x4){0.f, 0.f, 0.f, 0.f};
    const size_t rb = (size_t)b * 2048;
    float sqv[2][4]; unsigned ov[2][4];
#pragma unroll
    for (int mt = 0; mt < 2; ++mt)
#pragma unroll
        for (int r = 0; r < 4; ++r) { sqv[mt][r] = 0.f; ov[mt][r] = 0u; }
    const int npc = (wid < 5) ? 7 : 6;
#define GS_ISSUE(n_, bo_) do { const unsigned char* blob_ = GB + (size_t)((b * 32 + (n_)) * 4 + h) * GB_SIZE; \
        for (int p_ = wid; p_ < 53; p_ += 8) { const int so_ = p_ < 9 ? GB_VT + c4 * 9216 + p_ * 1024 : (p_ - 9) * 1024; \
            __builtin_amdgcn_global_load_lds((const unsigned*)(blob_ + so_ + lane * 16), (LAS unsigned*)(lds + (bo_) + p_ * 1024), 16, 0, 0); } } while (0)
    GS_ISSUE(0, 0); GS_ISSUE(1, GS_BUF);
    int bo = 0, bo2 = 2 * GS_BUF;
#pragma unroll 1
    for (int n = 0; n < 32; ++n) { const int t0 = n * 64;
        if (n + 1 < 32) { if (npc == 7) asm volatile("s_waitcnt vmcnt(7) lgkmcnt(0)\n\ts_barrier" ::: "memory"); else asm volatile("s_waitcnt vmcnt(6) lgkmcnt(0)\n\ts_barrier" ::: "memory"); } else asm volatile("s_waitcnt vmcnt(0) lgkmcnt(0)\n\ts_barrier" ::: "memory");
        if (n > 0) {
#pragma unroll
            for (int mt = 0; mt < 2; ++mt)
#pragma unroll
                for (int r = 0; r < 4; ++r) { const size_t trow = rb + (t0 - 64) + 32 * th + 16 * mt + 4 * q4 + r; GO[trow * 1024 + h * 256 + c4 * 64 + c16 * 16 + l15] = (bf16_t)ov[mt][r];
                    SS[(trow * 4 + h) * 16 + c4 * 4 + c16] = sqv[mt][r]; } }
        if (n + 2 < 32) GS_ISSUE(n + 2, bo2);
        const LAS unsigned char* bu = lds + bo;
        bf16x8 vf[2];
#pragma unroll
        for (int ks = 0; ks < 2; ++ks) vf[ks] = *(const LAS bf16x8*)(bu + GS_VT + (c16 * 16 + l15) * GP2 + ks * 64 + q4 * 16);
        bf16x8 sf[4];
#pragma unroll
        for (int ks = 0; ks < 4; ++ks) { const u32x4 w = {cvt_pk(sacc[2 * ks][0], sacc[2 * ks][1]), cvt_pk(sacc[2 * ks][2], sacc[2 * ks][3]), cvt_pk(sacc[2 * ks + 1][0], sacc[2 * ks + 1][1]), cvt_pk(sacc[2 * ks + 1][2], sacc[2 * ks + 1][3])}; sf[ks] = __builtin_bit_cast(bf16x8, w); }
#pragma unroll
        for (int mt = 0; mt < 2; ++mt) { const int i_ = 32 * th + 16 * mt + l15; f32x4 oa = {0.f, 0.f, 0.f, 0.f};
#pragma unroll
            for (int ks = 0; ks < 2; ++ks) { if (ks == 1 && th == 0) continue; const bf16x8 af = *(const LAS bf16x8*)(bu + GS_ATT + i_ * GP2 + ks * 64 + q4 * 16); oa = __builtin_amdgcn_mfma_f32_16x16x32_bf16(af, vf[ks], oa, 0, 0, 0); }
#pragma unroll
            for (int ks = 0; ks < 4; ++ks) { const u32x2 lo = *(const LAS u32x2*)(bu + GS_QIN + i_ * GP + (32 * ks + 4 * q4) * 2), hi2 = *(const LAS u32x2*)(bu + GS_QIN + i_ * GP + (32 * ks + 16 + 4 * q4) * 2);
                const u32x4 w = {lo.x, lo.y, hi2.x, hi2.y}; oa = __builtin_amdgcn_mfma_f32_16x16x32_bf16(__builtin_bit_cast(bf16x8, w), sf[ks], oa, 0, 0, 0); }
#pragma unroll
            for (int r = 0; r < 4; ++r) { ov[mt][r] = cvt_pk(oa[r], 0.f) & 0xffffu; float sq = oa[r] * oa[r]; sq += __shfl_xor(sq, 1); sq += __shfl_xor(sq, 2); sq += __shfl_xor(sq, 4); sq += __shfl_xor(sq, 8); sqv[mt][r] = sq; } }
#pragma unroll
        for (int md = 0; md < 8; ++md) { const f32x4 dc = *(const LAS f32x4*)(bu + GS_DEC + (16 * md + 4 * q4) * 4); sacc[md] = sacc[md] * dc;
#pragma unroll
            for (int ks = 0; ks < 2; ++ks) { const bf16x8 kf = *(const LAS bf16x8*)(bu + GS_KST + (16 * md + l15) * GP2 + ks * 64 + q4 * 16); sacc[md] = __builtin_amdgcn_mfma_f32_16x16x32_bf16(kf, vf[ks], sacc[md], 0, 0, 0); } }
        bo = (bo == 2 * GS_BUF) ? 0 : bo + GS_BUF; bo2 = (bo2 == 2 * GS_BUF) ? 0 : bo2 + GS_BUF;
    }
#undef GS_ISSUE
#pragma unroll
    for (int mt = 0; mt < 2; ++mt)
#pragma unroll
        for (int r = 0; r < 4; ++r) { const size_t trow = rb + 31 * 64 + 32 * th + 16 * mt + 4 * q4 + r; GO[trow * 1024 + h * 256 + c4 * 64 + c16 * 16 + l15] = (bf16_t)ov[mt][r]; SS[(trow * 4 + h) * 16 + c4 * 4 + c16] = sqv[mt][r]; }
    asm volatile("s_waitcnt vmcnt(0)" ::: "memory");
    __syncthreads();
}
DEV void p_gla_scan(Frame& F) { for (int v = F.vcu; v < 256; v += F.G) gla_scan_item(F, v >> 4, (v >> 2) & 3, v & 3); }

DEV void p_gla_norm(Frame& F) {
    const int gw = F.vcu * 8 + F.wave, NGW = F.G * 8, lane = F.lane; const bf16_t* GO = WSP(bf16_t, W_GLAO); const float* SS = WSP(float, W_SS); const bf16_t* H1 = WSP(bf16_t, W_HB); bf16_t* Y0 = WSP(bf16_t, W_Y0);
    const f32x4 nw = *(const f32x4*)(F.in[17] + lane * 4);
    for (int row = gw; row < T; row += NGW) {
#pragma unroll
        for (int h = 0; h < 4; ++h) { const float* sp = SS + ((size_t)row * 4 + h) * 16; const f32x4 a = *(const f32x4*)sp, b2 = *(const f32x4*)(sp + 4), c = *(const f32x4*)(sp + 8), d = *(const f32x4*)(sp + 12);
            const float sq = (a.x + a.y + a.z + a.w) + (b2.x + b2.y + b2.z + b2.w) + (c.x + c.y + c.z + c.w) + (d.x + d.y + d.z + d.w); const float r = 1.f / sqrtf(sq * (1.f / 256.f) + 1e-5f);
            const u32x2 o = *(const u32x2*)(GO + (size_t)row * 1024 + h * 256 + lane * 4); const u32x2 g = *(const u32x2*)(H1 + (size_t)row * 3072 + 2048 + h * 256 + lane * 4);
            const float g0 = bflo(g.x), g1 = bfhi(g.x), g2 = bflo(g.y), g3 = bfhi(g.y);
            u32x2 w; w.x = cvt_pk(bflo(o.x) * r * nw.x * g0 * fast_sigm(g0), bfhi(o.x) * r * nw.y * g1 * fast_sigm(g1)); w.y = cvt_pk(bflo(o.y) * r * nw.z * g2 * fast_sigm(g2), bfhi(o.y) * r * nw.w * g3 * fast_sigm(g3));
            *(u32x2*)(Y0 + (size_t)row * 1024 + h * 256 + lane * 4) = w; } }
}
struct FStoreScale { bf16_t* O; int ldc, c_lo, c_hi; float sc; static constexpr int NSIDE = 0;
    DEV const void* side(const Unit&, int) const { return nullptr; }
    DEV NoPre pre(const Unit&, int, const LAS float*) const { return NoPre{}; }
    DEV void operator()(const Unit&, int row, int col, f32x4 v0, f32x4 v1, NoPre, const LAS float*) const { const float s = (col >= c_lo && col < c_hi) ? sc : 1.f;
        const u32x4 w = {cvt_pk(v0[0] * s, v0[1] * s), cvt_pk(v0[2] * s, v0[3] * s), cvt_pk(v1[0] * s, v1[1] * s), cvt_pk(v1[2] * s, v1[3] * s)}; *(u32x4*)(O + (size_t)row * ldc + col) = w; } };
struct Pre8 { f32x4 b0, b1; };
struct FGlu { const bf16_t* Y; bf16_t* O; const float* b; static constexpr int NSIDE = 0;
    DEV const void* side(const Unit&, int) const { return nullptr; }
    DEV Pre8 pre(const Unit&, int col, const LAS float*) const { return Pre8{*(const f32x4*)(b + col), *(const f32x4*)(b + col + 4)}; }
    DEV void operator()(const Unit&, int row, int col, f32x4 v0, f32x4 v1, const Pre8& pp, const LAS float*) const { const u32x4 y = *(const u32x4*)(Y + (size_t)row * 512 + col); const f32x4 b0 = pp.b0, b1 = pp.b1;
        const u32x4 w = {cvt_pk(bflo(y.x) * fast_sigm(v0[0] + b0.x), bfhi(y.x) * fast_sigm(v0[1] + b0.y)), cvt_pk(bflo(y.y) * fast_sigm(v0[2] + b0.z), bfhi(y.y) * fast_sigm(v0[3] + b0.w)),
                         cvt_pk(bflo(y.z) * fast_sigm(v1[0] + b1.x), bfhi(y.z) * fast_sigm(v1[1] + b1.y)), cvt_pk(bflo(y.w) * fast_sigm(v1[2] + b1.z), bfhi(y.w) * fast_sigm(v1[3] + b1.w))};
        *(u32x4*)(O + (size_t)row * 1024 + col) = w; } };
constexpr float ACT_SCALE = 4.f, WDN_SCALE = 128.f;
DEV float swiglu1s(float g, float u) { g = fminf(g, 7.f); u = __builtin_amdgcn_fmed3f(u, -7.f, 7.f); const float r = __builtin_amdgcn_rcpf(1.f + __builtin_amdgcn_exp2f(-1.702f * 1.4426950408889634f * g)); return (g * r) * fmaf(u, ACT_SCALE, ACT_SCALE); }
struct FSwiglu { unsigned char* ACT; const float* bgu; float sc; static constexpr int NSIDE = 1;
    DEV const void* side(const Unit& u, int) const { return bgu + (size_t)u.e * 2048 + u.pn * BM; }
    DEV Pre8 pre(const Unit&, int, const LAS float* sb) const { return Pre8{*(const LAS f32x4*)sb, *(const LAS f32x4*)(sb + 4)}; }
    DEV void operator()(const Unit& u, int row, int col, f32x4 v0, f32x4 v1, const Pre8& pp, const LAS float*) const { const f32x4 b0 = pp.b0, b1 = pp.b1;
        const unsigned w = pk4_fp8(swiglu1s(fmaf(v0[0], sc, b0.x), fmaf(v0[1], sc, b0.y)), swiglu1s(fmaf(v0[2], sc, b0.z), fmaf(v0[3], sc, b0.w)), swiglu1s(fmaf(v1[0], sc, b1.x), fmaf(v1[1], sc, b1.y)), swiglu1s(fmaf(v1[2], sc, b1.z), fmaf(v1[3], sc, b1.w)));
        *(unsigned*)(ACT + (size_t)row * 1024 + (col >> 1)) = w; } };
struct FDown { bf16_t* YS; const float* bd; const float* wgt; float sc; static constexpr int NSIDE = 2;
    DEV const void* side(const Unit& u, int k) const { return k == 0 ? (const void*)(bd + (size_t)u.e * 1024 + u.pn * BM) : (const void*)(wgt + (size_t)u.pm * BM); }
    DEV Pre8 pre(const Unit&, int, const LAS float* sb) const { return Pre8{*(const LAS f32x4*)sb, *(const LAS f32x4*)(sb + 4)}; }
    DEV void operator()(const Unit& u, int row, int col, f32x4 v0, f32x4 v1, const Pre8& pp, const LAS float* sr) const { const f32x4 b0 = pp.b0, b1 = pp.b1; const float wt = *sr, ws_ = sc * wt;
        const u32x4 w = {cvt_pk(fmaf(v0[0], ws_, b0.x * wt), fmaf(v0[1], ws_, b0.y * wt)), cvt_pk(fmaf(v0[2], ws_, b0.z * wt), fmaf(v0[3], ws_, b0.w * wt)), cvt_pk(fmaf(v1[0], ws_, b1.x * wt), fmaf(v1[1], ws_, b1.y * wt)), cvt_pk(fmaf(v1[2], ws_, b1.z * wt), fmaf(v1[3], ws_, b1.w * wt))};
        *(u32x4*)(YS + (size_t)row * 1024 + col) = w; } };

constexpr int NPH = 21;
constexpr float X8_SCALE = 16.f, WGU_SCALE = 64.f;
constexpr float QSCALE0 = 0.125f * 1.4426950408889634f, QSCALE1 = 0.08838834764831845f;


#define NOINL __device__ __forceinline__
struct PA { const float* const* in; unsigned char* ws; float* out; int wave; };
#define MKFRAME extern __shared__ __attribute__((aligned(16))) unsigned char lds_[]; Frame F; F.lds = (LAS unsigned char*)lds_; F.wave = pa.wave; F.lane = (int)__builtin_amdgcn_mbcnt_hi(~0u, __builtin_amdgcn_mbcnt_lo(~0u, 0u)); F.tid = F.wave * 64 + F.lane; \
    F.G = gridDim.x; { const int bx = blockIdx.x; F.vcu = (F.G % 8 == 0) ? (bx % 8) * (F.G / 8) + bx / 8 : bx; } F.in = pa.in; F.ws = pa.ws;
template <class Fn> DEV void dense_gemm(Frame& F, const bf16_t* A, const bf16_t* Bt, int nM, int nN, int K, const Fn& fn) {
    Gemm g; g.A = A; g.Bt = Bt; g.rowmap = nullptr; g.bstride = 0; g.KB = K * 2; g.wave = F.wave;
    StaticOrder S; S.init(nM, nN, F.G, (int)blockIdx.x, nullptr);
    EpiRow8<Fn> E{fn};
    gemm_phase<false, false>(F.lds, g, S, E);
}
NOINL void ph_prologue(PA pa) { MKFRAME p0_prologue(F); }
NOINL void ph_in0(PA pa) { MKFRAME dense_gemm(F, WSP(bf16_t, W_XB), WSP(bf16_t, W_IN0), T / 256, 8, 1024, FStoreScale{WSP(bf16_t, W_HB), 2048, 512, 1024, QSCALE0}); }
NOINL void ph_kmean(PA pa) { MKFRAME p_kmean(F); }
NOINL void ph_s5moba(PA pa, int mode) { MKFRAME p_s5_moba(F, mode); }
NOINL void ph_glu(PA pa) { MKFRAME dense_gemm(F, WSP(bf16_t, W_YS5), WSP(bf16_t, W_GLU), T / 256, 2, 512, FGlu{WSP(bf16_t, W_YS5), WSP(bf16_t, W_Y0), F.in[11]}); }
NOINL void ph_out(PA pa, int layer) { MKFRAME dense_gemm(F, WSP(bf16_t, W_Y0), layer ? WSP(bf16_t, W_OUT1) : WSP(bf16_t, W_OUT0), T / 256, 4, 1024, FStoreScale{WSP(bf16_t, W_MIXB), 1024, 0, 0, 1.f}); }
NOINL void ph_in1(PA pa) { MKFRAME dense_gemm(F, WSP(bf16_t, W_XB), WSP(bf16_t, W_IN1), T / 256, 12, 1024, FStoreScale{WSP(bf16_t, W_HB), 3072, 0, 512, QSCALE1}); p_gr(F); }
NOINL void ph_glaprep(PA pa) { MKFRAME p_gla_prep(F); }
NOINL void ph_glascan(PA pa) { MKFRAME p_gla_scan(F); }
NOINL void ph_glanorm(PA pa) { MKFRAME p_gla_norm(F); }
NOINL void ph_lnrouter(PA pa, int layer) { MKFRAME
    if (layer == 0) p_ln<0, true, false, false>(F, nullptr, WSP(bf16_t, W_XB), WSP(bf16_t, W_XBB), nullptr, F.in[19], F.in[20], F.in[23], F.in[24]);
    else p_ln<0, true, false, false>(F, nullptr, WSP(bf16_t, W_XB), WSP(bf16_t, W_XBB), nullptr, F.in[19] + 1024, F.in[20] + 1024, F.in[23] + (size_t)1024 * 32, F.in[24] + 32); }
NOINL void ph_sort(PA pa) { MKFRAME p_sort(F); }
NOINL void ph_gateup(PA pa, int layer) { MKFRAME const int* SORT = WSP(int, W_SORT);
    Gemm g; g.A = WSP(unsigned char, W_X8); g.Bt = WSP(unsigned char, W_GU) + (size_t)layer * 32 * 2048 * 1024; g.rowmap = nullptr; g.bstride = (size_t)2048 * 1024; g.KB = 1024; g.wave = F.wave;
    StaticOrder S; S.init(__builtin_amdgcn_readfirstlane(SORT[33]), 8, F.G, (int)blockIdx.x, (const LAS int*)(F.lds + LDS_ELIST)); fill_elist(F.lds, S, SORT + 64, F.tid);
    EpiRow8<FSwiglu> E{FSwiglu{WSP(unsigned char, W_ACT), F.in[26] + (size_t)layer * 32 * 2048, 1.f / (X8_SCALE * WGU_SCALE)}};
    gemm_phase<false, true>(F.lds, g, S, E); }
NOINL void ph_down(PA pa, int layer) { MKFRAME const int* SORT = WSP(int, W_SORT);
    Gemm g; g.A = WSP(unsigned char, W_ACT); g.Bt = WSP(unsigned char, W_DN) + (size_t)layer * 32 * 1024 * 1024; g.rowmap = nullptr; g.bstride = (size_t)1024 * 1024; g.KB = 1024; g.wave = F.wave;
    StaticOrder S; S.init(__builtin_amdgcn_readfirstlane(SORT[33]), 4, F.G, (int)blockIdx.x, (const LAS int*)(F.lds + LDS_ELIST)); fill_elist(F.lds, S, SORT + 64, F.tid);
    EpiRow8<FDown> E{FDown{WSP(bf16_t, W_YS), F.in[28] + (size_t)layer * 32 * 1024, WSP(float, R_WGT), 1.f / (ACT_SCALE * WDN_SCALE)}};
    gemm_phase<false, true>(F.lds, g, S, E); }
NOINL void ph_combine(PA pa, int layer) { MKFRAME
    if (layer == 0) p_ln<1, false, false, false, false>(F, nullptr, WSP(bf16_t, W_XBB), WSP(bf16_t, W_XB), nullptr, F.in[21], F.in[22], nullptr, nullptr);
    else p_ln<1, false, false, true>(F, nullptr, WSP(bf16_t, W_XBB), nullptr, pa.out, F.in[21] + 1024, F.in[22] + 1024, nullptr, nullptr); }

__global__ void __launch_bounds__(512, 2) mega(Args args) {
    extern __shared__ __attribute__((aligned(16))) unsigned char lds_[];
    LAS unsigned char* lds = (LAS unsigned char*)lds_;
    unsigned* ctl = (unsigned*)(args.ws + W_CTL);
    for (int u = threadIdx.x; u < (LDS_BYTES - LDSCTL_OFF) / 4; u += 512) ((LAS unsigned*)(lds + LDSCTL_OFF))[u] = 0u;
    __syncthreads();
    const int lo = args.ph_lo, hi = args.ph_hi;
    PA pa; pa.in = args.in; pa.ws = args.ws; pa.out = args.out; pa.wave = __builtin_amdgcn_readfirstlane(threadIdx.x >> 6);
    XcdBarrier bar; bar.bar = ctl + CW_BAR; bar.x = 0; bar.st = nullptr; bar.wave = pa.wave;
    if (hi - lo > 1) bar = xcd_barrier_post(ctl + CW_BAR, (volatile LAS unsigned*)(lds + MISC_OFF) + 8, pa.wave);
#define IN(k) (lo <= (k) && (k) < hi)
#ifdef DIAG_LO
    volatile LAS unsigned long long* tsl = (volatile LAS unsigned long long*)(lds + MISC_OFF + 128);
    if (blockIdx.x == 0 && threadIdx.x == 0) tsl[0] = __builtin_amdgcn_s_memrealtime();
#define STAMP(k) do { if (blockIdx.x == 0 && threadIdx.x == 0) tsl[(k) + 1] = __builtin_amdgcn_s_memrealtime(); } while (0)
#else
#define STAMP(k) do { } while (0)
#endif
#define SEAM(k) do { if (IN(k) && IN((k) + 1)) xcd_barrier(bar); STAMP(k); } while (0)
#ifndef REP_PHASE
#define REP_PHASE -1
#define REP_N 0
#endif
#define RUN(k, call) do { if (IN(k)) { call; if ((k) == REP_PHASE) { xcd_barrier(bar); call; } } } while (0)
    RUN(0, ph_prologue(pa)); SEAM(0);
    RUN(1, ph_in0(pa)); SEAM(1);
    RUN(2, ph_kmean(pa)); SEAM(2);
    if (IN(3)) { ph_s5moba(pa, 1); if (REP_PHASE == 30) ph_s5moba(pa, 1); ph_s5moba(pa, 2); if (REP_PHASE == 31) ph_s5moba(pa, 2); } SEAM(3);
    RUN(4, ph_glu(pa)); SEAM(4);
    RUN(5, ph_out(pa, 0)); SEAM(5);
    if (REP_PHASE == 99) { for (int q_ = 0; q_ < 20; ++q_) xcd_barrier(bar); }
    RUN(6, ph_lnrouter(pa, 0)); SEAM(6);
    RUN(7, ph_sort(pa)); SEAM(7);
    RUN(8, ph_gateup(pa, 0)); SEAM(8);
    RUN(9, ph_down(pa, 0)); SEAM(9);
    RUN(10, ph_combine(pa, 0)); SEAM(10);
    RUN(11, ph_in1(pa)); SEAM(11);
    RUN(12, ph_glaprep(pa)); SEAM(12);
    RUN(13, ph_glascan(pa)); SEAM(13);
    RUN(14, ph_glanorm(pa)); SEAM(14);
    RUN(15, ph_out(pa, 1)); SEAM(15);
    RUN(16, ph_lnrouter(pa, 1)); SEAM(16);
    RUN(17, ph_sort(pa)); SEAM(17);
    RUN(18, ph_gateup(pa, 1)); SEAM(18);
    RUN(19, ph_down(pa, 1)); SEAM(19);
    RUN(20, ph_combine(pa, 1));
#ifdef DIAG_LO
    xcd_barrier(bar); STAMP(20);
    if (blockIdx.x == 0 && threadIdx.x == 0) { const unsigned long long dtk = tsl[DIAG_HI + 1] - tsl[DIAG_LO]; const float f = (float)dtk * (0.01f / 10000.f); __hip_atomic_store(ctl + 8, __float_as_uint(f), __ATOMIC_RELAXED, __HIP_MEMORY_SCOPE_AGENT); }
    xcd_barrier(bar);
    { const float f = __uint_as_float(__hip_atomic_load(ctl + 8, __ATOMIC_RELAXED, __HIP_MEMORY_SCOPE_AGENT));
      for (size_t i = (size_t)blockIdx.x * 512 + threadIdx.x; i < (size_t)T * 1024; i += (size_t)gridDim.x * 512) args.out[i] *= (1.f + f); }
#endif
#undef IN
#undef SEAM
}

static int g_grid = 0;
static bool launch_setup(size_t ws_size) {
    if (g_grid == 0) {
        if (ws_size < W_END) { fprintf(stderr, "kernel_launch: workspace too small: %zu < %zu\n", ws_size, (size_t)W_END); g_grid = -1; return false; }
        int dev = 0, cus = 0, per_cu = 0;
        if (hipGetDevice(&dev) != hipSuccess || hipDeviceGetAttribute(&cus, hipDeviceAttributeMultiprocessorCount, dev) != hipSuccess) { g_grid = -1; return false; }
        if (hipFuncSetAttribute((const void*)mega, hipFuncAttributeMaxDynamicSharedMemorySize, LDS_BYTES) != hipSuccess) { fprintf(stderr, "kernel_launch: hipFuncSetAttribute failed\n"); g_grid = -1; return false; }
        if (hipOccupancyMaxActiveBlocksPerMultiprocessor(&per_cu, (const void*)mega, 512, LDS_BYTES) != hipSuccess || per_cu < 1) fprintf(stderr, "kernel_launch: occupancy query reports %d blocks/CU\n", per_cu);
        (void)hipGetLastError();
        g_grid = cus;
    }
    return g_grid > 0;
}
static void launch_phases(hipStream_t stream, void* const* d_in, void* d_out, void* d_ws, int lo, int hi) {
    Args a; memset(&a, 0, sizeof a);
    for (int i = 0; i < 29; ++i) a.in[i] = (const float*)d_in[i];
    a.out = (float*)d_out; a.ws = (unsigned char*)d_ws; a.ph_lo = lo; a.ph_hi = hi;
    hipLaunchKernelGGL(mega, dim3(g_grid), dim3(512), LDS_BYTES, stream, a);
}
}
extern "C" void kernel_launch(void* const* d_in, const int* in_sizes, int n_in, void* d_out, int out_size, void* d_ws, size_t ws_size, hipStream_t stream) {
    if (n_in != 29 || out_size != T * D) { fprintf(stderr, "kernel_launch: unexpected arguments (n_in %d, out_size %d)\n", n_in, out_size); return; }
    if (!fk::launch_setup(ws_size)) return;
    (void)hipMemsetAsync((char*)d_ws + fk::W_CTL, 0, fk::CTL_ZERO_BYTES, stream);
    fk::launch_phases(stream, d_in, d_out, d_ws, 0, fk::NPH);
}
```

```cpp
#include <hip/hip_runtime.h>
#include <cstdio>
#include <cstdint>
#include <cmath>
#include <cstring>
#define DEV __device__ __forceinline__
constexpr int Bn = 16, L = 2048, D = 1024, T = Bn * L;
namespace fk {
#define LAS __attribute__((address_space(3)))
#define GAS __attribute__((address_space(1)))
typedef unsigned short bf16_t;
typedef short bf16x8 __attribute__((ext_vector_type(8)));
typedef short s16x4 __attribute__((ext_vector_type(4)));
typedef float f32x2 __attribute__((ext_vector_type(2)));
typedef float f32x4 __attribute__((ext_vector_type(4)));
typedef float f32x16 __attribute__((ext_vector_type(16)));
typedef unsigned u32x2 __attribute__((ext_vector_type(2)));
typedef unsigned u32x4 __attribute__((ext_vector_type(4)));
typedef __bf16 bf16x2_t __attribute__((ext_vector_type(2)));
struct u32x4x2 { u32x4 a, b; };
DEV unsigned cvt_pk(float lo, float hi) { f32x2 v = {lo, hi}; bf16x2_t b = __builtin_convertvector(v, bf16x2_t); return __builtin_bit_cast(unsigned, b); }
DEV float bflo(unsigned w) { return __uint_as_float(w << 16); }
DEV float bfhi(unsigned w) { return __uint_as_float(w & 0xffff0000u); }
DEV float fast_sigm(float x) { return __builtin_amdgcn_rcpf(1.f + __builtin_amdgcn_exp2f(-1.4426950408889634f * x)); }
DEV float gelu_tanh(float x) { const float u = 0.7978845608028654f * (x + 0.044715f * x * x * x); return x * fast_sigm(2.f * u); }
DEV float wave_sum(float v) {
#pragma unroll
    for (int o = 1; o < 64; o <<= 1) v += __shfl_xor(v, o);
    return v; }
DEV float swap32(float x) { auto rr = __builtin_amdgcn_permlane32_swap(__float_as_uint(x), __float_as_uint(x), false, false); return __uint_as_float((__builtin_amdgcn_mbcnt_lo(~0u, 0u) >> 5) ? rr[0] : rr[1]); }

constexpr int BM = 256, BK = 64, HALF = 128, HTB = HALF * BK * 2, STAGE_BYTES = 8 * HTB, NXCD = 8, WGM = 8;
constexpr int LDS_TOK = 135168 - 2048;
constexpr int LDS_SIDE = 135168;
constexpr int LDS_BYTES = 163840, LDSCTL_OFF = LDS_BYTES - 1024, MISC_OFF = LDSCTL_OFF + 320;

DEV int lds_byte(int r, int c) { const int st = (r >> 4) * 2 + (c >> 5), rr = r & 15, cc = c & 31, ob = rr * 64 + cc * 2; return st * 1024 + (ob ^ (((ob >> 9) & 1) << 5)); }
DEV void stage_rc(int b, int& R, int& C) { const int st = b / 1024, sb = b % 1024, swz = sb ^ (((sb >> 9) & 1) << 5); R = (st >> 1) * 16 + swz / 64; C = (st & 1) * 32 + (swz % 64) / 2; }
DEV int perm32(int rho) { const int n = rho >> 4, i = rho & 15; return 8 * (i >> 2) + 4 * n + (i & 3); }

struct Unit { int pm, pn, e; };
struct Gemm { const void* A; const void* Bt; const int* rowmap; size_t bstride; int KB; int wave; };

struct StaticOrder {
    int nM, nN, nwg, G, c; const LAS int* elist;
    DEV void init(int nM_, int nN_, int G_, int c_, const LAS int* el) { nM = nM_; nN = nN_; nwg = nM * nN; G = G_; c = c_; elist = el; }
    DEV bool place(int i, Unit& u) const {
        const long Lx = (long)i * G + c; if (Lx >= nwg) return false;
        int wgid = (int)Lx; { const int q = nwg / NXCD, r = nwg % NXCD, xcd = wgid % NXCD, off = wgid / NXCD; wgid = (xcd < r ? xcd * (q + 1) : r * (q + 1) + (xcd - r) * q) + off; }
        const int nig = WGM * nN, gid = wgid / nig, fm = gid * WGM, gsz = (nM - fm) < WGM ? (nM - fm) : WGM;
        u.pm = fm + ((wgid % nig) % gsz); u.pn = (wgid % nig) / gsz; u.e = 0; return true;
    }
    DEV bool next(int i, Unit& u) const { if (!place(i, u)) return false; if (elist) u.e = __builtin_amdgcn_readfirstlane(elist[i]); return true; }
};
constexpr int LDS_ELIST = 135168 + 6144;
DEV void fill_elist(LAS unsigned char* lds, const StaticOrder& S, const int* tile_e, int tid) {
    LAS int* el = (LAS int*)(lds + LDS_ELIST);
    if (tid < 64) { Unit u; el[tid] = S.place(tid, u) ? tile_e[u.pm] : 0; }
    __syncthreads();
}

struct NoPre {};
template <class F> struct EpiRow8 {
    static constexpr bool PERM = true; static constexpr int NSIDE = F::NSIDE; F f;
    DEV const void* side(const Unit& u, int k) const { return f.side(u, k); }
    DEV void operator()(const f32x4 (&acc)[2][2][4][2], const Unit& u, int wr, int wc, int fr, int fq, const LAS float* sd) const {
        { const int ln_ = (int)__builtin_amdgcn_mbcnt_hi(~0u, __builtin_amdgcn_mbcnt_lo(~0u, 0u)); fr = ln_ & 15; fq = ln_ >> 4; }
        const int cl = wc * 32 + 8 * fq, c0 = u.pn * BM + cl;
        if constexpr (NSIDE > 0) {
#pragma unroll
            for (int ai = 0; ai < 2; ++ai)
#pragma unroll
                for (int m = 0; m < 4; ++m) { const int rl = ai * HALF + wr * 64 + m * 16 + fr, row = u.pm * BM + rl;
                    f(u, row, c0, acc[ai][0][m][0], acc[ai][0][m][1], f.pre(u, c0, sd + cl), sd + 256 + rl); f(u, row, c0 + HALF, acc[ai][1][m][0], acc[ai][1][m][1], f.pre(u, c0 + HALF, sd + cl + HALF), sd + 256 + rl); }
        } else {
        const auto p0 = f.pre(u, c0, sd + cl), p1 = f.pre(u, c0 + HALF, sd + cl + HALF);
#pragma unroll
        for (int ai = 0; ai < 2; ++ai)
#pragma unroll
            for (int m = 0; m < 4; ++m) { const int rl = ai * HALF + wr * 64 + m * 16 + fr, row = u.pm * BM + rl;
                f(u, row, c0, acc[ai][0][m][0], acc[ai][0][m][1], p0, sd + 256 + rl); f(u, row, c0 + HALF, acc[ai][1][m][0], acc[ai][1][m][1], p1, sd + 256 + rl); }
        }
    }
};

typedef int v8i_t __attribute__((ext_vector_type(8)));
typedef int v4i_t __attribute__((ext_vector_type(4)));
template <bool GATHER, bool FP8, bool ALIGN, class Epi, class Sched>
DEV void gemm_phase(LAS unsigned char* lds, const Gemm g, const Sched& S, const Epi& E) {
    const int wid = g.wave, lane = (int)__builtin_amdgcn_mbcnt_hi(~0u, __builtin_amdgcn_mbcnt_lo(~0u, 0u)), tid = wid * 64 + lane, wr = wid >> 2, wc = wid & 3, fr = lane & 15, fq = lane >> 4;
    float z0 = 0.f; asm volatile("" : "+v"(z0));
    const int KB = g.KB, nt = KB / 128;
    int R0, C2; { int C; stage_rc(tid * 16, R0, C); C2 = C * 2; }
    unsigned voffB[2]; { const int Rb = Epi::PERM ? ((R0 & ~31) + perm32(R0 & 31)) : R0; voffB[0] = (unsigned)(Rb * KB + C2); voffB[1] = voffB[0] + 64u * (unsigned)KB; }
    const unsigned kstep = 128u, hstep = (unsigned)HALF * KB, tstep = 2u * hstep;
    const unsigned ldsw = (unsigned)wid * 1024u;
    const int aoff = lds_byte(wr * 64 + fr, fq * 8); int boff = lds_byte(wc * 32 + fr, fq * 8) + 4 * HTB; asm volatile("" : "+v"(boff));
    LAS int* tokb = (LAS int*)(lds + LDS_TOK);
    const auto rsA = __builtin_amdgcn_make_buffer_rsrc((void*)g.A, 0, 0x7fffffff, 0x00020000);
    const auto rsB = __builtin_amdgcn_make_buffer_rsrc((void*)g.Bt, 0, 0x7fffffff, 0x00020000);
    const auto rsT = __builtin_amdgcn_make_buffer_rsrc((void*)(GATHER ? (const void*)g.rowmap : g.A), 0, 0x7fffffff, 0x00020000);
#define PG8_SA(b, h) (((b) * 2 + (h)) * HTB)
#define PG8_SB(b, h) ((4 + (b) * 2 + (h)) * HTB)
#define PG8_STAGE(bufoff, rs, soff, voff) do { _Pragma("unroll") for (int _i = 0; _i < 2; ++_i) { \
        if constexpr (GATHER) __builtin_amdgcn_raw_ptr_buffer_load_lds(rs, (LAS void*)(lds + (bufoff) + ldsw + _i * 8192), 16, (int)(voff)[_i], (int)(soff), 0, 0); \
        else __builtin_amdgcn_raw_ptr_buffer_load_lds(rs, (LAS void*)(lds + (bufoff) + ldsw + _i * 8192), 16, (int)(voff)[0], (int)((soff) + _i * 64u * (unsigned)KB), 0, 0); } } while (0)
#define PG8_LDA(dst, b, h) do { _Pragma("unroll") for (int m = 0; m < 4; ++m) _Pragma("unroll") for (int k = 0; k < 2; ++k) dst[m][k] = *(const LAS bf16x8*)(lds + PG8_SA(b, h) + aoff + m * 2048 + k * 1024); } while (0)
#define PG8_LDB(dst, b, h) do { _Pragma("unroll") for (int n = 0; n < 2; ++n) _Pragma("unroll") for (int k = 0; k < 2; ++k) dst[n][k] = *(const LAS bf16x8*)(lds + boff + (PG8_SB(b, h) - 4 * HTB) + n * 2048 + k * 1024); } while (0)
#define PG8_CAT(x) __builtin_shufflevector(__builtin_bit_cast(v4i_t, x[0]), __builtin_bit_cast(v4i_t, x[1]), 0, 1, 2, 3, 4, 5, 6, 7)
#define PG8_MMA(ai, bj, At, Bt) do { __builtin_amdgcn_s_setprio(1); _Pragma("unroll") for (int m = 0; m < 4; ++m) _Pragma("unroll") for (int n = 0; n < 2; ++n) { \
        if constexpr (FP8) acc[ai][bj][m][n] = __builtin_amdgcn_mfma_scale_f32_16x16x128_f8f6f4(PG8_CAT(Bt[n]), PG8_CAT(At[m]), acc[ai][bj][m][n], 0, 0, 0, 0, 0, 0); \
        else { _Pragma("unroll") for (int k = 0; k < 2; ++k) acc[ai][bj][m][n] = __builtin_amdgcn_mfma_f32_16x16x32_bf16(Bt[n][k], At[m][k], acc[ai][bj][m][n], 0, 0, 0); } } __builtin_amdgcn_s_setprio(0); } while (0)
#define PG8_WAIT_V(n) asm volatile("s_waitcnt vmcnt(" #n ")" ::: "memory")
#define PG8_WAIT_L(n) asm volatile("s_waitcnt lgkmcnt(" #n ")" ::: "memory")
#define PG8_BAR __builtin_amdgcn_s_barrier()
#define PG8_SCHED __builtin_amdgcn_sched_barrier(0)
    Unit cur, nxt; int ui = 0;
    if (!S.next(0, cur)) return;
    f32x4 acc[2][2][4][2];
#pragma unroll
    for (int a = 0; a < 2; ++a)
#pragma unroll
        for (int b = 0; b < 2; ++b)
#pragma unroll
            for (int m = 0; m < 4; ++m)
#pragma unroll
                for (int n = 0; n < 2; ++n) acc[a][b][m][n] = (f32x4){z0, z0, z0, z0};
    bf16x8 At[4][2], B0[2][2], B1[2][2];
    unsigned cA, cB = (unsigned)cur.e * (unsigned)g.bstride + (unsigned)cur.pn * tstep;
    unsigned voffA[2]; voffA[0] = (unsigned)(R0 * KB + C2); voffA[1] = voffA[0] + 64u * (unsigned)KB;
    if constexpr (GATHER) { cA = 0u;
        if (wid < 4) __builtin_amdgcn_raw_ptr_buffer_load_lds(rsT, (LAS void*)(tokb + wid * 64), 4, (wid * 64 + lane) * 4, cur.pm * (BM * 4), 0, 0);
        asm volatile("s_waitcnt vmcnt(0)" ::: "memory"); __builtin_amdgcn_s_barrier();
    } else cA = (unsigned)cur.pm * tstep;
    const unsigned hA = GATHER ? 0u : hstep;
    LAS float* sideb = (LAS float*)(lds + LDS_SIDE);
#define PG8_SIDE(un, sel) do { if constexpr (Epi::NSIDE > 0) { if (wid < Epi::NSIDE) { const char* sp_ = (const char*)E.side(un, wid); int ln_ = (int)__builtin_amdgcn_mbcnt_hi(~0u, __builtin_amdgcn_mbcnt_lo(~0u, 0u)); asm volatile("" : "+v"(ln_)); \
        __builtin_amdgcn_global_load_lds((const unsigned*)(sp_ + ln_ * 16), (LAS unsigned*)(sideb + (sel) * 512 + wid * 256), 16, 0, 0); } } } while (0)
    PG8_SIDE(cur, 0);
#define PG8_OA(dst, sel, h) unsigned dst[2]; if constexpr (GATHER) { dst[0] = (unsigned)(tokb[(sel) * 256 + (h) * HALF + R0] * KB + C2); dst[1] = (unsigned)(tokb[(sel) * 256 + (h) * HALF + R0 + 64] * KB + C2); } else { dst[0] = voffA[0]; dst[1] = voffA[1]; }
    { PG8_OA(p0_, 0, 0); PG8_OA(p1_, 0, 1); PG8_STAGE(PG8_SB(0, 0), rsB, cB, voffB); PG8_STAGE(PG8_SB(0, 1), rsB, cB + hstep, voffB); PG8_STAGE(PG8_SA(0, 0), rsA, cA, p0_); PG8_STAGE(PG8_SA(0, 1), rsA, cA + hA, p1_); }
    if (wr == 1) PG8_BAR;
    PG8_WAIT_V(2); PG8_BAR;
    { PG8_OA(p0_, 0, 0); PG8_STAGE(PG8_SB(1, 0), rsB, cB + kstep, voffB); PG8_STAGE(PG8_SA(1, 0), rsA, cA + kstep, p0_); PG8_STAGE(PG8_SB(1, 1), rsB, cB + hstep + kstep, voffB); }
    PG8_WAIT_V(6); PG8_BAR;
    for (;;) {
        const bool has_next = S.next(ui + 1, nxt);
        unsigned nA = cA, nB = cB;
        if (has_next) { nB = (unsigned)nxt.e * (unsigned)g.bstride + (unsigned)nxt.pn * tstep;
            if constexpr (GATHER) { if (wid < 4) { const int ln_ = (int)__builtin_amdgcn_mbcnt_hi(~0u, __builtin_amdgcn_mbcnt_lo(~0u, 0u)); __builtin_amdgcn_raw_ptr_buffer_load_lds(rsT, (LAS void*)(tokb + ((ui + 1) & 1) * 256 + wid * 64), 4, (wid * 64 + ln_) * 4, nxt.pm * (BM * 4), 0, 0); } }
            else nA = (unsigned)nxt.pm * tstep;
            PG8_SIDE(nxt, (ui + 1) % 3); }
#pragma unroll 1
        for (int t = 0; t < nt; t += 2) {
            const bool last = (t == nt - 2);
            const unsigned a1 = cA + (unsigned)(t + 1) * kstep;
            const unsigned a2 = last ? nA : cA + (unsigned)(t + 2) * kstep, b2 = last ? nB : cB + (unsigned)(t + 2) * kstep;
            const unsigned a3 = a2 + kstep, b3 = b2 + kstep;
            const int selc = ui & 1, seln = (last && has_next) ? ((ui + 1) & 1) : selc;
            PG8_LDB(B0, 0, 0); PG8_LDB(B1, 0, 1); PG8_SCHED; PG8_LDA(At, 0, 0); { PG8_OA(q_, selc, 1); PG8_STAGE(PG8_SA(1, 1), rsA, a1 + hA, q_); }
            PG8_WAIT_V(8); PG8_WAIT_L(0); PG8_BAR; PG8_MMA(0, 0, At, B0); PG8_MMA(0, 1, At, B1); PG8_BAR; PG8_SCHED;
            PG8_LDA(At, 0, 1); PG8_STAGE(PG8_SB(0, 0), rsB, b2, voffB); PG8_STAGE(PG8_SB(0, 1), rsB, b2 + hstep, voffB); { PG8_OA(q_, seln, 0); PG8_STAGE(PG8_SA(0, 0), rsA, a2, q_); }
            PG8_WAIT_V(8); PG8_WAIT_L(0); PG8_BAR; PG8_MMA(1, 0, At, B0); PG8_MMA(1, 1, At, B1); PG8_BAR; PG8_SCHED;
            PG8_LDB(B0, 1, 0); PG8_LDB(B1, 1, 1); PG8_SCHED; PG8_LDA(At, 1, 0); { PG8_OA(q_, seln, 1); PG8_STAGE(PG8_SA(0, 1), rsA, a2 + hA, q_); }
            PG8_WAIT_V(8); PG8_WAIT_L(0); PG8_BAR; PG8_MMA(0, 0, At, B0); PG8_MMA(0, 1, At, B1); PG8_BAR; PG8_SCHED;
            PG8_LDA(At, 1, 1); PG8_STAGE(PG8_SB(1, 0), rsB, b3, voffB); PG8_STAGE(PG8_SB(1, 1), rsB, b3 + hstep, voffB); { PG8_OA(q_, seln, 0); PG8_STAGE(PG8_SA(1, 0), rsA, a3, q_); }
            PG8_WAIT_V(8); PG8_WAIT_L(0); PG8_BAR; PG8_MMA(1, 0, At, B0); PG8_MMA(1, 1, At, B1); PG8_BAR; PG8_SCHED;
        }
        if constexpr (ALIGN) { if (wr == 0) PG8_BAR; }
        E(acc, cur, wr, wc, fr, fq, sideb + (ui % 3) * 512);
        if (!has_next) break;
#pragma unroll
        for (int a = 0; a < 2; ++a)
#pragma unroll
            for (int b = 0; b < 2; ++b)
#pragma unroll
                for (int m = 0; m < 4; ++m)
#pragma unroll
                    for (int n = 0; n < 2; ++n) acc[a][b][m][n] = (f32x4){z0, z0, z0, z0};
        cur = nxt; cA = nA; cB = nB; ++ui;
        if constexpr (ALIGN) { if (wr == 1) PG8_BAR; }
    }
    PG8_WAIT_V(0);
    if constexpr (!ALIGN) { if (wr == 0) PG8_BAR; }
    PG8_BAR;
#undef PG8_SA
#undef PG8_SB
#undef PG8_STAGE
#undef PG8_SIDE
#undef PG8_OA
#undef PG8_LDA
#undef PG8_LDB
#undef PG8_MMA
#undef PG8_CAT
#undef PG8_WAIT_V
#undef PG8_WAIT_L
#undef PG8_BAR
#undef PG8_SCHED
}

typedef GAS unsigned gu32;
#define XB_TMO      128
#define XB_XCNT(j)  (256  + 64 * (j))
#define XB_XSUB(j)  (1280 + 64 * (j))
#define XB_XGEN(j)  (2304 + 64 * (j))
#define XB_TOP      3328
#define XB_TOPGEN   3392
#define XCD_BAR_WORDS 3456
#define XB_SPIN_CAP (1u << 20)
DEV unsigned xb_ld(unsigned* p) { return __hip_atomic_load(p, __ATOMIC_RELAXED, __HIP_MEMORY_SCOPE_AGENT); }
DEV unsigned xb_add(unsigned* p, unsigned v) { return __hip_atomic_fetch_add(p, v, __ATOMIC_RELAXED, __HIP_MEMORY_SCOPE_AGENT); }
DEV unsigned xb_xcc_id() { return (unsigned)__builtin_amdgcn_s_getreg((3 << 11) | 20) & 0xFu; }
#define XB_SPIN(cond, bar) do { unsigned _sp = 0; while (cond) { __builtin_amdgcn_s_sleep(1); \
    if ((++_sp & 255u) == 0u) { if (xb_ld(&(bar)[XB_TMO])) break; if (_sp > XB_SPIN_CAP) { atomicAdd(&(bar)[XB_TMO], 1u); break; } } } } while (0)
struct XcdBarrier { unsigned* bar; unsigned x; volatile LAS unsigned* st; int wave; };
DEV bool xb_thread0(int wave) { return wave == 0 && __builtin_amdgcn_mbcnt_hi(~0u, __builtin_amdgcn_mbcnt_lo(~0u, 0u)) == 0u; }
DEV XcdBarrier xcd_barrier_post(unsigned* bar, volatile LAS unsigned* st, int wave) {
    XcdBarrier b; b.bar = bar; b.x = xb_xcc_id(); b.st = st; b.wave = wave;
    if (xb_thread0(wave)) (void)xb_add(&bar[XB_XCNT(b.x)], 1u);
    return b;
}
DEV void xcd_barrier_complete(unsigned* bar, unsigned x, unsigned& nloc, unsigned& nx) {
    const unsigned G = gridDim.x * gridDim.y * gridDim.z;
    unsigned sum, cnt, mine, sp = 0u;
    for (;;) {
        sum = 0u; cnt = 0u; mine = 0u;
#pragma unroll
        for (unsigned j = 0; j < 16; ++j) { const unsigned c = xb_ld(&bar[XB_XCNT(j)]); sum += c; cnt += (c > 0u) ? 1u : 0u; mine = (j == x) ? c : mine; }
        if (sum == G) break;
        __builtin_amdgcn_s_sleep(1);
        if ((++sp & 255u) == 0u) { if (xb_ld(&bar[XB_TMO])) break; if (sp > XB_SPIN_CAP) { atomicAdd(&bar[XB_TMO], 1u); break; } }
    }
    nloc = mine > 0u ? mine : 1u; nx = cnt > 0u ? cnt : 1u;
}
DEV void xcd_barrier(const XcdBarrier& b) {
    asm volatile("s_waitcnt vmcnt(0)" ::: "memory");
    __syncthreads();
    if (xb_thread0(b.wave)) {
        unsigned* bar = b.bar;
        __builtin_amdgcn_s_waitcnt(0);
        unsigned nloc = b.st[0], nx = b.st[1];
        if (nloc == 0u) { xcd_barrier_complete(bar, b.x, nloc, nx); b.st[0] = nloc; b.st[1] = nx; }
        const unsigned old = xb_add(&bar[XB_XSUB(b.x)], 1u);
        const unsigned gen = old / nloc;
        if (old + 1u == (gen + 1u) * nloc) {
            __builtin_amdgcn_fence(__ATOMIC_RELEASE, "agent");
            asm volatile("s_waitcnt vmcnt(0)" ::: "memory");
            const unsigned og = xb_add(&bar[XB_TOP], 1u);
            const unsigned tg = og / nx;
            if (og + 1u == (tg + 1u) * nx) xb_add(&bar[XB_TOPGEN], 1u);
            else XB_SPIN(xb_ld(&bar[XB_TOPGEN]) == tg, bar);
            __builtin_amdgcn_fence(__ATOMIC_ACQUIRE, "agent");
            xb_add(&bar[XB_XGEN(b.x)], 1u);
            asm volatile("s_waitcnt vmcnt(0)" ::: "memory");
        } else {
            XB_SPIN(xb_ld(&bar[XB_XGEN(b.x)]) == gen, bar);
            __builtin_amdgcn_fence(__ATOMIC_ACQUIRE, "agent");
            asm volatile("s_waitcnt vmcnt(0)" ::: "memory");
        }
    }
    __syncthreads();
}
constexpr size_t MiB = 1u << 20;
constexpr int PMAX = 131072 + 32 * 256;
constexpr size_t W_CTL = 0, CTL_ZERO_BYTES = 64 * 1024;
constexpr size_t W_IN0 = 2 * MiB, W_GLU = 6 * MiB, W_OUT0 = 7 * MiB, W_IN1 = 9 * MiB, W_OUT1 = 16 * MiB;
constexpr size_t W_LUT = 18 * MiB, W_KM = W_LUT + 64 * 1024, W_HIST = W_KM + 256 * 1024, W_SORT = W_HIST + 64 * 1024  , W_GR = 20 * MiB  , W_SS = 22 * MiB  ;
constexpr size_t W_GU = 32 * MiB, W_DN = 288 * MiB, W_XB = 416 * MiB  , W_XBB = 480 * MiB  , W_X8 = 1024 * MiB  , W_HB = 736 * MiB, W_YS5 = 928 * MiB, W_Y0 = 960 * MiB, W_MIXB = 1024 * MiB, W_GLAO = 1088 * MiB;
constexpr size_t W_ROUTE = 26 * MiB  , W_ACT = 736 * MiB  , W_YS = 1160 * MiB, W_END = 1432 * MiB;
static_assert(W_ACT + (size_t)PMAX * 2048 <= W_MIXB && W_YS + (size_t)PMAX * 2048 <= W_END && W_X8 + (size_t)PMAX * 1024 <= W_YS && W_ROUTE + 4 * MiB <= W_GU, "ws map");
constexpr int CW_BAR = 4096;

struct Args { const float* in[29]; float* out; unsigned char* ws; int ph_lo, ph_hi; };
struct Frame {
    LAS unsigned char* lds; int tid, lane, wave, vcu, G;
    const float* const* in; unsigned char* ws;
};
#define WSP(T_, off) ((T_*)(F.ws + (off)))

DEV unsigned pk4_fp8(float a, float b, float c, float d) { unsigned w = 0u; w = __builtin_amdgcn_cvt_pk_fp8_f32(a, b, w, false); w = __builtin_amdgcn_cvt_pk_fp8_f32(c, d, w, true); return w; }
struct CvItem { const float* src; unsigned char* dst; int pitch, K; float sc; };
constexpr int P0_I_GU = 8 * 8, P0_I_DN = 8 * 4, P0_I_IN0 = 8 * 8, P0_I_GLU = 4 * 2, P0_I_O = 8 * 4, P0_I_IN1 = 8 * 12;
constexpr int P0_N_GU = 64 * P0_I_GU, P0_N_DN = 64 * P0_I_DN, P0_NITEMS = P0_N_GU + P0_N_DN + P0_I_IN0 + P0_I_GLU + 2 * P0_I_O + P0_I_IN1;
DEV CvItem cv_decode(Frame& F, int it) {
    int r = it; const float* W; unsigned char* D; int K, N, NP, es; float sc = 0.f;
    if (r < P0_N_GU) { const int m = r / P0_I_GU; r %= P0_I_GU; W = F.in[25] + (size_t)m * 1024 * 2048; D = WSP(unsigned char, W_GU) + (size_t)m * 2048 * 1024; K = 1024; N = 2048; NP = 2048; es = 1; sc = 64.f; }
    else if ((r -= P0_N_GU) < P0_N_DN) { const int m = r / P0_I_DN; r %= P0_I_DN; W = F.in[27] + (size_t)m * 1024 * 1024; D = WSP(unsigned char, W_DN) + (size_t)m * 1024 * 1024; K = 1024; N = 1024; NP = 1024; es = 1; sc = 128.f; }
    else if ((r -= P0_N_DN) < P0_I_IN0) { W = F.in[1]; D = WSP(unsigned char, W_IN0); K = 1024; N = 2048; NP = 2048; es = 2; }
    else if ((r -= P0_I_IN0) < P0_I_GLU) { W = F.in[10]; D = WSP(unsigned char, W_GLU); K = 512; N = 512; NP = 512; es = 2; }
    else if ((r -= P0_I_GLU) < P0_I_O) { W = F.in[13]; D = WSP(unsigned char, W_OUT0); K = 1024; N = 1024; NP = 1024; es = 2; }
    else if ((r -= P0_I_O) < P0_I_O) { W = F.in[18]; D = WSP(unsigned char, W_OUT1); K = 1024; N = 1024; NP = 1024; es = 2; }
    else { r -= P0_I_O; W = F.in[14]; D = WSP(unsigned char, W_IN1); K = 1024; N = 3072; NP = 3088; es = 2; }
    const int nblk = N / 256, kb = r / nblk, nb = r % nblk;
    CvItem c; c.src = W + (size_t)(128 * kb) * NP + 256 * nb; c.dst = D + ((size_t)(256 * nb) * K + 128 * kb) * es; c.pitch = NP; c.K = K; c.sc = sc; return c;
}
DEV void cv_load(const CvItem& c, f32x4 (&v)[16], int tid) {
#pragma unroll
    for (int i = 0; i < 16; ++i) v[i] = *(const f32x4*)(c.src + (size_t)(8 * i + (tid >> 6)) * c.pitch + 4 * (tid & 63));
}
DEV void cv_store(const CvItem& c, const f32x4 (&v)[16], LAS float* T_, int tid) {
#pragma unroll
    for (int i = 0; i < 16; ++i) *(LAS f32x4*)(T_ + (8 * i + (tid >> 6)) * 260 + 4 * (tid & 63)) = v[i];
    __syncthreads();
    const int n = tid & 255, kh = tid >> 8; const LAS float* s = T_ + (64 * kh) * 260 + n;
    if (c.sc > 0.f) { const float q = c.sc; unsigned char* d = c.dst + (size_t)n * c.K + 64 * kh;
#pragma unroll
        for (int g = 0; g < 4; ++g) { u32x4 o;
            o.x = pk4_fp8(s[(16 * g + 0) * 260] * q, s[(16 * g + 1) * 260] * q, s[(16 * g + 2) * 260] * q, s[(16 * g + 3) * 260] * q); o.y = pk4_fp8(s[(16 * g + 4) * 260] * q, s[(16 * g + 5) * 260] * q, s[(16 * g + 6) * 260] * q, s[(16 * g + 7) * 260] * q);
            o.z = pk4_fp8(s[(16 * g + 8) * 260] * q, s[(16 * g + 9) * 260] * q, s[(16 * g + 10) * 260] * q, s[(16 * g + 11) * 260] * q); o.w = pk4_fp8(s[(16 * g + 12) * 260] * q, s[(16 * g + 13) * 260] * q, s[(16 * g + 14) * 260] * q, s[(16 * g + 15) * 260] * q);
            *(u32x4*)(d + 16 * g) = o; }
    } else { unsigned char* d = c.dst + ((size_t)n * c.K + 64 * kh) * 2;
#pragma unroll
        for (int g = 0; g < 8; ++g) { u32x4 o; o.x = cvt_pk(s[(8 * g + 0) * 260], s[(8 * g + 1) * 260]); o.y = cvt_pk(s[(8 * g + 2) * 260], s[(8 * g + 3) * 260]); o.z = cvt_pk(s[(8 * g + 4) * 260], s[(8 * g + 5) * 260]); o.w = cvt_pk(s[(8 * g + 6) * 260], s[(8 * g + 7) * 260]);
            *(u32x4*)(d + 16 * g) = o; }
    }
    __syncthreads();
}
__constant__ int BUCKET_TH2[16] = {16, 22, 30, 40, 54, 73, 99, 134, 182, 246, 332, 450, 609, 825, 1117, 1513};
DEV void p0_prologue(Frame& F) {
    { LAS float* T_ = (LAS float*)F.lds; f32x4 va[16], vb[16];
      int it = F.vcu;
      if (it < P0_NITEMS) { CvItem ca = cv_decode(F, it); cv_load(ca, va, F.tid);
#pragma unroll 1
          for (;;) {
              const int it2 = it + F.G; CvItem cb = ca; const bool h2 = it2 < P0_NITEMS; if (h2) { cb = cv_decode(F, it2); cv_load(cb, vb, F.tid); }
              cv_store(ca, va, T_, F.tid);
              if (!h2) break;
              const int it3 = it2 + F.G; const bool h3 = it3 < P0_NITEMS; if (h3) { ca = cv_decode(F, it3); cv_load(ca, va, F.tid); }
              cv_store(cb, vb, T_, F.tid);
              if (!h3) break;
              it = it3;
          } } }
    const int gt = F.vcu * 512 + F.tid, NGT = F.G * 512;
    for (int i = gt; i < 16 * 1024; i += NGT) { const int n = i >> 10, k = i & 1023; WSP(bf16_t, W_IN1)[(size_t)(3072 + n) * 1024 + k] = (bf16_t)(cvt_pk(F.in[14][(size_t)k * 3088 + 3072 + n], 0.f) & 0xffffu); }
    { const f32x4* x4 = (const f32x4*)F.in[0]; u32x2* o = WSP(u32x2, W_XB);
      for (size_t i = gt; i < (size_t)T * 1024 / 4; i += (size_t)NGT * 8) { f32x4 v[8];
#pragma unroll
          for (int u = 0; u < 8; ++u) v[u] = x4[i + (size_t)u * NGT];
#pragma unroll
          for (int u = 0; u < 8; ++u) { u32x2 w; w.x = cvt_pk(v[u].x, v[u].y); w.y = cvt_pk(v[u].z, v[u].w); o[i + (size_t)u * NGT] = w; } } }
    for (int i = gt; i < 8 * 2048; i += NGT) { const int h = i >> 11, n = i & 2047; int bk = n;
        if (n >= 16) { bk = 16;
#pragma unroll
            for (int q = 1; q < 16; ++q) bk += (n >= BUCKET_TH2[q]) ? 1 : 0; }
        WSP(float, W_LUT)[i] = F.in[12][bk * 8 + h] * 1.4426950408889634f; }
}

DEV void p_kmean(Frame& F) {
    const int gw = F.vcu * 8 + F.wave, NGW = F.G * 8; const bf16_t* H0 = WSP(bf16_t, W_HB); float* KM = WSP(float, W_KM);
    for (int it = gw; it < 1024; it += NGW) { const int blk = it & 7, h = (it >> 3) & 7, b = it >> 6; const int r8 = F.lane >> 3, c = F.lane & 7;
        const bf16_t* p = H0 + (size_t)(b * 2048 + blk * 256 + r8) * 2048 + 1024 + h * 64 + c * 8; float s[8];
#pragma unroll
        for (int j = 0; j < 8; ++j) s[j] = 0.f;
#pragma unroll 8
        for (int i = 0; i < 32; ++i) { const u32x4 v = *(const u32x4*)(p + (size_t)i * 8 * 2048);
            s[0] += bflo(v.x); s[1] += bfhi(v.x); s[2] += bflo(v.y); s[3] += bfhi(v.y); s[4] += bflo(v.z); s[5] += bfhi(v.z); s[6] += bflo(v.w); s[7] += bfhi(v.w); }
#pragma unroll
        for (int j = 0; j < 8; ++j) { s[j] += __shfl_xor(s[j], 8); s[j] += __shfl_xor(s[j], 16); s[j] += __shfl_xor(s[j], 32); }
        if (F.lane < 8) {
#pragma unroll
            for (int j = 0; j < 8; ++j) KM[(size_t)it * 64 + c * 8 + j] = s[j] * (1.f / 256.f); } }
}

DEV void s5_item(Frame& F, int b, int g, LAS unsigned char* sl  ) {
    const int lane = F.lane, p0 = lane & 31, hi = lane >> 5, q4 = lane >> 4;
    const float* lam_re = F.in[2]; const float* lam_im = F.in[3]; const float* log_dt = F.in[4]; const float* b_re = F.in[5]; const float* b_im = F.in[6];
    const float* c_re = F.in[7]; const float* c_im = F.in[8]; const float* dsk = F.in[9];
    const bf16_t* H0 = WSP(bf16_t, W_HB); bf16_t* YS = WSP(bf16_t, W_YS5);
    const float dt = __expf(log_dt[g]);
    float ar[2], ai[2]; bf16x8 bfr[4];
#pragma unroll
    for (int s = 0; s < 2; ++s) { const int p = p0 + 32 * s; const float lr = lam_re[g * 64 + p], li = lam_im[g * 64 + p]; const float mag = __expf(lr * dt);
        ar[s] = mag * cosf(li * dt); ai[s] = mag * sinf(li * dt);
        const float er = ar[s] - 1.f, ei = ai[s], den = lr * lr + li * li; const float qr = (er * lr + ei * li) / den, qi = (ei * lr - er * li) / den;
        u32x4 wr_, wi_; float vr[8], vi[8];
#pragma unroll
        for (int j = 0; j < 8; ++j) { const float br = b_re[(g * 64 + p) * 16 + 8 * hi + j], bi = b_im[(g * 64 + p) * 16 + 8 * hi + j]; vr[j] = qr * br - qi * bi; vi[j] = qr * bi + qi * br; }
        wr_.x = cvt_pk(vr[0], vr[1]); wr_.y = cvt_pk(vr[2], vr[3]); wr_.z = cvt_pk(vr[4], vr[5]); wr_.w = cvt_pk(vr[6], vr[7]);
        wi_.x = cvt_pk(vi[0], vi[1]); wi_.y = cvt_pk(vi[2], vi[3]); wi_.z = cvt_pk(vi[4], vi[5]); wi_.w = cvt_pk(vi[6], vi[7]);
        bfr[2 * s] = __builtin_bit_cast(bf16x8, wr_); bfr[2 * s + 1] = __builtin_bit_cast(bf16x8, wi_); }
    bf16x8 cfr[4];
#pragma unroll
    for (int ks = 0; ks < 4; ++ks) { float v[8];
#pragma unroll
        for (int j = 0; j < 8; ++j) { const int c = 32 * ks + 8 * q4 + j, p = c >> 1; const int h = lane & 15; v[j] = (c & 1) ? -c_im[(g * 16 + h) * 64 + p] : c_re[(g * 16 + h) * 64 + p]; }
        u32x4 w; w.x = cvt_pk(v[0], v[1]); w.y = cvt_pk(v[2], v[3]); w.z = cvt_pk(v[4], v[5]); w.w = cvt_pk(v[6], v[7]); cfr[ks] = __builtin_bit_cast(bf16x8, w); }
    float dv[4];
#pragma unroll
    for (int r = 0; r < 4; ++r) dv[r] = dsk[g * 16 + 4 * q4 + r];
    const int tm = 16 * ((p0 >> 2) & 1) + 4 * (p0 >> 3) + (p0 & 3);
    const bf16_t* urow = H0 + (size_t)(b * 2048 + tm) * 2048 + g * 16 + 8 * hi;
    float cr[2] = {0.f, 0.f}, ci[2] = {0.f, 0.f};
    bf16x8 ufr = *(const bf16x8*)urow;
    for (int tile = 0; tile < 64; ++tile) {
        const bf16x8 ucur = ufr;
        if (tile + 1 < 64) ufr = *(const bf16x8*)(urow + (size_t)(tile + 1) * 32 * 2048);
        f32x16 x[4];
#pragma unroll
        for (int n = 0; n < 4; ++n) { f32x16 z;
#pragma unroll
            for (int r = 0; r < 16; ++r) z[r] = 0.f;
            x[n] = __builtin_amdgcn_mfma_f32_32x32x16_bf16(ucur, bfr[n], z, 0, 0, 0); }
#pragma unroll
        for (int s = 0; s < 2; ++s) {
            f32x16& xr = x[2 * s]; f32x16& xi = x[2 * s + 1];
            float sr = hi ? 0.f : cr[s], si = hi ? 0.f : ci[s];
#pragma unroll
            for (int r = 0; r < 16; ++r) { const float nr = ar[s] * sr - ai[s] * si + xr[r], ni = ar[s] * si + ai[s] * sr + xi[r]; xr[r] = nr; xi[r] = ni; sr = nr; si = ni; }
            const float o_r = swap32(sr), o_i = swap32(si);
            float wr_ = hi ? o_r : 0.f, wi_ = hi ? o_i : 0.f;
#pragma unroll
            for (int r = 0; r < 16; ++r) { const float nr = ar[s] * wr_ - ai[s] * wi_, ni = ar[s] * wi_ + ai[s] * wr_; wr_ = nr; wi_ = ni; xr[r] += wr_; xi[r] += wi_; }
            const float e_r = swap32(xr[15]), e_i = swap32(xi[15]);
            cr[s] = hi ? xr[15] : e_r; ci[s] = hi ? xi[15] : e_i;
#pragma unroll
            for (int r = 0; r < 16; ++r) *(LAS unsigned*)(sl + (16 * hi + r) * 256 + (p0 + 32 * s) * 4) = cvt_pk(xr[r], xi[r]);
        }
#pragma unroll
        for (int tt = 0; tt < 2; ++tt) {
            f32x4 y = {0.f, 0.f, 0.f, 0.f};
#pragma unroll
            for (int ks = 0; ks < 4; ++ks) { const bf16x8 sf = *(const LAS bf16x8*)(sl + (16 * tt + (lane & 15)) * 256 + ks * 64 + q4 * 16); y = __builtin_amdgcn_mfma_f32_16x16x32_bf16(cfr[ks], sf, y, 0, 0, 0); }
            const int t = tile * 32 + 16 * tt + (lane & 15);
            const u32x2 uw = *(const u32x2*)(H0 + (size_t)(b * 2048 + t) * 2048 + g * 16 + 4 * q4);
            const float y0 = gelu_tanh(y[0] + dv[0] * bflo(uw.x)), y1 = gelu_tanh(y[1] + dv[1] * bfhi(uw.x)), y2 = gelu_tanh(y[2] + dv[2] * bflo(uw.y)), y3 = gelu_tanh(y[3] + dv[3] * bfhi(uw.y));
            u32x2 ow; ow.x = cvt_pk(y0, y1); ow.y = cvt_pk(y2, y3);
            *(u32x2*)(YS + (size_t)(b * 2048 + t) * 512 + g * 16 + 4 * q4) = ow;
        }
    }
}

constexpr int AT_K = 0, AT_V = 24576, AT_WS = 49152, AT_OST = 51200, AT_LUT = AT_OST + 8 * 4096  , AT_LUTB = 8704, AT_Q = AT_LUT + 8 * AT_LUTB  , AT_END = AT_Q + 64;
DEV int crow(int r, int hi) { return (r & 3) + 8 * (r >> 2) + 4 * hi; }
DEV s16x4 vtr(const LAS unsigned char* p) { typedef short v4i16_t __attribute__((ext_vector_type(4))); return __builtin_bit_cast(s16x4, __builtin_amdgcn_ds_read_tr16_b64_v4i16((LAS v4i16_t*)p)); }
DEV void moba_unit(Frame& F, int b, int h, int own) {
    const int lane = F.lane, wid = F.wave, r32 = lane & 31, hi = lane >> 5;
    LAS unsigned char* lds = F.lds;
    const bf16_t* H0 = WSP(bf16_t, W_HB); const float* KM = WSP(float, W_KM);
    LAS float* lut = (LAS float*)(lds + AT_LUT + h * AT_LUTB); LAS float* wsf = (LAS float*)(lds + AT_WS) + wid * 64;
    const size_t rowbase = (size_t)b * 2048;
    const int qpos = own * 256 + wid * 32 + r32;
    bf16x8 qr[4];
#pragma unroll
    for (int d0 = 0; d0 < 4; ++d0) qr[d0] = *(const bf16x8*)(H0 + (rowbase + qpos) * 2048 + 512 + h * 64 + d0 * 16 + hi * 8);
    unsigned selmask = 0u;
    if (own > 0) {
        float gate[7];
#pragma unroll
        for (int j = 0; j < 7; ++j) { float s = 0.f;
            if (j < own) { const float* km = KM + ((size_t)(b * 8 + h) * 8 + j) * 64 + hi * 8;
#pragma unroll
                for (int d0 = 0; d0 < 4; ++d0) { const f32x4 k0 = *(const f32x4*)(km + d0 * 16), k1 = *(const f32x4*)(km + d0 * 16 + 4); const u32x4 qw = __builtin_bit_cast(u32x4, qr[d0]);
                    s += bflo(qw.x) * k0.x + bfhi(qw.x) * k0.y + bflo(qw.y) * k0.z + bfhi(qw.y) * k0.w + bflo(qw.z) * k1.x + bfhi(qw.z) * k1.y + bflo(qw.w) * k1.z + bfhi(qw.w) * k1.w; } }
            gate[j] = s + swap32(s); }
#pragma unroll
        for (int j = 0; j < 7; ++j) { int rank = 0;
#pragma unroll
            for (int j2 = 0; j2 < 7; ++j2) if (j2 != j && j2 < own && (gate[j2] > gate[j] || (gate[j2] == gate[j] && j2 < j))) ++rank;
            if (j < own && rank < 3) selmask |= 1u << j; }
    }
    const int NT = 4 * (own + 1);
#define KV0(i) ((i) < 4 ? own * 256 + (i) * 64 : (((i) - 4) >> 2) * 256 + (((i) - 4) & 3) * 64)
    const bf16_t* kbase = H0 + (rowbase + lane) * 2048 + 1024 + h * 64 + wid * 8;
    const bf16_t* vbase = H0 + (rowbase + 16 * (wid & 3) + (lane >> 2)) * 2048 + 1536 + h * 64 + (wid >> 2) * 32 + (lane & 3) * 8;
#define LOADKV(i, bo_) do { const int kv0_ = KV0(i); \
        __builtin_amdgcn_global_load_lds((const unsigned*)(kbase + (size_t)kv0_ * 2048), (LAS unsigned*)(lds + AT_K + bo_ + wid * 1024), 16, 0, 0); \
        __builtin_amdgcn_global_load_lds((const unsigned*)(vbase + (size_t)kv0_ * 2048), (LAS unsigned*)(lds + AT_V + bo_ + wid * 1024), 16, 0, 0); } while (0)
    LOADKV(0, 0); LOADKV(1, 8192);
    int bo = 0, bo2 = 16384;
    float m_ref = 0.f, l_run = 0.f; f32x16 o[2];
#pragma unroll
    for (int r = 0; r < 16; ++r) { o[0][r] = 0.f; o[1][r] = 0.f; }
    const int Q0 = own * 256 + wid * 32;
#pragma unroll 1
    for (int i = 0; i < NT; ++i) {
        if (i + 1 < NT) asm volatile("s_waitcnt vmcnt(2) lgkmcnt(0)\n\ts_barrier" ::: "memory"); else asm volatile("s_waitcnt vmcnt(0) lgkmcnt(0)\n\ts_barrier" ::: "memory");
        if (i + 2 < NT) LOADKV(i + 2, bo2);
        const int kv0 = KV0(i);
        const bool ownblk = i < 4;
        if (!(ownblk && kv0 > Q0 + 31)) {
            const bool partial = ownblk && (kv0 + 63 > Q0);
            const bool rowsel = ownblk || ((selmask >> ((i - 4) >> 2)) & 1u);
            f32x16 p0, p1;
            { const LAS float* lp = lut + 128 + (qpos - kv0 - 4 * hi - 59);
#pragma unroll
              for (int r = 0; r < 16; ++r) { const int c = (r & 3) + 8 * (r >> 2); p0[r] = lp[59 - c] - m_ref; p1[r] = lp[59 - c - 32] - m_ref; } }
            { const LAS unsigned char* kb = lds + AT_K + bo + hi * 1024 + r32 * 16;
#pragma unroll
              for (int d0 = 0; d0 < 4; ++d0) { const bf16x8 k0 = *(const LAS bf16x8*)(kb + d0 * 2048), k1 = *(const LAS bf16x8*)(kb + d0 * 2048 + 512);
                  p0 = __builtin_amdgcn_mfma_f32_32x32x16_bf16(k0, qr[d0], p0, 0, 0, 0); p1 = __builtin_amdgcn_mfma_f32_32x32x16_bf16(k1, qr[d0], p1, 0, 0, 0); } }
            if (partial) { const int dbase = qpos - kv0 - 4 * hi;
#pragma unroll
                for (int r = 0; r < 16; ++r) { const int d0_ = dbase - ((r & 3) + 8 * (r >> 2)); p0[r] = d0_ >= 0 ? p0[r] : -INFINITY; p1[r] = d0_ >= 32 ? p1[r] : -INFINITY; } }
            float rmax = fmaxf(p0[0], p1[0]);
#pragma unroll
            for (int r = 1; r < 16; ++r) rmax = fmaxf(rmax, fmaxf(p0[r], p1[r]));
            rmax = fmaxf(rmax, swap32(rmax));
            rmax = rowsel ? rmax : -INFINITY;
            if (i == 0 || __any(rmax > 8.f)) {
                const float dl = (i == 0) ? rmax : fmaxf(rmax, 0.f); m_ref += dl;
#pragma unroll
                for (int r = 0; r < 16; ++r) { p0[r] -= dl; p1[r] -= dl; }
                const float alpha = __builtin_amdgcn_exp2f(-dl); l_run *= alpha;
                if (hi == 0) wsf[r32] = alpha;
#pragma unroll
                for (int r = 0; r < 16; ++r) { const float f = wsf[crow(r, hi)]; o[0][r] *= f; o[1][r] *= f; }
            }
            float rs = 0.f;
#pragma unroll
            for (int r = 0; r < 16; ++r) { p0[r] = __builtin_amdgcn_exp2f(p0[r]); p1[r] = __builtin_amdgcn_exp2f(p1[r]); rs += p0[r] + p1[r]; }
            l_run += rowsel ? rs : 0.f;
            const unsigned km = rowsel ? 0xffffffffu : 0u;
            u32x4 pw[4];
            pw[0] = (u32x4){cvt_pk(p0[0], p0[1]) & km, cvt_pk(p0[2], p0[3]) & km, cvt_pk(p0[4], p0[5]) & km, cvt_pk(p0[6], p0[7]) & km};
            pw[1] = (u32x4){cvt_pk(p0[8], p0[9]) & km, cvt_pk(p0[10], p0[11]) & km, cvt_pk(p0[12], p0[13]) & km, cvt_pk(p0[14], p0[15]) & km};
            pw[2] = (u32x4){cvt_pk(p1[0], p1[1]) & km, cvt_pk(p1[2], p1[3]) & km, cvt_pk(p1[4], p1[5]) & km, cvt_pk(p1[6], p1[7]) & km};
            pw[3] = (u32x4){cvt_pk(p1[8], p1[9]) & km, cvt_pk(p1[10], p1[11]) & km, cvt_pk(p1[12], p1[13]) & km, cvt_pk(p1[14], p1[15]) & km};
            { const LAS unsigned char* vp = lds + AT_V + bo + ((lane >> 4) & 1) * 32 + (lane & 3) * 8 + (4 * hi + ((lane & 15) >> 2)) * 64;
#pragma unroll
              for (int d0 = 0; d0 < 2; ++d0)
#pragma unroll
                  for (int ks = 0; ks < 4; ++ks) { const s16x4 lo = vtr(vp + d0 * 4096 + ks * 1024), hh = vtr(vp + d0 * 4096 + ks * 1024 + 512);
                      const bf16x8 vf = (bf16x8){lo[0], lo[1], lo[2], lo[3], hh[0], hh[1], hh[2], hh[3]};
                      o[d0] = __builtin_amdgcn_mfma_f32_32x32x16_bf16(__builtin_bit_cast(bf16x8, pw[ks]), vf, o[d0], 0, 0, 0); } }
        }
        bo = (bo == 16384) ? 0 : bo + 8192; bo2 = (bo2 == 16384) ? 0 : bo2 + 8192;
    }
    __syncthreads();
#undef KV0
#undef LOADKV
    l_run += swap32(l_run);
    if (hi == 0) wsf[32 + r32] = 1.f / l_run;
    bf16_t* Ow = WSP(bf16_t, W_Y0) + (rowbase + own * 256 + wid * 32) * 1024 + 512 + h * 64;
    LAS bf16_t* stg = (LAS bf16_t*)(lds + AT_OST) + wid * 2048;
#pragma unroll
    for (int r = 0; r < 16; ++r) { const int orow = crow(r, hi); const float rl = wsf[32 + orow];
        stg[orow * 64 + r32] = (bf16_t)(cvt_pk(o[0][r] * rl, 0.f) & 0xffffu); stg[orow * 64 + 32 + r32] = (bf16_t)(cvt_pk(o[1][r] * rl, 0.f) & 0xffffu); }
#pragma unroll
    for (int i = 0; i < 4; ++i) { const int row = i * 8 + (lane >> 3), ch = lane & 7; const u32x4 v = *(const LAS u32x4*)(stg + row * 64 + ch * 8); *(u32x4*)(Ow + (size_t)row * 1024 + ch * 8) = v; }
    __syncthreads();
}
constexpr int CW_MOBAQ = 64;
DEV void p_s5_moba(Frame& F, int mode) {
    if ((mode & 1) && (F.vcu & 3) == 3) { const int it = (F.vcu >> 2) * 8 + F.wave; if (it < 512) s5_item(F, it >> 5, it & 31, F.lds + 65536 + F.wave * 8192); }
    __syncthreads();
    if (!(mode & 2)) return;
    for (int i = F.tid; i < 8 * 2176; i += 512) { const int hh = i / 2176, j = i % 2176; ((LAS float*)(F.lds + AT_LUT))[i] = j < 128 ? 0.f : WSP(float, W_LUT)[hh * 2048 + j - 128]; }
    volatile LAS int* qw = (volatile LAS int*)(F.lds + AT_Q);
    unsigned* ctl = (unsigned*)(F.ws + W_CTL);
    for (;;) {
        __syncthreads();
        if (F.tid == 0) qw[0] = (int)__hip_atomic_fetch_add(ctl + CW_MOBAQ, 1u, __ATOMIC_RELAXED, __HIP_MEMORY_SCOPE_AGENT);
        __syncthreads();
        const int u = __builtin_amdgcn_readfirstlane(qw[0]);
        if (u >= 1024) break;
        const int own = 7 - (u >> 7), bh = u & 127;
        moba_unit(F, bh >> 3, bh & 7, own);
    }
}
constexpr size_t R_RE = W_ROUTE, R_RW = W_ROUTE + 512 * 1024, R_POS = W_ROUTE + 1024 * 1024, R_TOK = W_ROUTE + 2 * MiB, R_WGT = W_ROUTE + 3 * MiB;
constexpr int WT_PITCH = 1028;
constexpr int RW_PITCH = 1032;
constexpr int LN_XT = 32 * RW_PITCH * 2;
constexpr int LN_LG = 147456;
constexpr int LN_HIST = LN_LG + 8 * 528;
static_assert(LN_XT + 8 * 8256 <= LDS_TOK && LN_HIST + 128 <= LDSCTL_OFF, "LN LDS map");
template <int MODE, bool ROUTER, bool XIN_F32, bool OUT_F32, bool GRP = false>
DEV void p_ln(Frame& F, const float* xin32, const bf16_t* xinb, bf16_t* xoutb, float* xout32, const float* gam, const float* bet, const float* wrt, const float* brt) {
    LAS bf16_t* whi = (LAS bf16_t*)F.lds; LAS bf16_t* xt = (LAS bf16_t*)(F.lds + LN_XT) + F.wave * 4128; LAS float* lgs = (LAS float*)(F.lds + LN_LG) + F.wave * 132; LAS int* hist = (LAS int*)(F.lds + LN_HIST);
    const int lane = F.lane, l15 = lane & 15, q4 = lane >> 4;
    if constexpr (ROUTER) {
        for (int i = F.tid; i < 1024 * 32; i += 512) { const int k = i >> 5, e = i & 31; whi[e * RW_PITCH + k] = (bf16_t)(cvt_pk(wrt[i], 0.f) & 0xffffu); }
        if (F.tid < 32) hist[F.tid] = 0;
        __syncthreads();
    }
    if constexpr (GRP) {
        const u32x4* src = (const u32x4*)(WSP(bf16_t, W_IN1) + (size_t)3072 * 1024);
        for (int i = F.tid; i < 16 * 128; i += 512) { const int e = i >> 7, c = i & 127; *(LAS u32x4*)(whi + e * RW_PITCH + c * 8) = src[i]; }
        __syncthreads();
    }
    const bf16_t* MIXB = WSP(bf16_t, W_MIXB); const unsigned char* YS8 = WSP(unsigned char, W_YS); const int* POS = WSP(int, R_POS);
    int* RE = WSP(int, R_RE); float* RW = WSP(float, R_RW);
    const float alpha = 1.4142135623730951f;
    f32x4 gq[4], bq[4];
#pragma unroll
    for (int j = 0; j < 4; ++j) { gq[j] = *(const f32x4*)(gam + j * 256 + lane * 4); bq[j] = *(const f32x4*)(bet + j * 256 + lane * 4); }
    float bias8[8];
    if constexpr (ROUTER) {
#pragma unroll
        for (int r = 0; r < 8; ++r) bias8[r] = brt[(r >> 2) * 16 + 4 * q4 + (r & 3)]; }
    for (int wgi = F.vcu; wgi < 256; wgi += F.G) {
        const int r0 = wgi * 128 + F.wave * 16;
        constexpr bool PF = (MODE == 0) && !XIN_F32;
        u32x2 rx[4][4], rm[4][4];
        if constexpr (PF) {
#pragma unroll
            for (int u = 0; u < 4; ++u)
#pragma unroll
                for (int j = 0; j < 4; ++j) { rx[u][j] = *(const u32x2*)(xinb + (size_t)(r0 + u) * 1024 + j * 256 + lane * 4); rm[u][j] = *(const u32x2*)(MIXB + (size_t)(r0 + u) * 1024 + j * 256 + lane * 4); } }
#pragma unroll 1
        for (int i4 = 0; i4 < 16; i4 += 4) {
            float v[4][16];
            if constexpr (PF) {
#pragma unroll
                for (int u = 0; u < 4; ++u)
#pragma unroll
                    for (int j = 0; j < 4; ++j) { v[u][4 * j] = alpha * bflo(rx[u][j].x) + bflo(rm[u][j].x); v[u][4 * j + 1] = alpha * bfhi(rx[u][j].x) + bfhi(rm[u][j].x); v[u][4 * j + 2] = alpha * bflo(rx[u][j].y) + bflo(rm[u][j].y); v[u][4 * j + 3] = alpha * bfhi(rx[u][j].y) + bfhi(rm[u][j].y); }
                if (i4 + 4 < 16) {
#pragma unroll
                    for (int u = 0; u < 4; ++u)
#pragma unroll
                        for (int j = 0; j < 4; ++j) { rx[u][j] = *(const u32x2*)(xinb + (size_t)(r0 + i4 + 4 + u) * 1024 + j * 256 + lane * 4); rm[u][j] = *(const u32x2*)(MIXB + (size_t)(r0 + i4 + 4 + u) * 1024 + j * 256 + lane * 4); } }
            } else {
#pragma unroll
            for (int u = 0; u < 4; ++u) { const int row = r0 + i4 + u;
                if constexpr (XIN_F32) {
#pragma unroll
                    for (int j = 0; j < 4; ++j) { const f32x4 a = *(const f32x4*)(xin32 + (size_t)row * 1024 + j * 256 + lane * 4); v[u][4 * j] = alpha * a.x; v[u][4 * j + 1] = alpha * a.y; v[u][4 * j + 2] = alpha * a.z; v[u][4 * j + 3] = alpha * a.w; }
                } else {
#pragma unroll
                    for (int j = 0; j < 4; ++j) { const u32x2 a = *(const u32x2*)(xinb + (size_t)row * 1024 + j * 256 + lane * 4); v[u][4 * j] = alpha * bflo(a.x); v[u][4 * j + 1] = alpha * bfhi(a.x); v[u][4 * j + 2] = alpha * bflo(a.y); v[u][4 * j + 3] = alpha * bfhi(a.y); }
                }
                if constexpr (MODE == 0) {
#pragma unroll
                    for (int j = 0; j < 4; ++j) { const u32x2 m = *(const u32x2*)(MIXB + (size_t)row * 1024 + j * 256 + lane * 4); v[u][4 * j] += bflo(m.x); v[u][4 * j + 1] += bfhi(m.x); v[u][4 * j + 2] += bflo(m.y); v[u][4 * j + 3] += bfhi(m.y); }
                } else {
                    const int4 pos4 = *(const int4*)(POS + row * 4);
                    const int ps[4] = {__builtin_amdgcn_readfirstlane(pos4.x), __builtin_amdgcn_readfirstlane(pos4.y), __builtin_amdgcn_readfirstlane(pos4.z), __builtin_amdgcn_readfirstlane(pos4.w)};
#pragma unroll
                    for (int kx = 0; kx < 4; ++kx)
#pragma unroll
                        for (int j = 0; j < 4; ++j) { const unsigned m = *(const unsigned*)(YS8 + (size_t)ps[kx] * 1024 + j * 256 + lane * 4); const f32x2 lo2 = __builtin_amdgcn_cvt_pk_f32_fp8(m, false), hi2 = __builtin_amdgcn_cvt_pk_f32_fp8(m, true);
                            v[u][4 * j] += lo2.x * (1.f / 64.f); v[u][4 * j + 1] += lo2.y * (1.f / 64.f); v[u][4 * j + 2] += hi2.x * (1.f / 64.f); v[u][4 * j + 3] += hi2.y * (1.f / 64.f); }
                }
            }
            }
            float s1[4], s2[4];
#pragma unroll
            for (int u = 0; u < 4; ++u) { s1[u] = 0.f; s2[u] = 0.f;
#pragma unroll
                for (int q = 0; q < 16; ++q) { s1[u] += v[u][q]; s2[u] = fmaf(v[u][q], v[u][q], s2[u]); } }
#pragma unroll
            for (int o = 1; o < 64; o <<= 1) {
#pragma unroll
                for (int u = 0; u < 4; ++u) { s1[u] += __shfl_xor(s1[u], o); s2[u] += __shfl_xor(s2[u], o); } }
#pragma unroll
            for (int u = 0; u < 4; ++u) { const int row = r0 + i4 + u; const float mean = s1[u] * (1.f / 1024.f); const float var = fmaxf(s2[u] * (1.f / 1024.f) - mean * mean, 0.f); const float rstd = 1.f / sqrtf(var + 1e-5f);
#pragma unroll
                for (int j = 0; j < 4; ++j) { const int c = j * 256 + lane * 4; const f32x4 g4 = gq[j], b4 = bq[j];
                    const float y0 = (v[u][4 * j] - mean) * rstd * g4.x + b4.x, y1 = (v[u][4 * j + 1] - mean) * rstd * g4.y + b4.y, y2 = (v[u][4 * j + 2] - mean) * rstd * g4.z + b4.z, y3 = (v[u][4 * j + 3] - mean) * rstd * g4.w + b4.w;
                    if constexpr (OUT_F32) *(f32x4*)(xout32 + (size_t)row * 1024 + c) = (f32x4){y0, y1, y2, y3};
                    else { u32x2 w; w.x = cvt_pk(y0, y1); w.y = cvt_pk(y2, y3); *(u32x2*)(xoutb + (size_t)row * 1024 + c) = w;
                        if constexpr (ROUTER || GRP) { *(LAS u32x2*)(xt + u * RW_PITCH + c) = w; } } } }
            if constexpr (GRP) {
                f32x4 ga = {0.f, 0.f, 0.f, 0.f};
#pragma unroll 8
                for (int ks = 0; ks < 32; ++ks) { const bf16x8 xb = *(const LAS bf16x8*)(xt + (l15 & 3) * RW_PITCH + ks * 32 + q4 * 8), wa = *(const LAS bf16x8*)(whi + l15 * RW_PITCH + ks * 32 + q4 * 8);
                    ga = __builtin_amdgcn_mfma_f32_16x16x32_bf16(wa, xb, ga, 0, 0, 0); }
                if (l15 < 4) *(f32x4*)(WSP(float, W_GR) + (size_t)(r0 + i4 + l15) * 16 + 4 * q4) = ga; }
            if constexpr (ROUTER) {
                f32x4 acc[2] = {{0.f, 0.f, 0.f, 0.f}, {0.f, 0.f, 0.f, 0.f}};
#pragma unroll 8
                for (int ks = 0; ks < 32; ++ks) { const bf16x8 xb = *(const LAS bf16x8*)(xt + (l15 & 3) * RW_PITCH + ks * 32 + q4 * 8);
#pragma unroll
                    for (int mt = 0; mt < 2; ++mt) { const bf16x8 wa = *(const LAS bf16x8*)(whi + (mt * 16 + l15) * RW_PITCH + ks * 32 + q4 * 8); acc[mt] = __builtin_amdgcn_mfma_f32_16x16x32_bf16(wa, xb, acc[mt], 0, 0, 0); } }
                if (l15 < 4) {
#pragma unroll
                    for (int mt = 0; mt < 2; ++mt)
#pragma unroll
                        for (int r = 0; r < 4; ++r) lgs[l15 * 33 + mt * 16 + 4 * q4 + r] = acc[mt][r] + bias8[mt * 4 + r]; }
                if (lane < 4) { float lg[32];
#pragma unroll
                    for (int e = 0; e < 32; ++e) lg[e] = lgs[lane * 33 + e];
                    unsigned taken = 0u; float tv[4]; int ti[4];
#pragma unroll
                    for (int r = 0; r < 4; ++r) { float best = -INFINITY; int bi = 0;
#pragma unroll
                        for (int e = 0; e < 32; ++e) { const bool ok = !((taken >> e) & 1u) && lg[e] > best; best = ok ? lg[e] : best; bi = ok ? e : bi; }
                        taken |= 1u << bi; tv[r] = best; ti[r] = bi; }
                    float ex[4], sm = 0.f;
#pragma unroll
                    for (int r = 0; r < 4; ++r) { ex[r] = __expf(tv[r] - tv[0]); sm += ex[r]; }
                    const float inv = 1.f / sm; const int row = r0 + i4 + lane;
                    *(int4*)(RE + row * 4) = make_int4(ti[0], ti[1], ti[2], ti[3]); *(f32x4*)(RW + row * 4) = (f32x4){ex[0] * inv, ex[1] * inv, ex[2] * inv, ex[3] * inv};
#pragma unroll
                    for (int r = 0; r < 4; ++r) atomicAdd((int*)(hist + ti[r]), 1); }
            }
        }
        if constexpr (ROUTER) { __syncthreads(); if (F.tid < 32) { WSP(int, W_HIST)[wgi * 32 + F.tid] = hist[F.tid]; hist[F.tid] = 0; } __syncthreads(); }
    }
}

DEV void p_sort(Frame& F) {
    LAS int* Ls = (LAS int*)F.lds; const int tid = F.tid;
    const int* HIST = WSP(int, W_HIST); int* SORT = WSP(int, W_SORT);
    const int* RE = WSP(int, R_RE); const float* RW = WSP(float, R_RW); int* POS = WSP(int, R_POS); int* TOK = WSP(int, R_TOK); float* WGT = WSP(float, R_WGT);
    for (int wgi = F.vcu; wgi < 256; wgi += F.G) {
        { const int e = tid & 31, part = tid >> 5; int tot = 0, pre = 0;
          for (int w = part * 16; w < part * 16 + 16; ++w) { const int hh = HIST[w * 32 + e]; tot += hh; pre += (w < wgi) ? hh : 0; }
          Ls[part * 32 + e] = tot; Ls[512 + part * 32 + e] = pre; }
        Ls[2048 + tid] = RE[wgi * 512 + tid];
        __syncthreads();
        if (tid < 32) { int tot = 0, pre = 0; for (int p = 0; p < 16; ++p) { tot += Ls[p * 32 + tid]; pre += Ls[512 + p * 32 + tid]; } Ls[1200 + tid] = tot; Ls[1300 + tid] = pre; }
        __syncthreads();
        if (tid == 0) { int a = 0; for (int e = 0; e < 32; ++e) { Ls[1024 + e] = a; a += (Ls[1200 + e] + 255) / 256 * 256; } Ls[1056] = a; }
        __syncthreads();
        { const int e = tid & 31, seg = tid >> 5; int cnt = 0;
#pragma unroll 8
          for (int i = 0; i < 32; ++i) cnt += (Ls[2048 + seg * 32 + i] == e) ? 1 : 0;
          Ls[3072 + seg * 32 + e] = cnt;
          __syncthreads();
          int c = Ls[1024 + e] + Ls[1300 + e];
          for (int s2 = 0; s2 < seg; ++s2) c += Ls[3072 + s2 * 32 + e];
#pragma unroll 8
          for (int i = 0; i < 32; ++i) if (Ls[2048 + seg * 32 + i] == e) { Ls[2560 + seg * 32 + i] = c; ++c; } }
        __syncthreads();
        { const int pos = Ls[2560 + tid]; TOK[pos] = wgi * 128 + (tid >> 2); WGT[pos] = RW[wgi * 512 + tid]; POS[wgi * 512 + tid] = pos; }
        { const bf16_t* XBBp = WSP(bf16_t, W_XBB); unsigned char* XS8 = WSP(unsigned char, W_X8);
          for (int rg = 0; rg < 16; rg += 4) {
              u32x4 a[4], b2[4];
#pragma unroll
              for (int u = 0; u < 4; ++u) { const int r = F.wave * 16 + rg + u; const u32x4* src = (const u32x4*)(XBBp + (size_t)(wgi * 128 + r) * 1024 + F.lane * 16); a[u] = src[0]; b2[u] = src[1]; }
#pragma unroll
              for (int u = 0; u < 4; ++u) { const int r = F.wave * 16 + rg + u;
                  u32x4 o; o.x = pk4_fp8(bflo(a[u].x) * 16.f, bfhi(a[u].x) * 16.f, bflo(a[u].y) * 16.f, bfhi(a[u].y) * 16.f); o.y = pk4_fp8(bflo(a[u].z) * 16.f, bfhi(a[u].z) * 16.f, bflo(a[u].w) * 16.f, bfhi(a[u].w) * 16.f);
                  o.z = pk4_fp8(bflo(b2[u].x) * 16.f, bfhi(b2[u].x) * 16.f, bflo(b2[u].y) * 16.f, bfhi(b2[u].y) * 16.f); o.w = pk4_fp8(bflo(b2[u].z) * 16.f, bfhi(b2[u].z) * 16.f, bflo(b2[u].w) * 16.f, bfhi(b2[u].w) * 16.f);
#pragma unroll
                  for (int kx = 0; kx < 4; ++kx) { const int pos = Ls[2560 + r * 4 + kx]; *(u32x4*)(XS8 + (size_t)pos * 1024 + F.lane * 16) = o; } } }
          if (wgi < 32) { const int e = wgi; for (int r = Ls[1024 + e] + Ls[1200 + e] + F.wave; r < Ls[1024 + e + 1]; r += 8) *(u32x4*)(XS8 + (size_t)r * 1024 + F.lane * 16) = (u32x4){0u, 0u, 0u, 0u}; } }
        if (wgi < 32) { const int e = wgi; for (int r = Ls[1024 + e] + Ls[1200 + e] + tid; r < Ls[1024 + e + 1]; r += 512) { TOK[r] = 0; WGT[r] = 0.f; } }
        if (wgi == 0) { if (tid < 33) SORT[tid] = Ls[1024 + tid]; if (tid == 0) SORT[33] = Ls[1056] / 256;
            for (int pm = tid; pm < PMAX / 256; pm += 512) { int e = 0; for (int j = 1; j < 32; ++j) if (pm * 256 >= Ls[1024 + j]) e = j; SORT[64 + pm] = e; } }
        __syncthreads();
    }
}

DEV void p_gr(Frame& F) {
    const int gw = F.vcu * 8 + F.wave, NGW = F.G * 8, lane = F.lane, q4 = lane >> 4; const bf16_t* XB = WSP(bf16_t, W_XB); const bf16_t* Wg = WSP(bf16_t, W_IN1) + (size_t)3072 * 1024; float* GR = WSP(float, W_GR);
    for (int it = gw; it < T / 16; it += NGW) { f32x4 acc = {0.f, 0.f, 0.f, 0.f};
        const bf16_t* ap = XB + (size_t)(it * 16 + (lane & 15)) * 1024 + q4 * 8; const bf16_t* bp = Wg + (size_t)(lane & 15) * 1024 + q4 * 8;
        bf16x8 a[32], bb[32];
#pragma unroll
        for (int ks = 0; ks < 32; ++ks) { a[ks] = *(const bf16x8*)(ap + ks * 32); bb[ks] = *(const bf16x8*)(bp + ks * 32); }
#pragma unroll
        for (int ks = 0; ks < 32; ++ks) acc = __builtin_amdgcn_mfma_f32_16x16x32_bf16(a[ks], bb[ks], acc, 0, 0, 0);
#pragma unroll
        for (int r = 0; r < 4; ++r) GR[(size_t)(it * 16 + 4 * q4 + r) * 16 + (lane & 15)] = acc[r]; }
}

constexpr int GP = 264, GP2 = 144;
constexpr int GB_QIN = 0, GB_KST = 16896, GB_ATT = 35328, GB_DEC = 44544, GB_VT = 45056, GB_SIZE = 81920;
constexpr size_t W_GB = W_YS;
static_assert((size_t)2048 * GB_SIZE <= (size_t)PMAX * 2048, "blob region");
constexpr int GA_GRS = 0, GA_GT = 4096, GA_BL = 8192  , GA_QIN = GA_BL + GB_QIN, GA_KST = GA_BL + GB_KST, GA_ATT = GA_BL + GB_ATT, GA_DEC = GA_BL + GB_DEC, GA_KIN = GA_BL + 45056  , GA_VT = GA_KIN + 17408, GA_END = GA_VT + 36864;
DEV float logsigm_fast(float z) { const float e = __builtin_amdgcn_exp2f(-1.4426950408889634f * fabsf(z)); return fminf(z, 0.f) - 0.6931471805599453f * __builtin_amdgcn_logf(1.f + e); }
struct GlaRaw { unsigned q[16], k[16], v[32]; f32x4 ga, gb; };
DEV void p_gla_prep(Frame& F) {
    LAS unsigned char* lds = F.lds; const int tid = F.tid, lane = F.lane, wid = F.wave, q4 = lane >> 4, l15 = lane & 15;
    const bf16_t* H1 = WSP(bf16_t, W_HB); const float* GR = WSP(float, W_GR); unsigned char* GB = F.ws + W_GB;
    const float* wg2 = F.in[15]; const float* bg = F.in[16];
    for (int i = tid; i < 64 * GP2 / 4; i += 512) ((LAS unsigned*)(lds + GA_ATT))[i] = 0u;
    const int dk = 32 * (wid & 3) + (lane & 31), tg = 2 * (wid >> 2) + (lane >> 5);
    const int dvl = tid & 255, th2 = tid >> 8;
    const int tzm = 16 * (((lane & 31) >> 2) & 1) + 4 * ((lane & 31) >> 3) + (lane & 3);
    for (int wg = F.vcu; wg < 256; wg += F.G) {
        const int b = wg >> 4, h = (wg >> 2) & 3, n0 = (wg & 3) * 8;
        bf16x8 w2f; { float wv[8];
#pragma unroll
          for (int j = 0; j < 8; ++j) wv[j] = wg2[(8 * (lane >> 5) + j) * 512 + h * 128 + dk];
          const u32x4 ww = {cvt_pk(wv[0], wv[1]), cvt_pk(wv[2], wv[3]), cvt_pk(wv[4], wv[5]), cvt_pk(wv[6], wv[7])}; w2f = __builtin_bit_cast(bf16x8, ww); }
        const float bgv = bg[h * 128 + dk];
#define GLA_LOAD(R, n_) do { const size_t rb_ = (size_t)b * 2048 + (n_) * 64; \
        _Pragma("unroll") for (int i = 0; i < 16; ++i) { const size_t ro = (rb_ + 16 * tg + i) * 3072; R.q[i] = H1[ro + h * 128 + dk]; R.k[i] = H1[ro + 512 + h * 128 + dk]; } \
        _Pragma("unroll") for (int i = 0; i < 32; ++i) R.v[i] = H1[(rb_ + 32 * th2 + i) * 3072 + 1024 + h * 256 + dvl]; \
        { const float* gp_ = GR + (rb_ + 32 * (wid >> 2) + tzm) * 16 + 8 * (lane >> 5); R.ga = *(const f32x4*)gp_; R.gb = *(const f32x4*)(gp_ + 4); } } while (0)
        GlaRaw cur, nxt; GLA_LOAD(cur, n0); nxt = cur;
#pragma unroll 1
      for (int sub = 0; sub < 8; ++sub) { const int n = n0 + sub;
        if (sub + 1 < 8) GLA_LOAD(nxt, n + 1);
        float cs[16]; float run = 0.f;
        { const u32x4 aw = {cvt_pk(cur.ga.x, cur.ga.y), cvt_pk(cur.ga.z, cur.ga.w), cvt_pk(cur.gb.x, cur.gb.y), cvt_pk(cur.gb.z, cur.gb.w)};
          f32x16 zz;
#pragma unroll
          for (int r = 0; r < 16; ++r) zz[r] = bgv;
          zz = __builtin_amdgcn_mfma_f32_32x32x16_bf16(__builtin_bit_cast(bf16x8, aw), w2f, zz, 0, 0, 0);
#pragma unroll
          for (int i = 0; i < 16; ++i) { run += logsigm_fast(zz[i]) * (1.f / 16.f); cs[i] = run; } }
        ((LAS float*)(lds + GA_GT))[tg * 128 + dk] = run;
        __syncthreads();
        float off = 0.f, btot = 0.f;
#pragma unroll
        for (int g2 = 0; g2 < 4; ++g2) { const float gtv = ((LAS float*)(lds + GA_GT))[g2 * 128 + dk]; btot += gtv; off += (g2 < tg) ? gtv : 0.f; }
        if (tg == 0) ((LAS float*)(lds + GA_DEC))[dk] = __expf(btot);
        { unsigned kst[8];
#pragma unroll
          for (int i = 0; i < 16; i += 2) { float kk[2];
#pragma unroll
              for (int u = 0; u < 2; ++u) { const int t = 16 * tg + i + u; const float bc = cs[i + u] + off; const float qv = bflo(cur.q[i + u]), kv = bflo(cur.k[i + u]);
                  *(LAS bf16_t*)(lds + GA_QIN + t * GP + dk * 2) = (bf16_t)(cvt_pk(qv * __expf(bc), 0.f) & 0xffffu);
                  *(LAS bf16_t*)(lds + GA_KIN + t * 272 + dk * 2) = (bf16_t)(cvt_pk(kv * __expf(-bc), 0.f) & 0xffffu);
                  kk[u] = kv * __expf(btot - bc); }
              kst[i >> 1] = cvt_pk(kk[0], kk[1]); }
          *(LAS u32x4*)(lds + GA_KST + dk * GP2 + tg * 32) = (u32x4){kst[0], kst[1], kst[2], kst[3]};
          *(LAS u32x4*)(lds + GA_KST + dk * GP2 + tg * 32 + 16) = (u32x4){kst[4], kst[5], kst[6], kst[7]}; }
#pragma unroll
        for (int i = 0; i < 32; i += 8) *(LAS u32x4*)(lds + GA_VT + dvl * GP2 + (32 * th2 + i) * 2) = (u32x4){cur.v[i] | (cur.v[i + 1] << 16), cur.v[i + 2] | (cur.v[i + 3] << 16), cur.v[i + 4] | (cur.v[i + 5] << 16), cur.v[i + 6] | (cur.v[i + 7] << 16)};
        __syncthreads();
#pragma unroll
        for (int rep = 0; rep < 2; ++rep) { const int ti = wid + 8 * rep; if (ti < 10) {
            int jt, it2; if (ti < 4) { jt = 0; it2 = ti; } else if (ti < 7) { jt = 1; it2 = ti - 3; } else if (ti < 9) { jt = 2; it2 = ti - 5; } else { jt = 3; it2 = 3; }
            f32x4 a4 = {0.f, 0.f, 0.f, 0.f};
#pragma unroll
            for (int ks = 0; ks < 4; ++ks) { const bf16x8 kf = *(const LAS bf16x8*)(lds + GA_KIN + (16 * jt + l15) * 272 + ks * 64 + q4 * 16); const u32x2 q0_ = *(const LAS u32x2*)(lds + GA_QIN + (16 * it2 + l15) * GP + ks * 64 + q4 * 16), q1_ = *(const LAS u32x2*)(lds + GA_QIN + (16 * it2 + l15) * GP + ks * 64 + q4 * 16 + 8); const bf16x8 qf = __builtin_bit_cast(bf16x8, (u32x4){q0_.x, q0_.y, q1_.x, q1_.y});
                a4 = __builtin_amdgcn_mfma_f32_16x16x32_bf16(kf, qf, a4, 0, 0, 0); }
            const int i_ = 16 * it2 + l15, j0 = 16 * jt + 4 * q4;
            u32x2 w; w.x = cvt_pk(j0 <= i_ ? a4[0] : 0.f, j0 + 1 <= i_ ? a4[1] : 0.f); w.y = cvt_pk(j0 + 2 <= i_ ? a4[2] : 0.f, j0 + 3 <= i_ ? a4[3] : 0.f);
            *(LAS u32x2*)(lds + GA_ATT + i_ * GP2 + j0 * 2) = w; } }
        __syncthreads();
        unsigned char* blob = GB + (size_t)((b * 32 + n) * 4 + h) * GB_SIZE;
        for (int c = tid; c < 45056 / 16; c += 512) *(u32x4*)(blob + c * 16) = *(const LAS u32x4*)(lds + GA_BL + c * 16);
        for (int c = tid; c < 36864 / 16; c += 512) *(u32x4*)(blob + GB_VT + c * 16) = *(const LAS u32x4*)(lds + GA_VT + c * 16);
        cur = nxt;
      }
#undef GLA_LOAD
    }
}
constexpr int GS_BUF = 54272;
constexpr int GS_VT = 0, GS_QIN = 9216, GS_KST = GS_QIN + 16896, GS_ATT = GS_KST + 18432, GS_DEC = GS_ATT + 9216;
static_assert(3 * GS_BUF <= LDSCTL_OFF, "GLA ring");
DEV void gla_scan_item(Frame& F, int b, int h, int c4) {
    LAS unsigned char* lds = F.lds; const int lane = F.lane, wid = F.wave, q4 = lane >> 4, l15 = lane & 15;
    bf16_t* GO = WSP(bf16_t, W_GLAO); float* SS = WSP(float, W_SS); const unsigned char* GB = F.ws + W_GB;
    const int c16 = wid & 3, th = wid >> 2;
    f32x4 sacc[8];
#pragma unroll
    for (int m = 0; m < 8; ++m) sacc[m] = (f32x4){0.f, 0.f, 0.f, 0.f};
    const size_t rb = (size_t)b * 2048;
    float sqv[2][4]; unsigned ov[2][4];
#pragma unroll
    for (int mt = 0; mt < 2; ++mt)
#pragma unroll
        for (int r = 0; r < 4; ++r) { sqv[mt][r] = 0.f; ov[mt][r] = 0u; }
    const int npc = (wid < 5) ? 7 : 6;
#define GS_ISSUE(n_, bo_) do { const unsigned char* blob_ = GB + (size_t)((b * 32 + (n_)) * 4 + h) * GB_SIZE; \
        for (int p_ = wid; p_ < 53; p_ += 8) { const int so_ = p_ < 9 ? GB_VT + c4 * 9216 + p_ * 1024 : (p_ - 9) * 1024; \
            __builtin_amdgcn_global_load_lds((const unsigned*)(blob_ + so_ + lane * 16), (LAS unsigned*)(lds + (bo_) + p_ * 1024), 16, 0, 0); } } while (0)
    GS_ISSUE(0, 0); GS_ISSUE(1, GS_BUF);
    int bo = 0, bo2 = 2 * GS_BUF;
#pragma unroll 1
    for (int n = 0; n < 32; ++n) { const int t0 = n * 64;
        if (n + 1 < 32) { if (npc == 7) asm volatile("s_waitcnt vmcnt(7) lgkmcnt(0)\n\ts_barrier" ::: "memory"); else asm volatile("s_waitcnt vmcnt(6) lgkmcnt(0)\n\ts_barrier" ::: "memory"); } else asm volatile("s_waitcnt vmcnt(0) lgkmcnt(0)\n\ts_barrier" ::: "memory");
        if (n > 0) {
#pragma unroll
            for (int mt = 0; mt < 2; ++mt)
#pragma unroll
                for (int r = 0; r < 4; ++r) { const size_t trow = rb + (t0 - 64) + 32 * th + 16 * mt + 4 * q4 + r; GO[trow * 1024 + h * 256 + c4 * 64 + c16 * 16 + l15] = (bf16_t)ov[mt][r];
                    SS[(trow * 4 + h) * 16 + c4 * 4 + c16] = sqv[mt][r]; } }
        if (n + 2 < 32) GS_ISSUE(n + 2, bo2);
        const LAS unsigned char* bu = lds + bo;
        bf16x8 vf[2];
#pragma unroll
        for (int ks = 0; ks < 2; ++ks) vf[ks] = *(const LAS bf16x8*)(bu + GS_VT + (c16 * 16 + l15) * GP2 + ks * 64 + q4 * 16);
        bf16x8 sf[4];
#pragma unroll
        for (int ks = 0; ks < 4; ++ks) { const u32x4 w = {cvt_pk(sacc[2 * ks][0], sacc[2 * ks][1]), cvt_pk(sacc[2 * ks][2], sacc[2 * ks][3]), cvt_pk(sacc[2 * ks + 1][0], sacc[2 * ks + 1][1]), cvt_pk(sacc[2 * ks + 1][2], sacc[2 * ks + 1][3])}; sf[ks] = __builtin_bit_cast(bf16x8, w); }
#pragma unroll
        for (int mt = 0; mt < 2; ++mt) { const int i_ = 32 * th + 16 * mt + l15; f32x4 oa = {0.f, 0.f, 0.f, 0.f};
#pragma unroll
            for (int ks = 0; ks < 2; ++ks) { if (ks == 1 && th == 0) continue; const bf16x8 af = *(const LAS bf16x8*)(bu + GS_ATT + i_ * GP2 + ks * 64 + q4 * 16); oa = __builtin_amdgcn_mfma_f32_16x16x32_bf16(af, vf[ks], oa, 0, 0, 0); }
#pragma unroll
            for (int ks = 0; ks < 4; ++ks) { const u32x2 lo = *(const LAS u32x2*)(bu + GS_QIN + i_ * GP + (32 * ks + 4 * q4) * 2), hi2 = *(const LAS u32x2*)(bu + GS_QIN + i_ * GP + (32 * ks + 16 + 4 * q4) * 2);
                const u32x4 w = {lo.x, lo.y, hi2.x, hi2.y}; oa = __builtin_amdgcn_mfma_f32_16x16x32_bf16(__builtin_bit_cast(bf16x8, w), sf[ks], oa, 0, 0, 0); }
#pragma unroll
            for (int r = 0; r < 4; ++r) { ov[mt][r] = cvt_pk(oa[r], 0.f) & 0xffffu; float sq = oa[r] * oa[r]; sq += __shfl_xor(sq, 1); sq += __shfl_xor(sq, 2); sq += __shfl_xor(sq, 4); sq += __shfl_xor(sq, 8); sqv[mt][r] = sq; } }
#pragma unroll
        for (int md = 0; md < 8; ++md) { const f32x4 dc = *(const LAS f32x4*)(bu + GS_DEC + (16 * md + 4 * q4) * 4); sacc[md] = sacc[md] * dc;
#pragma unroll
            for (int ks = 0; ks < 2; ++ks) { const bf16x8 kf = *(const LAS bf16x8*)(bu + GS_KST + (16 * md + l15) * GP2 + ks * 64 + q4 * 16); sacc[md] = __builtin_amdgcn_mfma_f32_16x16x32_bf16(kf, vf[ks], sacc[md], 0, 0, 0); } }
        bo = (bo == 2 * GS_BUF) ? 0 : bo + GS_BUF; bo2 = (bo2 == 2 * GS_BUF) ? 0 : bo2 + GS_BUF;
    }
#undef GS_ISSUE
#pragma unroll
    for (int mt = 0; mt < 2; ++mt)
#pragma unroll
        for (int r = 0; r < 4; ++r) { const size_t trow = rb + 31 * 64 + 32 * th + 16 * mt + 4 * q4 + r; GO[trow * 1024 + h * 256 + c4 * 64 + c16 * 16 + l15] = (bf16_t)ov[mt][r]; SS[(trow * 4 + h) * 16 + c4 * 4 + c16] = sqv[mt][r]; }
    asm volatile("s_waitcnt vmcnt(0)" ::: "memory");
    __syncthreads();
}
DEV void p_gla_scan(Frame& F) { for (int v = F.vcu; v < 256; v += F.G) gla_scan_item(F, v >> 4, (v >> 2) & 3, v & 3); }

DEV void p_gla_norm(Frame& F) {
    const int gw = F.vcu * 8 + F.wave, NGW = F.G * 8, lane = F.lane; const bf16_t* GO = WSP(bf16_t, W_GLAO); const float* SS = WSP(float, W_SS); const bf16_t* H1 = WSP(bf16_t, W_HB); bf16_t* Y0 = WSP(bf16_t, W_Y0);
    const f32x4 nw = *(const f32x4*)(F.in[17] + lane * 4);
    for (int row = gw; row < T; row += NGW) {
#pragma unroll
        for (int h = 0; h < 4; ++h) { const float* sp = SS + ((size_t)row * 4 + h) * 16; const f32x4 a = *(const f32x4*)sp, b2 = *(const f32x4*)(sp + 4), c = *(const f32x4*)(sp + 8), d = *(const f32x4*)(sp + 12);
            const float sq = (a.x + a.y + a.z + a.w) + (b2.x + b2.y + b2.z + b2.w) + (c.x + c.y + c.z + c.w) + (d.x + d.y + d.z + d.w); const float r = 1.f / sqrtf(sq * (1.f / 256.f) + 1e-5f);
            const u32x2 o = *(const u32x2*)(GO + (size_t)row * 1024 + h * 256 + lane * 4); const u32x2 g = *(const u32x2*)(H1 + (size_t)row * 3072 + 2048 + h * 256 + lane * 4);
            const float g0 = bflo(g.x), g1 = bfhi(g.x), g2 = bflo(g.y), g3 = bfhi(g.y);
            u32x2 w; w.x = cvt_pk(bflo(o.x) * r * nw.x * g0 * fast_sigm(g0), bfhi(o.x) * r * nw.y * g1 * fast_sigm(g1)); w.y = cvt_pk(bflo(o.y) * r * nw.z * g2 * fast_sigm(g2), bfhi(o.y) * r * nw.w * g3 * fast_sigm(g3));
            *(u32x2*)(Y0 + (size_t)row * 1024 + h * 256 + lane * 4) = w; } }
}
struct FStoreScale { bf16_t* O; int ldc, c_lo, c_hi; float sc; static constexpr int NSIDE = 0;
    DEV const void* side(const Unit&, int) const { return nullptr; }
    DEV NoPre pre(const Unit&, int, const LAS float*) const { return NoPre{}; }
    DEV void operator()(const Unit&, int row, int col, f32x4 v0, f32x4 v1, NoPre, const LAS float*) const { const float s = (col >= c_lo && col < c_hi) ? sc : 1.f;
        const u32x4 w = {cvt_pk(v0[0] * s, v0[1] * s), cvt_pk(v0[2] * s, v0[3] * s), cvt_pk(v1[0] * s, v1[1] * s), cvt_pk(v1[2] * s, v1[3] * s)}; *(u32x4*)(O + (size_t)row * ldc + col) = w; } };
struct Pre8 { f32x4 b0, b1; };
struct FGlu { const bf16_t* Y; bf16_t* O; const float* b; static constexpr int NSIDE = 0;
    DEV const void* side(const Unit&, int) const { return nullptr; }
    DEV Pre8 pre(const Unit&, int col, const LAS float*) const { return Pre8{*(const f32x4*)(b + col), *(const f32x4*)(b + col + 4)}; }
    DEV void operator()(const Unit&, int row, int col, f32x4 v0, f32x4 v1, const Pre8& pp, const LAS float*) const { const u32x4 y = *(const u32x4*)(Y + (size_t)row * 512 + col); const f32x4 b0 = pp.b0, b1 = pp.b1;
        const u32x4 w = {cvt_pk(bflo(y.x) * fast_sigm(v0[0] + b0.x), bfhi(y.x) * fast_sigm(v0[1] + b0.y)), cvt_pk(bflo(y.y) * fast_sigm(v0[2] + b0.z), bfhi(y.y) * fast_sigm(v0[3] + b0.w)),
                         cvt_pk(bflo(y.z) * fast_sigm(v1[0] + b1.x), bfhi(y.z) * fast_sigm(v1[1] + b1.y)), cvt_pk(bflo(y.w) * fast_sigm(v1[2] + b1.z), bfhi(y.w) * fast_sigm(v1[3] + b1.w))};
        *(u32x4*)(O + (size_t)row * 1024 + col) = w; } };
constexpr float ACT_SCALE = 4.f, WDN_SCALE = 128.f;
DEV float swiglu1s(float g, float u) { g = fminf(g, 7.f); u = __builtin_amdgcn_fmed3f(u, -7.f, 7.f); const float r = __builtin_amdgcn_rcpf(1.f + __builtin_amdgcn_exp2f(-1.702f * 1.4426950408889634f * g)); return (g * r) * fmaf(u, ACT_SCALE, ACT_SCALE); }
DEV f32x2 swiglu2(f32x2 g, f32x2 u) { g.x = fminf(g.x, 7.f); g.y = fminf(g.y, 7.f); u.x = __builtin_amdgcn_fmed3f(u.x, -7.f, 7.f); u.y = __builtin_amdgcn_fmed3f(u.y, -7.f, 7.f);
    const f32x2 a = g * (-1.702f * 1.4426950408889634f); f32x2 e; e.x = __builtin_amdgcn_exp2f(a.x); e.y = __builtin_amdgcn_exp2f(a.y); e = e + 1.f;
    f32x2 r; r.x = __builtin_amdgcn_rcpf(e.x); r.y = __builtin_amdgcn_rcpf(e.y); return (g * r) * (u * ACT_SCALE + ACT_SCALE); }
struct FSwiglu { unsigned char* ACT; const float* bgu; float sc; static constexpr int NSIDE = 1;
    DEV const void* side(const Unit& u, int) const { return bgu + (size_t)u.e * 2048 + u.pn * BM; }
    DEV Pre8 pre(const Unit&, int, const LAS float* sb) const { return Pre8{*(const LAS f32x4*)sb, *(const LAS f32x4*)(sb + 4)}; }
    DEV void operator()(const Unit& u, int row, int col, f32x4 v0, f32x4 v1, const Pre8& pp, const LAS float*) const { const f32x4 b0 = pp.b0, b1 = pp.b1;
        const unsigned w = pk4_fp8(swiglu1s(fmaf(v0[0], sc, b0.x), fmaf(v0[1], sc, b0.y)), swiglu1s(fmaf(v0[2], sc, b0.z), fmaf(v0[3], sc, b0.w)), swiglu1s(fmaf(v1[0], sc, b1.x), fmaf(v1[1], sc, b1.y)), swiglu1s(fmaf(v1[2], sc, b1.z), fmaf(v1[3], sc, b1.w)));
        *(unsigned*)(ACT + (size_t)row * 1024 + (col >> 1)) = w; } };
constexpr float YS_SCALE = 64.f;
struct FDown { unsigned char* YS; const float* bd; const float* wgt; float sc; static constexpr int NSIDE = 2;
    DEV const void* side(const Unit& u, int k) const { return k == 0 ? (const void*)(bd + (size_t)u.e * 1024 + u.pn * BM) : (const void*)(wgt + (size_t)u.pm * BM); }
    DEV Pre8 pre(const Unit&, int, const LAS float* sb) const { return Pre8{*(const LAS f32x4*)sb, *(const LAS f32x4*)(sb + 4)}; }
    DEV void operator()(const Unit& u, int row, int col, f32x4 v0, f32x4 v1, const Pre8& pp, const LAS float* sr) const { const f32x4 b0 = pp.b0, b1 = pp.b1; const float wt = *sr * YS_SCALE, ws_ = sc * wt;
        u32x2 w; w.x = pk4_fp8(fmaf(v0[0], ws_, b0.x * wt), fmaf(v0[1], ws_, b0.y * wt), fmaf(v0[2], ws_, b0.z * wt), fmaf(v0[3], ws_, b0.w * wt)); w.y = pk4_fp8(fmaf(v1[0], ws_, b1.x * wt), fmaf(v1[1], ws_, b1.y * wt), fmaf(v1[2], ws_, b1.z * wt), fmaf(v1[3], ws_, b1.w * wt));
        *(u32x2*)(YS + (size_t)row * 1024 + col) = w; } };

constexpr int NPH = 21;
constexpr float X8_SCALE = 16.f, WGU_SCALE = 64.f;
constexpr float QSCALE0 = 0.125f * 1.4426950408889634f, QSCALE1 = 0.08838834764831845f;


#define NOINL __device__ __forceinline__
struct PA { const float* const* in; unsigned char* ws; float* out; int wave; };
#define MKFRAME extern __shared__ __attribute__((aligned(16))) unsigned char lds_[]; Frame F; F.lds = (LAS unsigned char*)lds_; F.wave = pa.wave; F.lane = (int)__builtin_amdgcn_mbcnt_hi(~0u, __builtin_amdgcn_mbcnt_lo(~0u, 0u)); F.tid = F.wave * 64 + F.lane; \
    F.G = gridDim.x; { const int bx = blockIdx.x; F.vcu = (F.G % 8 == 0) ? (bx % 8) * (F.G / 8) + bx / 8 : bx; } F.in = pa.in; F.ws = pa.ws;
template <class Fn> DEV void dense_gemm(Frame& F, const bf16_t* A, const bf16_t* Bt, int nM, int nN, int K, const Fn& fn) {
    Gemm g; g.A = A; g.Bt = Bt; g.rowmap = nullptr; g.bstride = 0; g.KB = K * 2; g.wave = F.wave;
    StaticOrder S; S.init(nM, nN, F.G, (int)blockIdx.x, nullptr);
    EpiRow8<Fn> E{fn};
    gemm_phase<false, false, true>(F.lds, g, S, E);
}
NOINL void ph_prologue(PA pa) { MKFRAME p0_prologue(F); }
NOINL void ph_in0(PA pa) { MKFRAME dense_gemm(F, WSP(bf16_t, W_XB), WSP(bf16_t, W_IN0), T / 256, 8, 1024, FStoreScale{WSP(bf16_t, W_HB), 2048, 512, 1024, QSCALE0}); }
NOINL void ph_kmean(PA pa) { MKFRAME p_kmean(F); }
NOINL void ph_s5moba(PA pa, int mode) { MKFRAME p_s5_moba(F, mode); }
NOINL void ph_glu(PA pa) { MKFRAME dense_gemm(F, WSP(bf16_t, W_YS5), WSP(bf16_t, W_GLU), T / 256, 2, 512, FGlu{WSP(bf16_t, W_YS5), WSP(bf16_t, W_Y0), F.in[11]}); }
NOINL void ph_out(PA pa, int layer) { MKFRAME dense_gemm(F, WSP(bf16_t, W_Y0), layer ? WSP(bf16_t, W_OUT1) : WSP(bf16_t, W_OUT0), T / 256, 4, 1024, FStoreScale{WSP(bf16_t, W_MIXB), 1024, 0, 0, 1.f}); }
NOINL void ph_in1(PA pa) { MKFRAME dense_gemm(F, WSP(bf16_t, W_XB), WSP(bf16_t, W_IN1), T / 256, 12, 1024, FStoreScale{WSP(bf16_t, W_HB), 3072, 0, 512, QSCALE1}); p_gr(F); }
NOINL void ph_glaprep(PA pa) { MKFRAME p_gla_prep(F); }
NOINL void ph_glascan(PA pa) { MKFRAME p_gla_scan(F); }
NOINL void ph_glanorm(PA pa) { MKFRAME p_gla_norm(F); }
NOINL void ph_lnrouter(PA pa, int layer) { MKFRAME
    if (layer == 0) p_ln<0, true, false, false>(F, nullptr, WSP(bf16_t, W_XB), WSP(bf16_t, W_XBB), nullptr, F.in[19], F.in[20], F.in[23], F.in[24]);
    else p_ln<0, true, false, false>(F, nullptr, WSP(bf16_t, W_XB), WSP(bf16_t, W_XBB), nullptr, F.in[19] + 1024, F.in[20] + 1024, F.in[23] + (size_t)1024 * 32, F.in[24] + 32); }
NOINL void ph_sort(PA pa) { MKFRAME p_sort(F); }
NOINL void ph_gateup(PA pa, int layer) { MKFRAME const int* SORT = WSP(int, W_SORT);
    Gemm g; g.A = WSP(unsigned char, W_X8); g.Bt = WSP(unsigned char, W_GU) + (size_t)layer * 32 * 2048 * 1024; g.rowmap = nullptr; g.bstride = (size_t)2048 * 1024; g.KB = 1024; g.wave = F.wave;
    StaticOrder S; S.init(__builtin_amdgcn_readfirstlane(SORT[33]), 8, F.G, (int)blockIdx.x, (const LAS int*)(F.lds + LDS_ELIST)); fill_elist(F.lds, S, SORT + 64, F.tid);
    EpiRow8<FSwiglu> E{FSwiglu{WSP(unsigned char, W_ACT), F.in[26] + (size_t)layer * 32 * 2048, 1.f / (X8_SCALE * WGU_SCALE)}};
    gemm_phase<false, true, true>(F.lds, g, S, E); }
NOINL void ph_down(PA pa, int layer) { MKFRAME const int* SORT = WSP(int, W_SORT);
    Gemm g; g.A = WSP(unsigned char, W_ACT); g.Bt = WSP(unsigned char, W_DN) + (size_t)layer * 32 * 1024 * 1024; g.rowmap = nullptr; g.bstride = (size_t)1024 * 1024; g.KB = 1024; g.wave = F.wave;
    StaticOrder S; S.init(__builtin_amdgcn_readfirstlane(SORT[33]), 4, F.G, (int)blockIdx.x, (const LAS int*)(F.lds + LDS_ELIST)); fill_elist(F.lds, S, SORT + 64, F.tid);
    EpiRow8<FDown> E{FDown{WSP(unsigned char, W_YS), F.in[28] + (size_t)layer * 32 * 1024, WSP(float, R_WGT), 1.f / (ACT_SCALE * WDN_SCALE)}};
    gemm_phase<false, true, true>(F.lds, g, S, E); }
NOINL void ph_combine(PA pa, int layer) { MKFRAME
    if (layer == 0) p_ln<1, false, false, false, false>(F, nullptr, WSP(bf16_t, W_XBB), WSP(bf16_t, W_XB), nullptr, F.in[21], F.in[22], nullptr, nullptr);
    else p_ln<1, false, false, true>(F, nullptr, WSP(bf16_t, W_XBB), nullptr, pa.out, F.in[21] + 1024, F.in[22] + 1024, nullptr, nullptr); }

__global__ void __launch_bounds__(512, 2) mega(Args args) {
    extern __shared__ __attribute__((aligned(16))) unsigned char lds_[];
    LAS unsigned char* lds = (LAS unsigned char*)lds_;
    unsigned* ctl = (unsigned*)(args.ws + W_CTL);
    for (int u = threadIdx.x; u < (LDS_BYTES - LDSCTL_OFF) / 4; u += 512) ((LAS unsigned*)(lds + LDSCTL_OFF))[u] = 0u;
    __syncthreads();
    const int lo = args.ph_lo, hi = args.ph_hi;
    PA pa; pa.in = args.in; pa.ws = args.ws; pa.out = args.out; pa.wave = __builtin_amdgcn_readfirstlane(threadIdx.x >> 6);
    XcdBarrier bar; bar.bar = ctl + CW_BAR; bar.x = 0; bar.st = nullptr; bar.wave = pa.wave;
    if (hi - lo > 1) bar = xcd_barrier_post(ctl + CW_BAR, (volatile LAS unsigned*)(lds + MISC_OFF) + 8, pa.wave);
#define IN(k) (lo <= (k) && (k) < hi)
#ifdef DIAG_LO
    volatile LAS unsigned long long* tsl = (volatile LAS unsigned long long*)(lds + MISC_OFF + 128);
    if (blockIdx.x == 0 && threadIdx.x == 0) tsl[0] = __builtin_amdgcn_s_memrealtime();
#define STAMP(k) do { if (blockIdx.x == 0 && threadIdx.x == 0) tsl[(k) + 1] = __builtin_amdgcn_s_memrealtime(); } while (0)
#else
#define STAMP(k) do { } while (0)
#endif
#define SEAM(k) do { if (IN(k) && IN((k) + 1)) xcd_barrier(bar); STAMP(k); } while (0)
#ifndef REP_PHASE
#define REP_PHASE -1
#define REP_N 0
#endif
#define RUN(k, call) do { if (IN(k)) { call; if ((k) == REP_PHASE) { xcd_barrier(bar); call; } } } while (0)
    RUN(0, ph_prologue(pa)); SEAM(0);
    RUN(1, ph_in0(pa)); SEAM(1);
    RUN(2, ph_kmean(pa)); SEAM(2);
    if (IN(3)) { ph_s5moba(pa, 1); if (REP_PHASE == 30) ph_s5moba(pa, 1); ph_s5moba(pa, 2); if (REP_PHASE == 31) ph_s5moba(pa, 2); } SEAM(3);
    RUN(4, ph_glu(pa)); SEAM(4);
    RUN(5, ph_out(pa, 0)); SEAM(5);
    if (REP_PHASE == 99) { for (int q_ = 0; q_ < 20; ++q_) xcd_barrier(bar); }
    RUN(6, ph_lnrouter(pa, 0)); SEAM(6);
    RUN(7, ph_sort(pa)); SEAM(7);
    RUN(8, ph_gateup(pa, 0)); SEAM(8);
    RUN(9, ph_down(pa, 0)); SEAM(9);
    RUN(10, ph_combine(pa, 0)); SEAM(10);
    RUN(11, ph_in1(pa)); SEAM(11);
    RUN(12, ph_glaprep(pa)); SEAM(12);
    RUN(13, ph_glascan(pa)); SEAM(13);
    RUN(14, ph_glanorm(pa)); SEAM(14);
    RUN(15, ph_out(pa, 1)); SEAM(15);
    RUN(16, ph_lnrouter(pa, 1)); SEAM(16);
    RUN(17, ph_sort(pa)); SEAM(17);
    RUN(18, ph_gateup(pa, 1)); SEAM(18);
    RUN(19, ph_down(pa, 1)); SEAM(19);
    RUN(20, ph_combine(pa, 1));
#ifdef DIAG_LO
    xcd_barrier(bar); STAMP(20);
    if (blockIdx.x == 0 && threadIdx.x == 0) { const unsigned long long dtk = tsl[DIAG_HI + 1] - tsl[DIAG_LO]; const float f = (float)dtk * (0.01f / 10000.f); __hip_atomic_store(ctl + 8, __float_as_uint(f), __ATOMIC_RELAXED, __HIP_MEMORY_SCOPE_AGENT); }
    xcd_barrier(bar);
    { const float f = __uint_as_float(__hip_atomic_load(ctl + 8, __ATOMIC_RELAXED, __HIP_MEMORY_SCOPE_AGENT));
      for (size_t i = (size_t)blockIdx.x * 512 + threadIdx.x; i < (size_t)T * 1024; i += (size_t)gridDim.x * 512) args.out[i] *= (1.f + f); }
#endif
#undef IN
#undef SEAM
}

static int g_grid = 0;
static bool launch_setup(size_t ws_size) {
    if (g_grid == 0) {
        if (ws_size < W_END) { fprintf(stderr, "kernel_launch: workspace too small: %zu < %zu\n", ws_size, (size_t)W_END); g_grid = -1; return false; }
        int dev = 0, cus = 0, per_cu = 0;
        if (hipGetDevice(&dev) != hipSuccess || hipDeviceGetAttribute(&cus, hipDeviceAttributeMultiprocessorCount, dev) != hipSuccess) { g_grid = -1; return false; }
        if (hipFuncSetAttribute((const void*)mega, hipFuncAttributeMaxDynamicSharedMemorySize, LDS_BYTES) != hipSuccess) { fprintf(stderr, "kernel_launch: hipFuncSetAttribute failed\n"); g_grid = -1; return false; }
        if (hipOccupancyMaxActiveBlocksPerMultiprocessor(&per_cu, (const void*)mega, 512, LDS_BYTES) != hipSuccess || per_cu < 1) fprintf(stderr, "kernel_launch: occupancy query reports %d blocks/CU\n", per_cu);
        (void)hipGetLastError();
        g_grid = cus;
    }
    return g_grid > 0;
}
static void launch_phases(hipStream_t stream, void* const* d_in, void* d_out, void* d_ws, int lo, int hi) {
    Args a; memset(&a, 0, sizeof a);
    for (int i = 0; i < 29; ++i) a.in[i] = (const float*)d_in[i];
    a.out = (float*)d_out; a.ws = (unsigned char*)d_ws; a.ph_lo = lo; a.ph_hi = hi;
    hipLaunchKernelGGL(mega, dim3(g_grid), dim3(512), LDS_BYTES, stream, a);
}
}
extern "C" void kernel_launch(void* const* d_in, const int* in_sizes, int n_in, void* d_out, int out_size, void* d_ws, size_t ws_size, hipStream_t stream) {
    if (n_in != 29 || out_size != T * D) { fprintf(stderr, "kernel_launch: unexpected arguments (n_in %d, out_size %d)\n", n_in, out_size); return; }
    if (!fk::launch_setup(ws_size)) return;
    (void)hipMemsetAsync((char*)d_ws + fk::W_CTL, 0, fk::CTL_ZERO_BYTES, stream);
    fk::launch_phases(stream, d_in, d_out, d_ws, 0, fk::NPH);
}
```

```cpp
#include <hip/hip_runtime.h>
#include <type_traits>
#include <cstdio>
#include <cstdint>
#include <cmath>
#include <cstring>
#define DEV __device__ __forceinline__
constexpr int Bn = 16, L = 2048, D = 1024, T = Bn * L;
namespace fk {
#define LAS __attribute__((address_space(3)))
#define GAS __attribute__((address_space(1)))
typedef unsigned short bf16_t;
typedef short bf16x8 __attribute__((ext_vector_type(8)));
typedef short s16x4 __attribute__((ext_vector_type(4)));
typedef float f32x2 __attribute__((ext_vector_type(2)));
typedef float f32x4 __attribute__((ext_vector_type(4)));
typedef float f32x16 __attribute__((ext_vector_type(16)));
typedef unsigned u32x2 __attribute__((ext_vector_type(2)));
typedef unsigned u32x4 __attribute__((ext_vector_type(4)));
typedef __bf16 bf16x2_t __attribute__((ext_vector_type(2)));
struct u32x4x2 { u32x4 a, b; };
DEV unsigned cvt_pk(float lo, float hi) { f32x2 v = {lo, hi}; bf16x2_t b = __builtin_convertvector(v, bf16x2_t); return __builtin_bit_cast(unsigned, b); }
DEV float bflo(unsigned w) { return __uint_as_float(w << 16); }
DEV float bfhi(unsigned w) { return __uint_as_float(w & 0xffff0000u); }
DEV float fast_sigm(float x) { return __builtin_amdgcn_rcpf(1.f + __builtin_amdgcn_exp2f(-1.4426950408889634f * x)); }
DEV float gelu_tanh(float x) { const float u = 0.7978845608028654f * (x + 0.044715f * x * x * x); return x * fast_sigm(2.f * u); }
DEV float wave_sum(float v) {
#pragma unroll
    for (int o = 1; o < 64; o <<= 1) v += __shfl_xor(v, o);
    return v; }
DEV float swap32(float x) { auto rr = __builtin_amdgcn_permlane32_swap(__float_as_uint(x), __float_as_uint(x), false, false); return __uint_as_float((__builtin_amdgcn_mbcnt_lo(~0u, 0u) >> 5) ? rr[0] : rr[1]); }

constexpr int BM = 256, BK = 64, HALF = 128, HTB = HALF * BK * 2, STAGE_BYTES = 8 * HTB, NXCD = 8, WGM = 8;
constexpr int LDS_TOK = 135168 - 2048;
constexpr int LDS_SIDE = 135168;
constexpr int LDS_BYTES = 163840, LDSCTL_OFF = LDS_BYTES - 1024, MISC_OFF = LDSCTL_OFF + 320;

DEV int lds_byte(int r, int c) { const int st = (r >> 4) * 2 + (c >> 5), rr = r & 15, cc = c & 31, ob = rr * 64 + cc * 2; return st * 1024 + (ob ^ (((ob >> 9) & 1) << 5)); }
DEV void stage_rc(int b, int& R, int& C) { const int st = b / 1024, sb = b % 1024, swz = sb ^ (((sb >> 9) & 1) << 5); R = (st >> 1) * 16 + swz / 64; C = (st & 1) * 32 + (swz % 64) / 2; }
DEV int perm32(int rho) { const int n = rho >> 4, i = rho & 15; return 8 * (i >> 2) + 4 * n + (i & 3); }

struct Unit { int pm, pn, e; };
struct Gemm { const void* A; const void* Bt; const int* rowmap; size_t bstride; int KB; int wave; };

struct StaticOrder {
    int nM, nN, nwg, G, c; const LAS int* elist;
    DEV void init(int nM_, int nN_, int G_, int c_, const LAS int* el) { nM = nM_; nN = nN_; nwg = nM * nN; G = G_; c = c_; elist = el; }
    DEV bool place(int i, Unit& u) const {
        const long Lx = (long)i * G + c; if (Lx >= nwg) return false;
        int wgid = (int)Lx; { const int q = nwg / NXCD, r = nwg % NXCD, xcd = wgid % NXCD, off = wgid / NXCD; wgid = (xcd < r ? xcd * (q + 1) : r * (q + 1) + (xcd - r) * q) + off; }
        const int nig = WGM * nN, gid = wgid / nig, fm = gid * WGM, gsz = (nM - fm) < WGM ? (nM - fm) : WGM;
        u.pm = fm + ((wgid % nig) % gsz); u.pn = (wgid % nig) / gsz; u.e = 0; return true;
    }
    DEV bool next(int i, Unit& u) const { if (!place(i, u)) return false; if (elist) u.e = __builtin_amdgcn_readfirstlane(elist[i]); return true; }
};
template <class S_> struct DupOrder { S_ s; DEV bool next(int i, Unit& u) const { return s.next(i >> 1, u); } };
constexpr int LDS_ELIST = 135168 + 6144;
DEV void fill_elist(LAS unsigned char* lds, const StaticOrder& S, const int* tile_e, int tid) {
    LAS int* el = (LAS int*)(lds + LDS_ELIST);
    if (tid < 64) { Unit u; el[tid] = S.place(tid, u) ? tile_e[u.pm] : 0; }
    __syncthreads();
}

struct NoPre {};
constexpr int LDS_EST = 141568;
template <class F> struct EpiRow8 {
    static constexpr bool PERM = true, PERM2 = F::PERM2; static constexpr int NSIDE = F::NSIDE; F f;
    DEV const void* side(const Unit& u, int k) const { return f.side(u, k); }
    DEV void operator()(const f32x4 (&acc)[2][2][4][2], const Unit& u, int wr, int wc, int fr, int fq, const LAS float* sd, LAS unsigned char* lds) const {
        int ln_; asm volatile("v_mbcnt_lo_u32_b32 %0, -1, 0\n\tv_mbcnt_hi_u32_b32 %0, -1, %0" : "=v"(ln_)); fr = ln_ & 15; fq = ln_ >> 4;
        const int cl = wc * 32 + 8 * fq, c0 = u.pn * BM + cl;
        if constexpr (F::STAGE > 0) {
            constexpr int OB = F::STAGE; constexpr bool SPLIT = OB == 16; constexpr int RB = SPLIT ? 256 : 32 * OB, PITCH = RB + 16, CB = 32 * RB, VB = CB / 512;
            typedef typename F::PackT PackT;
            LAS unsigned char* est = lds + LDS_EST;
            const int wofs = (wr * 16 + fr) * PITCH + (wc * 4 + fq) * OB;
            const int o_ = ((wr * 4 + wc) * 64 + ln_) * VB, rc = o_ / RB, cb = o_ % RB, rofs = rc * PITCH + cb, rrow = (rc >> 4) * 64 + (rc & 15);
#define EPI_WAITBAR asm volatile("s_waitcnt lgkmcnt(0)\n\ts_barrier" ::: "memory")
            constexpr int NCH = SPLIT ? 16 : 8; typedef typename std::conditional<VB == 16, u32x4, u32x2>::type VT;
            auto wchunk = [&](int k) { const int ai = SPLIT ? (k >> 3) : (k >> 2), m = SPLIT ? ((k >> 1) & 3) : (k & 3); const int rl = ai * HALF + wr * 64 + m * 16 + fr; LAS unsigned char* b = est + (k & 1) * 8704;
                if constexpr (!SPLIT) {
                    *(LAS PackT*)(b + wofs) = f.pack(u, c0, acc[ai][0][m][0], acc[ai][0][m][1], f.pre(u, c0, sd + cl), sd + 256 + rl);
                    *(LAS PackT*)(b + wofs + 16 * OB) = f.pack(u, c0 + HALF, acc[ai][1][m][0], acc[ai][1][m][1], f.pre(u, c0 + HALF, sd + cl + HALF), sd + 256 + rl);
                } else { const int bj = k & 1;
                    *(LAS PackT*)(b + wofs) = f.pack(u, c0 + bj * HALF, acc[ai][bj][m][0], acc[ai][bj][m][1], f.pre(u, c0 + bj * HALF, sd + cl + bj * HALF), sd + 256 + rl); } };
            wchunk(0);
#pragma unroll
            for (int k = 0; k < NCH; ++k) { const int ai = SPLIT ? (k >> 3) : (k >> 2), m = SPLIT ? ((k >> 1) & 3) : (k & 3);
                EPI_WAITBAR;
                const VT v = *(const LAS VT*)(est + (k & 1) * 8704 + rofs);
                if (k + 1 < NCH) wchunk(k + 1);
                *(VT*)(f.rowptr(u, u.pm * BM + ai * HALF + m * 16 + rrow) + cb + (SPLIT ? (k & 1) * 256 : 0)) = v; }
#undef EPI_WAITBAR
        } else if constexpr (NSIDE > 0) {
#pragma unroll
            for (int ai = 0; ai < 2; ++ai)
#pragma unroll
                for (int m = 0; m < 4; ++m) { const int rl = ai * HALF + wr * 64 + m * 16 + fr, row = u.pm * BM + rl;
                    f(u, row, c0, acc[ai][0][m][0], acc[ai][0][m][1], f.pre(u, c0, sd + cl), sd + 256 + rl); f(u, row, c0 + HALF, acc[ai][1][m][0], acc[ai][1][m][1], f.pre(u, c0 + HALF, sd + cl + HALF), sd + 256 + rl); }
        } else {
        const auto p0 = f.pre(u, c0, sd + cl), p1 = f.pre(u, c0 + HALF, sd + cl + HALF);
#pragma unroll
        for (int ai = 0; ai < 2; ++ai)
#pragma unroll
            for (int m = 0; m < 4; ++m) { const int rl = ai * HALF + wr * 64 + m * 16 + fr, row = u.pm * BM + rl;
                f(u, row, c0, acc[ai][0][m][0], acc[ai][0][m][1], p0, sd + 256 + rl); f(u, row, c0 + HALF, acc[ai][1][m][0], acc[ai][1][m][1], p1, sd + 256 + rl); }
        }
    }
};

typedef int v8i_t __attribute__((ext_vector_type(8)));
typedef int v4i_t __attribute__((ext_vector_type(4)));
template <bool GATHER, bool FP8, bool ALIGN, int DUPK = 0, class Epi, class Sched>
DEV void gemm_phase(LAS unsigned char* lds, const Gemm g, const Sched& S, const Epi& E) {
    const int wid = g.wave, lane = (int)__builtin_amdgcn_mbcnt_hi(~0u, __builtin_amdgcn_mbcnt_lo(~0u, 0u)), tid = wid * 64 + lane, wr = wid >> 2, wc = wid & 3, fr = lane & 15, fq = lane >> 4;
    float z0 = 0.f; asm volatile("" : "+v"(z0));
    const int KB = g.KB, nt = KB / 128;
    int R0, C2; { int C; stage_rc(tid * 16, R0, C); C2 = C * 2; }
    unsigned voffB[2]; { int Rb = Epi::PERM ? ((R0 & ~31) + perm32(R0 & 31)) : R0; if constexpr (Epi::PERM2) Rb = (Rb & ~3) | ((Rb & 1) << 1) | ((Rb >> 1) & 1);
      voffB[0] = (unsigned)(Rb * KB + C2); voffB[1] = voffB[0] + 64u * (unsigned)KB; }
    const unsigned kstep = 128u, hstep = (unsigned)HALF * KB, tstep = 2u * hstep;
    const unsigned ldsw = (unsigned)wid * 1024u;
    const int aoff = lds_byte(wr * 64 + fr, fq * 8); int boff = lds_byte(wc * 32 + fr, fq * 8) + 4 * HTB; asm volatile("" : "+v"(boff));
    LAS int* tokb = (LAS int*)(lds + LDS_TOK);
    const auto rsA = __builtin_amdgcn_make_buffer_rsrc((void*)g.A, 0, 0x7fffffff, 0x00020000);
    const auto rsB = __builtin_amdgcn_make_buffer_rsrc((void*)g.Bt, 0, 0x7fffffff, 0x00020000);
    const auto rsT = __builtin_amdgcn_make_buffer_rsrc((void*)(GATHER ? (const void*)g.rowmap : g.A), 0, 0x7fffffff, 0x00020000);
#define PG8_SA(b, h) (((b) * 2 + (h)) * HTB)
#define PG8_SB(b, h) ((4 + (b) * 2 + (h)) * HTB)
#define PG8_STAGE(bufoff, rs, soff, voff) do { _Pragma("unroll") for (int _i = 0; _i < 2; ++_i) { \
        if constexpr (GATHER) __builtin_amdgcn_raw_ptr_buffer_load_lds(rs, (LAS void*)(lds + (bufoff) + ldsw + _i * 8192), 16, (int)(voff)[_i], (int)(soff), 0, 0); \
        else __builtin_amdgcn_raw_ptr_buffer_load_lds(rs, (LAS void*)(lds + (bufoff) + ldsw + _i * 8192), 16, (int)(voff)[0], (int)((soff) + _i * 64u * (unsigned)KB), 0, 0); } } while (0)
#define PG8_LDA(dst, b, h) do { _Pragma("unroll") for (int m = 0; m < 4; ++m) _Pragma("unroll") for (int k = 0; k < 2; ++k) dst[m][k] = *(const LAS bf16x8*)(lds + PG8_SA(b, h) + aoff + m * 2048 + k * 1024); } while (0)
#define PG8_LDB(dst, b, h) do { _Pragma("unroll") for (int n = 0; n < 2; ++n) _Pragma("unroll") for (int k = 0; k < 2; ++k) dst[n][k] = *(const LAS bf16x8*)(lds + boff + (PG8_SB(b, h) - 4 * HTB) + n * 2048 + k * 1024); } while (0)
#define PG8_CAT(x) __builtin_shufflevector(__builtin_bit_cast(v4i_t, x[0]), __builtin_bit_cast(v4i_t, x[1]), 0, 1, 2, 3, 4, 5, 6, 7)
#define PG8_MMA(ai, bj, At, Bt) do { __builtin_amdgcn_s_setprio(1); _Pragma("unroll") for (int m = 0; m < 4; ++m) _Pragma("unroll") for (int n = 0; n < 2; ++n) { \
        if constexpr (FP8) acc[ai][bj][m][n] = __builtin_amdgcn_mfma_scale_f32_16x16x128_f8f6f4(PG8_CAT(Bt[n]), PG8_CAT(At[m]), acc[ai][bj][m][n], 0, 0, 0, 0, 0, 0); \
        else { _Pragma("unroll") for (int k = 0; k < 2; ++k) acc[ai][bj][m][n] = __builtin_amdgcn_mfma_f32_16x16x32_bf16(Bt[n][k], At[m][k], acc[ai][bj][m][n], 0, 0, 0); } } __builtin_amdgcn_s_setprio(0); } while (0)
#define PG8_WAIT_V(n) asm volatile("s_waitcnt vmcnt(" #n ")" ::: "memory")
#define PG8_WAIT_L(n) asm volatile("s_waitcnt lgkmcnt(" #n ")" ::: "memory")
#define PG8_BAR __builtin_amdgcn_s_barrier()
#define PG8_SCHED __builtin_amdgcn_sched_barrier(0)
    Unit cur, nxt; int ui = 0;
    if (!S.next(0, cur)) return;
    f32x4 acc[2][2][4][2];
#pragma unroll
    for (int a = 0; a < 2; ++a)
#pragma unroll
        for (int b = 0; b < 2; ++b)
#pragma unroll
            for (int m = 0; m < 4; ++m)
#pragma unroll
                for (int n = 0; n < 2; ++n) acc[a][b][m][n] = (f32x4){z0, z0, z0, z0};
    bf16x8 At[4][2], B0[2][2], B1[2][2];
    unsigned cA, cB = (unsigned)cur.e * (unsigned)g.bstride + (unsigned)cur.pn * tstep;
    unsigned voffA[2]; voffA[0] = (unsigned)(R0 * KB + C2); voffA[1] = voffA[0] + 64u * (unsigned)KB;
    if constexpr (GATHER) { cA = 0u;
        if (wid < 4) __builtin_amdgcn_raw_ptr_buffer_load_lds(rsT, (LAS void*)(tokb + wid * 64), 4, (wid * 64 + lane) * 4, cur.pm * (BM * 4), 0, 0);
        asm volatile("s_waitcnt vmcnt(0)" ::: "memory"); __builtin_amdgcn_s_barrier();
    } else cA = (unsigned)cur.pm * tstep;
    const unsigned hA = GATHER ? 0u : hstep;
    LAS float* sideb = (LAS float*)(lds + LDS_SIDE);
#define PG8_SIDE(un, sel) do { if constexpr (Epi::NSIDE > 0) { if (wid < Epi::NSIDE) { const char* sp_ = (const char*)E.side(un, wid); int ln_ = (int)__builtin_amdgcn_mbcnt_hi(~0u, __builtin_amdgcn_mbcnt_lo(~0u, 0u)); asm volatile("" : "+v"(ln_)); \
        __builtin_amdgcn_global_load_lds((const unsigned*)(sp_ + ln_ * 16), (LAS unsigned*)(sideb + (sel) * 512 + wid * 256), 16, 0, 0); } } } while (0)
    PG8_SIDE(cur, 0);
#define PG8_OA(dst, sel, h) unsigned dst[2]; if constexpr (GATHER) { dst[0] = (unsigned)(tokb[(sel) * 256 + (h) * HALF + R0] * KB + C2); dst[1] = (unsigned)(tokb[(sel) * 256 + (h) * HALF + R0 + 64] * KB + C2); } else { dst[0] = voffA[0]; dst[1] = voffA[1]; }
    { PG8_OA(p0_, 0, 0); PG8_OA(p1_, 0, 1); PG8_STAGE(PG8_SB(0, 0), rsB, cB, voffB); PG8_STAGE(PG8_SB(0, 1), rsB, cB + hstep, voffB); PG8_STAGE(PG8_SA(0, 0), rsA, cA, p0_); PG8_STAGE(PG8_SA(0, 1), rsA, cA + hA, p1_); }
    if (wr == 1) PG8_BAR;
    PG8_WAIT_V(2); PG8_BAR;
    { PG8_OA(p0_, 0, 0); PG8_STAGE(PG8_SB(1, 0), rsB, cB + kstep, voffB); PG8_STAGE(PG8_SA(1, 0), rsA, cA + kstep, p0_); PG8_STAGE(PG8_SB(1, 1), rsB, cB + hstep + kstep, voffB); }
    PG8_WAIT_V(6); PG8_BAR;
    for (;;) {
        const bool has_next = S.next(ui + 1, nxt);
        unsigned nA = cA, nB = cB;
        if (has_next) { nB = (unsigned)nxt.e * (unsigned)g.bstride + (unsigned)nxt.pn * tstep;
            if constexpr (GATHER) { if (wid < 4) { const int ln_ = (int)__builtin_amdgcn_mbcnt_hi(~0u, __builtin_amdgcn_mbcnt_lo(~0u, 0u)); __builtin_amdgcn_raw_ptr_buffer_load_lds(rsT, (LAS void*)(tokb + ((ui + 1) & 1) * 256 + wid * 64), 4, (wid * 64 + ln_) * 4, nxt.pm * (BM * 4), 0, 0); } }
            else nA = (unsigned)nxt.pm * tstep;
            PG8_SIDE(nxt, (ui + 1) % 3); }
#pragma unroll 1
        for (int t = 0; t < nt; t += 2) {
            const bool last = (t == nt - 2);
            const unsigned tq_ = (DUPK == 3 && !(ui & 1)) ? 0u : 1u;
            const unsigned a1 = cA + (unsigned)(t + 1) * kstep * tq_;
            const unsigned a2 = last ? nA : cA + (unsigned)(t + 2) * kstep * tq_, b2 = last ? nB : cB + (unsigned)(t + 2) * kstep * tq_;
            const unsigned a3 = a2 + kstep, b3 = b2 + kstep;
            const bool dz_ = (DUPK >= 2) && !(ui & 1);
            const auto rsZ = __builtin_amdgcn_make_buffer_rsrc((void*)g.A, 0, 0, 0x00020000);
            const auto rsA1 = (DUPK == 2 && dz_) ? rsZ : rsA, rsA2 = (DUPK == 2 && dz_ && !last) ? rsZ : rsA, rsB2 = (DUPK == 2 && dz_ && !last) ? rsZ : rsB;
            const int selc = ui & 1, seln = (last && has_next) ? ((ui + 1) & 1) : selc;
            PG8_LDB(B0, 0, 0); PG8_LDB(B1, 0, 1); PG8_SCHED; PG8_LDA(At, 0, 0); { PG8_OA(q_, selc, 1); PG8_STAGE(PG8_SA(1, 1), rsA1, a1 + hA, q_); }
            PG8_WAIT_V(8); PG8_WAIT_L(0); PG8_BAR; PG8_MMA(0, 0, At, B0); PG8_MMA(0, 1, At, B1); PG8_BAR; PG8_SCHED;
            PG8_LDA(At, 0, 1); PG8_STAGE(PG8_SB(0, 0), rsB2, b2, voffB); PG8_STAGE(PG8_SB(0, 1), rsB2, b2 + hstep, voffB); { PG8_OA(q_, seln, 0); PG8_STAGE(PG8_SA(0, 0), rsA2, a2, q_); }
            PG8_WAIT_V(8); PG8_WAIT_L(0); PG8_BAR; PG8_MMA(1, 0, At, B0); PG8_MMA(1, 1, At, B1); PG8_BAR; PG8_SCHED;
            PG8_LDB(B0, 1, 0); PG8_LDB(B1, 1, 1); PG8_SCHED; PG8_LDA(At, 1, 0); { PG8_OA(q_, seln, 1); PG8_STAGE(PG8_SA(0, 1), rsA2, a2 + hA, q_); }
            PG8_WAIT_V(8); PG8_WAIT_L(0); PG8_BAR; PG8_MMA(0, 0, At, B0); PG8_MMA(0, 1, At, B1); PG8_BAR; PG8_SCHED;
            PG8_LDA(At, 1, 1); PG8_STAGE(PG8_SB(1, 0), rsB2, b3, voffB); PG8_STAGE(PG8_SB(1, 1), rsB2, b3 + hstep, voffB); { PG8_OA(q_, seln, 0); PG8_STAGE(PG8_SA(1, 0), rsA2, a3, q_); }
            PG8_WAIT_V(8); PG8_WAIT_L(0); PG8_BAR; PG8_MMA(1, 0, At, B0); PG8_MMA(1, 1, At, B1); PG8_BAR; PG8_SCHED;
        }
        if constexpr (ALIGN) { if (wr == 0) PG8_BAR; }
        if (!DUPK || DUPK == 5 || (ui & 1)) E(acc, cur, wr, wc, fr, fq, sideb + (ui % 3) * 512, lds);
        if constexpr (DUPK == 5) { asm volatile("" ::: "memory"); E(acc, cur, wr, wc, fr, fq, sideb + (ui % 3) * 512, lds); }
        if (!has_next) break;
#pragma unroll
        for (int a = 0; a < 2; ++a)
#pragma unroll
            for (int b = 0; b < 2; ++b)
#pragma unroll
                for (int m = 0; m < 4; ++m)
#pragma unroll
                    for (int n = 0; n < 2; ++n) acc[a][b][m][n] = (f32x4){z0, z0, z0, z0};
        cur = nxt; cA = nA; cB = nB; ++ui;
        if constexpr (ALIGN) { if (wr == 1) PG8_BAR; }
    }
    PG8_WAIT_V(0);
    if constexpr (!ALIGN) { if (wr == 0) PG8_BAR; }
    PG8_BAR;
#undef PG8_SA
#undef PG8_SB
#undef PG8_STAGE
#undef PG8_SIDE
#undef PG8_OA
#undef PG8_LDA
#undef PG8_LDB
#undef PG8_MMA
#undef PG8_CAT
#undef PG8_WAIT_V
#undef PG8_WAIT_L
#undef PG8_BAR
#undef PG8_SCHED
}

typedef GAS unsigned gu32;
#define XB_TMO      128
#define XB_XCNT(j)  (256  + 64 * (j))
#define XB_XSUB(j)  (1280 + 64 * (j))
#define XB_XGEN(j)  (2304 + 64 * (j))
#define XB_TOP      3328
#define XB_TOPGEN   3392
#define XCD_BAR_WORDS 3456
#define XB_SPIN_CAP (1u << 20)
DEV unsigned xb_ld(unsigned* p) { return __hip_atomic_load(p, __ATOMIC_RELAXED, __HIP_MEMORY_SCOPE_AGENT); }
DEV unsigned xb_add(unsigned* p, unsigned v) { return __hip_atomic_fetch_add(p, v, __ATOMIC_RELAXED, __HIP_MEMORY_SCOPE_AGENT); }
DEV unsigned xb_xcc_id() { return (unsigned)__builtin_amdgcn_s_getreg((3 << 11) | 20) & 0xFu; }
#define XB_SPIN(cond, bar) do { unsigned _sp = 0; while (cond) { __builtin_amdgcn_s_sleep(1); \
    if ((++_sp & 255u) == 0u) { if (xb_ld(&(bar)[XB_TMO])) break; if (_sp > XB_SPIN_CAP) { atomicAdd(&(bar)[XB_TMO], 1u); break; } } } } while (0)
struct XcdBarrier { unsigned* bar; unsigned x; volatile LAS unsigned* st; int wave; };
DEV bool xb_thread0(int wave) { return wave == 0 && __builtin_amdgcn_mbcnt_hi(~0u, __builtin_amdgcn_mbcnt_lo(~0u, 0u)) == 0u; }
DEV XcdBarrier xcd_barrier_post(unsigned* bar, volatile LAS unsigned* st, int wave) {
    XcdBarrier b; b.bar = bar; b.x = xb_xcc_id(); b.st = st; b.wave = wave;
    if (xb_thread0(wave)) (void)xb_add(&bar[XB_XCNT(b.x)], 1u);
    return b;
}
DEV void xcd_barrier_complete(unsigned* bar, unsigned x, unsigned& nloc, unsigned& nx) {
    const unsigned G = gridDim.x * gridDim.y * gridDim.z;
    unsigned sum, cnt, mine, sp = 0u;
    for (;;) {
        sum = 0u; cnt = 0u; mine = 0u;
#pragma unroll
        for (unsigned j = 0; j < 16; ++j) { const unsigned c = xb_ld(&bar[XB_XCNT(j)]); sum += c; cnt += (c > 0u) ? 1u : 0u; mine = (j == x) ? c : mine; }
        if (sum == G) break;
        __builtin_amdgcn_s_sleep(1);
        if ((++sp & 255u) == 0u) { if (xb_ld(&bar[XB_TMO])) break; if (sp > XB_SPIN_CAP) { atomicAdd(&bar[XB_TMO], 1u); break; } }
    }
    nloc = mine > 0u ? mine : 1u; nx = cnt > 0u ? cnt : 1u;
}
DEV void xcd_barrier(const XcdBarrier& b) {
    asm volatile("s_waitcnt vmcnt(0)" ::: "memory");
    __syncthreads();
    if (xb_thread0(b.wave)) {
        unsigned* bar = b.bar;
        __builtin_amdgcn_s_waitcnt(0);
        unsigned nloc = b.st[0], nx = b.st[1];
        if (nloc == 0u) { xcd_barrier_complete(bar, b.x, nloc, nx); b.st[0] = nloc; b.st[1] = nx; }
        const unsigned old = xb_add(&bar[XB_XSUB(b.x)], 1u);
        const unsigned gen = old / nloc;
        if (old + 1u == (gen + 1u) * nloc) {
            __builtin_amdgcn_fence(__ATOMIC_RELEASE, "agent");
            asm volatile("s_waitcnt vmcnt(0)" ::: "memory");
            const unsigned og = xb_add(&bar[XB_TOP], 1u);
            const unsigned tg = og / nx;
            if (og + 1u == (tg + 1u) * nx) xb_add(&bar[XB_TOPGEN], 1u);
            else XB_SPIN(xb_ld(&bar[XB_TOPGEN]) == tg, bar);
            __builtin_amdgcn_fence(__ATOMIC_ACQUIRE, "agent");
            xb_add(&bar[XB_XGEN(b.x)], 1u);
            asm volatile("s_waitcnt vmcnt(0)" ::: "memory");
        } else {
            XB_SPIN(xb_ld(&bar[XB_XGEN(b.x)]) == gen, bar);
            __builtin_amdgcn_fence(__ATOMIC_ACQUIRE, "agent");
            asm volatile("s_waitcnt vmcnt(0)" ::: "memory");
        }
    }
    __syncthreads();
}
constexpr size_t MiB = 1u << 20;
constexpr int PMAX = 131072 + 32 * 256;
constexpr size_t W_CTL = 0, CTL_ZERO_BYTES = 64 * 1024;
constexpr size_t W_IN0 = 2 * MiB, W_GLU = 6 * MiB, W_OUT0 = 7 * MiB, W_IN1 = 9 * MiB, W_OUT1 = 16 * MiB;
constexpr size_t W_LUT = 18 * MiB, W_KM = W_LUT + 64 * 1024, W_HIST = W_KM + 256 * 1024, W_SORT = W_HIST + 64 * 1024  , W_BGU2 = 19 * MiB  , W_GR = 20 * MiB  , W_SS = 22 * MiB  ;
constexpr size_t W_GU = 32 * MiB, W_DN = 288 * MiB, W_XB = 416 * MiB  , W_XBB = 480 * MiB  , W_X8 = 1024 * MiB  , W_HB = 736 * MiB, W_YS5 = 928 * MiB, W_Y0 = 960 * MiB, W_MIXB = 1024 * MiB, W_GLAO = 1088 * MiB;
constexpr size_t W_ROUTE = 26 * MiB  , W_ACT = 736 * MiB  , W_YS = 1160 * MiB, W_END = 1432 * MiB;
static_assert(W_ACT + (size_t)PMAX * 2048 <= W_MIXB && W_YS + (size_t)PMAX * 2048 <= W_END && W_X8 + (size_t)PMAX * 1024 <= W_YS && W_ROUTE + 4 * MiB <= W_GU, "ws map");
constexpr int CW_BAR = 4096;

struct Args { const float* in[29]; float* out; unsigned char* ws; int ph_lo, ph_hi; };
struct Frame {
    LAS unsigned char* lds; int tid, lane, wave, vcu, G;
    const float* const* in; unsigned char* ws;
};
#define WSP(T_, off) ((T_*)(F.ws + (off)))

DEV unsigned pk4_fp8(float a, float b, float c, float d) { unsigned w = 0u; w = __builtin_amdgcn_cvt_pk_fp8_f32(a, b, w, false); w = __builtin_amdgcn_cvt_pk_fp8_f32(c, d, w, true); return w; }
struct CvItem { const float* src; unsigned char* dst; int pitch, K; float sc; };
constexpr int P0_I_GU = 8 * 8, P0_I_DN = 8 * 4, P0_I_IN0 = 8 * 8, P0_I_GLU = 4 * 2, P0_I_O = 8 * 4, P0_I_IN1 = 8 * 12;
constexpr int P0_N_GU = 64 * P0_I_GU, P0_N_DN = 64 * P0_I_DN, P0_NITEMS = P0_N_GU + P0_N_DN + P0_I_IN0 + P0_I_GLU + 2 * P0_I_O + P0_I_IN1;
DEV CvItem cv_decode(Frame& F, int it) {
    int r = it; const float* W; unsigned char* D; int K, N, NP, es; float sc = 0.f;
    if (r < P0_N_GU) { const int m = r / P0_I_GU; r %= P0_I_GU; W = F.in[25] + (size_t)m * 1024 * 2048; D = WSP(unsigned char, W_GU) + (size_t)m * 2048 * 1024; K = 1024; N = 2048; NP = 2048; es = 1; sc = 64.f; }
    else if ((r -= P0_N_GU) < P0_N_DN) { const int m = r / P0_I_DN; r %= P0_I_DN; W = F.in[27] + (size_t)m * 1024 * 1024; D = WSP(unsigned char, W_DN) + (size_t)m * 1024 * 1024; K = 1024; N = 1024; NP = 1024; es = 1; sc = 128.f; }
    else if ((r -= P0_N_DN) < P0_I_IN0) { W = F.in[1]; D = WSP(unsigned char, W_IN0); K = 1024; N = 2048; NP = 2048; es = 2; }
    else if ((r -= P0_I_IN0) < P0_I_GLU) { W = F.in[10]; D = WSP(unsigned char, W_GLU); K = 512; N = 512; NP = 512; es = 2; }
    else if ((r -= P0_I_GLU) < P0_I_O) { W = F.in[13]; D = WSP(unsigned char, W_OUT0); K = 1024; N = 1024; NP = 1024; es = 2; }
    else if ((r -= P0_I_O) < P0_I_O) { W = F.in[18]; D = WSP(unsigned char, W_OUT1); K = 1024; N = 1024; NP = 1024; es = 2; }
    else { r -= P0_I_O; W = F.in[14]; D = WSP(unsigned char, W_IN1); K = 1024; N = 3072; NP = 3088; es = 2; }
    const int nblk = N / 256, kb = r / nblk, nb = r % nblk;
    CvItem c; c.src = W + (size_t)(128 * kb) * NP + 256 * nb; c.dst = D + ((size_t)(256 * nb) * K + 128 * kb) * es; c.pitch = NP; c.K = K; c.sc = sc; return c;
}
DEV void cv_load(const CvItem& c, f32x4 (&v)[16], int tid) {
#pragma unroll
    for (int i = 0; i < 16; ++i) v[i] = *(const f32x4*)(c.src + (size_t)(8 * i + (tid >> 6)) * c.pitch + 4 * (tid & 63));
}
DEV void cv_store(const CvItem& c, const f32x4 (&v)[16], LAS float* T_, int tid) {
#pragma unroll
    for (int i = 0; i < 16; ++i) *(LAS f32x4*)(T_ + (8 * i + (tid >> 6)) * 260 + 4 * (tid & 63)) = v[i];
    __syncthreads();
    const int n = tid & 255, kh = tid >> 8; const LAS float* s = T_ + (64 * kh) * 260 + n;
    if (c.sc > 0.f) { const float q = c.sc; unsigned char* d = c.dst + (size_t)n * c.K + 64 * kh;
#pragma unroll
        for (int g = 0; g < 4; ++g) { u32x4 o;
            o.x = pk4_fp8(s[(16 * g + 0) * 260] * q, s[(16 * g + 1) * 260] * q, s[(16 * g + 2) * 260] * q, s[(16 * g + 3) * 260] * q); o.y = pk4_fp8(s[(16 * g + 4) * 260] * q, s[(16 * g + 5) * 260] * q, s[(16 * g + 6) * 260] * q, s[(16 * g + 7) * 260] * q);
            o.z = pk4_fp8(s[(16 * g + 8) * 260] * q, s[(16 * g + 9) * 260] * q, s[(16 * g + 10) * 260] * q, s[(16 * g + 11) * 260] * q); o.w = pk4_fp8(s[(16 * g + 12) * 260] * q, s[(16 * g + 13) * 260] * q, s[(16 * g + 14) * 260] * q, s[(16 * g + 15) * 260] * q);
            *(u32x4*)(d + 16 * g) = o; }
    } else { unsigned char* d = c.dst + ((size_t)n * c.K + 64 * kh) * 2;
#pragma unroll
        for (int g = 0; g < 8; ++g) { u32x4 o; o.x = cvt_pk(s[(8 * g + 0) * 260], s[(8 * g + 1) * 260]); o.y = cvt_pk(s[(8 * g + 2) * 260], s[(8 * g + 3) * 260]); o.z = cvt_pk(s[(8 * g + 4) * 260], s[(8 * g + 5) * 260]); o.w = cvt_pk(s[(8 * g + 6) * 260], s[(8 * g + 7) * 260]);
            *(u32x4*)(d + 16 * g) = o; }
    }
    __syncthreads();
}
__constant__ int BUCKET_TH2[16] = {16, 22, 30, 40, 54, 73, 99, 134, 182, 246, 332, 450, 609, 825, 1117, 1513};
DEV void p0_prologue(Frame& F) {
    { LAS float* T_ = (LAS float*)F.lds; f32x4 va[16], vb[16];
      int it = F.vcu;
      if (it < P0_NITEMS) { CvItem ca = cv_decode(F, it); cv_load(ca, va, F.tid);
#pragma unroll 1
          for (;;) {
              const int it2 = it + F.G; CvItem cb = ca; const bool h2 = it2 < P0_NITEMS; if (h2) { cb = cv_decode(F, it2); cv_load(cb, vb, F.tid); }
              cv_store(ca, va, T_, F.tid);
              if (!h2) break;
              const int it3 = it2 + F.G; const bool h3 = it3 < P0_NITEMS; if (h3) { ca = cv_decode(F, it3); cv_load(ca, va, F.tid); }
              cv_store(cb, vb, T_, F.tid);
              if (!h3) break;
              it = it3;
          } } }
    const int gt = F.vcu * 512 + F.tid, NGT = F.G * 512;
    for (int i = gt; i < 16 * 1024; i += NGT) { const int n = i >> 10, k = i & 1023; WSP(bf16_t, W_IN1)[(size_t)(3072 + n) * 1024 + k] = (bf16_t)(cvt_pk(F.in[14][(size_t)k * 3088 + 3072 + n], 0.f) & 0xffffu); }
    { const f32x4* x4 = (const f32x4*)F.in[0]; u32x2* o = WSP(u32x2, W_XB);
      for (size_t i = gt; i < (size_t)T * 1024 / 4; i += (size_t)NGT * 8) { f32x4 v[8];
#pragma unroll
          for (int u = 0; u < 8; ++u) v[u] = x4[i + (size_t)u * NGT];
#pragma unroll
          for (int u = 0; u < 8; ++u) { u32x2 w; w.x = cvt_pk(v[u].x, v[u].y); w.y = cvt_pk(v[u].z, v[u].w); o[i + (size_t)u * NGT] = w; } } }
    for (int i = gt; i < 2 * 32 * 2048 / 4; i += NGT) { const f32x4 v = ((const f32x4*)F.in[26])[i]; WSP(f32x4, W_BGU2)[i] = (f32x4){v.x, v.z, 4.f * (v.y + 1.f), 4.f * (v.w + 1.f)}; }
    for (int i = gt; i < 8 * 2048; i += NGT) { const int h = i >> 11, n = i & 2047; int bk = n;
        if (n >= 16) { bk = 16;
#pragma unroll
            for (int q = 1; q < 16; ++q) bk += (n >= BUCKET_TH2[q]) ? 1 : 0; }
        WSP(float, W_LUT)[i] = F.in[12][bk * 8 + h] * 1.4426950408889634f; }
}

DEV void p_kmean(Frame& F) {
    const int gw = F.vcu * 8 + F.wave, NGW = F.G * 8; const bf16_t* H0 = WSP(bf16_t, W_HB); float* KM = WSP(float, W_KM);
    for (int it = gw; it < 1024; it += NGW) { const int blk = it & 7, h = (it >> 3) & 7, b = it >> 6; const int r8 = F.lane >> 3, c = F.lane & 7;
        const bf16_t* p = H0 + (size_t)(b * 2048 + blk * 256 + r8) * 2048 + 1024 + h * 64 + c * 8; float s[8];
#pragma unroll
        for (int j = 0; j < 8; ++j) s[j] = 0.f;
#pragma unroll 8
        for (int i = 0; i < 32; ++i) { const u32x4 v = *(const u32x4*)(p + (size_t)i * 8 * 2048);
            s[0] += bflo(v.x); s[1] += bfhi(v.x); s[2] += bflo(v.y); s[3] += bfhi(v.y); s[4] += bflo(v.z); s[5] += bfhi(v.z); s[6] += bflo(v.w); s[7] += bfhi(v.w); }
#pragma unroll
        for (int j = 0; j < 8; ++j) { s[j] += __shfl_xor(s[j], 8); s[j] += __shfl_xor(s[j], 16); s[j] += __shfl_xor(s[j], 32); }
        if (F.lane < 8) {
#pragma unroll
            for (int j = 0; j < 8; ++j) KM[(size_t)it * 64 + c * 8 + j] = s[j] * (1.f / 256.f); } }
}

DEV void s5_item(Frame& F, int b, int g, LAS unsigned char* sl  ) {
    const int lane = F.lane, p0 = lane & 31, hi = lane >> 5, q4 = lane >> 4;
    const float* lam_re = F.in[2]; const float* lam_im = F.in[3]; const float* log_dt = F.in[4]; const float* b_re = F.in[5]; const float* b_im = F.in[6];
    const float* c_re = F.in[7]; const float* c_im = F.in[8]; const float* dsk = F.in[9];
    const bf16_t* H0 = WSP(bf16_t, W_HB); bf16_t* YS = WSP(bf16_t, W_YS5);
    const float dt = __expf(log_dt[g]);
    float ar[2], ai[2]; bf16x8 bfr[4];
#pragma unroll
    for (int s = 0; s < 2; ++s) { const int p = p0 + 32 * s; const float lr = lam_re[g * 64 + p], li = lam_im[g * 64 + p]; const float mag = __expf(lr * dt);
        ar[s] = mag * cosf(li * dt); ai[s] = mag * sinf(li * dt);
        const float er = ar[s] - 1.f, ei = ai[s], den = lr * lr + li * li; const float qr = (er * lr + ei * li) / den, qi = (ei * lr - er * li) / den;
        u32x4 wr_, wi_; float vr[8], vi[8];
#pragma unroll
        for (int j = 0; j < 8; ++j) { const float br = b_re[(g * 64 + p) * 16 + 8 * hi + j], bi = b_im[(g * 64 + p) * 16 + 8 * hi + j]; vr[j] = qr * br - qi * bi; vi[j] = qr * bi + qi * br; }
        wr_.x = cvt_pk(vr[0], vr[1]); wr_.y = cvt_pk(vr[2], vr[3]); wr_.z = cvt_pk(vr[4], vr[5]); wr_.w = cvt_pk(vr[6], vr[7]);
        wi_.x = cvt_pk(vi[0], vi[1]); wi_.y = cvt_pk(vi[2], vi[3]); wi_.z = cvt_pk(vi[4], vi[5]); wi_.w = cvt_pk(vi[6], vi[7]);
        bfr[2 * s] = __builtin_bit_cast(bf16x8, wr_); bfr[2 * s + 1] = __builtin_bit_cast(bf16x8, wi_); }
    bf16x8 cfr[4];
#pragma unroll
    for (int ks = 0; ks < 4; ++ks) { float v[8];
#pragma unroll
        for (int j = 0; j < 8; ++j) { const int c = 32 * ks + 8 * q4 + j, p = c >> 1; const int h = lane & 15; v[j] = (c & 1) ? -c_im[(g * 16 + h) * 64 + p] : c_re[(g * 16 + h) * 64 + p]; }
        u32x4 w; w.x = cvt_pk(v[0], v[1]); w.y = cvt_pk(v[2], v[3]); w.z = cvt_pk(v[4], v[5]); w.w = cvt_pk(v[6], v[7]); cfr[ks] = __builtin_bit_cast(bf16x8, w); }
    float dv[4];
#pragma unroll
    for (int r = 0; r < 4; ++r) dv[r] = dsk[g * 16 + 4 * q4 + r];
    const int tm = 16 * ((p0 >> 2) & 1) + 4 * (p0 >> 3) + (p0 & 3);
    const bf16_t* urow = H0 + (size_t)(b * 2048 + tm) * 2048 + g * 16 + 8 * hi;
    float cr[2] = {0.f, 0.f}, ci[2] = {0.f, 0.f};
    bf16x8 ufr = *(const bf16x8*)urow;
    for (int tile = 0; tile < 64; ++tile) {
        const bf16x8 ucur = ufr;
        if (tile + 1 < 64) ufr = *(const bf16x8*)(urow + (size_t)(tile + 1) * 32 * 2048);
        f32x16 x[4];
#pragma unroll
        for (int n = 0; n < 4; ++n) { f32x16 z;
#pragma unroll
            for (int r = 0; r < 16; ++r) z[r] = 0.f;
            x[n] = __builtin_amdgcn_mfma_f32_32x32x16_bf16(ucur, bfr[n], z, 0, 0, 0); }
#pragma unroll
        for (int s = 0; s < 2; ++s) {
            f32x16& xr = x[2 * s]; f32x16& xi = x[2 * s + 1];
            float sr = hi ? 0.f : cr[s], si = hi ? 0.f : ci[s];
#pragma unroll
            for (int r = 0; r < 16; ++r) { const float nr = ar[s] * sr - ai[s] * si + xr[r], ni = ar[s] * si + ai[s] * sr + xi[r]; xr[r] = nr; xi[r] = ni; sr = nr; si = ni; }
            const float o_r = swap32(sr), o_i = swap32(si);
            float wr_ = hi ? o_r : 0.f, wi_ = hi ? o_i : 0.f;
#pragma unroll
            for (int r = 0; r < 16; ++r) { const float nr = ar[s] * wr_ - ai[s] * wi_, ni = ar[s] * wi_ + ai[s] * wr_; wr_ = nr; wi_ = ni; xr[r] += wr_; xi[r] += wi_; }
            const float e_r = swap32(xr[15]), e_i = swap32(xi[15]);
            cr[s] = hi ? xr[15] : e_r; ci[s] = hi ? xi[15] : e_i;
#pragma unroll
            for (int r = 0; r < 16; ++r) *(LAS unsigned*)(sl + (16 * hi + r) * 256 + (p0 + 32 * s) * 4) = cvt_pk(xr[r], xi[r]);
        }
#pragma unroll
        for (int tt = 0; tt < 2; ++tt) {
            f32x4 y = {0.f, 0.f, 0.f, 0.f};
#pragma unroll
            for (int ks = 0; ks < 4; ++ks) { const bf16x8 sf = *(const LAS bf16x8*)(sl + (16 * tt + (lane & 15)) * 256 + ks * 64 + q4 * 16); y = __builtin_amdgcn_mfma_f32_16x16x32_bf16(cfr[ks], sf, y, 0, 0, 0); }
            const int t = tile * 32 + 16 * tt + (lane & 15);
            const u32x2 uw = *(const u32x2*)(H0 + (size_t)(b * 2048 + t) * 2048 + g * 16 + 4 * q4);
            const float y0 = gelu_tanh(y[0] + dv[0] * bflo(uw.x)), y1 = gelu_tanh(y[1] + dv[1] * bfhi(uw.x)), y2 = gelu_tanh(y[2] + dv[2] * bflo(uw.y)), y3 = gelu_tanh(y[3] + dv[3] * bfhi(uw.y));
            u32x2 ow; ow.x = cvt_pk(y0, y1); ow.y = cvt_pk(y2, y3);
            *(u32x2*)(YS + (size_t)(b * 2048 + t) * 512 + g * 16 + 4 * q4) = ow;
        }
    }
}

constexpr int AT_K = 0, AT_V = 24576, AT_WS = 49152, AT_OST = 51200, AT_LUT = AT_OST + 8 * 4096  , AT_LUTB = 8704, AT_Q = AT_LUT + 8 * AT_LUTB  , AT_END = AT_Q + 64;
DEV int crow(int r, int hi) { return (r & 3) + 8 * (r >> 2) + 4 * hi; }
DEV s16x4 vtr(const LAS unsigned char* p) { typedef short v4i16_t __attribute__((ext_vector_type(4))); return __builtin_bit_cast(s16x4, __builtin_amdgcn_ds_read_tr16_b64_v4i16((LAS v4i16_t*)p)); }
DEV void moba_unit(Frame& F, int b, int h, int own) {
    const int lane = F.lane, wid = F.wave, r32 = lane & 31, hi = lane >> 5;
    LAS unsigned char* lds = F.lds;
    const bf16_t* H0 = WSP(bf16_t, W_HB); const float* KM = WSP(float, W_KM);
    LAS float* lut = (LAS float*)(lds + AT_LUT + h * AT_LUTB); LAS float* wsf = (LAS float*)(lds + AT_WS) + wid * 64;
    const size_t rowbase = (size_t)b * 2048;
    const int qpos = own * 256 + wid * 32 + r32;
    bf16x8 qr[4];
#pragma unroll
    for (int d0 = 0; d0 < 4; ++d0) qr[d0] = *(const bf16x8*)(H0 + (rowbase + qpos) * 2048 + 512 + h * 64 + d0 * 16 + hi * 8);
    unsigned selmask = 0u;
    if (own > 0) {
        float gate[7];
#pragma unroll
        for (int j = 0; j < 7; ++j) { float s = 0.f;
            if (j < own) { const float* km = KM + ((size_t)(b * 8 + h) * 8 + j) * 64 + hi * 8;
#pragma unroll
                for (int d0 = 0; d0 < 4; ++d0) { const f32x4 k0 = *(const f32x4*)(km + d0 * 16), k1 = *(const f32x4*)(km + d0 * 16 + 4); const u32x4 qw = __builtin_bit_cast(u32x4, qr[d0]);
                    s += bflo(qw.x) * k0.x + bfhi(qw.x) * k0.y + bflo(qw.y) * k0.z + bfhi(qw.y) * k0.w + bflo(qw.z) * k1.x + bfhi(qw.z) * k1.y + bflo(qw.w) * k1.z + bfhi(qw.w) * k1.w; } }
            gate[j] = s + swap32(s); }
#pragma unroll
        for (int j = 0; j < 7; ++j) { int rank = 0;
#pragma unroll
            for (int j2 = 0; j2 < 7; ++j2) if (j2 != j && j2 < own && (gate[j2] > gate[j] || (gate[j2] == gate[j] && j2 < j))) ++rank;
            if (j < own && rank < 3) selmask |= 1u << j; }
    }
    const int NT = 4 * (own + 1);
#define KV0(i) ((i) < 4 ? own * 256 + (i) * 64 : (((i) - 4) >> 2) * 256 + (((i) - 4) & 3) * 64)
    const bf16_t* kbase = H0 + (rowbase + lane) * 2048 + 1024 + h * 64 + wid * 8;
    const bf16_t* vbase = H0 + (rowbase + 16 * (wid & 3) + (lane >> 2)) * 2048 + 1536 + h * 64 + (wid >> 2) * 32 + (lane & 3) * 8;
#define LOADKV(i, bo_) do { const int kv0_ = KV0(i); \
        __builtin_amdgcn_global_load_lds((const unsigned*)(kbase + (size_t)kv0_ * 2048), (LAS unsigned*)(lds + AT_K + bo_ + wid * 1024), 16, 0, 0); \
        __builtin_amdgcn_global_load_lds((const unsigned*)(vbase + (size_t)kv0_ * 2048), (LAS unsigned*)(lds + AT_V + bo_ + wid * 1024), 16, 0, 0); } while (0)
    LOADKV(0, 0); LOADKV(1, 8192);
    int bo = 0, bo2 = 16384;
    float m_ref = 0.f, l_run = 0.f; f32x16 o[2];
#pragma unroll
    for (int r = 0; r < 16; ++r) { o[0][r] = 0.f; o[1][r] = 0.f; }
    const int Q0 = own * 256 + wid * 32;
#pragma unroll 1
    for (int i = 0; i < NT; ++i) {
        if (i + 1 < NT) asm volatile("s_waitcnt vmcnt(2) lgkmcnt(0)\n\ts_barrier" ::: "memory"); else asm volatile("s_waitcnt vmcnt(0) lgkmcnt(0)\n\ts_barrier" ::: "memory");
        if (i + 2 < NT) LOADKV(i + 2, bo2);
        const int kv0 = KV0(i);
        const bool ownblk = i < 4;
        if (!(ownblk && kv0 > Q0 + 31)) {
            const bool partial = ownblk && (kv0 + 63 > Q0);
            const bool rowsel = ownblk || ((selmask >> ((i - 4) >> 2)) & 1u);
            f32x16 p0, p1;
            { const LAS float* lp = lut + 128 + (qpos - kv0 - 4 * hi - 59);
#pragma unroll
              for (int r = 0; r < 16; ++r) { const int c = (r & 3) + 8 * (r >> 2); p0[r] = lp[59 - c] - m_ref; p1[r] = lp[59 - c - 32] - m_ref; } }
            { const LAS unsigned char* kb = lds + AT_K + bo + hi * 1024 + r32 * 16;
#pragma unroll
              for (int d0 = 0; d0 < 4; ++d0) { const bf16x8 k0 = *(const LAS bf16x8*)(kb + d0 * 2048), k1 = *(const LAS bf16x8*)(kb + d0 * 2048 + 512);
                  p0 = __builtin_amdgcn_mfma_f32_32x32x16_bf16(k0, qr[d0], p0, 0, 0, 0); p1 = __builtin_amdgcn_mfma_f32_32x32x16_bf16(k1, qr[d0], p1, 0, 0, 0); } }
            if (partial) { const int dbase = qpos - kv0 - 4 * hi;
#pragma unroll
                for (int r = 0; r < 16; ++r) { const int d0_ = dbase - ((r & 3) + 8 * (r >> 2)); p0[r] = d0_ >= 0 ? p0[r] : -INFINITY; p1[r] = d0_ >= 32 ? p1[r] : -INFINITY; } }
            float rmax = fmaxf(p0[0], p1[0]);
#pragma unroll
            for (int r = 1; r < 16; ++r) rmax = fmaxf(rmax, fmaxf(p0[r], p1[r]));
            rmax = fmaxf(rmax, swap32(rmax));
            rmax = rowsel ? rmax : -INFINITY;
            if (i == 0 || __any(rmax > 8.f)) {
                const float dl = (i == 0) ? rmax : fmaxf(rmax, 0.f); m_ref += dl;
#pragma unroll
                for (int r = 0; r < 16; ++r) { p0[r] -= dl; p1[r] -= dl; }
                const float alpha = __builtin_amdgcn_exp2f(-dl); l_run *= alpha;
                if (hi == 0) wsf[r32] = alpha;
#pragma unroll
                for (int r = 0; r < 16; ++r) { const float f = wsf[crow(r, hi)]; o[0][r] *= f; o[1][r] *= f; }
            }
            float rs = 0.f;
#pragma unroll
            for (int r = 0; r < 16; ++r) { p0[r] = __builtin_amdgcn_exp2f(p0[r]); p1[r] = __builtin_amdgcn_exp2f(p1[r]); rs += p0[r] + p1[r]; }
            l_run += rowsel ? rs : 0.f;
            const unsigned km = rowsel ? 0xffffffffu : 0u;
            u32x4 pw[4];
            pw[0] = (u32x4){cvt_pk(p0[0], p0[1]) & km, cvt_pk(p0[2], p0[3]) & km, cvt_pk(p0[4], p0[5]) & km, cvt_pk(p0[6], p0[7]) & km};
            pw[1] = (u32x4){cvt_pk(p0[8], p0[9]) & km, cvt_pk(p0[10], p0[11]) & km, cvt_pk(p0[12], p0[13]) & km, cvt_pk(p0[14], p0[15]) & km};
            pw[2] = (u32x4){cvt_pk(p1[0], p1[1]) & km, cvt_pk(p1[2], p1[3]) & km, cvt_pk(p1[4], p1[5]) & km, cvt_pk(p1[6], p1[7]) & km};
            pw[3] = (u32x4){cvt_pk(p1[8], p1[9]) & km, cvt_pk(p1[10], p1[11]) & km, cvt_pk(p1[12], p1[13]) & km, cvt_pk(p1[14], p1[15]) & km};
            { const LAS unsigned char* vp = lds + AT_V + bo + ((lane >> 4) & 1) * 32 + (lane & 3) * 8 + (4 * hi + ((lane & 15) >> 2)) * 64;
#pragma unroll
              for (int d0 = 0; d0 < 2; ++d0)
#pragma unroll
                  for (int ks = 0; ks < 4; ++ks) { const s16x4 lo = vtr(vp + d0 * 4096 + ks * 1024), hh = vtr(vp + d0 * 4096 + ks * 1024 + 512);
                      const bf16x8 vf = (bf16x8){lo[0], lo[1], lo[2], lo[3], hh[0], hh[1], hh[2], hh[3]};
                      o[d0] = __builtin_amdgcn_mfma_f32_32x32x16_bf16(__builtin_bit_cast(bf16x8, pw[ks]), vf, o[d0], 0, 0, 0); } }
        }
        bo = (bo == 16384) ? 0 : bo + 8192; bo2 = (bo2 == 16384) ? 0 : bo2 + 8192;
    }
    __syncthreads();
#undef KV0
#undef LOADKV
    l_run += swap32(l_run);
    if (hi == 0) wsf[32 + r32] = 1.f / l_run;
    bf16_t* Ow = WSP(bf16_t, W_Y0) + (rowbase + own * 256 + wid * 32) * 1024 + 512 + h * 64;
    LAS bf16_t* stg = (LAS bf16_t*)(lds + AT_OST) + wid * 2048;
#pragma unroll
    for (int r = 0; r < 16; ++r) { const int orow = crow(r, hi); const float rl = wsf[32 + orow];
        stg[orow * 64 + r32] = (bf16_t)(cvt_pk(o[0][r] * rl, 0.f) & 0xffffu); stg[orow * 64 + 32 + r32] = (bf16_t)(cvt_pk(o[1][r] * rl, 0.f) & 0xffffu); }
#pragma unroll
    for (int i = 0; i < 4; ++i) { const int row = i * 8 + (lane >> 3), ch = lane & 7; const u32x4 v = *(const LAS u32x4*)(stg + row * 64 + ch * 8); *(u32x4*)(Ow + (size_t)row * 1024 + ch * 8) = v; }
    __syncthreads();
}
constexpr int CW_MOBAQ = 64;
DEV void p_s5_moba(Frame& F, int mode) {
    if ((mode & 1) && (F.vcu & 3) == 3) { const int it = (F.vcu >> 2) * 8 + F.wave; if (it < 512) s5_item(F, it >> 5, it & 31, F.lds + 65536 + F.wave * 8192); }
    __syncthreads();
    if (!(mode & 2)) return;
    for (int i = F.tid; i < 8 * 2176; i += 512) { const int hh = i / 2176, j = i % 2176; ((LAS float*)(F.lds + AT_LUT))[i] = j < 128 ? 0.f : WSP(float, W_LUT)[hh * 2048 + j - 128]; }
    volatile LAS int* qw = (volatile LAS int*)(F.lds + AT_Q);
    unsigned* ctl = (unsigned*)(F.ws + W_CTL);
    for (;;) {
        __syncthreads();
        if (F.tid == 0) qw[0] = (int)__hip_atomic_fetch_add(ctl + CW_MOBAQ, 1u, __ATOMIC_RELAXED, __HIP_MEMORY_SCOPE_AGENT);
        __syncthreads();
        const int u = __builtin_amdgcn_readfirstlane(qw[0]);
        if (u >= 1024) break;
        const int own = 7 - (u >> 7), bh = u & 127;
        moba_unit(F, bh >> 3, bh & 7, own);
    }
}
constexpr size_t R_RE = W_ROUTE, R_RW = W_ROUTE + 512 * 1024, R_POS = W_ROUTE + 1024 * 1024, R_TOK = W_ROUTE + 2 * MiB, R_WGT = W_ROUTE + 3 * MiB;
constexpr int WT_PITCH = 1028;
constexpr int RW_PITCH = 1032;
constexpr int LN_XT = 32 * RW_PITCH * 2;
constexpr int LN_LG = 147456;
constexpr int LN_HIST = LN_LG + 8 * 528;
static_assert(LN_XT + 8 * 8256 <= LDS_TOK && LN_HIST + 128 <= LDSCTL_OFF, "LN LDS map");
template <int MODE, bool ROUTER, bool XIN_F32, bool OUT_F32, bool GRP = false>
DEV void p_ln(Frame& F, const float* xin32, const bf16_t* xinb, bf16_t* xoutb, float* xout32, const float* gam, const float* bet, const float* wrt, const float* brt) {
    LAS bf16_t* whi = (LAS bf16_t*)F.lds; LAS bf16_t* xt = (LAS bf16_t*)(F.lds + LN_XT) + F.wave * 4128; LAS float* lgs = (LAS float*)(F.lds + LN_LG) + F.wave * 132; LAS int* hist = (LAS int*)(F.lds + LN_HIST);
    const int lane = F.lane, l15 = lane & 15, q4 = lane >> 4;
    if constexpr (ROUTER) {
        for (int i = F.tid; i < 1024 * 32; i += 512) { const int k = i >> 5, e = i & 31; whi[e * RW_PITCH + k] = (bf16_t)(cvt_pk(wrt[i], 0.f) & 0xffffu); }
        if (F.tid < 32) hist[F.tid] = 0;
        __syncthreads();
    }
    if constexpr (GRP) {
        const u32x4* src = (const u32x4*)(WSP(bf16_t, W_IN1) + (size_t)3072 * 1024);
        for (int i = F.tid; i < 16 * 128; i += 512) { const int e = i >> 7, c = i & 127; *(LAS u32x4*)(whi + e * RW_PITCH + c * 8) = src[i]; }
        __syncthreads();
    }
    const bf16_t* MIXB = WSP(bf16_t, W_MIXB); const unsigned char* YS8 = WSP(unsigned char, W_YS); const int* POS = WSP(int, R_POS);
    int* RE = WSP(int, R_RE); float* RW = WSP(float, R_RW);
    const float alpha = 1.4142135623730951f;
    f32x4 gq[4], bq[4];
#pragma unroll
    for (int j = 0; j < 4; ++j) { gq[j] = *(const f32x4*)(gam + j * 256 + lane * 4); bq[j] = *(const f32x4*)(bet + j * 256 + lane * 4); }
    float bias8[8];
    if constexpr (ROUTER) {
#pragma unroll
        for (int r = 0; r < 8; ++r) bias8[r] = brt[(r >> 2) * 16 + 4 * q4 + (r & 3)]; }
    for (int wgi = F.vcu; wgi < 256; wgi += F.G) {
        const int r0 = wgi * 128 + F.wave * 16;
        constexpr bool PF = (MODE == 0) && !XIN_F32;
        u32x2 rx[4][4], rm[4][4];
        if constexpr (PF) {
#pragma unroll
            for (int u = 0; u < 4; ++u)
#pragma unroll
                for (int j = 0; j < 4; ++j) { rx[u][j] = *(const u32x2*)(xinb + (size_t)(r0 + u) * 1024 + j * 256 + lane * 4); rm[u][j] = *(const u32x2*)(MIXB + (size_t)(r0 + u) * 1024 + j * 256 + lane * 4); } }
#pragma unroll 1
        for (int i4 = 0; i4 < 16; i4 += 4) {
            float v[4][16];
            if constexpr (PF) {
#pragma unroll
                for (int u = 0; u < 4; ++u)
#pragma unroll
                    for (int j = 0; j < 4; ++j) { v[u][4 * j] = alpha * bflo(rx[u][j].x) + bflo(rm[u][j].x); v[u][4 * j + 1] = alpha * bfhi(rx[u][j].x) + bfhi(rm[u][j].x); v[u][4 * j + 2] = alpha * bflo(rx[u][j].y) + bflo(rm[u][j].y); v[u][4 * j + 3] = alpha * bfhi(rx[u][j].y) + bfhi(rm[u][j].y); }
                if (i4 + 4 < 16) {
#pragma unroll
                    for (int u = 0; u < 4; ++u)
#pragma unroll
                        for (int j = 0; j < 4; ++j) { rx[u][j] = *(const u32x2*)(xinb + (size_t)(r0 + i4 + 4 + u) * 1024 + j * 256 + lane * 4); rm[u][j] = *(const u32x2*)(MIXB + (size_t)(r0 + i4 + 4 + u) * 1024 + j * 256 + lane * 4); } }
            } else {
#pragma unroll
            for (int u = 0; u < 4; ++u) { const int row = r0 + i4 + u;
                if constexpr (XIN_F32) {
#pragma unroll
                    for (int j = 0; j < 4; ++j) { const f32x4 a = *(const f32x4*)(xin32 + (size_t)row * 1024 + j * 256 + lane * 4); v[u][4 * j] = alpha * a.x; v[u][4 * j + 1] = alpha * a.y; v[u][4 * j + 2] = alpha * a.z; v[u][4 * j + 3] = alpha * a.w; }
                } else {
#pragma unroll
                    for (int j = 0; j < 4; ++j) { const u32x2 a = *(const u32x2*)(xinb + (size_t)row * 1024 + j * 256 + lane * 4); v[u][4 * j] = alpha * bflo(a.x); v[u][4 * j + 1] = alpha * bfhi(a.x); v[u][4 * j + 2] = alpha * bflo(a.y); v[u][4 * j + 3] = alpha * bfhi(a.y); }
                }
                if constexpr (MODE == 0) {
#pragma unroll
                    for (int j = 0; j < 4; ++j) { const u32x2 m = *(const u32x2*)(MIXB + (size_t)row * 1024 + j * 256 + lane * 4); v[u][4 * j] += bflo(m.x); v[u][4 * j + 1] += bfhi(m.x); v[u][4 * j + 2] += bflo(m.y); v[u][4 * j + 3] += bfhi(m.y); }
                } else {
                    const int4 pos4 = *(const int4*)(POS + row * 4);
                    const int ps[4] = {__builtin_amdgcn_readfirstlane(pos4.x), __builtin_amdgcn_readfirstlane(pos4.y), __builtin_amdgcn_readfirstlane(pos4.z), __builtin_amdgcn_readfirstlane(pos4.w)};
#pragma unroll
                    for (int kx = 0; kx < 4; ++kx)
#pragma unroll
                        for (int j = 0; j < 4; ++j) { const unsigned m = *(const unsigned*)(YS8 + (size_t)ps[kx] * 1024 + j * 256 + lane * 4); const f32x2 lo2 = __builtin_amdgcn_cvt_pk_f32_fp8(m, false), hi2 = __builtin_amdgcn_cvt_pk_f32_fp8(m, true);
                            v[u][4 * j] += lo2.x * (1.f / 64.f); v[u][4 * j + 1] += lo2.y * (1.f / 64.f); v[u][4 * j + 2] += hi2.x * (1.f / 64.f); v[u][4 * j + 3] += hi2.y * (1.f / 64.f); }
                }
            }
            }
            float s1[4], s2[4];
#pragma unroll
            for (int u = 0; u < 4; ++u) { s1[u] = 0.f; s2[u] = 0.f;
#pragma unroll
                for (int q = 0; q < 16; ++q) { s1[u] += v[u][q]; s2[u] = fmaf(v[u][q], v[u][q], s2[u]); } }
#pragma unroll
            for (int o = 1; o < 64; o <<= 1) {
#pragma unroll
                for (int u = 0; u < 4; ++u) { s1[u] += __shfl_xor(s1[u], o); s2[u] += __shfl_xor(s2[u], o); } }
#pragma unroll
            for (int u = 0; u < 4; ++u) { const int row = r0 + i4 + u; const float mean = s1[u] * (1.f / 1024.f); const float var = fmaxf(s2[u] * (1.f / 1024.f) - mean * mean, 0.f); const float rstd = 1.f / sqrtf(var + 1e-5f);
#pragma unroll
                for (int j = 0; j < 4; ++j) { const int c = j * 256 + lane * 4; const f32x4 g4 = gq[j], b4 = bq[j];
                    const float y0 = (v[u][4 * j] - mean) * rstd * g4.x + b4.x, y1 = (v[u][4 * j + 1] - mean) * rstd * g4.y + b4.y, y2 = (v[u][4 * j + 2] - mean) * rstd * g4.z + b4.z, y3 = (v[u][4 * j + 3] - mean) * rstd * g4.w + b4.w;
                    if constexpr (OUT_F32) *(f32x4*)(xout32 + (size_t)row * 1024 + c) = (f32x4){y0, y1, y2, y3};
                    else { u32x2 w; w.x = cvt_pk(y0, y1); w.y = cvt_pk(y2, y3); *(u32x2*)(xoutb + (size_t)row * 1024 + c) = w;
                        if constexpr (ROUTER || GRP) { *(LAS u32x2*)(xt + u * RW_PITCH + c) = w; } } } }
            if constexpr (GRP) {
                f32x4 ga = {0.f, 0.f, 0.f, 0.f};
#pragma unroll 8
                for (int ks = 0; ks < 32; ++ks) { const bf16x8 xb = *(const LAS bf16x8*)(xt + (l15 & 3) * RW_PITCH + ks * 32 + q4 * 8), wa = *(const LAS bf16x8*)(whi + l15 * RW_PITCH + ks * 32 + q4 * 8);
                    ga = __builtin_amdgcn_mfma_f32_16x16x32_bf16(wa, xb, ga, 0, 0, 0); }
                if (l15 < 4) *(f32x4*)(WSP(float, W_GR) + (size_t)(r0 + i4 + l15) * 16 + 4 * q4) = ga; }
            if constexpr (ROUTER) {
                f32x4 acc[2] = {{0.f, 0.f, 0.f, 0.f}, {0.f, 0.f, 0.f, 0.f}};
#pragma unroll 8
                for (int ks = 0; ks < 32; ++ks) { const bf16x8 xb = *(const LAS bf16x8*)(xt + (l15 & 3) * RW_PITCH + ks * 32 + q4 * 8);
#pragma unroll
                    for (int mt = 0; mt < 2; ++mt) { const bf16x8 wa = *(const LAS bf16x8*)(whi + (mt * 16 + l15) * RW_PITCH + ks * 32 + q4 * 8); acc[mt] = __builtin_amdgcn_mfma_f32_16x16x32_bf16(wa, xb, acc[mt], 0, 0, 0); } }
                if (l15 < 4) {
#pragma unroll
                    for (int mt = 0; mt < 2; ++mt)
#pragma unroll
                        for (int r = 0; r < 4; ++r) lgs[l15 * 33 + mt * 16 + 4 * q4 + r] = acc[mt][r] + bias8[mt * 4 + r]; }
                if (lane < 4) { float lg[32];
#pragma unroll
                    for (int e = 0; e < 32; ++e) lg[e] = lgs[lane * 33 + e];
                    unsigned taken = 0u; float tv[4]; int ti[4];
#pragma unroll
                    for (int r = 0; r < 4; ++r) { float best = -INFINITY; int bi = 0;
#pragma unroll
                        for (int e = 0; e < 32; ++e) { const bool ok = !((taken >> e) & 1u) && lg[e] > best; best = ok ? lg[e] : best; bi = ok ? e : bi; }
                        taken |= 1u << bi; tv[r] = best; ti[r] = bi; }
                    float ex[4], sm = 0.f;
#pragma unroll
                    for (int r = 0; r < 4; ++r) { ex[r] = __expf(tv[r] - tv[0]); sm += ex[r]; }
                    const float inv = 1.f / sm; const int row = r0 + i4 + lane;
                    *(int4*)(RE + row * 4) = make_int4(ti[0], ti[1], ti[2], ti[3]); *(f32x4*)(RW + row * 4) = (f32x4){ex[0] * inv, ex[1] * inv, ex[2] * inv, ex[3] * inv};
#pragma unroll
                    for (int r = 0; r < 4; ++r) atomicAdd((int*)(hist + ti[r]), 1); }
            }
        }
        if constexpr (ROUTER) { __syncthreads(); if (F.tid < 32) { WSP(int, W_HIST)[wgi * 32 + F.tid] = hist[F.tid]; hist[F.tid] = 0; } __syncthreads(); }
    }
}

DEV void p_sort(Frame& F) {
    LAS int* Ls = (LAS int*)F.lds; const int tid = F.tid;
    const int* HIST = WSP(int, W_HIST); int* SORT = WSP(int, W_SORT);
    const int* RE = WSP(int, R_RE); const float* RW = WSP(float, R_RW); int* POS = WSP(int, R_POS); int* TOK = WSP(int, R_TOK); float* WGT = WSP(float, R_WGT);
    for (int wgi = F.vcu; wgi < 256; wgi += F.G) {
        { const int e = tid & 31, part = tid >> 5; int tot = 0, pre = 0;
          for (int w = part * 16; w < part * 16 + 16; ++w) { const int hh = HIST[w * 32 + e]; tot += hh; pre += (w < wgi) ? hh : 0; }
          Ls[part * 32 + e] = tot; Ls[512 + part * 32 + e] = pre; }
        Ls[2048 + tid] = RE[wgi * 512 + tid];
        __syncthreads();
        if (tid < 32) { int tot = 0, pre = 0; for (int p = 0; p < 16; ++p) { tot += Ls[p * 32 + tid]; pre += Ls[512 + p * 32 + tid]; } Ls[1200 + tid] = tot; Ls[1300 + tid] = pre; }
        __syncthreads();
        if (tid == 0) { int a = 0; for (int e = 0; e < 32; ++e) { Ls[1024 + e] = a; a += (Ls[1200 + e] + 255) / 256 * 256; } Ls[1056] = a; }
        __syncthreads();
        { const int e = tid & 31, seg = tid >> 5; int cnt = 0;
#pragma unroll 8
          for (int i = 0; i < 32; ++i) cnt += (Ls[2048 + seg * 32 + i] == e) ? 1 : 0;
          Ls[3072 + seg * 32 + e] = cnt;
          __syncthreads();
          int c = Ls[1024 + e] + Ls[1300 + e];
          for (int s2 = 0; s2 < seg; ++s2) c += Ls[3072 + s2 * 32 + e];
#pragma unroll 8
          for (int i = 0; i < 32; ++i) if (Ls[2048 + seg * 32 + i] == e) { Ls[2560 + seg * 32 + i] = c; ++c; } }
        __syncthreads();
        { const int pos = Ls[2560 + tid]; TOK[pos] = wgi * 128 + (tid >> 2); WGT[pos] = RW[wgi * 512 + tid]; POS[wgi * 512 + tid] = pos; }
        { const bf16_t* XBBp = WSP(bf16_t, W_XBB); unsigned char* XS8 = WSP(unsigned char, W_X8);
          for (int rg = 0; rg < 16; rg += 4) {
              u32x4 a[4], b2[4];
#pragma unroll
              for (int u = 0; u < 4; ++u) { const int r = F.wave * 16 + rg + u; const u32x4* src = (const u32x4*)(XBBp + (size_t)(wgi * 128 + r) * 1024 + F.lane * 16); a[u] = src[0]; b2[u] = src[1]; }
#pragma unroll
              for (int u = 0; u < 4; ++u) { const int r = F.wave * 16 + rg + u;
                  u32x4 o; o.x = pk4_fp8(bflo(a[u].x) * 16.f, bfhi(a[u].x) * 16.f, bflo(a[u].y) * 16.f, bfhi(a[u].y) * 16.f); o.y = pk4_fp8(bflo(a[u].z) * 16.f, bfhi(a[u].z) * 16.f, bflo(a[u].w) * 16.f, bfhi(a[u].w) * 16.f);
                  o.z = pk4_fp8(bflo(b2[u].x) * 16.f, bfhi(b2[u].x) * 16.f, bflo(b2[u].y) * 16.f, bfhi(b2[u].y) * 16.f); o.w = pk4_fp8(bflo(b2[u].z) * 16.f, bfhi(b2[u].z) * 16.f, bflo(b2[u].w) * 16.f, bfhi(b2[u].w) * 16.f);
#pragma unroll
                  for (int kx = 0; kx < 4; ++kx) { const int pos = Ls[2560 + r * 4 + kx]; *(u32x4*)(XS8 + (size_t)pos * 1024 + F.lane * 16) = o; } } }
          if (wgi < 32) { const int e = wgi; for (int r = Ls[1024 + e] + Ls[1200 + e] + F.wave; r < Ls[1024 + e + 1]; r += 8) *(u32x4*)(XS8 + (size_t)r * 1024 + F.lane * 16) = (u32x4){0u, 0u, 0u, 0u}; } }
        if (wgi < 32) { const int e = wgi; for (int r = Ls[1024 + e] + Ls[1200 + e] + tid; r < Ls[1024 + e + 1]; r += 512) { TOK[r] = 0; WGT[r] = 0.f; } }
        if (wgi == 0) { if (tid < 33) SORT[tid] = Ls[1024 + tid]; if (tid == 0) SORT[33] = Ls[1056] / 256;
            for (int pm = tid; pm < PMAX / 256; pm += 512) { int e = 0; for (int j = 1; j < 32; ++j) if (pm * 256 >= Ls[1024 + j]) e = j; SORT[64 + pm] = e; } }
        __syncthreads();
    }
}

DEV void p_gr(Frame& F) {
    const int gw = F.vcu * 8 + F.wave, NGW = F.G * 8, lane = F.lane, q4 = lane >> 4; const bf16_t* XB = WSP(bf16_t, W_XB); const bf16_t* Wg = WSP(bf16_t, W_IN1) + (size_t)3072 * 1024; float* GR = WSP(float, W_GR);
    for (int it = gw; it < T / 16; it += NGW) { f32x4 acc = {0.f, 0.f, 0.f, 0.f};
        const bf16_t* ap = XB + (size_t)(it * 16 + (lane & 15)) * 1024 + q4 * 8; const bf16_t* bp = Wg + (size_t)(lane & 15) * 1024 + q4 * 8;
        bf16x8 a[32], bb[32];
#pragma unroll
        for (int ks = 0; ks < 32; ++ks) { a[ks] = *(const bf16x8*)(ap + ks * 32); bb[ks] = *(const bf16x8*)(bp + ks * 32); }
#pragma unroll
        for (int ks = 0; ks < 32; ++ks) acc = __builtin_amdgcn_mfma_f32_16x16x32_bf16(a[ks], bb[ks], acc, 0, 0, 0);
#pragma unroll
        for (int r = 0; r < 4; ++r) GR[(size_t)(it * 16 + 4 * q4 + r) * 16 + (lane & 15)] = acc[r]; }
}

constexpr int GP = 264, GP2 = 144;
constexpr int GB_QIN = 0, GB_KST = 16896, GB_ATT = 35328, GB_DEC = 44544, GB_VT = 45056, GB_SIZE = 81920;
constexpr size_t W_GB = W_YS;
static_assert((size_t)2048 * GB_SIZE <= (size_t)PMAX * 2048, "blob region");
constexpr int GA_GRS = 0, GA_GT = 4096, GA_BL = 8192  , GA_QIN = GA_BL + GB_QIN, GA_KST = GA_BL + GB_KST, GA_ATT = GA_BL + GB_ATT, GA_DEC = GA_BL + GB_DEC, GA_KIN = GA_BL + 45056  , GA_VT = GA_KIN + 17408, GA_END = GA_VT + 36864;
DEV float logsigm_fast(float z) { const float e = __builtin_amdgcn_exp2f(-1.4426950408889634f * fabsf(z)); return fminf(z, 0.f) - 0.6931471805599453f * __builtin_amdgcn_logf(1.f + e); }
struct GlaRaw { unsigned q[16], k[16], v[32]; f32x4 ga, gb; };
DEV void p_gla_prep(Frame& F) {
    LAS unsigned char* lds = F.lds; const int tid = F.tid, lane = F.lane, wid = F.wave, q4 = lane >> 4, l15 = lane & 15;
    const bf16_t* H1 = WSP(bf16_t, W_HB); const float* GR = WSP(float, W_GR); unsigned char* GB = F.ws + W_GB;
    const float* wg2 = F.in[15]; const float* bg = F.in[16];
    for (int i = tid; i < 64 * GP2 / 4; i += 512) ((LAS unsigned*)(lds + GA_ATT))[i] = 0u;
    const int dk = 32 * (wid & 3) + (lane & 31), tg = 2 * (wid >> 2) + (lane >> 5);
    const int dvl = tid & 255, th2 = tid >> 8;
    const int tzm = 16 * (((lane & 31) >> 2) & 1) + 4 * ((lane & 31) >> 3) + (lane & 3);
    for (int wg = F.vcu; wg < 256; wg += F.G) {
        const int b = wg >> 4, h = (wg >> 2) & 3, n0 = (wg & 3) * 8;
        bf16x8 w2f; { float wv[8];
#pragma unroll
          for (int j = 0; j < 8; ++j) wv[j] = wg2[(8 * (lane >> 5) + j) * 512 + h * 128 + dk];
          const u32x4 ww = {cvt_pk(wv[0], wv[1]), cvt_pk(wv[2], wv[3]), cvt_pk(wv[4], wv[5]), cvt_pk(wv[6], wv[7])}; w2f = __builtin_bit_cast(bf16x8, ww); }
        const float bgv = bg[h * 128 + dk];
#define GLA_LOAD(R, n_) do { const size_t rb_ = (size_t)b * 2048 + (n_) * 64; \
        _Pragma("unroll") for (int i = 0; i < 16; ++i) { const size_t ro = (rb_ + 16 * tg + i) * 3072; R.q[i] = H1[ro + h * 128 + dk]; R.k[i] = H1[ro + 512 + h * 128 + dk]; } \
        _Pragma("unroll") for (int i = 0; i < 32; ++i) R.v[i] = H1[(rb_ + 32 * th2 + i) * 3072 + 1024 + h * 256 + dvl]; \
        { const float* gp_ = GR + (rb_ + 32 * (wid >> 2) + tzm) * 16 + 8 * (lane >> 5); R.ga = *(const f32x4*)gp_; R.gb = *(const f32x4*)(gp_ + 4); } } while (0)
        GlaRaw cur, nxt; GLA_LOAD(cur, n0); nxt = cur;
#pragma unroll 1
      for (int sub = 0; sub < 8; ++sub) { const int n = n0 + sub;
        if (sub + 1 < 8) GLA_LOAD(nxt, n + 1);
        float cs[16]; float run = 0.f;
        { const u32x4 aw = {cvt_pk(cur.ga.x, cur.ga.y), cvt_pk(cur.ga.z, cur.ga.w), cvt_pk(cur.gb.x, cur.gb.y), cvt_pk(cur.gb.z, cur.gb.w)};
          f32x16 zz;
#pragma unroll
          for (int r = 0; r < 16; ++r) zz[r] = bgv;
          zz = __builtin_amdgcn_mfma_f32_32x32x16_bf16(__builtin_bit_cast(bf16x8, aw), w2f, zz, 0, 0, 0);
#pragma unroll
          for (int i = 0; i < 16; ++i) { run += logsigm_fast(zz[i]) * (1.f / 16.f); cs[i] = run; } }
        ((LAS float*)(lds + GA_GT))[tg * 128 + dk] = run;
        __syncthreads();
        float off = 0.f, btot = 0.f;
#pragma unroll
        for (int g2 = 0; g2 < 4; ++g2) { const float gtv = ((LAS float*)(lds + GA_GT))[g2 * 128 + dk]; btot += gtv; off += (g2 < tg) ? gtv : 0.f; }
        if (tg == 0) ((LAS float*)(lds + GA_DEC))[dk] = __expf(btot);
        { unsigned kst[8];
#pragma unroll
          for (int i = 0; i < 16; i += 2) { float kk[2];
#pragma unroll
              for (int u = 0; u < 2; ++u) { const int t = 16 * tg + i + u; const float bc = cs[i + u] + off; const float qv = bflo(cur.q[i + u]), kv = bflo(cur.k[i + u]);
                  *(LAS bf16_t*)(lds + GA_QIN + t * GP + dk * 2) = (bf16_t)(cvt_pk(qv * __expf(bc), 0.f) & 0xffffu);
                  *(LAS bf16_t*)(lds + GA_KIN + t * 272 + dk * 2) = (bf16_t)(cvt_pk(kv * __expf(-bc), 0.f) & 0xffffu);
                  kk[u] = kv * __expf(btot - bc); }
              kst[i >> 1] = cvt_pk(kk[0], kk[1]); }
          *(LAS u32x4*)(lds + GA_KST + dk * GP2 + tg * 32) = (u32x4){kst[0], kst[1], kst[2], kst[3]};
          *(LAS u32x4*)(lds + GA_KST + dk * GP2 + tg * 32 + 16) = (u32x4){kst[4], kst[5], kst[6], kst[7]}; }
#pragma unroll
        for (int i = 0; i < 32; i += 8) *(LAS u32x4*)(lds + GA_VT + dvl * GP2 + (32 * th2 + i) * 2) = (u32x4){cur.v[i] | (cur.v[i + 1] << 16), cur.v[i + 2] | (cur.v[i + 3] << 16), cur.v[i + 4] | (cur.v[i + 5] << 16), cur.v[i + 6] | (cur.v[i + 7] << 16)};
        __syncthreads();
#pragma unroll
        for (int rep = 0; rep < 2; ++rep) { const int ti = wid + 8 * rep; if (ti < 10) {
            int jt, it2; if (ti < 4) { jt = 0; it2 = ti; } else if (ti < 7) { jt = 1; it2 = ti - 3; } else if (ti < 9) { jt = 2; it2 = ti - 5; } else { jt = 3; it2 = 3; }
            f32x4 a4 = {0.f, 0.f, 0.f, 0.f};
#pragma unroll
            for (int ks = 0; ks < 4; ++ks) { const bf16x8 kf = *(const LAS bf16x8*)(lds + GA_KIN + (16 * jt + l15) * 272 + ks * 64 + q4 * 16); const u32x2 q0_ = *(const LAS u32x2*)(lds + GA_QIN + (16 * it2 + l15) * GP + ks * 64 + q4 * 16), q1_ = *(const LAS u32x2*)(lds + GA_QIN + (16 * it2 + l15) * GP + ks * 64 + q4 * 16 + 8); const bf16x8 qf = __builtin_bit_cast(bf16x8, (u32x4){q0_.x, q0_.y, q1_.x, q1_.y});
                a4 = __builtin_amdgcn_mfma_f32_16x16x32_bf16(kf, qf, a4, 0, 0, 0); }
            const int i_ = 16 * it2 + l15, j0 = 16 * jt + 4 * q4;
            u32x2 w; w.x = cvt_pk(j0 <= i_ ? a4[0] : 0.f, j0 + 1 <= i_ ? a4[1] : 0.f); w.y = cvt_pk(j0 + 2 <= i_ ? a4[2] : 0.f, j0 + 3 <= i_ ? a4[3] : 0.f);
            *(LAS u32x2*)(lds + GA_ATT + i_ * GP2 + j0 * 2) = w; } }
        __syncthreads();
        unsigned char* blob = GB + (size_t)((b * 32 + n) * 4 + h) * GB_SIZE;
        for (int c = tid; c < 45056 / 16; c += 512) *(u32x4*)(blob + c * 16) = *(const LAS u32x4*)(lds + GA_BL + c * 16);
        for (int c = tid; c < 36864 / 16; c += 512) *(u32x4*)(blob + GB_VT + c * 16) = *(const LAS u32x4*)(lds + GA_VT + c * 16);
        cur = nxt;
      }
#undef GLA_LOAD
    }
}
constexpr int GS_BUF = 54272;
constexpr int GS_VT = 0, GS_QIN = 9216, GS_KST = GS_QIN + 16896, GS_ATT = GS_KST + 18432, GS_DEC = GS_ATT + 9216;
static_assert(3 * GS_BUF <= LDSCTL_OFF, "GLA ring");
DEV void gla_scan_item(Frame& F, int b, int h, int c4) {
    LAS unsigned char* lds = F.lds; const int lane = F.lane, wid = F.wave, q4 = lane >> 4, l15 = lane & 15;
    bf16_t* GO = WSP(bf16_t, W_GLAO); float* SS = WSP(float, W_SS); const unsigned char* GB = F.ws + W_GB;
    const int c16 = wid & 3, th = wid >> 2;
    f32x4 sacc[8];
#pragma unroll
    for (int m = 0; m < 8; ++m) sacc[m] = (f32x4){0.f, 0.f, 0.f, 0.f};
    const size_t rb = (size_t)b * 2048;
    float sqv[2][4]; unsigned ov[2][4];
#pragma unroll
    for (int mt = 0; mt < 2; ++mt)
#pragma unroll
        for (int r = 0; r < 4; ++r) { sqv[mt][r] = 0.f; ov[mt][r] = 0u; }
    const int npc = (wid < 5) ? 7 : 6;
#define GS_ISSUE(n_, bo_) do { const unsigned char* blob_ = GB + (size_t)((b * 32 + (n_)) * 4 + h) * GB_SIZE; \
        for (int p_ = wid; p_ < 53; p_ += 8) { const int so_ = p_ < 9 ? GB_VT + c4 * 9216 + p_ * 1024 : (p_ - 9) * 1024; \
            __builtin_amdgcn_global_load_lds((const unsigned*)(blob_ + so_ + lane * 16), (LAS unsigned*)(lds + (bo_) + p_ * 1024), 16, 0, 0); } } while (0)
    GS_ISSUE(0, 0); GS_ISSUE(1, GS_BUF);
    int bo = 0, bo2 = 2 * GS_BUF;
#pragma unroll 1
    for (int n = 0; n < 32; ++n) { const int t0 = n * 64;
        if (n + 1 < 32) { if (npc == 7) asm volatile("s_waitcnt vmcnt(7) lgkmcnt(0)\n\ts_barrier" ::: "memory"); else asm volatile("s_waitcnt vmcnt(6) lgkmcnt(0)\n\ts_barrier" ::: "memory"); } else asm volatile("s_waitcnt vmcnt(0) lgkmcnt(0)\n\ts_barrier" ::: "memory");
        if (n > 0) {
#pragma unroll
            for (int mt = 0; mt < 2; ++mt)
#pragma unroll
                for (int r = 0; r < 4; ++r) { const size_t trow = rb + (t0 - 64) + 32 * th + 16 * mt + 4 * q4 + r; GO[trow * 1024 + h * 256 + c4 * 64 + c16 * 16 + l15] = (bf16_t)ov[mt][r];
                    SS[(trow * 4 + h) * 16 + c4 * 4 + c16] = sqv[mt][r]; } }
        if (n + 2 < 32) GS_ISSUE(n + 2, bo2);
        const LAS unsigned char* bu = lds + bo;
        bf16x8 vf[2];
#pragma unroll
        for (int ks = 0; ks < 2; ++ks) vf[ks] = *(const LAS bf16x8*)(bu + GS_VT + (c16 * 16 + l15) * GP2 + ks * 64 + q4 * 16);
        bf16x8 sf[4];
#pragma unroll
        for (int ks = 0; ks < 4; ++ks) { const u32x4 w = {cvt_pk(sacc[2 * ks][0], sacc[2 * ks][1]), cvt_pk(sacc[2 * ks][2], sacc[2 * ks][3]), cvt_pk(sacc[2 * ks + 1][0], sacc[2 * ks + 1][1]), cvt_pk(sacc[2 * ks + 1][2], sacc[2 * ks + 1][3])}; sf[ks] = __builtin_bit_cast(bf16x8, w); }
#pragma unroll
        for (int mt = 0; mt < 2; ++mt) { const int i_ = 32 * th + 16 * mt + l15; f32x4 oa = {0.f, 0.f, 0.f, 0.f};
#pragma unroll
            for (int ks = 0; ks < 2; ++ks) { if (ks == 1 && th == 0) continue; const bf16x8 af = *(const LAS bf16x8*)(bu + GS_ATT + i_ * GP2 + ks * 64 + q4 * 16); oa = __builtin_amdgcn_mfma_f32_16x16x32_bf16(af, vf[ks], oa, 0, 0, 0); }
#pragma unroll
            for (int ks = 0; ks < 4; ++ks) { const u32x2 lo = *(const LAS u32x2*)(bu + GS_QIN + i_ * GP + (32 * ks + 4 * q4) * 2), hi2 = *(const LAS u32x2*)(bu + GS_QIN + i_ * GP + (32 * ks + 16 + 4 * q4) * 2);
                const u32x4 w = {lo.x, lo.y, hi2.x, hi2.y}; oa = __builtin_amdgcn_mfma_f32_16x16x32_bf16(__builtin_bit_cast(bf16x8, w), sf[ks], oa, 0, 0, 0); }
#pragma unroll
            for (int r = 0; r < 4; ++r) { ov[mt][r] = cvt_pk(oa[r], 0.f) & 0xffffu; float sq = oa[r] * oa[r]; sq += __shfl_xor(sq, 1); sq += __shfl_xor(sq, 2); sq += __shfl_xor(sq, 4); sq += __shfl_xor(sq, 8); sqv[mt][r] = sq; } }
#pragma unroll
        for (int md = 0; md < 8; ++md) { const f32x4 dc = *(const LAS f32x4*)(bu + GS_DEC + (16 * md + 4 * q4) * 4); sacc[md] = sacc[md] * dc;
#pragma unroll
            for (int ks = 0; ks < 2; ++ks) { const bf16x8 kf = *(const LAS bf16x8*)(bu + GS_KST + (16 * md + l15) * GP2 + ks * 64 + q4 * 16); sacc[md] = __builtin_amdgcn_mfma_f32_16x16x32_bf16(kf, vf[ks], sacc[md], 0, 0, 0); } }
        bo = (bo == 2 * GS_BUF) ? 0 : bo + GS_BUF; bo2 = (bo2 == 2 * GS_BUF) ? 0 : bo2 + GS_BUF;
    }
#undef GS_ISSUE
#pragma unroll
    for (int mt = 0; mt < 2; ++mt)
#pragma unroll
        for (int r = 0; r < 4; ++r) { const size_t trow = rb + 31 * 64 + 32 * th + 16 * mt + 4 * q4 + r; GO[trow * 1024 + h * 256 + c4 * 64 + c16 * 16 + l15] = (bf16_t)ov[mt][r]; SS[(trow * 4 + h) * 16 + c4 * 4 + c16] = sqv[mt][r]; }
    asm volatile("s_waitcnt vmcnt(0)" ::: "memory");
    __syncthreads();
}
DEV void p_gla_scan(Frame& F) { for (int v = F.vcu; v < 256; v += F.G) gla_scan_item(F, v >> 4, (v >> 2) & 3, v & 3); }

DEV void p_gla_norm(Frame& F) {
    const int gw = F.vcu * 8 + F.wave, NGW = F.G * 8, lane = F.lane; const bf16_t* GO = WSP(bf16_t, W_GLAO); const float* SS = WSP(float, W_SS); const bf16_t* H1 = WSP(bf16_t, W_HB); bf16_t* Y0 = WSP(bf16_t, W_Y0);
    const f32x4 nw = *(const f32x4*)(F.in[17] + lane * 4);
    for (int row = gw; row < T; row += NGW) {
#pragma unroll
        for (int h = 0; h < 4; ++h) { const float* sp = SS + ((size_t)row * 4 + h) * 16; const f32x4 a = *(const f32x4*)sp, b2 = *(const f32x4*)(sp + 4), c = *(const f32x4*)(sp + 8), d = *(const f32x4*)(sp + 12);
            const float sq = (a.x + a.y + a.z + a.w) + (b2.x + b2.y + b2.z + b2.w) + (c.x + c.y + c.z + c.w) + (d.x + d.y + d.z + d.w); const float r = 1.f / sqrtf(sq * (1.f / 256.f) + 1e-5f);
            const u32x2 o = *(const u32x2*)(GO + (size_t)row * 1024 + h * 256 + lane * 4); const u32x2 g = *(const u32x2*)(H1 + (size_t)row * 3072 + 2048 + h * 256 + lane * 4);
            const float g0 = bflo(g.x), g1 = bfhi(g.x), g2 = bflo(g.y), g3 = bfhi(g.y);
            u32x2 w; w.x = cvt_pk(bflo(o.x) * r * nw.x * g0 * fast_sigm(g0), bfhi(o.x) * r * nw.y * g1 * fast_sigm(g1)); w.y = cvt_pk(bflo(o.y) * r * nw.z * g2 * fast_sigm(g2), bfhi(o.y) * r * nw.w * g3 * fast_sigm(g3));
            *(u32x2*)(Y0 + (size_t)row * 1024 + h * 256 + lane * 4) = w; } }
}
#ifndef DENSE_STAGE
#define DENSE_STAGE 16
#endif
struct FStoreScale { bf16_t* O; int ldc, c_lo, c_hi; float sc; static constexpr int NSIDE = 0, STAGE = DENSE_STAGE; static constexpr bool PERM2 = false; typedef u32x4 PackT;
    DEV const void* side(const Unit&, int) const { return nullptr; }
    DEV NoPre pre(const Unit&, int, const LAS float*) const { return NoPre{}; }
    DEV unsigned char* rowptr(const Unit& u, int row) const { return (unsigned char*)(O + (size_t)row * ldc + u.pn * BM); }
    DEV u32x4 pack(const Unit&, int col, f32x4 v0, f32x4 v1, NoPre, const LAS float*) const { const float s = (col >= c_lo && col < c_hi) ? sc : 1.f;
        return (u32x4){cvt_pk(v0[0] * s, v0[1] * s), cvt_pk(v0[2] * s, v0[3] * s), cvt_pk(v1[0] * s, v1[1] * s), cvt_pk(v1[2] * s, v1[3] * s)}; }
    DEV void operator()(const Unit& u, int row, int col, f32x4 v0, f32x4 v1, NoPre p, const LAS float* sr) const { *(u32x4*)(O + (size_t)row * ldc + col) = pack(u, col, v0, v1, p, sr); } };
struct Pre8 { f32x4 b0, b1; };
struct FGlu { const bf16_t* Y; bf16_t* O; const float* b; static constexpr int NSIDE = 0, STAGE = 0; static constexpr bool PERM2 = false;
    DEV const void* side(const Unit&, int) const { return nullptr; }
    DEV Pre8 pre(const Unit&, int col, const LAS float*) const { return Pre8{*(const f32x4*)(b + col), *(const f32x4*)(b + col + 4)}; }
    DEV void operator()(const Unit&, int row, int col, f32x4 v0, f32x4 v1, const Pre8& pp, const LAS float*) const { const u32x4 y = *(const u32x4*)(Y + (size_t)row * 512 + col); const f32x4 b0 = pp.b0, b1 = pp.b1;
        const u32x4 w = {cvt_pk(bflo(y.x) * fast_sigm(v0[0] + b0.x), bfhi(y.x) * fast_sigm(v0[1] + b0.y)), cvt_pk(bflo(y.y) * fast_sigm(v0[2] + b0.z), bfhi(y.y) * fast_sigm(v0[3] + b0.w)),
                         cvt_pk(bflo(y.z) * fast_sigm(v1[0] + b1.x), bfhi(y.z) * fast_sigm(v1[1] + b1.y)), cvt_pk(bflo(y.w) * fast_sigm(v1[2] + b1.z), bfhi(y.w) * fast_sigm(v1[3] + b1.w))};
        *(u32x4*)(O + (size_t)row * 1024 + col) = w; } };
constexpr float ACT_SCALE = 4.f, WDN_SCALE = 128.f;
DEV float swiglu1s(float g, float u) { g = fminf(g, 7.f); u = __builtin_amdgcn_fmed3f(u, -7.f, 7.f); const float r = __builtin_amdgcn_rcpf(1.f + __builtin_amdgcn_exp2f(-1.702f * 1.4426950408889634f * g)); return (g * r) * fmaf(u, ACT_SCALE, ACT_SCALE); }
DEV f32x2 swiglu2(f32x2 g, f32x2 u4) { g.x = fminf(g.x, 7.f); g.y = fminf(g.y, 7.f); u4.x = __builtin_amdgcn_fmed3f(u4.x, -6.f * ACT_SCALE, 8.f * ACT_SCALE); u4.y = __builtin_amdgcn_fmed3f(u4.y, -6.f * ACT_SCALE, 8.f * ACT_SCALE);
    const f32x2 a = g * (-1.702f * 1.4426950408889634f); f32x2 e; e.x = __builtin_amdgcn_exp2f(a.x); e.y = __builtin_amdgcn_exp2f(a.y); e = e + 1.f;
    f32x2 r; r.x = __builtin_amdgcn_rcpf(e.x); r.y = __builtin_amdgcn_rcpf(e.y); return (g * r) * u4; }
struct FSwiglu { unsigned char* ACT; const float* bgu2; float sc; static constexpr int NSIDE = 1, STAGE = 4; static constexpr bool PERM2 = true; typedef unsigned PackT;
    DEV const void* side(const Unit& u, int) const { return bgu2 + (size_t)u.e * 2048 + u.pn * BM; }
    DEV Pre8 pre(const Unit&, int, const LAS float* sb) const { return Pre8{*(const LAS f32x4*)sb, *(const LAS f32x4*)(sb + 4)}; }
    DEV unsigned char* rowptr(const Unit& u, int row) const { return ACT + (size_t)row * 1024 + u.pn * (BM / 2); }
    DEV unsigned pack(const Unit& u, int col, f32x4 v0, f32x4 v1, const Pre8& pp, const LAS float*) const { const f32x4 b0 = pp.b0, b1 = pp.b1; const f32x2 sg = {sc, sc}, su = {sc * ACT_SCALE, sc * ACT_SCALE};
        const f32x2 a01 = swiglu2(__builtin_elementwise_fma((f32x2){v0[0], v0[1]}, sg, (f32x2){b0.x, b0.y}), __builtin_elementwise_fma((f32x2){v0[2], v0[3]}, su, (f32x2){b0.z, b0.w}));
        const f32x2 a23 = swiglu2(__builtin_elementwise_fma((f32x2){v1[0], v1[1]}, sg, (f32x2){b1.x, b1.y}), __builtin_elementwise_fma((f32x2){v1[2], v1[3]}, su, (f32x2){b1.z, b1.w}));
        return pk4_fp8(a01.x, a01.y, a23.x, a23.y); } };
constexpr float YS_SCALE = 64.f;
struct FDown { unsigned char* YS; const float* bd; const float* wgt; float sc; static constexpr int NSIDE = 2, STAGE = 8; static constexpr bool PERM2 = false; typedef u32x2 PackT;
    DEV const void* side(const Unit& u, int k) const { return k == 0 ? (const void*)(bd + (size_t)u.e * 1024 + u.pn * BM) : (const void*)(wgt + (size_t)u.pm * BM); }
    DEV Pre8 pre(const Unit&, int, const LAS float* sb) const { return Pre8{*(const LAS f32x4*)sb, *(const LAS f32x4*)(sb + 4)}; }
    DEV unsigned char* rowptr(const Unit& u, int row) const { return YS + (size_t)row * 1024 + u.pn * BM; }
    DEV u32x2 pack(const Unit& u, int col, f32x4 v0, f32x4 v1, const Pre8& pp, const LAS float* sr) const { const f32x4 b0 = pp.b0, b1 = pp.b1; const float wt = *sr * YS_SCALE, ws_ = sc * wt;
        u32x2 w; w.x = pk4_fp8(fmaf(v0[0], ws_, b0.x * wt), fmaf(v0[1], ws_, b0.y * wt), fmaf(v0[2], ws_, b0.z * wt), fmaf(v0[3], ws_, b0.w * wt)); w.y = pk4_fp8(fmaf(v1[0], ws_, b1.x * wt), fmaf(v1[1], ws_, b1.y * wt), fmaf(v1[2], ws_, b1.z * wt), fmaf(v1[3], ws_, b1.w * wt));
        return w; } };

constexpr int NPH = 21;
#ifndef DUP_GU
#define DUP_GU 0
#endif
#ifndef DUP_DN
#define DUP_DN 0
#endif
constexpr float X8_SCALE = 16.f, WGU_SCALE = 64.f;
constexpr float QSCALE0 = 0.125f * 1.4426950408889634f, QSCALE1 = 0.08838834764831845f;


#define NOINL __device__ __forceinline__
struct PA { const float* const* in; unsigned char* ws; float* out; int wave; };
#define MKFRAME extern __shared__ __attribute__((aligned(16))) unsigned char lds_[]; Frame F; F.lds = (LAS unsigned char*)lds_; F.wave = pa.wave; F.lane = (int)__builtin_amdgcn_mbcnt_hi(~0u, __builtin_amdgcn_mbcnt_lo(~0u, 0u)); F.tid = F.wave * 64 + F.lane; \
    F.G = gridDim.x; { const int bx = blockIdx.x; F.vcu = (F.G % 8 == 0) ? (bx % 8) * (F.G / 8) + bx / 8 : bx; } F.in = pa.in; F.ws = pa.ws;
template <class Fn> DEV void dense_gemm(Frame& F, const bf16_t* A, const bf16_t* Bt, int nM, int nN, int K, const Fn& fn) {
    Gemm g; g.A = A; g.Bt = Bt; g.rowmap = nullptr; g.bstride = 0; g.KB = K * 2; g.wave = F.wave;
    StaticOrder S; S.init(nM, nN, F.G, (int)blockIdx.x, nullptr);
    EpiRow8<Fn> E{fn};
    gemm_phase<false, false, true>(F.lds, g, S, E);
}
NOINL void ph_prologue(PA pa) { MKFRAME p0_prologue(F);
#ifdef WPROBE
    { u32x4* base = (u32x4*)(F.ws + W_HB) + (size_t)F.vcu * (2u << 20) / 16; const u32x4 v = {(unsigned)F.tid, 1u, 2u, 3u};
      for (int r = 0; r < 32; ++r) { u32x4* p = base + (WPROBE == 2 ? 0 : (size_t)r * 4096);
#pragma unroll
          for (int j = 0; j < 8; ++j) { if (WPROBE == 3) { const int fr_ = F.lane & 15, fq_ = F.lane >> 4; *(u32x2*)((unsigned char*)p + (size_t)(j * 16 + fr_) * 512 + F.wave * 32 + fq_ * 8) = (u32x2){v.x, v.y}; *(u32x2*)((unsigned char*)p + (size_t)(j * 16 + fr_) * 512 + 256 + F.wave * 32 + fq_ * 8) = (u32x2){v.z, v.w}; }
                                        else p[j * 512 + F.tid] = v; } } }
#endif
}
NOINL void ph_in0(PA pa) { MKFRAME dense_gemm(F, WSP(bf16_t, W_XB), WSP(bf16_t, W_IN0), T / 256, 8, 1024, FStoreScale{WSP(bf16_t, W_HB), 2048, 512, 1024, QSCALE0}); }
NOINL void ph_kmean(PA pa) { MKFRAME p_kmean(F); }
NOINL void ph_s5moba(PA pa, int mode) { MKFRAME p_s5_moba(F, mode); }
NOINL void ph_glu(PA pa) { MKFRAME dense_gemm(F, WSP(bf16_t, W_YS5), WSP(bf16_t, W_GLU), T / 256, 2, 512, FGlu{WSP(bf16_t, W_YS5), WSP(bf16_t, W_Y0), F.in[11]}); }
NOINL void ph_out(PA pa, int layer) { MKFRAME dense_gemm(F, WSP(bf16_t, W_Y0), layer ? WSP(bf16_t, W_OUT1) : WSP(bf16_t, W_OUT0), T / 256, 4, 1024, FStoreScale{WSP(bf16_t, W_MIXB), 1024, 0, 0, 1.f}); }
NOINL void ph_in1(PA pa) { MKFRAME dense_gemm(F, WSP(bf16_t, W_XB), WSP(bf16_t, W_IN1), T / 256, 12, 1024, FStoreScale{WSP(bf16_t, W_HB), 3072, 0, 512, QSCALE1}); p_gr(F); }
NOINL void ph_glaprep(PA pa) { MKFRAME p_gla_prep(F); }
NOINL void ph_glascan(PA pa) { MKFRAME p_gla_scan(F); }
NOINL void ph_glanorm(PA pa) { MKFRAME p_gla_norm(F); }
NOINL void ph_lnrouter(PA pa, int layer) { MKFRAME
    if (layer == 0) p_ln<0, true, false, false>(F, nullptr, WSP(bf16_t, W_XB), WSP(bf16_t, W_XBB), nullptr, F.in[19], F.in[20], F.in[23], F.in[24]);
    else p_ln<0, true, false, false>(F, nullptr, WSP(bf16_t, W_XB), WSP(bf16_t, W_XBB), nullptr, F.in[19] + 1024, F.in[20] + 1024, F.in[23] + (size_t)1024 * 32, F.in[24] + 32); }
NOINL void ph_sort(PA pa) { MKFRAME p_sort(F); }
NOINL void ph_gateup(PA pa, int layer) { MKFRAME const int* SORT = WSP(int, W_SORT);
    Gemm g; g.A = WSP(unsigned char, W_X8); g.Bt = WSP(unsigned char, W_GU) + (size_t)layer * 32 * 2048 * 1024; g.rowmap = nullptr; g.bstride = (size_t)2048 * 1024; g.KB = 1024; g.wave = F.wave;
    StaticOrder S; S.init(__builtin_amdgcn_readfirstlane(SORT[33]), 8, F.G, (int)blockIdx.x, (const LAS int*)(F.lds + LDS_ELIST)); fill_elist(F.lds, S, SORT + 64, F.tid);
    EpiRow8<FSwiglu> E{FSwiglu{WSP(unsigned char, W_ACT), WSP(float, W_BGU2) + (size_t)layer * 32 * 2048, 1.f / (X8_SCALE * WGU_SCALE)}};
#if DUP_GU
    if constexpr (DUP_GU == 5) gemm_phase<false, true, true, 5>(F.lds, g, S, E); else { DupOrder<StaticOrder> S2{S}; gemm_phase<false, true, true, DUP_GU>(F.lds, g, S2, E); } }
#else
    gemm_phase<false, true, true>(F.lds, g, S, E); }
#endif
NOINL void ph_down(PA pa, int layer) { MKFRAME const int* SORT = WSP(int, W_SORT);
    Gemm g; g.A = WSP(unsigned char, W_ACT); g.Bt = WSP(unsigned char, W_DN) + (size_t)layer * 32 * 1024 * 1024; g.rowmap = nullptr; g.bstride = (size_t)1024 * 1024; g.KB = 1024; g.wave = F.wave;
    StaticOrder S; S.init(__builtin_amdgcn_readfirstlane(SORT[33]), 4, F.G, (int)blockIdx.x, (const LAS int*)(F.lds + LDS_ELIST)); fill_elist(F.lds, S, SORT + 64, F.tid);
    EpiRow8<FDown> E{FDown{WSP(unsigned char, W_YS), F.in[28] + (size_t)layer * 32 * 1024, WSP(float, R_WGT), 1.f / (ACT_SCALE * WDN_SCALE)}};
#if DUP_DN
    if constexpr (DUP_DN == 5) gemm_phase<false, true, true, 5>(F.lds, g, S, E); else { DupOrder<StaticOrder> S2{S}; gemm_phase<false, true, true, DUP_DN>(F.lds, g, S2, E); } }
#else
    gemm_phase<false, true, true>(F.lds, g, S, E); }
#endif
NOINL void ph_combine(PA pa, int layer) { MKFRAME
    if (layer == 0) p_ln<1, false, false, false, false>(F, nullptr, WSP(bf16_t, W_XBB), WSP(bf16_t, W_XB), nullptr, F.in[21], F.in[22], nullptr, nullptr);
    else p_ln<1, false, false, true>(F, nullptr, WSP(bf16_t, W_XBB), nullptr, pa.out, F.in[21] + 1024, F.in[22] + 1024, nullptr, nullptr); }

__global__ void __launch_bounds__(512, 2) mega(Args args) {
    extern __shared__ __attribute__((aligned(16))) unsigned char lds_[];
    LAS unsigned char* lds = (LAS unsigned char*)lds_;
    unsigned* ctl = (unsigned*)(args.ws + W_CTL);
    for (int u = threadIdx.x; u < (LDS_BYTES - LDSCTL_OFF) / 4; u += 512) ((LAS unsigned*)(lds + LDSCTL_OFF))[u] = 0u;
    __syncthreads();
    const int lo = args.ph_lo, hi = args.ph_hi;
    PA pa; pa.in = args.in; pa.ws = args.ws; pa.out = args.out; pa.wave = __builtin_amdgcn_readfirstlane(threadIdx.x >> 6);
    XcdBarrier bar; bar.bar = ctl + CW_BAR; bar.x = 0; bar.st = nullptr; bar.wave = pa.wave;
    if (hi - lo > 1) bar = xcd_barrier_post(ctl + CW_BAR, (volatile LAS unsigned*)(lds + MISC_OFF) + 8, pa.wave);
#define IN(k) (lo <= (k) && (k) < hi)
#ifdef DIAG_LO
    volatile LAS unsigned long long* tsl = (volatile LAS unsigned long long*)(lds + MISC_OFF + 128);
    if (blockIdx.x == 0 && threadIdx.x == 0) tsl[0] = __builtin_amdgcn_s_memrealtime();
#define STAMP(k) do { if (blockIdx.x == 0 && threadIdx.x == 0) tsl[(k) + 1] = __builtin_amdgcn_s_memrealtime(); } while (0)
#else
#define STAMP(k) do { } while (0)
#endif
#define SEAM(k) do { if (IN(k) && IN((k) + 1)) xcd_barrier(bar); STAMP(k); } while (0)
#ifndef REP_PHASE
#define REP_PHASE -1
#define REP_N 0
#endif
#define RUN(k, call) do { if (IN(k)) { call; if ((k) == REP_PHASE) { xcd_barrier(bar); call; } } } while (0)
    RUN(0, ph_prologue(pa)); SEAM(0);
    RUN(1, ph_in0(pa)); SEAM(1);
    RUN(2, ph_kmean(pa)); SEAM(2);
    if (IN(3)) { ph_s5moba(pa, 1); if (REP_PHASE == 30) ph_s5moba(pa, 1); ph_s5moba(pa, 2); if (REP_PHASE == 31) ph_s5moba(pa, 2); } SEAM(3);
    RUN(4, ph_glu(pa)); SEAM(4);
    RUN(5, ph_out(pa, 0)); SEAM(5);
    if (REP_PHASE == 99) { for (int q_ = 0; q_ < 20; ++q_) xcd_barrier(bar); }
    RUN(6, ph_lnrouter(pa, 0)); SEAM(6);
    RUN(7, ph_sort(pa)); SEAM(7);
    RUN(8, ph_gateup(pa, 0)); SEAM(8);
    RUN(9, ph_down(pa, 0)); SEAM(9);
    RUN(10, ph_combine(pa, 0)); SEAM(10);
    RUN(11, ph_in1(pa)); SEAM(11);
    RUN(12, ph_glaprep(pa)); SEAM(12);
    RUN(13, ph_glascan(pa)); SEAM(13);
    RUN(14, ph_glanorm(pa)); SEAM(14);
    RUN(15, ph_out(pa, 1)); SEAM(15);
    RUN(16, ph_lnrouter(pa, 1)); SEAM(16);
    RUN(17, ph_sort(pa)); SEAM(17);
    RUN(18, ph_gateup(pa, 1)); SEAM(18);
    RUN(19, ph_down(pa, 1)); SEAM(19);
    RUN(20, ph_combine(pa, 1));
#ifdef DIAG_LO
    xcd_barrier(bar); STAMP(20);
    if (blockIdx.x == 0 && threadIdx.x == 0) { const unsigned long long dtk = tsl[DIAG_HI + 1] - tsl[DIAG_LO]; const float f = (float)dtk * (0.01f / 10000.f); __hip_atomic_store(ctl + 8, __float_as_uint(f), __ATOMIC_RELAXED, __HIP_MEMORY_SCOPE_AGENT); }
    xcd_barrier(bar);
    { const float f = __uint_as_float(__hip_atomic_load(ctl + 8, __ATOMIC_RELAXED, __HIP_MEMORY_SCOPE_AGENT));
      for (size_t i = (size_t)blockIdx.x * 512 + threadIdx.x; i < (size_t)T * 1024; i += (size_t)gridDim.x * 512) args.out[i] *= (1.f + f); }
#endif
#undef IN
#undef SEAM
}

static int g_grid = 0;
static bool launch_setup(size_t ws_size) {
    if (g_grid == 0) {
        if (ws_size < W_END) { fprintf(stderr, "kernel_launch: workspace too small: %zu < %zu\n", ws_size, (size_t)W_END); g_grid = -1; return false; }
        int dev = 0, cus = 0, per_cu = 0;
        if (hipGetDevice(&dev) != hipSuccess || hipDeviceGetAttribute(&cus, hipDeviceAttributeMultiprocessorCount, dev) != hipSuccess) { g_grid = -1; return false; }
        if (hipFuncSetAttribute((const void*)mega, hipFuncAttributeMaxDynamicSharedMemorySize, LDS_BYTES) != hipSuccess) { fprintf(stderr, "kernel_launch: hipFuncSetAttribute failed\n"); g_grid = -1; return false; }
        if (hipOccupancyMaxActiveBlocksPerMultiprocessor(&per_cu, (const void*)mega, 512, LDS_BYTES) != hipSuccess || per_cu < 1) fprintf(stderr, "kernel_launch: occupancy query reports %d blocks/CU\n", per_cu);
        (void)hipGetLastError();
        g_grid = cus;
    }
    return g_grid > 0;
}
static void launch_phases(hipStream_t stream, void* const* d_in, void* d_out, void* d_ws, int lo, int hi) {
    Args a; memset(&a, 0, sizeof a);
    for (int i = 0; i < 29; ++i) a.in[i] = (const float*)d_in[i];
    a.out = (float*)d_out; a.ws = (unsigned char*)d_ws; a.ph_lo = lo; a.ph_hi = hi;
    hipLaunchKernelGGL(mega, dim3(g_grid), dim3(512), LDS_BYTES, stream, a);
}
}
extern "C" void kernel_launch(void* const* d_in, const int* in_sizes, int n_in, void* d_out, int out_size, void* d_ws, size_t ws_size, hipStream_t stream) {
    if (n_in != 29 || out_size != T * D) { fprintf(stderr, "kernel_launch: unexpected arguments (n_in %d, out_size %d)\n", n_in, out_size); return; }
    if (!fk::launch_setup(ws_size)) return;
    (void)hipMemsetAsync((char*)d_ws + fk::W_CTL, 0, fk::CTL_ZERO_BYTES, stream);
    fk::launch_phases(stream, d_in, d_out, d_ws, 0, fk::NPH);
}
```

```cpp
#include <hip/hip_runtime.h>
#include <cstdio>
#include <cstdint>
#include <cmath>
#include <cstring>
#define DEV __device__ __forceinline__
constexpr int Bn = 16, L = 2048, D = 1024, T = Bn * L;
namespace fk {
#define LAS __attribute__((address_space(3)))
#define GAS __attribute__((address_space(1)))
typedef unsigned short bf16_t;
typedef short bf16x8 __attribute__((ext_vector_type(8)));
typedef short s16x4 __attribute__((ext_vector_type(4)));
typedef float f32x2 __attribute__((ext_vector_type(2)));
typedef float f32x4 __attribute__((ext_vector_type(4)));
typedef float f32x16 __attribute__((ext_vector_type(16)));
typedef unsigned u32x2 __attribute__((ext_vector_type(2)));
typedef unsigned u32x4 __attribute__((ext_vector_type(4)));
typedef __bf16 bf16x2_t __attribute__((ext_vector_type(2)));
struct u32x4x2 { u32x4 a, b; };
DEV unsigned cvt_pk(float lo, float hi) { f32x2 v = {lo, hi}; bf16x2_t b = __builtin_convertvector(v, bf16x2_t); return __builtin_bit_cast(unsigned, b); }
DEV float bflo(unsigned w) { return __uint_as_float(w << 16); }
DEV float bfhi(unsigned w) { return __uint_as_float(w & 0xffff0000u); }
DEV float fast_sigm(float x) { return __builtin_amdgcn_rcpf(1.f + __builtin_amdgcn_exp2f(-1.4426950408889634f * x)); }
DEV float gelu_tanh(float x) { const float u = 0.7978845608028654f * (x + 0.044715f * x * x * x); return x * fast_sigm(2.f * u); }
DEV float wave_sum(float v) {
#pragma unroll
    for (int o = 1; o < 64; o <<= 1) v += __shfl_xor(v, o);
    return v; }
DEV float swap32(float x) { auto rr = __builtin_amdgcn_permlane32_swap(__float_as_uint(x), __float_as_uint(x), false, false); return __uint_as_float((__builtin_amdgcn_mbcnt_lo(~0u, 0u) >> 5) ? rr[0] : rr[1]); }

constexpr int BM = 256, BK = 64, HALF = 128, HTB = HALF * BK * 2, STAGE_BYTES = 8 * HTB, NXCD = 8, WGM = 8;
constexpr int LDS_TOK = 135168 - 2048;
constexpr int LDS_SIDE = 135168;
constexpr int LDS_BYTES = 163840, LDSCTL_OFF = LDS_BYTES - 1024, MISC_OFF = LDSCTL_OFF + 320;

DEV int lds_byte(int r, int c) { const int st = (r >> 4) * 2 + (c >> 5), rr = r & 15, cc = c & 31, ob = rr * 64 + cc * 2; return st * 1024 + (ob ^ (((ob >> 9) & 1) << 5)); }
DEV void stage_rc(int b, int& R, int& C) { const int st = b / 1024, sb = b % 1024, swz = sb ^ (((sb >> 9) & 1) << 5); R = (st >> 1) * 16 + swz / 64; C = (st & 1) * 32 + (swz % 64) / 2; }
DEV int perm32(int rho) { const int n = rho >> 4, i = rho & 15; return 8 * (i >> 2) + 4 * n + (i & 3); }

struct Unit { int pm, pn, e; };
struct Gemm { const void* A; const void* Bt; const int* rowmap; size_t bstride; int KB; int wave; };

struct StaticOrder {
    int nM, nN, nwg, G, c; const LAS int* elist;
    DEV void init(int nM_, int nN_, int G_, int c_, const LAS int* el) { nM = nM_; nN = nN_; nwg = nM * nN; G = G_; c = c_; elist = el; }
    DEV bool place(int i, Unit& u) const {
        const long Lx = (long)i * G + c; if (Lx >= nwg) return false;
        int wgid = (int)Lx; { const int q = nwg / NXCD, r = nwg % NXCD, xcd = wgid % NXCD, off = wgid / NXCD; wgid = (xcd < r ? xcd * (q + 1) : r * (q + 1) + (xcd - r) * q) + off; }
        const int nig = WGM * nN, gid = wgid / nig, fm = gid * WGM, gsz = (nM - fm) < WGM ? (nM - fm) : WGM;
        u.pm = fm + ((wgid % nig) % gsz); u.pn = (wgid % nig) / gsz; u.e = 0; return true;
    }
    DEV bool next(int i, Unit& u) const { if (!place(i, u)) return false; if (elist) u.e = __builtin_amdgcn_readfirstlane(elist[i]); return true; }
};
constexpr int LDS_ELIST = 135168 + 6144;
DEV void fill_elist(LAS unsigned char* lds, const StaticOrder& S, const int* tile_e, int tid) {
    LAS int* el = (LAS int*)(lds + LDS_ELIST);
    if (tid < 64) { Unit u; el[tid] = S.place(tid, u) ? tile_e[u.pm] : 0; }
    __syncthreads();
}

struct NoPre {};
template <class F> struct EpiRow8 {
    static constexpr bool PERM = true; static constexpr int NSIDE = F::NSIDE; F f;
    DEV const void* side(const Unit& u, int k) const { return f.side(u, k); }
    DEV void operator()(const f32x4 (&acc)[2][2][4][2], const Unit& u, int wr, int wc, int fr, int fq, const LAS float* sd) const {
        { const int ln_ = (int)__builtin_amdgcn_mbcnt_hi(~0u, __builtin_amdgcn_mbcnt_lo(~0u, 0u)); fr = ln_ & 15; fq = ln_ >> 4; }
        const int cl = wc * 32 + 8 * fq, c0 = u.pn * BM + cl;
        if constexpr (NSIDE > 0) {
#pragma unroll
            for (int ai = 0; ai < 2; ++ai)
#pragma unroll
                for (int m = 0; m < 4; ++m) { const int rl = ai * HALF + wr * 64 + m * 16 + fr, row = u.pm * BM + rl;
                    f(u, row, c0, acc[ai][0][m][0], acc[ai][0][m][1], f.pre(u, c0, sd + cl), sd + 256 + rl); f(u, row, c0 + HALF, acc[ai][1][m][0], acc[ai][1][m][1], f.pre(u, c0 + HALF, sd + cl + HALF), sd + 256 + rl); }
        } else {
        const auto p0 = f.pre(u, c0, sd + cl), p1 = f.pre(u, c0 + HALF, sd + cl + HALF);
#pragma unroll
        for (int ai = 0; ai < 2; ++ai)
#pragma unroll
            for (int m = 0; m < 4; ++m) { const int rl = ai * HALF + wr * 64 + m * 16 + fr, row = u.pm * BM + rl;
                f(u, row, c0, acc[ai][0][m][0], acc[ai][0][m][1], p0, sd + 256 + rl); f(u, row, c0 + HALF, acc[ai][1][m][0], acc[ai][1][m][1], p1, sd + 256 + rl); }
        }
    }
};

typedef int v8i_t __attribute__((ext_vector_type(8)));
typedef int v4i_t __attribute__((ext_vector_type(4)));
template <bool GATHER, bool FP8, bool ALIGN, class Epi, class Sched>
DEV void gemm_phase(LAS unsigned char* lds, const Gemm g, const Sched& S, const Epi& E) {
    const int wid = g.wave, lane = (int)__builtin_amdgcn_mbcnt_hi(~0u, __builtin_amdgcn_mbcnt_lo(~0u, 0u)), tid = wid * 64 + lane, wr = wid >> 2, wc = wid & 3, fr = lane & 15, fq = lane >> 4;

    const int KB = g.KB, nt = KB / 128;
    int R0, C2; { int C; stage_rc(tid * 16, R0, C); C2 = C * 2; }
    unsigned voffB[2]; { const int Rb = Epi::PERM ? ((R0 & ~31) + perm32(R0 & 31)) : R0; voffB[0] = (unsigned)(Rb * KB + C2); voffB[1] = voffB[0] + 64u * (unsigned)KB; }
    const unsigned kstep = 128u, hstep = (unsigned)HALF * KB, tstep = 2u * hstep;
    const unsigned ldsw = (unsigned)wid * 1024u;
    const int aoff = lds_byte(wr * 64 + fr, fq * 8); int boff = lds_byte(wc * 32 + fr, fq * 8) + 4 * HTB; asm volatile("" : "+v"(boff));
    LAS int* tokb = (LAS int*)(lds + LDS_TOK);
    const auto rsA = __builtin_amdgcn_make_buffer_rsrc((void*)g.A, 0, 0x7fffffff, 0x00020000);
    const auto rsB = __builtin_amdgcn_make_buffer_rsrc((void*)g.Bt, 0, 0x7fffffff, 0x00020000);
    const auto rsT = __builtin_amdgcn_make_buffer_rsrc((void*)(GATHER ? (const void*)g.rowmap : g.A), 0, 0x7fffffff, 0x00020000);
#define PG8_SA(b, h) (((b) * 2 + (h)) * HTB)
#define PG8_SB(b, h) ((4 + (b) * 2 + (h)) * HTB)
#define PG8_STAGE(bufoff, rs, soff, voff) do { _Pragma("unroll") for (int _i = 0; _i < 2; ++_i) { \
        if constexpr (GATHER) __builtin_amdgcn_raw_ptr_buffer_load_lds(rs, (LAS void*)(lds + (bufoff) + ldsw + _i * 8192), 16, (int)(voff)[_i], (int)(soff), 0, 0); \
        else __builtin_amdgcn_raw_ptr_buffer_load_lds(rs, (LAS void*)(lds + (bufoff) + ldsw + _i * 8192), 16, (int)(voff)[0], (int)((soff) + _i * 64u * (unsigned)KB), 0, 0); } } while (0)
#define PG8_LDA(dst, b, h) do { _Pragma("unroll") for (int m = 0; m < 4; ++m) _Pragma("unroll") for (int k = 0; k < 2; ++k) dst[m][k] = *(const LAS bf16x8*)(lds + PG8_SA(b, h) + aoff + m * 2048 + k * 1024); } while (0)
#define PG8_LDB(dst, b, h) do { _Pragma("unroll") for (int n = 0; n < 2; ++n) _Pragma("unroll") for (int k = 0; k < 2; ++k) dst[n][k] = *(const LAS bf16x8*)(lds + boff + (PG8_SB(b, h) - 4 * HTB) + n * 2048 + k * 1024); } while (0)
#define PG8_CAT(x) __builtin_shufflevector(__builtin_bit_cast(v4i_t, x[0]), __builtin_bit_cast(v4i_t, x[1]), 0, 1, 2, 3, 4, 5, 6, 7)
#define PG8_MMA(ai, bj, At, Bt) do { __builtin_amdgcn_s_setprio(1); _Pragma("unroll") for (int m = 0; m < 4; ++m) _Pragma("unroll") for (int n = 0; n < 2; ++n) { \
        if constexpr (FP8) acc[ai][bj][m][n] = __builtin_amdgcn_mfma_scale_f32_16x16x128_f8f6f4(PG8_CAT(Bt[n]), PG8_CAT(At[m]), acc[ai][bj][m][n], 0, 0, 0, 0, 0, 0); \
        else { _Pragma("unroll") for (int k = 0; k < 2; ++k) acc[ai][bj][m][n] = __builtin_amdgcn_mfma_f32_16x16x32_bf16(Bt[n][k], At[m][k], acc[ai][bj][m][n], 0, 0, 0); } } __builtin_amdgcn_s_setprio(0); } while (0)
#define PG8_MMA0(ai, bj, At, Bt) do { __builtin_amdgcn_s_setprio(1); _Pragma("unroll") for (int m = 0; m < 4; ++m) _Pragma("unroll") for (int n = 0; n < 2; ++n) { const f32x4 zz_ = {0.f, 0.f, 0.f, 0.f}; \
        if constexpr (FP8) acc[ai][bj][m][n] = __builtin_amdgcn_mfma_scale_f32_16x16x128_f8f6f4(PG8_CAT(Bt[n]), PG8_CAT(At[m]), zz_, 0, 0, 0, 0, 0, 0); \
        else { acc[ai][bj][m][n] = __builtin_amdgcn_mfma_f32_16x16x32_bf16(Bt[n][0], At[m][0], zz_, 0, 0, 0); acc[ai][bj][m][n] = __builtin_amdgcn_mfma_f32_16x16x32_bf16(Bt[n][1], At[m][1], acc[ai][bj][m][n], 0, 0, 0); } } __builtin_amdgcn_s_setprio(0); } while (0)
#define PG8_WAIT_V(n) asm volatile("s_waitcnt vmcnt(" #n ")" ::: "memory")
#define PG8_WAIT_L(n) asm volatile("s_waitcnt lgkmcnt(" #n ")" ::: "memory")
#define PG8_BAR __builtin_amdgcn_s_barrier()
#define PG8_SCHED __builtin_amdgcn_sched_barrier(0)
    Unit cur, nxt; int ui = 0;
    if (!S.next(0, cur)) return;
    f32x4 acc[2][2][4][2];
    bf16x8 At[4][2], B0[2][2], B1[2][2];
    unsigned cA, cB = (unsigned)cur.e * (unsigned)g.bstride + (unsigned)cur.pn * tstep;
    unsigned voffA[2]; voffA[0] = (unsigned)(R0 * KB + C2); voffA[1] = voffA[0] + 64u * (unsigned)KB;
    if constexpr (GATHER) { cA = 0u;
        if (wid < 4) __builtin_amdgcn_raw_ptr_buffer_load_lds(rsT, (LAS void*)(tokb + wid * 64), 4, (wid * 64 + lane) * 4, cur.pm * (BM * 4), 0, 0);
        asm volatile("s_waitcnt vmcnt(0)" ::: "memory"); __builtin_amdgcn_s_barrier();
    } else cA = (unsigned)cur.pm * tstep;
    const unsigned hA = GATHER ? 0u : hstep;
    LAS float* sideb = (LAS float*)(lds + LDS_SIDE);
#define PG8_SIDE(un, sel) do { if constexpr (Epi::NSIDE > 0) { if (wid < Epi::NSIDE) { const char* sp_ = (const char*)E.side(un, wid); int ln_ = (int)__builtin_amdgcn_mbcnt_hi(~0u, __builtin_amdgcn_mbcnt_lo(~0u, 0u)); asm volatile("" : "+v"(ln_)); \
        __builtin_amdgcn_global_load_lds((const unsigned*)(sp_ + ln_ * 16), (LAS unsigned*)(sideb + (sel) * 512 + wid * 256), 16, 0, 0); } } } while (0)
    PG8_SIDE(cur, 0);
#define PG8_OA(dst, sel, h) unsigned dst[2]; if constexpr (GATHER) { dst[0] = (unsigned)(tokb[(sel) * 256 + (h) * HALF + R0] * KB + C2); dst[1] = (unsigned)(tokb[(sel) * 256 + (h) * HALF + R0 + 64] * KB + C2); } else { dst[0] = voffA[0]; dst[1] = voffA[1]; }
    { PG8_OA(p0_, 0, 0); PG8_OA(p1_, 0, 1); PG8_STAGE(PG8_SB(0, 0), rsB, cB, voffB); PG8_STAGE(PG8_SB(0, 1), rsB, cB + hstep, voffB); PG8_STAGE(PG8_SA(0, 0), rsA, cA, p0_); PG8_STAGE(PG8_SA(0, 1), rsA, cA + hA, p1_); }
    if (wr == 1) PG8_BAR;
    PG8_WAIT_V(2); PG8_BAR;
    { PG8_OA(p0_, 0, 0); PG8_STAGE(PG8_SB(1, 0), rsB, cB + kstep, voffB); PG8_STAGE(PG8_SA(1, 0), rsA, cA + kstep, p0_); PG8_STAGE(PG8_SB(1, 1), rsB, cB + hstep + kstep, voffB); }
    PG8_WAIT_V(6); PG8_BAR;
    for (;;) {
        const bool has_next = S.next(ui + 1, nxt);
        unsigned nA = cA, nB = cB;
        if (has_next) { nB = (unsigned)nxt.e * (unsigned)g.bstride + (unsigned)nxt.pn * tstep;
            if constexpr (GATHER) { if (wid < 4) { const int ln_ = (int)__builtin_amdgcn_mbcnt_hi(~0u, __builtin_amdgcn_mbcnt_lo(~0u, 0u)); __builtin_amdgcn_raw_ptr_buffer_load_lds(rsT, (LAS void*)(tokb + ((ui + 1) & 1) * 256 + wid * 64), 4, (wid * 64 + ln_) * 4, nxt.pm * (BM * 4), 0, 0); } }
            else nA = (unsigned)nxt.pm * tstep;
            PG8_SIDE(nxt, (ui + 1) % 3); }
#pragma unroll 1
        for (int t = 0; t < nt; t += 2) {
            const bool last = (t == nt - 2);
            const unsigned a1 = cA + (unsigned)(t + 1) * kstep;
            const unsigned a2 = last ? nA : cA + (unsigned)(t + 2) * kstep, b2 = last ? nB : cB + (unsigned)(t + 2) * kstep;
            const unsigned a3 = a2 + kstep, b3 = b2 + kstep;
            const int selc = ui & 1, seln = (last && has_next) ? ((ui + 1) & 1) : selc;
            PG8_LDB(B0, 0, 0); PG8_LDB(B1, 0, 1); PG8_SCHED; PG8_LDA(At, 0, 0); { PG8_OA(q_, selc, 1); PG8_STAGE(PG8_SA(1, 1), rsA, a1 + hA, q_); }
            PG8_WAIT_V(8); PG8_WAIT_L(0); PG8_BAR; if (t == 0) { PG8_MMA0(0, 0, At, B0); PG8_MMA0(0, 1, At, B1); } else { PG8_MMA(0, 0, At, B0); PG8_MMA(0, 1, At, B1); } PG8_BAR; PG8_SCHED;
            PG8_LDA(At, 0, 1); PG8_STAGE(PG8_SB(0, 0), rsB, b2, voffB); PG8_STAGE(PG8_SB(0, 1), rsB, b2 + hstep, voffB); { PG8_OA(q_, seln, 0); PG8_STAGE(PG8_SA(0, 0), rsA, a2, q_); }
            PG8_WAIT_V(8); PG8_WAIT_L(0); PG8_BAR; if (t == 0) { PG8_MMA0(1, 0, At, B0); PG8_MMA0(1, 1, At, B1); } else { PG8_MMA(1, 0, At, B0); PG8_MMA(1, 1, At, B1); } PG8_BAR; PG8_SCHED;
            PG8_LDB(B0, 1, 0); PG8_LDB(B1, 1, 1); PG8_SCHED; PG8_LDA(At, 1, 0); { PG8_OA(q_, seln, 1); PG8_STAGE(PG8_SA(0, 1), rsA, a2 + hA, q_); }
            PG8_WAIT_V(8); PG8_WAIT_L(0); PG8_BAR; PG8_MMA(0, 0, At, B0); PG8_MMA(0, 1, At, B1); PG8_BAR; PG8_SCHED;
            PG8_LDA(At, 1, 1); PG8_STAGE(PG8_SB(1, 0), rsB, b3, voffB); PG8_STAGE(PG8_SB(1, 1), rsB, b3 + hstep, voffB); { PG8_OA(q_, seln, 0); PG8_STAGE(PG8_SA(1, 0), rsA, a3, q_); }
            PG8_WAIT_V(8); PG8_WAIT_L(0); PG8_BAR; PG8_MMA(1, 0, At, B0); PG8_MMA(1, 1, At, B1); PG8_BAR; PG8_SCHED;
        }
        if constexpr (ALIGN) { if (wr == 0) PG8_BAR; }
        E(acc, cur, wr, wc, fr, fq, sideb + (ui % 3) * 512);
        if (!has_next) break;
        cur = nxt; cA = nA; cB = nB; ++ui;
        if constexpr (ALIGN) { if (wr == 1) PG8_BAR; }
    }
    PG8_WAIT_V(0);
    if constexpr (!ALIGN) { if (wr == 0) PG8_BAR; }
    PG8_BAR;
#undef PG8_SA
#undef PG8_SB
#undef PG8_STAGE
#undef PG8_SIDE
#undef PG8_OA
#undef PG8_LDA
#undef PG8_LDB
#undef PG8_MMA
#undef PG8_MMA0
#undef PG8_CAT
#undef PG8_WAIT_V
#undef PG8_WAIT_L
#undef PG8_BAR
#undef PG8_SCHED
}

typedef GAS unsigned gu32;
#define XB_TMO      128
#define XB_XCNT(j)  (256  + 64 * (j))
#define XB_XSUB(j)  (1280 + 64 * (j))
#define XB_XGEN(j)  (2304 + 64 * (j))
#define XB_TOP      3328
#define XB_TOPGEN   3392
#define XCD_BAR_WORDS 3456
#define XB_SPIN_CAP (1u << 20)
DEV unsigned xb_ld(unsigned* p) { return __hip_atomic_load(p, __ATOMIC_RELAXED, __HIP_MEMORY_SCOPE_AGENT); }
DEV unsigned xb_add(unsigned* p, unsigned v) { return __hip_atomic_fetch_add(p, v, __ATOMIC_RELAXED, __HIP_MEMORY_SCOPE_AGENT); }
DEV unsigned xb_xcc_id() { return (unsigned)__builtin_amdgcn_s_getreg((3 << 11) | 20) & 0xFu; }
#define XB_SPIN(cond, bar) do { unsigned _sp = 0; while (cond) { __builtin_amdgcn_s_sleep(1); \
    if ((++_sp & 255u) == 0u) { if (xb_ld(&(bar)[XB_TMO])) break; if (_sp > XB_SPIN_CAP) { atomicAdd(&(bar)[XB_TMO], 1u); break; } } } } while (0)
struct XcdBarrier { unsigned* bar; unsigned x; volatile LAS unsigned* st; int wave; };
DEV bool xb_thread0(int wave) { return wave == 0 && __builtin_amdgcn_mbcnt_hi(~0u, __builtin_amdgcn_mbcnt_lo(~0u, 0u)) == 0u; }
DEV XcdBarrier xcd_barrier_post(unsigned* bar, volatile LAS unsigned* st, int wave) {
    XcdBarrier b; b.bar = bar; b.x = xb_xcc_id(); b.st = st; b.wave = wave;
    if (xb_thread0(wave)) (void)xb_add(&bar[XB_XCNT(b.x)], 1u);
    return b;
}
DEV void xcd_barrier_complete(unsigned* bar, unsigned x, unsigned& nloc, unsigned& nx) {
    const unsigned G = gridDim.x * gridDim.y * gridDim.z;
    unsigned sum, cnt, mine, sp = 0u;
    for (;;) {
        sum = 0u; cnt = 0u; mine = 0u;
#pragma unroll
        for (unsigned j = 0; j < 16; ++j) { const unsigned c = xb_ld(&bar[XB_XCNT(j)]); sum += c; cnt += (c > 0u) ? 1u : 0u; mine = (j == x) ? c : mine; }
        if (sum == G) break;
        __builtin_amdgcn_s_sleep(1);
        if ((++sp & 255u) == 0u) { if (xb_ld(&bar[XB_TMO])) break; if (sp > XB_SPIN_CAP) { atomicAdd(&bar[XB_TMO], 1u); break; } }
    }
    nloc = mine > 0u ? mine : 1u; nx = cnt > 0u ? cnt : 1u;
}
DEV void xcd_barrier(const XcdBarrier& b) {
    asm volatile("s_waitcnt vmcnt(0)" ::: "memory");
    __syncthreads();
    if (xb_thread0(b.wave)) {
        unsigned* bar = b.bar;
        __builtin_amdgcn_s_waitcnt(0);
        unsigned nloc = b.st[0], nx = b.st[1];
        if (nloc == 0u) { xcd_barrier_complete(bar, b.x, nloc, nx); b.st[0] = nloc; b.st[1] = nx; }
        const unsigned old = xb_add(&bar[XB_XSUB(b.x)], 1u);
        const unsigned gen = old / nloc;
        if (old + 1u == (gen + 1u) * nloc) {
            __builtin_amdgcn_fence(__ATOMIC_RELEASE, "agent");
            asm volatile("s_waitcnt vmcnt(0)" ::: "memory");
            const unsigned og = xb_add(&bar[XB_TOP], 1u);
            const unsigned tg = og / nx;
            if (og + 1u == (tg + 1u) * nx) xb_add(&bar[XB_TOPGEN], 1u);
            else XB_SPIN(xb_ld(&bar[XB_TOPGEN]) == tg, bar);
            __builtin_amdgcn_fence(__ATOMIC_ACQUIRE, "agent");
            xb_add(&bar[XB_XGEN(b.x)], 1u);
            asm volatile("s_waitcnt vmcnt(0)" ::: "memory");
        } else {
            XB_SPIN(xb_ld(&bar[XB_XGEN(b.x)]) == gen, bar);
            __builtin_amdgcn_fence(__ATOMIC_ACQUIRE, "agent");
            asm volatile("s_waitcnt vmcnt(0)" ::: "memory");
        }
    }
    __syncthreads();
}
constexpr size_t MiB = 1u << 20;
constexpr int PMAX = 131072 + 32 * 256;
constexpr size_t W_CTL = 0, CTL_ZERO_BYTES = 64 * 1024;
constexpr size_t W_IN0 = 2 * MiB, W_GLU = 6 * MiB, W_OUT0 = 7 * MiB, W_IN1 = 9 * MiB, W_OUT1 = 16 * MiB;
constexpr size_t W_LUT = 18 * MiB, W_KM = W_LUT + 64 * 1024, W_HIST = W_KM + 256 * 1024, W_SORT = W_HIST + 64 * 1024  , W_GR = 20 * MiB  , W_SS = 22 * MiB  ;
constexpr size_t W_GU = 32 * MiB, W_DN = 288 * MiB, W_XB = 416 * MiB  , W_XBB = 480 * MiB  , W_X8 = 1024 * MiB  , W_HB = 736 * MiB, W_YS5 = 928 * MiB, W_Y0 = 960 * MiB, W_MIXB = 1024 * MiB, W_GLAO = 1088 * MiB;
constexpr size_t W_ROUTE = 26 * MiB  , W_ACT = 736 * MiB  , W_YS = 1160 * MiB, W_END = 1432 * MiB;
static_assert(W_ACT + (size_t)PMAX * 2048 <= W_MIXB && W_YS + (size_t)PMAX * 2048 <= W_END && W_X8 + (size_t)PMAX * 1024 <= W_YS && W_ROUTE + 4 * MiB <= W_GU, "ws map");
constexpr int CW_BAR = 4096;

struct Args { const float* in[29]; float* out; unsigned char* ws; int ph_lo, ph_hi; };
struct Frame {
    LAS unsigned char* lds; int tid, lane, wave, vcu, G;
    const float* const* in; unsigned char* ws;
};
#define WSP(T_, off) ((T_*)(F.ws + (off)))

DEV unsigned pk4_fp8(float a, float b, float c, float d) { unsigned w = 0u; w = __builtin_amdgcn_cvt_pk_fp8_f32(a, b, w, false); w = __builtin_amdgcn_cvt_pk_fp8_f32(c, d, w, true); return w; }
struct CvItem { const float* src; unsigned char* dst; int pitch, K; float sc; };
constexpr int P0_I_GU = 8 * 8, P0_I_DN = 8 * 4, P0_I_IN0 = 8 * 8, P0_I_GLU = 4 * 2, P0_I_O = 8 * 4, P0_I_IN1 = 8 * 12;
constexpr int P0_N_GU = 64 * P0_I_GU, P0_N_DN = 64 * P0_I_DN, P0_NITEMS = P0_N_GU + P0_N_DN + P0_I_IN0 + P0_I_GLU + 2 * P0_I_O + P0_I_IN1;
DEV CvItem cv_decode(Frame& F, int it) {
    int r = it; const float* W; unsigned char* D; int K, N, NP, es; float sc = 0.f;
    if (r < P0_N_GU) { const int m = r / P0_I_GU; r %= P0_I_GU; W = F.in[25] + (size_t)m * 1024 * 2048; D = WSP(unsigned char, W_GU) + (size_t)m * 2048 * 1024; K = 1024; N = 2048; NP = 2048; es = 1; sc = 64.f; }
    else if ((r -= P0_N_GU) < P0_N_DN) { const int m = r / P0_I_DN; r %= P0_I_DN; W = F.in[27] + (size_t)m * 1024 * 1024; D = WSP(unsigned char, W_DN) + (size_t)m * 1024 * 1024; K = 1024; N = 1024; NP = 1024; es = 1; sc = 128.f; }
    else if ((r -= P0_N_DN) < P0_I_IN0) { W = F.in[1]; D = WSP(unsigned char, W_IN0); K = 1024; N = 2048; NP = 2048; es = 2; }
    else if ((r -= P0_I_IN0) < P0_I_GLU) { W = F.in[10]; D = WSP(unsigned char, W_GLU); K = 512; N = 512; NP = 512; es = 2; }
    else if ((r -= P0_I_GLU) < P0_I_O) { W = F.in[13]; D = WSP(unsigned char, W_OUT0); K = 1024; N = 1024; NP = 1024; es = 2; }
    else if ((r -= P0_I_O) < P0_I_O) { W = F.in[18]; D = WSP(unsigned char, W_OUT1); K = 1024; N = 1024; NP = 1024; es = 2; }
    else { r -= P0_I_O; W = F.in[14]; D = WSP(unsigned char, W_IN1); K = 1024; N = 3072; NP = 3088; es = 2; }
    const int nblk = N / 256, kb = r / nblk, nb = r % nblk;
    CvItem c; c.src = W + (size_t)(128 * kb) * NP + 256 * nb; c.dst = D + ((size_t)(256 * nb) * K + 128 * kb) * es; c.pitch = NP; c.K = K; c.sc = sc; return c;
}
DEV void cv_load(const CvItem& c, f32x4 (&v)[16], int tid) {
#pragma unroll
    for (int i = 0; i < 16; ++i) v[i] = *(const f32x4*)(c.src + (size_t)(8 * i + (tid >> 6)) * c.pitch + 4 * (tid & 63));
}
DEV void cv_store(const CvItem& c, const f32x4 (&v)[16], LAS float* T_, int tid) {
#pragma unroll
    for (int i = 0; i < 16; ++i) *(LAS f32x4*)(T_ + (8 * i + (tid >> 6)) * 260 + 4 * (tid & 63)) = v[i];
    __syncthreads();
    const int n = tid & 255, kh = tid >> 8; const LAS float* s = T_ + (64 * kh) * 260 + n;
    if (c.sc > 0.f) { const float q = c.sc; unsigned char* d = c.dst + (size_t)n * c.K + 64 * kh;
#pragma unroll
        for (int g = 0; g < 4; ++g) { u32x4 o;
            o.x = pk4_fp8(s[(16 * g + 0) * 260] * q, s[(16 * g + 1) * 260] * q, s[(16 * g + 2) * 260] * q, s[(16 * g + 3) * 260] * q); o.y = pk4_fp8(s[(16 * g + 4) * 260] * q, s[(16 * g + 5) * 260] * q, s[(16 * g + 6) * 260] * q, s[(16 * g + 7) * 260] * q);
            o.z = pk4_fp8(s[(16 * g + 8) * 260] * q, s[(16 * g + 9) * 260] * q, s[(16 * g + 10) * 260] * q, s[(16 * g + 11) * 260] * q); o.w = pk4_fp8(s[(16 * g + 12) * 260] * q, s[(16 * g + 13) * 260] * q, s[(16 * g + 14) * 260] * q, s[(16 * g + 15) * 260] * q);
            *(u32x4*)(d + 16 * g) = o; }
    } else { unsigned char* d = c.dst + ((size_t)n * c.K + 64 * kh) * 2;
#pragma unroll
        for (int g = 0; g < 8; ++g) { u32x4 o; o.x = cvt_pk(s[(8 * g + 0) * 260], s[(8 * g + 1) * 260]); o.y = cvt_pk(s[(8 * g + 2) * 260], s[(8 * g + 3) * 260]); o.z = cvt_pk(s[(8 * g + 4) * 260], s[(8 * g + 5) * 260]); o.w = cvt_pk(s[(8 * g + 6) * 260], s[(8 * g + 7) * 260]);
            *(u32x4*)(d + 16 * g) = o; }
    }
    __syncthreads();
}
__constant__ int BUCKET_TH2[16] = {16, 22, 30, 40, 54, 73, 99, 134, 182, 246, 332, 450, 609, 825, 1117, 1513};
DEV void p0_prologue(Frame& F) {
    { LAS float* T_ = (LAS float*)F.lds; f32x4 va[16], vb[16];
      int it = F.vcu;
      if (it < P0_NITEMS) { CvItem ca = cv_decode(F, it); cv_load(ca, va, F.tid);
#pragma unroll 1
          for (;;) {
              const int it2 = it + F.G; CvItem cb = ca; const bool h2 = it2 < P0_NITEMS; if (h2) { cb = cv_decode(F, it2); cv_load(cb, vb, F.tid); }
              cv_store(ca, va, T_, F.tid);
              if (!h2) break;
              const int it3 = it2 + F.G; const bool h3 = it3 < P0_NITEMS; if (h3) { ca = cv_decode(F, it3); cv_load(ca, va, F.tid); }
              cv_store(cb, vb, T_, F.tid);
              if (!h3) break;
              it = it3;
          } } }
    const int gt = F.vcu * 512 + F.tid, NGT = F.G * 512;
    for (int i = gt; i < 16 * 1024; i += NGT) { const int n = i >> 10, k = i & 1023; WSP(bf16_t, W_IN1)[(size_t)(3072 + n) * 1024 + k] = (bf16_t)(cvt_pk(F.in[14][(size_t)k * 3088 + 3072 + n], 0.f) & 0xffffu); }
    { const f32x4* x4 = (const f32x4*)F.in[0]; u32x2* o = WSP(u32x2, W_XB);
      for (size_t i = gt; i < (size_t)T * 1024 / 4; i += (size_t)NGT * 8) { f32x4 v[8];
#pragma unroll
          for (int u = 0; u < 8; ++u) v[u] = x4[i + (size_t)u * NGT];
#pragma unroll
          for (int u = 0; u < 8; ++u) { u32x2 w; w.x = cvt_pk(v[u].x, v[u].y); w.y = cvt_pk(v[u].z, v[u].w); o[i + (size_t)u * NGT] = w; } } }
    for (int i = gt; i < 8 * 2048; i += NGT) { const int h = i >> 11, n = i & 2047; int bk = n;
        if (n >= 16) { bk = 16;
#pragma unroll
            for (int q = 1; q < 16; ++q) bk += (n >= BUCKET_TH2[q]) ? 1 : 0; }
        WSP(float, W_LUT)[i] = F.in[12][bk * 8 + h] * 1.4426950408889634f; }
}

DEV void p_kmean(Frame& F) {
    const int gw = F.vcu * 8 + F.wave, NGW = F.G * 8; const bf16_t* H0 = WSP(bf16_t, W_HB); float* KM = WSP(float, W_KM);
    for (int it = gw; it < 1024; it += NGW) { const int blk = it & 7, h = (it >> 3) & 7, b = it >> 6; const int r8 = F.lane >> 3, c = F.lane & 7;
        const bf16_t* p = H0 + (size_t)(b * 2048 + blk * 256 + r8) * 2048 + 1024 + h * 64 + c * 8; float s[8];
#pragma unroll
        for (int j = 0; j < 8; ++j) s[j] = 0.f;
#pragma unroll 8
        for (int i = 0; i < 32; ++i) { const u32x4 v = *(const u32x4*)(p + (size_t)i * 8 * 2048);
            s[0] += bflo(v.x); s[1] += bfhi(v.x); s[2] += bflo(v.y); s[3] += bfhi(v.y); s[4] += bflo(v.z); s[5] += bfhi(v.z); s[6] += bflo(v.w); s[7] += bfhi(v.w); }
#pragma unroll
        for (int j = 0; j < 8; ++j) { s[j] += __shfl_xor(s[j], 8); s[j] += __shfl_xor(s[j], 16); s[j] += __shfl_xor(s[j], 32); }
        if (F.lane < 8) {
#pragma unroll
            for (int j = 0; j < 8; ++j) KM[(size_t)it * 64 + c * 8 + j] = s[j] * (1.f / 256.f); } }
}

DEV void s5_item(Frame& F, int b, int g, LAS unsigned char* sl  ) {
    const int lane = F.lane, p0 = lane & 31, hi = lane >> 5, q4 = lane >> 4;
    const float* lam_re = F.in[2]; const float* lam_im = F.in[3]; const float* log_dt = F.in[4]; const float* b_re = F.in[5]; const float* b_im = F.in[6];
    const float* c_re = F.in[7]; const float* c_im = F.in[8]; const float* dsk = F.in[9];
    const bf16_t* H0 = WSP(bf16_t, W_HB); bf16_t* YS = WSP(bf16_t, W_YS5);
    const float dt = __expf(log_dt[g]);
    float ar[2], ai[2]; bf16x8 bfr[4];
#pragma unroll
    for (int s = 0; s < 2; ++s) { const int p = p0 + 32 * s; const float lr = lam_re[g * 64 + p], li = lam_im[g * 64 + p]; const float mag = __expf(lr * dt);
        ar[s] = mag * cosf(li * dt); ai[s] = mag * sinf(li * dt);
        const float er = ar[s] - 1.f, ei = ai[s], den = lr * lr + li * li; const float qr = (er * lr + ei * li) / den, qi = (ei * lr - er * li) / den;
        u32x4 wr_, wi_; float vr[8], vi[8];
#pragma unroll
        for (int j = 0; j < 8; ++j) { const float br = b_re[(g * 64 + p) * 16 + 8 * hi + j], bi = b_im[(g * 64 + p) * 16 + 8 * hi + j]; vr[j] = qr * br - qi * bi; vi[j] = qr * bi + qi * br; }
        wr_.x = cvt_pk(vr[0], vr[1]); wr_.y = cvt_pk(vr[2], vr[3]); wr_.z = cvt_pk(vr[4], vr[5]); wr_.w = cvt_pk(vr[6], vr[7]);
        wi_.x = cvt_pk(vi[0], vi[1]); wi_.y = cvt_pk(vi[2], vi[3]); wi_.z = cvt_pk(vi[4], vi[5]); wi_.w = cvt_pk(vi[6], vi[7]);
        bfr[2 * s] = __builtin_bit_cast(bf16x8, wr_); bfr[2 * s + 1] = __builtin_bit_cast(bf16x8, wi_); }
    bf16x8 cfr[4];
#pragma unroll
    for (int ks = 0; ks < 4; ++ks) { float v[8];
#pragma unroll
        for (int j = 0; j < 8; ++j) { const int c = 32 * ks + 8 * q4 + j, p = c >> 1; const int h = lane & 15; v[j] = (c & 1) ? -c_im[(g * 16 + h) * 64 + p] : c_re[(g * 16 + h) * 64 + p]; }
        u32x4 w; w.x = cvt_pk(v[0], v[1]); w.y = cvt_pk(v[2], v[3]); w.z = cvt_pk(v[4], v[5]); w.w = cvt_pk(v[6], v[7]); cfr[ks] = __builtin_bit_cast(bf16x8, w); }
    float dv[4];
#pragma unroll
    for (int r = 0; r < 4; ++r) dv[r] = dsk[g * 16 + 4 * q4 + r];
    const int tm = 16 * ((p0 >> 2) & 1) + 4 * (p0 >> 3) + (p0 & 3);
    const bf16_t* urow = H0 + (size_t)(b * 2048 + tm) * 2048 + g * 16 + 8 * hi;
    float cr[2] = {0.f, 0.f}, ci[2] = {0.f, 0.f};
    bf16x8 ufr = *(const bf16x8*)urow;
    for (int tile = 0; tile < 64; ++tile) {
        const bf16x8 ucur = ufr;
        if (tile + 1 < 64) ufr = *(const bf16x8*)(urow + (size_t)(tile + 1) * 32 * 2048);
        f32x16 x[4];
#pragma unroll
        for (int n = 0; n < 4; ++n) { f32x16 z;
#pragma unroll
            for (int r = 0; r < 16; ++r) z[r] = 0.f;
            x[n] = __builtin_amdgcn_mfma_f32_32x32x16_bf16(ucur, bfr[n], z, 0, 0, 0); }
#pragma unroll
        for (int s = 0; s < 2; ++s) {
            f32x16& xr = x[2 * s]; f32x16& xi = x[2 * s + 1];
            float sr = hi ? 0.f : cr[s], si = hi ? 0.f : ci[s];
#pragma unroll
            for (int r = 0; r < 16; ++r) { const float nr = ar[s] * sr - ai[s] * si + xr[r], ni = ar[s] * si + ai[s] * sr + xi[r]; xr[r] = nr; xi[r] = ni; sr = nr; si = ni; }
            const float o_r = swap32(sr), o_i = swap32(si);
            float wr_ = hi ? o_r : 0.f, wi_ = hi ? o_i : 0.f;
#pragma unroll
            for (int r = 0; r < 16; ++r) { const float nr = ar[s] * wr_ - ai[s] * wi_, ni = ar[s] * wi_ + ai[s] * wr_; wr_ = nr; wi_ = ni; xr[r] += wr_; xi[r] += wi_; }
            const float e_r = swap32(xr[15]), e_i = swap32(xi[15]);
            cr[s] = hi ? xr[15] : e_r; ci[s] = hi ? xi[15] : e_i;
#pragma unroll
            for (int r = 0; r < 16; ++r) *(LAS unsigned*)(sl + (16 * hi + r) * 256 + (p0 + 32 * s) * 4) = cvt_pk(xr[r], xi[r]);
        }
#pragma unroll
        for (int tt = 0; tt < 2; ++tt) {
            f32x4 y = {0.f, 0.f, 0.f, 0.f};
#pragma unroll
            for (int ks = 0; ks < 4; ++ks) { const bf16x8 sf = *(const LAS bf16x8*)(sl + (16 * tt + (lane & 15)) * 256 + ks * 64 + q4 * 16); y = __builtin_amdgcn_mfma_f32_16x16x32_bf16(cfr[ks], sf, y, 0, 0, 0); }
            const int t = tile * 32 + 16 * tt + (lane & 15);
            const u32x2 uw = *(const u32x2*)(H0 + (size_t)(b * 2048 + t) * 2048 + g * 16 + 4 * q4);
            const float y0 = gelu_tanh(y[0] + dv[0] * bflo(uw.x)), y1 = gelu_tanh(y[1] + dv[1] * bfhi(uw.x)), y2 = gelu_tanh(y[2] + dv[2] * bflo(uw.y)), y3 = gelu_tanh(y[3] + dv[3] * bfhi(uw.y));
            u32x2 ow; ow.x = cvt_pk(y0, y1); ow.y = cvt_pk(y2, y3);
            *(u32x2*)(YS + (size_t)(b * 2048 + t) * 512 + g * 16 + 4 * q4) = ow;
        }
    }
}

constexpr int AT_K = 0, AT_V = 24576, AT_WS = 49152, AT_OST = 51200, AT_LUT = AT_OST + 8 * 4096  , AT_LUTB = 8704, AT_Q = AT_LUT + 8 * AT_LUTB  , AT_END = AT_Q + 64;
DEV int crow(int r, int hi) { return (r & 3) + 8 * (r >> 2) + 4 * hi; }
DEV s16x4 vtr(const LAS unsigned char* p) { typedef short v4i16_t __attribute__((ext_vector_type(4))); return __builtin_bit_cast(s16x4, __builtin_amdgcn_ds_read_tr16_b64_v4i16((LAS v4i16_t*)p)); }
DEV void moba_unit(Frame& F, int b, int h, int own) {
    const int lane = F.lane, wid = F.wave, r32 = lane & 31, hi = lane >> 5;
    LAS unsigned char* lds = F.lds;
    const bf16_t* H0 = WSP(bf16_t, W_HB); const float* KM = WSP(float, W_KM);
    LAS float* lut = (LAS float*)(lds + AT_LUT + h * AT_LUTB); LAS float* wsf = (LAS float*)(lds + AT_WS) + wid * 64;
    const size_t rowbase = (size_t)b * 2048;
    const int qpos = own * 256 + wid * 32 + r32;
    bf16x8 qr[4];
#pragma unroll
    for (int d0 = 0; d0 < 4; ++d0) qr[d0] = *(const bf16x8*)(H0 + (rowbase + qpos) * 2048 + 512 + h * 64 + d0 * 16 + hi * 8);
    unsigned selmask = 0u;
    if (own > 0) {
        float gate[7];
#pragma unroll
        for (int j = 0; j < 7; ++j) { float s = 0.f;
            if (j < own) { const float* km = KM + ((size_t)(b * 8 + h) * 8 + j) * 64 + hi * 8;
#pragma unroll
                for (int d0 = 0; d0 < 4; ++d0) { const f32x4 k0 = *(const f32x4*)(km + d0 * 16), k1 = *(const f32x4*)(km + d0 * 16 + 4); const u32x4 qw = __builtin_bit_cast(u32x4, qr[d0]);
                    s += bflo(qw.x) * k0.x + bfhi(qw.x) * k0.y + bflo(qw.y) * k0.z + bfhi(qw.y) * k0.w + bflo(qw.z) * k1.x + bfhi(qw.z) * k1.y + bflo(qw.w) * k1.z + bfhi(qw.w) * k1.w; } }
            gate[j] = s + swap32(s); }
#pragma unroll
        for (int j = 0; j < 7; ++j) { int rank = 0;
#pragma unroll
            for (int j2 = 0; j2 < 7; ++j2) if (j2 != j && j2 < own && (gate[j2] > gate[j] || (gate[j2] == gate[j] && j2 < j))) ++rank;
            if (j < own && rank < 3) selmask |= 1u << j; }
    }
    const int NT = 4 * (own + 1);
#define KV0(i) ((i) < 4 ? own * 256 + (i) * 64 : (((i) - 4) >> 2) * 256 + (((i) - 4) & 3) * 64)
    const bf16_t* kbase = H0 + (rowbase + lane) * 2048 + 1024 + h * 64 + wid * 8;
    const bf16_t* vbase = H0 + (rowbase + 16 * (wid & 3) + (lane >> 2)) * 2048 + 1536 + h * 64 + (wid >> 2) * 32 + (lane & 3) * 8;
#define LOADKV(i, bo_) do { const int kv0_ = KV0(i); \
        __builtin_amdgcn_global_load_lds((const unsigned*)(kbase + (size_t)kv0_ * 2048), (LAS unsigned*)(lds + AT_K + bo_ + wid * 1024), 16, 0, 0); \
        __builtin_amdgcn_global_load_lds((const unsigned*)(vbase + (size_t)kv0_ * 2048), (LAS unsigned*)(lds + AT_V + bo_ + wid * 1024), 16, 0, 0); } while (0)
    LOADKV(0, 0); LOADKV(1, 8192);
    int bo = 0, bo2 = 16384;
    float m_ref = 0.f, l_run = 0.f; f32x16 o[2];
#pragma unroll
    for (int r = 0; r < 16; ++r) { o[0][r] = 0.f; o[1][r] = 0.f; }
    const int Q0 = own * 256 + wid * 32;
#pragma unroll 1
    for (int i = 0; i < NT; ++i) {
        if (i + 1 < NT) asm volatile("s_waitcnt vmcnt(2) lgkmcnt(0)\n\ts_barrier" ::: "memory"); else asm volatile("s_waitcnt vmcnt(0) lgkmcnt(0)\n\ts_barrier" ::: "memory");
        if (i + 2 < NT) LOADKV(i + 2, bo2);
        const int kv0 = KV0(i);
        const bool ownblk = i < 4;
        if (!(ownblk && kv0 > Q0 + 31)) {
            const bool partial = ownblk && (kv0 + 63 > Q0);
            const bool rowsel = ownblk || ((selmask >> ((i - 4) >> 2)) & 1u);
            f32x16 p0, p1;
            { const LAS float* lp = lut + 128 + (qpos - kv0 - 4 * hi - 59);
#pragma unroll
              for (int r = 0; r < 16; ++r) { const int c = (r & 3) + 8 * (r >> 2); p0[r] = lp[59 - c] - m_ref; p1[r] = lp[59 - c - 32] - m_ref; } }
            { const LAS unsigned char* kb = lds + AT_K + bo + hi * 1024 + r32 * 16;
#pragma unroll
              for (int d0 = 0; d0 < 4; ++d0) { const bf16x8 k0 = *(const LAS bf16x8*)(kb + d0 * 2048), k1 = *(const LAS bf16x8*)(kb + d0 * 2048 + 512);
                  p0 = __builtin_amdgcn_mfma_f32_32x32x16_bf16(k0, qr[d0], p0, 0, 0, 0); p1 = __builtin_amdgcn_mfma_f32_32x32x16_bf16(k1, qr[d0], p1, 0, 0, 0); } }
            if (partial) { const int dbase = qpos - kv0 - 4 * hi;
#pragma unroll
                for (int r = 0; r < 16; ++r) { const int d0_ = dbase - ((r & 3) + 8 * (r >> 2)); p0[r] = d0_ >= 0 ? p0[r] : -INFINITY; p1[r] = d0_ >= 32 ? p1[r] : -INFINITY; } }
            float rmax = fmaxf(p0[0], p1[0]);
#pragma unroll
            for (int r = 1; r < 16; ++r) rmax = fmaxf(rmax, fmaxf(p0[r], p1[r]));
            rmax = fmaxf(rmax, swap32(rmax));
            rmax = rowsel ? rmax : -INFINITY;
            if (i == 0 || __any(rmax > 8.f)) {
                const float dl = (i == 0) ? rmax : fmaxf(rmax, 0.f); m_ref += dl;
#pragma unroll
                for (int r = 0; r < 16; ++r) { p0[r] -= dl; p1[r] -= dl; }
                const float alpha = __builtin_amdgcn_exp2f(-dl); l_run *= alpha;
                if (hi == 0) wsf[r32] = alpha;
#pragma unroll
                for (int r = 0; r < 16; ++r) { const float f = wsf[crow(r, hi)]; o[0][r] *= f; o[1][r] *= f; }
            }
            float rs = 0.f;
#pragma unroll
            for (int r = 0; r < 16; ++r) { p0[r] = __builtin_amdgcn_exp2f(p0[r]); p1[r] = __builtin_amdgcn_exp2f(p1[r]); rs += p0[r] + p1[r]; }
            l_run += rowsel ? rs : 0.f;
            const unsigned km = rowsel ? 0xffffffffu : 0u;
            u32x4 pw[4];
            pw[0] = (u32x4){cvt_pk(p0[0], p0[1]) & km, cvt_pk(p0[2], p0[3]) & km, cvt_pk(p0[4], p0[5]) & km, cvt_pk(p0[6], p0[7]) & km};
            pw[1] = (u32x4){cvt_pk(p0[8], p0[9]) & km, cvt_pk(p0[10], p0[11]) & km, cvt_pk(p0[12], p0[13]) & km, cvt_pk(p0[14], p0[15]) & km};
            pw[2] = (u32x4){cvt_pk(p1[0], p1[1]) & km, cvt_pk(p1[2], p1[3]) & km, cvt_pk(p1[4], p1[5]) & km, cvt_pk(p1[6], p1[7]) & km};
            pw[3] = (u32x4){cvt_pk(p1[8], p1[9]) & km, cvt_pk(p1[10], p1[11]) & km, cvt_pk(p1[12], p1[13]) & km, cvt_pk(p1[14], p1[15]) & km};
            { const LAS unsigned char* vp = lds + AT_V + bo + ((lane >> 4) & 1) * 32 + (lane & 3) * 8 + (4 * hi + ((lane & 15) >> 2)) * 64;
#pragma unroll
              for (int d0 = 0; d0 < 2; ++d0)
#pragma unroll
                  for (int ks = 0; ks < 4; ++ks) { const s16x4 lo = vtr(vp + d0 * 4096 + ks * 1024), hh = vtr(vp + d0 * 4096 + ks * 1024 + 512);
                      const bf16x8 vf = (bf16x8){lo[0], lo[1], lo[2], lo[3], hh[0], hh[1], hh[2], hh[3]};
                      o[d0] = __builtin_amdgcn_mfma_f32_32x32x16_bf16(__builtin_bit_cast(bf16x8, pw[ks]), vf, o[d0], 0, 0, 0); } }
        }
        bo = (bo == 16384) ? 0 : bo + 8192; bo2 = (bo2 == 16384) ? 0 : bo2 + 8192;
    }
    __syncthreads();
#undef KV0
#undef LOADKV
    l_run += swap32(l_run);
    if (hi == 0) wsf[32 + r32] = 1.f / l_run;
    bf16_t* Ow = WSP(bf16_t, W_Y0) + (rowbase + own * 256 + wid * 32) * 1024 + 512 + h * 64;
    LAS bf16_t* stg = (LAS bf16_t*)(lds + AT_OST) + wid * 2048;
#pragma unroll
    for (int r = 0; r < 16; ++r) { const int orow = crow(r, hi); const float rl = wsf[32 + orow];
        stg[orow * 64 + r32] = (bf16_t)(cvt_pk(o[0][r] * rl, 0.f) & 0xffffu); stg[orow * 64 + 32 + r32] = (bf16_t)(cvt_pk(o[1][r] * rl, 0.f) & 0xffffu); }
#pragma unroll
    for (int i = 0; i < 4; ++i) { const int row = i * 8 + (lane >> 3), ch = lane & 7; const u32x4 v = *(const LAS u32x4*)(stg + row * 64 + ch * 8); *(u32x4*)(Ow + (size_t)row * 1024 + ch * 8) = v; }
    __syncthreads();
}
constexpr int CW_MOBAQ = 64;
DEV void p_s5_moba(Frame& F, int mode) {
    if ((mode & 1) && (F.vcu & 3) == 3) { const int it = (F.vcu >> 2) * 8 + F.wave; if (it < 512) s5_item(F, it >> 5, it & 31, F.lds + 65536 + F.wave * 8192); }
    __syncthreads();
    if (!(mode & 2)) return;
    for (int i = F.tid; i < 8 * 2176; i += 512) { const int hh = i / 2176, j = i % 2176; ((LAS float*)(F.lds + AT_LUT))[i] = j < 128 ? 0.f : WSP(float, W_LUT)[hh * 2048 + j - 128]; }
    volatile LAS int* qw = (volatile LAS int*)(F.lds + AT_Q);
    unsigned* ctl = (unsigned*)(F.ws + W_CTL);
    for (;;) {
        __syncthreads();
        if (F.tid == 0) qw[0] = (int)__hip_atomic_fetch_add(ctl + CW_MOBAQ, 1u, __ATOMIC_RELAXED, __HIP_MEMORY_SCOPE_AGENT);
        __syncthreads();
        const int u = __builtin_amdgcn_readfirstlane(qw[0]);
        if (u >= 1024) break;
        const int own = 7 - (u >> 7), bh = u & 127;
        moba_unit(F, bh >> 3, bh & 7, own);
    }
}
constexpr size_t R_RE = W_ROUTE, R_RW = W_ROUTE + 512 * 1024, R_POS = W_ROUTE + 1024 * 1024, R_TOK = W_ROUTE + 2 * MiB, R_WGT = W_ROUTE + 3 * MiB;
constexpr int WT_PITCH = 1028;
constexpr int RW_PITCH = 1032;
constexpr int LN_XT = 32 * RW_PITCH * 2;
constexpr int LN_LG = 147456;
constexpr int LN_HIST = LN_LG + 8 * 528;
static_assert(LN_XT + 8 * 8256 <= LDS_TOK && LN_HIST + 128 <= LDSCTL_OFF, "LN LDS map");
template <int MODE, bool ROUTER, bool XIN_F32, bool OUT_F32, bool GRP = false>
DEV void p_ln(Frame& F, const float* xin32, const bf16_t* xinb, bf16_t* xoutb, float* xout32, const float* gam, const float* bet, const float* wrt, const float* brt) {
    LAS bf16_t* whi = (LAS bf16_t*)F.lds; LAS bf16_t* xt = (LAS bf16_t*)(F.lds + LN_XT) + F.wave * 4128; LAS float* lgs = (LAS float*)(F.lds + LN_LG) + F.wave * 132; LAS int* hist = (LAS int*)(F.lds + LN_HIST);
    const int lane = F.lane, l15 = lane & 15, q4 = lane >> 4;
    if constexpr (ROUTER) {
        for (int i = F.tid; i < 1024 * 32; i += 512) { const int k = i >> 5, e = i & 31; whi[e * RW_PITCH + k] = (bf16_t)(cvt_pk(wrt[i], 0.f) & 0xffffu); }
        if (F.tid < 32) hist[F.tid] = 0;
        __syncthreads();
    }
    if constexpr (GRP) {
        const u32x4* src = (const u32x4*)(WSP(bf16_t, W_IN1) + (size_t)3072 * 1024);
        for (int i = F.tid; i < 16 * 128; i += 512) { const int e = i >> 7, c = i & 127; *(LAS u32x4*)(whi + e * RW_PITCH + c * 8) = src[i]; }
        __syncthreads();
    }
    const bf16_t* MIXB = WSP(bf16_t, W_MIXB); const unsigned char* YS8 = WSP(unsigned char, W_YS); const int* POS = WSP(int, R_POS);
    int* RE = WSP(int, R_RE); float* RW = WSP(float, R_RW);
    const float alpha = 1.4142135623730951f;
    f32x4 gq[4], bq[4];
#pragma unroll
    for (int j = 0; j < 4; ++j) { gq[j] = *(const f32x4*)(gam + j * 256 + lane * 4); bq[j] = *(const f32x4*)(bet + j * 256 + lane * 4); }
    float bias8[8];
    if constexpr (ROUTER) {
#pragma unroll
        for (int r = 0; r < 8; ++r) bias8[r] = brt[(r >> 2) * 16 + 4 * q4 + (r & 3)]; }
    for (int wgi = F.vcu; wgi < 256; wgi += F.G) {
        const int r0 = wgi * 128 + F.wave * 16;
        constexpr bool PF = (MODE == 0) && !XIN_F32;
        u32x2 rx[4][4], rm[4][4];
        if constexpr (PF) {
#pragma unroll
            for (int u = 0; u < 4; ++u)
#pragma unroll
                for (int j = 0; j < 4; ++j) { rx[u][j] = *(const u32x2*)(xinb + (size_t)(r0 + u) * 1024 + j * 256 + lane * 4); rm[u][j] = *(const u32x2*)(MIXB + (size_t)(r0 + u) * 1024 + j * 256 + lane * 4); } }
#pragma unroll 1
        for (int i4 = 0; i4 < 16; i4 += 4) {
            float v[4][16];
            if constexpr (PF) {
#pragma unroll
                for (int u = 0; u < 4; ++u)
#pragma unroll
                    for (int j = 0; j < 4; ++j) { v[u][4 * j] = alpha * bflo(rx[u][j].x) + bflo(rm[u][j].x); v[u][4 * j + 1] = alpha * bfhi(rx[u][j].x) + bfhi(rm[u][j].x); v[u][4 * j + 2] = alpha * bflo(rx[u][j].y) + bflo(rm[u][j].y); v[u][4 * j + 3] = alpha * bfhi(rx[u][j].y) + bfhi(rm[u][j].y); }
                if (i4 + 4 < 16) {
#pragma unroll
                    for (int u = 0; u < 4; ++u)
#pragma unroll
                        for (int j = 0; j < 4; ++j) { rx[u][j] = *(const u32x2*)(xinb + (size_t)(r0 + i4 + 4 + u) * 1024 + j * 256 + lane * 4); rm[u][j] = *(const u32x2*)(MIXB + (size_t)(r0 + i4 + 4 + u) * 1024 + j * 256 + lane * 4); } }
            } else {
#pragma unroll
            for (int u = 0; u < 4; ++u) { const int row = r0 + i4 + u;
                if constexpr (XIN_F32) {
#pragma unroll
                    for (int j = 0; j < 4; ++j) { const f32x4 a = *(const f32x4*)(xin32 + (size_t)row * 1024 + j * 256 + lane * 4); v[u][4 * j] = alpha * a.x; v[u][4 * j + 1] = alpha * a.y; v[u][4 * j + 2] = alpha * a.z; v[u][4 * j + 3] = alpha * a.w; }
                } else {
#pragma unroll
                    for (int j = 0; j < 4; ++j) { const u32x2 a = *(const u32x2*)(xinb + (size_t)row * 1024 + j * 256 + lane * 4); v[u][4 * j] = alpha * bflo(a.x); v[u][4 * j + 1] = alpha * bfhi(a.x); v[u][4 * j + 2] = alpha * bflo(a.y); v[u][4 * j + 3] = alpha * bfhi(a.y); }
                }
                if constexpr (MODE == 0) {
#pragma unroll
                    for (int j = 0; j < 4; ++j) { const u32x2 m = *(const u32x2*)(MIXB + (size_t)row * 1024 + j * 256 + lane * 4); v[u][4 * j] += bflo(m.x); v[u][4 * j + 1] += bfhi(m.x); v[u][4 * j + 2] += bflo(m.y); v[u][4 * j + 3] += bfhi(m.y); }
                } else {
                    const int4 pos4 = *(const int4*)(POS + row * 4);
                    const int ps[4] = {__builtin_amdgcn_readfirstlane(pos4.x), __builtin_amdgcn_readfirstlane(pos4.y), __builtin_amdgcn_readfirstlane(pos4.z), __builtin_amdgcn_readfirstlane(pos4.w)};
#pragma unroll
                    for (int kx = 0; kx < 4; ++kx)
#pragma unroll
                        for (int j = 0; j < 4; ++j) { const unsigned m = *(const unsigned*)(YS8 + (size_t)ps[kx] * 1024 + j * 256 + lane * 4); const f32x2 lo2 = __builtin_amdgcn_cvt_pk_f32_fp8(m, false), hi2 = __builtin_amdgcn_cvt_pk_f32_fp8(m, true);
                            v[u][4 * j] += lo2.x * (1.f / 64.f); v[u][4 * j + 1] += lo2.y * (1.f / 64.f); v[u][4 * j + 2] += hi2.x * (1.f / 64.f); v[u][4 * j + 3] += hi2.y * (1.f / 64.f); }
                }
            }
            }
            float s1[4], s2[4];
#pragma unroll
            for (int u = 0; u < 4; ++u) { s1[u] = 0.f; s2[u] = 0.f;
#pragma unroll
                for (int q = 0; q < 16; ++q) { s1[u] += v[u][q]; s2[u] = fmaf(v[u][q], v[u][q], s2[u]); } }
#pragma unroll
            for (int o = 1; o < 64; o <<= 1) {
#pragma unroll
                for (int u = 0; u < 4; ++u) { s1[u] += __shfl_xor(s1[u], o); s2[u] += __shfl_xor(s2[u], o); } }
#pragma unroll
            for (int u = 0; u < 4; ++u) { const int row = r0 + i4 + u; const float mean = s1[u] * (1.f / 1024.f); const float var = fmaxf(s2[u] * (1.f / 1024.f) - mean * mean, 0.f); const float rstd = 1.f / sqrtf(var + 1e-5f);
#pragma unroll
                for (int j = 0; j < 4; ++j) { const int c = j * 256 + lane * 4; const f32x4 g4 = gq[j], b4 = bq[j];
                    const float y0 = (v[u][4 * j] - mean) * rstd * g4.x + b4.x, y1 = (v[u][4 * j + 1] - mean) * rstd * g4.y + b4.y, y2 = (v[u][4 * j + 2] - mean) * rstd * g4.z + b4.z, y3 = (v[u][4 * j + 3] - mean) * rstd * g4.w + b4.w;
                    if constexpr (OUT_F32) *(f32x4*)(xout32 + (size_t)row * 1024 + c) = (f32x4){y0, y1, y2, y3};
                    else { u32x2 w; w.x = cvt_pk(y0, y1); w.y = cvt_pk(y2, y3); *(u32x2*)(xoutb + (size_t)row * 1024 + c) = w;
                        if constexpr (ROUTER || GRP) { *(LAS u32x2*)(xt + u * RW_PITCH + c) = w; } } } }
            if constexpr (GRP) {
                f32x4 ga = {0.f, 0.f, 0.f, 0.f};
#pragma unroll 8
                for (int ks = 0; ks < 32; ++ks) { const bf16x8 xb = *(const LAS bf16x8*)(xt + (l15 & 3) * RW_PITCH + ks * 32 + q4 * 8), wa = *(const LAS bf16x8*)(whi + l15 * RW_PITCH + ks * 32 + q4 * 8);
                    ga = __builtin_amdgcn_mfma_f32_16x16x32_bf16(wa, xb, ga, 0, 0, 0); }
                if (l15 < 4) *(f32x4*)(WSP(float, W_GR) + (size_t)(r0 + i4 + l15) * 16 + 4 * q4) = ga; }
            if constexpr (ROUTER) {
                f32x4 acc[2] = {{0.f, 0.f, 0.f, 0.f}, {0.f, 0.f, 0.f, 0.f}};
#pragma unroll 8
                for (int ks = 0; ks < 32; ++ks) { const bf16x8 xb = *(const LAS bf16x8*)(xt + (l15 & 3) * RW_PITCH + ks * 32 + q4 * 8);
#pragma unroll
                    for (int mt = 0; mt < 2; ++mt) { const bf16x8 wa = *(const LAS bf16x8*)(whi + (mt * 16 + l15) * RW_PITCH + ks * 32 + q4 * 8); acc[mt] = __builtin_amdgcn_mfma_f32_16x16x32_bf16(wa, xb, acc[mt], 0, 0, 0); } }
                if (l15 < 4) {
#pragma unroll
                    for (int mt = 0; mt < 2; ++mt)
#pragma unroll
                        for (int r = 0; r < 4; ++r) lgs[l15 * 33 + mt * 16 + 4 * q4 + r] = acc[mt][r] + bias8[mt * 4 + r]; }
                if (lane < 4) { float lg[32];
#pragma unroll
                    for (int e = 0; e < 32; ++e) lg[e] = lgs[lane * 33 + e];
                    unsigned taken = 0u; float tv[4]; int ti[4];
#pragma unroll
                    for (int r = 0; r < 4; ++r) { float best = -INFINITY; int bi = 0;
#pragma unroll
                        for (int e = 0; e < 32; ++e) { const bool ok = !((taken >> e) & 1u) && lg[e] > best; best = ok ? lg[e] : best; bi = ok ? e : bi; }
                        taken |= 1u << bi; tv[r] = best; ti[r] = bi; }
                    float ex[4], sm = 0.f;
#pragma unroll
                    for (int r = 0; r < 4; ++r) { ex[r] = __expf(tv[r] - tv[0]); sm += ex[r]; }
                    const float inv = 1.f / sm; const int row = r0 + i4 + lane;
                    *(int4*)(RE + row * 4) = make_int4(ti[0], ti[1], ti[2], ti[3]); *(f32x4*)(RW + row * 4) = (f32x4){ex[0] * inv, ex[1] * inv, ex[2] * inv, ex[3] * inv};
#pragma unroll
                    for (int r = 0; r < 4; ++r) atomicAdd((int*)(hist + ti[r]), 1); }
            }
        }
        if constexpr (ROUTER) { __syncthreads(); if (F.tid < 32) { WSP(int, W_HIST)[wgi * 32 + F.tid] = hist[F.tid]; hist[F.tid] = 0; } __syncthreads(); }
    }
}

DEV void p_sort(Frame& F) {
    LAS int* Ls = (LAS int*)F.lds; const int tid = F.tid;
    const int* HIST = WSP(int, W_HIST); int* SORT = WSP(int, W_SORT);
    const int* RE = WSP(int, R_RE); const float* RW = WSP(float, R_RW); int* POS = WSP(int, R_POS); int* TOK = WSP(int, R_TOK); float* WGT = WSP(float, R_WGT);
    for (int wgi = F.vcu; wgi < 256; wgi += F.G) {
        { const int e = tid & 31, part = tid >> 5; int tot = 0, pre = 0;
          for (int w = part * 16; w < part * 16 + 16; ++w) { const int hh = HIST[w * 32 + e]; tot += hh; pre += (w < wgi) ? hh : 0; }
          Ls[part * 32 + e] = tot; Ls[512 + part * 32 + e] = pre; }
        Ls[2048 + tid] = RE[wgi * 512 + tid];
        __syncthreads();
        if (tid < 32) { int tot = 0, pre = 0; for (int p = 0; p < 16; ++p) { tot += Ls[p * 32 + tid]; pre += Ls[512 + p * 32 + tid]; } Ls[1200 + tid] = tot; Ls[1300 + tid] = pre; }
        __syncthreads();
        if (tid == 0) { int a = 0; for (int e = 0; e < 32; ++e) { Ls[1024 + e] = a; a += (Ls[1200 + e] + 255) / 256 * 256; } Ls[1056] = a; }
        __syncthreads();
        { const int e = tid & 31, seg = tid >> 5; int cnt = 0;
#pragma unroll 8
          for (int i = 0; i < 32; ++i) cnt += (Ls[2048 + seg * 32 + i] == e) ? 1 : 0;
          Ls[3072 + seg * 32 + e] = cnt;
          __syncthreads();
          int c = Ls[1024 + e] + Ls[1300 + e];
          for (int s2 = 0; s2 < seg; ++s2) c += Ls[3072 + s2 * 32 + e];
#pragma unroll 8
          for (int i = 0; i < 32; ++i) if (Ls[2048 + seg * 32 + i] == e) { Ls[2560 + seg * 32 + i] = c; ++c; } }
        __syncthreads();
        { const int pos = Ls[2560 + tid]; TOK[pos] = wgi * 128 + (tid >> 2); WGT[pos] = RW[wgi * 512 + tid]; POS[wgi * 512 + tid] = pos; }
        { const bf16_t* XBBp = WSP(bf16_t, W_XBB); unsigned char* XS8 = WSP(unsigned char, W_X8);
          for (int rg = 0; rg < 16; rg += 4) {
              u32x4 a[4], b2[4];
#pragma unroll
              for (int u = 0; u < 4; ++u) { const int r = F.wave * 16 + rg + u; const u32x4* src = (const u32x4*)(XBBp + (size_t)(wgi * 128 + r) * 1024 + F.lane * 16); a[u] = src[0]; b2[u] = src[1]; }
#pragma unroll
              for (int u = 0; u < 4; ++u) { const int r = F.wave * 16 + rg + u;
                  u32x4 o; o.x = pk4_fp8(bflo(a[u].x) * 16.f, bfhi(a[u].x) * 16.f, bflo(a[u].y) * 16.f, bfhi(a[u].y) * 16.f); o.y = pk4_fp8(bflo(a[u].z) * 16.f, bfhi(a[u].z) * 16.f, bflo(a[u].w) * 16.f, bfhi(a[u].w) * 16.f);
                  o.z = pk4_fp8(bflo(b2[u].x) * 16.f, bfhi(b2[u].x) * 16.f, bflo(b2[u].y) * 16.f, bfhi(b2[u].y) * 16.f); o.w = pk4_fp8(bflo(b2[u].z) * 16.f, bfhi(b2[u].z) * 16.f, bflo(b2[u].w) * 16.f, bfhi(b2[u].w) * 16.f);
#pragma unroll
                  for (int kx = 0; kx < 4; ++kx) { const int pos = Ls[2560 + r * 4 + kx]; *(u32x4*)(XS8 + (size_t)pos * 1024 + F.lane * 16) = o; } } }
          if (wgi < 32) { const int e = wgi; for (int r = Ls[1024 + e] + Ls[1200 + e] + F.wave; r < Ls[1024 + e + 1]; r += 8) *(u32x4*)(XS8 + (size_t)r * 1024 + F.lane * 16) = (u32x4){0u, 0u, 0u, 0u}; } }
        if (wgi < 32) { const int e = wgi; for (int r = Ls[1024 + e] + Ls[1200 + e] + tid; r < Ls[1024 + e + 1]; r += 512) { TOK[r] = 0; WGT[r] = 0.f; } }
        if (wgi == 0) { if (tid < 33) SORT[tid] = Ls[1024 + tid]; if (tid == 0) SORT[33] = Ls[1056] / 256;
            for (int pm = tid; pm < PMAX / 256; pm += 512) { int e = 0; for (int j = 1; j < 32; ++j) if (pm * 256 >= Ls[1024 + j]) e = j; SORT[64 + pm] = e; } }
        __syncthreads();
    }
}

DEV void p_gr(Frame& F) {
    const int gw = F.vcu * 8 + F.wave, NGW = F.G * 8, lane = F.lane, q4 = lane >> 4; const bf16_t* XB = WSP(bf16_t, W_XB); const bf16_t* Wg = WSP(bf16_t, W_IN1) + (size_t)3072 * 1024; float* GR = WSP(float, W_GR);
    for (int it = gw; it < T / 16; it += NGW) { f32x4 acc = {0.f, 0.f, 0.f, 0.f};
        const bf16_t* ap = XB + (size_t)(it * 16 + (lane & 15)) * 1024 + q4 * 8; const bf16_t* bp = Wg + (size_t)(lane & 15) * 1024 + q4 * 8;
        bf16x8 a[32], bb[32];
#pragma unroll
        for (int ks = 0; ks < 32; ++ks) { a[ks] = *(const bf16x8*)(ap + ks * 32); bb[ks] = *(const bf16x8*)(bp + ks * 32); }
#pragma unroll
        for (int ks = 0; ks < 32; ++ks) acc = __builtin_amdgcn_mfma_f32_16x16x32_bf16(a[ks], bb[ks], acc, 0, 0, 0);
#pragma unroll
        for (int r = 0; r < 4; ++r) GR[(size_t)(it * 16 + 4 * q4 + r) * 16 + (lane & 15)] = acc[r]; }
}

constexpr int GP = 264, GP2 = 144;
constexpr int GB_QIN = 0, GB_KST = 16896, GB_ATT = 35328, GB_DEC = 44544, GB_VT = 45056, GB_SIZE = 81920;
constexpr size_t W_GB = W_YS;
static_assert((size_t)2048 * GB_SIZE <= (size_t)PMAX * 2048, "blob region");
constexpr int GA_GRS = 0, GA_GT = 4096, GA_BL = 8192  , GA_QIN = GA_BL + GB_QIN, GA_KST = GA_BL + GB_KST, GA_ATT = GA_BL + GB_ATT, GA_DEC = GA_BL + GB_DEC, GA_KIN = GA_BL + 45056  , GA_VT = GA_KIN + 17408, GA_END = GA_VT + 36864;
DEV float logsigm_fast(float z) { const float e = __builtin_amdgcn_exp2f(-1.4426950408889634f * fabsf(z)); return fminf(z, 0.f) - 0.6931471805599453f * __builtin_amdgcn_logf(1.f + e); }
struct GlaRaw { unsigned q[16], k[16], v[32]; f32x4 ga, gb; };
DEV void p_gla_prep(Frame& F) {
    LAS unsigned char* lds = F.lds; const int tid = F.tid, lane = F.lane, wid = F.wave, q4 = lane >> 4, l15 = lane & 15;
    const bf16_t* H1 = WSP(bf16_t, W_HB); const float* GR = WSP(float, W_GR); unsigned char* GB = F.ws + W_GB;
    const float* wg2 = F.in[15]; const float* bg = F.in[16];
    for (int i = tid; i < 64 * GP2 / 4; i += 512) ((LAS unsigned*)(lds + GA_ATT))[i] = 0u;
    const int dk = 32 * (wid & 3) + (lane & 31), tg = 2 * (wid >> 2) + (lane >> 5);
    const int dvl = tid & 255, th2 = tid >> 8;
    const int tzm = 16 * (((lane & 31) >> 2) & 1) + 4 * ((lane & 31) >> 3) + (lane & 3);
    for (int wg = F.vcu; wg < 256; wg += F.G) {
        const int b = wg >> 4, h = (wg >> 2) & 3, n0 = (wg & 3) * 8;
        bf16x8 w2f; { float wv[8];
#pragma unroll
          for (int j = 0; j < 8; ++j) wv[j] = wg2[(8 * (lane >> 5) + j) * 512 + h * 128 + dk];
          const u32x4 ww = {cvt_pk(wv[0], wv[1]), cvt_pk(wv[2], wv[3]), cvt_pk(wv[4], wv[5]), cvt_pk(wv[6], wv[7])}; w2f = __builtin_bit_cast(bf16x8, ww); }
        const float bgv = bg[h * 128 + dk];
#define GLA_LOAD(R, n_) do { const size_t rb_ = (size_t)b * 2048 + (n_) * 64; \
        _Pragma("unroll") for (int i = 0; i < 16; ++i) { const size_t ro = (rb_ + 16 * tg + i) * 3072; R.q[i] = H1[ro + h * 128 + dk]; R.k[i] = H1[ro + 512 + h * 128 + dk]; } \
        _Pragma("unroll") for (int i = 0; i < 32; ++i) R.v[i] = H1[(rb_ + 32 * th2 + i) * 3072 + 1024 + h * 256 + dvl]; \
        { const float* gp_ = GR + (rb_ + 32 * (wid >> 2) + tzm) * 16 + 8 * (lane >> 5); R.ga = *(const f32x4*)gp_; R.gb = *(const f32x4*)(gp_ + 4); } } while (0)
        GlaRaw cur, nxt; GLA_LOAD(cur, n0); nxt = cur;
#pragma unroll 1
      for (int sub = 0; sub < 8; ++sub) { const int n = n0 + sub;
        if (sub + 1 < 8) GLA_LOAD(nxt, n + 1);
        float cs[16]; float run = 0.f;
        { const u32x4 aw = {cvt_pk(cur.ga.x, cur.ga.y), cvt_pk(cur.ga.z, cur.ga.w), cvt_pk(cur.gb.x, cur.gb.y), cvt_pk(cur.gb.z, cur.gb.w)};
          f32x16 zz;
#pragma unroll
          for (int r = 0; r < 16; ++r) zz[r] = bgv;
          zz = __builtin_amdgcn_mfma_f32_32x32x16_bf16(__builtin_bit_cast(bf16x8, aw), w2f, zz, 0, 0, 0);
#pragma unroll
          for (int i = 0; i < 16; ++i) { run += logsigm_fast(zz[i]) * (1.f / 16.f); cs[i] = run; } }
        ((LAS float*)(lds + GA_GT))[tg * 128 + dk] = run;
        __syncthreads();
        float off = 0.f, btot = 0.f;
#pragma unroll
        for (int g2 = 0; g2 < 4; ++g2) { const float gtv = ((LAS float*)(lds + GA_GT))[g2 * 128 + dk]; btot += gtv; off += (g2 < tg) ? gtv : 0.f; }
        if (tg == 0) ((LAS float*)(lds + GA_DEC))[dk] = __expf(btot);
        { unsigned kst[8];
#pragma unroll
          for (int i = 0; i < 16; i += 2) { float kk[2];
#pragma unroll
              for (int u = 0; u < 2; ++u) { const int t = 16 * tg + i + u; const float bc = cs[i + u] + off; const float qv = bflo(cur.q[i + u]), kv = bflo(cur.k[i + u]);
                  *(LAS bf16_t*)(lds + GA_QIN + t * GP + dk * 2) = (bf16_t)(cvt_pk(qv * __expf(bc), 0.f) & 0xffffu);
                  *(LAS bf16_t*)(lds + GA_KIN + t * 272 + dk * 2) = (bf16_t)(cvt_pk(kv * __expf(-bc), 0.f) & 0xffffu);
                  kk[u] = kv * __expf(btot - bc); }
              kst[i >> 1] = cvt_pk(kk[0], kk[1]); }
          *(LAS u32x4*)(lds + GA_KST + dk * GP2 + tg * 32) = (u32x4){kst[0], kst[1], kst[2], kst[3]};
          *(LAS u32x4*)(lds + GA_KST + dk * GP2 + tg * 32 + 16) = (u32x4){kst[4], kst[5], kst[6], kst[7]}; }
#pragma unroll
        for (int i = 0; i < 32; i += 8) *(LAS u32x4*)(lds + GA_VT + dvl * GP2 + (32 * th2 + i) * 2) = (u32x4){cur.v[i] | (cur.v[i + 1] << 16), cur.v[i + 2] | (cur.v[i + 3] << 16), cur.v[i + 4] | (cur.v[i + 5] << 16), cur.v[i + 6] | (cur.v[i + 7] << 16)};
        __syncthreads();
#pragma unroll
        for (int rep = 0; rep < 2; ++rep) { const int ti = wid + 8 * rep; if (ti < 10) {
            int jt, it2; if (ti < 4) { jt = 0; it2 = ti; } else if (ti < 7) { jt = 1; it2 = ti - 3; } else if (ti < 9) { jt = 2; it2 = ti - 5; } else { jt = 3; it2 = 3; }
            f32x4 a4 = {0.f, 0.f, 0.f, 0.f};
#pragma unroll
            for (int ks = 0; ks < 4; ++ks) { const bf16x8 kf = *(const LAS bf16x8*)(lds + GA_KIN + (16 * jt + l15) * 272 + ks * 64 + q4 * 16); const u32x2 q0_ = *(const LAS u32x2*)(lds + GA_QIN + (16 * it2 + l15) * GP + ks * 64 + q4 * 16), q1_ = *(const LAS u32x2*)(lds + GA_QIN + (16 * it2 + l15) * GP + ks * 64 + q4 * 16 + 8); const bf16x8 qf = __builtin_bit_cast(bf16x8, (u32x4){q0_.x, q0_.y, q1_.x, q1_.y});
                a4 = __builtin_amdgcn_mfma_f32_16x16x32_bf16(kf, qf, a4, 0, 0, 0); }
            const int i_ = 16 * it2 + l15, j0 = 16 * jt + 4 * q4;
            u32x2 w; w.x = cvt_pk(j0 <= i_ ? a4[0] : 0.f, j0 + 1 <= i_ ? a4[1] : 0.f); w.y = cvt_pk(j0 + 2 <= i_ ? a4[2] : 0.f, j0 + 3 <= i_ ? a4[3] : 0.f);
            *(LAS u32x2*)(lds + GA_ATT + i_ * GP2 + j0 * 2) = w; } }
        __syncthreads();
        unsigned char* blob = GB + (size_t)((b * 32 + n) * 4 + h) * GB_SIZE;
        for (int c = tid; c < 45056 / 16; c += 512) *(u32x4*)(blob + c * 16) = *(const LAS u32x4*)(lds + GA_BL + c * 16);
        for (int c = tid; c < 36864 / 16; c += 512) *(u32x4*)(blob + GB_VT + c * 16) = *(const LAS u32x4*)(lds + GA_VT + c * 16);
        cur = nxt;
      }
#undef GLA_LOAD
    }
}
constexpr int GS_BUF = 54272;
constexpr int GS_VT = 0, GS_QIN = 9216, GS_KST = GS_QIN + 16896, GS_ATT = GS_KST + 18432, GS_DEC = GS_ATT + 9216;
static_assert(3 * GS_BUF <= LDSCTL_OFF, "GLA ring");
DEV void gla_scan_item(Frame& F, int b, int h, int c4) {
    LAS unsigned char* lds = F.lds; const int lane = F.lane, wid = F.wave, q4 = lane >> 4, l15 = lane & 15;
    bf16_t* GO = WSP(bf16_t, W_GLAO); float* SS = WSP(float, W_SS); const unsigned char* GB = F.ws + W_GB;
    const int c16 = wid & 3, th = wid >> 2;
    f32x4 sacc[8];
#pragma unroll
    for (int m = 0; m < 8; ++m) sacc[m] = (f32x4){0.f, 0.f, 0.f, 0.f};
    const size_t rb = (size_t)b * 2048;
    float sqv[2][4]; unsigned ov[2][4];
#pragma unroll
    for (int mt = 0; mt < 2; ++mt)
#pragma unroll
        for (int r = 0; r < 4; ++r) { sqv[mt][r] = 0.f; ov[mt][r] = 0u; }
    const int npc = (wid < 5) ? 7 : 6;
#define GS_ISSUE(n_, bo_) do { const unsigned char* blob_ = GB + (size_t)((b * 32 + (n_)) * 4 + h) * GB_SIZE; \
        for (int p_ = wid; p_ < 53; p_ += 8) { const int so_ = p_ < 9 ? GB_VT + c4 * 9216 + p_ * 1024 : (p_ - 9) * 1024; \
            __builtin_amdgcn_global_load_lds((const unsigned*)(blob_ + so_ + lane * 16), (LAS unsigned*)(lds + (bo_) + p_ * 1024), 16, 0, 0); } } while (0)
    GS_ISSUE(0, 0); GS_ISSUE(1, GS_BUF);
    int bo = 0, bo2 = 2 * GS_BUF;
#pragma unroll 1
    for (int n = 0; n < 32; ++n) { const int t0 = n * 64;
        if (n + 1 < 32) { if (npc == 7) asm volatile("s_waitcnt vmcnt(7) lgkmcnt(0)\n\ts_barrier" ::: "memory"); else asm volatile("s_waitcnt vmcnt(6) lgkmcnt(0)\n\ts_barrier" ::: "memory"); } else asm volatile("s_waitcnt vmcnt(0) lgkmcnt(0)\n\ts_barrier" ::: "memory");
        if (n > 0) {
#pragma unroll
            for (int mt = 0; mt < 2; ++mt)
#pragma unroll
                for (int r = 0; r < 4; ++r) { const size_t trow = rb + (t0 - 64) + 32 * th + 16 * mt + 4 * q4 + r; GO[trow * 1024 + h * 256 + c4 * 64 + c16 * 16 + l15] = (bf16_t)ov[mt][r];
                    SS[(trow * 4 + h) * 16 + c4 * 4 + c16] = sqv[mt][r]; } }
        if (n + 2 < 32) GS_ISSUE(n + 2, bo2);
        const LAS unsigned char* bu = lds + bo;
        bf16x8 vf[2];
#pragma unroll
        for (int ks = 0; ks < 2; ++ks) vf[ks] = *(const LAS bf16x8*)(bu + GS_VT + (c16 * 16 + l15) * GP2 + ks * 64 + q4 * 16);
        bf16x8 sf[4];
#pragma unroll
        for (int ks = 0; ks < 4; ++ks) { const u32x4 w = {cvt_pk(sacc[2 * ks][0], sacc[2 * ks][1]), cvt_pk(sacc[2 * ks][2], sacc[2 * ks][3]), cvt_pk(sacc[2 * ks + 1][0], sacc[2 * ks + 1][1]), cvt_pk(sacc[2 * ks + 1][2], sacc[2 * ks + 1][3])}; sf[ks] = __builtin_bit_cast(bf16x8, w); }
#pragma unroll
        for (int mt = 0; mt < 2; ++mt) { const int i_ = 32 * th + 16 * mt + l15; f32x4 oa = {0.f, 0.f, 0.f, 0.f};
#pragma unroll
            for (int ks = 0; ks < 2; ++ks) { if (ks == 1 && th == 0) continue; const bf16x8 af = *(const LAS bf16x8*)(bu + GS_ATT + i_ * GP2 + ks * 64 + q4 * 16); oa = __builtin_amdgcn_mfma_f32_16x16x32_bf16(af, vf[ks], oa, 0, 0, 0); }
#pragma unroll
            for (int ks = 0; ks < 4; ++ks) { const u32x2 lo = *(const LAS u32x2*)(bu + GS_QIN + i_ * GP + (32 * ks + 4 * q4) * 2), hi2 = *(const LAS u32x2*)(bu + GS_QIN + i_ * GP + (32 * ks + 16 + 4 * q4) * 2);
                const u32x4 w = {lo.x, lo.y, hi2.x, hi2.y}; oa = __builtin_amdgcn_mfma_f32_16x16x32_bf16(__builtin_bit_cast(bf16x8, w), sf[ks], oa, 0, 0, 0); }
#pragma unroll
            for (int r = 0; r < 4; ++r) { ov[mt][r] = cvt_pk(oa[r], 0.f) & 0xffffu; float sq = oa[r] * oa[r]; sq += __shfl_xor(sq, 1); sq += __shfl_xor(sq, 2); sq += __shfl_xor(sq, 4); sq += __shfl_xor(sq, 8); sqv[mt][r] = sq; } }
#pragma unroll
        for (int md = 0; md < 8; ++md) { const f32x4 dc = *(const LAS f32x4*)(bu + GS_DEC + (16 * md + 4 * q4) * 4); sacc[md] = sacc[md] * dc;
#pragma unroll
            for (int ks = 0; ks < 2; ++ks) { const bf16x8 kf = *(const LAS bf16x8*)(bu + GS_KST + (16 * md + l15) * GP2 + ks * 64 + q4 * 16); sacc[md] = __builtin_amdgcn_mfma_f32_16x16x32_bf16(kf, vf[ks], sacc[md], 0, 0, 0); } }
        bo = (bo == 2 * GS_BUF) ? 0 : bo + GS_BUF; bo2 = (bo2 == 2 * GS_BUF) ? 0 : bo2 + GS_BUF;
    }
#undef GS_ISSUE
#pragma unroll
    for (int mt = 0; mt < 2; ++mt)
#pragma unroll
        for (int r = 0; r < 4; ++r) { const size_t trow = rb + 31 * 64 + 32 * th + 16 * mt + 4 * q4 + r; GO[trow * 1024 + h * 256 + c4 * 64 + c16 * 16 + l15] = (bf16_t)ov[mt][r]; SS[(trow * 4 + h) * 16 + c4 * 4 + c16] = sqv[mt][r]; }
    asm volatile("s_waitcnt vmcnt(0)" ::: "memory");
    __syncthreads();
}
DEV void p_gla_scan(Frame& F) { for (int v = F.vcu; v < 256; v += F.G) gla_scan_item(F, v >> 4, (v >> 2) & 3, v & 3); }

DEV void p_gla_norm(Frame& F) {
    const int gw = F.vcu * 8 + F.wave, NGW = F.G * 8, lane = F.lane; const bf16_t* GO = WSP(bf16_t, W_GLAO); const float* SS = WSP(float, W_SS); const bf16_t* H1 = WSP(bf16_t, W_HB); bf16_t* Y0 = WSP(bf16_t, W_Y0);
    const f32x4 nw = *(const f32x4*)(F.in[17] + lane * 4);
    for (int row = gw; row < T; row += NGW) {
#pragma unroll
        for (int h = 0; h < 4; ++h) { const float* sp = SS + ((size_t)row * 4 + h) * 16; const f32x4 a = *(const f32x4*)sp, b2 = *(const f32x4*)(sp + 4), c = *(const f32x4*)(sp + 8), d = *(const f32x4*)(sp + 12);
            const float sq = (a.x + a.y + a.z + a.w) + (b2.x + b2.y + b2.z + b2.w) + (c.x + c.y + c.z + c.w) + (d.x + d.y + d.z + d.w); const float r = 1.f / sqrtf(sq * (1.f / 256.f) + 1e-5f);
            const u32x2 o = *(const u32x2*)(GO + (size_t)row * 1024 + h * 256 + lane * 4); const u32x2 g = *(const u32x2*)(H1 + (size_t)row * 3072 + 2048 + h * 256 + lane * 4);
            const float g0 = bflo(g.x), g1 = bfhi(g.x), g2 = bflo(g.y), g3 = bfhi(g.y);
            u32x2 w; w.x = cvt_pk(bflo(o.x) * r * nw.x * g0 * fast_sigm(g0), bfhi(o.x) * r * nw.y * g1 * fast_sigm(g1)); w.y = cvt_pk(bflo(o.y) * r * nw.z * g2 * fast_sigm(g2), bfhi(o.y) * r * nw.w * g3 * fast_sigm(g3));
            *(u32x2*)(Y0 + (size_t)row * 1024 + h * 256 + lane * 4) = w; } }
}
struct FStoreScale { bf16_t* O; int ldc, c_lo, c_hi; float sc; static constexpr int NSIDE = 0;
    DEV const void* side(const Unit&, int) const { return nullptr; }
    DEV NoPre pre(const Unit&, int, const LAS float*) const { return NoPre{}; }
    DEV void operator()(const Unit&, int row, int col, f32x4 v0, f32x4 v1, NoPre, const LAS float*) const { const float s = (col >= c_lo && col < c_hi) ? sc : 1.f;
        const u32x4 w = {cvt_pk(v0[0] * s, v0[1] * s), cvt_pk(v0[2] * s, v0[3] * s), cvt_pk(v1[0] * s, v1[1] * s), cvt_pk(v1[2] * s, v1[3] * s)}; *(u32x4*)(O + (size_t)row * ldc + col) = w; } };
struct Pre8 { f32x4 b0, b1; };
struct FGlu { const bf16_t* Y; bf16_t* O; const float* b; static constexpr int NSIDE = 0;
    DEV const void* side(const Unit&, int) const { return nullptr; }
    DEV Pre8 pre(const Unit&, int col, const LAS float*) const { return Pre8{*(const f32x4*)(b + col), *(const f32x4*)(b + col + 4)}; }
    DEV void operator()(const Unit&, int row, int col, f32x4 v0, f32x4 v1, const Pre8& pp, const LAS float*) const { const u32x4 y = *(const u32x4*)(Y + (size_t)row * 512 + col); const f32x4 b0 = pp.b0, b1 = pp.b1;
        const u32x4 w = {cvt_pk(bflo(y.x) * fast_sigm(v0[0] + b0.x), bfhi(y.x) * fast_sigm(v0[1] + b0.y)), cvt_pk(bflo(y.y) * fast_sigm(v0[2] + b0.z), bfhi(y.y) * fast_sigm(v0[3] + b0.w)),
                         cvt_pk(bflo(y.z) * fast_sigm(v1[0] + b1.x), bfhi(y.z) * fast_sigm(v1[1] + b1.y)), cvt_pk(bflo(y.w) * fast_sigm(v1[2] + b1.z), bfhi(y.w) * fast_sigm(v1[3] + b1.w))};
        *(u32x4*)(O + (size_t)row * 1024 + col) = w; } };
constexpr float ACT_SCALE = 4.f, WDN_SCALE = 128.f;
DEV float swiglu1s(float g, float u) { g = fminf(g, 7.f); u = __builtin_amdgcn_fmed3f(u, -7.f, 7.f); const float r = __builtin_amdgcn_rcpf(1.f + __builtin_amdgcn_exp2f(-1.702f * 1.4426950408889634f * g)); return (g * r) * fmaf(u, ACT_SCALE, ACT_SCALE); }
DEV f32x2 swiglu2(f32x2 g, f32x2 u) { g.x = fminf(g.x, 7.f); g.y = fminf(g.y, 7.f); u.x = __builtin_amdgcn_fmed3f(u.x, -7.f, 7.f); u.y = __builtin_amdgcn_fmed3f(u.y, -7.f, 7.f);
    const f32x2 a = g * (-1.702f * 1.4426950408889634f); f32x2 e; e.x = __builtin_amdgcn_exp2f(a.x); e.y = __builtin_amdgcn_exp2f(a.y); e = e + 1.f;
    f32x2 r; r.x = __builtin_amdgcn_rcpf(e.x); r.y = __builtin_amdgcn_rcpf(e.y); return (g * r) * (u * ACT_SCALE + ACT_SCALE); }
struct FSwiglu { unsigned char* ACT; const float* bgu; float sc; static constexpr int NSIDE = 1;
    DEV const void* side(const Unit& u, int) const { return bgu + (size_t)u.e * 2048 + u.pn * BM; }
    DEV Pre8 pre(const Unit&, int, const LAS float* sb) const { return Pre8{*(const LAS f32x4*)sb, *(const LAS f32x4*)(sb + 4)}; }
    DEV void operator()(const Unit& u, int row, int col, f32x4 v0, f32x4 v1, const Pre8& pp, const LAS float*) const { const f32x4 b0 = pp.b0, b1 = pp.b1;
        const unsigned w = pk4_fp8(swiglu1s(fmaf(v0[0], sc, b0.x), fmaf(v0[1], sc, b0.y)), swiglu1s(fmaf(v0[2], sc, b0.z), fmaf(v0[3], sc, b0.w)), swiglu1s(fmaf(v1[0], sc, b1.x), fmaf(v1[1], sc, b1.y)), swiglu1s(fmaf(v1[2], sc, b1.z), fmaf(v1[3], sc, b1.w)));
        *(unsigned*)(ACT + (size_t)row * 1024 + (col >> 1)) = w; } };
constexpr float YS_SCALE = 64.f;
struct FDown { unsigned char* YS; const float* bd; const float* wgt; float sc; static constexpr int NSIDE = 2;
    DEV const void* side(const Unit& u, int k) const { return k == 0 ? (const void*)(bd + (size_t)u.e * 1024 + u.pn * BM) : (const void*)(wgt + (size_t)u.pm * BM); }
    DEV Pre8 pre(const Unit&, int, const LAS float* sb) const { return Pre8{*(const LAS f32x4*)sb, *(const LAS f32x4*)(sb + 4)}; }
    DEV void operator()(const Unit& u, int row, int col, f32x4 v0, f32x4 v1, const Pre8& pp, const LAS float* sr) const { const f32x4 b0 = pp.b0, b1 = pp.b1; const float wt = *sr * YS_SCALE, ws_ = sc * wt;
        u32x2 w; w.x = pk4_fp8(fmaf(v0[0], ws_, b0.x * wt), fmaf(v0[1], ws_, b0.y * wt), fmaf(v0[2], ws_, b0.z * wt), fmaf(v0[3], ws_, b0.w * wt)); w.y = pk4_fp8(fmaf(v1[0], ws_, b1.x * wt), fmaf(v1[1], ws_, b1.y * wt), fmaf(v1[2], ws_, b1.z * wt), fmaf(v1[3], ws_, b1.w * wt));
        *(u32x2*)(YS + (size_t)row * 1024 + col) = w; } };

constexpr int NPH = 21;
constexpr float X8_SCALE = 16.f, WGU_SCALE = 64.f;
constexpr float QSCALE0 = 0.125f * 1.4426950408889634f, QSCALE1 = 0.08838834764831845f;


#define NOINL __device__ __forceinline__
struct PA { const float* const* in; unsigned char* ws; float* out; int wave; };
#define MKFRAME extern __shared__ __attribute__((aligned(16))) unsigned char lds_[]; Frame F; F.lds = (LAS unsigned char*)lds_; F.wave = pa.wave; F.lane = (int)__builtin_amdgcn_mbcnt_hi(~0u, __builtin_amdgcn_mbcnt_lo(~0u, 0u)); F.tid = F.wave * 64 + F.lane; \
    F.G = gridDim.x; { const int bx = blockIdx.x; F.vcu = (F.G % 8 == 0) ? (bx % 8) * (F.G / 8) + bx / 8 : bx; } F.in = pa.in; F.ws = pa.ws;
template <class Fn> DEV void dense_gemm(Frame& F, const bf16_t* A, const bf16_t* Bt, int nM, int nN, int K, const Fn& fn) {
    Gemm g; g.A = A; g.Bt = Bt; g.rowmap = nullptr; g.bstride = 0; g.KB = K * 2; g.wave = F.wave;
    StaticOrder S; S.init(nM, nN, F.G, (int)blockIdx.x, nullptr);
    EpiRow8<Fn> E{fn};
    gemm_phase<false, false, true>(F.lds, g, S, E);
}
NOINL void ph_prologue(PA pa) { MKFRAME p0_prologue(F); }
NOINL void ph_in0(PA pa) { MKFRAME dense_gemm(F, WSP(bf16_t, W_XB), WSP(bf16_t, W_IN0), T / 256, 8, 1024, FStoreScale{WSP(bf16_t, W_HB), 2048, 512, 1024, QSCALE0}); }
NOINL void ph_kmean(PA pa) { MKFRAME p_kmean(F); }
NOINL void ph_s5moba(PA pa, int mode) { MKFRAME p_s5_moba(F, mode); }
NOINL void ph_glu(PA pa) { MKFRAME dense_gemm(F, WSP(bf16_t, W_YS5), WSP(bf16_t, W_GLU), T / 256, 2, 512, FGlu{WSP(bf16_t, W_YS5), WSP(bf16_t, W_Y0), F.in[11]}); }
NOINL void ph_out(PA pa, int layer) { MKFRAME dense_gemm(F, WSP(bf16_t, W_Y0), layer ? WSP(bf16_t, W_OUT1) : WSP(bf16_t, W_OUT0), T / 256, 4, 1024, FStoreScale{WSP(bf16_t, W_MIXB), 1024, 0, 0, 1.f}); }
NOINL void ph_in1(PA pa) { MKFRAME dense_gemm(F, WSP(bf16_t, W_XB), WSP(bf16_t, W_IN1), T / 256, 12, 1024, FStoreScale{WSP(bf16_t, W_HB), 3072, 0, 512, QSCALE1}); p_gr(F); }
NOINL void ph_glaprep(PA pa) { MKFRAME p_gla_prep(F); }
NOINL void ph_glascan(PA pa) { MKFRAME p_gla_scan(F); }
NOINL void ph_glanorm(PA pa) { MKFRAME p_gla_norm(F); }
NOINL void ph_lnrouter(PA pa, int layer) { MKFRAME
    if (layer == 0) p_ln<0, true, false, false>(F, nullptr, WSP(bf16_t, W_XB), WSP(bf16_t, W_XBB), nullptr, F.in[19], F.in[20], F.in[23], F.in[24]);
    else p_ln<0, true, false, false>(F, nullptr, WSP(bf16_t, W_XB), WSP(bf16_t, W_XBB), nullptr, F.in[19] + 1024, F.in[20] + 1024, F.in[23] + (size_t)1024 * 32, F.in[24] + 32); }
NOINL void ph_sort(PA pa) { MKFRAME p_sort(F); }
NOINL void ph_gateup(PA pa, int layer) { MKFRAME const int* SORT = WSP(int, W_SORT);
    Gemm g; g.A = WSP(unsigned char, W_X8); g.Bt = WSP(unsigned char, W_GU) + (size_t)layer * 32 * 2048 * 1024; g.rowmap = nullptr; g.bstride = (size_t)2048 * 1024; g.KB = 1024; g.wave = F.wave;
    StaticOrder S; S.init(__builtin_amdgcn_readfirstlane(SORT[33]), 8, F.G, (int)blockIdx.x, (const LAS int*)(F.lds + LDS_ELIST)); fill_elist(F.lds, S, SORT + 64, F.tid);
    EpiRow8<FSwiglu> E{FSwiglu{WSP(unsigned char, W_ACT), F.in[26] + (size_t)layer * 32 * 2048, 1.f / (X8_SCALE * WGU_SCALE)}};
    gemm_phase<false, true, true>(F.lds, g, S, E); }
NOINL void ph_down(PA pa, int layer) { MKFRAME const int* SORT = WSP(int, W_SORT);
    Gemm g; g.A = WSP(unsigned char, W_ACT); g.Bt = WSP(unsigned char, W_DN) + (size_t)layer * 32 * 1024 * 1024; g.rowmap = nullptr; g.bstride = (size_t)1024 * 1024; g.KB = 1024; g.wave = F.wave;
    StaticOrder S; S.init(__builtin_amdgcn_readfirstlane(SORT[33]), 4, F.G, (int)blockIdx.x, (const LAS int*)(F.lds + LDS_ELIST)); fill_elist(F.lds, S, SORT + 64, F.tid);
    EpiRow8<FDown> E{FDown{WSP(unsigned char, W_YS), F.in[28] + (size_t)layer * 32 * 1024, WSP(float, R_WGT), 1.f / (ACT_SCALE * WDN_SCALE)}};
    gemm_phase<false, true, true>(F.lds, g, S, E); }
NOINL void ph_combine(PA pa, int layer) { MKFRAME
    if (layer == 0) p_ln<1, false, false, false, false>(F, nullptr, WSP(bf16_t, W_XBB), WSP(bf16_t, W_XB), nullptr, F.in[21], F.in[22], nullptr, nullptr);
    else p_ln<1, false, false, true>(F, nullptr, WSP(bf16_t, W_XBB), nullptr, pa.out, F.in[21] + 1024, F.in[22] + 1024, nullptr, nullptr); }

__global__ void __launch_bounds__(512, 2) mega(Args args) {
    extern __shared__ __attribute__((aligned(16))) unsigned char lds_[];
    LAS unsigned char* lds = (LAS unsigned char*)lds_;
    unsigned* ctl = (unsigned*)(args.ws + W_CTL);
    for (int u = threadIdx.x; u < (LDS_BYTES - LDSCTL_OFF) / 4; u += 512) ((LAS unsigned*)(lds + LDSCTL_OFF))[u] = 0u;
    __syncthreads();
    const int lo = args.ph_lo, hi = args.ph_hi;
    PA pa; pa.in = args.in; pa.ws = args.ws; pa.out = args.out; pa.wave = __builtin_amdgcn_readfirstlane(threadIdx.x >> 6);
    XcdBarrier bar; bar.bar = ctl + CW_BAR; bar.x = 0; bar.st = nullptr; bar.wave = pa.wave;
    if (hi - lo > 1) bar = xcd_barrier_post(ctl + CW_BAR, (volatile LAS unsigned*)(lds + MISC_OFF) + 8, pa.wave);
#define IN(k) (lo <= (k) && (k) < hi)
#ifdef DIAG_LO
    volatile LAS unsigned long long* tsl = (volatile LAS unsigned long long*)(lds + MISC_OFF + 128);
    if (blockIdx.x == 0 && threadIdx.x == 0) tsl[0] = __builtin_amdgcn_s_memrealtime();
#define STAMP(k) do { if (blockIdx.x == 0 && threadIdx.x == 0) tsl[(k) + 1] = __builtin_amdgcn_s_memrealtime(); } while (0)
#else
#define STAMP(k) do { } while (0)
#endif
#define SEAM(k) do { if (IN(k) && IN((k) + 1)) xcd_barrier(bar); STAMP(k); } while (0)
#ifndef REP_PHASE
#define REP_PHASE -1
#define REP_N 0
#endif
#define RUN(k, call) do { if (IN(k)) { call; if ((k) == REP_PHASE) { xcd_barrier(bar); call; } } } while (0)
    RUN(0, ph_prologue(pa)); SEAM(0);
    RUN(1, ph_in0(pa)); SEAM(1);
    RUN(2, ph_kmean(pa)); SEAM(2);
    if (IN(3)) { ph_s5moba(pa, 1); if (REP_PHASE == 30) ph_s5moba(pa, 1); ph_s5moba(pa, 2); if (REP_PHASE == 31) ph_s5moba(pa, 2); } SEAM(3);
    RUN(4, ph_glu(pa)); SEAM(4);
    RUN(5, ph_out(pa, 0)); SEAM(5);
    if (REP_PHASE == 99) { for (int q_ = 0; q_ < 20; ++q_) xcd_barrier(bar); }
    RUN(6, ph_lnrouter(pa, 0)); SEAM(6);
    RUN(7, ph_sort(pa)); SEAM(7);
    RUN(8, ph_gateup(pa, 0)); SEAM(8);
    RUN(9, ph_down(pa, 0)); SEAM(9);
    RUN(10, ph_combine(pa, 0)); SEAM(10);
    RUN(11, ph_in1(pa)); SEAM(11);
    RUN(12, ph_glaprep(pa)); SEAM(12);
    RUN(13, ph_glascan(pa)); SEAM(13);
    RUN(14, ph_glanorm(pa)); SEAM(14);
    RUN(15, ph_out(pa, 1)); SEAM(15);
    RUN(16, ph_lnrouter(pa, 1)); SEAM(16);
    RUN(17, ph_sort(pa)); SEAM(17);
    RUN(18, ph_gateup(pa, 1)); SEAM(18);
    RUN(19, ph_down(pa, 1)); SEAM(19);
    RUN(20, ph_combine(pa, 1));
#ifdef DIAG_LO
    xcd_barrier(bar); STAMP(20);
    if (blockIdx.x == 0 && threadIdx.x == 0) { const unsigned long long dtk = tsl[DIAG_HI + 1] - tsl[DIAG_LO]; const float f = (float)dtk * (0.01f / 10000.f); __hip_atomic_store(ctl + 8, __float_as_uint(f), __ATOMIC_RELAXED, __HIP_MEMORY_SCOPE_AGENT); }
    xcd_barrier(bar);
    { const float f = __uint_as_float(__hip_atomic_load(ctl + 8, __ATOMIC_RELAXED, __HIP_MEMORY_SCOPE_AGENT));
      for (size_t i = (size_t)blockIdx.x * 512 + threadIdx.x; i < (size_t)T * 1024; i += (size_t)gridDim.x * 512) args.out[i] *= (1.f + f); }
#endif
#undef IN
#undef SEAM
}

static int g_grid = 0;
static bool launch_setup(size_t ws_size) {
    if (g_grid == 0) {
        if (ws_size < W_END) { fprintf(stderr, "kernel_launch: workspace too small: %zu < %zu\n", ws_size, (size_t)W_END); g_grid = -1; return false; }
        int dev = 0, cus = 0, per_cu = 0;
        if (hipGetDevice(&dev) != hipSuccess || hipDeviceGetAttribute(&cus, hipDeviceAttributeMultiprocessorCount, dev) != hipSuccess) { g_grid = -1; return false; }
        if (hipFuncSetAttribute((const void*)mega, hipFuncAttributeMaxDynamicSharedMemorySize, LDS_BYTES) != hipSuccess) { fprintf(stderr, "kernel_launch: hipFuncSetAttribute failed\n"); g_grid = -1; return false; }
        if (hipOccupancyMaxActiveBlocksPerMultiprocessor(&per_cu, (const void*)mega, 512, LDS_BYTES) != hipSuccess || per_cu < 1) fprintf(stderr, "kernel_launch: occupancy query reports %d blocks/CU\n", per_cu);
        (void)hipGetLastError();
        g_grid = cus;
    }
    return g_grid > 0;
}
static void launch_phases(hipStream_t stream, void* const* d_in, void* d_out, void* d_ws, int lo, int hi) {
    Args a; memset(&a, 0, sizeof a);
    for (int i = 0; i < 29; ++i) a.in[i] = (const float*)d_in[i];
    a.out = (float*)d_out; a.ws = (unsigned char*)d_ws; a.ph_lo = lo; a.ph_hi = hi;
    hipLaunchKernelGGL(mega, dim3(g_grid), dim3(512), LDS_BYTES, stream, a);
}
}
extern "C" void kernel_launch(void* const* d_in, const int* in_sizes, int n_in, void* d_out, int out_size, void* d_ws, size_t ws_size, hipStream_t stream) {
    if (n_in != 29 || out_size != T * D) { fprintf(stderr, "kernel_launch: unexpected arguments (n_in %d, out_size %d)\n", n_in, out_size); return; }
    if (!fk::launch_setup(ws_size)) return;
    (void)hipMemsetAsync((char*)d_ws + fk::W_CTL, 0, fk::CTL_ZERO_BYTES, stream);
    fk::launch_phases(stream, d_in, d_out, d_ws, 0, fk::NPH);
}
```

```cpp
#include <hip/hip_runtime.h>
#include <cstdio>
#include <cstdint>
#include <cmath>
#include <cstring>
#define DEV __device__ __forceinline__
constexpr int Bn = 16, L = 2048, D = 1024, T = Bn * L;
namespace fk {
#define LAS __attribute__((address_space(3)))
#define GAS __attribute__((address_space(1)))
typedef unsigned short bf16_t;
typedef short bf16x8 __attribute__((ext_vector_type(8)));
typedef short s16x4 __attribute__((ext_vector_type(4)));
typedef float f32x2 __attribute__((ext_vector_type(2)));
typedef float f32x4 __attribute__((ext_vector_type(4)));
typedef float f32x16 __attribute__((ext_vector_type(16)));
typedef unsigned u32x2 __attribute__((ext_vector_type(2)));
typedef unsigned u32x4 __attribute__((ext_vector_type(4)));
typedef __bf16 bf16x2_t __attribute__((ext_vector_type(2)));
struct u32x4x2 { u32x4 a, b; };
DEV unsigned cvt_pk(float lo, float hi) { f32x2 v = {lo, hi}; bf16x2_t b = __builtin_convertvector(v, bf16x2_t); return __builtin_bit_cast(unsigned, b); }
DEV float bflo(unsigned w) { return __uint_as_float(w << 16); }
DEV float bfhi(unsigned w) { return __uint_as_float(w & 0xffff0000u); }
#ifndef WT_STORES
#define WT_STORES 0
#endif
DEV void st_wt(void* p, u32x4 v) { if (WT_STORES == 1) asm volatile("global_store_dwordx4 %0, %1, off sc1" :: "v"(p), "v"(v)); else if (WT_STORES == 2) __builtin_nontemporal_store(v, (u32x4*)p); else *(u32x4*)p = v; }
DEV void st_wt(void* p, u32x2 v) { if (WT_STORES == 1) asm volatile("global_store_dwordx2 %0, %1, off sc1" :: "v"(p), "v"(v)); else if (WT_STORES == 2) __builtin_nontemporal_store(v, (u32x2*)p); else *(u32x2*)p = v; }
DEV void st_wt(void* p, f32x4 v) { if (WT_STORES == 1) asm volatile("global_store_dwordx4 %0, %1, off sc1" :: "v"(p), "v"(v)); else if (WT_STORES == 2) __builtin_nontemporal_store(v, (f32x4*)p); else *(f32x4*)p = v; }
DEV float fast_sigm(float x) { return __builtin_amdgcn_rcpf(1.f + __builtin_amdgcn_exp2f(-1.4426950408889634f * x)); }
DEV float gelu_tanh(float x) { const float u = 0.7978845608028654f * (x + 0.044715f * x * x * x); return x * fast_sigm(2.f * u); }
DEV float wave_sum(float v) {
#pragma unroll
    for (int o = 1; o < 64; o <<= 1) v += __shfl_xor(v, o);
    return v; }
DEV float swap32(float x) { auto rr = __builtin_amdgcn_permlane32_swap(__float_as_uint(x), __float_as_uint(x), false, false); return __uint_as_float((__builtin_amdgcn_mbcnt_lo(~0u, 0u) >> 5) ? rr[0] : rr[1]); }

constexpr int BM = 256, BK = 64, HALF = 128, HTB = HALF * BK * 2, STAGE_BYTES = 8 * HTB, NXCD = 8, WGM = 8;
constexpr int LDS_TOK = 135168 - 2048;
constexpr int LDS_SIDE = 135168;
constexpr int LDS_BYTES = 163840, LDSCTL_OFF = LDS_BYTES - 1024, MISC_OFF = LDSCTL_OFF + 320;

DEV int lds_byte(int r, int c) { const int st = (r >> 4) * 2 + (c >> 5), rr = r & 15, cc = c & 31, ob = rr * 64 + cc * 2; return st * 1024 + (ob ^ (((ob >> 9) & 1) << 5)); }
DEV void stage_rc(int b, int& R, int& C) { const int st = b / 1024, sb = b % 1024, swz = sb ^ (((sb >> 9) & 1) << 5); R = (st >> 1) * 16 + swz / 64; C = (st & 1) * 32 + (swz % 64) / 2; }
DEV int perm32(int rho) { const int n = rho >> 4, i = rho & 15; return 8 * (i >> 2) + 4 * n + (i & 3); }

struct Unit { int pm, pn, e; };
struct Gemm { const void* A; const void* Bt; const int* rowmap; size_t bstride; int KB; int wave; };

struct StaticOrder {
    int nM, nN, nwg, G, c; const LAS int* elist;
    DEV void init(int nM_, int nN_, int G_, int c_, const LAS int* el) { nM = nM_; nN = nN_; nwg = nM * nN; G = G_; c = c_; elist = el; }
    DEV bool place(int i, Unit& u) const {
        const long Lx = (long)i * G + c; if (Lx >= nwg) return false;
        int wgid = (int)Lx; { const int q = nwg / NXCD, r = nwg % NXCD, xcd = wgid % NXCD, off = wgid / NXCD; wgid = (xcd < r ? xcd * (q + 1) : r * (q + 1) + (xcd - r) * q) + off; }
        const int nig = WGM * nN, gid = wgid / nig, fm = gid * WGM, gsz = (nM - fm) < WGM ? (nM - fm) : WGM;
        u.pm = fm + ((wgid % nig) % gsz); u.pn = (wgid % nig) / gsz; u.e = 0; return true;
    }
    DEV bool next(int i, Unit& u) const { if (!place(i, u)) return false; if (elist) u.e = __builtin_amdgcn_readfirstlane(elist[i]); return true; }
};
constexpr int LDS_ELIST = 135168 + 6144;
DEV void fill_elist(LAS unsigned char* lds, const StaticOrder& S, const int* tile_e, int tid) {
    LAS int* el = (LAS int*)(lds + LDS_ELIST);
    if (tid < 64) { Unit u; el[tid] = S.place(tid, u) ? tile_e[u.pm] : 0; }
    __syncthreads();
}

struct NoPre {};
template <class F> struct EpiRow8 {
    static constexpr bool PERM = true, PERM2 = F::PERM2; static constexpr int NSIDE = F::NSIDE; F f;
    DEV const void* side(const Unit& u, int k) const { return f.side(u, k); }
    DEV void operator()(const f32x4 (&acc)[2][2][4][2], const Unit& u, int wr, int wc, int fr, int fq, const LAS float* sd) const {
        { int ln_; asm volatile("v_mbcnt_lo_u32_b32 %0, -1, 0\n\tv_mbcnt_hi_u32_b32 %0, -1, %0" : "=v"(ln_)); fr = ln_ & 15; fq = ln_ >> 4; }
        const int cl = wc * 32 + 8 * fq, c0 = u.pn * BM + cl;
        if constexpr (NSIDE > 0) {
#pragma unroll
            for (int ai = 0; ai < 2; ++ai)
#pragma unroll
                for (int m = 0; m < 4; ++m) { const int rl = ai * HALF + wr * 64 + m * 16 + fr, row = u.pm * BM + rl;
                    f(u, row, c0, acc[ai][0][m][0], acc[ai][0][m][1], f.pre(u, c0, sd + cl), sd + 256 + rl); f(u, row, c0 + HALF, acc[ai][1][m][0], acc[ai][1][m][1], f.pre(u, c0 + HALF, sd + cl + HALF), sd + 256 + rl); }
        } else {
        const auto p0 = f.pre(u, c0, sd + cl), p1 = f.pre(u, c0 + HALF, sd + cl + HALF);
#pragma unroll
        for (int ai = 0; ai < 2; ++ai)
#pragma unroll
            for (int m = 0; m < 4; ++m) { const int rl = ai * HALF + wr * 64 + m * 16 + fr, row = u.pm * BM + rl;
                f(u, row, c0, acc[ai][0][m][0], acc[ai][0][m][1], p0, sd + 256 + rl); f(u, row, c0 + HALF, acc[ai][1][m][0], acc[ai][1][m][1], p1, sd + 256 + rl); }
        }
    }
};

typedef int v8i_t __attribute__((ext_vector_type(8)));
typedef int v4i_t __attribute__((ext_vector_type(4)));
template <bool GATHER, bool FP8, bool ALIGN, int DUPK = 0, class Epi, class Sched>
DEV void gemm_phase(LAS unsigned char* lds, const Gemm g, const Sched& S, const Epi& E) {
    const int wid = g.wave, lane = (int)__builtin_amdgcn_mbcnt_hi(~0u, __builtin_amdgcn_mbcnt_lo(~0u, 0u)), tid = wid * 64 + lane, wr = wid >> 2, wc = wid & 3, fr = lane & 15, fq = lane >> 4;

    const int KB = g.KB, nt = KB / 128;
    int R0, C2; { int C; stage_rc(tid * 16, R0, C); C2 = C * 2; }
    unsigned voffB[2]; { int Rb = Epi::PERM ? ((R0 & ~31) + perm32(R0 & 31)) : R0; if constexpr (Epi::PERM2) Rb = (Rb & ~3) | ((Rb & 1) << 1) | ((Rb >> 1) & 1);
      voffB[0] = (unsigned)(Rb * KB + C2); voffB[1] = voffB[0] + 64u * (unsigned)KB; }
    const unsigned kstep = 128u, hstep = (unsigned)HALF * KB, tstep = 2u * hstep;
    const unsigned ldsw = (unsigned)wid * 1024u;
    const int aoff = lds_byte(wr * 64 + fr, fq * 8); int boff = lds_byte(wc * 32 + fr, fq * 8) + 4 * HTB; asm volatile("" : "+v"(boff));
    LAS int* tokb = (LAS int*)(lds + LDS_TOK);
    const auto rsA = __builtin_amdgcn_make_buffer_rsrc((void*)g.A, 0, 0x7fffffff, 0x00020000);
    const auto rsB = __builtin_amdgcn_make_buffer_rsrc((void*)g.Bt, 0, 0x7fffffff, 0x00020000);
    const auto rsT = __builtin_amdgcn_make_buffer_rsrc((void*)(GATHER ? (const void*)g.rowmap : g.A), 0, 0x7fffffff, 0x00020000);
#define PG8_SA(b, h) (((b) * 2 + (h)) * HTB)
#define PG8_SB(b, h) ((4 + (b) * 2 + (h)) * HTB)
#define PG8_STAGE(bufoff, rs, soff, voff) do { _Pragma("unroll") for (int _i = 0; _i < 2; ++_i) { \
        if constexpr (GATHER) __builtin_amdgcn_raw_ptr_buffer_load_lds(rs, (LAS void*)(lds + (bufoff) + ldsw + _i * 8192), 16, (int)(voff)[_i], (int)(soff), 0, 0); \
        else __builtin_amdgcn_raw_ptr_buffer_load_lds(rs, (LAS void*)(lds + (bufoff) + ldsw + _i * 8192), 16, (int)(voff)[0], (int)((soff) + _i * 64u * (unsigned)KB), 0, 0); } } while (0)
#define PG8_LDA(dst, b, h) do { _Pragma("unroll") for (int m = 0; m < 4; ++m) _Pragma("unroll") for (int k = 0; k < 2; ++k) dst[m][k] = *(const LAS bf16x8*)(lds + PG8_SA(b, h) + aoff + m * 2048 + k * 1024); } while (0)
#define PG8_LDB(dst, b, h) do { _Pragma("unroll") for (int n = 0; n < 2; ++n) _Pragma("unroll") for (int k = 0; k < 2; ++k) dst[n][k] = *(const LAS bf16x8*)(lds + boff + (PG8_SB(b, h) - 4 * HTB) + n * 2048 + k * 1024); } while (0)
#define PG8_CAT(x) __builtin_shufflevector(__builtin_bit_cast(v4i_t, x[0]), __builtin_bit_cast(v4i_t, x[1]), 0, 1, 2, 3, 4, 5, 6, 7)
#define PG8_MMA(ai, bj, At, Bt) do { __builtin_amdgcn_s_setprio(1); _Pragma("unroll") for (int m = 0; m < 4; ++m) _Pragma("unroll") for (int n = 0; n < 2; ++n) { \
        if constexpr (FP8) acc[ai][bj][m][n] = __builtin_amdgcn_mfma_scale_f32_16x16x128_f8f6f4(PG8_CAT(Bt[n]), PG8_CAT(At[m]), acc[ai][bj][m][n], 0, 0, 0, 0, 0, 0); \
        else { _Pragma("unroll") for (int k = 0; k < 2; ++k) acc[ai][bj][m][n] = __builtin_amdgcn_mfma_f32_16x16x32_bf16(Bt[n][k], At[m][k], acc[ai][bj][m][n], 0, 0, 0); } } __builtin_amdgcn_s_setprio(0); } while (0)
#define PG8_MMA0(ai, bj, At, Bt) do { __builtin_amdgcn_s_setprio(1); _Pragma("unroll") for (int m = 0; m < 4; ++m) _Pragma("unroll") for (int n = 0; n < 2; ++n) { const f32x4 zz_ = {0.f, 0.f, 0.f, 0.f}; \
        if constexpr (FP8) acc[ai][bj][m][n] = __builtin_amdgcn_mfma_scale_f32_16x16x128_f8f6f4(PG8_CAT(Bt[n]), PG8_CAT(At[m]), zz_, 0, 0, 0, 0, 0, 0); \
        else { acc[ai][bj][m][n] = __builtin_amdgcn_mfma_f32_16x16x32_bf16(Bt[n][0], At[m][0], zz_, 0, 0, 0); acc[ai][bj][m][n] = __builtin_amdgcn_mfma_f32_16x16x32_bf16(Bt[n][1], At[m][1], acc[ai][bj][m][n], 0, 0, 0); } } __builtin_amdgcn_s_setprio(0); } while (0)
#define PG8_WAIT_V(n) asm volatile("s_waitcnt vmcnt(" #n ")" ::: "memory")
#define PG8_WAIT_L(n) asm volatile("s_waitcnt lgkmcnt(" #n ")" ::: "memory")
#define PG8_BAR __builtin_amdgcn_s_barrier()
#define PG8_SCHED __builtin_amdgcn_sched_barrier(0)
    Unit cur, nxt; int ui = 0;
    if (!S.next(0, cur)) return;
    f32x4 acc[2][2][4][2];
    bf16x8 At[4][2], B0[2][2], B1[2][2];
    unsigned cA, cB = (unsigned)cur.e * (unsigned)g.bstride + (unsigned)cur.pn * tstep;
    unsigned voffA[2]; voffA[0] = (unsigned)(R0 * KB + C2); voffA[1] = voffA[0] + 64u * (unsigned)KB;
    if constexpr (GATHER) { cA = 0u;
        if (wid < 4) __builtin_amdgcn_raw_ptr_buffer_load_lds(rsT, (LAS void*)(tokb + wid * 64), 4, (wid * 64 + lane) * 4, cur.pm * (BM * 4), 0, 0);
        asm volatile("s_waitcnt vmcnt(0)" ::: "memory"); __builtin_amdgcn_s_barrier();
    } else cA = (unsigned)cur.pm * tstep;
    const unsigned hA = GATHER ? 0u : hstep;
    LAS float* sideb = (LAS float*)(lds + LDS_SIDE);
#define PG8_SIDE(un, sel) do { if constexpr (Epi::NSIDE > 0) { if (wid < Epi::NSIDE) { const char* sp_ = (const char*)E.side(un, wid); int ln_ = (int)__builtin_amdgcn_mbcnt_hi(~0u, __builtin_amdgcn_mbcnt_lo(~0u, 0u)); asm volatile("" : "+v"(ln_)); \
        __builtin_amdgcn_global_load_lds((const unsigned*)(sp_ + ln_ * 16), (LAS unsigned*)(sideb + (sel) * 512 + wid * 256), 16, 0, 0); } } } while (0)
    PG8_SIDE(cur, 0);
#define PG8_OA(dst, sel, h) unsigned dst[2]; if constexpr (GATHER) { dst[0] = (unsigned)(tokb[(sel) * 256 + (h) * HALF + R0] * KB + C2); dst[1] = (unsigned)(tokb[(sel) * 256 + (h) * HALF + R0 + 64] * KB + C2); } else { dst[0] = voffA[0]; dst[1] = voffA[1]; }
    { PG8_OA(p0_, 0, 0); PG8_OA(p1_, 0, 1); PG8_STAGE(PG8_SB(0, 0), rsB, cB, voffB); PG8_STAGE(PG8_SB(0, 1), rsB, cB + hstep, voffB); PG8_STAGE(PG8_SA(0, 0), rsA, cA, p0_); PG8_STAGE(PG8_SA(0, 1), rsA, cA + hA, p1_); }
    if (wr == 1) PG8_BAR;
    PG8_WAIT_V(2); PG8_BAR;
    { PG8_OA(p0_, 0, 0); PG8_STAGE(PG8_SB(1, 0), rsB, cB + kstep, voffB); PG8_STAGE(PG8_SA(1, 0), rsA, cA + kstep, p0_); PG8_STAGE(PG8_SB(1, 1), rsB, cB + hstep + kstep, voffB); }
    PG8_WAIT_V(6); PG8_BAR;
    for (;;) {
        const bool has_next = S.next(ui + 1, nxt);
        unsigned nA = cA, nB = cB;
        if (has_next) { nB = (unsigned)nxt.e * (unsigned)g.bstride + (unsigned)nxt.pn * tstep;
            if constexpr (GATHER) { if (wid < 4) { const int ln_ = (int)__builtin_amdgcn_mbcnt_hi(~0u, __builtin_amdgcn_mbcnt_lo(~0u, 0u)); __builtin_amdgcn_raw_ptr_buffer_load_lds(rsT, (LAS void*)(tokb + ((ui + 1) & 1) * 256 + wid * 64), 4, (wid * 64 + ln_) * 4, nxt.pm * (BM * 4), 0, 0); } }
            else nA = (unsigned)nxt.pm * tstep;
            PG8_SIDE(nxt, (ui + 1) % 3); }
#pragma unroll 1
        for (int t = 0; t < nt; t += 2) {
            const bool last = (t == nt - 2);
            const unsigned a1 = cA + (unsigned)(t + 1) * kstep;
            const unsigned a2 = last ? nA : cA + (unsigned)(t + 2) * kstep, b2 = last ? nB : cB + (unsigned)(t + 2) * kstep;
            const unsigned a3 = a2 + kstep, b3 = b2 + kstep;
            const int selc = ui & 1, seln = (last && has_next) ? ((ui + 1) & 1) : selc;
            PG8_LDB(B0, 0, 0); PG8_LDB(B1, 0, 1); PG8_SCHED; PG8_LDA(At, 0, 0); { PG8_OA(q_, selc, 1); PG8_STAGE(PG8_SA(1, 1), rsA, a1 + hA, q_); }
            PG8_WAIT_V(8); PG8_WAIT_L(0); PG8_BAR; if (t == 0) { PG8_MMA0(0, 0, At, B0); PG8_MMA0(0, 1, At, B1); } else { PG8_MMA(0, 0, At, B0); PG8_MMA(0, 1, At, B1); } PG8_BAR; PG8_SCHED;
            PG8_LDA(At, 0, 1); PG8_STAGE(PG8_SB(0, 0), rsB, b2, voffB); PG8_STAGE(PG8_SB(0, 1), rsB, b2 + hstep, voffB); { PG8_OA(q_, seln, 0); PG8_STAGE(PG8_SA(0, 0), rsA, a2, q_); }
            PG8_WAIT_V(8); PG8_WAIT_L(0); PG8_BAR; if (t == 0) { PG8_MMA0(1, 0, At, B0); PG8_MMA0(1, 1, At, B1); } else { PG8_MMA(1, 0, At, B0); PG8_MMA(1, 1, At, B1); } PG8_BAR; PG8_SCHED;
            PG8_LDB(B0, 1, 0); PG8_LDB(B1, 1, 1); PG8_SCHED; PG8_LDA(At, 1, 0); { PG8_OA(q_, seln, 1); PG8_STAGE(PG8_SA(0, 1), rsA, a2 + hA, q_); }
            PG8_WAIT_V(8); PG8_WAIT_L(0); PG8_BAR; PG8_MMA(0, 0, At, B0); PG8_MMA(0, 1, At, B1); PG8_BAR; PG8_SCHED;
            PG8_LDA(At, 1, 1); PG8_STAGE(PG8_SB(1, 0), rsB, b3, voffB); PG8_STAGE(PG8_SB(1, 1), rsB, b3 + hstep, voffB); { PG8_OA(q_, seln, 0); PG8_STAGE(PG8_SA(1, 0), rsA, a3, q_); }
            PG8_WAIT_V(8); PG8_WAIT_L(0); PG8_BAR; PG8_MMA(1, 0, At, B0); PG8_MMA(1, 1, At, B1); PG8_BAR; PG8_SCHED;
        }
        if constexpr (ALIGN) { if (wr == 0) PG8_BAR; }
        E(acc, cur, wr, wc, fr, fq, sideb + (ui % 3) * 512);
        if constexpr (DUPK == 5) { asm volatile("" ::: "memory"); E(acc, cur, wr, wc, fr, fq, sideb + (ui % 3) * 512); }
        if (!has_next) break;
        cur = nxt; cA = nA; cB = nB; ++ui;
        if constexpr (ALIGN) { if (wr == 1) PG8_BAR; }
    }
    PG8_WAIT_V(0);
    if constexpr (!ALIGN) { if (wr == 0) PG8_BAR; }
    PG8_BAR;
#undef PG8_SA
#undef PG8_SB
#undef PG8_STAGE
#undef PG8_SIDE
#undef PG8_OA
#undef PG8_LDA
#undef PG8_LDB
#undef PG8_MMA
#undef PG8_MMA0
#undef PG8_CAT
#undef PG8_WAIT_V
#undef PG8_WAIT_L
#undef PG8_BAR
#undef PG8_SCHED
}

typedef GAS unsigned gu32;
#define XB_TMO      128
#define XB_XCNT(j)  (256  + 64 * (j))
#define XB_XSUB(j)  (1280 + 64 * (j))
#define XB_XGEN(j)  (2304 + 64 * (j))
#define XB_TOP      3328
#define XB_TOPGEN   3392
#define XCD_BAR_WORDS 3456
#define XB_SPIN_CAP (1u << 20)
DEV unsigned xb_ld(unsigned* p) { return __hip_atomic_load(p, __ATOMIC_RELAXED, __HIP_MEMORY_SCOPE_AGENT); }
DEV unsigned xb_add(unsigned* p, unsigned v) { return __hip_atomic_fetch_add(p, v, __ATOMIC_RELAXED, __HIP_MEMORY_SCOPE_AGENT); }
DEV unsigned xb_xcc_id() { return (unsigned)__builtin_amdgcn_s_getreg((3 << 11) | 20) & 0xFu; }
#define XB_SPIN(cond, bar) do { unsigned _sp = 0; while (cond) { __builtin_amdgcn_s_sleep(1); \
    if ((++_sp & 255u) == 0u) { if (xb_ld(&(bar)[XB_TMO])) break; if (_sp > XB_SPIN_CAP) { atomicAdd(&(bar)[XB_TMO], 1u); break; } } } } while (0)
struct XcdBarrier { unsigned* bar; unsigned x; volatile LAS unsigned* st; int wave; };
DEV bool xb_thread0(int wave) { return wave == 0 && __builtin_amdgcn_mbcnt_hi(~0u, __builtin_amdgcn_mbcnt_lo(~0u, 0u)) == 0u; }
DEV XcdBarrier xcd_barrier_post(unsigned* bar, volatile LAS unsigned* st, int wave) {
    XcdBarrier b; b.bar = bar; b.x = xb_xcc_id(); b.st = st; b.wave = wave;
    if (xb_thread0(wave)) (void)xb_add(&bar[XB_XCNT(b.x)], 1u);
    return b;
}
DEV void xcd_barrier_complete(unsigned* bar, unsigned x, unsigned& nloc, unsigned& nx) {
    const unsigned G = gridDim.x * gridDim.y * gridDim.z;
    unsigned sum, cnt, mine, sp = 0u;
    for (;;) {
        sum = 0u; cnt = 0u; mine = 0u;
#pragma unroll
        for (unsigned j = 0; j < 16; ++j) { const unsigned c = xb_ld(&bar[XB_XCNT(j)]); sum += c; cnt += (c > 0u) ? 1u : 0u; mine = (j == x) ? c : mine; }
        if (sum == G) break;
        __builtin_amdgcn_s_sleep(1);
        if ((++sp & 255u) == 0u) { if (xb_ld(&bar[XB_TMO])) break; if (sp > XB_SPIN_CAP) { atomicAdd(&bar[XB_TMO], 1u); break; } }
    }
    nloc = mine > 0u ? mine : 1u; nx = cnt > 0u ? cnt : 1u;
}
DEV void xcd_barrier(const XcdBarrier& b) {
    asm volatile("s_waitcnt vmcnt(0)" ::: "memory");
    __syncthreads();
    if (xb_thread0(b.wave)) {
        unsigned* bar = b.bar;
        __builtin_amdgcn_s_waitcnt(0);
        unsigned nloc = b.st[0], nx = b.st[1];
        if (nloc == 0u) { xcd_barrier_complete(bar, b.x, nloc, nx); b.st[0] = nloc; b.st[1] = nx; }
        const unsigned old = xb_add(&bar[XB_XSUB(b.x)], 1u);
        const unsigned gen = old / nloc;
        if (old + 1u == (gen + 1u) * nloc) {
            __builtin_amdgcn_fence(__ATOMIC_RELEASE, "agent");
            asm volatile("s_waitcnt vmcnt(0)" ::: "memory");
            const unsigned og = xb_add(&bar[XB_TOP], 1u);
            const unsigned tg = og / nx;
            if (og + 1u == (tg + 1u) * nx) xb_add(&bar[XB_TOPGEN], 1u);
            else XB_SPIN(xb_ld(&bar[XB_TOPGEN]) == tg, bar);
            __builtin_amdgcn_fence(__ATOMIC_ACQUIRE, "agent");
            xb_add(&bar[XB_XGEN(b.x)], 1u);
            asm volatile("s_waitcnt vmcnt(0)" ::: "memory");
        } else {
            XB_SPIN(xb_ld(&bar[XB_XGEN(b.x)]) == gen, bar);
            __builtin_amdgcn_fence(__ATOMIC_ACQUIRE, "agent");
            asm volatile("s_waitcnt vmcnt(0)" ::: "memory");
        }
    }
    __syncthreads();
}
constexpr size_t MiB = 1u << 20;
constexpr int PMAX = 131072 + 32 * 256;
constexpr size_t W_CTL = 0, CTL_ZERO_BYTES = 64 * 1024;
constexpr size_t W_IN0 = 2 * MiB, W_GLU = 6 * MiB, W_OUT0 = 7 * MiB, W_IN1 = 9 * MiB, W_OUT1 = 16 * MiB;
constexpr size_t W_LUT = 18 * MiB, W_KM = W_LUT + 64 * 1024, W_HIST = W_KM + 256 * 1024, W_SORT = W_HIST + 64 * 1024  , W_BGU2 = 19 * MiB  , W_GR = 20 * MiB  , W_SS = 22 * MiB  ;
constexpr size_t W_GU = 32 * MiB, W_DN = 288 * MiB, W_XB = 416 * MiB  , W_XBB = 480 * MiB  , W_X8 = 1024 * MiB  , W_HB = 736 * MiB, W_YS5 = 928 * MiB, W_Y0 = 960 * MiB, W_MIXB = 1024 * MiB, W_GLAO = 1088 * MiB;
constexpr size_t W_ROUTE = 26 * MiB  , W_ACT = 736 * MiB  , W_YS = 1160 * MiB, W_END = 1432 * MiB;
static_assert(W_ACT + (size_t)PMAX * 2048 <= W_MIXB && W_YS + (size_t)PMAX * 2048 <= W_END && W_X8 + (size_t)PMAX * 1024 <= W_YS && W_ROUTE + 4 * MiB <= W_GU, "ws map");
constexpr int CW_BAR = 4096;

struct Args { const float* in[29]; float* out; unsigned char* ws; int ph_lo, ph_hi; };
struct Frame {
    LAS unsigned char* lds; int tid, lane, wave, vcu, G;
    const float* const* in; unsigned char* ws;
};
#define WSP(T_, off) ((T_*)(F.ws + (off)))

DEV unsigned pk4_fp8(float a, float b, float c, float d) { unsigned w = 0u; w = __builtin_amdgcn_cvt_pk_fp8_f32(a, b, w, false); w = __builtin_amdgcn_cvt_pk_fp8_f32(c, d, w, true); return w; }
struct CvItem { const float* src; unsigned char* dst; int pitch, K; float sc; };
constexpr int P0_I_GU = 8 * 8, P0_I_DN = 8 * 4, P0_I_IN0 = 8 * 8, P0_I_GLU = 4 * 2, P0_I_O = 8 * 4, P0_I_IN1 = 8 * 12;
constexpr int P0_N_GU = 64 * P0_I_GU, P0_N_DN = 64 * P0_I_DN, P0_NITEMS = P0_N_GU + P0_N_DN + P0_I_IN0 + P0_I_GLU + 2 * P0_I_O + P0_I_IN1;
DEV CvItem cv_decode(Frame& F, int it) {
    int r = it; const float* W; unsigned char* D; int K, N, NP, es; float sc = 0.f;
    if (r < P0_N_GU) { const int m = r / P0_I_GU; r %= P0_I_GU; W = F.in[25] + (size_t)m * 1024 * 2048; D = WSP(unsigned char, W_GU) + (size_t)m * 2048 * 1024; K = 1024; N = 2048; NP = 2048; es = 1; sc = 64.f; }
    else if ((r -= P0_N_GU) < P0_N_DN) { const int m = r / P0_I_DN; r %= P0_I_DN; W = F.in[27] + (size_t)m * 1024 * 1024; D = WSP(unsigned char, W_DN) + (size_t)m * 1024 * 1024; K = 1024; N = 1024; NP = 1024; es = 1; sc = 128.f; }
    else if ((r -= P0_N_DN) < P0_I_IN0) { W = F.in[1]; D = WSP(unsigned char, W_IN0); K = 1024; N = 2048; NP = 2048; es = 2; }
    else if ((r -= P0_I_IN0) < P0_I_GLU) { W = F.in[10]; D = WSP(unsigned char, W_GLU); K = 512; N = 512; NP = 512; es = 2; }
    else if ((r -= P0_I_GLU) < P0_I_O) { W = F.in[13]; D = WSP(unsigned char, W_OUT0); K = 1024; N = 1024; NP = 1024; es = 2; }
    else if ((r -= P0_I_O) < P0_I_O) { W = F.in[18]; D = WSP(unsigned char, W_OUT1); K = 1024; N = 1024; NP = 1024; es = 2; }
    else { r -= P0_I_O; W = F.in[14]; D = WSP(unsigned char, W_IN1); K = 1024; N = 3072; NP = 3088; es = 2; }
    const int nblk = N / 256, kb = r / nblk, nb = r % nblk;
    CvItem c; c.src = W + (size_t)(128 * kb) * NP + 256 * nb; c.dst = D + ((size_t)(256 * nb) * K + 128 * kb) * es; c.pitch = NP; c.K = K; c.sc = sc; return c;
}
DEV void cv_load(const CvItem& c, f32x4 (&v)[16], int tid) {
#pragma unroll
    for (int i = 0; i < 16; ++i) v[i] = *(const f32x4*)(c.src + (size_t)(8 * i + (tid >> 6)) * c.pitch + 4 * (tid & 63));
}
DEV void cv_store(const CvItem& c, const f32x4 (&v)[16], LAS float* T_, int tid) {
#pragma unroll
    for (int i = 0; i < 16; ++i) *(LAS f32x4*)(T_ + (8 * i + (tid >> 6)) * 260 + 4 * (tid & 63)) = v[i];
    __syncthreads();
    const int n = tid & 255, kh = tid >> 8; const LAS float* s = T_ + (64 * kh) * 260 + n;
    if (c.sc > 0.f) { const float q = c.sc; unsigned char* d = c.dst + (size_t)n * c.K + 64 * kh;
#pragma unroll
        for (int g = 0; g < 4; ++g) { u32x4 o;
            o.x = pk4_fp8(s[(16 * g + 0) * 260] * q, s[(16 * g + 1) * 260] * q, s[(16 * g + 2) * 260] * q, s[(16 * g + 3) * 260] * q); o.y = pk4_fp8(s[(16 * g + 4) * 260] * q, s[(16 * g + 5) * 260] * q, s[(16 * g + 6) * 260] * q, s[(16 * g + 7) * 260] * q);
            o.z = pk4_fp8(s[(16 * g + 8) * 260] * q, s[(16 * g + 9) * 260] * q, s[(16 * g + 10) * 260] * q, s[(16 * g + 11) * 260] * q); o.w = pk4_fp8(s[(16 * g + 12) * 260] * q, s[(16 * g + 13) * 260] * q, s[(16 * g + 14) * 260] * q, s[(16 * g + 15) * 260] * q);
            st_wt(d + 16 * g, o); }
    } else { unsigned char* d = c.dst + ((size_t)n * c.K + 64 * kh) * 2;
#pragma unroll
        for (int g = 0; g < 8; ++g) { u32x4 o; o.x = cvt_pk(s[(8 * g + 0) * 260], s[(8 * g + 1) * 260]); o.y = cvt_pk(s[(8 * g + 2) * 260], s[(8 * g + 3) * 260]); o.z = cvt_pk(s[(8 * g + 4) * 260], s[(8 * g + 5) * 260]); o.w = cvt_pk(s[(8 * g + 6) * 260], s[(8 * g + 7) * 260]);
            st_wt(d + 16 * g, o); }
    }
    __syncthreads();
}
__constant__ int BUCKET_TH2[16] = {16, 22, 30, 40, 54, 73, 99, 134, 182, 246, 332, 450, 609, 825, 1117, 1513};
DEV void p0_prologue(Frame& F) {
    { LAS float* T_ = (LAS float*)F.lds; f32x4 va[16], vb[16];
      int it = F.vcu;
      if (it < P0_NITEMS) { CvItem ca = cv_decode(F, it); cv_load(ca, va, F.tid);
#pragma unroll 1
          for (;;) {
              const int it2 = it + F.G; CvItem cb = ca; const bool h2 = it2 < P0_NITEMS; if (h2) { cb = cv_decode(F, it2); cv_load(cb, vb, F.tid); }
              cv_store(ca, va, T_, F.tid);
              if (!h2) break;
              const int it3 = it2 + F.G; const bool h3 = it3 < P0_NITEMS; if (h3) { ca = cv_decode(F, it3); cv_load(ca, va, F.tid); }
              cv_store(cb, vb, T_, F.tid);
              if (!h3) break;
              it = it3;
          } } }
    const int gt = F.vcu * 512 + F.tid, NGT = F.G * 512;
    for (int i = gt; i < 16 * 1024; i += NGT) { const int n = i >> 10, k = i & 1023; WSP(bf16_t, W_IN1)[(size_t)(3072 + n) * 1024 + k] = (bf16_t)(cvt_pk(F.in[14][(size_t)k * 3088 + 3072 + n], 0.f) & 0xffffu); }
    { const f32x4* x4 = (const f32x4*)F.in[0]; u32x2* o = WSP(u32x2, W_XB);
      for (size_t i = gt; i < (size_t)T * 1024 / 4; i += (size_t)NGT * 8) { f32x4 v[8];
#pragma unroll
          for (int u = 0; u < 8; ++u) v[u] = x4[i + (size_t)u * NGT];
#pragma unroll
          for (int u = 0; u < 8; ++u) { u32x2 w; w.x = cvt_pk(v[u].x, v[u].y); w.y = cvt_pk(v[u].z, v[u].w); st_wt(o + i + (size_t)u * NGT, w); } } }
    for (int i = gt; i < 2 * 32 * 2048 / 4; i += NGT) { const f32x4 v = ((const f32x4*)F.in[26])[i]; WSP(f32x4, W_BGU2)[i] = (f32x4){v.x, v.z, 4.f * (v.y + 1.f), 4.f * (v.w + 1.f)}; }
    for (int i = gt; i < 8 * 2048; i += NGT) { const int h = i >> 11, n = i & 2047; int bk = n;
        if (n >= 16) { bk = 16;
#pragma unroll
            for (int q = 1; q < 16; ++q) bk += (n >= BUCKET_TH2[q]) ? 1 : 0; }
        WSP(float, W_LUT)[i] = F.in[12][bk * 8 + h] * 1.4426950408889634f; }
}

DEV void p_kmean(Frame& F) {
    const int gw = F.vcu * 8 + F.wave, NGW = F.G * 8; const bf16_t* H0 = WSP(bf16_t, W_HB); float* KM = WSP(float, W_KM);
    for (int it = gw; it < 1024; it += NGW) { const int blk = it & 7, h = (it >> 3) & 7, b = it >> 6; const int r8 = F.lane >> 3, c = F.lane & 7;
        const bf16_t* p = H0 + (size_t)(b * 2048 + blk * 256 + r8) * 2048 + 1024 + h * 64 + c * 8; float s[8];
#pragma unroll
        for (int j = 0; j < 8; ++j) s[j] = 0.f;
#pragma unroll 8
        for (int i = 0; i < 32; ++i) { const u32x4 v = *(const u32x4*)(p + (size_t)i * 8 * 2048);
            s[0] += bflo(v.x); s[1] += bfhi(v.x); s[2] += bflo(v.y); s[3] += bfhi(v.y); s[4] += bflo(v.z); s[5] += bfhi(v.z); s[6] += bflo(v.w); s[7] += bfhi(v.w); }
#pragma unroll
        for (int j = 0; j < 8; ++j) { s[j] += __shfl_xor(s[j], 8); s[j] += __shfl_xor(s[j], 16); s[j] += __shfl_xor(s[j], 32); }
        if (F.lane < 8) {
#pragma unroll
            for (int j = 0; j < 8; ++j) KM[(size_t)it * 64 + c * 8 + j] = s[j] * (1.f / 256.f); } }
}

DEV void s5_item(Frame& F, int b, int g, LAS unsigned char* sl  ) {
    const int lane = F.lane, p0 = lane & 31, hi = lane >> 5, q4 = lane >> 4;
    const float* lam_re = F.in[2]; const float* lam_im = F.in[3]; const float* log_dt = F.in[4]; const float* b_re = F.in[5]; const float* b_im = F.in[6];
    const float* c_re = F.in[7]; const float* c_im = F.in[8]; const float* dsk = F.in[9];
    const bf16_t* H0 = WSP(bf16_t, W_HB); bf16_t* YS = WSP(bf16_t, W_YS5);
    const float dt = __expf(log_dt[g]);
    float ar[2], ai[2]; bf16x8 bfr[4];
#pragma unroll
    for (int s = 0; s < 2; ++s) { const int p = p0 + 32 * s; const float lr = lam_re[g * 64 + p], li = lam_im[g * 64 + p]; const float mag = __expf(lr * dt);
        ar[s] = mag * cosf(li * dt); ai[s] = mag * sinf(li * dt);
        const float er = ar[s] - 1.f, ei = ai[s], den = lr * lr + li * li; const float qr = (er * lr + ei * li) / den, qi = (ei * lr - er * li) / den;
        u32x4 wr_, wi_; float vr[8], vi[8];
#pragma unroll
        for (int j = 0; j < 8; ++j) { const float br = b_re[(g * 64 + p) * 16 + 8 * hi + j], bi = b_im[(g * 64 + p) * 16 + 8 * hi + j]; vr[j] = qr * br - qi * bi; vi[j] = qr * bi + qi * br; }
        wr_.x = cvt_pk(vr[0], vr[1]); wr_.y = cvt_pk(vr[2], vr[3]); wr_.z = cvt_pk(vr[4], vr[5]); wr_.w = cvt_pk(vr[6], vr[7]);
        wi_.x = cvt_pk(vi[0], vi[1]); wi_.y = cvt_pk(vi[2], vi[3]); wi_.z = cvt_pk(vi[4], vi[5]); wi_.w = cvt_pk(vi[6], vi[7]);
        bfr[2 * s] = __builtin_bit_cast(bf16x8, wr_); bfr[2 * s + 1] = __builtin_bit_cast(bf16x8, wi_); }
    bf16x8 cfr[4];
#pragma unroll
    for (int ks = 0; ks < 4; ++ks) { float v[8];
#pragma unroll
        for (int j = 0; j < 8; ++j) { const int c = 32 * ks + 8 * q4 + j, p = c >> 1; const int h = lane & 15; v[j] = (c & 1) ? -c_im[(g * 16 + h) * 64 + p] : c_re[(g * 16 + h) * 64 + p]; }
        u32x4 w; w.x = cvt_pk(v[0], v[1]); w.y = cvt_pk(v[2], v[3]); w.z = cvt_pk(v[4], v[5]); w.w = cvt_pk(v[6], v[7]); cfr[ks] = __builtin_bit_cast(bf16x8, w); }
    float dv[4];
#pragma unroll
    for (int r = 0; r < 4; ++r) dv[r] = dsk[g * 16 + 4 * q4 + r];
    const int tm = 16 * ((p0 >> 2) & 1) + 4 * (p0 >> 3) + (p0 & 3);
    const bf16_t* urow = H0 + (size_t)(b * 2048 + tm) * 2048 + g * 16 + 8 * hi;
    float cr[2] = {0.f, 0.f}, ci[2] = {0.f, 0.f};
    bf16x8 ufr = *(const bf16x8*)urow;
    for (int tile = 0; tile < 64; ++tile) {
        const bf16x8 ucur = ufr;
        if (tile + 1 < 64) ufr = *(const bf16x8*)(urow + (size_t)(tile + 1) * 32 * 2048);
        f32x16 x[4];
#pragma unroll
        for (int n = 0; n < 4; ++n) { f32x16 z;
#pragma unroll
            for (int r = 0; r < 16; ++r) z[r] = 0.f;
            x[n] = __builtin_amdgcn_mfma_f32_32x32x16_bf16(ucur, bfr[n], z, 0, 0, 0); }
#pragma unroll
        for (int s = 0; s < 2; ++s) {
            f32x16& xr = x[2 * s]; f32x16& xi = x[2 * s + 1];
            float sr = hi ? 0.f : cr[s], si = hi ? 0.f : ci[s];
#pragma unroll
            for (int r = 0; r < 16; ++r) { const float nr = ar[s] * sr - ai[s] * si + xr[r], ni = ar[s] * si + ai[s] * sr + xi[r]; xr[r] = nr; xi[r] = ni; sr = nr; si = ni; }
            const float o_r = swap32(sr), o_i = swap32(si);
            float wr_ = hi ? o_r : 0.f, wi_ = hi ? o_i : 0.f;
#pragma unroll
            for (int r = 0; r < 16; ++r) { const float nr = ar[s] * wr_ - ai[s] * wi_, ni = ar[s] * wi_ + ai[s] * wr_; wr_ = nr; wi_ = ni; xr[r] += wr_; xi[r] += wi_; }
            const float e_r = swap32(xr[15]), e_i = swap32(xi[15]);
            cr[s] = hi ? xr[15] : e_r; ci[s] = hi ? xi[15] : e_i;
#pragma unroll
            for (int r = 0; r < 16; ++r) *(LAS unsigned*)(sl + (16 * hi + r) * 256 + (p0 + 32 * s) * 4) = cvt_pk(xr[r], xi[r]);
        }
#pragma unroll
        for (int tt = 0; tt < 2; ++tt) {
            f32x4 y = {0.f, 0.f, 0.f, 0.f};
#pragma unroll
            for (int ks = 0; ks < 4; ++ks) { const bf16x8 sf = *(const LAS bf16x8*)(sl + (16 * tt + (lane & 15)) * 256 + ks * 64 + q4 * 16); y = __builtin_amdgcn_mfma_f32_16x16x32_bf16(cfr[ks], sf, y, 0, 0, 0); }
            const int t = tile * 32 + 16 * tt + (lane & 15);
            const u32x2 uw = *(const u32x2*)(H0 + (size_t)(b * 2048 + t) * 2048 + g * 16 + 4 * q4);
            const float y0 = gelu_tanh(y[0] + dv[0] * bflo(uw.x)), y1 = gelu_tanh(y[1] + dv[1] * bfhi(uw.x)), y2 = gelu_tanh(y[2] + dv[2] * bflo(uw.y)), y3 = gelu_tanh(y[3] + dv[3] * bfhi(uw.y));
            u32x2 ow; ow.x = cvt_pk(y0, y1); ow.y = cvt_pk(y2, y3);
            *(u32x2*)(YS + (size_t)(b * 2048 + t) * 512 + g * 16 + 4 * q4) = ow;
        }
    }
}

constexpr int AT_K = 0, AT_V = 24576, AT_WS = 49152, AT_OST = 51200, AT_LUT = AT_OST + 8 * 4096  , AT_LUTB = 8704, AT_Q = AT_LUT + 8 * AT_LUTB  , AT_END = AT_Q + 64;
DEV int crow(int r, int hi) { return (r & 3) + 8 * (r >> 2) + 4 * hi; }
DEV s16x4 vtr(const LAS unsigned char* p) { typedef short v4i16_t __attribute__((ext_vector_type(4))); return __builtin_bit_cast(s16x4, __builtin_amdgcn_ds_read_tr16_b64_v4i16((LAS v4i16_t*)p)); }
DEV void moba_unit(Frame& F, int b, int h, int own) {
    const int lane = F.lane, wid = F.wave, r32 = lane & 31, hi = lane >> 5;
    LAS unsigned char* lds = F.lds;
    const bf16_t* H0 = WSP(bf16_t, W_HB); const float* KM = WSP(float, W_KM);
    LAS float* lut = (LAS float*)(lds + AT_LUT + h * AT_LUTB); LAS float* wsf = (LAS float*)(lds + AT_WS) + wid * 64;
    const size_t rowbase = (size_t)b * 2048;
    const int qpos = own * 256 + wid * 32 + r32;
    bf16x8 qr[4];
#pragma unroll
    for (int d0 = 0; d0 < 4; ++d0) qr[d0] = *(const bf16x8*)(H0 + (rowbase + qpos) * 2048 + 512 + h * 64 + d0 * 16 + hi * 8);
    unsigned selmask = 0u;
    if (own > 0) {
        float gate[7];
#pragma unroll
        for (int j = 0; j < 7; ++j) { float s = 0.f;
            if (j < own) { const float* km = KM + ((size_t)(b * 8 + h) * 8 + j) * 64 + hi * 8;
#pragma unroll
                for (int d0 = 0; d0 < 4; ++d0) { const f32x4 k0 = *(const f32x4*)(km + d0 * 16), k1 = *(const f32x4*)(km + d0 * 16 + 4); const u32x4 qw = __builtin_bit_cast(u32x4, qr[d0]);
                    s += bflo(qw.x) * k0.x + bfhi(qw.x) * k0.y + bflo(qw.y) * k0.z + bfhi(qw.y) * k0.w + bflo(qw.z) * k1.x + bfhi(qw.z) * k1.y + bflo(qw.w) * k1.z + bfhi(qw.w) * k1.w; } }
            gate[j] = s + swap32(s); }
#pragma unroll
        for (int j = 0; j < 7; ++j) { int rank = 0;
#pragma unroll
            for (int j2 = 0; j2 < 7; ++j2) if (j2 != j && j2 < own && (gate[j2] > gate[j] || (gate[j2] == gate[j] && j2 < j))) ++rank;
            if (j < own && rank < 3) selmask |= 1u << j; }
    }
    const int NT = 4 * (own + 1);
#define KV0(i) ((i) < 4 ? own * 256 + (i) * 64 : (((i) - 4) >> 2) * 256 + (((i) - 4) & 3) * 64)
    const bf16_t* kbase = H0 + (rowbase + lane) * 2048 + 1024 + h * 64 + wid * 8;
    const bf16_t* vbase = H0 + (rowbase + 16 * (wid & 3) + (lane >> 2)) * 2048 + 1536 + h * 64 + (wid >> 2) * 32 + (lane & 3) * 8;
#define LOADKV(i, bo_) do { const int kv0_ = KV0(i); \
        __builtin_amdgcn_global_load_lds((const unsigned*)(kbase + (size_t)kv0_ * 2048), (LAS unsigned*)(lds + AT_K + bo_ + wid * 1024), 16, 0, 0); \
        __builtin_amdgcn_global_load_lds((const unsigned*)(vbase + (size_t)kv0_ * 2048), (LAS unsigned*)(lds + AT_V + bo_ + wid * 1024), 16, 0, 0); } while (0)
    LOADKV(0, 0); LOADKV(1, 8192);
    int bo = 0, bo2 = 16384;
    float m_ref = 0.f, l_run = 0.f; f32x16 o[2];
#pragma unroll
    for (int r = 0; r < 16; ++r) { o[0][r] = 0.f; o[1][r] = 0.f; }
    const int Q0 = own * 256 + wid * 32;
#pragma unroll 1
    for (int i = 0; i < NT; ++i) {
        if (i + 1 < NT) asm volatile("s_waitcnt vmcnt(2) lgkmcnt(0)\n\ts_barrier" ::: "memory"); else asm volatile("s_waitcnt vmcnt(0) lgkmcnt(0)\n\ts_barrier" ::: "memory");
        if (i + 2 < NT) LOADKV(i + 2, bo2);
        const int kv0 = KV0(i);
        const bool ownblk = i < 4;
        if (!(ownblk && kv0 > Q0 + 31)) {
            const bool partial = ownblk && (kv0 + 63 > Q0);
            const bool rowsel = ownblk || ((selmask >> ((i - 4) >> 2)) & 1u);
            f32x16 p0, p1;
            { const LAS float* lp = lut + 128 + (qpos - kv0 - 4 * hi - 59);
#pragma unroll
              for (int r = 0; r < 16; ++r) { const int c = (r & 3) + 8 * (r >> 2); p0[r] = lp[59 - c] - m_ref; p1[r] = lp[59 - c - 32] - m_ref; } }
            { const LAS unsigned char* kb = lds + AT_K + bo + hi * 1024 + r32 * 16;
#pragma unroll
              for (int d0 = 0; d0 < 4; ++d0) { const bf16x8 k0 = *(const LAS bf16x8*)(kb + d0 * 2048), k1 = *(const LAS bf16x8*)(kb + d0 * 2048 + 512);
                  p0 = __builtin_amdgcn_mfma_f32_32x32x16_bf16(k0, qr[d0], p0, 0, 0, 0); p1 = __builtin_amdgcn_mfma_f32_32x32x16_bf16(k1, qr[d0], p1, 0, 0, 0); } }
            if (partial) { const int dbase = qpos - kv0 - 4 * hi;
#pragma unroll
                for (int r = 0; r < 16; ++r) { const int d0_ = dbase - ((r & 3) + 8 * (r >> 2)); p0[r] = d0_ >= 0 ? p0[r] : -INFINITY; p1[r] = d0_ >= 32 ? p1[r] : -INFINITY; } }
            float rmax = fmaxf(p0[0], p1[0]);
#pragma unroll
            for (int r = 1; r < 16; ++r) rmax = fmaxf(rmax, fmaxf(p0[r], p1[r]));
            rmax = fmaxf(rmax, swap32(rmax));
            rmax = rowsel ? rmax : -INFINITY;
            if (i == 0 || __any(rmax > 8.f)) {
                const float dl = (i == 0) ? rmax : fmaxf(rmax, 0.f); m_ref += dl;
#pragma unroll
                for (int r = 0; r < 16; ++r) { p0[r] -= dl; p1[r] -= dl; }
                const float alpha = __builtin_amdgcn_exp2f(-dl); l_run *= alpha;
                if (hi == 0) wsf[r32] = alpha;
#pragma unroll
                for (int r = 0; r < 16; ++r) { const float f = wsf[crow(r, hi)]; o[0][r] *= f; o[1][r] *= f; }
            }
            float rs = 0.f;
#pragma unroll
            for (int r = 0; r < 16; ++r) { p0[r] = __builtin_amdgcn_exp2f(p0[r]); p1[r] = __builtin_amdgcn_exp2f(p1[r]); rs += p0[r] + p1[r]; }
            l_run += rowsel ? rs : 0.f;
            const unsigned km = rowsel ? 0xffffffffu : 0u;
            u32x4 pw[4];
            pw[0] = (u32x4){cvt_pk(p0[0], p0[1]) & km, cvt_pk(p0[2], p0[3]) & km, cvt_pk(p0[4], p0[5]) & km, cvt_pk(p0[6], p0[7]) & km};
            pw[1] = (u32x4){cvt_pk(p0[8], p0[9]) & km, cvt_pk(p0[10], p0[11]) & km, cvt_pk(p0[12], p0[13]) & km, cvt_pk(p0[14], p0[15]) & km};
            pw[2] = (u32x4){cvt_pk(p1[0], p1[1]) & km, cvt_pk(p1[2], p1[3]) & km, cvt_pk(p1[4], p1[5]) & km, cvt_pk(p1[6], p1[7]) & km};
            pw[3] = (u32x4){cvt_pk(p1[8], p1[9]) & km, cvt_pk(p1[10], p1[11]) & km, cvt_pk(p1[12], p1[13]) & km, cvt_pk(p1[14], p1[15]) & km};
            { const LAS unsigned char* vp = lds + AT_V + bo + ((lane >> 4) & 1) * 32 + (lane & 3) * 8 + (4 * hi + ((lane & 15) >> 2)) * 64;
#pragma unroll
              for (int d0 = 0; d0 < 2; ++d0)
#pragma unroll
                  for (int ks = 0; ks < 4; ++ks) { const s16x4 lo = vtr(vp + d0 * 4096 + ks * 1024), hh = vtr(vp + d0 * 4096 + ks * 1024 + 512);
                      const bf16x8 vf = (bf16x8){lo[0], lo[1], lo[2], lo[3], hh[0], hh[1], hh[2], hh[3]};
                      o[d0] = __builtin_amdgcn_mfma_f32_32x32x16_bf16(__builtin_bit_cast(bf16x8, pw[ks]), vf, o[d0], 0, 0, 0); } }
        }
        bo = (bo == 16384) ? 0 : bo + 8192; bo2 = (bo2 == 16384) ? 0 : bo2 + 8192;
    }
    __syncthreads();
#undef KV0
#undef LOADKV
    l_run += swap32(l_run);
    if (hi == 0) wsf[32 + r32] = 1.f / l_run;
    bf16_t* Ow = WSP(bf16_t, W_Y0) + (rowbase + own * 256 + wid * 32) * 1024 + 512 + h * 64;
    LAS bf16_t* stg = (LAS bf16_t*)(lds + AT_OST) + wid * 2048;
#pragma unroll
    for (int r = 0; r < 16; ++r) { const int orow = crow(r, hi); const float rl = wsf[32 + orow];
        stg[orow * 64 + r32] = (bf16_t)(cvt_pk(o[0][r] * rl, 0.f) & 0xffffu); stg[orow * 64 + 32 + r32] = (bf16_t)(cvt_pk(o[1][r] * rl, 0.f) & 0xffffu); }
#pragma unroll
    for (int i = 0; i < 4; ++i) { const int row = i * 8 + (lane >> 3), ch = lane & 7; const u32x4 v = *(const LAS u32x4*)(stg + row * 64 + ch * 8); *(u32x4*)(Ow + (size_t)row * 1024 + ch * 8) = v; }
    __syncthreads();
}
constexpr int CW_MOBAQ = 64;
DEV void p_s5_moba(Frame& F, int mode) {
    if ((mode & 1) && (F.vcu & 3) == 3) { const int it = (F.vcu >> 2) * 8 + F.wave; if (it < 512) s5_item(F, it >> 5, it & 31, F.lds + 65536 + F.wave * 8192); }
    __syncthreads();
    if (!(mode & 2)) return;
    for (int i = F.tid; i < 8 * 2176; i += 512) { const int hh = i / 2176, j = i % 2176; ((LAS float*)(F.lds + AT_LUT))[i] = j < 128 ? 0.f : WSP(float, W_LUT)[hh * 2048 + j - 128]; }
    volatile LAS int* qw = (volatile LAS int*)(F.lds + AT_Q);
    unsigned* ctl = (unsigned*)(F.ws + W_CTL);
    for (;;) {
        __syncthreads();
        if (F.tid == 0) qw[0] = (int)__hip_atomic_fetch_add(ctl + CW_MOBAQ, 1u, __ATOMIC_RELAXED, __HIP_MEMORY_SCOPE_AGENT);
        __syncthreads();
        const int u = __builtin_amdgcn_readfirstlane(qw[0]);
        if (u >= 1024) break;
        const int own = 7 - (u >> 7), bh = u & 127;
        moba_unit(F, bh >> 3, bh & 7, own);
    }
}
constexpr size_t R_RE = W_ROUTE, R_RW = W_ROUTE + 512 * 1024, R_POS = W_ROUTE + 1024 * 1024, R_TOK = W_ROUTE + 2 * MiB, R_WGT = W_ROUTE + 3 * MiB;
constexpr int WT_PITCH = 1028;
constexpr int RW_PITCH = 1032;
constexpr int LN_XT = 32 * RW_PITCH * 2;
constexpr int LN_LG = 147456;
constexpr int LN_HIST = LN_LG + 8 * 528;
static_assert(LN_XT + 8 * 8256 <= LDS_TOK && LN_HIST + 128 <= LDSCTL_OFF, "LN LDS map");
template <int MODE, bool ROUTER, bool XIN_F32, bool OUT_F32, bool GRP = false>
DEV void p_ln(Frame& F, const float* xin32, const bf16_t* xinb, bf16_t* xoutb, float* xout32, const float* gam, const float* bet, const float* wrt, const float* brt) {
    LAS bf16_t* whi = (LAS bf16_t*)F.lds; LAS bf16_t* xt = (LAS bf16_t*)(F.lds + LN_XT) + F.wave * 4128; LAS float* lgs = (LAS float*)(F.lds + LN_LG) + F.wave * 132; LAS int* hist = (LAS int*)(F.lds + LN_HIST);
    const int lane = F.lane, l15 = lane & 15, q4 = lane >> 4;
    if constexpr (ROUTER) {
        for (int i = F.tid; i < 1024 * 32; i += 512) { const int k = i >> 5, e = i & 31; whi[e * RW_PITCH + k] = (bf16_t)(cvt_pk(wrt[i], 0.f) & 0xffffu); }
        if (F.tid < 32) hist[F.tid] = 0;
        __syncthreads();
    }
    if constexpr (GRP) {
        const u32x4* src = (const u32x4*)(WSP(bf16_t, W_IN1) + (size_t)3072 * 1024);
        for (int i = F.tid; i < 16 * 128; i += 512) { const int e = i >> 7, c = i & 127; *(LAS u32x4*)(whi + e * RW_PITCH + c * 8) = src[i]; }
        __syncthreads();
    }
    const bf16_t* MIXB = WSP(bf16_t, W_MIXB); const unsigned char* YS8 = WSP(unsigned char, W_YS); const int* POS = WSP(int, R_POS);
    int* RE = WSP(int, R_RE); float* RW = WSP(float, R_RW);
    const float alpha = 1.4142135623730951f;
    f32x4 gq[4], bq[4];
#pragma unroll
    for (int j = 0; j < 4; ++j) { gq[j] = *(const f32x4*)(gam + j * 256 + lane * 4); bq[j] = *(const f32x4*)(bet + j * 256 + lane * 4); }
    float bias8[8];
    if constexpr (ROUTER) {
#pragma unroll
        for (int r = 0; r < 8; ++r) bias8[r] = brt[(r >> 2) * 16 + 4 * q4 + (r & 3)]; }
    for (int wgi = F.vcu; wgi < 256; wgi += F.G) {
        const int r0 = wgi * 128 + F.wave * 16;
        constexpr bool PF = (MODE == 0) && !XIN_F32;
        u32x2 rx[4][4], rm[4][4];
        if constexpr (PF) {
#pragma unroll
            for (int u = 0; u < 4; ++u)
#pragma unroll
                for (int j = 0; j < 4; ++j) { rx[u][j] = *(const u32x2*)(xinb + (size_t)(r0 + u) * 1024 + j * 256 + lane * 4); rm[u][j] = *(const u32x2*)(MIXB + (size_t)(r0 + u) * 1024 + j * 256 + lane * 4); } }
#pragma unroll 1
        for (int i4 = 0; i4 < 16; i4 += 4) {
            float v[4][16];
            if constexpr (PF) {
#pragma unroll
                for (int u = 0; u < 4; ++u)
#pragma unroll
                    for (int j = 0; j < 4; ++j) { v[u][4 * j] = alpha * bflo(rx[u][j].x) + bflo(rm[u][j].x); v[u][4 * j + 1] = alpha * bfhi(rx[u][j].x) + bfhi(rm[u][j].x); v[u][4 * j + 2] = alpha * bflo(rx[u][j].y) + bflo(rm[u][j].y); v[u][4 * j + 3] = alpha * bfhi(rx[u][j].y) + bfhi(rm[u][j].y); }
                if (i4 + 4 < 16) {
#pragma unroll
                    for (int u = 0; u < 4; ++u)
#pragma unroll
                        for (int j = 0; j < 4; ++j) { rx[u][j] = *(const u32x2*)(xinb + (size_t)(r0 + i4 + 4 + u) * 1024 + j * 256 + lane * 4); rm[u][j] = *(const u32x2*)(MIXB + (size_t)(r0 + i4 + 4 + u) * 1024 + j * 256 + lane * 4); } }
            } else {
#pragma unroll
            for (int u = 0; u < 4; ++u) { const int row = r0 + i4 + u;
                if constexpr (XIN_F32) {
#pragma unroll
                    for (int j = 0; j < 4; ++j) { const f32x4 a = *(const f32x4*)(xin32 + (size_t)row * 1024 + j * 256 + lane * 4); v[u][4 * j] = alpha * a.x; v[u][4 * j + 1] = alpha * a.y; v[u][4 * j + 2] = alpha * a.z; v[u][4 * j + 3] = alpha * a.w; }
                } else {
#pragma unroll
                    for (int j = 0; j < 4; ++j) { const u32x2 a = *(const u32x2*)(xinb + (size_t)row * 1024 + j * 256 + lane * 4); v[u][4 * j] = alpha * bflo(a.x); v[u][4 * j + 1] = alpha * bfhi(a.x); v[u][4 * j + 2] = alpha * bflo(a.y); v[u][4 * j + 3] = alpha * bfhi(a.y); }
                }
                if constexpr (MODE == 0) {
#pragma unroll
                    for (int j = 0; j < 4; ++j) { const u32x2 m = *(const u32x2*)(MIXB + (size_t)row * 1024 + j * 256 + lane * 4); v[u][4 * j] += bflo(m.x); v[u][4 * j + 1] += bfhi(m.x); v[u][4 * j + 2] += bflo(m.y); v[u][4 * j + 3] += bfhi(m.y); }
                } else {
                    const int4 pos4 = *(const int4*)(POS + row * 4);
                    const int ps[4] = {__builtin_amdgcn_readfirstlane(pos4.x), __builtin_amdgcn_readfirstlane(pos4.y), __builtin_amdgcn_readfirstlane(pos4.z), __builtin_amdgcn_readfirstlane(pos4.w)};
#pragma unroll
                    for (int kx = 0; kx < 4; ++kx)
#pragma unroll
                        for (int j = 0; j < 4; ++j) { const unsigned m = *(const unsigned*)(YS8 + (size_t)ps[kx] * 1024 + j * 256 + lane * 4); const f32x2 lo2 = __builtin_amdgcn_cvt_pk_f32_fp8(m, false), hi2 = __builtin_amdgcn_cvt_pk_f32_fp8(m, true);
                            v[u][4 * j] += lo2.x * (1.f / 64.f); v[u][4 * j + 1] += lo2.y * (1.f / 64.f); v[u][4 * j + 2] += hi2.x * (1.f / 64.f); v[u][4 * j + 3] += hi2.y * (1.f / 64.f); }
                }
            }
            }
            float s1[4], s2[4];
#pragma unroll
            for (int u = 0; u < 4; ++u) { s1[u] = 0.f; s2[u] = 0.f;
#pragma unroll
                for (int q = 0; q < 16; ++q) { s1[u] += v[u][q]; s2[u] = fmaf(v[u][q], v[u][q], s2[u]); } }
#pragma unroll
            for (int o = 1; o < 64; o <<= 1) {
#pragma unroll
                for (int u = 0; u < 4; ++u) { s1[u] += __shfl_xor(s1[u], o); s2[u] += __shfl_xor(s2[u], o); } }
#pragma unroll
            for (int u = 0; u < 4; ++u) { const int row = r0 + i4 + u; const float mean = s1[u] * (1.f / 1024.f); const float var = fmaxf(s2[u] * (1.f / 1024.f) - mean * mean, 0.f); const float rstd = 1.f / sqrtf(var + 1e-5f);
#pragma unroll
                for (int j = 0; j < 4; ++j) { const int c = j * 256 + lane * 4; const f32x4 g4 = gq[j], b4 = bq[j];
                    const float y0 = (v[u][4 * j] - mean) * rstd * g4.x + b4.x, y1 = (v[u][4 * j + 1] - mean) * rstd * g4.y + b4.y, y2 = (v[u][4 * j + 2] - mean) * rstd * g4.z + b4.z, y3 = (v[u][4 * j + 3] - mean) * rstd * g4.w + b4.w;
                    if constexpr (OUT_F32) st_wt(xout32 + (size_t)row * 1024 + c, (f32x4){y0, y1, y2, y3});
                    else { u32x2 w; w.x = cvt_pk(y0, y1); w.y = cvt_pk(y2, y3); st_wt(xoutb + (size_t)row * 1024 + c, w);
                        if constexpr (ROUTER || GRP) { *(LAS u32x2*)(xt + u * RW_PITCH + c) = w; } } } }
            if constexpr (GRP) {
                f32x4 ga = {0.f, 0.f, 0.f, 0.f};
#pragma unroll 8
                for (int ks = 0; ks < 32; ++ks) { const bf16x8 xb = *(const LAS bf16x8*)(xt + (l15 & 3) * RW_PITCH + ks * 32 + q4 * 8), wa = *(const LAS bf16x8*)(whi + l15 * RW_PITCH + ks * 32 + q4 * 8);
                    ga = __builtin_amdgcn_mfma_f32_16x16x32_bf16(wa, xb, ga, 0, 0, 0); }
                if (l15 < 4) *(f32x4*)(WSP(float, W_GR) + (size_t)(r0 + i4 + l15) * 16 + 4 * q4) = ga; }
            if constexpr (ROUTER) {
                f32x4 acc[2] = {{0.f, 0.f, 0.f, 0.f}, {0.f, 0.f, 0.f, 0.f}};
#pragma unroll 8
                for (int ks = 0; ks < 32; ++ks) { const bf16x8 xb = *(const LAS bf16x8*)(xt + (l15 & 3) * RW_PITCH + ks * 32 + q4 * 8);
#pragma unroll
                    for (int mt = 0; mt < 2; ++mt) { const bf16x8 wa = *(const LAS bf16x8*)(whi + (mt * 16 + l15) * RW_PITCH + ks * 32 + q4 * 8); acc[mt] = __builtin_amdgcn_mfma_f32_16x16x32_bf16(wa, xb, acc[mt], 0, 0, 0); } }
                if (l15 < 4) {
#pragma unroll
                    for (int mt = 0; mt < 2; ++mt)
#pragma unroll
                        for (int r = 0; r < 4; ++r) lgs[l15 * 33 + mt * 16 + 4 * q4 + r] = acc[mt][r] + bias8[mt * 4 + r]; }
                if (lane < 4) { float lg[32];
#pragma unroll
                    for (int e = 0; e < 32; ++e) lg[e] = lgs[lane * 33 + e];
                    unsigned taken = 0u; float tv[4]; int ti[4];
#pragma unroll
                    for (int r = 0; r < 4; ++r) { float best = -INFINITY; int bi = 0;
#pragma unroll
                        for (int e = 0; e < 32; ++e) { const bool ok = !((taken >> e) & 1u) && lg[e] > best; best = ok ? lg[e] : best; bi = ok ? e : bi; }
                        taken |= 1u << bi; tv[r] = best; ti[r] = bi; }
                    float ex[4], sm = 0.f;
#pragma unroll
                    for (int r = 0; r < 4; ++r) { ex[r] = __expf(tv[r] - tv[0]); sm += ex[r]; }
                    const float inv = 1.f / sm; const int row = r0 + i4 + lane;
                    *(int4*)(RE + row * 4) = make_int4(ti[0], ti[1], ti[2], ti[3]); *(f32x4*)(RW + row * 4) = (f32x4){ex[0] * inv, ex[1] * inv, ex[2] * inv, ex[3] * inv};
#pragma unroll
                    for (int r = 0; r < 4; ++r) atomicAdd((int*)(hist + ti[r]), 1); }
            }
        }
        if constexpr (ROUTER) { __syncthreads(); if (F.tid < 32) { WSP(int, W_HIST)[wgi * 32 + F.tid] = hist[F.tid]; hist[F.tid] = 0; } __syncthreads(); }
    }
}

DEV void p_sort(Frame& F) {
    LAS int* Ls = (LAS int*)F.lds; const int tid = F.tid;
    const int* HIST = WSP(int, W_HIST); int* SORT = WSP(int, W_SORT);
    const int* RE = WSP(int, R_RE); const float* RW = WSP(float, R_RW); int* POS = WSP(int, R_POS); int* TOK = WSP(int, R_TOK); float* WGT = WSP(float, R_WGT);
    for (int wgi = F.vcu; wgi < 256; wgi += F.G) {
        { const int e = tid & 31, part = tid >> 5; int tot = 0, pre = 0;
          for (int w = part * 16; w < part * 16 + 16; ++w) { const int hh = HIST[w * 32 + e]; tot += hh; pre += (w < wgi) ? hh : 0; }
          Ls[part * 32 + e] = tot; Ls[512 + part * 32 + e] = pre; }
        Ls[2048 + tid] = RE[wgi * 512 + tid];
        __syncthreads();
        if (tid < 32) { int tot = 0, pre = 0; for (int p = 0; p < 16; ++p) { tot += Ls[p * 32 + tid]; pre += Ls[512 + p * 32 + tid]; } Ls[1200 + tid] = tot; Ls[1300 + tid] = pre; }
        __syncthreads();
        if (tid == 0) { int a = 0; for (int e = 0; e < 32; ++e) { Ls[1024 + e] = a; a += (Ls[1200 + e] + 255) / 256 * 256; } Ls[1056] = a; }
        __syncthreads();
        { const int e = tid & 31, seg = tid >> 5; int cnt = 0;
#pragma unroll 8
          for (int i = 0; i < 32; ++i) cnt += (Ls[2048 + seg * 32 + i] == e) ? 1 : 0;
          Ls[3072 + seg * 32 + e] = cnt;
          __syncthreads();
          int c = Ls[1024 + e] + Ls[1300 + e];
          for (int s2 = 0; s2 < seg; ++s2) c += Ls[3072 + s2 * 32 + e];
#pragma unroll 8
          for (int i = 0; i < 32; ++i) if (Ls[2048 + seg * 32 + i] == e) { Ls[2560 + seg * 32 + i] = c; ++c; } }
        __syncthreads();
        { const int pos = Ls[2560 + tid]; TOK[pos] = wgi * 128 + (tid >> 2); WGT[pos] = RW[wgi * 512 + tid]; POS[wgi * 512 + tid] = pos; }
        { const bf16_t* XBBp = WSP(bf16_t, W_XBB); unsigned char* XS8 = WSP(unsigned char, W_X8);
          for (int rg = 0; rg < 16; rg += 4) {
              u32x4 a[4], b2[4];
#pragma unroll
              for (int u = 0; u < 4; ++u) { const int r = F.wave * 16 + rg + u; const u32x4* src = (const u32x4*)(XBBp + (size_t)(wgi * 128 + r) * 1024 + F.lane * 16); a[u] = src[0]; b2[u] = src[1]; }
#pragma unroll
              for (int u = 0; u < 4; ++u) { const int r = F.wave * 16 + rg + u;
                  u32x4 o; o.x = pk4_fp8(bflo(a[u].x) * 16.f, bfhi(a[u].x) * 16.f, bflo(a[u].y) * 16.f, bfhi(a[u].y) * 16.f); o.y = pk4_fp8(bflo(a[u].z) * 16.f, bfhi(a[u].z) * 16.f, bflo(a[u].w) * 16.f, bfhi(a[u].w) * 16.f);
                  o.z = pk4_fp8(bflo(b2[u].x) * 16.f, bfhi(b2[u].x) * 16.f, bflo(b2[u].y) * 16.f, bfhi(b2[u].y) * 16.f); o.w = pk4_fp8(bflo(b2[u].z) * 16.f, bfhi(b2[u].z) * 16.f, bflo(b2[u].w) * 16.f, bfhi(b2[u].w) * 16.f);
#pragma unroll
                  for (int kx = 0; kx < 4; ++kx) { const int pos = Ls[2560 + r * 4 + kx]; st_wt(XS8 + (size_t)pos * 1024 + F.lane * 16, o); } } }
          if (wgi < 32) { const int e = wgi; for (int r = Ls[1024 + e] + Ls[1200 + e] + F.wave; r < Ls[1024 + e + 1]; r += 8) st_wt(XS8 + (size_t)r * 1024 + F.lane * 16, (u32x4){0u, 0u, 0u, 0u}); } }
        if (wgi < 32) { const int e = wgi; for (int r = Ls[1024 + e] + Ls[1200 + e] + tid; r < Ls[1024 + e + 1]; r += 512) { TOK[r] = 0; WGT[r] = 0.f; } }
        if (wgi == 0) { if (tid < 33) SORT[tid] = Ls[1024 + tid]; if (tid == 0) SORT[33] = Ls[1056] / 256;
            for (int pm = tid; pm < PMAX / 256; pm += 512) { int e = 0; for (int j = 1; j < 32; ++j) if (pm * 256 >= Ls[1024 + j]) e = j; SORT[64 + pm] = e; } }
        __syncthreads();
    }
}

DEV void p_gr(Frame& F) {
    const int gw = F.vcu * 8 + F.wave, NGW = F.G * 8, lane = F.lane, q4 = lane >> 4; const bf16_t* XB = WSP(bf16_t, W_XB); const bf16_t* Wg = WSP(bf16_t, W_IN1) + (size_t)3072 * 1024; float* GR = WSP(float, W_GR);
    for (int it = gw; it < T / 16; it += NGW) { f32x4 acc = {0.f, 0.f, 0.f, 0.f};
        const bf16_t* ap = XB + (size_t)(it * 16 + (lane & 15)) * 1024 + q4 * 8; const bf16_t* bp = Wg + (size_t)(lane & 15) * 1024 + q4 * 8;
        bf16x8 a[32], bb[32];
#pragma unroll
        for (int ks = 0; ks < 32; ++ks) { a[ks] = *(const bf16x8*)(ap + ks * 32); bb[ks] = *(const bf16x8*)(bp + ks * 32); }
#pragma unroll
        for (int ks = 0; ks < 32; ++ks) acc = __builtin_amdgcn_mfma_f32_16x16x32_bf16(a[ks], bb[ks], acc, 0, 0, 0);
#pragma unroll
        for (int r = 0; r < 4; ++r) GR[(size_t)(it * 16 + 4 * q4 + r) * 16 + (lane & 15)] = acc[r]; }
}

constexpr int GP = 264, GP2 = 144;
constexpr int GB_QIN = 0, GB_KST = 16896, GB_ATT = 35328, GB_DEC = 44544, GB_VT = 45056, GB_SIZE = 81920;
constexpr size_t W_GB = W_YS;
static_assert((size_t)2048 * GB_SIZE <= (size_t)PMAX * 2048, "blob region");
constexpr int GA_GRS = 0, GA_GT = 4096, GA_BL = 8192  , GA_QIN = GA_BL + GB_QIN, GA_KST = GA_BL + GB_KST, GA_ATT = GA_BL + GB_ATT, GA_DEC = GA_BL + GB_DEC, GA_KIN = GA_BL + 45056  , GA_VT = GA_KIN + 17408, GA_END = GA_VT + 36864;
DEV float logsigm_fast(float z) { const float e = __builtin_amdgcn_exp2f(-1.4426950408889634f * fabsf(z)); return fminf(z, 0.f) - 0.6931471805599453f * __builtin_amdgcn_logf(1.f + e); }
struct GlaRaw { unsigned q[16], k[16], v[32]; f32x4 ga, gb; };
DEV void p_gla_prep(Frame& F) {
    LAS unsigned char* lds = F.lds; const int tid = F.tid, lane = F.lane, wid = F.wave, q4 = lane >> 4, l15 = lane & 15;
    const bf16_t* H1 = WSP(bf16_t, W_HB); const float* GR = WSP(float, W_GR); unsigned char* GB = F.ws + W_GB;
    const float* wg2 = F.in[15]; const float* bg = F.in[16];
    for (int i = tid; i < 64 * GP2 / 4; i += 512) ((LAS unsigned*)(lds + GA_ATT))[i] = 0u;
    const int dk = 32 * (wid & 3) + (lane & 31), tg = 2 * (wid >> 2) + (lane >> 5);
    const int dvl = tid & 255, th2 = tid >> 8;
    const int tzm = 16 * (((lane & 31) >> 2) & 1) + 4 * ((lane & 31) >> 3) + (lane & 3);
    for (int wg = F.vcu; wg < 256; wg += F.G) {
        const int b = wg >> 4, h = (wg >> 2) & 3, n0 = (wg & 3) * 8;
        bf16x8 w2f; { float wv[8];
#pragma unroll
          for (int j = 0; j < 8; ++j) wv[j] = wg2[(8 * (lane >> 5) + j) * 512 + h * 128 + dk];
          const u32x4 ww = {cvt_pk(wv[0], wv[1]), cvt_pk(wv[2], wv[3]), cvt_pk(wv[4], wv[5]), cvt_pk(wv[6], wv[7])}; w2f = __builtin_bit_cast(bf16x8, ww); }
        const float bgv = bg[h * 128 + dk];
#define GLA_LOAD(R, n_) do { const size_t rb_ = (size_t)b * 2048 + (n_) * 64; \
        _Pragma("unroll") for (int i = 0; i < 16; ++i) { const size_t ro = (rb_ + 16 * tg + i) * 3072; R.q[i] = H1[ro + h * 128 + dk]; R.k[i] = H1[ro + 512 + h * 128 + dk]; } \
        _Pragma("unroll") for (int i = 0; i < 32; ++i) R.v[i] = H1[(rb_ + 32 * th2 + i) * 3072 + 1024 + h * 256 + dvl]; \
        { const float* gp_ = GR + (rb_ + 32 * (wid >> 2) + tzm) * 16 + 8 * (lane >> 5); R.ga = *(const f32x4*)gp_; R.gb = *(const f32x4*)(gp_ + 4); } } while (0)
        GlaRaw cur, nxt; GLA_LOAD(cur, n0); nxt = cur;
#pragma unroll 1
      for (int sub = 0; sub < 8; ++sub) { const int n = n0 + sub;
        if (sub + 1 < 8) GLA_LOAD(nxt, n + 1);
        float cs[16]; float run = 0.f;
        { const u32x4 aw = {cvt_pk(cur.ga.x, cur.ga.y), cvt_pk(cur.ga.z, cur.ga.w), cvt_pk(cur.gb.x, cur.gb.y), cvt_pk(cur.gb.z, cur.gb.w)};
          f32x16 zz;
#pragma unroll
          for (int r = 0; r < 16; ++r) zz[r] = bgv;
          zz = __builtin_amdgcn_mfma_f32_32x32x16_bf16(__builtin_bit_cast(bf16x8, aw), w2f, zz, 0, 0, 0);
#pragma unroll
          for (int i = 0; i < 16; ++i) { run += logsigm_fast(zz[i]) * (1.f / 16.f); cs[i] = run; } }
        ((LAS float*)(lds + GA_GT))[tg * 128 + dk] = run;
        __syncthreads();
        float off = 0.f, btot = 0.f;
#pragma unroll
        for (int g2 = 0; g2 < 4; ++g2) { const float gtv = ((LAS float*)(lds + GA_GT))[g2 * 128 + dk]; btot += gtv; off += (g2 < tg) ? gtv : 0.f; }
        if (tg == 0) ((LAS float*)(lds + GA_DEC))[dk] = __expf(btot);
        { unsigned kst[8];
#pragma unroll
          for (int i = 0; i < 16; i += 2) { float kk[2];
#pragma unroll
              for (int u = 0; u < 2; ++u) { const int t = 16 * tg + i + u; const float bc = cs[i + u] + off; const float qv = bflo(cur.q[i + u]), kv = bflo(cur.k[i + u]);
                  *(LAS bf16_t*)(lds + GA_QIN + t * GP + dk * 2) = (bf16_t)(cvt_pk(qv * __expf(bc), 0.f) & 0xffffu);
                  *(LAS bf16_t*)(lds + GA_KIN + t * 272 + dk * 2) = (bf16_t)(cvt_pk(kv * __expf(-bc), 0.f) & 0xffffu);
                  kk[u] = kv * __expf(btot - bc); }
              kst[i >> 1] = cvt_pk(kk[0], kk[1]); }
          *(LAS u32x4*)(lds + GA_KST + dk * GP2 + tg * 32) = (u32x4){kst[0], kst[1], kst[2], kst[3]};
          *(LAS u32x4*)(lds + GA_KST + dk * GP2 + tg * 32 + 16) = (u32x4){kst[4], kst[5], kst[6], kst[7]}; }
#pragma unroll
        for (int i = 0; i < 32; i += 8) *(LAS u32x4*)(lds + GA_VT + dvl * GP2 + (32 * th2 + i) * 2) = (u32x4){cur.v[i] | (cur.v[i + 1] << 16), cur.v[i + 2] | (cur.v[i + 3] << 16), cur.v[i + 4] | (cur.v[i + 5] << 16), cur.v[i + 6] | (cur.v[i + 7] << 16)};
        __syncthreads();
#pragma unroll
        for (int rep = 0; rep < 2; ++rep) { const int ti = wid + 8 * rep; if (ti < 10) {
            int jt, it2; if (ti < 4) { jt = 0; it2 = ti; } else if (ti < 7) { jt = 1; it2 = ti - 3; } else if (ti < 9) { jt = 2; it2 = ti - 5; } else { jt = 3; it2 = 3; }
            f32x4 a4 = {0.f, 0.f, 0.f, 0.f};
#pragma unroll
            for (int ks = 0; ks < 4; ++ks) { const bf16x8 kf = *(const LAS bf16x8*)(lds + GA_KIN + (16 * jt + l15) * 272 + ks * 64 + q4 * 16); const u32x2 q0_ = *(const LAS u32x2*)(lds + GA_QIN + (16 * it2 + l15) * GP + ks * 64 + q4 * 16), q1_ = *(const LAS u32x2*)(lds + GA_QIN + (16 * it2 + l15) * GP + ks * 64 + q4 * 16 + 8); const bf16x8 qf = __builtin_bit_cast(bf16x8, (u32x4){q0_.x, q0_.y, q1_.x, q1_.y});
                a4 = __builtin_amdgcn_mfma_f32_16x16x32_bf16(kf, qf, a4, 0, 0, 0); }
            const int i_ = 16 * it2 + l15, j0 = 16 * jt + 4 * q4;
            u32x2 w; w.x = cvt_pk(j0 <= i_ ? a4[0] : 0.f, j0 + 1 <= i_ ? a4[1] : 0.f); w.y = cvt_pk(j0 + 2 <= i_ ? a4[2] : 0.f, j0 + 3 <= i_ ? a4[3] : 0.f);
            *(LAS u32x2*)(lds + GA_ATT + i_ * GP2 + j0 * 2) = w; } }
        __syncthreads();
        unsigned char* blob = GB + (size_t)((b * 32 + n) * 4 + h) * GB_SIZE;
        for (int c = tid; c < 45056 / 16; c += 512) st_wt(blob + c * 16, *(const LAS u32x4*)(lds + GA_BL + c * 16));
        for (int c = tid; c < 36864 / 16; c += 512) st_wt(blob + GB_VT + c * 16, *(const LAS u32x4*)(lds + GA_VT + c * 16));
        cur = nxt;
      }
#undef GLA_LOAD
    }
}
constexpr int GS_BUF = 54272;
constexpr int GS_VT = 0, GS_QIN = 9216, GS_KST = GS_QIN + 16896, GS_ATT = GS_KST + 18432, GS_DEC = GS_ATT + 9216;
static_assert(3 * GS_BUF <= LDSCTL_OFF, "GLA ring");
DEV void gla_scan_item(Frame& F, int b, int h, int c4) {
    LAS unsigned char* lds = F.lds; const int lane = F.lane, wid = F.wave, q4 = lane >> 4, l15 = lane & 15;
    bf16_t* GO = WSP(bf16_t, W_GLAO); float* SS = WSP(float, W_SS); const unsigned char* GB = F.ws + W_GB;
    const int c16 = wid & 3, th = wid >> 2;
    f32x4 sacc[8];
#pragma unroll
    for (int m = 0; m < 8; ++m) sacc[m] = (f32x4){0.f, 0.f, 0.f, 0.f};
    const size_t rb = (size_t)b * 2048;
    float sqv[2][4]; unsigned ov[2][4];
#pragma unroll
    for (int mt = 0; mt < 2; ++mt)
#pragma unroll
        for (int r = 0; r < 4; ++r) { sqv[mt][r] = 0.f; ov[mt][r] = 0u; }
    const int npc = (wid < 5) ? 7 : 6;
#define GS_ISSUE(n_, bo_) do { const unsigned char* blob_ = GB + (size_t)((b * 32 + (n_)) * 4 + h) * GB_SIZE; \
        for (int p_ = wid; p_ < 53; p_ += 8) { const int so_ = p_ < 9 ? GB_VT + c4 * 9216 + p_ * 1024 : (p_ - 9) * 1024; \
            __builtin_amdgcn_global_load_lds((const unsigned*)(blob_ + so_ + lane * 16), (LAS unsigned*)(lds + (bo_) + p_ * 1024), 16, 0, 0); } } while (0)
    GS_ISSUE(0, 0); GS_ISSUE(1, GS_BUF);
    int bo = 0, bo2 = 2 * GS_BUF;
#pragma unroll 1
    for (int n = 0; n < 32; ++n) { const int t0 = n * 64;
        if (n + 1 < 32) { if (npc == 7) asm volatile("s_waitcnt vmcnt(7) lgkmcnt(0)\n\ts_barrier" ::: "memory"); else asm volatile("s_waitcnt vmcnt(6) lgkmcnt(0)\n\ts_barrier" ::: "memory"); } else asm volatile("s_waitcnt vmcnt(0) lgkmcnt(0)\n\ts_barrier" ::: "memory");
        if (n > 0) {
#pragma unroll
            for (int mt = 0; mt < 2; ++mt)
#pragma unroll
                for (int r = 0; r < 4; ++r) { const size_t trow = rb + (t0 - 64) + 32 * th + 16 * mt + 4 * q4 + r; GO[trow * 1024 + h * 256 + c4 * 64 + c16 * 16 + l15] = (bf16_t)ov[mt][r];
                    SS[(trow * 4 + h) * 16 + c4 * 4 + c16] = sqv[mt][r]; } }
        if (n + 2 < 32) GS_ISSUE(n + 2, bo2);
        const LAS unsigned char* bu = lds + bo;
        bf16x8 vf[2];
#pragma unroll
        for (int ks = 0; ks < 2; ++ks) vf[ks] = *(const LAS bf16x8*)(bu + GS_VT + (c16 * 16 + l15) * GP2 + ks * 64 + q4 * 16);
        bf16x8 sf[4];
#pragma unroll
        for (int ks = 0; ks < 4; ++ks) { const u32x4 w = {cvt_pk(sacc[2 * ks][0], sacc[2 * ks][1]), cvt_pk(sacc[2 * ks][2], sacc[2 * ks][3]), cvt_pk(sacc[2 * ks + 1][0], sacc[2 * ks + 1][1]), cvt_pk(sacc[2 * ks + 1][2], sacc[2 * ks + 1][3])}; sf[ks] = __builtin_bit_cast(bf16x8, w); }
#pragma unroll
        for (int mt = 0; mt < 2; ++mt) { const int i_ = 32 * th + 16 * mt + l15; f32x4 oa = {0.f, 0.f, 0.f, 0.f};
#pragma unroll
            for (int ks = 0; ks < 2; ++ks) { if (ks == 1 && th == 0) continue; const bf16x8 af = *(const LAS bf16x8*)(bu + GS_ATT + i_ * GP2 + ks * 64 + q4 * 16); oa = __builtin_amdgcn_mfma_f32_16x16x32_bf16(af, vf[ks], oa, 0, 0, 0); }
#pragma unroll
            for (int ks = 0; ks < 4; ++ks) { const u32x2 lo = *(const LAS u32x2*)(bu + GS_QIN + i_ * GP + (32 * ks + 4 * q4) * 2), hi2 = *(const LAS u32x2*)(bu + GS_QIN + i_ * GP + (32 * ks + 16 + 4 * q4) * 2);
                const u32x4 w = {lo.x, lo.y, hi2.x, hi2.y}; oa = __builtin_amdgcn_mfma_f32_16x16x32_bf16(__builtin_bit_cast(bf16x8, w), sf[ks], oa, 0, 0, 0); }
#pragma unroll
            for (int r = 0; r < 4; ++r) { ov[mt][r] = cvt_pk(oa[r], 0.f) & 0xffffu; float sq = oa[r] * oa[r]; sq += __shfl_xor(sq, 1); sq += __shfl_xor(sq, 2); sq += __shfl_xor(sq, 4); sq += __shfl_xor(sq, 8); sqv[mt][r] = sq; } }
#pragma unroll
        for (int md = 0; md < 8; ++md) { const f32x4 dc = *(const LAS f32x4*)(bu + GS_DEC + (16 * md + 4 * q4) * 4); sacc[md] = sacc[md] * dc;
#pragma unroll
            for (int ks = 0; ks < 2; ++ks) { const bf16x8 kf = *(const LAS bf16x8*)(bu + GS_KST + (16 * md + l15) * GP2 + ks * 64 + q4 * 16); sacc[md] = __builtin_amdgcn_mfma_f32_16x16x32_bf16(kf, vf[ks], sacc[md], 0, 0, 0); } }
        bo = (bo == 2 * GS_BUF) ? 0 : bo + GS_BUF; bo2 = (bo2 == 2 * GS_BUF) ? 0 : bo2 + GS_BUF;
    }
#undef GS_ISSUE
#pragma unroll
    for (int mt = 0; mt < 2; ++mt)
#pragma unroll
        for (int r = 0; r < 4; ++r) { const size_t trow = rb + 31 * 64 + 32 * th + 16 * mt + 4 * q4 + r; GO[trow * 1024 + h * 256 + c4 * 64 + c16 * 16 + l15] = (bf16_t)ov[mt][r]; SS[(trow * 4 + h) * 16 + c4 * 4 + c16] = sqv[mt][r]; }
    asm volatile("s_waitcnt vmcnt(0)" ::: "memory");
    __syncthreads();
}
DEV void p_gla_scan(Frame& F) { for (int v = F.vcu; v < 256; v += F.G) gla_scan_item(F, v >> 4, (v >> 2) & 3, v & 3); }

DEV void p_gla_norm(Frame& F) {
    const int gw = F.vcu * 8 + F.wave, NGW = F.G * 8, lane = F.lane; const bf16_t* GO = WSP(bf16_t, W_GLAO); const float* SS = WSP(float, W_SS); const bf16_t* H1 = WSP(bf16_t, W_HB); bf16_t* Y0 = WSP(bf16_t, W_Y0);
    const f32x4 nw = *(const f32x4*)(F.in[17] + lane * 4);
    for (int row = gw; row < T; row += NGW) {
#pragma unroll
        for (int h = 0; h < 4; ++h) { const float* sp = SS + ((size_t)row * 4 + h) * 16; const f32x4 a = *(const f32x4*)sp, b2 = *(const f32x4*)(sp + 4), c = *(const f32x4*)(sp + 8), d = *(const f32x4*)(sp + 12);
            const float sq = (a.x + a.y + a.z + a.w) + (b2.x + b2.y + b2.z + b2.w) + (c.x + c.y + c.z + c.w) + (d.x + d.y + d.z + d.w); const float r = 1.f / sqrtf(sq * (1.f / 256.f) + 1e-5f);
            const u32x2 o = *(const u32x2*)(GO + (size_t)row * 1024 + h * 256 + lane * 4); const u32x2 g = *(const u32x2*)(H1 + (size_t)row * 3072 + 2048 + h * 256 + lane * 4);
            const float g0 = bflo(g.x), g1 = bfhi(g.x), g2 = bflo(g.y), g3 = bfhi(g.y);
            u32x2 w; w.x = cvt_pk(bflo(o.x) * r * nw.x * g0 * fast_sigm(g0), bfhi(o.x) * r * nw.y * g1 * fast_sigm(g1)); w.y = cvt_pk(bflo(o.y) * r * nw.z * g2 * fast_sigm(g2), bfhi(o.y) * r * nw.w * g3 * fast_sigm(g3));
            st_wt(Y0 + (size_t)row * 1024 + h * 256 + lane * 4, w); } }
}
#ifndef PK_SWIGLU
#define PK_SWIGLU 1
#endif
struct FStoreScale { bf16_t* O; int ldc, c_lo, c_hi; float sc; static constexpr int NSIDE = 0; static constexpr bool PERM2 = false;
    DEV const void* side(const Unit&, int) const { return nullptr; }
    DEV NoPre pre(const Unit&, int, const LAS float*) const { return NoPre{}; }
    DEV void operator()(const Unit&, int row, int col, f32x4 v0, f32x4 v1, NoPre, const LAS float*) const { const float s = (col >= c_lo && col < c_hi) ? sc : 1.f;
        const u32x4 w = {cvt_pk(v0[0] * s, v0[1] * s), cvt_pk(v0[2] * s, v0[3] * s), cvt_pk(v1[0] * s, v1[1] * s), cvt_pk(v1[2] * s, v1[3] * s)}; *(u32x4*)(O + (size_t)row * ldc + col) = w; } };
struct Pre8 { f32x4 b0, b1; };
struct FGlu { const bf16_t* Y; bf16_t* O; const float* b; static constexpr int NSIDE = 0; static constexpr bool PERM2 = false;
    DEV const void* side(const Unit&, int) const { return nullptr; }
    DEV Pre8 pre(const Unit&, int col, const LAS float*) const { return Pre8{*(const f32x4*)(b + col), *(const f32x4*)(b + col + 4)}; }
    DEV void operator()(const Unit&, int row, int col, f32x4 v0, f32x4 v1, const Pre8& pp, const LAS float*) const { const u32x4 y = *(const u32x4*)(Y + (size_t)row * 512 + col); const f32x4 b0 = pp.b0, b1 = pp.b1;
        const u32x4 w = {cvt_pk(bflo(y.x) * fast_sigm(v0[0] + b0.x), bfhi(y.x) * fast_sigm(v0[1] + b0.y)), cvt_pk(bflo(y.y) * fast_sigm(v0[2] + b0.z), bfhi(y.y) * fast_sigm(v0[3] + b0.w)),
                         cvt_pk(bflo(y.z) * fast_sigm(v1[0] + b1.x), bfhi(y.z) * fast_sigm(v1[1] + b1.y)), cvt_pk(bflo(y.w) * fast_sigm(v1[2] + b1.z), bfhi(y.w) * fast_sigm(v1[3] + b1.w))};
        *(u32x4*)(O + (size_t)row * 1024 + col) = w; } };
constexpr float ACT_SCALE = 4.f, WDN_SCALE = 128.f;
#ifdef NEWTON_RCP
DEV float rcp_nr(float e) { float r = __builtin_bit_cast(float, 0x7EF311C7u - __builtin_bit_cast(unsigned, e)); r = r * fmaf(-e, r, 2.f); r = r * fmaf(-e, r, 2.f); return r; }
#else
DEV float rcp_nr(float e) { return __builtin_amdgcn_rcpf(e); }
#endif
DEV float swiglu1s(float g, float u) { g = fminf(g, 7.f); u = __builtin_amdgcn_fmed3f(u, -7.f, 7.f); const float r = rcp_nr(1.f + __builtin_amdgcn_exp2f(-1.702f * 1.4426950408889634f * g)); return (g * r) * fmaf(u, ACT_SCALE, ACT_SCALE); }
#if PK_SWIGLU
DEV f32x2 swiglu2(f32x2 g, f32x2 u4) { g.x = fminf(g.x, 7.f); g.y = fminf(g.y, 7.f); u4.x = __builtin_amdgcn_fmed3f(u4.x, -6.f * ACT_SCALE, 8.f * ACT_SCALE); u4.y = __builtin_amdgcn_fmed3f(u4.y, -6.f * ACT_SCALE, 8.f * ACT_SCALE);
    const f32x2 a = g * (-1.702f * 1.4426950408889634f); f32x2 e; e.x = __builtin_amdgcn_exp2f(a.x); e.y = __builtin_amdgcn_exp2f(a.y); e = e + 1.f;
    f32x2 r; r.x = __builtin_amdgcn_rcpf(e.x); r.y = __builtin_amdgcn_rcpf(e.y); return (g * r) * u4; }
struct FSwiglu { unsigned char* ACT; const float* bgu2; float sc; static constexpr int NSIDE = 1; static constexpr bool PERM2 = true;
    DEV const void* side(const Unit& u, int) const { return bgu2 + (size_t)u.e * 2048 + u.pn * BM; }
    DEV Pre8 pre(const Unit&, int, const LAS float* sb) const { return Pre8{*(const LAS f32x4*)sb, *(const LAS f32x4*)(sb + 4)}; }
    DEV void operator()(const Unit& u, int row, int col, f32x4 v0, f32x4 v1, const Pre8& pp, const LAS float*) const { const f32x4 b0 = pp.b0, b1 = pp.b1; const f32x2 sg = {sc, sc}, su = {sc * ACT_SCALE, sc * ACT_SCALE};
        const f32x2 a01 = swiglu2(__builtin_elementwise_fma((f32x2){v0[0], v0[1]}, sg, (f32x2){b0.x, b0.y}), __builtin_elementwise_fma((f32x2){v0[2], v0[3]}, su, (f32x2){b0.z, b0.w}));
        const f32x2 a23 = swiglu2(__builtin_elementwise_fma((f32x2){v1[0], v1[1]}, sg, (f32x2){b1.x, b1.y}), __builtin_elementwise_fma((f32x2){v1[2], v1[3]}, su, (f32x2){b1.z, b1.w}));
        *(unsigned*)(ACT + (size_t)row * 1024 + (col >> 1)) = pk4_fp8(a01.x, a01.y, a23.x, a23.y); } };
#else
struct FSwiglu { unsigned char* ACT; const float* bgu; float sc; static constexpr int NSIDE = 1; static constexpr bool PERM2 = false;
    DEV const void* side(const Unit& u, int) const { return bgu + (size_t)u.e * 2048 + u.pn * BM; }
    DEV Pre8 pre(const Unit&, int, const LAS float* sb) const { return Pre8{*(const LAS f32x4*)sb, *(const LAS f32x4*)(sb + 4)}; }
    DEV void operator()(const Unit& u, int row, int col, f32x4 v0, f32x4 v1, const Pre8& pp, const LAS float*) const { const f32x4 b0 = pp.b0, b1 = pp.b1;
        const unsigned w = pk4_fp8(swiglu1s(fmaf(v0[0], sc, b0.x), fmaf(v0[1], sc, b0.y)), swiglu1s(fmaf(v0[2], sc, b0.z), fmaf(v0[3], sc, b0.w)), swiglu1s(fmaf(v1[0], sc, b1.x), fmaf(v1[1], sc, b1.y)), swiglu1s(fmaf(v1[2], sc, b1.z), fmaf(v1[3], sc, b1.w)));
        *(unsigned*)(ACT + (size_t)row * 1024 + (col >> 1)) = w; } };
#endif
constexpr float YS_SCALE = 64.f;
struct FDown { unsigned char* YS; const float* bd; const float* wgt; float sc; static constexpr int NSIDE = 2; static constexpr bool PERM2 = false;
    DEV const void* side(const Unit& u, int k) const { return k == 0 ? (const void*)(bd + (size_t)u.e * 1024 + u.pn * BM) : (const void*)(wgt + (size_t)u.pm * BM); }
    DEV Pre8 pre(const Unit&, int, const LAS float* sb) const { return Pre8{*(const LAS f32x4*)sb, *(const LAS f32x4*)(sb + 4)}; }
    DEV void operator()(const Unit& u, int row, int col, f32x4 v0, f32x4 v1, const Pre8& pp, const LAS float* sr) const { const f32x4 b0 = pp.b0, b1 = pp.b1; const float wt = *sr * YS_SCALE, ws_ = sc * wt;
        u32x2 w; w.x = pk4_fp8(fmaf(v0[0], ws_, b0.x * wt), fmaf(v0[1], ws_, b0.y * wt), fmaf(v0[2], ws_, b0.z * wt), fmaf(v0[3], ws_, b0.w * wt)); w.y = pk4_fp8(fmaf(v1[0], ws_, b1.x * wt), fmaf(v1[1], ws_, b1.y * wt), fmaf(v1[2], ws_, b1.z * wt), fmaf(v1[3], ws_, b1.w * wt));
        *(u32x2*)(YS + (size_t)row * 1024 + col) = w; } };

constexpr int NPH = 21;
#ifndef DUP_GU
#define DUP_GU 0
#endif
constexpr float X8_SCALE = 16.f, WGU_SCALE = 64.f;
constexpr float QSCALE0 = 0.125f * 1.4426950408889634f, QSCALE1 = 0.08838834764831845f;


#define NOINL __device__ __forceinline__
struct PA { const float* const* in; unsigned char* ws; float* out; int wave; };
#define MKFRAME extern __shared__ __attribute__((aligned(16))) unsigned char lds_[]; Frame F; F.lds = (LAS unsigned char*)lds_; F.wave = pa.wave; F.lane = (int)__builtin_amdgcn_mbcnt_hi(~0u, __builtin_amdgcn_mbcnt_lo(~0u, 0u)); F.tid = F.wave * 64 + F.lane; \
    F.G = gridDim.x; { const int bx = blockIdx.x; F.vcu = (F.G % 8 == 0) ? (bx % 8) * (F.G / 8) + bx / 8 : bx; } F.in = pa.in; F.ws = pa.ws;
template <class Fn> DEV void dense_gemm(Frame& F, const bf16_t* A, const bf16_t* Bt, int nM, int nN, int K, const Fn& fn) {
    Gemm g; g.A = A; g.Bt = Bt; g.rowmap = nullptr; g.bstride = 0; g.KB = K * 2; g.wave = F.wave;
    StaticOrder S; S.init(nM, nN, F.G, (int)blockIdx.x, nullptr);
    EpiRow8<Fn> E{fn};
    gemm_phase<false, false, true>(F.lds, g, S, E);
}
NOINL void ph_prologue(PA pa) { MKFRAME p0_prologue(F); }
NOINL void ph_in0(PA pa) { MKFRAME dense_gemm(F, WSP(bf16_t, W_XB), WSP(bf16_t, W_IN0), T / 256, 8, 1024, FStoreScale{WSP(bf16_t, W_HB), 2048, 512, 1024, QSCALE0}); }
NOINL void ph_kmean(PA pa) { MKFRAME p_kmean(F); }
NOINL void ph_s5moba(PA pa, int mode) { MKFRAME p_s5_moba(F, mode); }
NOINL void ph_glu(PA pa) { MKFRAME dense_gemm(F, WSP(bf16_t, W_YS5), WSP(bf16_t, W_GLU), T / 256, 2, 512, FGlu{WSP(bf16_t, W_YS5), WSP(bf16_t, W_Y0), F.in[11]}); }
NOINL void ph_out(PA pa, int layer) { MKFRAME dense_gemm(F, WSP(bf16_t, W_Y0), layer ? WSP(bf16_t, W_OUT1) : WSP(bf16_t, W_OUT0), T / 256, 4, 1024, FStoreScale{WSP(bf16_t, W_MIXB), 1024, 0, 0, 1.f}); }
NOINL void ph_in1(PA pa) { MKFRAME dense_gemm(F, WSP(bf16_t, W_XB), WSP(bf16_t, W_IN1), T / 256, 12, 1024, FStoreScale{WSP(bf16_t, W_HB), 3072, 0, 512, QSCALE1}); p_gr(F); }
NOINL void ph_glaprep(PA pa) { MKFRAME p_gla_prep(F); }
NOINL void ph_glascan(PA pa) { MKFRAME p_gla_scan(F); }
NOINL void ph_glanorm(PA pa) { MKFRAME p_gla_norm(F); }
NOINL void ph_lnrouter(PA pa, int layer) { MKFRAME
    if (layer == 0) p_ln<0, true, false, false>(F, nullptr, WSP(bf16_t, W_XB), WSP(bf16_t, W_XBB), nullptr, F.in[19], F.in[20], F.in[23], F.in[24]);
    else p_ln<0, true, false, false>(F, nullptr, WSP(bf16_t, W_XB), WSP(bf16_t, W_XBB), nullptr, F.in[19] + 1024, F.in[20] + 1024, F.in[23] + (size_t)1024 * 32, F.in[24] + 32); }
NOINL void ph_sort(PA pa) { MKFRAME p_sort(F); }
NOINL void ph_gateup(PA pa, int layer) { MKFRAME const int* SORT = WSP(int, W_SORT);
    Gemm g; g.A = WSP(unsigned char, W_X8); g.Bt = WSP(unsigned char, W_GU) + (size_t)layer * 32 * 2048 * 1024; g.rowmap = nullptr; g.bstride = (size_t)2048 * 1024; g.KB = 1024; g.wave = F.wave;
    StaticOrder S; S.init(__builtin_amdgcn_readfirstlane(SORT[33]), 8, F.G, (int)blockIdx.x, (const LAS int*)(F.lds + LDS_ELIST)); fill_elist(F.lds, S, SORT + 64, F.tid);
    EpiRow8<FSwiglu> E{FSwiglu{WSP(unsigned char, W_ACT), (PK_SWIGLU ? WSP(float, W_BGU2) : F.in[26]) + (size_t)layer * 32 * 2048, 1.f / (X8_SCALE * WGU_SCALE)}};
    gemm_phase<false, true, true, DUP_GU>(F.lds, g, S, E); }
NOINL void ph_down(PA pa, int layer) { MKFRAME const int* SORT = WSP(int, W_SORT);
    Gemm g; g.A = WSP(unsigned char, W_ACT); g.Bt = WSP(unsigned char, W_DN) + (size_t)layer * 32 * 1024 * 1024; g.rowmap = nullptr; g.bstride = (size_t)1024 * 1024; g.KB = 1024; g.wave = F.wave;
    StaticOrder S; S.init(__builtin_amdgcn_readfirstlane(SORT[33]), 4, F.G, (int)blockIdx.x, (const LAS int*)(F.lds + LDS_ELIST)); fill_elist(F.lds, S, SORT + 64, F.tid);
    EpiRow8<FDown> E{FDown{WSP(unsigned char, W_YS), F.in[28] + (size_t)layer * 32 * 1024, WSP(float, R_WGT), 1.f / (ACT_SCALE * WDN_SCALE)}};
    gemm_phase<false, true, true>(F.lds, g, S, E); }
NOINL void ph_combine(PA pa, int layer) { MKFRAME
    if (layer == 0) p_ln<1, false, false, false, false>(F, nullptr, WSP(bf16_t, W_XBB), WSP(bf16_t, W_XB), nullptr, F.in[21], F.in[22], nullptr, nullptr);
    else p_ln<1, false, false, true>(F, nullptr, WSP(bf16_t, W_XBB), nullptr, pa.out, F.in[21] + 1024, F.in[22] + 1024, nullptr, nullptr); }

__global__ void __launch_bounds__(512, 2) mega(Args args) {
    extern __shared__ __attribute__((aligned(16))) unsigned char lds_[];
    LAS unsigned char* lds = (LAS unsigned char*)lds_;
    unsigned* ctl = (unsigned*)(args.ws + W_CTL);
    for (int u = threadIdx.x; u < (LDS_BYTES - LDSCTL_OFF) / 4; u += 512) ((LAS unsigned*)(lds + LDSCTL_OFF))[u] = 0u;
    __syncthreads();
    const int lo = args.ph_lo, hi = args.ph_hi;
    PA pa; pa.in = args.in; pa.ws = args.ws; pa.out = args.out; pa.wave = __builtin_amdgcn_readfirstlane(threadIdx.x >> 6);
    XcdBarrier bar; bar.bar = ctl + CW_BAR; bar.x = 0; bar.st = nullptr; bar.wave = pa.wave;
    if (hi - lo > 1) bar = xcd_barrier_post(ctl + CW_BAR, (volatile LAS unsigned*)(lds + MISC_OFF) + 8, pa.wave);
#define IN(k) (lo <= (k) && (k) < hi)
#ifdef DIAG_LO
    volatile LAS unsigned long long* tsl = (volatile LAS unsigned long long*)(lds + MISC_OFF + 128);
    if (blockIdx.x == 0 && threadIdx.x == 0) tsl[0] = __builtin_amdgcn_s_memrealtime();
#define STAMP(k) do { if (blockIdx.x == 0 && threadIdx.x == 0) tsl[(k) + 1] = __builtin_amdgcn_s_memrealtime(); } while (0)
#else
#define STAMP(k) do { } while (0)
#endif
#define SEAM(k) do { if (IN(k) && IN((k) + 1)) xcd_barrier(bar); STAMP(k); } while (0)
#ifndef REP_PHASE
#define REP_PHASE -1
#define REP_N 0
#endif
#define RUN(k, call) do { if (IN(k)) { call; if ((k) == REP_PHASE) { xcd_barrier(bar); call; } } } while (0)
    RUN(0, ph_prologue(pa)); SEAM(0);
    RUN(1, ph_in0(pa)); SEAM(1);
    RUN(2, ph_kmean(pa)); SEAM(2);
    if (IN(3)) { ph_s5moba(pa, 1); if (REP_PHASE == 30) ph_s5moba(pa, 1); ph_s5moba(pa, 2); if (REP_PHASE == 31) ph_s5moba(pa, 2); } SEAM(3);
    RUN(4, ph_glu(pa)); SEAM(4);
    RUN(5, ph_out(pa, 0)); SEAM(5);
    if (REP_PHASE == 99) { for (int q_ = 0; q_ < 20; ++q_) xcd_barrier(bar); }
    RUN(6, ph_lnrouter(pa, 0)); SEAM(6);
    RUN(7, ph_sort(pa)); SEAM(7);
    RUN(8, ph_gateup(pa, 0)); SEAM(8);
    RUN(9, ph_down(pa, 0)); SEAM(9);
    RUN(10, ph_combine(pa, 0)); SEAM(10);
    RUN(11, ph_in1(pa)); SEAM(11);
    RUN(12, ph_glaprep(pa)); SEAM(12);
    RUN(13, ph_glascan(pa)); SEAM(13);
    RUN(14, ph_glanorm(pa)); SEAM(14);
    RUN(15, ph_out(pa, 1)); SEAM(15);
    RUN(16, ph_lnrouter(pa, 1)); SEAM(16);
    RUN(17, ph_sort(pa)); SEAM(17);
    RUN(18, ph_gateup(pa, 1)); SEAM(18);
    RUN(19, ph_down(pa, 1)); SEAM(19);
    RUN(20, ph_combine(pa, 1));
#ifdef DIAG_LO
    xcd_barrier(bar); STAMP(20);
    if (blockIdx.x == 0 && threadIdx.x == 0) { const unsigned long long dtk = tsl[DIAG_HI + 1] - tsl[DIAG_LO]; const float f = (float)dtk * (0.01f / 10000.f); __hip_atomic_store(ctl + 8, __float_as_uint(f), __ATOMIC_RELAXED, __HIP_MEMORY_SCOPE_AGENT); }
    xcd_barrier(bar);
    { const float f = __uint_as_float(__hip_atomic_load(ctl + 8, __ATOMIC_RELAXED, __HIP_MEMORY_SCOPE_AGENT));
      for (size_t i = (size_t)blockIdx.x * 512 + threadIdx.x; i < (size_t)T * 1024; i += (size_t)gridDim.x * 512) args.out[i] *= (1.f + f); }
#endif
#undef IN
#undef SEAM
}

static int g_grid = 0;
static bool launch_setup(size_t ws_size) {
    if (g_grid == 0) {
        if (ws_size < W_END) { fprintf(stderr, "kernel_launch: workspace too small: %zu < %zu\n", ws_size, (size_t)W_END); g_grid = -1; return false; }
        int dev = 0, cus = 0, per_cu = 0;
        if (hipGetDevice(&dev) != hipSuccess || hipDeviceGetAttribute(&cus, hipDeviceAttributeMultiprocessorCount, dev) != hipSuccess) { g_grid = -1; return false; }
        if (hipFuncSetAttribute((const void*)mega, hipFuncAttributeMaxDynamicSharedMemorySize, LDS_BYTES) != hipSuccess) { fprintf(stderr, "kernel_launch: hipFuncSetAttribute failed\n"); g_grid = -1; return false; }
        if (hipOccupancyMaxActiveBlocksPerMultiprocessor(&per_cu, (const void*)mega, 512, LDS_BYTES) != hipSuccess || per_cu < 1) fprintf(stderr, "kernel_launch: occupancy query reports %d blocks/CU\n", per_cu);
        (void)hipGetLastError();
        g_grid = cus;
    }
    return g_grid > 0;
}
static void launch_phases(hipStream_t stream, void* const* d_in, void* d_out, void* d_ws, int lo, int hi) {
    Args a; memset(&a, 0, sizeof a);
    for (int i = 0; i < 29; ++i) a.in[i] = (const float*)d_in[i];
    a.out = (float*)d_out; a.ws = (unsigned char*)d_ws; a.ph_lo = lo; a.ph_hi = hi;
    hipLaunchKernelGGL(mega, dim3(g_grid), dim3(512), LDS_BYTES, stream, a);
}
}
extern "C" void kernel_launch(void* const* d_in, const int* in_sizes, int n_in, void* d_out, int out_size, void* d_ws, size_t ws_size, hipStream_t stream) {
    if (n_in != 29 || out_size != T * D) { fprintf(stderr, "kernel_launch: unexpected arguments (n_in %d, out_size %d)\n", n_in, out_size); return; }
    if (!fk::launch_setup(ws_size)) return;
    (void)hipMemsetAsync((char*)d_ws + fk::W_CTL, 0, fk::CTL_ZERO_BYTES, stream);
    fk::launch_phases(stream, d_in, d_out, d_ws, 0, fk::NPH);
}
```

```cpp
#include <hip/hip_runtime.h>
#include <cstdio>
#include <cstdint>
#include <cmath>
#include <cstring>
#define DEV __device__ __forceinline__
constexpr int Bn = 16, L = 2048, D = 1024, T = Bn * L;
namespace fk {
#define LAS __attribute__((address_space(3)))
#define GAS __attribute__((address_space(1)))
typedef unsigned short bf16_t;
typedef short bf16x8 __attribute__((ext_vector_type(8)));
typedef short s16x4 __attribute__((ext_vector_type(4)));
typedef float f32x2 __attribute__((ext_vector_type(2)));
typedef float f32x4 __attribute__((ext_vector_type(4)));
typedef float f32x16 __attribute__((ext_vector_type(16)));
typedef unsigned u32x2 __attribute__((ext_vector_type(2)));
typedef unsigned u32x4 __attribute__((ext_vector_type(4)));
typedef __bf16 bf16x2_t __attribute__((ext_vector_type(2)));
struct u32x4x2 { u32x4 a, b; };
DEV unsigned cvt_pk(float lo, float hi) { f32x2 v = {lo, hi}; bf16x2_t b = __builtin_convertvector(v, bf16x2_t); return __builtin_bit_cast(unsigned, b); }
DEV float bflo(unsigned w) { return __uint_as_float(w << 16); }
DEV float bfhi(unsigned w) { return __uint_as_float(w & 0xffff0000u); }
#ifndef WT_STORES
#define WT_STORES 0
#endif
DEV void st_wt(void* p, u32x4 v) { if (WT_STORES == 1) asm volatile("global_store_dwordx4 %0, %1, off sc1" :: "v"(p), "v"(v)); else if (WT_STORES == 2) __builtin_nontemporal_store(v, (u32x4*)p); else *(u32x4*)p = v; }
DEV void st_wt(void* p, u32x2 v) { if (WT_STORES == 1) asm volatile("global_store_dwordx2 %0, %1, off sc1" :: "v"(p), "v"(v)); else if (WT_STORES == 2) __builtin_nontemporal_store(v, (u32x2*)p); else *(u32x2*)p = v; }
DEV void st_wt(void* p, f32x4 v) { if (WT_STORES == 1) asm volatile("global_store_dwordx4 %0, %1, off sc1" :: "v"(p), "v"(v)); else if (WT_STORES == 2) __builtin_nontemporal_store(v, (f32x4*)p); else *(f32x4*)p = v; }
DEV float fast_sigm(float x) { return __builtin_amdgcn_rcpf(1.f + __builtin_amdgcn_exp2f(-1.4426950408889634f * x)); }
DEV float gelu_tanh(float x) { const float u = 0.7978845608028654f * (x + 0.044715f * x * x * x); return x * fast_sigm(2.f * u); }
DEV float wave_sum(float v) {
#pragma unroll
    for (int o = 1; o < 64; o <<= 1) v += __shfl_xor(v, o);
    return v; }
DEV float swap32(float x) { auto rr = __builtin_amdgcn_permlane32_swap(__float_as_uint(x), __float_as_uint(x), false, false); return __uint_as_float((__builtin_amdgcn_mbcnt_lo(~0u, 0u) >> 5) ? rr[0] : rr[1]); }

constexpr int BM = 256, BK = 64, HALF = 128, HTB = HALF * BK * 2, STAGE_BYTES = 8 * HTB, NXCD = 8, WGM = 8;
constexpr int LDS_TOK = 135168 - 2048;
constexpr int LDS_SIDE = 135168;
constexpr int LDS_BYTES = 163840, LDSCTL_OFF = LDS_BYTES - 1024, MISC_OFF = LDSCTL_OFF + 320;

DEV int lds_byte(int r, int c) { const int st = (r >> 4) * 2 + (c >> 5), rr = r & 15, cc = c & 31, ob = rr * 64 + cc * 2; return st * 1024 + (ob ^ (((ob >> 9) & 1) << 5)); }
DEV void stage_rc(int b, int& R, int& C) { const int st = b / 1024, sb = b % 1024, swz = sb ^ (((sb >> 9) & 1) << 5); R = (st >> 1) * 16 + swz / 64; C = (st & 1) * 32 + (swz % 64) / 2; }
DEV int perm32(int rho) { const int n = rho >> 4, i = rho & 15; return 8 * (i >> 2) + 4 * n + (i & 3); }

struct Unit { int pm, pn, e; };
struct Gemm { const void* A; const void* Bt; const int* rowmap; size_t bstride; int KB; int wave; };

struct StaticOrder {
    int nM, nN, nwg, G, c; const LAS int* elist;
    DEV void init(int nM_, int nN_, int G_, int c_, const LAS int* el) { nM = nM_; nN = nN_; nwg = nM * nN; G = G_; c = c_; elist = el; }
    DEV bool place(int i, Unit& u) const {
        const long Lx = (long)i * G + c; if (Lx >= nwg) return false;
        int wgid = (int)Lx; { const int q = nwg / NXCD, r = nwg % NXCD, xcd = wgid % NXCD, off = wgid / NXCD; wgid = (xcd < r ? xcd * (q + 1) : r * (q + 1) + (xcd - r) * q) + off; }
        const int nig = WGM * nN, gid = wgid / nig, fm = gid * WGM, gsz = (nM - fm) < WGM ? (nM - fm) : WGM;
        u.pm = fm + ((wgid % nig) % gsz); u.pn = (wgid % nig) / gsz; u.e = 0; return true;
    }
    DEV bool next(int i, Unit& u) const { if (!place(i, u)) return false; if (elist) u.e = __builtin_amdgcn_readfirstlane(elist[i]); return true; }
};
constexpr int LDS_ELIST = 135168 + 6144;
DEV void fill_elist(LAS unsigned char* lds, const StaticOrder& S, const int* tile_e, int tid) {
    LAS int* el = (LAS int*)(lds + LDS_ELIST);
    if (tid < 64) { Unit u; el[tid] = S.place(tid, u) ? tile_e[u.pm] : 0; }
    __syncthreads();
}

struct NoPre {};
template <class F> struct EpiRow8 {
    static constexpr bool PERM = true, PERM2 = F::PERM2; static constexpr int NSIDE = F::NSIDE; F f;
    DEV const void* side(const Unit& u, int k) const { return f.side(u, k); }
    DEV void operator()(const f32x4 (&acc)[2][2][4][2], const Unit& u, int wr, int wc, int fr, int fq, const LAS float* sd) const {
        { int ln_; asm volatile("v_mbcnt_lo_u32_b32 %0, -1, 0\n\tv_mbcnt_hi_u32_b32 %0, -1, %0" : "=v"(ln_)); fr = ln_ & 15; fq = ln_ >> 4; }
        const int cl = wc * 32 + 8 * fq, c0 = u.pn * BM + cl;
        if constexpr (NSIDE > 0) {
#pragma unroll
            for (int ai = 0; ai < 2; ++ai)
#pragma unroll
                for (int m = 0; m < 4; ++m) { const int rl = ai * HALF + wr * 64 + m * 16 + fr, row = u.pm * BM + rl;
                    f(u, row, c0, acc[ai][0][m][0], acc[ai][0][m][1], f.pre(u, c0, sd + cl), sd + 256 + rl); f(u, row, c0 + HALF, acc[ai][1][m][0], acc[ai][1][m][1], f.pre(u, c0 + HALF, sd + cl + HALF), sd + 256 + rl); }
        } else {
        const auto p0 = f.pre(u, c0, sd + cl), p1 = f.pre(u, c0 + HALF, sd + cl + HALF);
#pragma unroll
        for (int ai = 0; ai < 2; ++ai)
#pragma unroll
            for (int m = 0; m < 4; ++m) { const int rl = ai * HALF + wr * 64 + m * 16 + fr, row = u.pm * BM + rl;
                f(u, row, c0, acc[ai][0][m][0], acc[ai][0][m][1], p0, sd + 256 + rl); f(u, row, c0 + HALF, acc[ai][1][m][0], acc[ai][1][m][1], p1, sd + 256 + rl); }
        }
    }
};

typedef int v8i_t __attribute__((ext_vector_type(8)));
typedef int v4i_t __attribute__((ext_vector_type(4)));
template <bool GATHER, bool FP8, bool ALIGN, int DUPK = 0, class Epi, class Sched>
DEV void gemm_phase(LAS unsigned char* lds, const Gemm g, const Sched& S, const Epi& E) {
    const int wid = g.wave, lane = (int)__builtin_amdgcn_mbcnt_hi(~0u, __builtin_amdgcn_mbcnt_lo(~0u, 0u)), tid = wid * 64 + lane, wr = wid >> 2, wc = wid & 3, fr = lane & 15, fq = lane >> 4;

    const int KB = g.KB, nt = KB / 128;
    int R0, C2; { int C; stage_rc(tid * 16, R0, C); C2 = C * 2; }
    unsigned voffB[2]; { int Rb = Epi::PERM ? ((R0 & ~31) + perm32(R0 & 31)) : R0; if constexpr (Epi::PERM2) Rb = (Rb & ~3) | ((Rb & 1) << 1) | ((Rb >> 1) & 1);
      voffB[0] = (unsigned)(Rb * KB + C2); voffB[1] = voffB[0] + 64u * (unsigned)KB; }
    const unsigned kstep = 128u, hstep = (unsigned)HALF * KB, tstep = 2u * hstep;
    const unsigned ldsw = (unsigned)wid * 1024u;
    const int aoff = lds_byte(wr * 64 + fr, fq * 8); int boff = lds_byte(wc * 32 + fr, fq * 8) + 4 * HTB; asm volatile("" : "+v"(boff));
    LAS int* tokb = (LAS int*)(lds + LDS_TOK);
    const auto rsA = __builtin_amdgcn_make_buffer_rsrc((void*)g.A, 0, 0x7fffffff, 0x00020000);
    const auto rsB = __builtin_amdgcn_make_buffer_rsrc((void*)g.Bt, 0, 0x7fffffff, 0x00020000);
    const auto rsT = __builtin_amdgcn_make_buffer_rsrc((void*)(GATHER ? (const void*)g.rowmap : g.A), 0, 0x7fffffff, 0x00020000);
#define PG8_SA(b, h) (((b) * 2 + (h)) * HTB)
#define PG8_SB(b, h) ((4 + (b) * 2 + (h)) * HTB)
#define PG8_STAGE(bufoff, rs, soff, voff) do { _Pragma("unroll") for (int _i = 0; _i < 2; ++_i) { \
        if constexpr (GATHER) __builtin_amdgcn_raw_ptr_buffer_load_lds(rs, (LAS void*)(lds + (bufoff) + ldsw + _i * 8192), 16, (int)(voff)[_i], (int)(soff), 0, 0); \
        else __builtin_amdgcn_raw_ptr_buffer_load_lds(rs, (LAS void*)(lds + (bufoff) + ldsw + _i * 8192), 16, (int)(voff)[0], (int)((soff) + _i * 64u * (unsigned)KB), 0, 0); } } while (0)
#define PG8_LDA(dst, b, h) do { _Pragma("unroll") for (int m = 0; m < 4; ++m) _Pragma("unroll") for (int k = 0; k < 2; ++k) dst[m][k] = *(const LAS bf16x8*)(lds + PG8_SA(b, h) + aoff + m * 2048 + k * 1024); } while (0)
#define PG8_LDB(dst, b, h) do { _Pragma("unroll") for (int n = 0; n < 2; ++n) _Pragma("unroll") for (int k = 0; k < 2; ++k) dst[n][k] = *(const LAS bf16x8*)(lds + boff + (PG8_SB(b, h) - 4 * HTB) + n * 2048 + k * 1024); } while (0)
#define PG8_CAT(x) __builtin_shufflevector(__builtin_bit_cast(v4i_t, x[0]), __builtin_bit_cast(v4i_t, x[1]), 0, 1, 2, 3, 4, 5, 6, 7)
#define PG8_MMA(ai, bj, At, Bt) do { __builtin_amdgcn_s_setprio(1); _Pragma("unroll") for (int m = 0; m < 4; ++m) _Pragma("unroll") for (int n = 0; n < 2; ++n) { \
        if constexpr (FP8) acc[ai][bj][m][n] = __builtin_amdgcn_mfma_scale_f32_16x16x128_f8f6f4(PG8_CAT(Bt[n]), PG8_CAT(At[m]), acc[ai][bj][m][n], 0, 0, 0, 0, 0, 0); \
        else { _Pragma("unroll") for (int k = 0; k < 2; ++k) acc[ai][bj][m][n] = __builtin_amdgcn_mfma_f32_16x16x32_bf16(Bt[n][k], At[m][k], acc[ai][bj][m][n], 0, 0, 0); } } __builtin_amdgcn_s_setprio(0); } while (0)
#define PG8_MMA0(ai, bj, At, Bt) do { __builtin_amdgcn_s_setprio(1); _Pragma("unroll") for (int m = 0; m < 4; ++m) _Pragma("unroll") for (int n = 0; n < 2; ++n) { const f32x4 zz_ = {0.f, 0.f, 0.f, 0.f}; \
        if constexpr (FP8) acc[ai][bj][m][n] = __builtin_amdgcn_mfma_scale_f32_16x16x128_f8f6f4(PG8_CAT(Bt[n]), PG8_CAT(At[m]), zz_, 0, 0, 0, 0, 0, 0); \
        else { acc[ai][bj][m][n] = __builtin_amdgcn_mfma_f32_16x16x32_bf16(Bt[n][0], At[m][0], zz_, 0, 0, 0); acc[ai][bj][m][n] = __builtin_amdgcn_mfma_f32_16x16x32_bf16(Bt[n][1], At[m][1], acc[ai][bj][m][n], 0, 0, 0); } } __builtin_amdgcn_s_setprio(0); } while (0)
#define PG8_WAIT_V(n) asm volatile("s_waitcnt vmcnt(" #n ")" ::: "memory")
#define PG8_WAIT_L(n) asm volatile("s_waitcnt lgkmcnt(" #n ")" ::: "memory")
#define PG8_BAR __builtin_amdgcn_s_barrier()
#define PG8_SCHED __builtin_amdgcn_sched_barrier(0)
    Unit cur, nxt; int ui = 0;
    if (!S.next(0, cur)) return;
    f32x4 acc[2][2][4][2];
    bf16x8 At[4][2], B0[2][2], B1[2][2];
    unsigned cA, cB = (unsigned)cur.e * (unsigned)g.bstride + (unsigned)cur.pn * tstep;
    unsigned voffA[2]; voffA[0] = (unsigned)(R0 * KB + C2); voffA[1] = voffA[0] + 64u * (unsigned)KB;
    if constexpr (GATHER) { cA = 0u;
        if (wid < 4) __builtin_amdgcn_raw_ptr_buffer_load_lds(rsT, (LAS void*)(tokb + wid * 64), 4, (wid * 64 + lane) * 4, cur.pm * (BM * 4), 0, 0);
        asm volatile("s_waitcnt vmcnt(0)" ::: "memory"); __builtin_amdgcn_s_barrier();
    } else cA = (unsigned)cur.pm * tstep;
    const unsigned hA = GATHER ? 0u : hstep;
    LAS float* sideb = (LAS float*)(lds + LDS_SIDE);
#define PG8_SIDE(un, sel) do { if constexpr (Epi::NSIDE > 0) { if (wid < Epi::NSIDE) { const char* sp_ = (const char*)E.side(un, wid); int ln_ = (int)__builtin_amdgcn_mbcnt_hi(~0u, __builtin_amdgcn_mbcnt_lo(~0u, 0u)); asm volatile("" : "+v"(ln_)); \
        __builtin_amdgcn_global_load_lds((const unsigned*)(sp_ + ln_ * 16), (LAS unsigned*)(sideb + (sel) * 512 + wid * 256), 16, 0, 0); } } } while (0)
    PG8_SIDE(cur, 0);
#define PG8_OA(dst, sel, h) unsigned dst[2]; if constexpr (GATHER) { dst[0] = (unsigned)(tokb[(sel) * 256 + (h) * HALF + R0] * KB + C2); dst[1] = (unsigned)(tokb[(sel) * 256 + (h) * HALF + R0 + 64] * KB + C2); } else { dst[0] = voffA[0]; dst[1] = voffA[1]; }
    { PG8_OA(p0_, 0, 0); PG8_OA(p1_, 0, 1); PG8_STAGE(PG8_SB(0, 0), rsB, cB, voffB); PG8_STAGE(PG8_SB(0, 1), rsB, cB + hstep, voffB); PG8_STAGE(PG8_SA(0, 0), rsA, cA, p0_); PG8_STAGE(PG8_SA(0, 1), rsA, cA + hA, p1_); }
    if (wr == 1) PG8_BAR;
    PG8_WAIT_V(2); PG8_BAR;
    { PG8_OA(p0_, 0, 0); PG8_STAGE(PG8_SB(1, 0), rsB, cB + kstep, voffB); PG8_STAGE(PG8_SA(1, 0), rsA, cA + kstep, p0_); PG8_STAGE(PG8_SB(1, 1), rsB, cB + hstep + kstep, voffB); }
    PG8_WAIT_V(6); PG8_BAR;
    for (;;) {
        const bool has_next = S.next(ui + 1, nxt);
        unsigned nA = cA, nB = cB;
        if (has_next) { nB = (unsigned)nxt.e * (unsigned)g.bstride + (unsigned)nxt.pn * tstep;
            if constexpr (GATHER) { if (wid < 4) { const int ln_ = (int)__builtin_amdgcn_mbcnt_hi(~0u, __builtin_amdgcn_mbcnt_lo(~0u, 0u)); __builtin_amdgcn_raw_ptr_buffer_load_lds(rsT, (LAS void*)(tokb + ((ui + 1) & 1) * 256 + wid * 64), 4, (wid * 64 + ln_) * 4, nxt.pm * (BM * 4), 0, 0); } }
            else nA = (unsigned)nxt.pm * tstep;
            PG8_SIDE(nxt, (ui + 1) % 3); }
#pragma unroll 1
        for (int t = 0; t < nt; t += 2) {
            const bool last = (t == nt - 2);
            const unsigned a1 = cA + (unsigned)(t + 1) * kstep;
            const unsigned a2 = last ? nA : cA + (unsigned)(t + 2) * kstep, b2 = last ? nB : cB + (unsigned)(t + 2) * kstep;
            const unsigned a3 = a2 + kstep, b3 = b2 + kstep;
            const int selc = ui & 1, seln = (last && has_next) ? ((ui + 1) & 1) : selc;
            PG8_LDB(B0, 0, 0); PG8_LDB(B1, 0, 1); PG8_SCHED; PG8_LDA(At, 0, 0); { PG8_OA(q_, selc, 1); PG8_STAGE(PG8_SA(1, 1), rsA, a1 + hA, q_); }
            PG8_WAIT_V(8); PG8_WAIT_L(0); PG8_BAR; if (t == 0) { PG8_MMA0(0, 0, At, B0); PG8_MMA0(0, 1, At, B1); } else { PG8_MMA(0, 0, At, B0); PG8_MMA(0, 1, At, B1); } PG8_BAR; PG8_SCHED;
            PG8_LDA(At, 0, 1); PG8_STAGE(PG8_SB(0, 0), rsB, b2, voffB); PG8_STAGE(PG8_SB(0, 1), rsB, b2 + hstep, voffB); { PG8_OA(q_, seln, 0); PG8_STAGE(PG8_SA(0, 0), rsA, a2, q_); }
            PG8_WAIT_V(8); PG8_WAIT_L(0); PG8_BAR; if (t == 0) { PG8_MMA0(1, 0, At, B0); PG8_MMA0(1, 1, At, B1); } else { PG8_MMA(1, 0, At, B0); PG8_MMA(1, 1, At, B1); } PG8_BAR; PG8_SCHED;
            PG8_LDB(B0, 1, 0); PG8_LDB(B1, 1, 1); PG8_SCHED; PG8_LDA(At, 1, 0); { PG8_OA(q_, seln, 1); PG8_STAGE(PG8_SA(0, 1), rsA, a2 + hA, q_); }
            PG8_WAIT_V(8); PG8_WAIT_L(0); PG8_BAR; PG8_MMA(0, 0, At, B0); PG8_MMA(0, 1, At, B1); PG8_BAR; PG8_SCHED;
            PG8_LDA(At, 1, 1); PG8_STAGE(PG8_SB(1, 0), rsB, b3, voffB); PG8_STAGE(PG8_SB(1, 1), rsB, b3 + hstep, voffB); { PG8_OA(q_, seln, 0); PG8_STAGE(PG8_SA(1, 0), rsA, a3, q_); }
            PG8_WAIT_V(8); PG8_WAIT_L(0); PG8_BAR; PG8_MMA(1, 0, At, B0); PG8_MMA(1, 1, At, B1); PG8_BAR; PG8_SCHED;
        }
        if constexpr (ALIGN) { if (wr == 0) PG8_BAR; }
        E(acc, cur, wr, wc, fr, fq, sideb + (ui % 3) * 512);
        if constexpr (DUPK == 5) { asm volatile("" ::: "memory"); E(acc, cur, wr, wc, fr, fq, sideb + (ui % 3) * 512); }
        if (!has_next) break;
        cur = nxt; cA = nA; cB = nB; ++ui;
        if constexpr (ALIGN) { if (wr == 1) PG8_BAR; }
    }
    PG8_WAIT_V(0);
    if constexpr (!ALIGN) { if (wr == 0) PG8_BAR; }
    PG8_BAR;
#undef PG8_SA
#undef PG8_SB
#undef PG8_STAGE
#undef PG8_SIDE
#undef PG8_OA
#undef PG8_LDA
#undef PG8_LDB
#undef PG8_MMA
#undef PG8_MMA0
#undef PG8_CAT
#undef PG8_WAIT_V
#undef PG8_WAIT_L
#undef PG8_BAR
#undef PG8_SCHED
}

typedef GAS unsigned gu32;
#define XB_TMO      128
#define XB_XCNT(j)  (256  + 64 * (j))
#define XB_XSUB(j)  (1280 + 64 * (j))
#define XB_XGEN(j)  (2304 + 64 * (j))
#define XB_TOP      3328
#define XB_TOPGEN   3392
#define XCD_BAR_WORDS 3456
#define XB_SPIN_CAP (1u << 20)
#ifndef XB_DIRECT
#define XB_DIRECT 1
#endif
DEV unsigned xb_ld(unsigned* p) { return __hip_atomic_load(p, __ATOMIC_RELAXED, __HIP_MEMORY_SCOPE_AGENT); }
DEV unsigned xb_add(unsigned* p, unsigned v) { return __hip_atomic_fetch_add(p, v, __ATOMIC_RELAXED, __HIP_MEMORY_SCOPE_AGENT); }
DEV unsigned xb_xcc_id() { return (unsigned)__builtin_amdgcn_s_getreg((3 << 11) | 20) & 0xFu; }
#define XB_SPIN(cond, bar) do { unsigned _sp = 0; while (cond) { __builtin_amdgcn_s_sleep(1); \
    if ((++_sp & 255u) == 0u) { if (xb_ld(&(bar)[XB_TMO])) break; if (_sp > XB_SPIN_CAP) { atomicAdd(&(bar)[XB_TMO], 1u); break; } } } } while (0)
struct XcdBarrier { unsigned* bar; unsigned x; volatile LAS unsigned* st; int wave; };
DEV bool xb_thread0(int wave) { return wave == 0 && __builtin_amdgcn_mbcnt_hi(~0u, __builtin_amdgcn_mbcnt_lo(~0u, 0u)) == 0u; }
DEV XcdBarrier xcd_barrier_post(unsigned* bar, volatile LAS unsigned* st, int wave) {
    XcdBarrier b; b.bar = bar; b.x = xb_xcc_id(); b.st = st; b.wave = wave;
    if (xb_thread0(wave)) (void)xb_add(&bar[XB_XCNT(b.x)], 1u);
    return b;
}
DEV void xcd_barrier_complete(unsigned* bar, unsigned x, unsigned& nloc, unsigned& nx) {
    const unsigned G = gridDim.x * gridDim.y * gridDim.z;
    unsigned sum, cnt, mine, sp = 0u;
    for (;;) {
        sum = 0u; cnt = 0u; mine = 0u;
#pragma unroll
        for (unsigned j = 0; j < 16; ++j) { const unsigned c = xb_ld(&bar[XB_XCNT(j)]); sum += c; cnt += (c > 0u) ? 1u : 0u; mine = (j == x) ? c : mine; }
        if (sum == G) break;
        __builtin_amdgcn_s_sleep(1);
        if ((++sp & 255u) == 0u) { if (xb_ld(&bar[XB_TMO])) break; if (sp > XB_SPIN_CAP) { atomicAdd(&bar[XB_TMO], 1u); break; } }
    }
    nloc = mine > 0u ? mine : 1u; nx = cnt > 0u ? cnt : 1u;
}
DEV void xcd_barrier(const XcdBarrier& b) {
    asm volatile("s_waitcnt vmcnt(0)" ::: "memory");
    __syncthreads();
    if (xb_thread0(b.wave)) {
        unsigned* bar = b.bar;
        __builtin_amdgcn_s_waitcnt(0);
        unsigned nloc = b.st[0], nx = b.st[1];
        if (nloc == 0u) { xcd_barrier_complete(bar, b.x, nloc, nx); b.st[0] = nloc; b.st[1] = nx; }
        const unsigned old = xb_add(&bar[XB_XSUB(b.x)], 1u);
        const unsigned gen = old / nloc;
        if (old + 1u == (gen + 1u) * nloc) {
            __builtin_amdgcn_fence(__ATOMIC_RELEASE, "agent");
            asm volatile("s_waitcnt vmcnt(0)" ::: "memory");
            const unsigned og = xb_add(&bar[XB_TOP], 1u);
            const unsigned tg = og / nx;
            if (og + 1u == (tg + 1u) * nx) xb_add(&bar[XB_TOPGEN], 1u);
            else XB_SPIN(xb_ld(&bar[XB_TOPGEN]) == tg, bar);
            __builtin_amdgcn_fence(__ATOMIC_ACQUIRE, "agent");
#if !XB_DIRECT
            xb_add(&bar[XB_XGEN(b.x)], 1u);
#endif
            asm volatile("s_waitcnt vmcnt(0)" ::: "memory");
        } else {
#if XB_DIRECT
            XB_SPIN(xb_ld(&bar[XB_TOPGEN]) == gen, bar);
#else
            XB_SPIN(xb_ld(&bar[XB_XGEN(b.x)]) == gen, bar);
#endif
            __builtin_amdgcn_fence(__ATOMIC_ACQUIRE, "agent");
            asm volatile("s_waitcnt vmcnt(0)" ::: "memory");
        }
    }
    __syncthreads();
}
constexpr size_t MiB = 1u << 20;
constexpr int PMAX = 131072 + 32 * 256;
constexpr size_t W_CTL = 0, CTL_ZERO_BYTES = 64 * 1024;
constexpr size_t W_IN0 = 2 * MiB, W_GLU = 6 * MiB, W_OUT0 = 7 * MiB, W_IN1 = 9 * MiB, W_OUT1 = 16 * MiB;
constexpr size_t W_LUT = 18 * MiB, W_KM = W_LUT + 64 * 1024, W_HIST = W_KM + 256 * 1024, W_SORT = W_HIST + 64 * 1024  , W_BGU2 = 19 * MiB  , W_GR = 20 * MiB  , W_SS = 22 * MiB  ;
constexpr size_t W_GU = 32 * MiB, W_DN = 288 * MiB, W_XB = 416 * MiB  , W_XBB = 480 * MiB  , W_X8 = 1024 * MiB  , W_HB = 736 * MiB, W_YS5 = 928 * MiB, W_Y0 = 960 * MiB, W_MIXB = 1024 * MiB, W_GLAO = 1088 * MiB;
constexpr size_t W_ROUTE = 26 * MiB  , W_ACT = 736 * MiB  , W_YS = 1160 * MiB, W_END = 1432 * MiB;
static_assert(W_ACT + (size_t)PMAX * 2048 <= W_MIXB && W_YS + (size_t)PMAX * 2048 <= W_END && W_X8 + (size_t)PMAX * 1024 <= W_YS && W_ROUTE + 4 * MiB <= W_GU, "ws map");
constexpr int CW_BAR = 4096;

struct Args { const float* in[29]; float* out; unsigned char* ws; int ph_lo, ph_hi; };
struct Frame {
    LAS unsigned char* lds; int tid, lane, wave, vcu, G;
    const float* const* in; unsigned char* ws;
};
#define WSP(T_, off) ((T_*)(F.ws + (off)))

DEV unsigned pk4_fp8(float a, float b, float c, float d) { unsigned w = 0u; w = __builtin_amdgcn_cvt_pk_fp8_f32(a, b, w, false); w = __builtin_amdgcn_cvt_pk_fp8_f32(c, d, w, true); return w; }
struct CvItem { const float* src; unsigned char* dst; int pitch, K; float sc; };
constexpr int P0_I_GU = 8 * 8, P0_I_DN = 8 * 4, P0_I_IN0 = 8 * 8, P0_I_GLU = 4 * 2, P0_I_O = 8 * 4, P0_I_IN1 = 8 * 12;
constexpr int P0_N_GU = 64 * P0_I_GU, P0_N_DN = 64 * P0_I_DN, P0_NITEMS = P0_N_GU + P0_N_DN + P0_I_IN0 + P0_I_GLU + 2 * P0_I_O + P0_I_IN1;
DEV CvItem cv_decode(Frame& F, int it) {
    int r = it; const float* W; unsigned char* D; int K, N, NP, es; float sc = 0.f;
    if (r < P0_N_GU) { const int m = r / P0_I_GU; r %= P0_I_GU; W = F.in[25] + (size_t)m * 1024 * 2048; D = WSP(unsigned char, W_GU) + (size_t)m * 2048 * 1024; K = 1024; N = 2048; NP = 2048; es = 1; sc = 64.f; }
    else if ((r -= P0_N_GU) < P0_N_DN) { const int m = r / P0_I_DN; r %= P0_I_DN; W = F.in[27] + (size_t)m * 1024 * 1024; D = WSP(unsigned char, W_DN) + (size_t)m * 1024 * 1024; K = 1024; N = 1024; NP = 1024; es = 1; sc = 128.f; }
    else if ((r -= P0_N_DN) < P0_I_IN0) { W = F.in[1]; D = WSP(unsigned char, W_IN0); K = 1024; N = 2048; NP = 2048; es = 2; }
    else if ((r -= P0_I_IN0) < P0_I_GLU) { W = F.in[10]; D = WSP(unsigned char, W_GLU); K = 512; N = 512; NP = 512; es = 2; }
    else if ((r -= P0_I_GLU) < P0_I_O) { W = F.in[13]; D = WSP(unsigned char, W_OUT0); K = 1024; N = 1024; NP = 1024; es = 2; }
    else if ((r -= P0_I_O) < P0_I_O) { W = F.in[18]; D = WSP(unsigned char, W_OUT1); K = 1024; N = 1024; NP = 1024; es = 2; }
    else { r -= P0_I_O; W = F.in[14]; D = WSP(unsigned char, W_IN1); K = 1024; N = 3072; NP = 3088; es = 2; }
    const int nblk = N / 256, kb = r / nblk, nb = r % nblk;
    CvItem c; c.src = W + (size_t)(128 * kb) * NP + 256 * nb; c.dst = D + ((size_t)(256 * nb) * K + 128 * kb) * es; c.pitch = NP; c.K = K; c.sc = sc; return c;
}
DEV void cv_load(const CvItem& c, f32x4 (&v)[16], int tid) {
#pragma unroll
    for (int i = 0; i < 16; ++i) v[i] = *(const f32x4*)(c.src + (size_t)(8 * i + (tid >> 6)) * c.pitch + 4 * (tid & 63));
}
DEV void cv_store(const CvItem& c, const f32x4 (&v)[16], LAS float* T_, int tid) {
#pragma unroll
    for (int i = 0; i < 16; ++i) *(LAS f32x4*)(T_ + (8 * i + (tid >> 6)) * 260 + 4 * (tid & 63)) = v[i];
    __syncthreads();
    const int n = tid & 255, kh = tid >> 8; const LAS float* s = T_ + (64 * kh) * 260 + n;
    if (c.sc > 0.f) { const float q = c.sc; unsigned char* d = c.dst + (size_t)n * c.K + 64 * kh;
#pragma unroll
        for (int g = 0; g < 4; ++g) { u32x4 o;
            o.x = pk4_fp8(s[(16 * g + 0) * 260] * q, s[(16 * g + 1) * 260] * q, s[(16 * g + 2) * 260] * q, s[(16 * g + 3) * 260] * q); o.y = pk4_fp8(s[(16 * g + 4) * 260] * q, s[(16 * g + 5) * 260] * q, s[(16 * g + 6) * 260] * q, s[(16 * g + 7) * 260] * q);
            o.z = pk4_fp8(s[(16 * g + 8) * 260] * q, s[(16 * g + 9) * 260] * q, s[(16 * g + 10) * 260] * q, s[(16 * g + 11) * 260] * q); o.w = pk4_fp8(s[(16 * g + 12) * 260] * q, s[(16 * g + 13) * 260] * q, s[(16 * g + 14) * 260] * q, s[(16 * g + 15) * 260] * q);
            st_wt(d + 16 * g, o); }
    } else { unsigned char* d = c.dst + ((size_t)n * c.K + 64 * kh) * 2;
#pragma unroll
        for (int g = 0; g < 8; ++g) { u32x4 o; o.x = cvt_pk(s[(8 * g + 0) * 260], s[(8 * g + 1) * 260]); o.y = cvt_pk(s[(8 * g + 2) * 260], s[(8 * g + 3) * 260]); o.z = cvt_pk(s[(8 * g + 4) * 260], s[(8 * g + 5) * 260]); o.w = cvt_pk(s[(8 * g + 6) * 260], s[(8 * g + 7) * 260]);
            st_wt(d + 16 * g, o); }
    }
    __syncthreads();
}
__constant__ int BUCKET_TH2[16] = {16, 22, 30, 40, 54, 73, 99, 134, 182, 246, 332, 450, 609, 825, 1117, 1513};
DEV void p0_prologue(Frame& F) {
    { LAS float* T_ = (LAS float*)F.lds; f32x4 va[16], vb[16];
      int it = F.vcu;
      if (it < P0_NITEMS) { CvItem ca = cv_decode(F, it); cv_load(ca, va, F.tid);
#pragma unroll 1
          for (;;) {
              const int it2 = it + F.G; CvItem cb = ca; const bool h2 = it2 < P0_NITEMS; if (h2) { cb = cv_decode(F, it2); cv_load(cb, vb, F.tid); }
              cv_store(ca, va, T_, F.tid);
              if (!h2) break;
              const int it3 = it2 + F.G; const bool h3 = it3 < P0_NITEMS; if (h3) { ca = cv_decode(F, it3); cv_load(ca, va, F.tid); }
              cv_store(cb, vb, T_, F.tid);
              if (!h3) break;
              it = it3;
          } } }
    const int gt = F.vcu * 512 + F.tid, NGT = F.G * 512;
    for (int i = gt; i < 16 * 1024; i += NGT) { const int n = i >> 10, k = i & 1023; WSP(bf16_t, W_IN1)[(size_t)(3072 + n) * 1024 + k] = (bf16_t)(cvt_pk(F.in[14][(size_t)k * 3088 + 3072 + n], 0.f) & 0xffffu); }
    { const f32x4* x4 = (const f32x4*)F.in[0]; u32x2* o = WSP(u32x2, W_XB);
      for (size_t i = gt; i < (size_t)T * 1024 / 4; i += (size_t)NGT * 8) { f32x4 v[8];
#pragma unroll
          for (int u = 0; u < 8; ++u) v[u] = x4[i + (size_t)u * NGT];
#pragma unroll
          for (int u = 0; u < 8; ++u) { u32x2 w; w.x = cvt_pk(v[u].x, v[u].y); w.y = cvt_pk(v[u].z, v[u].w); st_wt(o + i + (size_t)u * NGT, w); } } }
    for (int i = gt; i < 2 * 32 * 2048 / 4; i += NGT) { const f32x4 v = ((const f32x4*)F.in[26])[i]; WSP(f32x4, W_BGU2)[i] = (f32x4){v.x, v.z, 4.f * (v.y + 1.f), 4.f * (v.w + 1.f)}; }
    for (int i = gt; i < 8 * 2048; i += NGT) { const int h = i >> 11, n = i & 2047; int bk = n;
        if (n >= 16) { bk = 16;
#pragma unroll
            for (int q = 1; q < 16; ++q) bk += (n >= BUCKET_TH2[q]) ? 1 : 0; }
        WSP(float, W_LUT)[i] = F.in[12][bk * 8 + h] * 1.4426950408889634f; }
}

DEV void p_kmean(Frame& F) {
    const int gw = F.vcu * 8 + F.wave, NGW = F.G * 8; const bf16_t* H0 = WSP(bf16_t, W_HB); float* KM = WSP(float, W_KM);
    for (int it = gw; it < 1024; it += NGW) { const int blk = it & 7, h = (it >> 3) & 7, b = it >> 6; const int r8 = F.lane >> 3, c = F.lane & 7;
        const bf16_t* p = H0 + (size_t)(b * 2048 + blk * 256 + r8) * 2048 + 1024 + h * 64 + c * 8; float s[8];
#pragma unroll
        for (int j = 0; j < 8; ++j) s[j] = 0.f;
#pragma unroll 8
        for (int i = 0; i < 32; ++i) { const u32x4 v = *(const u32x4*)(p + (size_t)i * 8 * 2048);
            s[0] += bflo(v.x); s[1] += bfhi(v.x); s[2] += bflo(v.y); s[3] += bfhi(v.y); s[4] += bflo(v.z); s[5] += bfhi(v.z); s[6] += bflo(v.w); s[7] += bfhi(v.w); }
#pragma unroll
        for (int j = 0; j < 8; ++j) { s[j] += __shfl_xor(s[j], 8); s[j] += __shfl_xor(s[j], 16); s[j] += __shfl_xor(s[j], 32); }
        if (F.lane < 8) {
#pragma unroll
            for (int j = 0; j < 8; ++j) KM[(size_t)it * 64 + c * 8 + j] = s[j] * (1.f / 256.f); } }
}

DEV void s5_item(Frame& F, int b, int g, LAS unsigned char* sl  ) {
    const int lane = F.lane, p0 = lane & 31, hi = lane >> 5, q4 = lane >> 4;
    const float* lam_re = F.in[2]; const float* lam_im = F.in[3]; const float* log_dt = F.in[4]; const float* b_re = F.in[5]; const float* b_im = F.in[6];
    const float* c_re = F.in[7]; const float* c_im = F.in[8]; const float* dsk = F.in[9];
    const bf16_t* H0 = WSP(bf16_t, W_HB); bf16_t* YS = WSP(bf16_t, W_YS5);
    const float dt = __expf(log_dt[g]);
    float ar[2], ai[2]; bf16x8 bfr[4];
#pragma unroll
    for (int s = 0; s < 2; ++s) { const int p = p0 + 32 * s; const float lr = lam_re[g * 64 + p], li = lam_im[g * 64 + p]; const float mag = __expf(lr * dt);
        ar[s] = mag * cosf(li * dt); ai[s] = mag * sinf(li * dt);
        const float er = ar[s] - 1.f, ei = ai[s], den = lr * lr + li * li; const float qr = (er * lr + ei * li) / den, qi = (ei * lr - er * li) / den;
        u32x4 wr_, wi_; float vr[8], vi[8];
#pragma unroll
        for (int j = 0; j < 8; ++j) { const float br = b_re[(g * 64 + p) * 16 + 8 * hi + j], bi = b_im[(g * 64 + p) * 16 + 8 * hi + j]; vr[j] = qr * br - qi * bi; vi[j] = qr * bi + qi * br; }
        wr_.x = cvt_pk(vr[0], vr[1]); wr_.y = cvt_pk(vr[2], vr[3]); wr_.z = cvt_pk(vr[4], vr[5]); wr_.w = cvt_pk(vr[6], vr[7]);
        wi_.x = cvt_pk(vi[0], vi[1]); wi_.y = cvt_pk(vi[2], vi[3]); wi_.z = cvt_pk(vi[4], vi[5]); wi_.w = cvt_pk(vi[6], vi[7]);
        bfr[2 * s] = __builtin_bit_cast(bf16x8, wr_); bfr[2 * s + 1] = __builtin_bit_cast(bf16x8, wi_); }
    bf16x8 cfr[4];
#pragma unroll
    for (int ks = 0; ks < 4; ++ks) { float v[8];
#pragma unroll
        for (int j = 0; j < 8; ++j) { const int c = 32 * ks + 8 * q4 + j, p = c >> 1; const int h = lane & 15; v[j] = (c & 1) ? -c_im[(g * 16 + h) * 64 + p] : c_re[(g * 16 + h) * 64 + p]; }
        u32x4 w; w.x = cvt_pk(v[0], v[1]); w.y = cvt_pk(v[2], v[3]); w.z = cvt_pk(v[4], v[5]); w.w = cvt_pk(v[6], v[7]); cfr[ks] = __builtin_bit_cast(bf16x8, w); }
    float dv[4];
#pragma unroll
    for (int r = 0; r < 4; ++r) dv[r] = dsk[g * 16 + 4 * q4 + r];
    const int tm = 16 * ((p0 >> 2) & 1) + 4 * (p0 >> 3) + (p0 & 3);
    const bf16_t* urow = H0 + (size_t)(b * 2048 + tm) * 2048 + g * 16 + 8 * hi;
    float cr[2] = {0.f, 0.f}, ci[2] = {0.f, 0.f};
    bf16x8 ufr = *(const bf16x8*)urow;
    for (int tile = 0; tile < 64; ++tile) {
        const bf16x8 ucur = ufr;
        if (tile + 1 < 64) ufr = *(const bf16x8*)(urow + (size_t)(tile + 1) * 32 * 2048);
        f32x16 x[4];
#pragma unroll
        for (int n = 0; n < 4; ++n) { f32x16 z;
#pragma unroll
            for (int r = 0; r < 16; ++r) z[r] = 0.f;
            x[n] = __builtin_amdgcn_mfma_f32_32x32x16_bf16(ucur, bfr[n], z, 0, 0, 0); }
#pragma unroll
        for (int s = 0; s < 2; ++s) {
            f32x16& xr = x[2 * s]; f32x16& xi = x[2 * s + 1];
            float sr = hi ? 0.f : cr[s], si = hi ? 0.f : ci[s];
#pragma unroll
            for (int r = 0; r < 16; ++r) { const float nr = ar[s] * sr - ai[s] * si + xr[r], ni = ar[s] * si + ai[s] * sr + xi[r]; xr[r] = nr; xi[r] = ni; sr = nr; si = ni; }
            const float o_r = swap32(sr), o_i = swap32(si);
            float wr_ = hi ? o_r : 0.f, wi_ = hi ? o_i : 0.f;
#pragma unroll
            for (int r = 0; r < 16; ++r) { const float nr = ar[s] * wr_ - ai[s] * wi_, ni = ar[s] * wi_ + ai[s] * wr_; wr_ = nr; wi_ = ni; xr[r] += wr_; xi[r] += wi_; }
            const float e_r = swap32(xr[15]), e_i = swap32(xi[15]);
            cr[s] = hi ? xr[15] : e_r; ci[s] = hi ? xi[15] : e_i;
#pragma unroll
            for (int r = 0; r < 16; ++r) *(LAS unsigned*)(sl + (16 * hi + r) * 256 + (p0 + 32 * s) * 4) = cvt_pk(xr[r], xi[r]);
        }
#pragma unroll
        for (int tt = 0; tt < 2; ++tt) {
            f32x4 y = {0.f, 0.f, 0.f, 0.f};
#pragma unroll
            for (int ks = 0; ks < 4; ++ks) { const bf16x8 sf = *(const LAS bf16x8*)(sl + (16 * tt + (lane & 15)) * 256 + ks * 64 + q4 * 16); y = __builtin_amdgcn_mfma_f32_16x16x32_bf16(cfr[ks], sf, y, 0, 0, 0); }
            const int t = tile * 32 + 16 * tt + (lane & 15);
            const u32x2 uw = *(const u32x2*)(H0 + (size_t)(b * 2048 + t) * 2048 + g * 16 + 4 * q4);
            const float y0 = gelu_tanh(y[0] + dv[0] * bflo(uw.x)), y1 = gelu_tanh(y[1] + dv[1] * bfhi(uw.x)), y2 = gelu_tanh(y[2] + dv[2] * bflo(uw.y)), y3 = gelu_tanh(y[3] + dv[3] * bfhi(uw.y));
            u32x2 ow; ow.x = cvt_pk(y0, y1); ow.y = cvt_pk(y2, y3);
            *(u32x2*)(YS + (size_t)(b * 2048 + t) * 512 + g * 16 + 4 * q4) = ow;
        }
    }
}

constexpr int AT_K = 0, AT_V = 24576, AT_WS = 49152, AT_OST = 51200, AT_LUT = AT_OST + 8 * 4096  , AT_LUTB = 8704, AT_Q = AT_LUT + 8 * AT_LUTB  , AT_END = AT_Q + 64;
DEV int crow(int r, int hi) { return (r & 3) + 8 * (r >> 2) + 4 * hi; }
DEV s16x4 vtr(const LAS unsigned char* p) { typedef short v4i16_t __attribute__((ext_vector_type(4))); return __builtin_bit_cast(s16x4, __builtin_amdgcn_ds_read_tr16_b64_v4i16((LAS v4i16_t*)p)); }
DEV void moba_unit(Frame& F, int b, int h, int own) {
    const int lane = F.lane, wid = F.wave, r32 = lane & 31, hi = lane >> 5;
    LAS unsigned char* lds = F.lds;
    const bf16_t* H0 = WSP(bf16_t, W_HB); const float* KM = WSP(float, W_KM);
    LAS float* lut = (LAS float*)(lds + AT_LUT + h * AT_LUTB); LAS float* wsf = (LAS float*)(lds + AT_WS) + wid * 64;
    const size_t rowbase = (size_t)b * 2048;
    const int qpos = own * 256 + wid * 32 + r32;
    bf16x8 qr[4];
#pragma unroll
    for (int d0 = 0; d0 < 4; ++d0) qr[d0] = *(const bf16x8*)(H0 + (rowbase + qpos) * 2048 + 512 + h * 64 + d0 * 16 + hi * 8);
    unsigned selmask = 0u;
    if (own > 0) {
        float gate[7];
#pragma unroll
        for (int j = 0; j < 7; ++j) { float s = 0.f;
            if (j < own) { const float* km = KM + ((size_t)(b * 8 + h) * 8 + j) * 64 + hi * 8;
#pragma unroll
                for (int d0 = 0; d0 < 4; ++d0) { const f32x4 k0 = *(const f32x4*)(km + d0 * 16), k1 = *(const f32x4*)(km + d0 * 16 + 4); const u32x4 qw = __builtin_bit_cast(u32x4, qr[d0]);
                    s += bflo(qw.x) * k0.x + bfhi(qw.x) * k0.y + bflo(qw.y) * k0.z + bfhi(qw.y) * k0.w + bflo(qw.z) * k1.x + bfhi(qw.z) * k1.y + bflo(qw.w) * k1.z + bfhi(qw.w) * k1.w; } }
            gate[j] = s + swap32(s); }
#pragma unroll
        for (int j = 0; j < 7; ++j) { int rank = 0;
#pragma unroll
            for (int j2 = 0; j2 < 7; ++j2) if (j2 != j && j2 < own && (gate[j2] > gate[j] || (gate[j2] == gate[j] && j2 < j))) ++rank;
            if (j < own && rank < 3) selmask |= 1u << j; }
    }
    const int NT = 4 * (own + 1);
#define KV0(i) ((i) < 4 ? own * 256 + (i) * 64 : (((i) - 4) >> 2) * 256 + (((i) - 4) & 3) * 64)
    const bf16_t* kbase = H0 + (rowbase + lane) * 2048 + 1024 + h * 64 + wid * 8;
    const bf16_t* vbase = H0 + (rowbase + 16 * (wid & 3) + (lane >> 2)) * 2048 + 1536 + h * 64 + (wid >> 2) * 32 + (lane & 3) * 8;
#define LOADKV(i, bo_) do { const int kv0_ = KV0(i); \
        __builtin_amdgcn_global_load_lds((const unsigned*)(kbase + (size_t)kv0_ * 2048), (LAS unsigned*)(lds + AT_K + bo_ + wid * 1024), 16, 0, 0); \
        __builtin_amdgcn_global_load_lds((const unsigned*)(vbase + (size_t)kv0_ * 2048), (LAS unsigned*)(lds + AT_V + bo_ + wid * 1024), 16, 0, 0); } while (0)
    LOADKV(0, 0); LOADKV(1, 8192);
    int bo = 0, bo2 = 16384;
    float m_ref = 0.f, l_run = 0.f; f32x16 o[2];
#pragma unroll
    for (int r = 0; r < 16; ++r) { o[0][r] = 0.f; o[1][r] = 0.f; }
    const int Q0 = own * 256 + wid * 32;
#pragma unroll 1
    for (int i = 0; i < NT; ++i) {
        if (i + 1 < NT) asm volatile("s_waitcnt vmcnt(2) lgkmcnt(0)\n\ts_barrier" ::: "memory"); else asm volatile("s_waitcnt vmcnt(0) lgkmcnt(0)\n\ts_barrier" ::: "memory");
        if (i + 2 < NT) LOADKV(i + 2, bo2);
        const int kv0 = KV0(i);
        const bool ownblk = i < 4;
        if (!(ownblk && kv0 > Q0 + 31)) {
            const bool partial = ownblk && (kv0 + 63 > Q0);
            const bool rowsel = ownblk || ((selmask >> ((i - 4) >> 2)) & 1u);
            f32x16 p0, p1;
            { const LAS float* lp = lut + 128 + (qpos - kv0 - 4 * hi - 59);
#pragma unroll
              for (int r = 0; r < 16; ++r) { const int c = (r & 3) + 8 * (r >> 2); p0[r] = lp[59 - c] - m_ref; p1[r] = lp[59 - c - 32] - m_ref; } }
            { const LAS unsigned char* kb = lds + AT_K + bo + hi * 1024 + r32 * 16;
#pragma unroll
              for (int d0 = 0; d0 < 4; ++d0) { const bf16x8 k0 = *(const LAS bf16x8*)(kb + d0 * 2048), k1 = *(const LAS bf16x8*)(kb + d0 * 2048 + 512);
                  p0 = __builtin_amdgcn_mfma_f32_32x32x16_bf16(k0, qr[d0], p0, 0, 0, 0); p1 = __builtin_amdgcn_mfma_f32_32x32x16_bf16(k1, qr[d0], p1, 0, 0, 0); } }
            if (partial) { const int dbase = qpos - kv0 - 4 * hi;
#pragma unroll
                for (int r = 0; r < 16; ++r) { const int d0_ = dbase - ((r & 3) + 8 * (r >> 2)); p0[r] = d0_ >= 0 ? p0[r] : -INFINITY; p1[r] = d0_ >= 32 ? p1[r] : -INFINITY; } }
            float rmax = fmaxf(p0[0], p1[0]);
#pragma unroll
            for (int r = 1; r < 16; ++r) rmax = fmaxf(rmax, fmaxf(p0[r], p1[r]));
            rmax = fmaxf(rmax, swap32(rmax));
            rmax = rowsel ? rmax : -INFINITY;
            if (i == 0 || __any(rmax > 8.f)) {
                const float dl = (i == 0) ? rmax : fmaxf(rmax, 0.f); m_ref += dl;
#pragma unroll
                for (int r = 0; r < 16; ++r) { p0[r] -= dl; p1[r] -= dl; }
                const float alpha = __builtin_amdgcn_exp2f(-dl); l_run *= alpha;
                if (hi == 0) wsf[r32] = alpha;
#pragma unroll
                for (int r = 0; r < 16; ++r) { const float f = wsf[crow(r, hi)]; o[0][r] *= f; o[1][r] *= f; }
            }
            float rs = 0.f;
#pragma unroll
            for (int r = 0; r < 16; ++r) { p0[r] = __builtin_amdgcn_exp2f(p0[r]); p1[r] = __builtin_amdgcn_exp2f(p1[r]); rs += p0[r] + p1[r]; }
            l_run += rowsel ? rs : 0.f;
            const unsigned km = rowsel ? 0xffffffffu : 0u;
            u32x4 pw[4];
            pw[0] = (u32x4){cvt_pk(p0[0], p0[1]) & km, cvt_pk(p0[2], p0[3]) & km, cvt_pk(p0[4], p0[5]) & km, cvt_pk(p0[6], p0[7]) & km};
            pw[1] = (u32x4){cvt_pk(p0[8], p0[9]) & km, cvt_pk(p0[10], p0[11]) & km, cvt_pk(p0[12], p0[13]) & km, cvt_pk(p0[14], p0[15]) & km};
            pw[2] = (u32x4){cvt_pk(p1[0], p1[1]) & km, cvt_pk(p1[2], p1[3]) & km, cvt_pk(p1[4], p1[5]) & km, cvt_pk(p1[6], p1[7]) & km};
            pw[3] = (u32x4){cvt_pk(p1[8], p1[9]) & km, cvt_pk(p1[10], p1[11]) & km, cvt_pk(p1[12], p1[13]) & km, cvt_pk(p1[14], p1[15]) & km};
            { const LAS unsigned char* vp = lds + AT_V + bo + ((lane >> 4) & 1) * 32 + (lane & 3) * 8 + (4 * hi + ((lane & 15) >> 2)) * 64;
#pragma unroll
              for (int d0 = 0; d0 < 2; ++d0)
#pragma unroll
                  for (int ks = 0; ks < 4; ++ks) { const s16x4 lo = vtr(vp + d0 * 4096 + ks * 1024), hh = vtr(vp + d0 * 4096 + ks * 1024 + 512);
                      const bf16x8 vf = (bf16x8){lo[0], lo[1], lo[2], lo[3], hh[0], hh[1], hh[2], hh[3]};
                      o[d0] = __builtin_amdgcn_mfma_f32_32x32x16_bf16(__builtin_bit_cast(bf16x8, pw[ks]), vf, o[d0], 0, 0, 0); } }
        }
        bo = (bo == 16384) ? 0 : bo + 8192; bo2 = (bo2 == 16384) ? 0 : bo2 + 8192;
    }
    __syncthreads();
#undef KV0
#undef LOADKV
    l_run += swap32(l_run);
    if (hi == 0) wsf[32 + r32] = 1.f / l_run;
    bf16_t* Ow = WSP(bf16_t, W_Y0) + (rowbase + own * 256 + wid * 32) * 1024 + 512 + h * 64;
    LAS bf16_t* stg = (LAS bf16_t*)(lds + AT_OST) + wid * 2048;
#pragma unroll
    for (int r = 0; r < 16; ++r) { const int orow = crow(r, hi); const float rl = wsf[32 + orow];
        stg[orow * 64 + r32] = (bf16_t)(cvt_pk(o[0][r] * rl, 0.f) & 0xffffu); stg[orow * 64 + 32 + r32] = (bf16_t)(cvt_pk(o[1][r] * rl, 0.f) & 0xffffu); }
#pragma unroll
    for (int i = 0; i < 4; ++i) { const int row = i * 8 + (lane >> 3), ch = lane & 7; const u32x4 v = *(const LAS u32x4*)(stg + row * 64 + ch * 8); *(u32x4*)(Ow + (size_t)row * 1024 + ch * 8) = v; }
    __syncthreads();
}
constexpr int CW_MOBAQ = 64;
DEV void p_s5_moba(Frame& F, int mode) {
    if ((mode & 1) && (F.vcu & 3) == 3) { const int it = (F.vcu >> 2) * 8 + F.wave; if (it < 512) s5_item(F, it >> 5, it & 31, F.lds + 65536 + F.wave * 8192); }
    __syncthreads();
    if (!(mode & 2)) return;
    for (int i = F.tid; i < 8 * 2176; i += 512) { const int hh = i / 2176, j = i % 2176; ((LAS float*)(F.lds + AT_LUT))[i] = j < 128 ? 0.f : WSP(float, W_LUT)[hh * 2048 + j - 128]; }
    volatile LAS int* qw = (volatile LAS int*)(F.lds + AT_Q);
    unsigned* ctl = (unsigned*)(F.ws + W_CTL);
    for (;;) {
        __syncthreads();
        if (F.tid == 0) qw[0] = (int)__hip_atomic_fetch_add(ctl + CW_MOBAQ, 1u, __ATOMIC_RELAXED, __HIP_MEMORY_SCOPE_AGENT);
        __syncthreads();
        const int u = __builtin_amdgcn_readfirstlane(qw[0]);
        if (u >= 1024) break;
        const int own = 7 - (u >> 7), bh = u & 127;
        moba_unit(F, bh >> 3, bh & 7, own);
    }
}
constexpr size_t R_RE = W_ROUTE, R_RW = W_ROUTE + 512 * 1024, R_POS = W_ROUTE + 1024 * 1024, R_TOK = W_ROUTE + 2 * MiB, R_WGT = W_ROUTE + 3 * MiB;
constexpr int WT_PITCH = 1028;
constexpr int RW_PITCH = 1032;
constexpr int LN_XT = 32 * RW_PITCH * 2;
constexpr int LN_LG = 147456;
constexpr int LN_HIST = LN_LG + 8 * 528;
static_assert(LN_XT + 8 * 8256 <= LDS_TOK && LN_HIST + 128 <= LDSCTL_OFF, "LN LDS map");
template <int MODE, bool ROUTER, bool XIN_F32, bool OUT_F32, bool GRP = false>
DEV void p_ln(Frame& F, const float* xin32, const bf16_t* xinb, bf16_t* xoutb, float* xout32, const float* gam, const float* bet, const float* wrt, const float* brt) {
    LAS bf16_t* whi = (LAS bf16_t*)F.lds; LAS bf16_t* xt = (LAS bf16_t*)(F.lds + LN_XT) + F.wave * 4128; LAS float* lgs = (LAS float*)(F.lds + LN_LG) + F.wave * 132; LAS int* hist = (LAS int*)(F.lds + LN_HIST);
    const int lane = F.lane, l15 = lane & 15, q4 = lane >> 4;
    if constexpr (ROUTER) {
        for (int i = F.tid; i < 1024 * 32; i += 512) { const int k = i >> 5, e = i & 31; whi[e * RW_PITCH + k] = (bf16_t)(cvt_pk(wrt[i], 0.f) & 0xffffu); }
        if (F.tid < 32) hist[F.tid] = 0;
        __syncthreads();
    }
    if constexpr (GRP) {
        const u32x4* src = (const u32x4*)(WSP(bf16_t, W_IN1) + (size_t)3072 * 1024);
        for (int i = F.tid; i < 16 * 128; i += 512) { const int e = i >> 7, c = i & 127; *(LAS u32x4*)(whi + e * RW_PITCH + c * 8) = src[i]; }
        __syncthreads();
    }
    const bf16_t* MIXB = WSP(bf16_t, W_MIXB); const unsigned char* YS8 = WSP(unsigned char, W_YS); const int* POS = WSP(int, R_POS);
    int* RE = WSP(int, R_RE); float* RW = WSP(float, R_RW);
    const float alpha = 1.4142135623730951f;
    f32x4 gq[4], bq[4];
#pragma unroll
    for (int j = 0; j < 4; ++j) { gq[j] = *(const f32x4*)(gam + j * 256 + lane * 4); bq[j] = *(const f32x4*)(bet + j * 256 + lane * 4); }
    float bias8[8];
    if constexpr (ROUTER) {
#pragma unroll
        for (int r = 0; r < 8; ++r) bias8[r] = brt[(r >> 2) * 16 + 4 * q4 + (r & 3)]; }
    for (int wgi = F.vcu; wgi < 256; wgi += F.G) {
        const int r0 = wgi * 128 + F.wave * 16;
        constexpr bool PF = (MODE == 0) && !XIN_F32;
        u32x2 rx[4][4], rm[4][4];
        if constexpr (PF) {
#pragma unroll
            for (int u = 0; u < 4; ++u)
#pragma unroll
                for (int j = 0; j < 4; ++j) { rx[u][j] = *(const u32x2*)(xinb + (size_t)(r0 + u) * 1024 + j * 256 + lane * 4); rm[u][j] = *(const u32x2*)(MIXB + (size_t)(r0 + u) * 1024 + j * 256 + lane * 4); } }
#pragma unroll 1
        for (int i4 = 0; i4 < 16; i4 += 4) {
            float v[4][16];
            if constexpr (PF) {
#pragma unroll
                for (int u = 0; u < 4; ++u)
#pragma unroll
                    for (int j = 0; j < 4; ++j) { v[u][4 * j] = alpha * bflo(rx[u][j].x) + bflo(rm[u][j].x); v[u][4 * j + 1] = alpha * bfhi(rx[u][j].x) + bfhi(rm[u][j].x); v[u][4 * j + 2] = alpha * bflo(rx[u][j].y) + bflo(rm[u][j].y); v[u][4 * j + 3] = alpha * bfhi(rx[u][j].y) + bfhi(rm[u][j].y); }
                if (i4 + 4 < 16) {
#pragma unroll
                    for (int u = 0; u < 4; ++u)
#pragma unroll
                        for (int j = 0; j < 4; ++j) { rx[u][j] = *(const u32x2*)(xinb + (size_t)(r0 + i4 + 4 + u) * 1024 + j * 256 + lane * 4); rm[u][j] = *(const u32x2*)(MIXB + (size_t)(r0 + i4 + 4 + u) * 1024 + j * 256 + lane * 4); } }
            } else {
#pragma unroll
            for (int u = 0; u < 4; ++u) { const int row = r0 + i4 + u;
                if constexpr (XIN_F32) {
#pragma unroll
                    for (int j = 0; j < 4; ++j) { const f32x4 a = *(const f32x4*)(xin32 + (size_t)row * 1024 + j * 256 + lane * 4); v[u][4 * j] = alpha * a.x; v[u][4 * j + 1] = alpha * a.y; v[u][4 * j + 2] = alpha * a.z; v[u][4 * j + 3] = alpha * a.w; }
                } else {
#pragma unroll
                    for (int j = 0; j < 4; ++j) { const u32x2 a = *(const u32x2*)(xinb + (size_t)row * 1024 + j * 256 + lane * 4); v[u][4 * j] = alpha * bflo(a.x); v[u][4 * j + 1] = alpha * bfhi(a.x); v[u][4 * j + 2] = alpha * bflo(a.y); v[u][4 * j + 3] = alpha * bfhi(a.y); }
                }
                if constexpr (MODE == 0) {
#pragma unroll
                    for (int j = 0; j < 4; ++j) { const u32x2 m = *(const u32x2*)(MIXB + (size_t)row * 1024 + j * 256 + lane * 4); v[u][4 * j] += bflo(m.x); v[u][4 * j + 1] += bfhi(m.x); v[u][4 * j + 2] += bflo(m.y); v[u][4 * j + 3] += bfhi(m.y); }
                } else {
                    const int4 pos4 = *(const int4*)(POS + row * 4);
                    const int ps[4] = {__builtin_amdgcn_readfirstlane(pos4.x), __builtin_amdgcn_readfirstlane(pos4.y), __builtin_amdgcn_readfirstlane(pos4.z), __builtin_amdgcn_readfirstlane(pos4.w)};
#pragma unroll
                    for (int kx = 0; kx < 4; ++kx)
#pragma unroll
                        for (int j = 0; j < 4; ++j) { const unsigned m = *(const unsigned*)(YS8 + (size_t)ps[kx] * 1024 + j * 256 + lane * 4); const f32x2 lo2 = __builtin_amdgcn_cvt_pk_f32_fp8(m, false), hi2 = __builtin_amdgcn_cvt_pk_f32_fp8(m, true);
                            v[u][4 * j] += lo2.x * (1.f / 64.f); v[u][4 * j + 1] += lo2.y * (1.f / 64.f); v[u][4 * j + 2] += hi2.x * (1.f / 64.f); v[u][4 * j + 3] += hi2.y * (1.f / 64.f); }
                }
            }
            }
            float s1[4], s2[4];
#pragma unroll
            for (int u = 0; u < 4; ++u) { s1[u] = 0.f; s2[u] = 0.f;
#pragma unroll
                for (int q = 0; q < 16; ++q) { s1[u] += v[u][q]; s2[u] = fmaf(v[u][q], v[u][q], s2[u]); } }
#pragma unroll
            for (int o = 1; o < 64; o <<= 1) {
#pragma unroll
                for (int u = 0; u < 4; ++u) { s1[u] += __shfl_xor(s1[u], o); s2[u] += __shfl_xor(s2[u], o); } }
#pragma unroll
            for (int u = 0; u < 4; ++u) { const int row = r0 + i4 + u; const float mean = s1[u] * (1.f / 1024.f); const float var = fmaxf(s2[u] * (1.f / 1024.f) - mean * mean, 0.f); const float rstd = 1.f / sqrtf(var + 1e-5f);
#pragma unroll
                for (int j = 0; j < 4; ++j) { const int c = j * 256 + lane * 4; const f32x4 g4 = gq[j], b4 = bq[j];
                    const float y0 = (v[u][4 * j] - mean) * rstd * g4.x + b4.x, y1 = (v[u][4 * j + 1] - mean) * rstd * g4.y + b4.y, y2 = (v[u][4 * j + 2] - mean) * rstd * g4.z + b4.z, y3 = (v[u][4 * j + 3] - mean) * rstd * g4.w + b4.w;
                    if constexpr (OUT_F32) st_wt(xout32 + (size_t)row * 1024 + c, (f32x4){y0, y1, y2, y3});
                    else { u32x2 w; w.x = cvt_pk(y0, y1); w.y = cvt_pk(y2, y3); st_wt(xoutb + (size_t)row * 1024 + c, w);
                        if constexpr (ROUTER || GRP) { *(LAS u32x2*)(xt + u * RW_PITCH + c) = w; } } } }
            if constexpr (GRP) {
                f32x4 ga = {0.f, 0.f, 0.f, 0.f};
#pragma unroll 8
                for (int ks = 0; ks < 32; ++ks) { const bf16x8 xb = *(const LAS bf16x8*)(xt + (l15 & 3) * RW_PITCH + ks * 32 + q4 * 8), wa = *(const LAS bf16x8*)(whi + l15 * RW_PITCH + ks * 32 + q4 * 8);
                    ga = __builtin_amdgcn_mfma_f32_16x16x32_bf16(wa, xb, ga, 0, 0, 0); }
                if (l15 < 4) *(f32x4*)(WSP(float, W_GR) + (size_t)(r0 + i4 + l15) * 16 + 4 * q4) = ga; }
            if constexpr (ROUTER) {
                f32x4 acc[2] = {{0.f, 0.f, 0.f, 0.f}, {0.f, 0.f, 0.f, 0.f}};
#pragma unroll 8
                for (int ks = 0; ks < 32; ++ks) { const bf16x8 xb = *(const LAS bf16x8*)(xt + (l15 & 3) * RW_PITCH + ks * 32 + q4 * 8);
#pragma unroll
                    for (int mt = 0; mt < 2; ++mt) { const bf16x8 wa = *(const LAS bf16x8*)(whi + (mt * 16 + l15) * RW_PITCH + ks * 32 + q4 * 8); acc[mt] = __builtin_amdgcn_mfma_f32_16x16x32_bf16(wa, xb, acc[mt], 0, 0, 0); } }
                if (l15 < 4) {
#pragma unroll
                    for (int mt = 0; mt < 2; ++mt)
#pragma unroll
                        for (int r = 0; r < 4; ++r) lgs[l15 * 33 + mt * 16 + 4 * q4 + r] = acc[mt][r] + bias8[mt * 4 + r]; }
                if (lane < 4) { float lg[32];
#pragma unroll
                    for (int e = 0; e < 32; ++e) lg[e] = lgs[lane * 33 + e];
                    unsigned taken = 0u; float tv[4]; int ti[4];
#pragma unroll
                    for (int r = 0; r < 4; ++r) { float best = -INFINITY; int bi = 0;
#pragma unroll
                        for (int e = 0; e < 32; ++e) { const bool ok = !((taken >> e) & 1u) && lg[e] > best; best = ok ? lg[e] : best; bi = ok ? e : bi; }
                        taken |= 1u << bi; tv[r] = best; ti[r] = bi; }
                    float ex[4], sm = 0.f;
#pragma unroll
                    for (int r = 0; r < 4; ++r) { ex[r] = __expf(tv[r] - tv[0]); sm += ex[r]; }
                    const float inv = 1.f / sm; const int row = r0 + i4 + lane;
                    *(int4*)(RE + row * 4) = make_int4(ti[0], ti[1], ti[2], ti[3]); *(f32x4*)(RW + row * 4) = (f32x4){ex[0] * inv, ex[1] * inv, ex[2] * inv, ex[3] * inv};
#pragma unroll
                    for (int r = 0; r < 4; ++r) atomicAdd((int*)(hist + ti[r]), 1); }
            }
        }
        if constexpr (ROUTER) { __syncthreads(); if (F.tid < 32) { WSP(int, W_HIST)[wgi * 32 + F.tid] = hist[F.tid]; hist[F.tid] = 0; } __syncthreads(); }
    }
}

DEV void p_sort(Frame& F) {
    LAS int* Ls = (LAS int*)F.lds; const int tid = F.tid;
    const int* HIST = WSP(int, W_HIST); int* SORT = WSP(int, W_SORT);
    const int* RE = WSP(int, R_RE); const float* RW = WSP(float, R_RW); int* POS = WSP(int, R_POS); int* TOK = WSP(int, R_TOK); float* WGT = WSP(float, R_WGT);
    for (int wgi = F.vcu; wgi < 256; wgi += F.G) {
        { const int e = tid & 31, part = tid >> 5; int tot = 0, pre = 0;
          for (int w = part * 16; w < part * 16 + 16; ++w) { const int hh = HIST[w * 32 + e]; tot += hh; pre += (w < wgi) ? hh : 0; }
          Ls[part * 32 + e] = tot; Ls[512 + part * 32 + e] = pre; }
        Ls[2048 + tid] = RE[wgi * 512 + tid];
        __syncthreads();
        if (tid < 32) { int tot = 0, pre = 0; for (int p = 0; p < 16; ++p) { tot += Ls[p * 32 + tid]; pre += Ls[512 + p * 32 + tid]; } Ls[1200 + tid] = tot; Ls[1300 + tid] = pre; }
        __syncthreads();
        if (tid == 0) { int a = 0; for (int e = 0; e < 32; ++e) { Ls[1024 + e] = a; a += (Ls[1200 + e] + 255) / 256 * 256; } Ls[1056] = a; }
        __syncthreads();
        { const int e = tid & 31, seg = tid >> 5; int cnt = 0;
#pragma unroll 8
          for (int i = 0; i < 32; ++i) cnt += (Ls[2048 + seg * 32 + i] == e) ? 1 : 0;
          Ls[3072 + seg * 32 + e] = cnt;
          __syncthreads();
          int c = Ls[1024 + e] + Ls[1300 + e];
          for (int s2 = 0; s2 < seg; ++s2) c += Ls[3072 + s2 * 32 + e];
#pragma unroll 8
          for (int i = 0; i < 32; ++i) if (Ls[2048 + seg * 32 + i] == e) { Ls[2560 + seg * 32 + i] = c; ++c; } }
        __syncthreads();
        { const int pos = Ls[2560 + tid]; TOK[pos] = wgi * 128 + (tid >> 2); WGT[pos] = RW[wgi * 512 + tid]; POS[wgi * 512 + tid] = pos; }
        { const bf16_t* XBBp = WSP(bf16_t, W_XBB); unsigned char* XS8 = WSP(unsigned char, W_X8);
          for (int rg = 0; rg < 16; rg += 4) {
              u32x4 a[4], b2[4];
#pragma unroll
              for (int u = 0; u < 4; ++u) { const int r = F.wave * 16 + rg + u; const u32x4* src = (const u32x4*)(XBBp + (size_t)(wgi * 128 + r) * 1024 + F.lane * 16); a[u] = src[0]; b2[u] = src[1]; }
#pragma unroll
              for (int u = 0; u < 4; ++u) { const int r = F.wave * 16 + rg + u;
                  u32x4 o; o.x = pk4_fp8(bflo(a[u].x) * 16.f, bfhi(a[u].x) * 16.f, bflo(a[u].y) * 16.f, bfhi(a[u].y) * 16.f); o.y = pk4_fp8(bflo(a[u].z) * 16.f, bfhi(a[u].z) * 16.f, bflo(a[u].w) * 16.f, bfhi(a[u].w) * 16.f);
                  o.z = pk4_fp8(bflo(b2[u].x) * 16.f, bfhi(b2[u].x) * 16.f, bflo(b2[u].y) * 16.f, bfhi(b2[u].y) * 16.f); o.w = pk4_fp8(bflo(b2[u].z) * 16.f, bfhi(b2[u].z) * 16.f, bflo(b2[u].w) * 16.f, bfhi(b2[u].w) * 16.f);
#pragma unroll
                  for (int kx = 0; kx < 4; ++kx) { const int pos = Ls[2560 + r * 4 + kx]; st_wt(XS8 + (size_t)pos * 1024 + F.lane * 16, o); } } }
          if (wgi < 32) { const int e = wgi; for (int r = Ls[1024 + e] + Ls[1200 + e] + F.wave; r < Ls[1024 + e + 1]; r += 8) st_wt(XS8 + (size_t)r * 1024 + F.lane * 16, (u32x4){0u, 0u, 0u, 0u}); } }
        if (wgi < 32) { const int e = wgi; for (int r = Ls[1024 + e] + Ls[1200 + e] + tid; r < Ls[1024 + e + 1]; r += 512) { TOK[r] = 0; WGT[r] = 0.f; } }
        if (wgi == 0) { if (tid < 33) SORT[tid] = Ls[1024 + tid]; if (tid == 0) SORT[33] = Ls[1056] / 256;
            for (int pm = tid; pm < PMAX / 256; pm += 512) { int e = 0; for (int j = 1; j < 32; ++j) if (pm * 256 >= Ls[1024 + j]) e = j; SORT[64 + pm] = e; } }
        __syncthreads();
    }
}

DEV void p_gr(Frame& F) {
    const int gw = F.vcu * 8 + F.wave, NGW = F.G * 8, lane = F.lane, q4 = lane >> 4; const bf16_t* XB = WSP(bf16_t, W_XB); const bf16_t* Wg = WSP(bf16_t, W_IN1) + (size_t)3072 * 1024; float* GR = WSP(float, W_GR);
    for (int it = gw; it < T / 16; it += NGW) { f32x4 acc = {0.f, 0.f, 0.f, 0.f};
        const bf16_t* ap = XB + (size_t)(it * 16 + (lane & 15)) * 1024 + q4 * 8; const bf16_t* bp = Wg + (size_t)(lane & 15) * 1024 + q4 * 8;
        bf16x8 a[32], bb[32];
#pragma unroll
        for (int ks = 0; ks < 32; ++ks) { a[ks] = *(const bf16x8*)(ap + ks * 32); bb[ks] = *(const bf16x8*)(bp + ks * 32); }
#pragma unroll
        for (int ks = 0; ks < 32; ++ks) acc = __builtin_amdgcn_mfma_f32_16x16x32_bf16(a[ks], bb[ks], acc, 0, 0, 0);
#pragma unroll
        for (int r = 0; r < 4; ++r) GR[(size_t)(it * 16 + 4 * q4 + r) * 16 + (lane & 15)] = acc[r]; }
}

constexpr int GP = 264, GP2 = 144;
constexpr int GB_QIN = 0, GB_KST = 16896, GB_ATT = 35328, GB_DEC = 44544, GB_VT = 45056, GB_SIZE = 81920;
constexpr size_t W_GB = W_YS;
static_assert((size_t)2048 * GB_SIZE <= (size_t)PMAX * 2048, "blob region");
constexpr int GA_GRS = 0, GA_GT = 4096, GA_BL = 8192  , GA_QIN = GA_BL + GB_QIN, GA_KST = GA_BL + GB_KST, GA_ATT = GA_BL + GB_ATT, GA_DEC = GA_BL + GB_DEC, GA_KIN = GA_BL + 45056  , GA_VT = GA_KIN + 17408, GA_END = GA_VT + 36864;
DEV float logsigm_fast(float z) { const float e = __builtin_amdgcn_exp2f(-1.4426950408889634f * fabsf(z)); return fminf(z, 0.f) - 0.6931471805599453f * __builtin_amdgcn_logf(1.f + e); }
struct GlaRaw { unsigned q[16], k[16], v[32]; f32x4 ga, gb; };
DEV void p_gla_prep(Frame& F) {
    LAS unsigned char* lds = F.lds; const int tid = F.tid, lane = F.lane, wid = F.wave, q4 = lane >> 4, l15 = lane & 15;
    const bf16_t* H1 = WSP(bf16_t, W_HB); const float* GR = WSP(float, W_GR); unsigned char* GB = F.ws + W_GB;
    const float* wg2 = F.in[15]; const float* bg = F.in[16];
    for (int i = tid; i < 64 * GP2 / 4; i += 512) ((LAS unsigned*)(lds + GA_ATT))[i] = 0u;
    const int dk = 32 * (wid & 3) + (lane & 31), tg = 2 * (wid >> 2) + (lane >> 5);
    const int dvl = tid & 255, th2 = tid >> 8;
    const int tzm = 16 * (((lane & 31) >> 2) & 1) + 4 * ((lane & 31) >> 3) + (lane & 3);
    for (int wg = F.vcu; wg < 256; wg += F.G) {
        const int b = wg >> 4, h = (wg >> 2) & 3, n0 = (wg & 3) * 8;
        bf16x8 w2f; { float wv[8];
#pragma unroll
          for (int j = 0; j < 8; ++j) wv[j] = wg2[(8 * (lane >> 5) + j) * 512 + h * 128 + dk];
          const u32x4 ww = {cvt_pk(wv[0], wv[1]), cvt_pk(wv[2], wv[3]), cvt_pk(wv[4], wv[5]), cvt_pk(wv[6], wv[7])}; w2f = __builtin_bit_cast(bf16x8, ww); }
        const float bgv = bg[h * 128 + dk];
#define GLA_LOAD(R, n_) do { const size_t rb_ = (size_t)b * 2048 + (n_) * 64; \
        _Pragma("unroll") for (int i = 0; i < 16; ++i) { const size_t ro = (rb_ + 16 * tg + i) * 3072; R.q[i] = H1[ro + h * 128 + dk]; R.k[i] = H1[ro + 512 + h * 128 + dk]; } \
        _Pragma("unroll") for (int i = 0; i < 32; ++i) R.v[i] = H1[(rb_ + 32 * th2 + i) * 3072 + 1024 + h * 256 + dvl]; \
        { const float* gp_ = GR + (rb_ + 32 * (wid >> 2) + tzm) * 16 + 8 * (lane >> 5); R.ga = *(const f32x4*)gp_; R.gb = *(const f32x4*)(gp_ + 4); } } while (0)
        GlaRaw cur, nxt; GLA_LOAD(cur, n0); nxt = cur;
#pragma unroll 1
      for (int sub = 0; sub < 8; ++sub) { const int n = n0 + sub;
        if (sub + 1 < 8) GLA_LOAD(nxt, n + 1);
        float cs[16]; float run = 0.f;
        { const u32x4 aw = {cvt_pk(cur.ga.x, cur.ga.y), cvt_pk(cur.ga.z, cur.ga.w), cvt_pk(cur.gb.x, cur.gb.y), cvt_pk(cur.gb.z, cur.gb.w)};
          f32x16 zz;
#pragma unroll
          for (int r = 0; r < 16; ++r) zz[r] = bgv;
          zz = __builtin_amdgcn_mfma_f32_32x32x16_bf16(__builtin_bit_cast(bf16x8, aw), w2f, zz, 0, 0, 0);
#pragma unroll
          for (int i = 0; i < 16; ++i) { run += logsigm_fast(zz[i]) * (1.f / 16.f); cs[i] = run; } }
        ((LAS float*)(lds + GA_GT))[tg * 128 + dk] = run;
        __syncthreads();
        float off = 0.f, btot = 0.f;
#pragma unroll
        for (int g2 = 0; g2 < 4; ++g2) { const float gtv = ((LAS float*)(lds + GA_GT))[g2 * 128 + dk]; btot += gtv; off += (g2 < tg) ? gtv : 0.f; }
        if (tg == 0) ((LAS float*)(lds + GA_DEC))[dk] = __expf(btot);
        { unsigned kst[8];
#pragma unroll
          for (int i = 0; i < 16; i += 2) { float kk[2];
#pragma unroll
              for (int u = 0; u < 2; ++u) { const int t = 16 * tg + i + u; const float bc = cs[i + u] + off; const float qv = bflo(cur.q[i + u]), kv = bflo(cur.k[i + u]);
                  *(LAS bf16_t*)(lds + GA_QIN + t * GP + dk * 2) = (bf16_t)(cvt_pk(qv * __expf(bc), 0.f) & 0xffffu);
                  *(LAS bf16_t*)(lds + GA_KIN + t * 272 + dk * 2) = (bf16_t)(cvt_pk(kv * __expf(-bc), 0.f) & 0xffffu);
                  kk[u] = kv * __expf(btot - bc); }
              kst[i >> 1] = cvt_pk(kk[0], kk[1]); }
          *(LAS u32x4*)(lds + GA_KST + dk * GP2 + tg * 32) = (u32x4){kst[0], kst[1], kst[2], kst[3]};
          *(LAS u32x4*)(lds + GA_KST + dk * GP2 + tg * 32 + 16) = (u32x4){kst[4], kst[5], kst[6], kst[7]}; }
#pragma unroll
        for (int i = 0; i < 32; i += 8) *(LAS u32x4*)(lds + GA_VT + dvl * GP2 + (32 * th2 + i) * 2) = (u32x4){cur.v[i] | (cur.v[i + 1] << 16), cur.v[i + 2] | (cur.v[i + 3] << 16), cur.v[i + 4] | (cur.v[i + 5] << 16), cur.v[i + 6] | (cur.v[i + 7] << 16)};
        __syncthreads();
#pragma unroll
        for (int rep = 0; rep < 2; ++rep) { const int ti = wid + 8 * rep; if (ti < 10) {
            int jt, it2; if (ti < 4) { jt = 0; it2 = ti; } else if (ti < 7) { jt = 1; it2 = ti - 3; } else if (ti < 9) { jt = 2; it2 = ti - 5; } else { jt = 3; it2 = 3; }
            f32x4 a4 = {0.f, 0.f, 0.f, 0.f};
#pragma unroll
            for (int ks = 0; ks < 4; ++ks) { const bf16x8 kf = *(const LAS bf16x8*)(lds + GA_KIN + (16 * jt + l15) * 272 + ks * 64 + q4 * 16); const u32x2 q0_ = *(const LAS u32x2*)(lds + GA_QIN + (16 * it2 + l15) * GP + ks * 64 + q4 * 16), q1_ = *(const LAS u32x2*)(lds + GA_QIN + (16 * it2 + l15) * GP + ks * 64 + q4 * 16 + 8); const bf16x8 qf = __builtin_bit_cast(bf16x8, (u32x4){q0_.x, q0_.y, q1_.x, q1_.y});
                a4 = __builtin_amdgcn_mfma_f32_16x16x32_bf16(kf, qf, a4, 0, 0, 0); }
            const int i_ = 16 * it2 + l15, j0 = 16 * jt + 4 * q4;
            u32x2 w; w.x = cvt_pk(j0 <= i_ ? a4[0] : 0.f, j0 + 1 <= i_ ? a4[1] : 0.f); w.y = cvt_pk(j0 + 2 <= i_ ? a4[2] : 0.f, j0 + 3 <= i_ ? a4[3] : 0.f);
            *(LAS u32x2*)(lds + GA_ATT + i_ * GP2 + j0 * 2) = w; } }
        __syncthreads();
        unsigned char* blob = GB + (size_t)((b * 32 + n) * 4 + h) * GB_SIZE;
        for (int c = tid; c < 45056 / 16; c += 512) st_wt(blob + c * 16, *(const LAS u32x4*)(lds + GA_BL + c * 16));
        for (int c = tid; c < 36864 / 16; c += 512) st_wt(blob + GB_VT + c * 16, *(const LAS u32x4*)(lds + GA_VT + c * 16));
        cur = nxt;
      }
#undef GLA_LOAD
    }
}
constexpr int GS_BUF = 54272;
constexpr int GS_VT = 0, GS_QIN = 9216, GS_KST = GS_QIN + 16896, GS_ATT = GS_KST + 18432, GS_DEC = GS_ATT + 9216;
static_assert(3 * GS_BUF <= LDSCTL_OFF, "GLA ring");
DEV void gla_scan_item(Frame& F, int b, int h, int c4) {
    LAS unsigned char* lds = F.lds; const int lane = F.lane, wid = F.wave, q4 = lane >> 4, l15 = lane & 15;
    bf16_t* GO = WSP(bf16_t, W_GLAO); float* SS = WSP(float, W_SS); const unsigned char* GB = F.ws + W_GB;
    const int c16 = wid & 3, th = wid >> 2;
    f32x4 sacc[8];
#pragma unroll
    for (int m = 0; m < 8; ++m) sacc[m] = (f32x4){0.f, 0.f, 0.f, 0.f};
    const size_t rb = (size_t)b * 2048;
    float sqv[2][4]; unsigned ov[2][4];
#pragma unroll
    for (int mt = 0; mt < 2; ++mt)
#pragma unroll
        for (int r = 0; r < 4; ++r) { sqv[mt][r] = 0.f; ov[mt][r] = 0u; }
    const int npc = (wid < 5) ? 7 : 6;
#define GS_ISSUE(n_, bo_) do { const unsigned char* blob_ = GB + (size_t)((b * 32 + (n_)) * 4 + h) * GB_SIZE; \
        for (int p_ = wid; p_ < 53; p_ += 8) { const int so_ = p_ < 9 ? GB_VT + c4 * 9216 + p_ * 1024 : (p_ - 9) * 1024; \
            __builtin_amdgcn_global_load_lds((const unsigned*)(blob_ + so_ + lane * 16), (LAS unsigned*)(lds + (bo_) + p_ * 1024), 16, 0, 0); } } while (0)
    GS_ISSUE(0, 0); GS_ISSUE(1, GS_BUF);
    int bo = 0, bo2 = 2 * GS_BUF;
#pragma unroll 1
    for (int n = 0; n < 32; ++n) { const int t0 = n * 64;
        if (n + 1 < 32) { if (npc == 7) asm volatile("s_waitcnt vmcnt(7) lgkmcnt(0)\n\ts_barrier" ::: "memory"); else asm volatile("s_waitcnt vmcnt(6) lgkmcnt(0)\n\ts_barrier" ::: "memory"); } else asm volatile("s_waitcnt vmcnt(0) lgkmcnt(0)\n\ts_barrier" ::: "memory");
        if (n > 0) {
#pragma unroll
            for (int mt = 0; mt < 2; ++mt)
#pragma unroll
                for (int r = 0; r < 4; ++r) { const size_t trow = rb + (t0 - 64) + 32 * th + 16 * mt + 4 * q4 + r; GO[trow * 1024 + h * 256 + c4 * 64 + c16 * 16 + l15] = (bf16_t)ov[mt][r];
                    SS[(trow * 4 + h) * 16 + c4 * 4 + c16] = sqv[mt][r]; } }
        if (n + 2 < 32) GS_ISSUE(n + 2, bo2);
        const LAS unsigned char* bu = lds + bo;
        bf16x8 vf[2];
#pragma unroll
        for (int ks = 0; ks < 2; ++ks) vf[ks] = *(const LAS bf16x8*)(bu + GS_VT + (c16 * 16 + l15) * GP2 + ks * 64 + q4 * 16);
        bf16x8 sf[4];
#pragma unroll
        for (int ks = 0; ks < 4; ++ks) { const u32x4 w = {cvt_pk(sacc[2 * ks][0], sacc[2 * ks][1]), cvt_pk(sacc[2 * ks][2], sacc[2 * ks][3]), cvt_pk(sacc[2 * ks + 1][0], sacc[2 * ks + 1][1]), cvt_pk(sacc[2 * ks + 1][2], sacc[2 * ks + 1][3])}; sf[ks] = __builtin_bit_cast(bf16x8, w); }
#pragma unroll
        for (int mt = 0; mt < 2; ++mt) { const int i_ = 32 * th + 16 * mt + l15; f32x4 oa = {0.f, 0.f, 0.f, 0.f};
#pragma unroll
            for (int ks = 0; ks < 2; ++ks) { if (ks == 1 && th == 0) continue; const bf16x8 af = *(const LAS bf16x8*)(bu + GS_ATT + i_ * GP2 + ks * 64 + q4 * 16); oa = __builtin_amdgcn_mfma_f32_16x16x32_bf16(af, vf[ks], oa, 0, 0, 0); }
#pragma unroll
            for (int ks = 0; ks < 4; ++ks) { const u32x2 lo = *(const LAS u32x2*)(bu + GS_QIN + i_ * GP + (32 * ks + 4 * q4) * 2), hi2 = *(const LAS u32x2*)(bu + GS_QIN + i_ * GP + (32 * ks + 16 + 4 * q4) * 2);
                const u32x4 w = {lo.x, lo.y, hi2.x, hi2.y}; oa = __builtin_amdgcn_mfma_f32_16x16x32_bf16(__builtin_bit_cast(bf16x8, w), sf[ks], oa, 0, 0, 0); }
#pragma unroll
            for (int r = 0; r < 4; ++r) { ov[mt][r] = cvt_pk(oa[r], 0.f) & 0xffffu; float sq = oa[r] * oa[r]; sq += __shfl_xor(sq, 1); sq += __shfl_xor(sq, 2); sq += __shfl_xor(sq, 4); sq += __shfl_xor(sq, 8); sqv[mt][r] = sq; } }
#pragma unroll
        for (int md = 0; md < 8; ++md) { const f32x4 dc = *(const LAS f32x4*)(bu + GS_DEC + (16 * md + 4 * q4) * 4); sacc[md] = sacc[md] * dc;
#pragma unroll
            for (int ks = 0; ks < 2; ++ks) { const bf16x8 kf = *(const LAS bf16x8*)(bu + GS_KST + (16 * md + l15) * GP2 + ks * 64 + q4 * 16); sacc[md] = __builtin_amdgcn_mfma_f32_16x16x32_bf16(kf, vf[ks], sacc[md], 0, 0, 0); } }
        bo = (bo == 2 * GS_BUF) ? 0 : bo + GS_BUF; bo2 = (bo2 == 2 * GS_BUF) ? 0 : bo2 + GS_BUF;
    }
#undef GS_ISSUE
#pragma unroll
    for (int mt = 0; mt < 2; ++mt)
#pragma unroll
        for (int r = 0; r < 4; ++r) { const size_t trow = rb + 31 * 64 + 32 * th + 16 * mt + 4 * q4 + r; GO[trow * 1024 + h * 256 + c4 * 64 + c16 * 16 + l15] = (bf16_t)ov[mt][r]; SS[(trow * 4 + h) * 16 + c4 * 4 + c16] = sqv[mt][r]; }
    asm volatile("s_waitcnt vmcnt(0)" ::: "memory");
    __syncthreads();
}
DEV void p_gla_scan(Frame& F) { for (int v = F.vcu; v < 256; v += F.G) gla_scan_item(F, v >> 4, (v >> 2) & 3, v & 3); }

DEV void p_gla_norm(Frame& F) {
    const int gw = F.vcu * 8 + F.wave, NGW = F.G * 8, lane = F.lane; const bf16_t* GO = WSP(bf16_t, W_GLAO); const float* SS = WSP(float, W_SS); const bf16_t* H1 = WSP(bf16_t, W_HB); bf16_t* Y0 = WSP(bf16_t, W_Y0);
    const f32x4 nw = *(const f32x4*)(F.in[17] + lane * 4);
    for (int row = gw; row < T; row += NGW) {
#pragma unroll
        for (int h = 0; h < 4; ++h) { const float* sp = SS + ((size_t)row * 4 + h) * 16; const f32x4 a = *(const f32x4*)sp, b2 = *(const f32x4*)(sp + 4), c = *(const f32x4*)(sp + 8), d = *(const f32x4*)(sp + 12);
            const float sq = (a.x + a.y + a.z + a.w) + (b2.x + b2.y + b2.z + b2.w) + (c.x + c.y + c.z + c.w) + (d.x + d.y + d.z + d.w); const float r = 1.f / sqrtf(sq * (1.f / 256.f) + 1e-5f);
            const u32x2 o = *(const u32x2*)(GO + (size_t)row * 1024 + h * 256 + lane * 4); const u32x2 g = *(const u32x2*)(H1 + (size_t)row * 3072 + 2048 + h * 256 + lane * 4);
            const float g0 = bflo(g.x), g1 = bfhi(g.x), g2 = bflo(g.y), g3 = bfhi(g.y);
            u32x2 w; w.x = cvt_pk(bflo(o.x) * r * nw.x * g0 * fast_sigm(g0), bfhi(o.x) * r * nw.y * g1 * fast_sigm(g1)); w.y = cvt_pk(bflo(o.y) * r * nw.z * g2 * fast_sigm(g2), bfhi(o.y) * r * nw.w * g3 * fast_sigm(g3));
            st_wt(Y0 + (size_t)row * 1024 + h * 256 + lane * 4, w); } }
}
#ifndef PK_SWIGLU
#define PK_SWIGLU 1
#endif
struct FStoreScale { bf16_t* O; int ldc, c_lo, c_hi; float sc; static constexpr int NSIDE = 0; static constexpr bool PERM2 = false;
    DEV const void* side(const Unit&, int) const { return nullptr; }
    DEV NoPre pre(const Unit&, int, const LAS float*) const { return NoPre{}; }
    DEV void operator()(const Unit&, int row, int col, f32x4 v0, f32x4 v1, NoPre, const LAS float*) const { const float s = (col >= c_lo && col < c_hi) ? sc : 1.f;
        const u32x4 w = {cvt_pk(v0[0] * s, v0[1] * s), cvt_pk(v0[2] * s, v0[3] * s), cvt_pk(v1[0] * s, v1[1] * s), cvt_pk(v1[2] * s, v1[3] * s)}; *(u32x4*)(O + (size_t)row * ldc + col) = w; } };
struct Pre8 { f32x4 b0, b1; };
struct FGlu { const bf16_t* Y; bf16_t* O; const float* b; static constexpr int NSIDE = 0; static constexpr bool PERM2 = false;
    DEV const void* side(const Unit&, int) const { return nullptr; }
    DEV Pre8 pre(const Unit&, int col, const LAS float*) const { return Pre8{*(const f32x4*)(b + col), *(const f32x4*)(b + col + 4)}; }
    DEV void operator()(const Unit&, int row, int col, f32x4 v0, f32x4 v1, const Pre8& pp, const LAS float*) const { const u32x4 y = *(const u32x4*)(Y + (size_t)row * 512 + col); const f32x4 b0 = pp.b0, b1 = pp.b1;
        const u32x4 w = {cvt_pk(bflo(y.x) * fast_sigm(v0[0] + b0.x), bfhi(y.x) * fast_sigm(v0[1] + b0.y)), cvt_pk(bflo(y.y) * fast_sigm(v0[2] + b0.z), bfhi(y.y) * fast_sigm(v0[3] + b0.w)),
                         cvt_pk(bflo(y.z) * fast_sigm(v1[0] + b1.x), bfhi(y.z) * fast_sigm(v1[1] + b1.y)), cvt_pk(bflo(y.w) * fast_sigm(v1[2] + b1.z), bfhi(y.w) * fast_sigm(v1[3] + b1.w))};
        *(u32x4*)(O + (size_t)row * 1024 + col) = w; } };
constexpr float ACT_SCALE = 4.f, WDN_SCALE = 128.f;
#ifdef NEWTON_RCP
DEV float rcp_nr(float e) { float r = __builtin_bit_cast(float, 0x7EF311C7u - __builtin_bit_cast(unsigned, e)); r = r * fmaf(-e, r, 2.f); r = r * fmaf(-e, r, 2.f); return r; }
#else
DEV float rcp_nr(float e) { return __builtin_amdgcn_rcpf(e); }
#endif
DEV float swiglu1s(float g, float u) { g = fminf(g, 7.f); u = __builtin_amdgcn_fmed3f(u, -7.f, 7.f); const float r = rcp_nr(1.f + __builtin_amdgcn_exp2f(-1.702f * 1.4426950408889634f * g)); return (g * r) * fmaf(u, ACT_SCALE, ACT_SCALE); }
#if PK_SWIGLU
DEV f32x2 swiglu2(f32x2 g, f32x2 u4) { g.x = fminf(g.x, 7.f); g.y = fminf(g.y, 7.f); u4.x = __builtin_amdgcn_fmed3f(u4.x, -6.f * ACT_SCALE, 8.f * ACT_SCALE); u4.y = __builtin_amdgcn_fmed3f(u4.y, -6.f * ACT_SCALE, 8.f * ACT_SCALE);
    const f32x2 a = g * (-1.702f * 1.4426950408889634f); f32x2 e; e.x = __builtin_amdgcn_exp2f(a.x); e.y = __builtin_amdgcn_exp2f(a.y); e = e + 1.f;
    f32x2 r; r.x = __builtin_amdgcn_rcpf(e.x); r.y = __builtin_amdgcn_rcpf(e.y); return (g * r) * u4; }
struct FSwiglu { unsigned char* ACT; const float* bgu2; float sc; static constexpr int NSIDE = 1; static constexpr bool PERM2 = true;
    DEV const void* side(const Unit& u, int) const { return bgu2 + (size_t)u.e * 2048 + u.pn * BM; }
    DEV Pre8 pre(const Unit&, int, const LAS float* sb) const { return Pre8{*(const LAS f32x4*)sb, *(const LAS f32x4*)(sb + 4)}; }
    DEV void operator()(const Unit& u, int row, int col, f32x4 v0, f32x4 v1, const Pre8& pp, const LAS float*) const { const f32x4 b0 = pp.b0, b1 = pp.b1; const f32x2 sg = {sc, sc}, su = {sc * ACT_SCALE, sc * ACT_SCALE};
        const f32x2 a01 = swiglu2(__builtin_elementwise_fma((f32x2){v0[0], v0[1]}, sg, (f32x2){b0.x, b0.y}), __builtin_elementwise_fma((f32x2){v0[2], v0[3]}, su, (f32x2){b0.z, b0.w}));
        const f32x2 a23 = swiglu2(__builtin_elementwise_fma((f32x2){v1[0], v1[1]}, sg, (f32x2){b1.x, b1.y}), __builtin_elementwise_fma((f32x2){v1[2], v1[3]}, su, (f32x2){b1.z, b1.w}));
        *(unsigned*)(ACT + (size_t)row * 1024 + (col >> 1)) = pk4_fp8(a01.x, a01.y, a23.x, a23.y); } };
#else
struct FSwiglu { unsigned char* ACT; const float* bgu; float sc; static constexpr int NSIDE = 1; static constexpr bool PERM2 = false;
    DEV const void* side(const Unit& u, int) const { return bgu + (size_t)u.e * 2048 + u.pn * BM; }
    DEV Pre8 pre(const Unit&, int, const LAS float* sb) const { return Pre8{*(const LAS f32x4*)sb, *(const LAS f32x4*)(sb + 4)}; }
    DEV void operator()(const Unit& u, int row, int col, f32x4 v0, f32x4 v1, const Pre8& pp, const LAS float*) const { const f32x4 b0 = pp.b0, b1 = pp.b1;
        const unsigned w = pk4_fp8(swiglu1s(fmaf(v0[0], sc, b0.x), fmaf(v0[1], sc, b0.y)), swiglu1s(fmaf(v0[2], sc, b0.z), fmaf(v0[3], sc, b0.w)), swiglu1s(fmaf(v1[0], sc, b1.x), fmaf(v1[1], sc, b1.y)), swiglu1s(fmaf(v1[2], sc, b1.z), fmaf(v1[3], sc, b1.w)));
        *(unsigned*)(ACT + (size_t)row * 1024 + (col >> 1)) = w; } };
#endif
constexpr float YS_SCALE = 64.f;
struct FDown { unsigned char* YS; const float* bd; const float* wgt; float sc; static constexpr int NSIDE = 2; static constexpr bool PERM2 = false;
    DEV const void* side(const Unit& u, int k) const { return k == 0 ? (const void*)(bd + (size_t)u.e * 1024 + u.pn * BM) : (const void*)(wgt + (size_t)u.pm * BM); }
    DEV Pre8 pre(const Unit&, int, const LAS float* sb) const { return Pre8{*(const LAS f32x4*)sb, *(const LAS f32x4*)(sb + 4)}; }
    DEV void operator()(const Unit& u, int row, int col, f32x4 v0, f32x4 v1, const Pre8& pp, const LAS float* sr) const { const f32x4 b0 = pp.b0, b1 = pp.b1; const float wt = *sr * YS_SCALE, ws_ = sc * wt;
        u32x2 w; w.x = pk4_fp8(fmaf(v0[0], ws_, b0.x * wt), fmaf(v0[1], ws_, b0.y * wt), fmaf(v0[2], ws_, b0.z * wt), fmaf(v0[3], ws_, b0.w * wt)); w.y = pk4_fp8(fmaf(v1[0], ws_, b1.x * wt), fmaf(v1[1], ws_, b1.y * wt), fmaf(v1[2], ws_, b1.z * wt), fmaf(v1[3], ws_, b1.w * wt));
        *(u32x2*)(YS + (size_t)row * 1024 + col) = w; } };

constexpr int NPH = 21;
#ifndef DUP_GU
#define DUP_GU 0
#endif
constexpr float X8_SCALE = 16.f, WGU_SCALE = 64.f;
constexpr float QSCALE0 = 0.125f * 1.4426950408889634f, QSCALE1 = 0.08838834764831845f;


#define NOINL __device__ __forceinline__
struct PA { const float* const* in; unsigned char* ws; float* out; int wave; };
#define MKFRAME extern __shared__ __attribute__((aligned(16))) unsigned char lds_[]; Frame F; F.lds = (LAS unsigned char*)lds_; F.wave = pa.wave; F.lane = (int)__builtin_amdgcn_mbcnt_hi(~0u, __builtin_amdgcn_mbcnt_lo(~0u, 0u)); F.tid = F.wave * 64 + F.lane; \
    F.G = gridDim.x; { const int bx = blockIdx.x; F.vcu = (F.G % 8 == 0) ? (bx % 8) * (F.G / 8) + bx / 8 : bx; } F.in = pa.in; F.ws = pa.ws;
template <class Fn> DEV void dense_gemm(Frame& F, const bf16_t* A, const bf16_t* Bt, int nM, int nN, int K, const Fn& fn) {
    Gemm g; g.A = A; g.Bt = Bt; g.rowmap = nullptr; g.bstride = 0; g.KB = K * 2; g.wave = F.wave;
    StaticOrder S; S.init(nM, nN, F.G, (int)blockIdx.x, nullptr);
    EpiRow8<Fn> E{fn};
    gemm_phase<false, false, true>(F.lds, g, S, E);
}
NOINL void ph_prologue(PA pa) { MKFRAME p0_prologue(F); }
NOINL void ph_in0(PA pa) { MKFRAME dense_gemm(F, WSP(bf16_t, W_XB), WSP(bf16_t, W_IN0), T / 256, 8, 1024, FStoreScale{WSP(bf16_t, W_HB), 2048, 512, 1024, QSCALE0}); }
NOINL void ph_kmean(PA pa) { MKFRAME p_kmean(F); }
NOINL void ph_s5moba(PA pa, int mode) { MKFRAME p_s5_moba(F, mode); }
NOINL void ph_glu(PA pa) { MKFRAME dense_gemm(F, WSP(bf16_t, W_YS5), WSP(bf16_t, W_GLU), T / 256, 2, 512, FGlu{WSP(bf16_t, W_YS5), WSP(bf16_t, W_Y0), F.in[11]}); }
NOINL void ph_out(PA pa, int layer) { MKFRAME dense_gemm(F, WSP(bf16_t, W_Y0), layer ? WSP(bf16_t, W_OUT1) : WSP(bf16_t, W_OUT0), T / 256, 4, 1024, FStoreScale{WSP(bf16_t, W_MIXB), 1024, 0, 0, 1.f}); }
NOINL void ph_in1(PA pa) { MKFRAME dense_gemm(F, WSP(bf16_t, W_XB), WSP(bf16_t, W_IN1), T / 256, 12, 1024, FStoreScale{WSP(bf16_t, W_HB), 3072, 0, 512, QSCALE1}); p_gr(F); }
NOINL void ph_glaprep(PA pa) { MKFRAME p_gla_prep(F); }
NOINL void ph_glascan(PA pa) { MKFRAME p_gla_scan(F); }
NOINL void ph_glanorm(PA pa) { MKFRAME p_gla_norm(F); }
NOINL void ph_lnrouter(PA pa, int layer) { MKFRAME
    if (layer == 0) p_ln<0, true, false, false>(F, nullptr, WSP(bf16_t, W_XB), WSP(bf16_t, W_XBB), nullptr, F.in[19], F.in[20], F.in[23], F.in[24]);
    else p_ln<0, true, false, false>(F, nullptr, WSP(bf16_t, W_XB), WSP(bf16_t, W_XBB), nullptr, F.in[19] + 1024, F.in[20] + 1024, F.in[23] + (size_t)1024 * 32, F.in[24] + 32); }
NOINL void ph_sort(PA pa) { MKFRAME p_sort(F); }
NOINL void ph_gateup(PA pa, int layer) { MKFRAME const int* SORT = WSP(int, W_SORT);
    Gemm g; g.A = WSP(unsigned char, W_X8); g.Bt = WSP(unsigned char, W_GU) + (size_t)layer * 32 * 2048 * 1024; g.rowmap = nullptr; g.bstride = (size_t)2048 * 1024; g.KB = 1024; g.wave = F.wave;
    StaticOrder S; S.init(__builtin_amdgcn_readfirstlane(SORT[33]), 8, F.G, (int)blockIdx.x, (const LAS int*)(F.lds + LDS_ELIST)); fill_elist(F.lds, S, SORT + 64, F.tid);
    EpiRow8<FSwiglu> E{FSwiglu{WSP(unsigned char, W_ACT), (PK_SWIGLU ? WSP(float, W_BGU2) : F.in[26]) + (size_t)layer * 32 * 2048, 1.f / (X8_SCALE * WGU_SCALE)}};
    gemm_phase<false, true, true, DUP_GU>(F.lds, g, S, E); }
NOINL void ph_down(PA pa, int layer) { MKFRAME const int* SORT = WSP(int, W_SORT);
    Gemm g; g.A = WSP(unsigned char, W_ACT); g.Bt = WSP(unsigned char, W_DN) + (size_t)layer * 32 * 1024 * 1024; g.rowmap = nullptr; g.bstride = (size_t)1024 * 1024; g.KB = 1024; g.wave = F.wave;
    StaticOrder S; S.init(__builtin_amdgcn_readfirstlane(SORT[33]), 4, F.G, (int)blockIdx.x, (const LAS int*)(F.lds + LDS_ELIST)); fill_elist(F.lds, S, SORT + 64, F.tid);
    EpiRow8<FDown> E{FDown{WSP(unsigned char, W_YS), F.in[28] + (size_t)layer * 32 * 1024, WSP(float, R_WGT), 1.f / (ACT_SCALE * WDN_SCALE)}};
    gemm_phase<false, true, true>(F.lds, g, S, E); }
NOINL void ph_combine(PA pa, int layer) { MKFRAME
    if (layer == 0) p_ln<1, false, false, false, false>(F, nullptr, WSP(bf16_t, W_XBB), WSP(bf16_t, W_XB), nullptr, F.in[21], F.in[22], nullptr, nullptr);
    else p_ln<1, false, false, true>(F, nullptr, WSP(bf16_t, W_XBB), nullptr, pa.out, F.in[21] + 1024, F.in[22] + 1024, nullptr, nullptr); }

__global__ void __launch_bounds__(512, 2) mega(Args args) {
    extern __shared__ __attribute__((aligned(16))) unsigned char lds_[];
    LAS unsigned char* lds = (LAS unsigned char*)lds_;
    unsigned* ctl = (unsigned*)(args.ws + W_CTL);
    for (int u = threadIdx.x; u < (LDS_BYTES - LDSCTL_OFF) / 4; u += 512) ((LAS unsigned*)(lds + LDSCTL_OFF))[u] = 0u;
    __syncthreads();
    const int lo = args.ph_lo, hi = args.ph_hi;
    PA pa; pa.in = args.in; pa.ws = args.ws; pa.out = args.out; pa.wave = __builtin_amdgcn_readfirstlane(threadIdx.x >> 6);
    XcdBarrier bar; bar.bar = ctl + CW_BAR; bar.x = 0; bar.st = nullptr; bar.wave = pa.wave;
    if (hi - lo > 1) bar = xcd_barrier_post(ctl + CW_BAR, (volatile LAS unsigned*)(lds + MISC_OFF) + 8, pa.wave);
#define IN(k) (lo <= (k) && (k) < hi)
#ifdef DIAG_LO
    volatile LAS unsigned long long* tsl = (volatile LAS unsigned long long*)(lds + MISC_OFF + 128);
    if (blockIdx.x == 0 && threadIdx.x == 0) tsl[0] = __builtin_amdgcn_s_memrealtime();
#define STAMP(k) do { if (blockIdx.x == 0 && threadIdx.x == 0) tsl[(k) + 1] = __builtin_amdgcn_s_memrealtime(); } while (0)
#else
#define STAMP(k) do { } while (0)
#endif
#define SEAM(k) do { if (IN(k) && IN((k) + 1)) xcd_barrier(bar); STAMP(k); } while (0)
#ifndef REP_PHASE
#define REP_PHASE -1
#define REP_N 0
#endif
#define RUN(k, call) do { if (IN(k)) { call; if ((k) == REP_PHASE) { xcd_barrier(bar); call; } } } while (0)
    RUN(0, ph_prologue(pa)); SEAM(0);
    RUN(1, ph_in0(pa)); SEAM(1);
    RUN(2, ph_kmean(pa)); SEAM(2);
    if (IN(3)) { ph_s5moba(pa, 1); if (REP_PHASE == 30) ph_s5moba(pa, 1); ph_s5moba(pa, 2); if (REP_PHASE == 31) ph_s5moba(pa, 2); } SEAM(3);
    RUN(4, ph_glu(pa)); SEAM(4);
    RUN(5, ph_out(pa, 0)); SEAM(5);
    if (REP_PHASE == 99) { for (int q_ = 0; q_ < 20; ++q_) xcd_barrier(bar); }
    RUN(6, ph_lnrouter(pa, 0)); SEAM(6);
    RUN(7, ph_sort(pa)); SEAM(7);
    RUN(8, ph_gateup(pa, 0)); SEAM(8);
    RUN(9, ph_down(pa, 0)); SEAM(9);
    RUN(10, ph_combine(pa, 0)); SEAM(10);
    RUN(11, ph_in1(pa)); SEAM(11);
    RUN(12, ph_glaprep(pa)); SEAM(12);
    RUN(13, ph_glascan(pa)); SEAM(13);
    RUN(14, ph_glanorm(pa)); SEAM(14);
    RUN(15, ph_out(pa, 1)); SEAM(15);
    RUN(16, ph_lnrouter(pa, 1)); SEAM(16);
    RUN(17, ph_sort(pa)); SEAM(17);
    RUN(18, ph_gateup(pa, 1)); SEAM(18);
    RUN(19, ph_down(pa, 1)); SEAM(19);
    RUN(20, ph_combine(pa, 1));
#ifdef DIAG_LO
    xcd_barrier(bar); STAMP(20);
    if (blockIdx.x == 0 && threadIdx.x == 0) { const unsigned long long dtk = tsl[DIAG_HI + 1] - tsl[DIAG_LO]; const float f = (float)dtk * (0.01f / 10000.f); __hip_atomic_store(ctl + 8, __float_as_uint(f), __ATOMIC_RELAXED, __HIP_MEMORY_SCOPE_AGENT); }
    xcd_barrier(bar);
    { const float f = __uint_as_float(__hip_atomic_load(ctl + 8, __ATOMIC_RELAXED, __HIP_MEMORY_SCOPE_AGENT));
      for (size_t i = (size_t)blockIdx.x * 512 + threadIdx.x; i < (size_t)T * 1024; i += (size_t)gridDim.x * 512) args.out[i] *= (1.f + f); }
#endif
#undef IN
#undef SEAM
}

static int g_grid = 0;
static bool launch_setup(size_t ws_size) {
    if (g_grid == 0) {
        if (ws_size < W_END) { fprintf(stderr, "kernel_launch: workspace too small: %zu < %zu\n", ws_size, (size_t)W_END); g_grid = -1; return false; }
        int dev = 0, cus = 0, per_cu = 0;
        if (hipGetDevice(&dev) != hipSuccess || hipDeviceGetAttribute(&cus, hipDeviceAttributeMultiprocessorCount, dev) != hipSuccess) { g_grid = -1; return false; }
        if (hipFuncSetAttribute((const void*)mega, hipFuncAttributeMaxDynamicSharedMemorySize, LDS_BYTES) != hipSuccess) { fprintf(stderr, "kernel_launch: hipFuncSetAttribute failed\n"); g_grid = -1; return false; }
        if (hipOccupancyMaxActiveBlocksPerMultiprocessor(&per_cu, (const void*)mega, 512, LDS_BYTES) != hipSuccess || per_cu < 1) fprintf(stderr, "kernel_launch: occupancy query reports %d blocks/CU\n", per_cu);
        (void)hipGetLastError();
        g_grid = cus;
    }
    return g_grid > 0;
}
static void launch_phases(hipStream_t stream, void* const* d_in, void* d_out, void* d_ws, int lo, int hi) {
    Args a; memset(&a, 0, sizeof a);
    for (int i = 0; i < 29; ++i) a.in[i] = (const float*)d_in[i];
    a.out = (float*)d_out; a.ws = (unsigned char*)d_ws; a.ph_lo = lo; a.ph_hi = hi;
    hipLaunchKernelGGL(mega, dim3(g_grid), dim3(512), LDS_BYTES, stream, a);
}
}
extern "C" void kernel_launch(void* const* d_in, const int* in_sizes, int n_in, void* d_out, int out_size, void* d_ws, size_t ws_size, hipStream_t stream) {
    if (n_in != 29 || out_size != T * D) { fprintf(stderr, "kernel_launch: unexpected arguments (n_in %d, out_size %d)\n", n_in, out_size); return; }
    if (!fk::launch_setup(ws_size)) return;
    (void)hipMemsetAsync((char*)d_ws + fk::W_CTL, 0, fk::CTL_ZERO_BYTES, stream);
    fk::launch_phases(stream, d_in, d_out, d_ws, 0, fk::NPH);
}
```

```cpp
#include <hip/hip_runtime.h>
#include <cstdio>
#include <cstdint>
#include <cmath>
#include <cstring>
#define DEV __device__ __forceinline__
constexpr int Bn = 16, L = 2048, D = 1024, T = Bn * L;
namespace fk {
#define LAS __attribute__((address_space(3)))
#define GAS __attribute__((address_space(1)))
typedef unsigned short bf16_t;
typedef short bf16x8 __attribute__((ext_vector_type(8)));
typedef short s16x4 __attribute__((ext_vector_type(4)));
typedef float f32x2 __attribute__((ext_vector_type(2)));
typedef float f32x4 __attribute__((ext_vector_type(4)));
typedef float f32x16 __attribute__((ext_vector_type(16)));
typedef unsigned u32x2 __attribute__((ext_vector_type(2)));
typedef unsigned u32x4 __attribute__((ext_vector_type(4)));
typedef __bf16 bf16x2_t __attribute__((ext_vector_type(2)));
struct u32x4x2 { u32x4 a, b; };
DEV unsigned cvt_pk(float lo, float hi) { f32x2 v = {lo, hi}; bf16x2_t b = __builtin_convertvector(v, bf16x2_t); return __builtin_bit_cast(unsigned, b); }
DEV float bflo(unsigned w) { return __uint_as_float(w << 16); }
DEV float bfhi(unsigned w) { return __uint_as_float(w & 0xffff0000u); }
#ifndef WT_STORES
#define WT_STORES 0
#endif
DEV void st_wt(void* p, u32x4 v) { if (WT_STORES == 1) asm volatile("global_store_dwordx4 %0, %1, off sc1" :: "v"(p), "v"(v)); else if (WT_STORES == 2) __builtin_nontemporal_store(v, (u32x4*)p); else *(u32x4*)p = v; }
DEV void st_wt(void* p, u32x2 v) { if (WT_STORES == 1) asm volatile("global_store_dwordx2 %0, %1, off sc1" :: "v"(p), "v"(v)); else if (WT_STORES == 2) __builtin_nontemporal_store(v, (u32x2*)p); else *(u32x2*)p = v; }
DEV void st_wt(void* p, f32x4 v) { if (WT_STORES == 1) asm volatile("global_store_dwordx4 %0, %1, off sc1" :: "v"(p), "v"(v)); else if (WT_STORES == 2) __builtin_nontemporal_store(v, (f32x4*)p); else *(f32x4*)p = v; }
DEV float fast_sigm(float x) { return __builtin_amdgcn_rcpf(1.f + __builtin_amdgcn_exp2f(-1.4426950408889634f * x)); }
DEV float gelu_tanh(float x) { const float u = 0.7978845608028654f * (x + 0.044715f * x * x * x); return x * fast_sigm(2.f * u); }
DEV float wave_sum(float v) {
#pragma unroll
    for (int o = 1; o < 64; o <<= 1) v += __shfl_xor(v, o);
    return v; }
DEV float swap32(float x) { auto rr = __builtin_amdgcn_permlane32_swap(__float_as_uint(x), __float_as_uint(x), false, false); return __uint_as_float((__builtin_amdgcn_mbcnt_lo(~0u, 0u) >> 5) ? rr[0] : rr[1]); }

constexpr int BM = 256, BK = 64, HALF = 128, HTB = HALF * BK * 2, STAGE_BYTES = 8 * HTB, NXCD = 8, WGM = 8;
constexpr int LDS_TOK = 135168 - 2048;
constexpr int LDS_SIDE = 135168;
constexpr int LDS_BYTES = 163840, LDSCTL_OFF = LDS_BYTES - 1024, MISC_OFF = LDSCTL_OFF + 320;

DEV int lds_byte(int r, int c) { const int st = (r >> 4) * 2 + (c >> 5), rr = r & 15, cc = c & 31, ob = rr * 64 + cc * 2; return st * 1024 + (ob ^ (((ob >> 9) & 1) << 5)); }
DEV void stage_rc(int b, int& R, int& C) { const int st = b / 1024, sb = b % 1024, swz = sb ^ (((sb >> 9) & 1) << 5); R = (st >> 1) * 16 + swz / 64; C = (st & 1) * 32 + (swz % 64) / 2; }
DEV int perm32(int rho) { const int n = rho >> 4, i = rho & 15; return 8 * (i >> 2) + 4 * n + (i & 3); }

struct Unit { int pm, pn, e; };
struct Gemm { const void* A; const void* Bt; const int* rowmap; size_t bstride; int KB; int wave; };

struct StaticOrder {
    int nM, nN, nwg, G, c; const LAS int* elist;
    DEV void init(int nM_, int nN_, int G_, int c_, const LAS int* el) { nM = nM_; nN = nN_; nwg = nM * nN; G = G_; c = c_; elist = el; }
    DEV bool place(int i, Unit& u) const {
        const long Lx = (long)i * G + c; if (Lx >= nwg) return false;
        int wgid = (int)Lx; { const int q = nwg / NXCD, r = nwg % NXCD, xcd = wgid % NXCD, off = wgid / NXCD; wgid = (xcd < r ? xcd * (q + 1) : r * (q + 1) + (xcd - r) * q) + off; }
        const int nig = WGM * nN, gid = wgid / nig, fm = gid * WGM, gsz = (nM - fm) < WGM ? (nM - fm) : WGM;
        u.pm = fm + ((wgid % nig) % gsz); u.pn = (wgid % nig) / gsz; u.e = 0; return true;
    }
    DEV bool next(int i, Unit& u) const { if (!place(i, u)) return false; if (elist) u.e = __builtin_amdgcn_readfirstlane(elist[i]); return true; }
};
constexpr int LDS_ELIST = 135168 + 6144;
DEV void fill_elist(LAS unsigned char* lds, const StaticOrder& S, const int* tile_e, int tid) {
    LAS int* el = (LAS int*)(lds + LDS_ELIST);
    if (tid < 64) { Unit u; el[tid] = S.place(tid, u) ? tile_e[u.pm] : 0; }
    __syncthreads();
}

struct NoPre {};
template <class F> struct EpiRow8 {
    static constexpr bool PERM = true, PERM2 = F::PERM2; static constexpr int NSIDE = F::NSIDE; F f;
    DEV const void* side(const Unit& u, int k) const { return f.side(u, k); }
    DEV void operator()(const f32x4 (&acc)[2][2][4][2], const Unit& u, int wr, int wc, int fr, int fq, const LAS float* sd) const {
        { int ln_; asm volatile("v_mbcnt_lo_u32_b32 %0, -1, 0\n\tv_mbcnt_hi_u32_b32 %0, -1, %0" : "=v"(ln_)); fr = ln_ & 15; fq = ln_ >> 4; }
        const int cl = wc * 32 + 8 * fq, c0 = u.pn * BM + cl;
        if constexpr (NSIDE > 0) {
#pragma unroll
            for (int ai = 0; ai < 2; ++ai)
#pragma unroll
                for (int m = 0; m < 4; ++m) { const int rl = ai * HALF + wr * 64 + m * 16 + fr, row = u.pm * BM + rl;
                    f(u, row, c0, acc[ai][0][m][0], acc[ai][0][m][1], f.pre(u, c0, sd + cl), sd + 256 + rl); f(u, row, c0 + HALF, acc[ai][1][m][0], acc[ai][1][m][1], f.pre(u, c0 + HALF, sd + cl + HALF), sd + 256 + rl); }
        } else {
        const auto p0 = f.pre(u, c0, sd + cl), p1 = f.pre(u, c0 + HALF, sd + cl + HALF);
#pragma unroll
        for (int ai = 0; ai < 2; ++ai)
#pragma unroll
            for (int m = 0; m < 4; ++m) { const int rl = ai * HALF + wr * 64 + m * 16 + fr, row = u.pm * BM + rl;
                f(u, row, c0, acc[ai][0][m][0], acc[ai][0][m][1], p0, sd + 256 + rl); f(u, row, c0 + HALF, acc[ai][1][m][0], acc[ai][1][m][1], p1, sd + 256 + rl); }
        if constexpr (F::COLSUM) { if (f.colsum_tile(u)) {
            f32x4 ks[4];
#pragma unroll
            for (int q = 0; q < 4; ++q) { ks[q] = acc[0][q >> 1][0][q & 1];
#pragma unroll
                for (int am = 1; am < 8; ++am) ks[q] += acc[am >> 2][q >> 1][am & 3][q & 1]; }
#pragma unroll
            for (int q = 0; q < 4; ++q)
#pragma unroll
                for (int j = 0; j < 4; ++j) { float v = ks[q][j]; v += __shfl_xor(v, 1); v += __shfl_xor(v, 2); v += __shfl_xor(v, 4); v += __shfl_xor(v, 8); ks[q][j] = v; }
            if (fr == 0) {
#pragma unroll
                for (int q = 0; q < 4; ++q)
#pragma unroll
                    for (int j = 0; j < 4; ++j) f.colsum_add(u, c0 + (q >> 1) * HALF + (q & 1) * 4 + j, ks[q][j]); } } }
        }
    }
};

typedef int v8i_t __attribute__((ext_vector_type(8)));
typedef int v4i_t __attribute__((ext_vector_type(4)));
template <bool GATHER, bool FP8, bool ALIGN, int DUPK = 0, class Epi, class Sched>
DEV void gemm_phase(LAS unsigned char* lds, const Gemm g, const Sched& S, const Epi& E) {
    const int wid = g.wave, lane = (int)__builtin_amdgcn_mbcnt_hi(~0u, __builtin_amdgcn_mbcnt_lo(~0u, 0u)), tid = wid * 64 + lane, wr = wid >> 2, wc = wid & 3, fr = lane & 15, fq = lane >> 4;

    const int KB = g.KB, nt = KB / 128;
    int R0, C2; { int C; stage_rc(tid * 16, R0, C); C2 = C * 2; }
    unsigned voffB[2]; { int Rb = Epi::PERM ? ((R0 & ~31) + perm32(R0 & 31)) : R0; if constexpr (Epi::PERM2) Rb = (Rb & ~3) | ((Rb & 1) << 1) | ((Rb >> 1) & 1);
      voffB[0] = (unsigned)(Rb * KB + C2); voffB[1] = voffB[0] + 64u * (unsigned)KB; }
    const unsigned kstep = 128u, hstep = (unsigned)HALF * KB, tstep = 2u * hstep;
    const unsigned ldsw = (unsigned)wid * 1024u;
    const int aoff = lds_byte(wr * 64 + fr, fq * 8); int boff = lds_byte(wc * 32 + fr, fq * 8) + 4 * HTB; asm volatile("" : "+v"(boff));
    LAS int* tokb = (LAS int*)(lds + LDS_TOK);
    const auto rsA = __builtin_amdgcn_make_buffer_rsrc((void*)g.A, 0, 0x7fffffff, 0x00020000);
    const auto rsB = __builtin_amdgcn_make_buffer_rsrc((void*)g.Bt, 0, 0x7fffffff, 0x00020000);
    const auto rsT = __builtin_amdgcn_make_buffer_rsrc((void*)(GATHER ? (const void*)g.rowmap : g.A), 0, 0x7fffffff, 0x00020000);
#define PG8_SA(b, h) (((b) * 2 + (h)) * HTB)
#define PG8_SB(b, h) ((4 + (b) * 2 + (h)) * HTB)
#define PG8_STAGE(bufoff, rs, soff, voff) do { _Pragma("unroll") for (int _i = 0; _i < 2; ++_i) { \
        if constexpr (GATHER) __builtin_amdgcn_raw_ptr_buffer_load_lds(rs, (LAS void*)(lds + (bufoff) + ldsw + _i * 8192), 16, (int)(voff)[_i], (int)(soff), 0, 0); \
        else __builtin_amdgcn_raw_ptr_buffer_load_lds(rs, (LAS void*)(lds + (bufoff) + ldsw + _i * 8192), 16, (int)(voff)[0], (int)((soff) + _i * 64u * (unsigned)KB), 0, 0); } } while (0)
#define PG8_LDA(dst, b, h) do { _Pragma("unroll") for (int m = 0; m < 4; ++m) _Pragma("unroll") for (int k = 0; k < 2; ++k) dst[m][k] = *(const LAS bf16x8*)(lds + PG8_SA(b, h) + aoff + m * 2048 + k * 1024); } while (0)
#define PG8_LDB(dst, b, h) do { _Pragma("unroll") for (int n = 0; n < 2; ++n) _Pragma("unroll") for (int k = 0; k < 2; ++k) dst[n][k] = *(const LAS bf16x8*)(lds + boff + (PG8_SB(b, h) - 4 * HTB) + n * 2048 + k * 1024); } while (0)
#define PG8_CAT(x) __builtin_shufflevector(__builtin_bit_cast(v4i_t, x[0]), __builtin_bit_cast(v4i_t, x[1]), 0, 1, 2, 3, 4, 5, 6, 7)
#define PG8_MMA(ai, bj, At, Bt) do { __builtin_amdgcn_s_setprio(1); _Pragma("unroll") for (int m = 0; m < 4; ++m) _Pragma("unroll") for (int n = 0; n < 2; ++n) { \
        if constexpr (FP8) acc[ai][bj][m][n] = __builtin_amdgcn_mfma_scale_f32_16x16x128_f8f6f4(PG8_CAT(Bt[n]), PG8_CAT(At[m]), acc[ai][bj][m][n], 0, 0, 0, 0, 0, 0); \
        else { _Pragma("unroll") for (int k = 0; k < 2; ++k) acc[ai][bj][m][n] = __builtin_amdgcn_mfma_f32_16x16x32_bf16(Bt[n][k], At[m][k], acc[ai][bj][m][n], 0, 0, 0); } } __builtin_amdgcn_s_setprio(0); } while (0)
#define PG8_MMA0(ai, bj, At, Bt) do { __builtin_amdgcn_s_setprio(1); _Pragma("unroll") for (int m = 0; m < 4; ++m) _Pragma("unroll") for (int n = 0; n < 2; ++n) { const f32x4 zz_ = {0.f, 0.f, 0.f, 0.f}; \
        if constexpr (FP8) acc[ai][bj][m][n] = __builtin_amdgcn_mfma_scale_f32_16x16x128_f8f6f4(PG8_CAT(Bt[n]), PG8_CAT(At[m]), zz_, 0, 0, 0, 0, 0, 0); \
        else { acc[ai][bj][m][n] = __builtin_amdgcn_mfma_f32_16x16x32_bf16(Bt[n][0], At[m][0], zz_, 0, 0, 0); acc[ai][bj][m][n] = __builtin_amdgcn_mfma_f32_16x16x32_bf16(Bt[n][1], At[m][1], acc[ai][bj][m][n], 0, 0, 0); } } __builtin_amdgcn_s_setprio(0); } while (0)
#define PG8_WAIT_V(n) asm volatile("s_waitcnt vmcnt(" #n ")" ::: "memory")
#define PG8_WAIT_L(n) asm volatile("s_waitcnt lgkmcnt(" #n ")" ::: "memory")
#define PG8_BAR __builtin_amdgcn_s_barrier()
#define PG8_SCHED __builtin_amdgcn_sched_barrier(0)
    Unit cur, nxt; int ui = 0;
    if (!S.next(0, cur)) return;
    f32x4 acc[2][2][4][2];
    bf16x8 At[4][2], B0[2][2], B1[2][2];
    unsigned cA, cB = (unsigned)cur.e * (unsigned)g.bstride + (unsigned)cur.pn * tstep;
    unsigned voffA[2]; voffA[0] = (unsigned)(R0 * KB + C2); voffA[1] = voffA[0] + 64u * (unsigned)KB;
    if constexpr (GATHER) { cA = 0u;
        if (wid < 4) __builtin_amdgcn_raw_ptr_buffer_load_lds(rsT, (LAS void*)(tokb + wid * 64), 4, (wid * 64 + lane) * 4, cur.pm * (BM * 4), 0, 0);
        asm volatile("s_waitcnt vmcnt(0)" ::: "memory"); __builtin_amdgcn_s_barrier();
    } else cA = (unsigned)cur.pm * tstep;
    const unsigned hA = GATHER ? 0u : hstep;
    LAS float* sideb = (LAS float*)(lds + LDS_SIDE);
#define PG8_SIDE(un, sel) do { if constexpr (Epi::NSIDE > 0) { if (wid < Epi::NSIDE) { const char* sp_ = (const char*)E.side(un, wid); int ln_ = (int)__builtin_amdgcn_mbcnt_hi(~0u, __builtin_amdgcn_mbcnt_lo(~0u, 0u)); asm volatile("" : "+v"(ln_)); \
        __builtin_amdgcn_global_load_lds((const unsigned*)(sp_ + ln_ * 16), (LAS unsigned*)(sideb + (sel) * 512 + wid * 256), 16, 0, 0); } } } while (0)
    PG8_SIDE(cur, 0);
#define PG8_OA(dst, sel, h) unsigned dst[2]; if constexpr (GATHER) { dst[0] = (unsigned)(tokb[(sel) * 256 + (h) * HALF + R0] * KB + C2); dst[1] = (unsigned)(tokb[(sel) * 256 + (h) * HALF + R0 + 64] * KB + C2); } else { dst[0] = voffA[0]; dst[1] = voffA[1]; }
    { PG8_OA(p0_, 0, 0); PG8_OA(p1_, 0, 1); PG8_STAGE(PG8_SB(0, 0), rsB, cB, voffB); PG8_STAGE(PG8_SB(0, 1), rsB, cB + hstep, voffB); PG8_STAGE(PG8_SA(0, 0), rsA, cA, p0_); PG8_STAGE(PG8_SA(0, 1), rsA, cA + hA, p1_); }
    if (wr == 1) PG8_BAR;
    PG8_WAIT_V(2); PG8_BAR;
    { PG8_OA(p0_, 0, 0); PG8_STAGE(PG8_SB(1, 0), rsB, cB + kstep, voffB); PG8_STAGE(PG8_SA(1, 0), rsA, cA + kstep, p0_); PG8_STAGE(PG8_SB(1, 1), rsB, cB + hstep + kstep, voffB); }
    PG8_WAIT_V(6); PG8_BAR;
    for (;;) {
        const bool has_next = S.next(ui + 1, nxt);
        unsigned nA = cA, nB = cB;
        if (has_next) { nB = (unsigned)nxt.e * (unsigned)g.bstride + (unsigned)nxt.pn * tstep;
            if constexpr (GATHER) { if (wid < 4) { const int ln_ = (int)__builtin_amdgcn_mbcnt_hi(~0u, __builtin_amdgcn_mbcnt_lo(~0u, 0u)); __builtin_amdgcn_raw_ptr_buffer_load_lds(rsT, (LAS void*)(tokb + ((ui + 1) & 1) * 256 + wid * 64), 4, (wid * 64 + ln_) * 4, nxt.pm * (BM * 4), 0, 0); } }
            else nA = (unsigned)nxt.pm * tstep;
            PG8_SIDE(nxt, (ui + 1) % 3); }
#pragma unroll 1
        for (int t = 0; t < nt; t += 2) {
            const bool last = (t == nt - 2);
            const unsigned a1 = cA + (unsigned)(t + 1) * kstep;
            const unsigned a2 = last ? nA : cA + (unsigned)(t + 2) * kstep, b2 = last ? nB : cB + (unsigned)(t + 2) * kstep;
            const unsigned a3 = a2 + kstep, b3 = b2 + kstep;
            const int selc = ui & 1, seln = (last && has_next) ? ((ui + 1) & 1) : selc;
            PG8_LDB(B0, 0, 0); PG8_LDB(B1, 0, 1); PG8_SCHED; PG8_LDA(At, 0, 0); { PG8_OA(q_, selc, 1); PG8_STAGE(PG8_SA(1, 1), rsA, a1 + hA, q_); }
            PG8_WAIT_V(8); PG8_WAIT_L(0); PG8_BAR; if (t == 0) { PG8_MMA0(0, 0, At, B0); PG8_MMA0(0, 1, At, B1); } else { PG8_MMA(0, 0, At, B0); PG8_MMA(0, 1, At, B1); } PG8_BAR; PG8_SCHED;
            PG8_LDA(At, 0, 1); PG8_STAGE(PG8_SB(0, 0), rsB, b2, voffB); PG8_STAGE(PG8_SB(0, 1), rsB, b2 + hstep, voffB); { PG8_OA(q_, seln, 0); PG8_STAGE(PG8_SA(0, 0), rsA, a2, q_); }
            PG8_WAIT_V(8); PG8_WAIT_L(0); PG8_BAR; if (t == 0) { PG8_MMA0(1, 0, At, B0); PG8_MMA0(1, 1, At, B1); } else { PG8_MMA(1, 0, At, B0); PG8_MMA(1, 1, At, B1); } PG8_BAR; PG8_SCHED;
            PG8_LDB(B0, 1, 0); PG8_LDB(B1, 1, 1); PG8_SCHED; PG8_LDA(At, 1, 0); { PG8_OA(q_, seln, 1); PG8_STAGE(PG8_SA(0, 1), rsA, a2 + hA, q_); }
            PG8_WAIT_V(8); PG8_WAIT_L(0); PG8_BAR; PG8_MMA(0, 0, At, B0); PG8_MMA(0, 1, At, B1); PG8_BAR; PG8_SCHED;
            PG8_LDA(At, 1, 1); PG8_STAGE(PG8_SB(1, 0), rsB, b3, voffB); PG8_STAGE(PG8_SB(1, 1), rsB, b3 + hstep, voffB); { PG8_OA(q_, seln, 0); PG8_STAGE(PG8_SA(1, 0), rsA, a3, q_); }
            PG8_WAIT_V(8); PG8_WAIT_L(0); PG8_BAR; PG8_MMA(1, 0, At, B0); PG8_MMA(1, 1, At, B1); PG8_BAR; PG8_SCHED;
        }
        if constexpr (ALIGN) { if (wr == 0) PG8_BAR; }
        E(acc, cur, wr, wc, fr, fq, sideb + (ui % 3) * 512);
        if constexpr (DUPK == 5) { asm volatile("" ::: "memory"); E(acc, cur, wr, wc, fr, fq, sideb + (ui % 3) * 512); }
        if (!has_next) break;
        cur = nxt; cA = nA; cB = nB; ++ui;
        if constexpr (ALIGN) { if (wr == 1) PG8_BAR; }
    }
    PG8_WAIT_V(0);
    if constexpr (!ALIGN) { if (wr == 0) PG8_BAR; }
    PG8_BAR;
#undef PG8_SA
#undef PG8_SB
#undef PG8_STAGE
#undef PG8_SIDE
#undef PG8_OA
#undef PG8_LDA
#undef PG8_LDB
#undef PG8_MMA
#undef PG8_MMA0
#undef PG8_CAT
#undef PG8_WAIT_V
#undef PG8_WAIT_L
#undef PG8_BAR
#undef PG8_SCHED
}

typedef GAS unsigned gu32;
#define XB_TMO      128
#define XB_XCNT(j)  (256  + 64 * (j))
#define XB_XSUB(j)  (1280 + 64 * (j))
#define XB_XGEN(j)  (2304 + 64 * (j))
#define XB_TOP      3328
#define XB_TOPGEN   3392
#define XCD_BAR_WORDS 3456
#define XB_SPIN_CAP (1u << 20)
#ifndef XB_DIRECT
#define XB_DIRECT 1
#endif
DEV unsigned xb_ld(unsigned* p) { return __hip_atomic_load(p, __ATOMIC_RELAXED, __HIP_MEMORY_SCOPE_AGENT); }
DEV unsigned xb_add(unsigned* p, unsigned v) { return __hip_atomic_fetch_add(p, v, __ATOMIC_RELAXED, __HIP_MEMORY_SCOPE_AGENT); }
DEV unsigned xb_xcc_id() { return (unsigned)__builtin_amdgcn_s_getreg((3 << 11) | 20) & 0xFu; }
#define XB_SPIN(cond, bar) do { unsigned _sp = 0; while (cond) { __builtin_amdgcn_s_sleep(1); \
    if ((++_sp & 255u) == 0u) { if (xb_ld(&(bar)[XB_TMO])) break; if (_sp > XB_SPIN_CAP) { atomicAdd(&(bar)[XB_TMO], 1u); break; } } } } while (0)
struct XcdBarrier { unsigned* bar; unsigned x; volatile LAS unsigned* st; int wave; };
DEV bool xb_thread0(int wave) { return wave == 0 && __builtin_amdgcn_mbcnt_hi(~0u, __builtin_amdgcn_mbcnt_lo(~0u, 0u)) == 0u; }
DEV XcdBarrier xcd_barrier_post(unsigned* bar, volatile LAS unsigned* st, int wave) {
    XcdBarrier b; b.bar = bar; b.x = xb_xcc_id(); b.st = st; b.wave = wave;
    if (xb_thread0(wave)) (void)xb_add(&bar[XB_XCNT(b.x)], 1u);
    return b;
}
DEV void xcd_barrier_complete(unsigned* bar, unsigned x, unsigned& nloc, unsigned& nx) {
    const unsigned G = gridDim.x * gridDim.y * gridDim.z;
    unsigned sum, cnt, mine, sp = 0u;
    for (;;) {
        sum = 0u; cnt = 0u; mine = 0u;
#pragma unroll
        for (unsigned j = 0; j < 16; ++j) { const unsigned c = xb_ld(&bar[XB_XCNT(j)]); sum += c; cnt += (c > 0u) ? 1u : 0u; mine = (j == x) ? c : mine; }
        if (sum == G) break;
        __builtin_amdgcn_s_sleep(1);
        if ((++sp & 255u) == 0u) { if (xb_ld(&bar[XB_TMO])) break; if (sp > XB_SPIN_CAP) { atomicAdd(&bar[XB_TMO], 1u); break; } }
    }
    nloc = mine > 0u ? mine : 1u; nx = cnt > 0u ? cnt : 1u;
}
DEV void xcd_barrier(const XcdBarrier& b) {
    asm volatile("s_waitcnt vmcnt(0)" ::: "memory");
    __syncthreads();
    if (xb_thread0(b.wave)) {
        unsigned* bar = b.bar;
        __builtin_amdgcn_s_waitcnt(0);
        unsigned nloc = b.st[0], nx = b.st[1];
        if (nloc == 0u) { xcd_barrier_complete(bar, b.x, nloc, nx); b.st[0] = nloc; b.st[1] = nx; }
        const unsigned old = xb_add(&bar[XB_XSUB(b.x)], 1u);
        const unsigned gen = old / nloc;
        if (old + 1u == (gen + 1u) * nloc) {
            __builtin_amdgcn_fence(__ATOMIC_RELEASE, "agent");
            asm volatile("s_waitcnt vmcnt(0)" ::: "memory");
            const unsigned og = xb_add(&bar[XB_TOP], 1u);
            const unsigned tg = og / nx;
            if (og + 1u == (tg + 1u) * nx) xb_add(&bar[XB_TOPGEN], 1u);
            else XB_SPIN(xb_ld(&bar[XB_TOPGEN]) == tg, bar);
            __builtin_amdgcn_fence(__ATOMIC_ACQUIRE, "agent");
#if !XB_DIRECT
            xb_add(&bar[XB_XGEN(b.x)], 1u);
#endif
            asm volatile("s_waitcnt vmcnt(0)" ::: "memory");
        } else {
#if XB_DIRECT
            XB_SPIN(xb_ld(&bar[XB_TOPGEN]) == gen, bar);
#else
            XB_SPIN(xb_ld(&bar[XB_XGEN(b.x)]) == gen, bar);
#endif
            __builtin_amdgcn_fence(__ATOMIC_ACQUIRE, "agent");
            asm volatile("s_waitcnt vmcnt(0)" ::: "memory");
        }
    }
    __syncthreads();
}
constexpr size_t MiB = 1u << 20;
constexpr int PMAX = 131072 + 32 * 256;
constexpr size_t W_CTL = 0, CTL_ZERO_BYTES = 64 * 1024;
constexpr size_t W_IN0 = 2 * MiB, W_GLU = 6 * MiB, W_OUT0 = 7 * MiB, W_IN1 = 9 * MiB, W_OUT1 = 16 * MiB;
constexpr size_t W_LUT = 18 * MiB, W_KM = W_LUT + 64 * 1024, W_HIST = W_KM + 256 * 1024, W_SORT = W_HIST + 64 * 1024  , W_BGU2 = 19 * MiB  , W_GR = 20 * MiB  , W_SS = 22 * MiB  ;
constexpr size_t W_GU = 32 * MiB, W_DN = 288 * MiB, W_XB = 416 * MiB  , W_XBB = 480 * MiB  , W_X8 = 1024 * MiB  , W_HB = 736 * MiB, W_YS5 = 928 * MiB, W_Y0 = 960 * MiB, W_MIXB = 1024 * MiB, W_GLAO = 1088 * MiB;
constexpr size_t W_ROUTE = 26 * MiB  , W_ACT = 736 * MiB  , W_YS = 1160 * MiB, W_END = 1432 * MiB;
static_assert(W_ACT + (size_t)PMAX * 2048 <= W_MIXB && W_YS + (size_t)PMAX * 2048 <= W_END && W_X8 + (size_t)PMAX * 1024 <= W_YS && W_ROUTE + 4 * MiB <= W_GU, "ws map");
constexpr int CW_BAR = 4096;

struct Args { const float* in[29]; float* out; unsigned char* ws; int ph_lo, ph_hi; };
struct Frame {
    LAS unsigned char* lds; int tid, lane, wave, vcu, G;
    const float* const* in; unsigned char* ws;
};
#define WSP(T_, off) ((T_*)(F.ws + (off)))

DEV unsigned pk4_fp8(float a, float b, float c, float d) { unsigned w = 0u; w = __builtin_amdgcn_cvt_pk_fp8_f32(a, b, w, false); w = __builtin_amdgcn_cvt_pk_fp8_f32(c, d, w, true); return w; }
struct CvItem { const float* src; unsigned char* dst; int pitch, K; float sc; };
constexpr int P0_I_GU = 8 * 8, P0_I_DN = 8 * 4, P0_I_IN0 = 8 * 8, P0_I_GLU = 4 * 2, P0_I_O = 8 * 4, P0_I_IN1 = 8 * 12;
constexpr int P0_N_GU = 64 * P0_I_GU, P0_N_DN = 64 * P0_I_DN, P0_NITEMS = P0_N_GU + P0_N_DN + P0_I_IN0 + P0_I_GLU + 2 * P0_I_O + P0_I_IN1;
DEV CvItem cv_decode(Frame& F, int it) {
    int r = it; const float* W; unsigned char* D; int K, N, NP, es; float sc = 0.f;
    if (r < P0_N_GU) { const int m = r / P0_I_GU; r %= P0_I_GU; W = F.in[25] + (size_t)m * 1024 * 2048; D = WSP(unsigned char, W_GU) + (size_t)m * 2048 * 1024; K = 1024; N = 2048; NP = 2048; es = 1; sc = 64.f; }
    else if ((r -= P0_N_GU) < P0_N_DN) { const int m = r / P0_I_DN; r %= P0_I_DN; W = F.in[27] + (size_t)m * 1024 * 1024; D = WSP(unsigned char, W_DN) + (size_t)m * 1024 * 1024; K = 1024; N = 1024; NP = 1024; es = 1; sc = 128.f; }
    else if ((r -= P0_N_DN) < P0_I_IN0) { W = F.in[1]; D = WSP(unsigned char, W_IN0); K = 1024; N = 2048; NP = 2048; es = 2; }
    else if ((r -= P0_I_IN0) < P0_I_GLU) { W = F.in[10]; D = WSP(unsigned char, W_GLU); K = 512; N = 512; NP = 512; es = 2; }
    else if ((r -= P0_I_GLU) < P0_I_O) { W = F.in[13]; D = WSP(unsigned char, W_OUT0); K = 1024; N = 1024; NP = 1024; es = 2; }
    else if ((r -= P0_I_O) < P0_I_O) { W = F.in[18]; D = WSP(unsigned char, W_OUT1); K = 1024; N = 1024; NP = 1024; es = 2; }
    else { r -= P0_I_O; W = F.in[14]; D = WSP(unsigned char, W_IN1); K = 1024; N = 3072; NP = 3088; es = 2; }
    const int nblk = N / 256, kb = r / nblk, nb = r % nblk;
    CvItem c; c.src = W + (size_t)(128 * kb) * NP + 256 * nb; c.dst = D + ((size_t)(256 * nb) * K + 128 * kb) * es; c.pitch = NP; c.K = K; c.sc = sc; return c;
}
DEV void cv_load(const CvItem& c, f32x4 (&v)[16], int tid) {
#pragma unroll
    for (int i = 0; i < 16; ++i) v[i] = *(const f32x4*)(c.src + (size_t)(8 * i + (tid >> 6)) * c.pitch + 4 * (tid & 63));
}
DEV void cv_store(const CvItem& c, const f32x4 (&v)[16], LAS float* T_, int tid) {
#pragma unroll
    for (int i = 0; i < 16; ++i) *(LAS f32x4*)(T_ + (8 * i + (tid >> 6)) * 260 + 4 * (tid & 63)) = v[i];
    __syncthreads();
    const int n = tid & 255, kh = tid >> 8; const LAS float* s = T_ + (64 * kh) * 260 + n;
    if (c.sc > 0.f) { const float q = c.sc; unsigned char* d = c.dst + (size_t)n * c.K + 64 * kh;
#pragma unroll
        for (int g = 0; g < 4; ++g) { u32x4 o;
            o.x = pk4_fp8(s[(16 * g + 0) * 260] * q, s[(16 * g + 1) * 260] * q, s[(16 * g + 2) * 260] * q, s[(16 * g + 3) * 260] * q); o.y = pk4_fp8(s[(16 * g + 4) * 260] * q, s[(16 * g + 5) * 260] * q, s[(16 * g + 6) * 260] * q, s[(16 * g + 7) * 260] * q);
            o.z = pk4_fp8(s[(16 * g + 8) * 260] * q, s[(16 * g + 9) * 260] * q, s[(16 * g + 10) * 260] * q, s[(16 * g + 11) * 260] * q); o.w = pk4_fp8(s[(16 * g + 12) * 260] * q, s[(16 * g + 13) * 260] * q, s[(16 * g + 14) * 260] * q, s[(16 * g + 15) * 260] * q);
            st_wt(d + 16 * g, o); }
    } else { unsigned char* d = c.dst + ((size_t)n * c.K + 64 * kh) * 2;
#pragma unroll
        for (int g = 0; g < 8; ++g) { u32x4 o; o.x = cvt_pk(s[(8 * g + 0) * 260], s[(8 * g + 1) * 260]); o.y = cvt_pk(s[(8 * g + 2) * 260], s[(8 * g + 3) * 260]); o.z = cvt_pk(s[(8 * g + 4) * 260], s[(8 * g + 5) * 260]); o.w = cvt_pk(s[(8 * g + 6) * 260], s[(8 * g + 7) * 260]);
            st_wt(d + 16 * g, o); }
    }
    __syncthreads();
}
__constant__ int BUCKET_TH2[16] = {16, 22, 30, 40, 54, 73, 99, 134, 182, 246, 332, 450, 609, 825, 1117, 1513};
DEV void p0_prologue(Frame& F) {
    { LAS float* T_ = (LAS float*)F.lds; f32x4 va[16], vb[16];
      int it = F.vcu;
      if (it < P0_NITEMS) { CvItem ca = cv_decode(F, it); cv_load(ca, va, F.tid);
#pragma unroll 1
          for (;;) {
              const int it2 = it + F.G; CvItem cb = ca; const bool h2 = it2 < P0_NITEMS; if (h2) { cb = cv_decode(F, it2); cv_load(cb, vb, F.tid); }
              cv_store(ca, va, T_, F.tid);
              if (!h2) break;
              const int it3 = it2 + F.G; const bool h3 = it3 < P0_NITEMS; if (h3) { ca = cv_decode(F, it3); cv_load(ca, va, F.tid); }
              cv_store(cb, vb, T_, F.tid);
              if (!h3) break;
              it = it3;
          } } }
    const int gt = F.vcu * 512 + F.tid, NGT = F.G * 512;
    for (int i = gt; i < 16 * 1024; i += NGT) { const int n = i >> 10, k = i & 1023; WSP(bf16_t, W_IN1)[(size_t)(3072 + n) * 1024 + k] = (bf16_t)(cvt_pk(F.in[14][(size_t)k * 3088 + 3072 + n], 0.f) & 0xffffu); }
    { const f32x4* x4 = (const f32x4*)F.in[0]; u32x2* o = WSP(u32x2, W_XB);
      for (size_t i = gt; i < (size_t)T * 1024 / 4; i += (size_t)NGT * 8) { f32x4 v[8];
#pragma unroll
          for (int u = 0; u < 8; ++u) v[u] = x4[i + (size_t)u * NGT];
#pragma unroll
          for (int u = 0; u < 8; ++u) { u32x2 w; w.x = cvt_pk(v[u].x, v[u].y); w.y = cvt_pk(v[u].z, v[u].w); st_wt(o + i + (size_t)u * NGT, w); } } }
    for (int i = gt; i < 2 * 32 * 2048 / 4; i += NGT) { const f32x4 v = ((const f32x4*)F.in[26])[i]; WSP(f32x4, W_BGU2)[i] = (f32x4){v.x, v.z, 4.f * (v.y + 1.f), 4.f * (v.w + 1.f)}; }
    for (int i = gt; i < 1024 * 64 / 4; i += NGT) WSP(f32x4, W_KM)[i] = (f32x4){0.f, 0.f, 0.f, 0.f};
    for (int i = gt; i < 8 * 2048; i += NGT) { const int h = i >> 11, n = i & 2047; int bk = n;
        if (n >= 16) { bk = 16;
#pragma unroll
            for (int q = 1; q < 16; ++q) bk += (n >= BUCKET_TH2[q]) ? 1 : 0; }
        WSP(float, W_LUT)[i] = F.in[12][bk * 8 + h] * 1.4426950408889634f; }
}

DEV void p_kmean(Frame& F) {
    const int gw = F.vcu * 8 + F.wave, NGW = F.G * 8; const bf16_t* H0 = WSP(bf16_t, W_HB); float* KM = WSP(float, W_KM);
    for (int it = gw; it < 1024; it += NGW) { const int blk = it & 7, h = (it >> 3) & 7, b = it >> 6; const int r8 = F.lane >> 3, c = F.lane & 7;
        const bf16_t* p = H0 + (size_t)(b * 2048 + blk * 256 + r8) * 2048 + 1024 + h * 64 + c * 8; float s[8];
#pragma unroll
        for (int j = 0; j < 8; ++j) s[j] = 0.f;
#pragma unroll 8
        for (int i = 0; i < 32; ++i) { const u32x4 v = *(const u32x4*)(p + (size_t)i * 8 * 2048);
            s[0] += bflo(v.x); s[1] += bfhi(v.x); s[2] += bflo(v.y); s[3] += bfhi(v.y); s[4] += bflo(v.z); s[5] += bfhi(v.z); s[6] += bflo(v.w); s[7] += bfhi(v.w); }
#pragma unroll
        for (int j = 0; j < 8; ++j) { s[j] += __shfl_xor(s[j], 8); s[j] += __shfl_xor(s[j], 16); s[j] += __shfl_xor(s[j], 32); }
        if (F.lane < 8) {
#pragma unroll
            for (int j = 0; j < 8; ++j) KM[(size_t)it * 64 + c * 8 + j] = s[j] * (1.f / 256.f); } }
}

DEV void s5_item(Frame& F, int b, int g, LAS unsigned char* sl  ) {
    const int lane = F.lane, p0 = lane & 31, hi = lane >> 5, q4 = lane >> 4;
    const float* lam_re = F.in[2]; const float* lam_im = F.in[3]; const float* log_dt = F.in[4]; const float* b_re = F.in[5]; const float* b_im = F.in[6];
    const float* c_re = F.in[7]; const float* c_im = F.in[8]; const float* dsk = F.in[9];
    const bf16_t* H0 = WSP(bf16_t, W_HB); bf16_t* YS = WSP(bf16_t, W_YS5);
    const float dt = __expf(log_dt[g]);
    float ar[2], ai[2]; bf16x8 bfr[4];
#pragma unroll
    for (int s = 0; s < 2; ++s) { const int p = p0 + 32 * s; const float lr = lam_re[g * 64 + p], li = lam_im[g * 64 + p]; const float mag = __expf(lr * dt);
        ar[s] = mag * cosf(li * dt); ai[s] = mag * sinf(li * dt);
        const float er = ar[s] - 1.f, ei = ai[s], den = lr * lr + li * li; const float qr = (er * lr + ei * li) / den, qi = (ei * lr - er * li) / den;
        u32x4 wr_, wi_; float vr[8], vi[8];
#pragma unroll
        for (int j = 0; j < 8; ++j) { const float br = b_re[(g * 64 + p) * 16 + 8 * hi + j], bi = b_im[(g * 64 + p) * 16 + 8 * hi + j]; vr[j] = qr * br - qi * bi; vi[j] = qr * bi + qi * br; }
        wr_.x = cvt_pk(vr[0], vr[1]); wr_.y = cvt_pk(vr[2], vr[3]); wr_.z = cvt_pk(vr[4], vr[5]); wr_.w = cvt_pk(vr[6], vr[7]);
        wi_.x = cvt_pk(vi[0], vi[1]); wi_.y = cvt_pk(vi[2], vi[3]); wi_.z = cvt_pk(vi[4], vi[5]); wi_.w = cvt_pk(vi[6], vi[7]);
        bfr[2 * s] = __builtin_bit_cast(bf16x8, wr_); bfr[2 * s + 1] = __builtin_bit_cast(bf16x8, wi_); }
    bf16x8 cfr[4];
#pragma unroll
    for (int ks = 0; ks < 4; ++ks) { float v[8];
#pragma unroll
        for (int j = 0; j < 8; ++j) { const int c = 32 * ks + 8 * q4 + j, p = c >> 1; const int h = lane & 15; v[j] = (c & 1) ? -c_im[(g * 16 + h) * 64 + p] : c_re[(g * 16 + h) * 64 + p]; }
        u32x4 w; w.x = cvt_pk(v[0], v[1]); w.y = cvt_pk(v[2], v[3]); w.z = cvt_pk(v[4], v[5]); w.w = cvt_pk(v[6], v[7]); cfr[ks] = __builtin_bit_cast(bf16x8, w); }
    float dv[4];
#pragma unroll
    for (int r = 0; r < 4; ++r) dv[r] = dsk[g * 16 + 4 * q4 + r];
    const int tm = 16 * ((p0 >> 2) & 1) + 4 * (p0 >> 3) + (p0 & 3);
    const bf16_t* urow = H0 + (size_t)(b * 2048 + tm) * 2048 + g * 16 + 8 * hi;
    float cr[2] = {0.f, 0.f}, ci[2] = {0.f, 0.f};
    bf16x8 ufr = *(const bf16x8*)urow;
    for (int tile = 0; tile < 64; ++tile) {
        const bf16x8 ucur = ufr;
        if (tile + 1 < 64) ufr = *(const bf16x8*)(urow + (size_t)(tile + 1) * 32 * 2048);
        f32x16 x[4];
#pragma unroll
        for (int n = 0; n < 4; ++n) { f32x16 z;
#pragma unroll
            for (int r = 0; r < 16; ++r) z[r] = 0.f;
            x[n] = __builtin_amdgcn_mfma_f32_32x32x16_bf16(ucur, bfr[n], z, 0, 0, 0); }
#pragma unroll
        for (int s = 0; s < 2; ++s) {
            f32x16& xr = x[2 * s]; f32x16& xi = x[2 * s + 1];
            float sr = hi ? 0.f : cr[s], si = hi ? 0.f : ci[s];
#pragma unroll
            for (int r = 0; r < 16; ++r) { const float nr = ar[s] * sr - ai[s] * si + xr[r], ni = ar[s] * si + ai[s] * sr + xi[r]; xr[r] = nr; xi[r] = ni; sr = nr; si = ni; }
            const float o_r = swap32(sr), o_i = swap32(si);
            float wr_ = hi ? o_r : 0.f, wi_ = hi ? o_i : 0.f;
#pragma unroll
            for (int r = 0; r < 16; ++r) { const float nr = ar[s] * wr_ - ai[s] * wi_, ni = ar[s] * wi_ + ai[s] * wr_; wr_ = nr; wi_ = ni; xr[r] += wr_; xi[r] += wi_; }
            const float e_r = swap32(xr[15]), e_i = swap32(xi[15]);
            cr[s] = hi ? xr[15] : e_r; ci[s] = hi ? xi[15] : e_i;
#pragma unroll
            for (int r = 0; r < 16; ++r) *(LAS unsigned*)(sl + (16 * hi + r) * 256 + (p0 + 32 * s) * 4) = cvt_pk(xr[r], xi[r]);
        }
#pragma unroll
        for (int tt = 0; tt < 2; ++tt) {
            f32x4 y = {0.f, 0.f, 0.f, 0.f};
#pragma unroll
            for (int ks = 0; ks < 4; ++ks) { const bf16x8 sf = *(const LAS bf16x8*)(sl + (16 * tt + (lane & 15)) * 256 + ks * 64 + q4 * 16); y = __builtin_amdgcn_mfma_f32_16x16x32_bf16(cfr[ks], sf, y, 0, 0, 0); }
            const int t = tile * 32 + 16 * tt + (lane & 15);
            const u32x2 uw = *(const u32x2*)(H0 + (size_t)(b * 2048 + t) * 2048 + g * 16 + 4 * q4);
            const float y0 = gelu_tanh(y[0] + dv[0] * bflo(uw.x)), y1 = gelu_tanh(y[1] + dv[1] * bfhi(uw.x)), y2 = gelu_tanh(y[2] + dv[2] * bflo(uw.y)), y3 = gelu_tanh(y[3] + dv[3] * bfhi(uw.y));
            u32x2 ow; ow.x = cvt_pk(y0, y1); ow.y = cvt_pk(y2, y3);
            *(u32x2*)(YS + (size_t)(b * 2048 + t) * 512 + g * 16 + 4 * q4) = ow;
        }
    }
}

constexpr int AT_K = 0, AT_V = 24576, AT_WS = 49152, AT_OST = 51200, AT_LUT = AT_OST + 8 * 4096  , AT_LUTB = 8704, AT_Q = AT_LUT + 8 * AT_LUTB  , AT_END = AT_Q + 64;
DEV int crow(int r, int hi) { return (r & 3) + 8 * (r >> 2) + 4 * hi; }
DEV s16x4 vtr(const LAS unsigned char* p) { typedef short v4i16_t __attribute__((ext_vector_type(4))); return __builtin_bit_cast(s16x4, __builtin_amdgcn_ds_read_tr16_b64_v4i16((LAS v4i16_t*)p)); }
DEV void moba_unit(Frame& F, int b, int h, int own) {
    const int lane = F.lane, wid = F.wave, r32 = lane & 31, hi = lane >> 5;
    LAS unsigned char* lds = F.lds;
    const bf16_t* H0 = WSP(bf16_t, W_HB); const float* KM = WSP(float, W_KM);
    LAS float* lut = (LAS float*)(lds + AT_LUT + h * AT_LUTB); LAS float* wsf = (LAS float*)(lds + AT_WS) + wid * 64;
    const size_t rowbase = (size_t)b * 2048;
    const int qpos = own * 256 + wid * 32 + r32;
    bf16x8 qr[4];
#pragma unroll
    for (int d0 = 0; d0 < 4; ++d0) qr[d0] = *(const bf16x8*)(H0 + (rowbase + qpos) * 2048 + 512 + h * 64 + d0 * 16 + hi * 8);
    unsigned selmask = 0u;
    if (own > 0) {
        float gate[7];
#pragma unroll
        for (int j = 0; j < 7; ++j) { float s = 0.f;
            if (j < own) { const float* km = KM + ((size_t)(b * 8 + h) * 8 + j) * 64 + hi * 8;
#pragma unroll
                for (int d0 = 0; d0 < 4; ++d0) { const f32x4 k0 = *(const f32x4*)(km + d0 * 16), k1 = *(const f32x4*)(km + d0 * 16 + 4); const u32x4 qw = __builtin_bit_cast(u32x4, qr[d0]);
                    s += bflo(qw.x) * k0.x + bfhi(qw.x) * k0.y + bflo(qw.y) * k0.z + bfhi(qw.y) * k0.w + bflo(qw.z) * k1.x + bfhi(qw.z) * k1.y + bflo(qw.w) * k1.z + bfhi(qw.w) * k1.w; } }
            gate[j] = s + swap32(s); }
#pragma unroll
        for (int j = 0; j < 7; ++j) { int rank = 0;
#pragma unroll
            for (int j2 = 0; j2 < 7; ++j2) if (j2 != j && j2 < own && (gate[j2] > gate[j] || (gate[j2] == gate[j] && j2 < j))) ++rank;
            if (j < own && rank < 3) selmask |= 1u << j; }
    }
    const int NT = 4 * (own + 1);
#define KV0(i) ((i) < 4 ? own * 256 + (i) * 64 : (((i) - 4) >> 2) * 256 + (((i) - 4) & 3) * 64)
    const bf16_t* kbase = H0 + (rowbase + lane) * 2048 + 1024 + h * 64 + wid * 8;
    const bf16_t* vbase = H0 + (rowbase + 16 * (wid & 3) + (lane >> 2)) * 2048 + 1536 + h * 64 + (wid >> 2) * 32 + (lane & 3) * 8;
#define LOADKV(i, bo_) do { const int kv0_ = KV0(i); \
        __builtin_amdgcn_global_load_lds((const unsigned*)(kbase + (size_t)kv0_ * 2048), (LAS unsigned*)(lds + AT_K + bo_ + wid * 1024), 16, 0, 0); \
        __builtin_amdgcn_global_load_lds((const unsigned*)(vbase + (size_t)kv0_ * 2048), (LAS unsigned*)(lds + AT_V + bo_ + wid * 1024), 16, 0, 0); } while (0)
    LOADKV(0, 0); LOADKV(1, 8192);
    int bo = 0, bo2 = 16384;
    float m_ref = 0.f, l_run = 0.f; f32x16 o[2];
#pragma unroll
    for (int r = 0; r < 16; ++r) { o[0][r] = 0.f; o[1][r] = 0.f; }
    const int Q0 = own * 256 + wid * 32;
#pragma unroll 1
    for (int i = 0; i < NT; ++i) {
        if (i + 1 < NT) asm volatile("s_waitcnt vmcnt(2) lgkmcnt(0)\n\ts_barrier" ::: "memory"); else asm volatile("s_waitcnt vmcnt(0) lgkmcnt(0)\n\ts_barrier" ::: "memory");
        if (i + 2 < NT) LOADKV(i + 2, bo2);
        const int kv0 = KV0(i);
        const bool ownblk = i < 4;
        if (!(ownblk && kv0 > Q0 + 31)) {
            const bool partial = ownblk && (kv0 + 63 > Q0);
            const bool rowsel = ownblk || ((selmask >> ((i - 4) >> 2)) & 1u);
            f32x16 p0, p1;
            { const LAS float* lp = lut + 128 + (qpos - kv0 - 4 * hi - 59);
#pragma unroll
              for (int r = 0; r < 16; ++r) { const int c = (r & 3) + 8 * (r >> 2); p0[r] = lp[59 - c] - m_ref; p1[r] = lp[59 - c - 32] - m_ref; } }
            { const LAS unsigned char* kb = lds + AT_K + bo + hi * 1024 + r32 * 16;
#pragma unroll
              for (int d0 = 0; d0 < 4; ++d0) { const bf16x8 k0 = *(const LAS bf16x8*)(kb + d0 * 2048), k1 = *(const LAS bf16x8*)(kb + d0 * 2048 + 512);
                  p0 = __builtin_amdgcn_mfma_f32_32x32x16_bf16(k0, qr[d0], p0, 0, 0, 0); p1 = __builtin_amdgcn_mfma_f32_32x32x16_bf16(k1, qr[d0], p1, 0, 0, 0); } }
            if (partial) { const int dbase = qpos - kv0 - 4 * hi;
#pragma unroll
                for (int r = 0; r < 16; ++r) { const int d0_ = dbase - ((r & 3) + 8 * (r >> 2)); p0[r] = d0_ >= 0 ? p0[r] : -INFINITY; p1[r] = d0_ >= 32 ? p1[r] : -INFINITY; } }
            float rmax = fmaxf(p0[0], p1[0]);
#pragma unroll
            for (int r = 1; r < 16; ++r) rmax = fmaxf(rmax, fmaxf(p0[r], p1[r]));
            rmax = fmaxf(rmax, swap32(rmax));
            rmax = rowsel ? rmax : -INFINITY;
            if (i == 0 || __any(rmax > 8.f)) {
                const float dl = (i == 0) ? rmax : fmaxf(rmax, 0.f); m_ref += dl;
#pragma unroll
                for (int r = 0; r < 16; ++r) { p0[r] -= dl; p1[r] -= dl; }
                const float alpha = __builtin_amdgcn_exp2f(-dl); l_run *= alpha;
                if (hi == 0) wsf[r32] = alpha;
#pragma unroll
                for (int r = 0; r < 16; ++r) { const float f = wsf[crow(r, hi)]; o[0][r] *= f; o[1][r] *= f; }
            }
            float rs = 0.f;
#pragma unroll
            for (int r = 0; r < 16; ++r) { p0[r] = __builtin_amdgcn_exp2f(p0[r]); p1[r] = __builtin_amdgcn_exp2f(p1[r]); rs += p0[r] + p1[r]; }
            l_run += rowsel ? rs : 0.f;
            const unsigned km = rowsel ? 0xffffffffu : 0u;
            u32x4 pw[4];
            pw[0] = (u32x4){cvt_pk(p0[0], p0[1]) & km, cvt_pk(p0[2], p0[3]) & km, cvt_pk(p0[4], p0[5]) & km, cvt_pk(p0[6], p0[7]) & km};
            pw[1] = (u32x4){cvt_pk(p0[8], p0[9]) & km, cvt_pk(p0[10], p0[11]) & km, cvt_pk(p0[12], p0[13]) & km, cvt_pk(p0[14], p0[15]) & km};
            pw[2] = (u32x4){cvt_pk(p1[0], p1[1]) & km, cvt_pk(p1[2], p1[3]) & km, cvt_pk(p1[4], p1[5]) & km, cvt_pk(p1[6], p1[7]) & km};
            pw[3] = (u32x4){cvt_pk(p1[8], p1[9]) & km, cvt_pk(p1[10], p1[11]) & km, cvt_pk(p1[12], p1[13]) & km, cvt_pk(p1[14], p1[15]) & km};
            { const LAS unsigned char* vp = lds + AT_V + bo + ((lane >> 4) & 1) * 32 + (lane & 3) * 8 + (4 * hi + ((lane & 15) >> 2)) * 64;
#pragma unroll
              for (int d0 = 0; d0 < 2; ++d0)
#pragma unroll
                  for (int ks = 0; ks < 4; ++ks) { const s16x4 lo = vtr(vp + d0 * 4096 + ks * 1024), hh = vtr(vp + d0 * 4096 + ks * 1024 + 512);
                      const bf16x8 vf = (bf16x8){lo[0], lo[1], lo[2], lo[3], hh[0], hh[1], hh[2], hh[3]};
                      o[d0] = __builtin_amdgcn_mfma_f32_32x32x16_bf16(__builtin_bit_cast(bf16x8, pw[ks]), vf, o[d0], 0, 0, 0); } }
        }
        bo = (bo == 16384) ? 0 : bo + 8192; bo2 = (bo2 == 16384) ? 0 : bo2 + 8192;
    }
    __syncthreads();
#undef KV0
#undef LOADKV
    l_run += swap32(l_run);
    if (hi == 0) wsf[32 + r32] = 1.f / l_run;
    bf16_t* Ow = WSP(bf16_t, W_Y0) + (rowbase + own * 256 + wid * 32) * 1024 + 512 + h * 64;
    LAS bf16_t* stg = (LAS bf16_t*)(lds + AT_OST) + wid * 2048;
#pragma unroll
    for (int r = 0; r < 16; ++r) { const int orow = crow(r, hi); const float rl = wsf[32 + orow];
        stg[orow * 64 + r32] = (bf16_t)(cvt_pk(o[0][r] * rl, 0.f) & 0xffffu); stg[orow * 64 + 32 + r32] = (bf16_t)(cvt_pk(o[1][r] * rl, 0.f) & 0xffffu); }
#pragma unroll
    for (int i = 0; i < 4; ++i) { const int row = i * 8 + (lane >> 3), ch = lane & 7; const u32x4 v = *(const LAS u32x4*)(stg + row * 64 + ch * 8); *(u32x4*)(Ow + (size_t)row * 1024 + ch * 8) = v; }
    __syncthreads();
}
constexpr int CW_MOBAQ = 64;
DEV void p_s5_moba(Frame& F, int mode) {
    if ((mode & 1) && (F.vcu & 3) == 3) { const int it = (F.vcu >> 2) * 8 + F.wave; if (it < 512) s5_item(F, it >> 5, it & 31, F.lds + 65536 + F.wave * 8192); }
    __syncthreads();
    if (!(mode & 2)) return;
    for (int i = F.tid; i < 8 * 2176; i += 512) { const int hh = i / 2176, j = i % 2176; ((LAS float*)(F.lds + AT_LUT))[i] = j < 128 ? 0.f : WSP(float, W_LUT)[hh * 2048 + j - 128]; }
    volatile LAS int* qw = (volatile LAS int*)(F.lds + AT_Q);
    unsigned* ctl = (unsigned*)(F.ws + W_CTL);
    __syncthreads();
    if (F.tid == 0) qw[0] = (int)__hip_atomic_fetch_add(ctl + CW_MOBAQ, 1u, __ATOMIC_RELAXED, __HIP_MEMORY_SCOPE_AGENT);
    __syncthreads();
    for (;;) {
        const int u = __builtin_amdgcn_readfirstlane(qw[0]);
        if (u >= 1024) break;
        unsigned nx_ = 0u; if (F.tid == 0) nx_ = __hip_atomic_fetch_add(ctl + CW_MOBAQ, 1u, __ATOMIC_RELAXED, __HIP_MEMORY_SCOPE_AGENT);
        const int own = 7 - (u >> 7), bh = u & 127;
        moba_unit(F, bh >> 3, bh & 7, own);
        __syncthreads();
        if (F.tid == 0) qw[0] = (int)nx_;
        __syncthreads();
    }
}
constexpr size_t R_RE = W_ROUTE, R_RW = W_ROUTE + 512 * 1024, R_POS = W_ROUTE + 1024 * 1024, R_TOK = W_ROUTE + 2 * MiB, R_WGT = W_ROUTE + 3 * MiB;
constexpr int WT_PITCH = 1028;
constexpr int RW_PITCH = 1032;
constexpr int LN_XT = 32 * RW_PITCH * 2;
constexpr int LN_LG = 147456;
constexpr int LN_HIST = LN_LG + 8 * 528;
static_assert(LN_XT + 8 * 8256 <= LDS_TOK && LN_HIST + 128 <= LDSCTL_OFF, "LN LDS map");
template <int MODE, bool ROUTER, bool XIN_F32, bool OUT_F32, bool GRP = false>
DEV void p_ln(Frame& F, const float* xin32, const bf16_t* xinb, bf16_t* xoutb, float* xout32, const float* gam, const float* bet, const float* wrt, const float* brt) {
    LAS bf16_t* whi = (LAS bf16_t*)F.lds; LAS bf16_t* xt = (LAS bf16_t*)(F.lds + LN_XT) + F.wave * 4128; LAS float* lgs = (LAS float*)(F.lds + LN_LG) + F.wave * 132; LAS int* hist = (LAS int*)(F.lds + LN_HIST);
    const int lane = F.lane, l15 = lane & 15, q4 = lane >> 4;
    if constexpr (ROUTER) {
        for (int i = F.tid; i < 1024 * 32; i += 512) { const int k = i >> 5, e = i & 31; whi[e * RW_PITCH + k] = (bf16_t)(cvt_pk(wrt[i], 0.f) & 0xffffu); }
        if (F.tid < 32) hist[F.tid] = 0;
        __syncthreads();
    }
    if constexpr (GRP) {
        const u32x4* src = (const u32x4*)(WSP(bf16_t, W_IN1) + (size_t)3072 * 1024);
        for (int i = F.tid; i < 16 * 128; i += 512) { const int e = i >> 7, c = i & 127; *(LAS u32x4*)(whi + e * RW_PITCH + c * 8) = src[i]; }
        __syncthreads();
    }
    const bf16_t* MIXB = WSP(bf16_t, W_MIXB); const unsigned char* YS8 = WSP(unsigned char, W_YS); const int* POS = WSP(int, R_POS);
    int* RE = WSP(int, R_RE); float* RW = WSP(float, R_RW);
    const float alpha = 1.4142135623730951f;
    f32x4 gq[4], bq[4];
#pragma unroll
    for (int j = 0; j < 4; ++j) { gq[j] = *(const f32x4*)(gam + j * 256 + lane * 4); bq[j] = *(const f32x4*)(bet + j * 256 + lane * 4); }
    float bias8[8];
    if constexpr (ROUTER) {
#pragma unroll
        for (int r = 0; r < 8; ++r) bias8[r] = brt[(r >> 2) * 16 + 4 * q4 + (r & 3)]; }
    for (int wgi = F.vcu; wgi < 256; wgi += F.G) {
        const int r0 = wgi * 128 + F.wave * 16;
        constexpr bool PF = (MODE == 0) && !XIN_F32;
        u32x2 rx[4][4], rm[4][4];
        if constexpr (PF) {
#pragma unroll
            for (int u = 0; u < 4; ++u)
#pragma unroll
                for (int j = 0; j < 4; ++j) { rx[u][j] = *(const u32x2*)(xinb + (size_t)(r0 + u) * 1024 + j * 256 + lane * 4); rm[u][j] = *(const u32x2*)(MIXB + (size_t)(r0 + u) * 1024 + j * 256 + lane * 4); } }
#pragma unroll 1
        for (int i4 = 0; i4 < 16; i4 += 4) {
            float v[4][16];
            if constexpr (PF) {
#pragma unroll
                for (int u = 0; u < 4; ++u)
#pragma unroll
                    for (int j = 0; j < 4; ++j) { v[u][4 * j] = alpha * bflo(rx[u][j].x) + bflo(rm[u][j].x); v[u][4 * j + 1] = alpha * bfhi(rx[u][j].x) + bfhi(rm[u][j].x); v[u][4 * j + 2] = alpha * bflo(rx[u][j].y) + bflo(rm[u][j].y); v[u][4 * j + 3] = alpha * bfhi(rx[u][j].y) + bfhi(rm[u][j].y); }
                if (i4 + 4 < 16) {
#pragma unroll
                    for (int u = 0; u < 4; ++u)
#pragma unroll
                        for (int j = 0; j < 4; ++j) { rx[u][j] = *(const u32x2*)(xinb + (size_t)(r0 + i4 + 4 + u) * 1024 + j * 256 + lane * 4); rm[u][j] = *(const u32x2*)(MIXB + (size_t)(r0 + i4 + 4 + u) * 1024 + j * 256 + lane * 4); } }
            } else {
#pragma unroll
            for (int u = 0; u < 4; ++u) { const int row = r0 + i4 + u;
                if constexpr (XIN_F32) {
#pragma unroll
                    for (int j = 0; j < 4; ++j) { const f32x4 a = *(const f32x4*)(xin32 + (size_t)row * 1024 + j * 256 + lane * 4); v[u][4 * j] = alpha * a.x; v[u][4 * j + 1] = alpha * a.y; v[u][4 * j + 2] = alpha * a.z; v[u][4 * j + 3] = alpha * a.w; }
                } else {
#pragma unroll
                    for (int j = 0; j < 4; ++j) { const u32x2 a = *(const u32x2*)(xinb + (size_t)row * 1024 + j * 256 + lane * 4); v[u][4 * j] = alpha * bflo(a.x); v[u][4 * j + 1] = alpha * bfhi(a.x); v[u][4 * j + 2] = alpha * bflo(a.y); v[u][4 * j + 3] = alpha * bfhi(a.y); }
                }
                if constexpr (MODE == 0) {
#pragma unroll
                    for (int j = 0; j < 4; ++j) { const u32x2 m = *(const u32x2*)(MIXB + (size_t)row * 1024 + j * 256 + lane * 4); v[u][4 * j] += bflo(m.x); v[u][4 * j + 1] += bfhi(m.x); v[u][4 * j + 2] += bflo(m.y); v[u][4 * j + 3] += bfhi(m.y); }
                } else {
                    const int4 pos4 = *(const int4*)(POS + row * 4);
                    const int ps[4] = {__builtin_amdgcn_readfirstlane(pos4.x), __builtin_amdgcn_readfirstlane(pos4.y), __builtin_amdgcn_readfirstlane(pos4.z), __builtin_amdgcn_readfirstlane(pos4.w)};
#pragma unroll
                    for (int kx = 0; kx < 4; ++kx)
#pragma unroll
                        for (int j = 0; j < 4; ++j) { const unsigned m = *(const unsigned*)(YS8 + (size_t)ps[kx] * 1024 + j * 256 + lane * 4); const f32x2 lo2 = __builtin_amdgcn_cvt_pk_f32_fp8(m, false), hi2 = __builtin_amdgcn_cvt_pk_f32_fp8(m, true);
                            v[u][4 * j] += lo2.x * (1.f / 64.f); v[u][4 * j + 1] += lo2.y * (1.f / 64.f); v[u][4 * j + 2] += hi2.x * (1.f / 64.f); v[u][4 * j + 3] += hi2.y * (1.f / 64.f); }
                }
            }
            }
            float s1[4], s2[4];
#pragma unroll
            for (int u = 0; u < 4; ++u) { s1[u] = 0.f; s2[u] = 0.f;
#pragma unroll
                for (int q = 0; q < 16; ++q) { s1[u] += v[u][q]; s2[u] = fmaf(v[u][q], v[u][q], s2[u]); } }
#pragma unroll
            for (int o = 1; o < 64; o <<= 1) {
#pragma unroll
                for (int u = 0; u < 4; ++u) { s1[u] += __shfl_xor(s1[u], o); s2[u] += __shfl_xor(s2[u], o); } }
#pragma unroll
            for (int u = 0; u < 4; ++u) { const int row = r0 + i4 + u; const float mean = s1[u] * (1.f / 1024.f); const float var = fmaxf(s2[u] * (1.f / 1024.f) - mean * mean, 0.f); const float rstd = 1.f / sqrtf(var + 1e-5f);
#pragma unroll
                for (int j = 0; j < 4; ++j) { const int c = j * 256 + lane * 4; const f32x4 g4 = gq[j], b4 = bq[j];
                    const float y0 = (v[u][4 * j] - mean) * rstd * g4.x + b4.x, y1 = (v[u][4 * j + 1] - mean) * rstd * g4.y + b4.y, y2 = (v[u][4 * j + 2] - mean) * rstd * g4.z + b4.z, y3 = (v[u][4 * j + 3] - mean) * rstd * g4.w + b4.w;
                    if constexpr (OUT_F32) st_wt(xout32 + (size_t)row * 1024 + c, (f32x4){y0, y1, y2, y3});
                    else { u32x2 w; w.x = cvt_pk(y0, y1); w.y = cvt_pk(y2, y3); st_wt(xoutb + (size_t)row * 1024 + c, w);
                        if constexpr (ROUTER || GRP) { *(LAS u32x2*)(xt + u * RW_PITCH + c) = w; } } } }
            if constexpr (GRP) {
                f32x4 ga = {0.f, 0.f, 0.f, 0.f};
#pragma unroll 8
                for (int ks = 0; ks < 32; ++ks) { const bf16x8 xb = *(const LAS bf16x8*)(xt + (l15 & 3) * RW_PITCH + ks * 32 + q4 * 8), wa = *(const LAS bf16x8*)(whi + l15 * RW_PITCH + ks * 32 + q4 * 8);
                    ga = __builtin_amdgcn_mfma_f32_16x16x32_bf16(wa, xb, ga, 0, 0, 0); }
                if (l15 < 4) *(f32x4*)(WSP(float, W_GR) + (size_t)(r0 + i4 + l15) * 16 + 4 * q4) = ga; }
            if constexpr (ROUTER) {
                f32x4 acc[2] = {{0.f, 0.f, 0.f, 0.f}, {0.f, 0.f, 0.f, 0.f}};
#pragma unroll 8
                for (int ks = 0; ks < 32; ++ks) { const bf16x8 xb = *(const LAS bf16x8*)(xt + (l15 & 3) * RW_PITCH + ks * 32 + q4 * 8);
#pragma unroll
                    for (int mt = 0; mt < 2; ++mt) { const bf16x8 wa = *(const LAS bf16x8*)(whi + (mt * 16 + l15) * RW_PITCH + ks * 32 + q4 * 8); acc[mt] = __builtin_amdgcn_mfma_f32_16x16x32_bf16(wa, xb, acc[mt], 0, 0, 0); } }
                if (l15 < 4) {
#pragma unroll
                    for (int mt = 0; mt < 2; ++mt)
#pragma unroll
                        for (int r = 0; r < 4; ++r) lgs[l15 * 33 + mt * 16 + 4 * q4 + r] = acc[mt][r] + bias8[mt * 4 + r]; }
                if (lane < 4) { float lg[32];
#pragma unroll
                    for (int e = 0; e < 32; ++e) lg[e] = lgs[lane * 33 + e];
                    unsigned taken = 0u; float tv[4]; int ti[4];
#pragma unroll
                    for (int r = 0; r < 4; ++r) { float best = -INFINITY; int bi = 0;
#pragma unroll
                        for (int e = 0; e < 32; ++e) { const bool ok = !((taken >> e) & 1u) && lg[e] > best; best = ok ? lg[e] : best; bi = ok ? e : bi; }
                        taken |= 1u << bi; tv[r] = best; ti[r] = bi; }
                    float ex[4], sm = 0.f;
#pragma unroll
                    for (int r = 0; r < 4; ++r) { ex[r] = __expf(tv[r] - tv[0]); sm += ex[r]; }
                    const float inv = 1.f / sm; const int row = r0 + i4 + lane;
                    *(int4*)(RE + row * 4) = make_int4(ti[0], ti[1], ti[2], ti[3]); *(f32x4*)(RW + row * 4) = (f32x4){ex[0] * inv, ex[1] * inv, ex[2] * inv, ex[3] * inv};
#pragma unroll
                    for (int r = 0; r < 4; ++r) atomicAdd((int*)(hist + ti[r]), 1); }
            }
        }
        if constexpr (ROUTER) { __syncthreads(); if (F.tid < 32) { WSP(int, W_HIST)[wgi * 32 + F.tid] = hist[F.tid]; hist[F.tid] = 0; } __syncthreads(); }
    }
}

DEV void p_sort(Frame& F) {
    LAS int* Ls = (LAS int*)F.lds; const int tid = F.tid;
    const int* HIST = WSP(int, W_HIST); int* SORT = WSP(int, W_SORT);
    const int* RE = WSP(int, R_RE); const float* RW = WSP(float, R_RW); int* POS = WSP(int, R_POS); int* TOK = WSP(int, R_TOK); float* WGT = WSP(float, R_WGT);
    for (int wgi = F.vcu; wgi < 256; wgi += F.G) {
        { const int e = tid & 31, part = tid >> 5; int tot = 0, pre = 0;
          for (int w = part * 16; w < part * 16 + 16; ++w) { const int hh = HIST[w * 32 + e]; tot += hh; pre += (w < wgi) ? hh : 0; }
          Ls[part * 32 + e] = tot; Ls[512 + part * 32 + e] = pre; }
        Ls[2048 + tid] = RE[wgi * 512 + tid];
        __syncthreads();
        if (tid < 32) { int tot = 0, pre = 0; for (int p = 0; p < 16; ++p) { tot += Ls[p * 32 + tid]; pre += Ls[512 + p * 32 + tid]; } Ls[1200 + tid] = tot; Ls[1300 + tid] = pre; }
        __syncthreads();
        if (tid == 0) { int a = 0; for (int e = 0; e < 32; ++e) { Ls[1024 + e] = a; a += (Ls[1200 + e] + 255) / 256 * 256; } Ls[1056] = a; }
        __syncthreads();
        { const int e = tid & 31, seg = tid >> 5; int cnt = 0;
#pragma unroll 8
          for (int i = 0; i < 32; ++i) cnt += (Ls[2048 + seg * 32 + i] == e) ? 1 : 0;
          Ls[3072 + seg * 32 + e] = cnt;
          __syncthreads();
          int c = Ls[1024 + e] + Ls[1300 + e];
          for (int s2 = 0; s2 < seg; ++s2) c += Ls[3072 + s2 * 32 + e];
#pragma unroll 8
          for (int i = 0; i < 32; ++i) if (Ls[2048 + seg * 32 + i] == e) { Ls[2560 + seg * 32 + i] = c; ++c; } }
        __syncthreads();
        { const int pos = Ls[2560 + tid]; TOK[pos] = wgi * 128 + (tid >> 2); WGT[pos] = RW[wgi * 512 + tid]; POS[wgi * 512 + tid] = pos; }
        { const bf16_t* XBBp = WSP(bf16_t, W_XBB); unsigned char* XS8 = WSP(unsigned char, W_X8);
          for (int rg = 0; rg < 16; rg += 4) {
              u32x4 a[4], b2[4];
#pragma unroll
              for (int u = 0; u < 4; ++u) { const int r = F.wave * 16 + rg + u; const u32x4* src = (const u32x4*)(XBBp + (size_t)(wgi * 128 + r) * 1024 + F.lane * 16); a[u] = src[0]; b2[u] = src[1]; }
#pragma unroll
              for (int u = 0; u < 4; ++u) { const int r = F.wave * 16 + rg + u;
                  u32x4 o; o.x = pk4_fp8(bflo(a[u].x) * 16.f, bfhi(a[u].x) * 16.f, bflo(a[u].y) * 16.f, bfhi(a[u].y) * 16.f); o.y = pk4_fp8(bflo(a[u].z) * 16.f, bfhi(a[u].z) * 16.f, bflo(a[u].w) * 16.f, bfhi(a[u].w) * 16.f);
                  o.z = pk4_fp8(bflo(b2[u].x) * 16.f, bfhi(b2[u].x) * 16.f, bflo(b2[u].y) * 16.f, bfhi(b2[u].y) * 16.f); o.w = pk4_fp8(bflo(b2[u].z) * 16.f, bfhi(b2[u].z) * 16.f, bflo(b2[u].w) * 16.f, bfhi(b2[u].w) * 16.f);
#pragma unroll
                  for (int kx = 0; kx < 4; ++kx) { const int pos = Ls[2560 + r * 4 + kx]; st_wt(XS8 + (size_t)pos * 1024 + F.lane * 16, o); } } }
          if (wgi < 32) { const int e = wgi; for (int r = Ls[1024 + e] + Ls[1200 + e] + F.wave; r < Ls[1024 + e + 1]; r += 8) st_wt(XS8 + (size_t)r * 1024 + F.lane * 16, (u32x4){0u, 0u, 0u, 0u}); } }
        if (wgi < 32) { const int e = wgi; for (int r = Ls[1024 + e] + Ls[1200 + e] + tid; r < Ls[1024 + e + 1]; r += 512) { TOK[r] = 0; WGT[r] = 0.f; } }
        if (wgi == 0) { if (tid < 33) SORT[tid] = Ls[1024 + tid]; if (tid == 0) SORT[33] = Ls[1056] / 256;
            for (int pm = tid; pm < PMAX / 256; pm += 512) { int e = 0; for (int j = 1; j < 32; ++j) if (pm * 256 >= Ls[1024 + j]) e = j; SORT[64 + pm] = e; } }
        __syncthreads();
    }
}

DEV void p_gr(Frame& F) {
    const int gw = F.vcu * 8 + F.wave, NGW = F.G * 8, lane = F.lane, q4 = lane >> 4; const bf16_t* XB = WSP(bf16_t, W_XB); const bf16_t* Wg = WSP(bf16_t, W_IN1) + (size_t)3072 * 1024; float* GR = WSP(float, W_GR);
    for (int it = gw; it < T / 16; it += NGW) { f32x4 acc = {0.f, 0.f, 0.f, 0.f};
        const bf16_t* ap = XB + (size_t)(it * 16 + (lane & 15)) * 1024 + q4 * 8; const bf16_t* bp = Wg + (size_t)(lane & 15) * 1024 + q4 * 8;
        bf16x8 a[32], bb[32];
#pragma unroll
        for (int ks = 0; ks < 32; ++ks) { a[ks] = *(const bf16x8*)(ap + ks * 32); bb[ks] = *(const bf16x8*)(bp + ks * 32); }
#pragma unroll
        for (int ks = 0; ks < 32; ++ks) acc = __builtin_amdgcn_mfma_f32_16x16x32_bf16(a[ks], bb[ks], acc, 0, 0, 0);
#pragma unroll
        for (int r = 0; r < 4; ++r) GR[(size_t)(it * 16 + 4 * q4 + r) * 16 + (lane & 15)] = acc[r]; }
}

constexpr int GP = 264, GP2 = 144;
constexpr int GB_QIN = 0, GB_KST = 16896, GB_ATT = 35328, GB_DEC = 44544, GB_VT = 45056, GB_SIZE = 81920;
constexpr size_t W_GB = W_YS;
static_assert((size_t)2048 * GB_SIZE <= (size_t)PMAX * 2048, "blob region");
constexpr int GA_GRS = 0, GA_GT = 4096, GA_BL = 8192  , GA_QIN = GA_BL + GB_QIN, GA_KST = GA_BL + GB_KST, GA_ATT = GA_BL + GB_ATT, GA_DEC = GA_BL + GB_DEC, GA_KIN = GA_BL + 45056  , GA_VT = GA_KIN + 17408, GA_END = GA_VT + 36864;
DEV float logsigm_fast(float z) { const float e = __builtin_amdgcn_exp2f(-1.4426950408889634f * fabsf(z)); return fminf(z, 0.f) - 0.6931471805599453f * __builtin_amdgcn_logf(1.f + e); }
struct GlaRaw { unsigned q[16], k[16], v[32]; f32x4 ga, gb; };
DEV void p_gla_prep(Frame& F) {
    LAS unsigned char* lds = F.lds; const int tid = F.tid, lane = F.lane, wid = F.wave, q4 = lane >> 4, l15 = lane & 15;
    const bf16_t* H1 = WSP(bf16_t, W_HB); const float* GR = WSP(float, W_GR); unsigned char* GB = F.ws + W_GB;
    const float* wg2 = F.in[15]; const float* bg = F.in[16];
    for (int i = tid; i < 64 * GP2 / 4; i += 512) ((LAS unsigned*)(lds + GA_ATT))[i] = 0u;
    const int dk = 32 * (wid & 3) + (lane & 31), tg = 2 * (wid >> 2) + (lane >> 5);
    const int dvl = tid & 255, th2 = tid >> 8;
    const int tzm = 16 * (((lane & 31) >> 2) & 1) + 4 * ((lane & 31) >> 3) + (lane & 3);
    for (int wg = F.vcu; wg < 256; wg += F.G) {
        const int b = wg >> 4, h = (wg >> 2) & 3, n0 = (wg & 3) * 8;
        bf16x8 w2f; { float wv[8];
#pragma unroll
          for (int j = 0; j < 8; ++j) wv[j] = wg2[(8 * (lane >> 5) + j) * 512 + h * 128 + dk];
          const u32x4 ww = {cvt_pk(wv[0], wv[1]), cvt_pk(wv[2], wv[3]), cvt_pk(wv[4], wv[5]), cvt_pk(wv[6], wv[7])}; w2f = __builtin_bit_cast(bf16x8, ww); }
        const float bgv = bg[h * 128 + dk];
#define GLA_LOAD(R, n_) do { const size_t rb_ = (size_t)b * 2048 + (n_) * 64; \
        _Pragma("unroll") for (int i = 0; i < 16; ++i) { const size_t ro = (rb_ + 16 * tg + i) * 3072; R.q[i] = H1[ro + h * 128 + dk]; R.k[i] = H1[ro + 512 + h * 128 + dk]; } \
        _Pragma("unroll") for (int i = 0; i < 32; ++i) R.v[i] = H1[(rb_ + 32 * th2 + i) * 3072 + 1024 + h * 256 + dvl]; \
        { const float* gp_ = GR + (rb_ + 32 * (wid >> 2) + tzm) * 16 + 8 * (lane >> 5); R.ga = *(const f32x4*)gp_; R.gb = *(const f32x4*)(gp_ + 4); } } while (0)
        GlaRaw cur, nxt; GLA_LOAD(cur, n0); nxt = cur;
#pragma unroll 1
      for (int sub = 0; sub < 8; ++sub) { const int n = n0 + sub;
        if (sub + 1 < 8) GLA_LOAD(nxt, n + 1);
        float cs[16]; float run = 0.f;
        { const u32x4 aw = {cvt_pk(cur.ga.x, cur.ga.y), cvt_pk(cur.ga.z, cur.ga.w), cvt_pk(cur.gb.x, cur.gb.y), cvt_pk(cur.gb.z, cur.gb.w)};
          f32x16 zz;
#pragma unroll
          for (int r = 0; r < 16; ++r) zz[r] = bgv;
          zz = __builtin_amdgcn_mfma_f32_32x32x16_bf16(__builtin_bit_cast(bf16x8, aw), w2f, zz, 0, 0, 0);
#pragma unroll
          for (int i = 0; i < 16; ++i) { run += logsigm_fast(zz[i]) * (1.f / 16.f); cs[i] = run; } }
        ((LAS float*)(lds + GA_GT))[tg * 128 + dk] = run;
        __syncthreads();
        float off = 0.f, btot = 0.f;
#pragma unroll
        for (int g2 = 0; g2 < 4; ++g2) { const float gtv = ((LAS float*)(lds + GA_GT))[g2 * 128 + dk]; btot += gtv; off += (g2 < tg) ? gtv : 0.f; }
        if (tg == 0) ((LAS float*)(lds + GA_DEC))[dk] = __expf(btot);
        { unsigned kst[8];
#pragma unroll
          for (int i = 0; i < 16; i += 2) { float kk[2];
#pragma unroll
              for (int u = 0; u < 2; ++u) { const int t = 16 * tg + i + u; const float bc = cs[i + u] + off; const float qv = bflo(cur.q[i + u]), kv = bflo(cur.k[i + u]);
                  *(LAS bf16_t*)(lds + GA_QIN + t * GP + dk * 2) = (bf16_t)(cvt_pk(qv * __expf(bc), 0.f) & 0xffffu);
                  *(LAS bf16_t*)(lds + GA_KIN + t * 272 + dk * 2) = (bf16_t)(cvt_pk(kv * __expf(-bc), 0.f) & 0xffffu);
                  kk[u] = kv * __expf(btot - bc); }
              kst[i >> 1] = cvt_pk(kk[0], kk[1]); }
          *(LAS u32x4*)(lds + GA_KST + dk * GP2 + tg * 32) = (u32x4){kst[0], kst[1], kst[2], kst[3]};
          *(LAS u32x4*)(lds + GA_KST + dk * GP2 + tg * 32 + 16) = (u32x4){kst[4], kst[5], kst[6], kst[7]}; }
#pragma unroll
        for (int i = 0; i < 32; i += 8) *(LAS u32x4*)(lds + GA_VT + dvl * GP2 + (32 * th2 + i) * 2) = (u32x4){cur.v[i] | (cur.v[i + 1] << 16), cur.v[i + 2] | (cur.v[i + 3] << 16), cur.v[i + 4] | (cur.v[i + 5] << 16), cur.v[i + 6] | (cur.v[i + 7] << 16)};
        __syncthreads();
#pragma unroll
        for (int rep = 0; rep < 2; ++rep) { const int ti = wid + 8 * rep; if (ti < 10) {
            int jt, it2; if (ti < 4) { jt = 0; it2 = ti; } else if (ti < 7) { jt = 1; it2 = ti - 3; } else if (ti < 9) { jt = 2; it2 = ti - 5; } else { jt = 3; it2 = 3; }
            f32x4 a4 = {0.f, 0.f, 0.f, 0.f};
#pragma unroll
            for (int ks = 0; ks < 4; ++ks) { const bf16x8 kf = *(const LAS bf16x8*)(lds + GA_KIN + (16 * jt + l15) * 272 + ks * 64 + q4 * 16); const u32x2 q0_ = *(const LAS u32x2*)(lds + GA_QIN + (16 * it2 + l15) * GP + ks * 64 + q4 * 16), q1_ = *(const LAS u32x2*)(lds + GA_QIN + (16 * it2 + l15) * GP + ks * 64 + q4 * 16 + 8); const bf16x8 qf = __builtin_bit_cast(bf16x8, (u32x4){q0_.x, q0_.y, q1_.x, q1_.y});
                a4 = __builtin_amdgcn_mfma_f32_16x16x32_bf16(kf, qf, a4, 0, 0, 0); }
            const int i_ = 16 * it2 + l15, j0 = 16 * jt + 4 * q4;
            u32x2 w; w.x = cvt_pk(j0 <= i_ ? a4[0] : 0.f, j0 + 1 <= i_ ? a4[1] : 0.f); w.y = cvt_pk(j0 + 2 <= i_ ? a4[2] : 0.f, j0 + 3 <= i_ ? a4[3] : 0.f);
            *(LAS u32x2*)(lds + GA_ATT + i_ * GP2 + j0 * 2) = w; } }
        __syncthreads();
        unsigned char* blob = GB + (size_t)((b * 32 + n) * 4 + h) * GB_SIZE;
        for (int c = tid; c < 45056 / 16; c += 512) st_wt(blob + c * 16, *(const LAS u32x4*)(lds + GA_BL + c * 16));
        for (int c = tid; c < 36864 / 16; c += 512) st_wt(blob + GB_VT + c * 16, *(const LAS u32x4*)(lds + GA_VT + c * 16));
        cur = nxt;
      }
#undef GLA_LOAD
    }
}
constexpr int GS_BUF = 54272;
constexpr int GS_VT = 0, GS_QIN = 9216, GS_KST = GS_QIN + 16896, GS_ATT = GS_KST + 18432, GS_DEC = GS_ATT + 9216;
static_assert(3 * GS_BUF <= LDSCTL_OFF, "GLA ring");
DEV void gla_scan_item(Frame& F, int b, int h, int c4) {
    LAS unsigned char* lds = F.lds; const int lane = F.lane, wid = F.wave, q4 = lane >> 4, l15 = lane & 15;
    bf16_t* GO = WSP(bf16_t, W_GLAO); float* SS = WSP(float, W_SS); const unsigned char* GB = F.ws + W_GB;
    const int c16 = wid & 3, th = wid >> 2;
    f32x4 sacc[8];
#pragma unroll
    for (int m = 0; m < 8; ++m) sacc[m] = (f32x4){0.f, 0.f, 0.f, 0.f};
    const size_t rb = (size_t)b * 2048;
    float sqv[2][4]; unsigned ov[2][4];
#pragma unroll
    for (int mt = 0; mt < 2; ++mt)
#pragma unroll
        for (int r = 0; r < 4; ++r) { sqv[mt][r] = 0.f; ov[mt][r] = 0u; }
    const int npc = (wid < 5) ? 7 : 6;
#define GS_ISSUE(n_, bo_) do { const unsigned char* blob_ = GB + (size_t)((b * 32 + (n_)) * 4 + h) * GB_SIZE; \
        for (int p_ = wid; p_ < 53; p_ += 8) { const int so_ = p_ < 9 ? GB_VT + c4 * 9216 + p_ * 1024 : (p_ - 9) * 1024; \
            __builtin_amdgcn_global_load_lds((const unsigned*)(blob_ + so_ + lane * 16), (LAS unsigned*)(lds + (bo_) + p_ * 1024), 16, 0, 0); } } while (0)
    GS_ISSUE(0, 0); GS_ISSUE(1, GS_BUF);
    int bo = 0, bo2 = 2 * GS_BUF;
#pragma unroll 1
    for (int n = 0; n < 32; ++n) { const int t0 = n * 64;
        if (n + 1 < 32) { if (npc == 7) asm volatile("s_waitcnt vmcnt(7) lgkmcnt(0)\n\ts_barrier" ::: "memory"); else asm volatile("s_waitcnt vmcnt(6) lgkmcnt(0)\n\ts_barrier" ::: "memory"); } else asm volatile("s_waitcnt vmcnt(0) lgkmcnt(0)\n\ts_barrier" ::: "memory");
        if (n > 0) {
#pragma unroll
            for (int mt = 0; mt < 2; ++mt)
#pragma unroll
                for (int r = 0; r < 4; ++r) { const size_t trow = rb + (t0 - 64) + 32 * th + 16 * mt + 4 * q4 + r; GO[trow * 1024 + h * 256 + c4 * 64 + c16 * 16 + l15] = (bf16_t)ov[mt][r];
                    SS[(trow * 4 + h) * 16 + c4 * 4 + c16] = sqv[mt][r]; } }
        if (n + 2 < 32) GS_ISSUE(n + 2, bo2);
        const LAS unsigned char* bu = lds + bo;
        bf16x8 vf[2];
#pragma unroll
        for (int ks = 0; ks < 2; ++ks) vf[ks] = *(const LAS bf16x8*)(bu + GS_VT + (c16 * 16 + l15) * GP2 + ks * 64 + q4 * 16);
        bf16x8 sf[4];
#pragma unroll
        for (int ks = 0; ks < 4; ++ks) { const u32x4 w = {cvt_pk(sacc[2 * ks][0], sacc[2 * ks][1]), cvt_pk(sacc[2 * ks][2], sacc[2 * ks][3]), cvt_pk(sacc[2 * ks + 1][0], sacc[2 * ks + 1][1]), cvt_pk(sacc[2 * ks + 1][2], sacc[2 * ks + 1][3])}; sf[ks] = __builtin_bit_cast(bf16x8, w); }
#pragma unroll
        for (int mt = 0; mt < 2; ++mt) { const int i_ = 32 * th + 16 * mt + l15; f32x4 oa = {0.f, 0.f, 0.f, 0.f};
#pragma unroll
            for (int ks = 0; ks < 2; ++ks) { if (ks == 1 && th == 0) continue; const bf16x8 af = *(const LAS bf16x8*)(bu + GS_ATT + i_ * GP2 + ks * 64 + q4 * 16); oa = __builtin_amdgcn_mfma_f32_16x16x32_bf16(af, vf[ks], oa, 0, 0, 0); }
#pragma unroll
            for (int ks = 0; ks < 4; ++ks) { const u32x2 lo = *(const LAS u32x2*)(bu + GS_QIN + i_ * GP + (32 * ks + 4 * q4) * 2), hi2 = *(const LAS u32x2*)(bu + GS_QIN + i_ * GP + (32 * ks + 16 + 4 * q4) * 2);
                const u32x4 w = {lo.x, lo.y, hi2.x, hi2.y}; oa = __builtin_amdgcn_mfma_f32_16x16x32_bf16(__builtin_bit_cast(bf16x8, w), sf[ks], oa, 0, 0, 0); }
#pragma unroll
            for (int r = 0; r < 4; ++r) { ov[mt][r] = cvt_pk(oa[r], 0.f) & 0xffffu; float sq = oa[r] * oa[r]; sq += __shfl_xor(sq, 1); sq += __shfl_xor(sq, 2); sq += __shfl_xor(sq, 4); sq += __shfl_xor(sq, 8); sqv[mt][r] = sq; } }
#pragma unroll
        for (int md = 0; md < 8; ++md) { const f32x4 dc = *(const LAS f32x4*)(bu + GS_DEC + (16 * md + 4 * q4) * 4); sacc[md] = sacc[md] * dc;
#pragma unroll
            for (int ks = 0; ks < 2; ++ks) { const bf16x8 kf = *(const LAS bf16x8*)(bu + GS_KST + (16 * md + l15) * GP2 + ks * 64 + q4 * 16); sacc[md] = __builtin_amdgcn_mfma_f32_16x16x32_bf16(kf, vf[ks], sacc[md], 0, 0, 0); } }
        bo = (bo == 2 * GS_BUF) ? 0 : bo + GS_BUF; bo2 = (bo2 == 2 * GS_BUF) ? 0 : bo2 + GS_BUF;
    }
#undef GS_ISSUE
#pragma unroll
    for (int mt = 0; mt < 2; ++mt)
#pragma unroll
        for (int r = 0; r < 4; ++r) { const size_t trow = rb + 31 * 64 + 32 * th + 16 * mt + 4 * q4 + r; GO[trow * 1024 + h * 256 + c4 * 64 + c16 * 16 + l15] = (bf16_t)ov[mt][r]; SS[(trow * 4 + h) * 16 + c4 * 4 + c16] = sqv[mt][r]; }
    asm volatile("s_waitcnt vmcnt(0)" ::: "memory");
    __syncthreads();
}
DEV void p_gla_scan(Frame& F) { for (int v = F.vcu; v < 256; v += F.G) gla_scan_item(F, v >> 4, (v >> 2) & 3, v & 3); }

DEV void p_gla_norm(Frame& F) {
    const int gw = F.vcu * 8 + F.wave, NGW = F.G * 8, lane = F.lane; const bf16_t* GO = WSP(bf16_t, W_GLAO); const float* SS = WSP(float, W_SS); const bf16_t* H1 = WSP(bf16_t, W_HB); bf16_t* Y0 = WSP(bf16_t, W_Y0);
    const f32x4 nw = *(const f32x4*)(F.in[17] + lane * 4);
    for (int row = gw; row < T; row += NGW) {
#pragma unroll
        for (int h = 0; h < 4; ++h) { const float* sp = SS + ((size_t)row * 4 + h) * 16; const f32x4 a = *(const f32x4*)sp, b2 = *(const f32x4*)(sp + 4), c = *(const f32x4*)(sp + 8), d = *(const f32x4*)(sp + 12);
            const float sq = (a.x + a.y + a.z + a.w) + (b2.x + b2.y + b2.z + b2.w) + (c.x + c.y + c.z + c.w) + (d.x + d.y + d.z + d.w); const float r = 1.f / sqrtf(sq * (1.f / 256.f) + 1e-5f);
            const u32x2 o = *(const u32x2*)(GO + (size_t)row * 1024 + h * 256 + lane * 4); const u32x2 g = *(const u32x2*)(H1 + (size_t)row * 3072 + 2048 + h * 256 + lane * 4);
            const float g0 = bflo(g.x), g1 = bfhi(g.x), g2 = bflo(g.y), g3 = bfhi(g.y);
            u32x2 w; w.x = cvt_pk(bflo(o.x) * r * nw.x * g0 * fast_sigm(g0), bfhi(o.x) * r * nw.y * g1 * fast_sigm(g1)); w.y = cvt_pk(bflo(o.y) * r * nw.z * g2 * fast_sigm(g2), bfhi(o.y) * r * nw.w * g3 * fast_sigm(g3));
            st_wt(Y0 + (size_t)row * 1024 + h * 256 + lane * 4, w); } }
}
#ifndef PK_SWIGLU
#define PK_SWIGLU 1
#endif
template <bool KM_> struct FStoreScaleT { bf16_t* O; int ldc, c_lo, c_hi; float sc; float* km; static constexpr int NSIDE = 0; static constexpr bool PERM2 = false, COLSUM = KM_;
    DEV bool colsum_tile(const Unit& u) const { return (u.pn >> 1) == 2; }
    DEV void colsum_add(const Unit& u, int col, float s) const { const int h = (col - 1024) >> 6, d = col & 63; __hip_atomic_fetch_add(km + (size_t)(((u.pm >> 3) * 8 + h) * 8 + (u.pm & 7)) * 64 + d, s * (1.f / 256.f), __ATOMIC_RELAXED, __HIP_MEMORY_SCOPE_AGENT); }
    DEV const void* side(const Unit&, int) const { return nullptr; }
    DEV NoPre pre(const Unit&, int, const LAS float*) const { return NoPre{}; }
    DEV void operator()(const Unit&, int row, int col, f32x4 v0, f32x4 v1, NoPre, const LAS float*) const { const float s = (col >= c_lo && col < c_hi) ? sc : 1.f;
        const u32x4 w = {cvt_pk(v0[0] * s, v0[1] * s), cvt_pk(v0[2] * s, v0[3] * s), cvt_pk(v1[0] * s, v1[1] * s), cvt_pk(v1[2] * s, v1[3] * s)}; *(u32x4*)(O + (size_t)row * ldc + col) = w; } };
typedef FStoreScaleT<false> FStoreScale;
struct Pre8 { f32x4 b0, b1; };
struct FGlu { const bf16_t* Y; bf16_t* O; const float* b; static constexpr int NSIDE = 0; static constexpr bool PERM2 = false, COLSUM = false;
    DEV const void* side(const Unit&, int) const { return nullptr; }
    DEV Pre8 pre(const Unit&, int col, const LAS float*) const { return Pre8{*(const f32x4*)(b + col), *(const f32x4*)(b + col + 4)}; }
    DEV void operator()(const Unit&, int row, int col, f32x4 v0, f32x4 v1, const Pre8& pp, const LAS float*) const { const u32x4 y = *(const u32x4*)(Y + (size_t)row * 512 + col); const f32x4 b0 = pp.b0, b1 = pp.b1;
        const u32x4 w = {cvt_pk(bflo(y.x) * fast_sigm(v0[0] + b0.x), bfhi(y.x) * fast_sigm(v0[1] + b0.y)), cvt_pk(bflo(y.y) * fast_sigm(v0[2] + b0.z), bfhi(y.y) * fast_sigm(v0[3] + b0.w)),
                         cvt_pk(bflo(y.z) * fast_sigm(v1[0] + b1.x), bfhi(y.z) * fast_sigm(v1[1] + b1.y)), cvt_pk(bflo(y.w) * fast_sigm(v1[2] + b1.z), bfhi(y.w) * fast_sigm(v1[3] + b1.w))};
        *(u32x4*)(O + (size_t)row * 1024 + col) = w; } };
constexpr float ACT_SCALE = 4.f, WDN_SCALE = 128.f;
#ifdef NEWTON_RCP
DEV float rcp_nr(float e) { float r = __builtin_bit_cast(float, 0x7EF311C7u - __builtin_bit_cast(unsigned, e)); r = r * fmaf(-e, r, 2.f); r = r * fmaf(-e, r, 2.f); return r; }
#else
DEV float rcp_nr(float e) { return __builtin_amdgcn_rcpf(e); }
#endif
DEV float swiglu1s(float g, float u) { g = fminf(g, 7.f); u = __builtin_amdgcn_fmed3f(u, -7.f, 7.f); const float r = rcp_nr(1.f + __builtin_amdgcn_exp2f(-1.702f * 1.4426950408889634f * g)); return (g * r) * fmaf(u, ACT_SCALE, ACT_SCALE); }
#if PK_SWIGLU
DEV f32x2 swiglu2(f32x2 g, f32x2 u4) { g.x = fminf(g.x, 7.f); g.y = fminf(g.y, 7.f); u4.x = __builtin_amdgcn_fmed3f(u4.x, -6.f * ACT_SCALE, 8.f * ACT_SCALE); u4.y = __builtin_amdgcn_fmed3f(u4.y, -6.f * ACT_SCALE, 8.f * ACT_SCALE);
    const f32x2 a = g * (-1.702f * 1.4426950408889634f); f32x2 e; e.x = __builtin_amdgcn_exp2f(a.x); e.y = __builtin_amdgcn_exp2f(a.y); e = e + 1.f;
    f32x2 r; r.x = __builtin_amdgcn_rcpf(e.x); r.y = __builtin_amdgcn_rcpf(e.y); return (g * r) * u4; }
struct FSwiglu { unsigned char* ACT; const float* bgu2; float sc; static constexpr int NSIDE = 1; static constexpr bool PERM2 = true;
    DEV const void* side(const Unit& u, int) const { return bgu2 + (size_t)u.e * 2048 + u.pn * BM; }
    DEV Pre8 pre(const Unit&, int, const LAS float* sb) const { return Pre8{*(const LAS f32x4*)sb, *(const LAS f32x4*)(sb + 4)}; }
    DEV void operator()(const Unit& u, int row, int col, f32x4 v0, f32x4 v1, const Pre8& pp, const LAS float*) const { const f32x4 b0 = pp.b0, b1 = pp.b1; const f32x2 sg = {sc, sc}, su = {sc * ACT_SCALE, sc * ACT_SCALE};
        const f32x2 a01 = swiglu2(__builtin_elementwise_fma((f32x2){v0[0], v0[1]}, sg, (f32x2){b0.x, b0.y}), __builtin_elementwise_fma((f32x2){v0[2], v0[3]}, su, (f32x2){b0.z, b0.w}));
        const f32x2 a23 = swiglu2(__builtin_elementwise_fma((f32x2){v1[0], v1[1]}, sg, (f32x2){b1.x, b1.y}), __builtin_elementwise_fma((f32x2){v1[2], v1[3]}, su, (f32x2){b1.z, b1.w}));
        *(unsigned*)(ACT + (size_t)row * 1024 + (col >> 1)) = pk4_fp8(a01.x, a01.y, a23.x, a23.y); } };
#else
struct FSwiglu { unsigned char* ACT; const float* bgu; float sc; static constexpr int NSIDE = 1; static constexpr bool PERM2 = false;
    DEV const void* side(const Unit& u, int) const { return bgu + (size_t)u.e * 2048 + u.pn * BM; }
    DEV Pre8 pre(const Unit&, int, const LAS float* sb) const { return Pre8{*(const LAS f32x4*)sb, *(const LAS f32x4*)(sb + 4)}; }
    DEV void operator()(const Unit& u, int row, int col, f32x4 v0, f32x4 v1, const Pre8& pp, const LAS float*) const { const f32x4 b0 = pp.b0, b1 = pp.b1;
        const unsigned w = pk4_fp8(swiglu1s(fmaf(v0[0], sc, b0.x), fmaf(v0[1], sc, b0.y)), swiglu1s(fmaf(v0[2], sc, b0.z), fmaf(v0[3], sc, b0.w)), swiglu1s(fmaf(v1[0], sc, b1.x), fmaf(v1[1], sc, b1.y)), swiglu1s(fmaf(v1[2], sc, b1.z), fmaf(v1[3], sc, b1.w)));
        *(unsigned*)(ACT + (size_t)row * 1024 + (col >> 1)) = w; } };
#endif
constexpr float YS_SCALE = 64.f;
struct FDown { unsigned char* YS; const float* bd; const float* wgt; float sc; static constexpr int NSIDE = 2; static constexpr bool PERM2 = false;
    DEV const void* side(const Unit& u, int k) const { return k == 0 ? (const void*)(bd + (size_t)u.e * 1024 + u.pn * BM) : (const void*)(wgt + (size_t)u.pm * BM); }
    DEV Pre8 pre(const Unit&, int, const LAS float* sb) const { return Pre8{*(const LAS f32x4*)sb, *(const LAS f32x4*)(sb + 4)}; }
    DEV void operator()(const Unit& u, int row, int col, f32x4 v0, f32x4 v1, const Pre8& pp, const LAS float* sr) const { const f32x4 b0 = pp.b0, b1 = pp.b1; const float wt = *sr * YS_SCALE, ws_ = sc * wt;
        u32x2 w; w.x = pk4_fp8(fmaf(v0[0], ws_, b0.x * wt), fmaf(v0[1], ws_, b0.y * wt), fmaf(v0[2], ws_, b0.z * wt), fmaf(v0[3], ws_, b0.w * wt)); w.y = pk4_fp8(fmaf(v1[0], ws_, b1.x * wt), fmaf(v1[1], ws_, b1.y * wt), fmaf(v1[2], ws_, b1.z * wt), fmaf(v1[3], ws_, b1.w * wt));
        *(u32x2*)(YS + (size_t)row * 1024 + col) = w; } };

constexpr int NPH = 21;
#ifndef DUP_GU
#define DUP_GU 0
#endif
constexpr float X8_SCALE = 16.f, WGU_SCALE = 64.f;
constexpr float QSCALE0 = 0.125f * 1.4426950408889634f, QSCALE1 = 0.08838834764831845f;


#define NOINL __device__ __forceinline__
struct PA { const float* const* in; unsigned char* ws; float* out; int wave; };
#define MKFRAME extern __shared__ __attribute__((aligned(16))) unsigned char lds_[]; Frame F; F.lds = (LAS unsigned char*)lds_; F.wave = pa.wave; F.lane = (int)__builtin_amdgcn_mbcnt_hi(~0u, __builtin_amdgcn_mbcnt_lo(~0u, 0u)); F.tid = F.wave * 64 + F.lane; \
    F.G = gridDim.x; { const int bx = blockIdx.x; F.vcu = (F.G % 8 == 0) ? (bx % 8) * (F.G / 8) + bx / 8 : bx; } F.in = pa.in; F.ws = pa.ws;
template <class Fn> DEV void dense_gemm(Frame& F, const bf16_t* A, const bf16_t* Bt, int nM, int nN, int K, const Fn& fn) {
    Gemm g; g.A = A; g.Bt = Bt; g.rowmap = nullptr; g.bstride = 0; g.KB = K * 2; g.wave = F.wave;
    StaticOrder S; S.init(nM, nN, F.G, (int)blockIdx.x, nullptr);
    EpiRow8<Fn> E{fn};
    gemm_phase<false, false, true>(F.lds, g, S, E);
}
NOINL void ph_prologue(PA pa) { MKFRAME p0_prologue(F); }
NOINL void ph_in0(PA pa) { MKFRAME dense_gemm(F, WSP(bf16_t, W_XB), WSP(bf16_t, W_IN0), T / 256, 8, 1024, FStoreScaleT<true>{WSP(bf16_t, W_HB), 2048, 512, 1024, QSCALE0, WSP(float, W_KM)}); }
NOINL void ph_kmean(PA pa) { MKFRAME p_kmean(F); }
NOINL void ph_s5moba(PA pa, int mode) { MKFRAME p_s5_moba(F, mode); }
NOINL void ph_glu(PA pa) { MKFRAME dense_gemm(F, WSP(bf16_t, W_YS5), WSP(bf16_t, W_GLU), T / 256, 2, 512, FGlu{WSP(bf16_t, W_YS5), WSP(bf16_t, W_Y0), F.in[11]}); }
NOINL void ph_out(PA pa, int layer) { MKFRAME dense_gemm(F, WSP(bf16_t, W_Y0), layer ? WSP(bf16_t, W_OUT1) : WSP(bf16_t, W_OUT0), T / 256, 4, 1024, FStoreScale{WSP(bf16_t, W_MIXB), 1024, 0, 0, 1.f, nullptr}); }
NOINL void ph_in1(PA pa) { MKFRAME dense_gemm(F, WSP(bf16_t, W_XB), WSP(bf16_t, W_IN1), T / 256, 12, 1024, FStoreScale{WSP(bf16_t, W_HB), 3072, 0, 512, QSCALE1, nullptr}); p_gr(F); }
NOINL void ph_glaprep(PA pa) { MKFRAME p_gla_prep(F); }
NOINL void ph_glascan(PA pa) { MKFRAME p_gla_scan(F); }
NOINL void ph_glanorm(PA pa) { MKFRAME p_gla_norm(F); }
NOINL void ph_lnrouter(PA pa, int layer) { MKFRAME
    if (layer == 0) p_ln<0, true, false, false>(F, nullptr, WSP(bf16_t, W_XB), WSP(bf16_t, W_XBB), nullptr, F.in[19], F.in[20], F.in[23], F.in[24]);
    else p_ln<0, true, false, false>(F, nullptr, WSP(bf16_t, W_XB), WSP(bf16_t, W_XBB), nullptr, F.in[19] + 1024, F.in[20] + 1024, F.in[23] + (size_t)1024 * 32, F.in[24] + 32); }
NOINL void ph_sort(PA pa) { MKFRAME p_sort(F); }
NOINL void ph_gateup(PA pa, int layer) { MKFRAME const int* SORT = WSP(int, W_SORT);
    Gemm g; g.A = WSP(unsigned char, W_X8); g.Bt = WSP(unsigned char, W_GU) + (size_t)layer * 32 * 2048 * 1024; g.rowmap = nullptr; g.bstride = (size_t)2048 * 1024; g.KB = 1024; g.wave = F.wave;
    StaticOrder S; S.init(__builtin_amdgcn_readfirstlane(SORT[33]), 8, F.G, (int)blockIdx.x, (const LAS int*)(F.lds + LDS_ELIST)); fill_elist(F.lds, S, SORT + 64, F.tid);
    EpiRow8<FSwiglu> E{FSwiglu{WSP(unsigned char, W_ACT), (PK_SWIGLU ? WSP(float, W_BGU2) : F.in[26]) + (size_t)layer * 32 * 2048, 1.f / (X8_SCALE * WGU_SCALE)}};
    gemm_phase<false, true, true, DUP_GU>(F.lds, g, S, E); }
NOINL void ph_down(PA pa, int layer) { MKFRAME const int* SORT = WSP(int, W_SORT);
    Gemm g; g.A = WSP(unsigned char, W_ACT); g.Bt = WSP(unsigned char, W_DN) + (size_t)layer * 32 * 1024 * 1024; g.rowmap = nullptr; g.bstride = (size_t)1024 * 1024; g.KB = 1024; g.wave = F.wave;
    StaticOrder S; S.init(__builtin_amdgcn_readfirstlane(SORT[33]), 4, F.G, (int)blockIdx.x, (const LAS int*)(F.lds + LDS_ELIST)); fill_elist(F.lds, S, SORT + 64, F.tid);
    EpiRow8<FDown> E{FDown{WSP(unsigned char, W_YS), F.in[28] + (size_t)layer * 32 * 1024, WSP(float, R_WGT), 1.f / (ACT_SCALE * WDN_SCALE)}};
    gemm_phase<false, true, true>(F.lds, g, S, E); }
NOINL void ph_combine(PA pa, int layer) { MKFRAME
    if (layer == 0) p_ln<1, false, false, false, false>(F, nullptr, WSP(bf16_t, W_XBB), WSP(bf16_t, W_XB), nullptr, F.in[21], F.in[22], nullptr, nullptr);
    else p_ln<1, false, false, true>(F, nullptr, WSP(bf16_t, W_XBB), nullptr, pa.out, F.in[21] + 1024, F.in[22] + 1024, nullptr, nullptr); }

__global__ void __launch_bounds__(512, 2) mega(Args args) {
    extern __shared__ __attribute__((aligned(16))) unsigned char lds_[];
    LAS unsigned char* lds = (LAS unsigned char*)lds_;
    unsigned* ctl = (unsigned*)(args.ws + W_CTL);
    for (int u = threadIdx.x; u < (LDS_BYTES - LDSCTL_OFF) / 4; u += 512) ((LAS unsigned*)(lds + LDSCTL_OFF))[u] = 0u;
    __syncthreads();
    const int lo = args.ph_lo, hi = args.ph_hi;
    PA pa; pa.in = args.in; pa.ws = args.ws; pa.out = args.out; pa.wave = __builtin_amdgcn_readfirstlane(threadIdx.x >> 6);
    XcdBarrier bar; bar.bar = ctl + CW_BAR; bar.x = 0; bar.st = nullptr; bar.wave = pa.wave;
    if (hi - lo > 1) bar = xcd_barrier_post(ctl + CW_BAR, (volatile LAS unsigned*)(lds + MISC_OFF) + 8, pa.wave);
#define IN(k) (lo <= (k) && (k) < hi)
#ifdef DIAG_LO
    volatile LAS unsigned long long* tsl = (volatile LAS unsigned long long*)(lds + MISC_OFF + 128);
    if (blockIdx.x == 0 && threadIdx.x == 0) tsl[0] = __builtin_amdgcn_s_memrealtime();
#define STAMP(k) do { if (blockIdx.x == 0 && threadIdx.x == 0) tsl[(k) + 1] = __builtin_amdgcn_s_memrealtime(); } while (0)
#else
#define STAMP(k) do { } while (0)
#endif
#define SEAM(k) do { if (IN(k) && IN((k) + 1)) xcd_barrier(bar); STAMP(k); } while (0)
#ifndef REP_PHASE
#define REP_PHASE -1
#define REP_N 0
#endif
#define RUN(k, call) do { if (IN(k)) { call; if ((k) == REP_PHASE) { xcd_barrier(bar); call; } } } while (0)
    RUN(0, ph_prologue(pa)); SEAM(0);
    RUN(1, ph_in0(pa)); SEAM(1);
    if (IN(3)) { ph_s5moba(pa, 1); if (REP_PHASE == 30) ph_s5moba(pa, 1); ph_s5moba(pa, 2); if (REP_PHASE == 31) ph_s5moba(pa, 2); } SEAM(3);
    RUN(4, ph_glu(pa)); SEAM(4);
    RUN(5, ph_out(pa, 0)); SEAM(5);
    if (REP_PHASE == 99) { for (int q_ = 0; q_ < 20; ++q_) xcd_barrier(bar); }
    RUN(6, ph_lnrouter(pa, 0)); SEAM(6);
    RUN(7, ph_sort(pa)); SEAM(7);
    RUN(8, ph_gateup(pa, 0)); SEAM(8);
    RUN(9, ph_down(pa, 0)); SEAM(9);
    RUN(10, ph_combine(pa, 0)); SEAM(10);
    RUN(11, ph_in1(pa)); SEAM(11);
    RUN(12, ph_glaprep(pa)); SEAM(12);
    RUN(13, ph_glascan(pa)); SEAM(13);
    RUN(14, ph_glanorm(pa)); SEAM(14);
    RUN(15, ph_out(pa, 1)); SEAM(15);
    RUN(16, ph_lnrouter(pa, 1)); SEAM(16);
    RUN(17, ph_sort(pa)); SEAM(17);
    RUN(18, ph_gateup(pa, 1)); SEAM(18);
    RUN(19, ph_down(pa, 1)); SEAM(19);
    RUN(20, ph_combine(pa, 1));
#ifdef DIAG_LO
    xcd_barrier(bar); STAMP(20);
    if (blockIdx.x == 0 && threadIdx.x == 0) { const unsigned long long dtk = tsl[DIAG_HI + 1] - tsl[DIAG_LO]; const float f = (float)dtk * (0.01f / 10000.f); __hip_atomic_store(ctl + 8, __float_as_uint(f), __ATOMIC_RELAXED, __HIP_MEMORY_SCOPE_AGENT); }
    xcd_barrier(bar);
    { const float f = __uint_as_float(__hip_atomic_load(ctl + 8, __ATOMIC_RELAXED, __HIP_MEMORY_SCOPE_AGENT));
      for (size_t i = (size_t)blockIdx.x * 512 + threadIdx.x; i < (size_t)T * 1024; i += (size_t)gridDim.x * 512) args.out[i] *= (1.f + f); }
#endif
#undef IN
#undef SEAM
}

static int g_grid = 0;
static bool launch_setup(size_t ws_size) {
    if (g_grid == 0) {
        if (ws_size < W_END) { fprintf(stderr, "kernel_launch: workspace too small: %zu < %zu\n", ws_size, (size_t)W_END); g_grid = -1; return false; }
        int dev = 0, cus = 0, per_cu = 0;
        if (hipGetDevice(&dev) != hipSuccess || hipDeviceGetAttribute(&cus, hipDeviceAttributeMultiprocessorCount, dev) != hipSuccess) { g_grid = -1; return false; }
        if (hipFuncSetAttribute((const void*)mega, hipFuncAttributeMaxDynamicSharedMemorySize, LDS_BYTES) != hipSuccess) { fprintf(stderr, "kernel_launch: hipFuncSetAttribute failed\n"); g_grid = -1; return false; }
        if (hipOccupancyMaxActiveBlocksPerMultiprocessor(&per_cu, (const void*)mega, 512, LDS_BYTES) != hipSuccess || per_cu < 1) fprintf(stderr, "kernel_launch: occupancy query reports %d blocks/CU\n", per_cu);
        (void)hipGetLastError();
        g_grid = cus;
    }
    return g_grid > 0;
}
static void launch_phases(hipStream_t stream, void* const* d_in, void* d_out, void* d_ws, int lo, int hi) {
    Args a; memset(&a, 0, sizeof a);
    for (int i = 0; i < 29; ++i) a.in[i] = (const float*)d_in[i];
    a.out = (float*)d_out; a.ws = (unsigned char*)d_ws; a.ph_lo = lo; a.ph_hi = hi;
    hipLaunchKernelGGL(mega, dim3(g_grid), dim3(512), LDS_BYTES, stream, a);
}
}
extern "C" void kernel_launch(void* const* d_in, const int* in_sizes, int n_in, void* d_out, int out_size, void* d_ws, size_t ws_size, hipStream_t stream) {
    if (n_in != 29 || out_size != T * D) { fprintf(stderr, "kernel_launch: unexpected arguments (n_in %d, out_size %d)\n", n_in, out_size); return; }
    if (!fk::launch_setup(ws_size)) return;
    (void)hipMemsetAsync((char*)d_ws + fk::W_CTL, 0, fk::CTL_ZERO_BYTES, stream);
    fk::launch_phases(stream, d_in, d_out, d_ws, 0, fk::NPH);
}
```

```cpp
#include <hip/hip_runtime.h>
#include <cstdio>
#include <cstdint>
#include <cmath>
#include <cstring>
#define DEV __device__ __forceinline__
constexpr int Bn = 16, L = 2048, D = 1024, T = Bn * L;
namespace fk {
#define LAS __attribute__((address_space(3)))
#define GAS __attribute__((address_space(1)))
typedef unsigned short bf16_t;
typedef short bf16x8 __attribute__((ext_vector_type(8)));
typedef short s16x4 __attribute__((ext_vector_type(4)));
typedef float f32x2 __attribute__((ext_vector_type(2)));
typedef float f32x4 __attribute__((ext_vector_type(4)));
typedef float f32x16 __attribute__((ext_vector_type(16)));
typedef unsigned u32x2 __attribute__((ext_vector_type(2)));
typedef unsigned u32x4 __attribute__((ext_vector_type(4)));
typedef __bf16 bf16x2_t __attribute__((ext_vector_type(2)));
struct u32x4x2 { u32x4 a, b; };
DEV unsigned cvt_pk(float lo, float hi) { f32x2 v = {lo, hi}; bf16x2_t b = __builtin_convertvector(v, bf16x2_t); return __builtin_bit_cast(unsigned, b); }
DEV float bflo(unsigned w) { return __uint_as_float(w << 16); }
DEV float bfhi(unsigned w) { return __uint_as_float(w & 0xffff0000u); }
#ifndef WT_STORES
#define WT_STORES 0
#endif
DEV void st_wt(void* p, u32x4 v) { if (WT_STORES == 1) asm volatile("global_store_dwordx4 %0, %1, off sc1" :: "v"(p), "v"(v)); else if (WT_STORES == 2) __builtin_nontemporal_store(v, (u32x4*)p); else *(u32x4*)p = v; }
DEV void st_wt(void* p, u32x2 v) { if (WT_STORES == 1) asm volatile("global_store_dwordx2 %0, %1, off sc1" :: "v"(p), "v"(v)); else if (WT_STORES == 2) __builtin_nontemporal_store(v, (u32x2*)p); else *(u32x2*)p = v; }
DEV void st_wt(void* p, f32x4 v) { if (WT_STORES == 1) asm volatile("global_store_dwordx4 %0, %1, off sc1" :: "v"(p), "v"(v)); else if (WT_STORES == 2) __builtin_nontemporal_store(v, (f32x4*)p); else *(f32x4*)p = v; }
DEV float fast_sigm(float x) { return __builtin_amdgcn_rcpf(1.f + __builtin_amdgcn_exp2f(-1.4426950408889634f * x)); }
DEV float gelu_tanh(float x) { const float u = 0.7978845608028654f * (x + 0.044715f * x * x * x); return x * fast_sigm(2.f * u); }
DEV float wave_sum(float v) {
#pragma unroll
    for (int o = 1; o < 64; o <<= 1) v += __shfl_xor(v, o);
    return v; }
DEV float swap32(float x) { auto rr = __builtin_amdgcn_permlane32_swap(__float_as_uint(x), __float_as_uint(x), false, false); return __uint_as_float((__builtin_amdgcn_mbcnt_lo(~0u, 0u) >> 5) ? rr[0] : rr[1]); }

constexpr int BM = 256, BK = 64, HALF = 128, HTB = HALF * BK * 2, STAGE_BYTES = 8 * HTB, NXCD = 8, WGM = 8;
constexpr int LDS_TOK = 135168 - 2048;
constexpr int LDS_SIDE = 135168;
constexpr int LDS_BYTES = 163840, LDSCTL_OFF = LDS_BYTES - 1024, MISC_OFF = LDSCTL_OFF + 320;

DEV int lds_byte(int r, int c) { const int st = (r >> 4) * 2 + (c >> 5), rr = r & 15, cc = c & 31, ob = rr * 64 + cc * 2; return st * 1024 + (ob ^ (((ob >> 9) & 1) << 5)); }
DEV void stage_rc(int b, int& R, int& C) { const int st = b / 1024, sb = b % 1024, swz = sb ^ (((sb >> 9) & 1) << 5); R = (st >> 1) * 16 + swz / 64; C = (st & 1) * 32 + (swz % 64) / 2; }
DEV int perm32(int rho) { const int n = rho >> 4, i = rho & 15; return 8 * (i >> 2) + 4 * n + (i & 3); }

struct Unit { int pm, pn, e; };
struct Gemm { const void* A; const void* Bt; const int* rowmap; size_t bstride; int KB; int wave; };

struct StaticOrder {
    int nM, nN, nwg, G, c, wgm; const LAS int* elist;
    DEV void init(int nM_, int nN_, int G_, int c_, const LAS int* el, int wgm_ = WGM) { nM = nM_; nN = nN_; nwg = nM * nN; G = G_; c = c_; elist = el; wgm = wgm_; }
    DEV bool place(int i, Unit& u) const {
        const int Lx = i * G + c; if (Lx >= nwg) return false;
        int wgid = Lx; { const int q = nwg / NXCD, r = nwg % NXCD, xcd = wgid % NXCD, off = wgid / NXCD; wgid = (xcd < r ? xcd * (q + 1) : r * (q + 1) + (xcd - r) * q) + off; }
        const int nig = wgm * nN, gid = wgid / nig, fm = gid * wgm, gsz = (nM - fm) < wgm ? (nM - fm) : wgm;
        u.pm = fm + ((wgid % nig) % gsz); u.pn = (wgid % nig) / gsz; u.e = 0; return true;
    }
    DEV bool next(int i, Unit& u) const { if (!place(i, u)) return false; if (elist) u.e = __builtin_amdgcn_readfirstlane(elist[i]); return true; }
};
constexpr int LDS_ELIST = 135168 + 6144;
DEV void fill_elist(LAS unsigned char* lds, const StaticOrder& S, const int* tile_e, int tid) {
    LAS int* el = (LAS int*)(lds + LDS_ELIST);
    if (tid < 64) { Unit u; el[tid] = S.place(tid, u) ? tile_e[u.pm] : 0; }
    __syncthreads();
}

struct NoPre {};
template <class F> struct EpiRow8 {
    static constexpr bool PERM = true, PERM2 = F::PERM2; static constexpr int NSIDE = F::NSIDE; F f;
    DEV const void* side(const Unit& u, int k) const { return f.side(u, k); }
    DEV void operator()(const f32x4 (&acc)[2][2][4][2], const Unit& u, int wr, int wc, int fr, int fq, const LAS float* sd) const {
        { int ln_; asm volatile("v_mbcnt_lo_u32_b32 %0, -1, 0\n\tv_mbcnt_hi_u32_b32 %0, -1, %0" : "=v"(ln_)); fr = ln_ & 15; fq = ln_ >> 4; }
        const int cl = wc * 32 + 8 * fq, c0 = u.pn * BM + cl;
        if constexpr (NSIDE > 0) {
#pragma unroll
            for (int ai = 0; ai < 2; ++ai)
#pragma unroll
                for (int m = 0; m < 4; ++m) { const int rl = ai * HALF + wr * 64 + m * 16 + fr, row = u.pm * BM + rl;
                    f(u, row, c0, acc[ai][0][m][0], acc[ai][0][m][1], f.pre(u, c0, sd + cl), sd + 256 + rl); f(u, row, c0 + HALF, acc[ai][1][m][0], acc[ai][1][m][1], f.pre(u, c0 + HALF, sd + cl + HALF), sd + 256 + rl); }
        } else {
        const auto p0 = f.pre(u, c0, sd + cl), p1 = f.pre(u, c0 + HALF, sd + cl + HALF);
#pragma unroll
        for (int ai = 0; ai < 2; ++ai)
#pragma unroll
            for (int m = 0; m < 4; ++m) { const int rl = ai * HALF + wr * 64 + m * 16 + fr, row = u.pm * BM + rl;
                f(u, row, c0, acc[ai][0][m][0], acc[ai][0][m][1], p0, sd + 256 + rl); f(u, row, c0 + HALF, acc[ai][1][m][0], acc[ai][1][m][1], p1, sd + 256 + rl); }
        if constexpr (F::COLSUM) { if (f.colsum_tile(u)) {
            f32x4 ks[4];
#pragma unroll
            for (int q = 0; q < 4; ++q) { ks[q] = acc[0][q >> 1][0][q & 1];
#pragma unroll
                for (int am = 1; am < 8; ++am) ks[q] += acc[am >> 2][q >> 1][am & 3][q & 1]; }
#pragma unroll
            for (int q = 0; q < 4; ++q)
#pragma unroll
                for (int j = 0; j < 4; ++j) { float v = ks[q][j]; v += __shfl_xor(v, 1); v += __shfl_xor(v, 2); v += __shfl_xor(v, 4); v += __shfl_xor(v, 8); ks[q][j] = v; }
            if (fr == 0) {
#pragma unroll
                for (int q = 0; q < 4; ++q)
#pragma unroll
                    for (int j = 0; j < 4; ++j) f.colsum_add(u, c0 + (q >> 1) * HALF + (q & 1) * 4 + j, ks[q][j]); } } }
        }
    }
};

#ifndef PG8_AUX
#define PG8_AUX 0
#endif
typedef int v8i_t __attribute__((ext_vector_type(8)));
typedef int v4i_t __attribute__((ext_vector_type(4)));
template <bool GATHER, bool FP8, bool ALIGN, int DUPK = 0, class Epi, class Sched>
DEV void gemm_phase(LAS unsigned char* lds, const Gemm g, const Sched& S, const Epi& E) {
    const int wid = g.wave, lane = (int)__builtin_amdgcn_mbcnt_hi(~0u, __builtin_amdgcn_mbcnt_lo(~0u, 0u)), tid = wid * 64 + lane, wr = wid >> 2, wc = wid & 3, fr = lane & 15, fq = lane >> 4;

    const int KB = g.KB, nt = KB / 128;
    int R0, C2; { int C; stage_rc(tid * 16, R0, C); C2 = C * 2; }
    unsigned voffB[2]; { int Rb = Epi::PERM ? ((R0 & ~31) + perm32(R0 & 31)) : R0; if constexpr (Epi::PERM2) Rb = (Rb & ~3) | ((Rb & 1) << 1) | ((Rb >> 1) & 1);
      voffB[0] = (unsigned)(Rb * KB + C2); voffB[1] = voffB[0] + 64u * (unsigned)KB; }
    const unsigned kstep = 128u, hstep = (unsigned)HALF * KB, tstep = 2u * hstep;
    const unsigned ldsw = (unsigned)wid * 1024u;
    const int aoff = lds_byte(wr * 64 + fr, fq * 8); int boff = lds_byte(wc * 32 + fr, fq * 8) + 4 * HTB; asm volatile("" : "+v"(boff));
    LAS int* tokb = (LAS int*)(lds + LDS_TOK);
    const auto rsA = __builtin_amdgcn_make_buffer_rsrc((void*)g.A, 0, 0x7fffffff, 0x00020000);
    const auto rsB = __builtin_amdgcn_make_buffer_rsrc((void*)g.Bt, 0, 0x7fffffff, 0x00020000);
    const auto rsT = __builtin_amdgcn_make_buffer_rsrc((void*)(GATHER ? (const void*)g.rowmap : g.A), 0, 0x7fffffff, 0x00020000);
#define PG8_SA(b, h) (((b) * 2 + (h)) * HTB)
#define PG8_SB(b, h) ((4 + (b) * 2 + (h)) * HTB)
#define PG8_STAGE(bufoff, rs, soff, voff) do { _Pragma("unroll") for (int _i = 0; _i < 2; ++_i) { \
        if constexpr (GATHER) __builtin_amdgcn_raw_ptr_buffer_load_lds(rs, (LAS void*)(lds + (bufoff) + ldsw + _i * 8192), 16, (int)(voff)[_i], (int)(soff), 0, 0); \
        else __builtin_amdgcn_raw_ptr_buffer_load_lds(rs, (LAS void*)(lds + (bufoff) + ldsw + _i * 8192), 16, (int)(voff)[0], (int)((soff) + _i * 64u * (unsigned)KB), 0, PG8_AUX); } } while (0)
#define PG8_LDA(dst, b, h) do { _Pragma("unroll") for (int m = 0; m < 4; ++m) _Pragma("unroll") for (int k = 0; k < 2; ++k) dst[m][k] = *(const LAS bf16x8*)(lds + PG8_SA(b, h) + aoff + m * 2048 + k * 1024); } while (0)
#define PG8_LDB(dst, b, h) do { _Pragma("unroll") for (int n = 0; n < 2; ++n) _Pragma("unroll") for (int k = 0; k < 2; ++k) dst[n][k] = *(const LAS bf16x8*)(lds + boff + (PG8_SB(b, h) - 4 * HTB) + n * 2048 + k * 1024); } while (0)
#define PG8_CAT(x) __builtin_shufflevector(__builtin_bit_cast(v4i_t, x[0]), __builtin_bit_cast(v4i_t, x[1]), 0, 1, 2, 3, 4, 5, 6, 7)
#define PG8_MMA(ai, bj, At, Bt) do { __builtin_amdgcn_s_setprio(1); _Pragma("unroll") for (int m = 0; m < 4; ++m) _Pragma("unroll") for (int n = 0; n < 2; ++n) { \
        if constexpr (FP8) acc[ai][bj][m][n] = __builtin_amdgcn_mfma_scale_f32_16x16x128_f8f6f4(PG8_CAT(Bt[n]), PG8_CAT(At[m]), acc[ai][bj][m][n], 0, 0, 0, 0, 0, 0); \
        else { _Pragma("unroll") for (int k = 0; k < 2; ++k) acc[ai][bj][m][n] = __builtin_amdgcn_mfma_f32_16x16x32_bf16(Bt[n][k], At[m][k], acc[ai][bj][m][n], 0, 0, 0); } } __builtin_amdgcn_s_setprio(0); } while (0)
#define PG8_MMA0(ai, bj, At, Bt) do { __builtin_amdgcn_s_setprio(1); _Pragma("unroll") for (int m = 0; m < 4; ++m) _Pragma("unroll") for (int n = 0; n < 2; ++n) { const f32x4 zz_ = {0.f, 0.f, 0.f, 0.f}; \
        if constexpr (FP8) acc[ai][bj][m][n] = __builtin_amdgcn_mfma_scale_f32_16x16x128_f8f6f4(PG8_CAT(Bt[n]), PG8_CAT(At[m]), zz_, 0, 0, 0, 0, 0, 0); \
        else { acc[ai][bj][m][n] = __builtin_amdgcn_mfma_f32_16x16x32_bf16(Bt[n][0], At[m][0], zz_, 0, 0, 0); acc[ai][bj][m][n] = __builtin_amdgcn_mfma_f32_16x16x32_bf16(Bt[n][1], At[m][1], acc[ai][bj][m][n], 0, 0, 0); } } __builtin_amdgcn_s_setprio(0); } while (0)
#define PG8_WAIT_V(n) asm volatile("s_waitcnt vmcnt(" #n ")" ::: "memory")
#define PG8_WAIT_L(n) asm volatile("s_waitcnt lgkmcnt(" #n ")" ::: "memory")
#define PG8_BAR __builtin_amdgcn_s_barrier()
#define PG8_SCHED __builtin_amdgcn_sched_barrier(0)
    Unit cur, nxt; int ui = 0;
    if (!S.next(0, cur)) return;
    f32x4 acc[2][2][4][2];
#define PG8_ZACC do { if constexpr (GATHER) { float z0_ = 0.f; asm volatile("" : "+v"(z0_)); _Pragma("unroll") for (int a = 0; a < 2; ++a) _Pragma("unroll") for (int b = 0; b < 2; ++b) _Pragma("unroll") for (int m = 0; m < 4; ++m) _Pragma("unroll") for (int n = 0; n < 2; ++n) acc[a][b][m][n] = (f32x4){z0_, z0_, z0_, z0_}; } } while (0)
    PG8_ZACC;
    bf16x8 At[4][2], B0[2][2], B1[2][2];
    unsigned cA, cB = (unsigned)cur.e * (unsigned)g.bstride + (unsigned)cur.pn * tstep;
    unsigned voffA[2]; voffA[0] = (unsigned)(R0 * KB + C2); voffA[1] = voffA[0] + 64u * (unsigned)KB;
    if constexpr (GATHER) { cA = 0u;
        if (wid < 4) __builtin_amdgcn_raw_ptr_buffer_load_lds(rsT, (LAS void*)(tokb + wid * 64), 4, (wid * 64 + lane) * 4, cur.pm * (BM * 4), 0, 0);
        asm volatile("s_waitcnt vmcnt(0)" ::: "memory"); __builtin_amdgcn_s_barrier();
    } else cA = (unsigned)cur.pm * tstep;
    const unsigned hA = GATHER ? 0u : hstep;
    LAS float* sideb = (LAS float*)(lds + LDS_SIDE);
#define PG8_SIDE(un, sel) do { if constexpr (Epi::NSIDE > 0) { if (wid < Epi::NSIDE) { const char* sp_ = (const char*)E.side(un, wid); int ln_ = (int)__builtin_amdgcn_mbcnt_hi(~0u, __builtin_amdgcn_mbcnt_lo(~0u, 0u)); asm volatile("" : "+v"(ln_)); \
        __builtin_amdgcn_global_load_lds((const unsigned*)(sp_ + ln_ * 16), (LAS unsigned*)(sideb + (sel) * 512 + wid * 256), 16, 0, 0); } } } while (0)
    PG8_SIDE(cur, 0);
#define PG8_OA(dst, sel, h) unsigned dst[2]; if constexpr (GATHER) { int ix_ = (sel) * 256 + (h) * HALF + R0; asm volatile("" : "+v"(ix_)); dst[0] = (unsigned)(tokb[ix_] * KB + C2); dst[1] = (unsigned)(tokb[ix_ + 64] * KB + C2); } else { dst[0] = voffA[0]; dst[1] = voffA[1]; }
    { PG8_OA(p0_, 0, 0); PG8_OA(p1_, 0, 1); PG8_STAGE(PG8_SB(0, 0), rsB, cB, voffB); PG8_STAGE(PG8_SB(0, 1), rsB, cB + hstep, voffB); PG8_STAGE(PG8_SA(0, 0), rsA, cA, p0_); PG8_STAGE(PG8_SA(0, 1), rsA, cA + hA, p1_); }
    if (wr == 1) PG8_BAR;
    PG8_WAIT_V(2); PG8_BAR;
    { PG8_OA(p0_, 0, 0); PG8_STAGE(PG8_SB(1, 0), rsB, cB + kstep, voffB); PG8_STAGE(PG8_SA(1, 0), rsA, cA + kstep, p0_); PG8_STAGE(PG8_SB(1, 1), rsB, cB + hstep + kstep, voffB); }
    PG8_WAIT_V(6); PG8_BAR;
    for (;;) {
        const bool has_next = S.next(ui + 1, nxt);
        unsigned nA = cA, nB = cB;
        if (has_next) { nB = (unsigned)nxt.e * (unsigned)g.bstride + (unsigned)nxt.pn * tstep;
            if constexpr (GATHER) { if (wid < 4) { int ln_; asm volatile("v_mbcnt_lo_u32_b32 %0, -1, 0\n\tv_mbcnt_hi_u32_b32 %0, -1, %0" : "=v"(ln_)); __builtin_amdgcn_raw_ptr_buffer_load_lds(rsT, (LAS void*)(tokb + ((ui + 1) & 1) * 256 + wid * 64), 4, (wid * 64 + ln_) * 4, nxt.pm * (BM * 4), 0, 0); } }
            else nA = (unsigned)nxt.pm * tstep;
            PG8_SIDE(nxt, (ui + 1) % 3); }
#pragma unroll 1
        for (int t = 0; t < nt; t += 2) {
            const bool last = (t == nt - 2);
            const unsigned a1 = cA + (unsigned)(t + 1) * kstep;
            const unsigned a2 = last ? nA : cA + (unsigned)(t + 2) * kstep, b2 = last ? nB : cB + (unsigned)(t + 2) * kstep;
            const unsigned a3 = a2 + kstep, b3 = b2 + kstep;
            const int selc = ui & 1, seln = (last && has_next) ? ((ui + 1) & 1) : selc;
            PG8_LDB(B0, 0, 0); PG8_LDB(B1, 0, 1); PG8_SCHED; PG8_LDA(At, 0, 0); { PG8_OA(q_, selc, 1); PG8_STAGE(PG8_SA(1, 1), rsA, a1 + hA, q_); }
            PG8_WAIT_V(8); PG8_WAIT_L(0); PG8_BAR; if (!GATHER && t == 0) { PG8_MMA0(0, 0, At, B0); PG8_MMA0(0, 1, At, B1); } else { PG8_MMA(0, 0, At, B0); PG8_MMA(0, 1, At, B1); } PG8_BAR; PG8_SCHED;
            PG8_LDA(At, 0, 1); PG8_STAGE(PG8_SB(0, 0), rsB, b2, voffB); PG8_STAGE(PG8_SB(0, 1), rsB, b2 + hstep, voffB); { PG8_OA(q_, seln, 0); PG8_STAGE(PG8_SA(0, 0), rsA, a2, q_); }
            PG8_WAIT_V(8); PG8_WAIT_L(0); PG8_BAR; if (!GATHER && t == 0) { PG8_MMA0(1, 0, At, B0); PG8_MMA0(1, 1, At, B1); } else { PG8_MMA(1, 0, At, B0); PG8_MMA(1, 1, At, B1); } PG8_BAR; PG8_SCHED;
            PG8_LDB(B0, 1, 0); PG8_LDB(B1, 1, 1); PG8_SCHED; PG8_LDA(At, 1, 0); { PG8_OA(q_, seln, 1); PG8_STAGE(PG8_SA(0, 1), rsA, a2 + hA, q_); }
            PG8_WAIT_V(8); PG8_WAIT_L(0); PG8_BAR; PG8_MMA(0, 0, At, B0); PG8_MMA(0, 1, At, B1); PG8_BAR; PG8_SCHED;
            PG8_LDA(At, 1, 1); PG8_STAGE(PG8_SB(1, 0), rsB, b3, voffB); PG8_STAGE(PG8_SB(1, 1), rsB, b3 + hstep, voffB); { PG8_OA(q_, seln, 0); PG8_STAGE(PG8_SA(1, 0), rsA, a3, q_); }
            PG8_WAIT_V(8); PG8_WAIT_L(0); PG8_BAR; PG8_MMA(1, 0, At, B0); PG8_MMA(1, 1, At, B1); PG8_BAR; PG8_SCHED;
        }
        if constexpr (ALIGN) { if (wr == 0) PG8_BAR; }
        E(acc, cur, wr, wc, fr, fq, sideb + (ui % 3) * 512);
        if constexpr (DUPK == 5) { asm volatile("" ::: "memory"); E(acc, cur, wr, wc, fr, fq, sideb + (ui % 3) * 512); }
        if (!has_next) break;
        PG8_ZACC;
        cur = nxt; cA = nA; cB = nB; ++ui;
        if constexpr (ALIGN) { if (wr == 1) PG8_BAR; }
    }
    PG8_WAIT_V(0);
    if constexpr (!ALIGN) { if (wr == 0) PG8_BAR; }
    PG8_BAR;
#undef PG8_SA
#undef PG8_SB
#undef PG8_STAGE
#undef PG8_SIDE
#undef PG8_OA
#undef PG8_LDA
#undef PG8_LDB
#undef PG8_MMA
#undef PG8_MMA0
#undef PG8_CAT
#undef PG8_WAIT_V
#undef PG8_WAIT_L
#undef PG8_BAR
#undef PG8_SCHED
}

typedef GAS unsigned gu32;
#define XB_TMO      128
#define XB_XCNT(j)  (256  + 64 * (j))
#define XB_XSUB(j)  (1280 + 64 * (j))
#define XB_XGEN(j)  (2304 + 64 * (j))
#define XB_TOP      3328
#define XB_TOPGEN   3392
#define XCD_BAR_WORDS 3456
#define XB_SPIN_CAP (1u << 20)
#ifndef XB_DIRECT
#define XB_DIRECT 1
#endif
DEV unsigned xb_ld(unsigned* p) { return __hip_atomic_load(p, __ATOMIC_RELAXED, __HIP_MEMORY_SCOPE_AGENT); }
DEV unsigned xb_add(unsigned* p, unsigned v) { return __hip_atomic_fetch_add(p, v, __ATOMIC_RELAXED, __HIP_MEMORY_SCOPE_AGENT); }
DEV unsigned xb_xcc_id() { return (unsigned)__builtin_amdgcn_s_getreg((3 << 11) | 20) & 0xFu; }
#define XB_SPIN(cond, bar) do { unsigned _sp = 0; while (cond) {            \
    if ((++_sp & 255u) == 0u) { if (xb_ld(&(bar)[XB_TMO])) break; if (_sp > XB_SPIN_CAP) { atomicAdd(&(bar)[XB_TMO], 1u); break; } } } } while (0)
struct XcdBarrier { unsigned* bar; unsigned x; volatile LAS unsigned* st; int wave; };
DEV bool xb_thread0(int wave) { return wave == 0 && __builtin_amdgcn_mbcnt_hi(~0u, __builtin_amdgcn_mbcnt_lo(~0u, 0u)) == 0u; }
DEV XcdBarrier xcd_barrier_post(unsigned* bar, volatile LAS unsigned* st, int wave) {
    XcdBarrier b; b.bar = bar; b.x = xb_xcc_id(); b.st = st; b.wave = wave;
    if (xb_thread0(wave)) (void)xb_add(&bar[XB_XCNT(b.x)], 1u);
    return b;
}
DEV void xcd_barrier_complete(unsigned* bar, unsigned x, unsigned& nloc, unsigned& nx) {
    const unsigned G = gridDim.x * gridDim.y * gridDim.z;
    unsigned sum, cnt, mine, sp = 0u;
    for (;;) {
        sum = 0u; cnt = 0u; mine = 0u;
#pragma unroll
        for (unsigned j = 0; j < 16; ++j) { const unsigned c = xb_ld(&bar[XB_XCNT(j)]); sum += c; cnt += (c > 0u) ? 1u : 0u; mine = (j == x) ? c : mine; }
        if (sum == G) break;
        __builtin_amdgcn_s_sleep(1);
        if ((++sp & 255u) == 0u) { if (xb_ld(&bar[XB_TMO])) break; if (sp > XB_SPIN_CAP) { atomicAdd(&bar[XB_TMO], 1u); break; } }
    }
    nloc = mine > 0u ? mine : 1u; nx = cnt > 0u ? cnt : 1u;
}
DEV void xcd_barrier(const XcdBarrier& b) {
    asm volatile("s_waitcnt vmcnt(0)" ::: "memory");
    __syncthreads();
    if (xb_thread0(b.wave)) {
        unsigned* bar = b.bar;
        __builtin_amdgcn_s_waitcnt(0);
        unsigned nloc = b.st[0], nx = b.st[1];
        if (nloc == 0u) { xcd_barrier_complete(bar, b.x, nloc, nx); b.st[0] = nloc; b.st[1] = nx; }
        const unsigned old = xb_add(&bar[XB_XSUB(b.x)], 1u);
        const unsigned gen = old / nloc;
        if (old + 1u == (gen + 1u) * nloc) {
            __builtin_amdgcn_fence(__ATOMIC_RELEASE, "agent");
            asm volatile("s_waitcnt vmcnt(0)" ::: "memory");
            const unsigned og = xb_add(&bar[XB_TOP], 1u);
            const unsigned tg = og / nx;
            if (og + 1u == (tg + 1u) * nx) xb_add(&bar[XB_TOPGEN], 1u);
            else XB_SPIN(xb_ld(&bar[XB_TOPGEN]) == tg, bar);
            __builtin_amdgcn_fence(__ATOMIC_ACQUIRE, "agent");
#if !XB_DIRECT
            xb_add(&bar[XB_XGEN(b.x)], 1u);
#endif
            asm volatile("s_waitcnt vmcnt(0)" ::: "memory");
        } else {
#if XB_DIRECT
            XB_SPIN(xb_ld(&bar[XB_TOPGEN]) == gen, bar);
#else
            XB_SPIN(xb_ld(&bar[XB_XGEN(b.x)]) == gen, bar);
#endif
            __builtin_amdgcn_fence(__ATOMIC_ACQUIRE, "agent");
            asm volatile("s_waitcnt vmcnt(0)" ::: "memory");
        }
    }
    __syncthreads();
}
constexpr size_t MiB = 1u << 20;
constexpr int PMAX = 131072 + 32 * 256;
#ifndef IN1_FP8
#define IN1_FP8 1
#endif
constexpr float WIN1_SCALE = 64.f;
#ifndef GU_GATHER
#define GU_GATHER 1
#endif
constexpr size_t W_CTL = 0, CTL_ZERO_BYTES = 64 * 1024;
constexpr size_t W_IN0 = 2 * MiB, W_GLU = 6 * MiB, W_OUT0 = 7 * MiB, W_IN1 = 9 * MiB, W_OUT1 = 16 * MiB;
constexpr size_t W_LUT = 18 * MiB, W_KM = W_LUT + 64 * 1024, W_HIST = W_KM + 256 * 1024, W_SORT = W_HIST + 64 * 1024  , W_BGU2 = 19 * MiB  , W_GR = 20 * MiB  , W_SS = 22 * MiB  ;
constexpr size_t W_GU = 32 * MiB, W_DN = 288 * MiB, W_XB = 416 * MiB  , W_XBB = 480 * MiB  , W_X8 = 1024 * MiB  , W_HB = 736 * MiB, W_YS5 = 928 * MiB, W_Y0 = 960 * MiB, W_MIXB = 1024 * MiB, W_GLAO = 1088 * MiB;
constexpr size_t W_ROUTE = 26 * MiB  , W_X8T = 1088 * MiB  , W_ACT = 736 * MiB  , W_YS = 1160 * MiB, W_END = 1432 * MiB;
static_assert(W_ACT + (size_t)PMAX * 2048 <= W_MIXB && W_YS + (size_t)PMAX * 2048 <= W_END && W_X8 + (size_t)PMAX * 1024 <= W_YS && W_ROUTE + 4 * MiB <= W_GU, "ws map");
constexpr int CW_BAR = 4096;

struct Args { const float* in[29]; float* out; unsigned char* ws; int ph_lo, ph_hi; };
struct Frame {
    LAS unsigned char* lds; int tid, lane, wave, vcu, G;
    const float* const* in; unsigned char* ws;
};
#define WSP(T_, off) ((T_*)(F.ws + (off)))

DEV unsigned pk4_fp8(float a, float b, float c, float d) { unsigned w = 0u; w = __builtin_amdgcn_cvt_pk_fp8_f32(a, b, w, false); w = __builtin_amdgcn_cvt_pk_fp8_f32(c, d, w, true); return w; }
struct CvItem { const float* src; unsigned char* dst; int pitch, K; float sc; };
constexpr int P0_I_GU = 8 * 8, P0_I_DN = 8 * 4, P0_I_IN0 = 8 * 8, P0_I_GLU = 4 * 2, P0_I_O = 8 * 4, P0_I_IN1 = 8 * 12;
constexpr int P0_N_GU = 64 * P0_I_GU, P0_N_DN = 64 * P0_I_DN, P0_NITEMS = P0_N_GU + P0_N_DN + P0_I_IN0 + P0_I_GLU + 2 * P0_I_O + P0_I_IN1;
DEV CvItem cv_decode(Frame& F, int it) {
    int r = it; const float* W; unsigned char* D; int K, N, NP, es; float sc = 0.f;
    if (r < P0_N_GU) { const int m = r / P0_I_GU; r %= P0_I_GU; W = F.in[25] + (size_t)m * 1024 * 2048; D = WSP(unsigned char, W_GU) + (size_t)m * 2048 * 1024; K = 1024; N = 2048; NP = 2048; es = 1; sc = 64.f; }
    else if ((r -= P0_N_GU) < P0_N_DN) { const int m = r / P0_I_DN; r %= P0_I_DN; W = F.in[27] + (size_t)m * 1024 * 1024; D = WSP(unsigned char, W_DN) + (size_t)m * 1024 * 1024; K = 1024; N = 1024; NP = 1024; es = 1; sc = 128.f; }
    else if ((r -= P0_N_DN) < P0_I_IN0) { W = F.in[1]; D = WSP(unsigned char, W_IN0); K = 1024; N = 2048; NP = 2048; es = 2; }
    else if ((r -= P0_I_IN0) < P0_I_GLU) { W = F.in[10]; D = WSP(unsigned char, W_GLU); K = 512; N = 512; NP = 512; es = 2; }
    else if ((r -= P0_I_GLU) < P0_I_O) { W = F.in[13]; D = WSP(unsigned char, W_OUT0); K = 1024; N = 1024; NP = 1024; es = 2; }
    else if ((r -= P0_I_O) < P0_I_O) { W = F.in[18]; D = WSP(unsigned char, W_OUT1); K = 1024; N = 1024; NP = 1024; es = 2; }
    else { r -= P0_I_O; W = F.in[14]; D = WSP(unsigned char, W_IN1); K = 1024; N = 3072; NP = 3088; es = IN1_FP8 ? 1 : 2; sc = IN1_FP8 ? WIN1_SCALE : 0.f; }
    const int nblk = N / 256, kb = r / nblk, nb = r % nblk;
    CvItem c; c.src = W + (size_t)(128 * kb) * NP + 256 * nb; c.dst = D + ((size_t)(256 * nb) * K + 128 * kb) * es; c.pitch = NP; c.K = K; c.sc = sc; return c;
}
DEV void cv_load(const CvItem& c, f32x4 (&v)[16], int tid) {
#pragma unroll
    for (int i = 0; i < 16; ++i) v[i] = *(const f32x4*)(c.src + (size_t)(8 * i + (tid >> 6)) * c.pitch + 4 * (tid & 63));
}
DEV void cv_store(const CvItem& c, const f32x4 (&v)[16], LAS float* T_, int tid) {
#pragma unroll
    for (int i = 0; i < 16; ++i) *(LAS f32x4*)(T_ + (8 * i + (tid >> 6)) * 260 + 4 * (tid & 63)) = v[i];
    __syncthreads();
    const int n = tid & 255, kh = tid >> 8; const LAS float* s = T_ + (64 * kh) * 260 + n;
    if (c.sc > 0.f) { const float q = c.sc; unsigned char* d = c.dst + (size_t)n * c.K + 64 * kh;
#pragma unroll
        for (int g = 0; g < 4; ++g) { u32x4 o;
            o.x = pk4_fp8(s[(16 * g + 0) * 260] * q, s[(16 * g + 1) * 260] * q, s[(16 * g + 2) * 260] * q, s[(16 * g + 3) * 260] * q); o.y = pk4_fp8(s[(16 * g + 4) * 260] * q, s[(16 * g + 5) * 260] * q, s[(16 * g + 6) * 260] * q, s[(16 * g + 7) * 260] * q);
            o.z = pk4_fp8(s[(16 * g + 8) * 260] * q, s[(16 * g + 9) * 260] * q, s[(16 * g + 10) * 260] * q, s[(16 * g + 11) * 260] * q); o.w = pk4_fp8(s[(16 * g + 12) * 260] * q, s[(16 * g + 13) * 260] * q, s[(16 * g + 14) * 260] * q, s[(16 * g + 15) * 260] * q);
            st_wt(d + 16 * g, o); }
    } else { unsigned char* d = c.dst + ((size_t)n * c.K + 64 * kh) * 2;
#pragma unroll
        for (int g = 0; g < 8; ++g) { u32x4 o; o.x = cvt_pk(s[(8 * g + 0) * 260], s[(8 * g + 1) * 260]); o.y = cvt_pk(s[(8 * g + 2) * 260], s[(8 * g + 3) * 260]); o.z = cvt_pk(s[(8 * g + 4) * 260], s[(8 * g + 5) * 260]); o.w = cvt_pk(s[(8 * g + 6) * 260], s[(8 * g + 7) * 260]);
            st_wt(d + 16 * g, o); }
    }
    __syncthreads();
}
__constant__ int BUCKET_TH2[16] = {16, 22, 30, 40, 54, 73, 99, 134, 182, 246, 332, 450, 609, 825, 1117, 1513};
#ifndef CV_NB
#define CV_NB 704
#endif
constexpr int P0_NA = P0_NITEMS - CV_NB, P0_B0 = P0_N_GU - CV_NB;
DEV int cv_item_a(int p) { return p < P0_B0 ? p : p + CV_NB; }
DEV int cv_item_b(int q) { return P0_B0 + q; }
template <bool LISTB> DEV void cv_run(Frame& F, int first, int end, int stride) {
    LAS float* T_ = (LAS float*)F.lds; f32x4 va[16], vb[16];
    int it = first;
    if (it < end) { CvItem ca = cv_decode(F, LISTB ? cv_item_b(it) : cv_item_a(it)); cv_load(ca, va, F.tid);
#pragma unroll 1
        for (;;) {
            const int it2 = it + stride; CvItem cb = ca; const bool h2 = it2 < end; if (h2) { cb = cv_decode(F, LISTB ? cv_item_b(it2) : cv_item_a(it2)); cv_load(cb, vb, F.tid); }
            cv_store(ca, va, T_, F.tid);
            if (!h2) break;
            const int it3 = it2 + stride; const bool h3 = it3 < end; if (h3) { ca = cv_decode(F, LISTB ? cv_item_b(it3) : cv_item_a(it3)); cv_load(ca, va, F.tid); }
            cv_store(cb, vb, T_, F.tid);
            if (!h3) break;
            it = it3;
        } }
}
constexpr int CW_CVQ = 192;
constexpr int LDS_CVQ = 142000;
DEV void cv_pull(Frame& F, int batch, int rounds) {
    volatile LAS int* qw = (volatile LAS int*)(F.lds + LDS_CVQ); unsigned* ctl = (unsigned*)(F.ws + W_CTL);
    for (int r = 0; rounds < 0 || r < rounds; ++r) {
        __syncthreads();
        if (F.tid == 0) qw[0] = (int)__hip_atomic_fetch_add(ctl + CW_CVQ, (unsigned)batch, __ATOMIC_RELAXED, __HIP_MEMORY_SCOPE_AGENT);
        __syncthreads();
        const int base = __builtin_amdgcn_readfirstlane(qw[0]);
        if (base >= CV_NB) break;
        cv_run<true>(F, base, (base + batch < CV_NB) ? base + batch : CV_NB, 1);
    }
    __syncthreads();
}
DEV int spare_wgs(int nwg, int G) { const int most = (nwg + G - 1) / G; const int need = (nwg + most - 1) / most; return G - need; }
DEV void p0_prologue(Frame& F) {
    cv_run<false>(F, F.vcu, P0_NA, F.G);
    const int gt = F.vcu * 512 + F.tid, NGT = F.G * 512;
    for (int i = gt; i < 16 * 1024; i += NGT) { const int n = i >> 10, k = i & 1023; WSP(bf16_t, W_IN1)[(size_t)(3072 + n) * 1024 + k] = (bf16_t)(cvt_pk(F.in[14][(size_t)k * 3088 + 3072 + n], 0.f) & 0xffffu); }
    { const f32x4* x4 = (const f32x4*)F.in[0]; u32x2* o = WSP(u32x2, W_XB);
      for (size_t i = gt; i < (size_t)T * 1024 / 4; i += (size_t)NGT * 8) { f32x4 v[8];
#pragma unroll
          for (int u = 0; u < 8; ++u) v[u] = x4[i + (size_t)u * NGT];
#pragma unroll
          for (int u = 0; u < 8; ++u) { u32x2 w; w.x = cvt_pk(v[u].x, v[u].y); w.y = cvt_pk(v[u].z, v[u].w); st_wt(o + i + (size_t)u * NGT, w); } } }
    for (int i = gt; i < 2 * 32 * 2048 / 4; i += NGT) { const f32x4 v = ((const f32x4*)F.in[26])[i]; WSP(f32x4, W_BGU2)[i] = (f32x4){v.x, v.z, 4.f * (v.y + 1.f), 4.f * (v.w + 1.f)}; }
    for (int i = gt; i < 1024 * 64 / 4; i += NGT) WSP(f32x4, W_KM)[i] = (f32x4){0.f, 0.f, 0.f, 0.f};
    for (int i = gt; i < 8 * 2048; i += NGT) { const int h = i >> 11, n = i & 2047; int bk = n;
        if (n >= 16) { bk = 16;
#pragma unroll
            for (int q = 1; q < 16; ++q) bk += (n >= BUCKET_TH2[q]) ? 1 : 0; }
        WSP(float, W_LUT)[i] = F.in[12][bk * 8 + h] * 1.4426950408889634f; }
}

DEV void p_kmean(Frame& F) {
    const int gw = F.vcu * 8 + F.wave, NGW = F.G * 8; const bf16_t* H0 = WSP(bf16_t, W_HB); float* KM = WSP(float, W_KM);
    for (int it = gw; it < 1024; it += NGW) { const int blk = it & 7, h = (it >> 3) & 7, b = it >> 6; const int r8 = F.lane >> 3, c = F.lane & 7;
        const bf16_t* p = H0 + (size_t)(b * 2048 + blk * 256 + r8) * 2048 + 1024 + h * 64 + c * 8; float s[8];
#pragma unroll
        for (int j = 0; j < 8; ++j) s[j] = 0.f;
#pragma unroll 8
        for (int i = 0; i < 32; ++i) { const u32x4 v = *(const u32x4*)(p + (size_t)i * 8 * 2048);
            s[0] += bflo(v.x); s[1] += bfhi(v.x); s[2] += bflo(v.y); s[3] += bfhi(v.y); s[4] += bflo(v.z); s[5] += bfhi(v.z); s[6] += bflo(v.w); s[7] += bfhi(v.w); }
#pragma unroll
        for (int j = 0; j < 8; ++j) { s[j] += __shfl_xor(s[j], 8); s[j] += __shfl_xor(s[j], 16); s[j] += __shfl_xor(s[j], 32); }
        if (F.lane < 8) {
#pragma unroll
            for (int j = 0; j < 8; ++j) KM[(size_t)it * 64 + c * 8 + j] = s[j] * (1.f / 256.f); } }
}

DEV void s5_item(Frame& F, int b, int g, LAS unsigned char* sl  ) {
    const int lane = F.lane, p0 = lane & 31, hi = lane >> 5, q4 = lane >> 4;
    const float* lam_re = F.in[2]; const float* lam_im = F.in[3]; const float* log_dt = F.in[4]; const float* b_re = F.in[5]; const float* b_im = F.in[6];
    const float* c_re = F.in[7]; const float* c_im = F.in[8]; const float* dsk = F.in[9];
    const bf16_t* H0 = WSP(bf16_t, W_HB); bf16_t* YS = WSP(bf16_t, W_YS5);
    const float dt = __expf(log_dt[g]);
    float ar[2], ai[2]; bf16x8 bfr[4];
#pragma unroll
    for (int s = 0; s < 2; ++s) { const int p = p0 + 32 * s; const float lr = lam_re[g * 64 + p], li = lam_im[g * 64 + p]; const float mag = __expf(lr * dt);
        ar[s] = mag * cosf(li * dt); ai[s] = mag * sinf(li * dt);
        const float er = ar[s] - 1.f, ei = ai[s], den = lr * lr + li * li; const float qr = (er * lr + ei * li) / den, qi = (ei * lr - er * li) / den;
        u32x4 wr_, wi_; float vr[8], vi[8];
#pragma unroll
        for (int j = 0; j < 8; ++j) { const float br = b_re[(g * 64 + p) * 16 + 8 * hi + j], bi = b_im[(g * 64 + p) * 16 + 8 * hi + j]; vr[j] = qr * br - qi * bi; vi[j] = qr * bi + qi * br; }
        wr_.x = cvt_pk(vr[0], vr[1]); wr_.y = cvt_pk(vr[2], vr[3]); wr_.z = cvt_pk(vr[4], vr[5]); wr_.w = cvt_pk(vr[6], vr[7]);
        wi_.x = cvt_pk(vi[0], vi[1]); wi_.y = cvt_pk(vi[2], vi[3]); wi_.z = cvt_pk(vi[4], vi[5]); wi_.w = cvt_pk(vi[6], vi[7]);
        bfr[2 * s] = __builtin_bit_cast(bf16x8, wr_); bfr[2 * s + 1] = __builtin_bit_cast(bf16x8, wi_); }
    bf16x8 cfr[4];
#pragma unroll
    for (int ks = 0; ks < 4; ++ks) { float v[8];
#pragma unroll
        for (int j = 0; j < 8; ++j) { const int c = 32 * ks + 8 * q4 + j, p = c >> 1; const int h = lane & 15; v[j] = (c & 1) ? -c_im[(g * 16 + h) * 64 + p] : c_re[(g * 16 + h) * 64 + p]; }
        u32x4 w; w.x = cvt_pk(v[0], v[1]); w.y = cvt_pk(v[2], v[3]); w.z = cvt_pk(v[4], v[5]); w.w = cvt_pk(v[6], v[7]); cfr[ks] = __builtin_bit_cast(bf16x8, w); }
    float dv[4];
#pragma unroll
    for (int r = 0; r < 4; ++r) dv[r] = dsk[g * 16 + 4 * q4 + r];
    const int tm = 16 * ((p0 >> 2) & 1) + 4 * (p0 >> 3) + (p0 & 3);
    const bf16_t* urow = H0 + (size_t)(b * 2048 + tm) * 2048 + g * 16 + 8 * hi;
    float cr[2] = {0.f, 0.f}, ci[2] = {0.f, 0.f};
    bf16x8 ufr = *(const bf16x8*)urow;
    for (int tile = 0; tile < 64; ++tile) {
        const bf16x8 ucur = ufr;
        if (tile + 1 < 64) ufr = *(const bf16x8*)(urow + (size_t)(tile + 1) * 32 * 2048);
        f32x16 x[4];
#pragma unroll
        for (int n = 0; n < 4; ++n) { f32x16 z;
#pragma unroll
            for (int r = 0; r < 16; ++r) z[r] = 0.f;
            x[n] = __builtin_amdgcn_mfma_f32_32x32x16_bf16(ucur, bfr[n], z, 0, 0, 0); }
#pragma unroll
        for (int s = 0; s < 2; ++s) {
            f32x16& xr = x[2 * s]; f32x16& xi = x[2 * s + 1];
            float sr = hi ? 0.f : cr[s], si = hi ? 0.f : ci[s];
#pragma unroll
            for (int r = 0; r < 16; ++r) { const float nr = ar[s] * sr - ai[s] * si + xr[r], ni = ar[s] * si + ai[s] * sr + xi[r]; xr[r] = nr; xi[r] = ni; sr = nr; si = ni; }
            const float o_r = swap32(sr), o_i = swap32(si);
            float wr_ = hi ? o_r : 0.f, wi_ = hi ? o_i : 0.f;
#pragma unroll
            for (int r = 0; r < 16; ++r) { const float nr = ar[s] * wr_ - ai[s] * wi_, ni = ar[s] * wi_ + ai[s] * wr_; wr_ = nr; wi_ = ni; xr[r] += wr_; xi[r] += wi_; }
            const float e_r = swap32(xr[15]), e_i = swap32(xi[15]);
            cr[s] = hi ? xr[15] : e_r; ci[s] = hi ? xi[15] : e_i;
#pragma unroll
            for (int r = 0; r < 16; ++r) *(LAS unsigned*)(sl + (16 * hi + r) * 256 + (p0 + 32 * s) * 4) = cvt_pk(xr[r], xi[r]);
        }
#pragma unroll
        for (int tt = 0; tt < 2; ++tt) {
            f32x4 y = {0.f, 0.f, 0.f, 0.f};
#pragma unroll
            for (int ks = 0; ks < 4; ++ks) { const bf16x8 sf = *(const LAS bf16x8*)(sl + (16 * tt + (lane & 15)) * 256 + ks * 64 + q4 * 16); y = __builtin_amdgcn_mfma_f32_16x16x32_bf16(cfr[ks], sf, y, 0, 0, 0); }
            const int t = tile * 32 + 16 * tt + (lane & 15);
            const u32x2 uw = *(const u32x2*)(H0 + (size_t)(b * 2048 + t) * 2048 + g * 16 + 4 * q4);
            const float y0 = gelu_tanh(y[0] + dv[0] * bflo(uw.x)), y1 = gelu_tanh(y[1] + dv[1] * bfhi(uw.x)), y2 = gelu_tanh(y[2] + dv[2] * bflo(uw.y)), y3 = gelu_tanh(y[3] + dv[3] * bfhi(uw.y));
            u32x2 ow; ow.x = cvt_pk(y0, y1); ow.y = cvt_pk(y2, y3);
            *(u32x2*)(YS + (size_t)(b * 2048 + t) * 512 + g * 16 + 4 * q4) = ow;
        }
    }
}

constexpr int AT_K = 0, AT_V = 24576, AT_WS = 49152, AT_OST = 51200, AT_LUT = AT_OST + 8 * 4096  , AT_LUTB = 8704, AT_Q = AT_LUT + 8 * AT_LUTB  , AT_END = AT_Q + 64;
DEV int crow(int r, int hi) { return (r & 3) + 8 * (r >> 2) + 4 * hi; }
DEV s16x4 vtr(const LAS unsigned char* p) { typedef short v4i16_t __attribute__((ext_vector_type(4))); return __builtin_bit_cast(s16x4, __builtin_amdgcn_ds_read_tr16_b64_v4i16((LAS v4i16_t*)p)); }
DEV void moba_unit(Frame& F, int b, int h, int own) {
    const int lane = F.lane, wid = F.wave, r32 = lane & 31, hi = lane >> 5;
    LAS unsigned char* lds = F.lds;
    const bf16_t* H0 = WSP(bf16_t, W_HB); const float* KM = WSP(float, W_KM);
    LAS float* lut = (LAS float*)(lds + AT_LUT + h * AT_LUTB); LAS float* wsf = (LAS float*)(lds + AT_WS) + wid * 64;
    const size_t rowbase = (size_t)b * 2048;
    const int qpos = own * 256 + wid * 32 + r32;
    bf16x8 qr[4];
#pragma unroll
    for (int d0 = 0; d0 < 4; ++d0) qr[d0] = *(const bf16x8*)(H0 + (rowbase + qpos) * 2048 + 512 + h * 64 + d0 * 16 + hi * 8);
    unsigned selmask = 0u;
    if (own > 0) {
        float gate[7];
#pragma unroll
        for (int j = 0; j < 7; ++j) { float s = 0.f;
            if (j < own) { const float* km = KM + ((size_t)(b * 8 + h) * 8 + j) * 64 + hi * 8;
#pragma unroll
                for (int d0 = 0; d0 < 4; ++d0) { const f32x4 k0 = *(const f32x4*)(km + d0 * 16), k1 = *(const f32x4*)(km + d0 * 16 + 4); const u32x4 qw = __builtin_bit_cast(u32x4, qr[d0]);
                    s += bflo(qw.x) * k0.x + bfhi(qw.x) * k0.y + bflo(qw.y) * k0.z + bfhi(qw.y) * k0.w + bflo(qw.z) * k1.x + bfhi(qw.z) * k1.y + bflo(qw.w) * k1.z + bfhi(qw.w) * k1.w; } }
            gate[j] = s + swap32(s); }
#pragma unroll
        for (int j = 0; j < 7; ++j) { int rank = 0;
#pragma unroll
            for (int j2 = 0; j2 < 7; ++j2) if (j2 != j && j2 < own && (gate[j2] > gate[j] || (gate[j2] == gate[j] && j2 < j))) ++rank;
            if (j < own && rank < 3) selmask |= 1u << j; }
    }
    const int NT = 4 * (own + 1);
#define KV0(i) ((i) < 4 ? own * 256 + (i) * 64 : (((i) - 4) >> 2) * 256 + (((i) - 4) & 3) * 64)
    const bf16_t* kbase = H0 + (rowbase + lane) * 2048 + 1024 + h * 64 + wid * 8;
    const bf16_t* vbase = H0 + (rowbase + 16 * (wid & 3) + (lane >> 2)) * 2048 + 1536 + h * 64 + (wid >> 2) * 32 + (lane & 3) * 8;
#define LOADKV(i, bo_) do { const int kv0_ = KV0(i); \
        __builtin_amdgcn_global_load_lds((const unsigned*)(kbase + (size_t)kv0_ * 2048), (LAS unsigned*)(lds + AT_K + bo_ + wid * 1024), 16, 0, 0); \
        __builtin_amdgcn_global_load_lds((const unsigned*)(vbase + (size_t)kv0_ * 2048), (LAS unsigned*)(lds + AT_V + bo_ + wid * 1024), 16, 0, 0); } while (0)
    LOADKV(0, 0); LOADKV(1, 8192);
    int bo = 0, bo2 = 16384;
    float m_ref = 0.f, l_run = 0.f; f32x16 o[2];
#pragma unroll
    for (int r = 0; r < 16; ++r) { o[0][r] = 0.f; o[1][r] = 0.f; }
    const int Q0 = own * 256 + wid * 32;
#pragma unroll 1
    for (int i = 0; i < NT; ++i) {
        if (i + 1 < NT) asm volatile("s_waitcnt vmcnt(2) lgkmcnt(0)\n\ts_barrier" ::: "memory"); else asm volatile("s_waitcnt vmcnt(0) lgkmcnt(0)\n\ts_barrier" ::: "memory");
        if (i + 2 < NT) LOADKV(i + 2, bo2);
        const int kv0 = KV0(i);
        const bool ownblk = i < 4;
        if (!(ownblk && kv0 > Q0 + 31)) {
            const bool partial = ownblk && (kv0 + 63 > Q0);
            const bool rowsel = ownblk || ((selmask >> ((i - 4) >> 2)) & 1u);
            f32x16 p0, p1;
            { const LAS float* lp = lut + 128 + (qpos - kv0 - 4 * hi - 59);
              const float mr = rowsel ? m_ref : INFINITY;
#pragma unroll
              for (int r = 0; r < 16; ++r) { const int c = (r & 3) + 8 * (r >> 2); p0[r] = lp[59 - c] - mr; p1[r] = lp[59 - c - 32] - mr; } }
            { const LAS unsigned char* kb = lds + AT_K + bo + hi * 1024 + r32 * 16;
#pragma unroll
              for (int d0 = 0; d0 < 4; ++d0) { const bf16x8 k0 = *(const LAS bf16x8*)(kb + d0 * 2048), k1 = *(const LAS bf16x8*)(kb + d0 * 2048 + 512);
                  p0 = __builtin_amdgcn_mfma_f32_32x32x16_bf16(k0, qr[d0], p0, 0, 0, 0); p1 = __builtin_amdgcn_mfma_f32_32x32x16_bf16(k1, qr[d0], p1, 0, 0, 0); } }
            if (partial) { const int dbase = qpos - kv0 - 4 * hi;
#pragma unroll
                for (int r = 0; r < 16; ++r) { const int d0_ = dbase - ((r & 3) + 8 * (r >> 2)); p0[r] = d0_ >= 0 ? p0[r] : -INFINITY; p1[r] = d0_ >= 32 ? p1[r] : -INFINITY; } }
            float rmax = fmaxf(p0[0], p1[0]);
#pragma unroll
            for (int r = 1; r < 16; ++r) rmax = fmaxf(rmax, fmaxf(p0[r], p1[r]));
            rmax = fmaxf(rmax, swap32(rmax));
            if (i == 0 || __any(rmax > 8.f)) {
                const float dl = (i == 0) ? rmax : fmaxf(rmax, 0.f); m_ref += dl;
#pragma unroll
                for (int r = 0; r < 16; ++r) { p0[r] -= dl; p1[r] -= dl; }
                const float alpha = __builtin_amdgcn_exp2f(-dl); l_run *= alpha;
                if (hi == 0) wsf[r32] = alpha;
#pragma unroll
                for (int r = 0; r < 16; ++r) { const float f = wsf[crow(r, hi)]; o[0][r] *= f; o[1][r] *= f; }
            }
            float rs = 0.f;
#pragma unroll
            for (int r = 0; r < 16; ++r) { p0[r] = __builtin_amdgcn_exp2f(p0[r]); p1[r] = __builtin_amdgcn_exp2f(p1[r]); rs += p0[r] + p1[r]; }
            l_run += rs;
            u32x4 pw[4];
            pw[0] = (u32x4){cvt_pk(p0[0], p0[1]), cvt_pk(p0[2], p0[3]), cvt_pk(p0[4], p0[5]), cvt_pk(p0[6], p0[7])};
            pw[1] = (u32x4){cvt_pk(p0[8], p0[9]), cvt_pk(p0[10], p0[11]), cvt_pk(p0[12], p0[13]), cvt_pk(p0[14], p0[15])};
            pw[2] = (u32x4){cvt_pk(p1[0], p1[1]), cvt_pk(p1[2], p1[3]), cvt_pk(p1[4], p1[5]), cvt_pk(p1[6], p1[7])};
            pw[3] = (u32x4){cvt_pk(p1[8], p1[9]), cvt_pk(p1[10], p1[11]), cvt_pk(p1[12], p1[13]), cvt_pk(p1[14], p1[15])};
            { const LAS unsigned char* vp = lds + AT_V + bo + ((lane >> 4) & 1) * 32 + (lane & 3) * 8 + (4 * hi + ((lane & 15) >> 2)) * 64;
#pragma unroll
              for (int d0 = 0; d0 < 2; ++d0)
#pragma unroll
                  for (int ks = 0; ks < 4; ++ks) { const s16x4 lo = vtr(vp + d0 * 4096 + ks * 1024), hh = vtr(vp + d0 * 4096 + ks * 1024 + 512);
                      const bf16x8 vf = (bf16x8){lo[0], lo[1], lo[2], lo[3], hh[0], hh[1], hh[2], hh[3]};
                      o[d0] = __builtin_amdgcn_mfma_f32_32x32x16_bf16(__builtin_bit_cast(bf16x8, pw[ks]), vf, o[d0], 0, 0, 0); } }
        }
        bo = (bo == 16384) ? 0 : bo + 8192; bo2 = (bo2 == 16384) ? 0 : bo2 + 8192;
    }
    __syncthreads();
#undef KV0
#undef LOADKV
    l_run += swap32(l_run);
    if (hi == 0) wsf[32 + r32] = 1.f / l_run;
    bf16_t* Ow = WSP(bf16_t, W_Y0) + (rowbase + own * 256 + wid * 32) * 1024 + 512 + h * 64;
    LAS bf16_t* stg = (LAS bf16_t*)(lds + AT_OST) + wid * 2048;
#pragma unroll
    for (int r = 0; r < 16; ++r) { const int orow = crow(r, hi); const float rl = wsf[32 + orow];
        stg[orow * 64 + r32] = (bf16_t)(cvt_pk(o[0][r] * rl, 0.f) & 0xffffu); stg[orow * 64 + 32 + r32] = (bf16_t)(cvt_pk(o[1][r] * rl, 0.f) & 0xffffu); }
#pragma unroll
    for (int i = 0; i < 4; ++i) { const int row = i * 8 + (lane >> 3), ch = lane & 7; const u32x4 v = *(const LAS u32x4*)(stg + row * 64 + ch * 8); *(u32x4*)(Ow + (size_t)row * 1024 + ch * 8) = v; }
    __syncthreads();
}
constexpr int CW_MOBAQ = 64;
DEV void p_s5_moba(Frame& F, int mode) {
    if ((mode & 1) && (F.vcu & 3) == 3) { const int it = (F.vcu >> 2) * 8 + F.wave; if (it < 512) s5_item(F, it >> 5, it & 31, F.lds + 65536 + F.wave * 8192); }
    __syncthreads();
    if (!(mode & 2)) return;
    for (int i = F.tid; i < 8 * 2176; i += 512) { const int hh = i / 2176, j = i % 2176; ((LAS float*)(F.lds + AT_LUT))[i] = j < 128 ? 0.f : WSP(float, W_LUT)[hh * 2048 + j - 128]; }
    volatile LAS int* qw = (volatile LAS int*)(F.lds + AT_Q);
    unsigned* ctl = (unsigned*)(F.ws + W_CTL);
    __syncthreads();
    if (F.tid == 0) qw[0] = (int)__hip_atomic_fetch_add(ctl + CW_MOBAQ, 1u, __ATOMIC_RELAXED, __HIP_MEMORY_SCOPE_AGENT);
    __syncthreads();
    for (;;) {
        const int u = __builtin_amdgcn_readfirstlane(qw[0]);
        if (u >= 1024) break;
        unsigned nx_ = 0u; if (F.tid == 0) nx_ = __hip_atomic_fetch_add(ctl + CW_MOBAQ, 1u, __ATOMIC_RELAXED, __HIP_MEMORY_SCOPE_AGENT);
        const int own = 7 - (u >> 7), bh = u & 127;
        moba_unit(F, bh >> 3, bh & 7, own);
        __syncthreads();
        if (F.tid == 0) qw[0] = (int)nx_;
        __syncthreads();
    }
}
constexpr size_t R_RE = W_ROUTE, R_RW = W_ROUTE + 512 * 1024, R_POS = W_ROUTE + 1024 * 1024, R_TOK = W_ROUTE + 2 * MiB, R_WGT = W_ROUTE + 3 * MiB;
constexpr int WT_PITCH = 1028;
constexpr int RW_PITCH = 1032;
constexpr int LN_XT = 32 * RW_PITCH * 2;
constexpr int LN_LG = 147456;
constexpr int LN_HIST = LN_LG + 8 * 528;
static_assert(LN_XT + 8 * 8256 <= LDS_TOK && LN_HIST + 128 <= LDSCTL_OFF, "LN LDS map");
template <int MODE, bool ROUTER, bool XIN_F32, bool OUT_F32, bool GRP = false>
DEV void p_ln(Frame& F, const float* xin32, const bf16_t* xinb, bf16_t* xoutb, float* xout32, const float* gam, const float* bet, const float* wrt, const float* brt) {
    LAS bf16_t* whi = (LAS bf16_t*)F.lds; LAS bf16_t* xt = (LAS bf16_t*)(F.lds + LN_XT) + F.wave * 4128; LAS float* lgs = (LAS float*)(F.lds + LN_LG) + F.wave * 132; LAS int* hist = (LAS int*)(F.lds + LN_HIST);
    const int lane = F.lane, l15 = lane & 15, q4 = lane >> 4;
    if constexpr (ROUTER) {
        for (int i = F.tid; i < 1024 * 32; i += 512) { const int k = i >> 5, e = i & 31; whi[e * RW_PITCH + k] = (bf16_t)(cvt_pk(wrt[i], 0.f) & 0xffffu); }
        if (F.tid < 32) hist[F.tid] = 0;
        __syncthreads();
    }
    if constexpr (GRP) {
        const u32x4* src = (const u32x4*)(WSP(bf16_t, W_IN1) + (size_t)3072 * 1024);
        for (int i = F.tid; i < 16 * 128; i += 512) { const int e = i >> 7, c = i & 127; *(LAS u32x4*)(whi + e * RW_PITCH + c * 8) = src[i]; }
        __syncthreads();
    }
    const bf16_t* MIXB = WSP(bf16_t, W_MIXB); const unsigned char* YS8 = WSP(unsigned char, W_YS); const int* POS = WSP(int, R_POS);
    int* RE = WSP(int, R_RE); float* RW = WSP(float, R_RW);
    const float alpha = 1.4142135623730951f;
    f32x4 gq[4], bq[4];
#pragma unroll
    for (int j = 0; j < 4; ++j) { gq[j] = *(const f32x4*)(gam + j * 256 + lane * 4); bq[j] = *(const f32x4*)(bet + j * 256 + lane * 4); }
    float bias8[8];
    if constexpr (ROUTER) {
#pragma unroll
        for (int r = 0; r < 8; ++r) bias8[r] = brt[(r >> 2) * 16 + 4 * q4 + (r & 3)]; }
    for (int wgi = F.vcu; wgi < 256; wgi += F.G) {
        const int r0 = wgi * 128 + F.wave * 16;
        constexpr bool PF = (MODE == 0) && !XIN_F32;
        u32x2 rx[4][4], rm[4][4];
        if constexpr (PF) {
#pragma unroll
            for (int u = 0; u < 4; ++u)
#pragma unroll
                for (int j = 0; j < 4; ++j) { rx[u][j] = *(const u32x2*)(xinb + (size_t)(r0 + u) * 1024 + j * 256 + lane * 4); rm[u][j] = *(const u32x2*)(MIXB + (size_t)(r0 + u) * 1024 + j * 256 + lane * 4); } }
#pragma unroll 1
        for (int i4 = 0; i4 < 16; i4 += 4) {
            float v[4][16];
            if constexpr (PF) {
#pragma unroll
                for (int u = 0; u < 4; ++u)
#pragma unroll
                    for (int j = 0; j < 4; ++j) { v[u][4 * j] = alpha * bflo(rx[u][j].x) + bflo(rm[u][j].x); v[u][4 * j + 1] = alpha * bfhi(rx[u][j].x) + bfhi(rm[u][j].x); v[u][4 * j + 2] = alpha * bflo(rx[u][j].y) + bflo(rm[u][j].y); v[u][4 * j + 3] = alpha * bfhi(rx[u][j].y) + bfhi(rm[u][j].y); }
                if (i4 + 4 < 16) {
#pragma unroll
                    for (int u = 0; u < 4; ++u)
#pragma unroll
                        for (int j = 0; j < 4; ++j) { rx[u][j] = *(const u32x2*)(xinb + (size_t)(r0 + i4 + 4 + u) * 1024 + j * 256 + lane * 4); rm[u][j] = *(const u32x2*)(MIXB + (size_t)(r0 + i4 + 4 + u) * 1024 + j * 256 + lane * 4); } }
            } else {
#pragma unroll
            for (int u = 0; u < 4; ++u) { const int row = r0 + i4 + u;
                if constexpr (XIN_F32) {
#pragma unroll
                    for (int j = 0; j < 4; ++j) { const f32x4 a = *(const f32x4*)(xin32 + (size_t)row * 1024 + j * 256 + lane * 4); v[u][4 * j] = alpha * a.x; v[u][4 * j + 1] = alpha * a.y; v[u][4 * j + 2] = alpha * a.z; v[u][4 * j + 3] = alpha * a.w; }
                } else {
#pragma unroll
                    for (int j = 0; j < 4; ++j) { const u32x2 a = *(const u32x2*)(xinb + (size_t)row * 1024 + j * 256 + lane * 4); v[u][4 * j] = alpha * bflo(a.x); v[u][4 * j + 1] = alpha * bfhi(a.x); v[u][4 * j + 2] = alpha * bflo(a.y); v[u][4 * j + 3] = alpha * bfhi(a.y); }
                }
                if constexpr (MODE == 0) {
#pragma unroll
                    for (int j = 0; j < 4; ++j) { const u32x2 m = *(const u32x2*)(MIXB + (size_t)row * 1024 + j * 256 + lane * 4); v[u][4 * j] += bflo(m.x); v[u][4 * j + 1] += bfhi(m.x); v[u][4 * j + 2] += bflo(m.y); v[u][4 * j + 3] += bfhi(m.y); }
                } else {
                    const int4 pos4 = *(const int4*)(POS + row * 4);
                    const int ps[4] = {__builtin_amdgcn_readfirstlane(pos4.x), __builtin_amdgcn_readfirstlane(pos4.y), __builtin_amdgcn_readfirstlane(pos4.z), __builtin_amdgcn_readfirstlane(pos4.w)};
#pragma unroll
                    for (int kx = 0; kx < 4; ++kx)
#pragma unroll
                        for (int j = 0; j < 4; ++j) { const unsigned m = *(const unsigned*)(YS8 + (size_t)ps[kx] * 1024 + j * 256 + lane * 4); const f32x2 lo2 = __builtin_amdgcn_cvt_pk_f32_fp8(m, false), hi2 = __builtin_amdgcn_cvt_pk_f32_fp8(m, true);
                            v[u][4 * j] += lo2.x * (1.f / 64.f); v[u][4 * j + 1] += lo2.y * (1.f / 64.f); v[u][4 * j + 2] += hi2.x * (1.f / 64.f); v[u][4 * j + 3] += hi2.y * (1.f / 64.f); }
                }
            }
            }
            float s1[4], s2[4];
#pragma unroll
            for (int u = 0; u < 4; ++u) { s1[u] = 0.f; s2[u] = 0.f;
#pragma unroll
                for (int q = 0; q < 16; ++q) { s1[u] += v[u][q]; s2[u] = fmaf(v[u][q], v[u][q], s2[u]); } }
#pragma unroll
            for (int o = 1; o < 64; o <<= 1) {
#pragma unroll
                for (int u = 0; u < 4; ++u) { s1[u] += __shfl_xor(s1[u], o); s2[u] += __shfl_xor(s2[u], o); } }
#pragma unroll
            for (int u = 0; u < 4; ++u) { const int row = r0 + i4 + u; const float mean = s1[u] * (1.f / 1024.f); const float var = fmaxf(s2[u] * (1.f / 1024.f) - mean * mean, 0.f); const float rstd = 1.f / sqrtf(var + 1e-5f);
#pragma unroll
                for (int j = 0; j < 4; ++j) { const int c = j * 256 + lane * 4; const f32x4 g4 = gq[j], b4 = bq[j];
                    const float y0 = (v[u][4 * j] - mean) * rstd * g4.x + b4.x, y1 = (v[u][4 * j + 1] - mean) * rstd * g4.y + b4.y, y2 = (v[u][4 * j + 2] - mean) * rstd * g4.z + b4.z, y3 = (v[u][4 * j + 3] - mean) * rstd * g4.w + b4.w;
                    if constexpr (OUT_F32) st_wt(xout32 + (size_t)row * 1024 + c, (f32x4){y0, y1, y2, y3});
                    else { u32x2 w; w.x = cvt_pk(y0, y1); w.y = cvt_pk(y2, y3); st_wt(xoutb + (size_t)row * 1024 + c, w);
                        if constexpr (ROUTER || GRP) { *(LAS u32x2*)(xt + u * RW_PITCH + c) = w; }
                        if constexpr ((ROUTER && GU_GATHER) || (MODE == 1 && IN1_FP8)) *(unsigned*)(WSP(unsigned char, W_X8T) + (size_t)row * 1024 + c) = pk4_fp8(y0 * 16.f, y1 * 16.f, y2 * 16.f, y3 * 16.f); } } }
            if constexpr (GRP) {
                f32x4 ga = {0.f, 0.f, 0.f, 0.f};
#pragma unroll 8
                for (int ks = 0; ks < 32; ++ks) { const bf16x8 xb = *(const LAS bf16x8*)(xt + (l15 & 3) * RW_PITCH + ks * 32 + q4 * 8), wa = *(const LAS bf16x8*)(whi + l15 * RW_PITCH + ks * 32 + q4 * 8);
                    ga = __builtin_amdgcn_mfma_f32_16x16x32_bf16(wa, xb, ga, 0, 0, 0); }
                if (l15 < 4) *(f32x4*)(WSP(float, W_GR) + (size_t)(r0 + i4 + l15) * 16 + 4 * q4) = ga; }
            if constexpr (ROUTER) {
                f32x4 acc[2] = {{0.f, 0.f, 0.f, 0.f}, {0.f, 0.f, 0.f, 0.f}};
#pragma unroll 8
                for (int ks = 0; ks < 32; ++ks) { const bf16x8 xb = *(const LAS bf16x8*)(xt + (l15 & 3) * RW_PITCH + ks * 32 + q4 * 8);
#pragma unroll
                    for (int mt = 0; mt < 2; ++mt) { const bf16x8 wa = *(const LAS bf16x8*)(whi + (mt * 16 + l15) * RW_PITCH + ks * 32 + q4 * 8); acc[mt] = __builtin_amdgcn_mfma_f32_16x16x32_bf16(wa, xb, acc[mt], 0, 0, 0); } }
                if (l15 < 4) {
#pragma unroll
                    for (int mt = 0; mt < 2; ++mt)
#pragma unroll
                        for (int r = 0; r < 4; ++r) lgs[l15 * 33 + mt * 16 + 4 * q4 + r] = acc[mt][r] + bias8[mt * 4 + r]; }
                if (lane < 4) { float lg[32];
#pragma unroll
                    for (int e = 0; e < 32; ++e) lg[e] = lgs[lane * 33 + e];
                    unsigned taken = 0u; float tv[4]; int ti[4];
#pragma unroll
                    for (int r = 0; r < 4; ++r) { float best = -INFINITY; int bi = 0;
#pragma unroll
                        for (int e = 0; e < 32; ++e) { const bool ok = !((taken >> e) & 1u) && lg[e] > best; best = ok ? lg[e] : best; bi = ok ? e : bi; }
                        taken |= 1u << bi; tv[r] = best; ti[r] = bi; }
                    float ex[4], sm = 0.f;
#pragma unroll
                    for (int r = 0; r < 4; ++r) { ex[r] = __expf(tv[r] - tv[0]); sm += ex[r]; }
                    const float inv = 1.f / sm; const int row = r0 + i4 + lane;
                    *(int4*)(RE + row * 4) = make_int4(ti[0], ti[1], ti[2], ti[3]); *(f32x4*)(RW + row * 4) = (f32x4){ex[0] * inv, ex[1] * inv, ex[2] * inv, ex[3] * inv};
#pragma unroll
                    for (int r = 0; r < 4; ++r) atomicAdd((int*)(hist + ti[r]), 1); }
            }
        }
        if constexpr (ROUTER) { __syncthreads(); if (F.tid < 32) { WSP(int, W_HIST)[wgi * 32 + F.tid] = hist[F.tid]; hist[F.tid] = 0; } __syncthreads(); }
    }
}

DEV void p_sort(Frame& F) {
    LAS int* Ls = (LAS int*)F.lds; const int tid = F.tid;
    const int* HIST = WSP(int, W_HIST); int* SORT = WSP(int, W_SORT);
    const int* RE = WSP(int, R_RE); const float* RW = WSP(float, R_RW); int* POS = WSP(int, R_POS); int* TOK = WSP(int, R_TOK); float* WGT = WSP(float, R_WGT);
    for (int wgi = F.vcu; wgi < 256; wgi += F.G) {
        { const int e = tid & 31, part = tid >> 5; int tot = 0, pre = 0;
          for (int w = part * 16; w < part * 16 + 16; ++w) { const int hh = HIST[w * 32 + e]; tot += hh; pre += (w < wgi) ? hh : 0; }
          Ls[part * 32 + e] = tot; Ls[512 + part * 32 + e] = pre; }
        Ls[2048 + tid] = RE[wgi * 512 + tid];
        __syncthreads();
        if (tid < 32) { int tot = 0, pre = 0; for (int p = 0; p < 16; ++p) { tot += Ls[p * 32 + tid]; pre += Ls[512 + p * 32 + tid]; } Ls[1200 + tid] = tot; Ls[1300 + tid] = pre; }
        __syncthreads();
        if (tid == 0) { int a = 0; for (int e = 0; e < 32; ++e) { Ls[1024 + e] = a; a += (Ls[1200 + e] + 255) / 256 * 256; } Ls[1056] = a; }
        __syncthreads();
        { const int e = tid & 31, seg = tid >> 5; int cnt = 0;
#pragma unroll 8
          for (int i = 0; i < 32; ++i) cnt += (Ls[2048 + seg * 32 + i] == e) ? 1 : 0;
          Ls[3072 + seg * 32 + e] = cnt;
          __syncthreads();
          int c = Ls[1024 + e] + Ls[1300 + e];
          for (int s2 = 0; s2 < seg; ++s2) c += Ls[3072 + s2 * 32 + e];
#pragma unroll 8
          for (int i = 0; i < 32; ++i) if (Ls[2048 + seg * 32 + i] == e) { Ls[2560 + seg * 32 + i] = c; ++c; } }
        __syncthreads();
        { const int pos = Ls[2560 + tid]; TOK[pos] = wgi * 128 + (tid >> 2); WGT[pos] = RW[wgi * 512 + tid]; POS[wgi * 512 + tid] = pos; }
        if constexpr (!GU_GATHER) { const bf16_t* XBBp = WSP(bf16_t, W_XBB); unsigned char* XS8 = WSP(unsigned char, W_X8);
          for (int rg = 0; rg < 16; rg += 4) {
              u32x4 a[4], b2[4];
#pragma unroll
              for (int u = 0; u < 4; ++u) { const int r = F.wave * 16 + rg + u; const u32x4* src = (const u32x4*)(XBBp + (size_t)(wgi * 128 + r) * 1024 + F.lane * 16); a[u] = src[0]; b2[u] = src[1]; }
#pragma unroll
              for (int u = 0; u < 4; ++u) { const int r = F.wave * 16 + rg + u;
                  u32x4 o; o.x = pk4_fp8(bflo(a[u].x) * 16.f, bfhi(a[u].x) * 16.f, bflo(a[u].y) * 16.f, bfhi(a[u].y) * 16.f); o.y = pk4_fp8(bflo(a[u].z) * 16.f, bfhi(a[u].z) * 16.f, bflo(a[u].w) * 16.f, bfhi(a[u].w) * 16.f);
                  o.z = pk4_fp8(bflo(b2[u].x) * 16.f, bfhi(b2[u].x) * 16.f, bflo(b2[u].y) * 16.f, bfhi(b2[u].y) * 16.f); o.w = pk4_fp8(bflo(b2[u].z) * 16.f, bfhi(b2[u].z) * 16.f, bflo(b2[u].w) * 16.f, bfhi(b2[u].w) * 16.f);
#pragma unroll
                  for (int kx = 0; kx < 4; ++kx) { const int pos = Ls[2560 + r * 4 + kx]; st_wt(XS8 + (size_t)pos * 1024 + F.lane * 16, o); } } }
          if (wgi < 32) { const int e = wgi; for (int r = Ls[1024 + e] + Ls[1200 + e] + F.wave; r < Ls[1024 + e + 1]; r += 8) st_wt(XS8 + (size_t)r * 1024 + F.lane * 16, (u32x4){0u, 0u, 0u, 0u}); } }
        if (wgi < 32) { const int e = wgi; for (int r = Ls[1024 + e] + Ls[1200 + e] + tid; r < Ls[1024 + e + 1]; r += 512) { TOK[r] = 0; WGT[r] = 0.f; } }
        if (wgi == 0) { if (tid < 33) SORT[tid] = Ls[1024 + tid]; if (tid == 0) SORT[33] = Ls[1056] / 256;
            for (int pm = tid; pm < PMAX / 256; pm += 512) { int e = 0; for (int j = 1; j < 32; ++j) if (pm * 256 >= Ls[1024 + j]) e = j; SORT[64 + pm] = e; } }
        __syncthreads();
    }
}

DEV void p_gr(Frame& F) {
    const int gw = F.vcu * 8 + F.wave, NGW = F.G * 8, lane = F.lane, q4 = lane >> 4; const bf16_t* XB = WSP(bf16_t, W_XB); const bf16_t* Wg = WSP(bf16_t, W_IN1) + (size_t)3072 * 1024; float* GR = WSP(float, W_GR);
    for (int it = gw; it < T / 16; it += NGW) { f32x4 acc = {0.f, 0.f, 0.f, 0.f};
        const bf16_t* ap = XB + (size_t)(it * 16 + (lane & 15)) * 1024 + q4 * 8; const bf16_t* bp = Wg + (size_t)(lane & 15) * 1024 + q4 * 8;
        bf16x8 a[32], bb[32];
#pragma unroll
        for (int ks = 0; ks < 32; ++ks) { a[ks] = *(const bf16x8*)(ap + ks * 32); bb[ks] = *(const bf16x8*)(bp + ks * 32); }
#pragma unroll
        for (int ks = 0; ks < 32; ++ks) acc = __builtin_amdgcn_mfma_f32_16x16x32_bf16(a[ks], bb[ks], acc, 0, 0, 0);
#pragma unroll
        for (int r = 0; r < 4; ++r) GR[(size_t)(it * 16 + 4 * q4 + r) * 16 + (lane & 15)] = acc[r]; }
}

constexpr int GP = 264, GP2 = 144;
constexpr int GB_QIN = 0, GB_KST = 16896, GB_ATT = 35328, GB_DEC = 44544, GB_VT = 45056, GB_SIZE = 81920;
constexpr size_t W_GB = W_YS;
static_assert((size_t)2048 * GB_SIZE <= (size_t)PMAX * 2048, "blob region");
constexpr int GA_GRS = 0, GA_GT = 4096, GA_BL = 8192  , GA_QIN = GA_BL + GB_QIN, GA_KST = GA_BL + GB_KST, GA_ATT = GA_BL + GB_ATT, GA_DEC = GA_BL + GB_DEC, GA_KIN = GA_BL + 45056  , GA_VT = GA_KIN + 17408, GA_END = GA_VT + 36864;
DEV float logsigm_fast(float z) { const float e = __builtin_amdgcn_exp2f(-1.4426950408889634f * fabsf(z)); return fminf(z, 0.f) - 0.6931471805599453f * __builtin_amdgcn_logf(1.f + e); }
struct GlaRaw { unsigned q[16], k[16], v[32]; f32x4 ga, gb; };
DEV void p_gla_prep(Frame& F) {
    LAS unsigned char* lds = F.lds; const int tid = F.tid, lane = F.lane, wid = F.wave, q4 = lane >> 4, l15 = lane & 15;
    const bf16_t* H1 = WSP(bf16_t, W_HB); const float* GR = WSP(float, W_GR); unsigned char* GB = F.ws + W_GB;
    const float* wg2 = F.in[15]; const float* bg = F.in[16];
    for (int i = tid; i < 64 * GP2 / 4; i += 512) ((LAS unsigned*)(lds + GA_ATT))[i] = 0u;
    const int dk = 32 * (wid & 3) + (lane & 31), tg = 2 * (wid >> 2) + (lane >> 5);
    const int dvl = tid & 255, th2 = tid >> 8;
    const int tzm = 16 * (((lane & 31) >> 2) & 1) + 4 * ((lane & 31) >> 3) + (lane & 3);
    for (int wg = F.vcu; wg < 256; wg += F.G) {
        const int b = wg >> 4, h = (wg >> 2) & 3, n0 = (wg & 3) * 8;
        bf16x8 w2f; { float wv[8];
#pragma unroll
          for (int j = 0; j < 8; ++j) wv[j] = wg2[(8 * (lane >> 5) + j) * 512 + h * 128 + dk];
          const u32x4 ww = {cvt_pk(wv[0], wv[1]), cvt_pk(wv[2], wv[3]), cvt_pk(wv[4], wv[5]), cvt_pk(wv[6], wv[7])}; w2f = __builtin_bit_cast(bf16x8, ww); }
        const float bgv = bg[h * 128 + dk];
#define GLA_LOAD(R, n_) do { const size_t rb_ = (size_t)b * 2048 + (n_) * 64; \
        _Pragma("unroll") for (int i = 0; i < 16; ++i) { const size_t ro = (rb_ + 16 * tg + i) * 3072; R.q[i] = H1[ro + h * 128 + dk]; R.k[i] = H1[ro + 512 + h * 128 + dk]; } \
        _Pragma("unroll") for (int i = 0; i < 32; ++i) R.v[i] = H1[(rb_ + 32 * th2 + i) * 3072 + 1024 + h * 256 + dvl]; \
        { const float* gp_ = GR + (rb_ + 32 * (wid >> 2) + tzm) * 16 + 8 * (lane >> 5); R.ga = *(const f32x4*)gp_; R.gb = *(const f32x4*)(gp_ + 4); } } while (0)
        GlaRaw cur, nxt; GLA_LOAD(cur, n0); nxt = cur;
#pragma unroll 1
      for (int sub = 0; sub < 8; ++sub) { const int n = n0 + sub;
        if (sub + 1 < 8) GLA_LOAD(nxt, n + 1);
        float cs[16]; float run = 0.f;
        { const u32x4 aw = {cvt_pk(cur.ga.x, cur.ga.y), cvt_pk(cur.ga.z, cur.ga.w), cvt_pk(cur.gb.x, cur.gb.y), cvt_pk(cur.gb.z, cur.gb.w)};
          f32x16 zz;
#pragma unroll
          for (int r = 0; r < 16; ++r) zz[r] = bgv;
          zz = __builtin_amdgcn_mfma_f32_32x32x16_bf16(__builtin_bit_cast(bf16x8, aw), w2f, zz, 0, 0, 0);
#pragma unroll
          for (int i = 0; i < 16; ++i) { run += logsigm_fast(zz[i]) * (1.f / 16.f); cs[i] = run; } }
        ((LAS float*)(lds + GA_GT))[tg * 128 + dk] = run;
        __syncthreads();
        float off = 0.f, btot = 0.f;
#pragma unroll
        for (int g2 = 0; g2 < 4; ++g2) { const float gtv = ((LAS float*)(lds + GA_GT))[g2 * 128 + dk]; btot += gtv; off += (g2 < tg) ? gtv : 0.f; }
        if (tg == 0) ((LAS float*)(lds + GA_DEC))[dk] = __expf(btot);
        { unsigned kst[8];
#pragma unroll
          for (int i = 0; i < 16; i += 2) { float kk[2];
#pragma unroll
              for (int u = 0; u < 2; ++u) { const int t = 16 * tg + i + u; const float bc = cs[i + u] + off; const float qv = bflo(cur.q[i + u]), kv = bflo(cur.k[i + u]);
                  *(LAS bf16_t*)(lds + GA_QIN + t * GP + dk * 2) = (bf16_t)(cvt_pk(qv * __expf(bc), 0.f) & 0xffffu);
                  *(LAS bf16_t*)(lds + GA_KIN + t * 272 + dk * 2) = (bf16_t)(cvt_pk(kv * __expf(-bc), 0.f) & 0xffffu);
                  kk[u] = kv * __expf(btot - bc); }
              kst[i >> 1] = cvt_pk(kk[0], kk[1]); }
          *(LAS u32x4*)(lds + GA_KST + dk * GP2 + tg * 32) = (u32x4){kst[0], kst[1], kst[2], kst[3]};
          *(LAS u32x4*)(lds + GA_KST + dk * GP2 + tg * 32 + 16) = (u32x4){kst[4], kst[5], kst[6], kst[7]}; }
#pragma unroll
        for (int i = 0; i < 32; i += 8) *(LAS u32x4*)(lds + GA_VT + dvl * GP2 + (32 * th2 + i) * 2) = (u32x4){cur.v[i] | (cur.v[i + 1] << 16), cur.v[i + 2] | (cur.v[i + 3] << 16), cur.v[i + 4] | (cur.v[i + 5] << 16), cur.v[i + 6] | (cur.v[i + 7] << 16)};
        __syncthreads();
#pragma unroll
        for (int rep = 0; rep < 2; ++rep) { const int ti = wid + 8 * rep; if (ti < 10) {
            int jt, it2; if (ti < 4) { jt = 0; it2 = ti; } else if (ti < 7) { jt = 1; it2 = ti - 3; } else if (ti < 9) { jt = 2; it2 = ti - 5; } else { jt = 3; it2 = 3; }
            f32x4 a4 = {0.f, 0.f, 0.f, 0.f};
#pragma unroll
            for (int ks = 0; ks < 4; ++ks) { const bf16x8 kf = *(const LAS bf16x8*)(lds + GA_KIN + (16 * jt + l15) * 272 + ks * 64 + q4 * 16); const u32x2 q0_ = *(const LAS u32x2*)(lds + GA_QIN + (16 * it2 + l15) * GP + ks * 64 + q4 * 16), q1_ = *(const LAS u32x2*)(lds + GA_QIN + (16 * it2 + l15) * GP + ks * 64 + q4 * 16 + 8); const bf16x8 qf = __builtin_bit_cast(bf16x8, (u32x4){q0_.x, q0_.y, q1_.x, q1_.y});
                a4 = __builtin_amdgcn_mfma_f32_16x16x32_bf16(kf, qf, a4, 0, 0, 0); }
            const int i_ = 16 * it2 + l15, j0 = 16 * jt + 4 * q4;
            u32x2 w; w.x = cvt_pk(j0 <= i_ ? a4[0] : 0.f, j0 + 1 <= i_ ? a4[1] : 0.f); w.y = cvt_pk(j0 + 2 <= i_ ? a4[2] : 0.f, j0 + 3 <= i_ ? a4[3] : 0.f);
            *(LAS u32x2*)(lds + GA_ATT + i_ * GP2 + j0 * 2) = w; } }
        __syncthreads();
        unsigned char* blob = GB + (size_t)((b * 32 + n) * 4 + h) * GB_SIZE;
        for (int c = tid; c < 45056 / 16; c += 512) st_wt(blob + c * 16, *(const LAS u32x4*)(lds + GA_BL + c * 16));
        for (int c = tid; c < 36864 / 16; c += 512) st_wt(blob + GB_VT + c * 16, *(const LAS u32x4*)(lds + GA_VT + c * 16));
        cur = nxt;
      }
#undef GLA_LOAD
    }
}
constexpr int GS_BUF = 54272;
constexpr int GS_VT = 0, GS_QIN = 9216, GS_KST = GS_QIN + 16896, GS_ATT = GS_KST + 18432, GS_DEC = GS_ATT + 9216;
static_assert(3 * GS_BUF <= LDSCTL_OFF, "GLA ring");
DEV float sum16_dpp(float v) {
    v += __builtin_bit_cast(float, __builtin_amdgcn_update_dpp(0, __builtin_bit_cast(int, v), 0xB1, 0xF, 0xF, false));
    v += __builtin_bit_cast(float, __builtin_amdgcn_update_dpp(0, __builtin_bit_cast(int, v), 0x4E, 0xF, 0xF, false));
    v += __builtin_bit_cast(float, __builtin_amdgcn_update_dpp(0, __builtin_bit_cast(int, v), 0x141, 0xF, 0xF, false));
    v += __builtin_bit_cast(float, __builtin_amdgcn_update_dpp(0, __builtin_bit_cast(int, v), 0x140, 0xF, 0xF, false));
    return v; }
DEV void gla_scan_item(Frame& F, int b, int h, int c4) {
    LAS unsigned char* lds = F.lds; const int lane = F.lane, wid = F.wave, q4 = lane >> 4, l15 = lane & 15;
    bf16_t* GO = WSP(bf16_t, W_GLAO); float* SS = WSP(float, W_SS); const unsigned char* GB = F.ws + W_GB;
    const int c16 = wid & 3, th = wid >> 2;
    f32x4 sacc[8];
#pragma unroll
    for (int m = 0; m < 8; ++m) sacc[m] = (f32x4){0.f, 0.f, 0.f, 0.f};
    const size_t rb = (size_t)b * 2048;
    float sqv[2][4]; unsigned ov[2][4];
#pragma unroll
    for (int mt = 0; mt < 2; ++mt)
#pragma unroll
        for (int r = 0; r < 4; ++r) { sqv[mt][r] = 0.f; ov[mt][r] = 0u; }
    const int npc = (wid < 5) ? 7 : 6;
#define GS_ISSUE(n_, bo_) do { const unsigned char* blob_ = GB + (size_t)((b * 32 + (n_)) * 4 + h) * GB_SIZE; \
        for (int p_ = wid; p_ < 53; p_ += 8) { const int so_ = p_ < 9 ? GB_VT + c4 * 9216 + p_ * 1024 : (p_ - 9) * 1024; \
            __builtin_amdgcn_global_load_lds((const unsigned*)(blob_ + so_ + lane * 16), (LAS unsigned*)(lds + (bo_) + p_ * 1024), 16, 0, 0); } } while (0)
    GS_ISSUE(0, 0); GS_ISSUE(1, GS_BUF);
    int bo = 0, bo2 = 2 * GS_BUF;
#pragma unroll 1
    for (int n = 0; n < 32; ++n) { const int t0 = n * 64;
        if (n + 1 < 32) { if (npc == 7) asm volatile("s_waitcnt vmcnt(7) lgkmcnt(0)\n\ts_barrier" ::: "memory"); else asm volatile("s_waitcnt vmcnt(6) lgkmcnt(0)\n\ts_barrier" ::: "memory"); } else asm volatile("s_waitcnt vmcnt(0) lgkmcnt(0)\n\ts_barrier" ::: "memory");
        if (n > 0) {
#pragma unroll
            for (int mt = 0; mt < 2; ++mt)
#pragma unroll
                for (int r = 0; r < 4; ++r) { const size_t trow = rb + (t0 - 64) + 32 * th + 16 * mt + 4 * q4 + r; GO[trow * 1024 + h * 256 + c4 * 64 + c16 * 16 + l15] = (bf16_t)ov[mt][r];
                    SS[(trow * 4 + h) * 16 + c4 * 4 + c16] = sqv[mt][r]; } }
        if (n + 2 < 32) GS_ISSUE(n + 2, bo2);
        const LAS unsigned char* bu = lds + bo;
        bf16x8 vf[2];
#pragma unroll
        for (int ks = 0; ks < 2; ++ks) vf[ks] = *(const LAS bf16x8*)(bu + GS_VT + (c16 * 16 + l15) * GP2 + ks * 64 + q4 * 16);
        bf16x8 sf[4];
#pragma unroll
        for (int ks = 0; ks < 4; ++ks) { const u32x4 w = {cvt_pk(sacc[2 * ks][0], sacc[2 * ks][1]), cvt_pk(sacc[2 * ks][2], sacc[2 * ks][3]), cvt_pk(sacc[2 * ks + 1][0], sacc[2 * ks + 1][1]), cvt_pk(sacc[2 * ks + 1][2], sacc[2 * ks + 1][3])}; sf[ks] = __builtin_bit_cast(bf16x8, w); }
#pragma unroll
        for (int mt = 0; mt < 2; ++mt) { const int i_ = 32 * th + 16 * mt + l15; f32x4 oa = {0.f, 0.f, 0.f, 0.f};
#pragma unroll
            for (int ks = 0; ks < 2; ++ks) { if (ks == 1 && th == 0) continue; const bf16x8 af = *(const LAS bf16x8*)(bu + GS_ATT + i_ * GP2 + ks * 64 + q4 * 16); oa = __builtin_amdgcn_mfma_f32_16x16x32_bf16(af, vf[ks], oa, 0, 0, 0); }
#pragma unroll
            for (int ks = 0; ks < 4; ++ks) { const u32x2 lo = *(const LAS u32x2*)(bu + GS_QIN + i_ * GP + (32 * ks + 4 * q4) * 2), hi2 = *(const LAS u32x2*)(bu + GS_QIN + i_ * GP + (32 * ks + 16 + 4 * q4) * 2);
                const u32x4 w = {lo.x, lo.y, hi2.x, hi2.y}; oa = __builtin_amdgcn_mfma_f32_16x16x32_bf16(__builtin_bit_cast(bf16x8, w), sf[ks], oa, 0, 0, 0); }
#pragma unroll
            for (int r = 0; r < 4; ++r) { ov[mt][r] = cvt_pk(oa[r], 0.f) & 0xffffu; float sq = oa[r] * oa[r]; sq = sum16_dpp(sq); sqv[mt][r] = sq; } }
#pragma unroll
        for (int md = 0; md < 8; ++md) { const f32x4 dc = *(const LAS f32x4*)(bu + GS_DEC + (16 * md + 4 * q4) * 4); sacc[md] = sacc[md] * dc;
#pragma unroll
            for (int ks = 0; ks < 2; ++ks) { const bf16x8 kf = *(const LAS bf16x8*)(bu + GS_KST + (16 * md + l15) * GP2 + ks * 64 + q4 * 16); sacc[md] = __builtin_amdgcn_mfma_f32_16x16x32_bf16(kf, vf[ks], sacc[md], 0, 0, 0); } }
        bo = (bo == 2 * GS_BUF) ? 0 : bo + GS_BUF; bo2 = (bo2 == 2 * GS_BUF) ? 0 : bo2 + GS_BUF;
    }
#undef GS_ISSUE
#pragma unroll
    for (int mt = 0; mt < 2; ++mt)
#pragma unroll
        for (int r = 0; r < 4; ++r) { const size_t trow = rb + 31 * 64 + 32 * th + 16 * mt + 4 * q4 + r; GO[trow * 1024 + h * 256 + c4 * 64 + c16 * 16 + l15] = (bf16_t)ov[mt][r]; SS[(trow * 4 + h) * 16 + c4 * 4 + c16] = sqv[mt][r]; }
    asm volatile("s_waitcnt vmcnt(0)" ::: "memory");
    __syncthreads();
}
DEV void p_gla_scan(Frame& F) { for (int v = F.vcu; v < 256; v += F.G) gla_scan_item(F, v >> 4, (v >> 2) & 3, v & 3); }

DEV void p_gla_norm(Frame& F) {
    const int gw = F.vcu * 8 + F.wave, NGW = F.G * 8, lane = F.lane; const bf16_t* GO = WSP(bf16_t, W_GLAO); const float* SS = WSP(float, W_SS); const bf16_t* H1 = WSP(bf16_t, W_HB); bf16_t* Y0 = WSP(bf16_t, W_Y0);
    const f32x4 nw = *(const f32x4*)(F.in[17] + lane * 4);
    for (int row = gw; row < T; row += NGW) {
#pragma unroll
        for (int h = 0; h < 4; ++h) { const float* sp = SS + ((size_t)row * 4 + h) * 16; const f32x4 a = *(const f32x4*)sp, b2 = *(const f32x4*)(sp + 4), c = *(const f32x4*)(sp + 8), d = *(const f32x4*)(sp + 12);
            const float sq = (a.x + a.y + a.z + a.w) + (b2.x + b2.y + b2.z + b2.w) + (c.x + c.y + c.z + c.w) + (d.x + d.y + d.z + d.w); const float r = 1.f / sqrtf(sq * (1.f / 256.f) + 1e-5f);
            const u32x2 o = *(const u32x2*)(GO + (size_t)row * 1024 + h * 256 + lane * 4); const u32x2 g = *(const u32x2*)(H1 + (size_t)row * 3072 + 2048 + h * 256 + lane * 4);
            const float g0 = bflo(g.x), g1 = bfhi(g.x), g2 = bflo(g.y), g3 = bfhi(g.y);
            u32x2 w; w.x = cvt_pk(bflo(o.x) * r * nw.x * g0 * fast_sigm(g0), bfhi(o.x) * r * nw.y * g1 * fast_sigm(g1)); w.y = cvt_pk(bflo(o.y) * r * nw.z * g2 * fast_sigm(g2), bfhi(o.y) * r * nw.w * g3 * fast_sigm(g3));
            st_wt(Y0 + (size_t)row * 1024 + h * 256 + lane * 4, w); } }
}
#ifndef PK_SWIGLU
#define PK_SWIGLU 1
#endif
template <bool KM_> struct FStoreScaleT { bf16_t* O; int ldc, c_lo, c_hi; float sc; float* km; float gs = 1.f; static constexpr int NSIDE = 0; static constexpr bool PERM2 = false, COLSUM = KM_;
    DEV bool colsum_tile(const Unit& u) const { return (u.pn >> 1) == 2; }
    DEV void colsum_add(const Unit& u, int col, float s) const { const int h = (col - 1024) >> 6, d = col & 63; __hip_atomic_fetch_add(km + (size_t)(((u.pm >> 3) * 8 + h) * 8 + (u.pm & 7)) * 64 + d, s * (1.f / 256.f), __ATOMIC_RELAXED, __HIP_MEMORY_SCOPE_AGENT); }
    DEV const void* side(const Unit&, int) const { return nullptr; }
    DEV NoPre pre(const Unit&, int, const LAS float*) const { return NoPre{}; }
    DEV void operator()(const Unit&, int row, int col, f32x4 v0, f32x4 v1, NoPre, const LAS float*) const { const float s = ((col >= c_lo && col < c_hi) ? sc : 1.f) * gs;
        const u32x4 w = {cvt_pk(v0[0] * s, v0[1] * s), cvt_pk(v0[2] * s, v0[3] * s), cvt_pk(v1[0] * s, v1[1] * s), cvt_pk(v1[2] * s, v1[3] * s)}; *(u32x4*)(O + (size_t)row * ldc + col) = w; } };
typedef FStoreScaleT<false> FStoreScale;
struct Pre8 { f32x4 b0, b1; };
struct FGlu { const bf16_t* Y; bf16_t* O; const float* b; static constexpr int NSIDE = 0; static constexpr bool PERM2 = false, COLSUM = false;
    DEV const void* side(const Unit&, int) const { return nullptr; }
    DEV Pre8 pre(const Unit&, int col, const LAS float*) const { return Pre8{*(const f32x4*)(b + col), *(const f32x4*)(b + col + 4)}; }
    DEV void operator()(const Unit&, int row, int col, f32x4 v0, f32x4 v1, const Pre8& pp, const LAS float*) const { const u32x4 y = *(const u32x4*)(Y + (size_t)row * 512 + col); const f32x4 b0 = pp.b0, b1 = pp.b1;
        const u32x4 w = {cvt_pk(bflo(y.x) * fast_sigm(v0[0] + b0.x), bfhi(y.x) * fast_sigm(v0[1] + b0.y)), cvt_pk(bflo(y.y) * fast_sigm(v0[2] + b0.z), bfhi(y.y) * fast_sigm(v0[3] + b0.w)),
                         cvt_pk(bflo(y.z) * fast_sigm(v1[0] + b1.x), bfhi(y.z) * fast_sigm(v1[1] + b1.y)), cvt_pk(bflo(y.w) * fast_sigm(v1[2] + b1.z), bfhi(y.w) * fast_sigm(v1[3] + b1.w))};
        *(u32x4*)(O + (size_t)row * 1024 + col) = w; } };
constexpr float ACT_SCALE = 4.f, WDN_SCALE = 128.f;
#ifdef NEWTON_RCP
DEV float rcp_nr(float e) { float r = __builtin_bit_cast(float, 0x7EF311C7u - __builtin_bit_cast(unsigned, e)); r = r * fmaf(-e, r, 2.f); r = r * fmaf(-e, r, 2.f); return r; }
#else
DEV float rcp_nr(float e) { return __builtin_amdgcn_rcpf(e); }
#endif
DEV float swiglu1s(float g, float u) { g = fminf(g, 7.f); u = __builtin_amdgcn_fmed3f(u, -7.f, 7.f); const float r = rcp_nr(1.f + __builtin_amdgcn_exp2f(-1.702f * 1.4426950408889634f * g)); return (g * r) * fmaf(u, ACT_SCALE, ACT_SCALE); }
#if PK_SWIGLU
DEV f32x2 swiglu2(f32x2 g, f32x2 u4) { g.x = fminf(g.x, 7.f); g.y = fminf(g.y, 7.f); u4.x = __builtin_amdgcn_fmed3f(u4.x, -6.f * ACT_SCALE, 8.f * ACT_SCALE); u4.y = __builtin_amdgcn_fmed3f(u4.y, -6.f * ACT_SCALE, 8.f * ACT_SCALE);
    const f32x2 a = g * (-1.702f * 1.4426950408889634f); f32x2 e; e.x = __builtin_amdgcn_exp2f(a.x); e.y = __builtin_amdgcn_exp2f(a.y); e = e + 1.f;
    f32x2 r; r.x = __builtin_amdgcn_rcpf(e.x); r.y = __builtin_amdgcn_rcpf(e.y); return (g * r) * u4; }
struct FSwiglu { unsigned char* ACT; const float* bgu2; float sc; static constexpr int NSIDE = 1; static constexpr bool PERM2 = true;
    DEV const void* side(const Unit& u, int) const { return bgu2 + (size_t)u.e * 2048 + u.pn * BM; }
    DEV Pre8 pre(const Unit&, int, const LAS float* sb) const { return Pre8{*(const LAS f32x4*)sb, *(const LAS f32x4*)(sb + 4)}; }
    DEV void operator()(const Unit& u, int row, int col, f32x4 v0, f32x4 v1, const Pre8& pp, const LAS float*) const { const f32x4 b0 = pp.b0, b1 = pp.b1; const f32x2 sg = {sc, sc}, su = {sc * ACT_SCALE, sc * ACT_SCALE};
        const f32x2 a01 = swiglu2(__builtin_elementwise_fma((f32x2){v0[0], v0[1]}, sg, (f32x2){b0.x, b0.y}), __builtin_elementwise_fma((f32x2){v0[2], v0[3]}, su, (f32x2){b0.z, b0.w}));
        const f32x2 a23 = swiglu2(__builtin_elementwise_fma((f32x2){v1[0], v1[1]}, sg, (f32x2){b1.x, b1.y}), __builtin_elementwise_fma((f32x2){v1[2], v1[3]}, su, (f32x2){b1.z, b1.w}));
        *(unsigned*)(ACT + (size_t)row * 1024 + (col >> 1)) = pk4_fp8(a01.x, a01.y, a23.x, a23.y); } };
#else
struct FSwiglu { unsigned char* ACT; const float* bgu; float sc; static constexpr int NSIDE = 1; static constexpr bool PERM2 = false;
    DEV const void* side(const Unit& u, int) const { return bgu + (size_t)u.e * 2048 + u.pn * BM; }
    DEV Pre8 pre(const Unit&, int, const LAS float* sb) const { return Pre8{*(const LAS f32x4*)sb, *(const LAS f32x4*)(sb + 4)}; }
    DEV void operator()(const Unit& u, int row, int col, f32x4 v0, f32x4 v1, const Pre8& pp, const LAS float*) const { const f32x4 b0 = pp.b0, b1 = pp.b1;
        const unsigned w = pk4_fp8(swiglu1s(fmaf(v0[0], sc, b0.x), fmaf(v0[1], sc, b0.y)), swiglu1s(fmaf(v0[2], sc, b0.z), fmaf(v0[3], sc, b0.w)), swiglu1s(fmaf(v1[0], sc, b1.x), fmaf(v1[1], sc, b1.y)), swiglu1s(fmaf(v1[2], sc, b1.z), fmaf(v1[3], sc, b1.w)));
        *(unsigned*)(ACT + (size_t)row * 1024 + (col >> 1)) = w; } };
#endif
constexpr float YS_SCALE = 64.f;
struct FDown { unsigned char* YS; const float* bd; const float* wgt; float sc; static constexpr int NSIDE = 2; static constexpr bool PERM2 = false;
    DEV const void* side(const Unit& u, int k) const { return k == 0 ? (const void*)(bd + (size_t)u.e * 1024 + u.pn * BM) : (const void*)(wgt + (size_t)u.pm * BM); }
    DEV Pre8 pre(const Unit&, int, const LAS float* sb) const { return Pre8{*(const LAS f32x4*)sb, *(const LAS f32x4*)(sb + 4)}; }
    DEV void operator()(const Unit& u, int row, int col, f32x4 v0, f32x4 v1, const Pre8& pp, const LAS float* sr) const { const f32x4 b0 = pp.b0, b1 = pp.b1; const float wt = *sr * YS_SCALE, ws_ = sc * wt;
        u32x2 w; w.x = pk4_fp8(fmaf(v0[0], ws_, b0.x * wt), fmaf(v0[1], ws_, b0.y * wt), fmaf(v0[2], ws_, b0.z * wt), fmaf(v0[3], ws_, b0.w * wt)); w.y = pk4_fp8(fmaf(v1[0], ws_, b1.x * wt), fmaf(v1[1], ws_, b1.y * wt), fmaf(v1[2], ws_, b1.z * wt), fmaf(v1[3], ws_, b1.w * wt));
        *(u32x2*)(YS + (size_t)row * 1024 + col) = w; } };

constexpr int NPH = 21;
#ifndef DENSE_WGM
#define DENSE_WGM 8
#endif
#ifndef DN_WGM
#define DN_WGM 8
#endif
#ifndef MOE_ALIGN
#define MOE_ALIGN true
#endif
#ifndef CV_Q_GU
#define CV_Q_GU 44
#endif
#ifndef CV_Q_DN
#define CV_Q_DN 20
#endif
#ifndef GU_WGM
#define GU_WGM 4
#endif
#ifndef DUP_GU
#define DUP_GU 0
#endif
constexpr float X8_SCALE = 16.f, WGU_SCALE = 64.f;
constexpr float QSCALE0 = 0.125f * 1.4426950408889634f, QSCALE1 = 0.08838834764831845f;


#define NOINL __device__ __forceinline__
struct PA { const float* const* in; unsigned char* ws; float* out; int wave; };
#define MKFRAME extern __shared__ __attribute__((aligned(16))) unsigned char lds_[]; Frame F; F.lds = (LAS unsigned char*)lds_; F.wave = pa.wave; F.lane = (int)__builtin_amdgcn_mbcnt_hi(~0u, __builtin_amdgcn_mbcnt_lo(~0u, 0u)); F.tid = F.wave * 64 + F.lane; \
    F.G = gridDim.x; { const int bx = blockIdx.x; F.vcu = (F.G % 8 == 0) ? (bx % 8) * (F.G / 8) + bx / 8 : bx; } F.in = pa.in; F.ws = pa.ws;
template <class Fn> DEV void dense_gemm(Frame& F, const bf16_t* A, const bf16_t* Bt, int nM, int nN, int K, const Fn& fn) {
    Gemm g; g.A = A; g.Bt = Bt; g.rowmap = nullptr; g.bstride = 0; g.KB = K * 2; g.wave = F.wave;
    StaticOrder S; S.init(nM, nN, F.G, (int)blockIdx.x, nullptr, DENSE_WGM);
    EpiRow8<Fn> E{fn};
    gemm_phase<false, false, true>(F.lds, g, S, E);
}
NOINL void ph_prologue(PA pa) { MKFRAME p0_prologue(F); }
NOINL void ph_in0(PA pa) { MKFRAME dense_gemm(F, WSP(bf16_t, W_XB), WSP(bf16_t, W_IN0), T / 256, 8, 1024, FStoreScaleT<true>{WSP(bf16_t, W_HB), 2048, 512, 1024, QSCALE0, WSP(float, W_KM)}); }
NOINL void ph_kmean(PA pa) { MKFRAME p_kmean(F); }
NOINL void ph_s5moba(PA pa, int mode) { MKFRAME p_s5_moba(F, mode); }
NOINL void ph_glu(PA pa) { MKFRAME dense_gemm(F, WSP(bf16_t, W_YS5), WSP(bf16_t, W_GLU), T / 256, 2, 512, FGlu{WSP(bf16_t, W_YS5), WSP(bf16_t, W_Y0), F.in[11]}); }
NOINL void ph_out(PA pa, int layer) { MKFRAME dense_gemm(F, WSP(bf16_t, W_Y0), layer ? WSP(bf16_t, W_OUT1) : WSP(bf16_t, W_OUT0), T / 256, 4, 1024, FStoreScale{WSP(bf16_t, W_MIXB), 1024, 0, 0, 1.f, nullptr}); }
NOINL void ph_in1(PA pa) { MKFRAME
#if IN1_FP8
    { Gemm g; g.A = WSP(unsigned char, W_X8T); g.Bt = WSP(unsigned char, W_IN1); g.rowmap = nullptr; g.bstride = 0; g.KB = 1024; g.wave = F.wave;
      StaticOrder S; S.init(T / 256, 12, F.G, (int)blockIdx.x, nullptr);
      EpiRow8<FStoreScale> E{FStoreScale{WSP(bf16_t, W_HB), 3072, 0, 512, QSCALE1, nullptr, 1.f / (X8_SCALE * WIN1_SCALE)}};
      gemm_phase<false, true, true>(F.lds, g, S, E); }
#else
    dense_gemm(F, WSP(bf16_t, W_XB), WSP(bf16_t, W_IN1), T / 256, 12, 1024, FStoreScale{WSP(bf16_t, W_HB), 3072, 0, 512, QSCALE1, nullptr});
#endif
    p_gr(F); }
NOINL void ph_glaprep(PA pa) { MKFRAME p_gla_prep(F); }
NOINL void ph_glascan(PA pa) { MKFRAME p_gla_scan(F); }
NOINL void ph_glanorm(PA pa) { MKFRAME p_gla_norm(F); }
NOINL void ph_lnrouter(PA pa, int layer) { MKFRAME
    if (layer == 0) p_ln<0, true, false, false>(F, nullptr, WSP(bf16_t, W_XB), WSP(bf16_t, W_XBB), nullptr, F.in[19], F.in[20], F.in[23], F.in[24]);
    else p_ln<0, true, false, false>(F, nullptr, WSP(bf16_t, W_XB), WSP(bf16_t, W_XBB), nullptr, F.in[19] + 1024, F.in[20] + 1024, F.in[23] + (size_t)1024 * 32, F.in[24] + 32); }
NOINL void ph_sort(PA pa, int layer) { MKFRAME if (layer == 1 && CV_NB > 0) cv_pull(F, 2, -1);        p_sort(F); }
NOINL void ph_gateup(PA pa, int layer) { MKFRAME const int* SORT = WSP(int, W_SORT);
    Gemm g; g.A = GU_GATHER ? WSP(unsigned char, W_X8T) : WSP(unsigned char, W_X8); g.Bt = WSP(unsigned char, W_GU) + (size_t)layer * 32 * 2048 * 1024; g.rowmap = GU_GATHER ? WSP(int, R_TOK) : nullptr; g.bstride = (size_t)2048 * 1024; g.KB = 1024; g.wave = F.wave;
    int GG = F.G;
    if (layer == 0 && CV_NB > 0) { GG -= spare_wgs(__builtin_amdgcn_readfirstlane(SORT[33]) * 8, F.G); if ((int)blockIdx.x >= GG) { cv_pull(F, 2, CV_Q_GU / 2); return; } }
    StaticOrder S; S.init(__builtin_amdgcn_readfirstlane(SORT[33]), 8, GG, (int)blockIdx.x, (const LAS int*)(F.lds + LDS_ELIST), GU_WGM); fill_elist(F.lds, S, SORT + 64, F.tid);
    EpiRow8<FSwiglu> E{FSwiglu{WSP(unsigned char, W_ACT), (PK_SWIGLU ? WSP(float, W_BGU2) : F.in[26]) + (size_t)layer * 32 * 2048, 1.f / (X8_SCALE * WGU_SCALE)}};
    gemm_phase<GU_GATHER != 0, true, MOE_ALIGN, DUP_GU>(F.lds, g, S, E); }
NOINL void ph_down(PA pa, int layer) { MKFRAME const int* SORT = WSP(int, W_SORT);
    Gemm g; g.A = WSP(unsigned char, W_ACT); g.Bt = WSP(unsigned char, W_DN) + (size_t)layer * 32 * 1024 * 1024; g.rowmap = nullptr; g.bstride = (size_t)1024 * 1024; g.KB = 1024; g.wave = F.wave;
    int GG = F.G;
    if (layer == 0 && CV_NB > 0) { GG -= spare_wgs(__builtin_amdgcn_readfirstlane(SORT[33]) * 4, F.G); if ((int)blockIdx.x >= GG) { cv_pull(F, 2, CV_Q_DN / 2); return; } }
    StaticOrder S; S.init(__builtin_amdgcn_readfirstlane(SORT[33]), 4, GG, (int)blockIdx.x, (const LAS int*)(F.lds + LDS_ELIST), DN_WGM); fill_elist(F.lds, S, SORT + 64, F.tid);
    EpiRow8<FDown> E{FDown{WSP(unsigned char, W_YS), F.in[28] + (size_t)layer * 32 * 1024, WSP(float, R_WGT), 1.f / (ACT_SCALE * WDN_SCALE)}};
    gemm_phase<false, true, MOE_ALIGN>(F.lds, g, S, E); }
NOINL void ph_combine(PA pa, int layer) { MKFRAME
    if (layer == 0) p_ln<1, false, false, false, false>(F, nullptr, WSP(bf16_t, W_XBB), WSP(bf16_t, W_XB), nullptr, F.in[21], F.in[22], nullptr, nullptr);
    else p_ln<1, false, false, true>(F, nullptr, WSP(bf16_t, W_XBB), nullptr, pa.out, F.in[21] + 1024, F.in[22] + 1024, nullptr, nullptr); }

__global__ void __launch_bounds__(512, 2) mega(Args args) {
    extern __shared__ __attribute__((aligned(16))) unsigned char lds_[];
    LAS unsigned char* lds = (LAS unsigned char*)lds_;
    unsigned* ctl = (unsigned*)(args.ws + W_CTL);
    for (int u = threadIdx.x; u < (LDS_BYTES - LDSCTL_OFF) / 4; u += 512) ((LAS unsigned*)(lds + LDSCTL_OFF))[u] = 0u;
    __syncthreads();
    const int lo = args.ph_lo, hi = args.ph_hi;
    PA pa; pa.in = args.in; pa.ws = args.ws; pa.out = args.out; pa.wave = __builtin_amdgcn_readfirstlane(threadIdx.x >> 6);
    XcdBarrier bar; bar.bar = ctl + CW_BAR; bar.x = 0; bar.st = nullptr; bar.wave = pa.wave;
    if (hi - lo > 1) bar = xcd_barrier_post(ctl + CW_BAR, (volatile LAS unsigned*)(lds + MISC_OFF) + 8, pa.wave);
#define IN(k) (lo <= (k) && (k) < hi)
#ifdef DIAG_LO
    volatile LAS unsigned long long* tsl = (volatile LAS unsigned long long*)(lds + MISC_OFF + 128);
    if (blockIdx.x == 0 && threadIdx.x == 0) tsl[0] = __builtin_amdgcn_s_memrealtime();
#define STAMP(k) do { if (blockIdx.x == 0 && threadIdx.x == 0) tsl[(k) + 1] = __builtin_amdgcn_s_memrealtime(); } while (0)
#else
#define STAMP(k) do { } while (0)
#endif
#define SEAM(k) do { if (IN(k) && IN((k) + 1)) xcd_barrier(bar); STAMP(k); } while (0)
#ifndef REP_PHASE
#define REP_PHASE -1
#define REP_N 0
#endif
#define RUN(k, call) do { if (IN(k)) { call; if ((k) == REP_PHASE) { xcd_barrier(bar); call; } } } while (0)
    RUN(0, ph_prologue(pa)); SEAM(0);
    RUN(1, ph_in0(pa)); SEAM(1);
    if (IN(3)) { ph_s5moba(pa, 1); if (REP_PHASE == 30) ph_s5moba(pa, 1); ph_s5moba(pa, 2); if (REP_PHASE == 31) ph_s5moba(pa, 2); } SEAM(3);
    RUN(4, ph_glu(pa)); SEAM(4);
    RUN(5, ph_out(pa, 0)); SEAM(5);
    if (REP_PHASE == 99) { for (int q_ = 0; q_ < 20; ++q_) xcd_barrier(bar); }
    RUN(6, ph_lnrouter(pa, 0)); SEAM(6);
    RUN(7, ph_sort(pa, 0)); SEAM(7);
    RUN(8, ph_gateup(pa, 0)); SEAM(8);
    RUN(9, ph_down(pa, 0)); SEAM(9);
    RUN(10, ph_combine(pa, 0)); SEAM(10);
    RUN(11, ph_in1(pa)); SEAM(11);
    RUN(12, ph_glaprep(pa)); SEAM(12);
    RUN(13, ph_glascan(pa)); SEAM(13);
    RUN(14, ph_glanorm(pa)); SEAM(14);
    RUN(15, ph_out(pa, 1)); SEAM(15);
    RUN(16, ph_lnrouter(pa, 1)); SEAM(16);
    RUN(17, ph_sort(pa, 1)); SEAM(17);
    RUN(18, ph_gateup(pa, 1)); SEAM(18);
    RUN(19, ph_down(pa, 1)); SEAM(19);
    RUN(20, ph_combine(pa, 1));
#ifdef DIAG_LO
    xcd_barrier(bar); STAMP(20);
    if (blockIdx.x == 0 && threadIdx.x == 0) { const unsigned long long dtk = tsl[DIAG_HI + 1] - tsl[DIAG_LO]; const float f = (float)dtk * (0.01f / 10000.f); __hip_atomic_store(ctl + 8, __float_as_uint(f), __ATOMIC_RELAXED, __HIP_MEMORY_SCOPE_AGENT); }
    xcd_barrier(bar);
    { const float f = __uint_as_float(__hip_atomic_load(ctl + 8, __ATOMIC_RELAXED, __HIP_MEMORY_SCOPE_AGENT));
      for (size_t i = (size_t)blockIdx.x * 512 + threadIdx.x; i < (size_t)T * 1024; i += (size_t)gridDim.x * 512) args.out[i] *= (1.f + f); }
#endif
#undef IN
#undef SEAM
}

static int g_grid = 0;
static bool launch_setup(size_t ws_size) {
    if (g_grid == 0) {
        if (ws_size < W_END) { fprintf(stderr, "kernel_launch: workspace too small: %zu < %zu\n", ws_size, (size_t)W_END); g_grid = -1; return false; }
        int dev = 0, cus = 0, per_cu = 0;
        if (hipGetDevice(&dev) != hipSuccess || hipDeviceGetAttribute(&cus, hipDeviceAttributeMultiprocessorCount, dev) != hipSuccess) { g_grid = -1; return false; }
        if (hipFuncSetAttribute((const void*)mega, hipFuncAttributeMaxDynamicSharedMemorySize, LDS_BYTES) != hipSuccess) { fprintf(stderr, "kernel_launch: hipFuncSetAttribute failed\n"); g_grid = -1; return false; }
        if (hipOccupancyMaxActiveBlocksPerMultiprocessor(&per_cu, (const void*)mega, 512, LDS_BYTES) != hipSuccess || per_cu < 1) fprintf(stderr, "kernel_launch: occupancy query reports %d blocks/CU\n", per_cu);
        (void)hipGetLastError();
        g_grid = cus;
    }
    return g_grid > 0;
}
static void launch_phases(hipStream_t stream, void* const* d_in, void* d_out, void* d_ws, int lo, int hi) {
    Args a; memset(&a, 0, sizeof a);
    for (int i = 0; i < 29; ++i) a.in[i] = (const float*)d_in[i];
    a.out = (float*)d_out; a.ws = (unsigned char*)d_ws; a.ph_lo = lo; a.ph_hi = hi;
    hipLaunchKernelGGL(mega, dim3(g_grid), dim3(512), LDS_BYTES, stream, a);
}
}
extern "C" void kernel_launch(void* const* d_in, const int* in_sizes, int n_in, void* d_out, int out_size, void* d_ws, size_t ws_size, hipStream_t stream) {
    if (n_in != 29 || out_size != T * D) { fprintf(stderr, "kernel_launch: unexpected arguments (n_in %d, out_size %d)\n", n_in, out_size); return; }
    if (!fk::launch_setup(ws_size)) return;
    (void)hipMemsetAsync((char*)d_ws + fk::W_CTL, 0, fk::CTL_ZERO_BYTES, stream);
    fk::launch_phases(stream, d_in, d_out, d_ws, 0, fk::NPH);
}
```
